# Optimizing an MI355X kernel written in HIP

```python
import math
import jax, jax.numpy as jnp
from jax import lax
import numpy as np

D_MODEL = 2048
BATCH = 1
SEQ = 16384
DEPTH = 1

GRID_W = 64
CTX_LEN = 256
N_HEADS = 8
QK_HEAD = 64
V_HEAD = 128
QK_W = N_HEADS * QK_HEAD
MV_W = N_HEADS * V_HEAD
HY_W = D_MODEL - MV_W
CHUNK = 128
FILT_BANDS = 16
FILT_EMB = 2 * FILT_BANDS + 1
FILT_HIDDEN = 64
DECAY_TARGET = 1e-2
FAST_DECAY_PCT = 0.3
SLOW_DECAY_PCT = 1.5
N_EXPERTS = 64
N_GROUPS = 8
E_PER_GROUP = N_EXPERTS // N_GROUPS
TOPK_GROUPS = 4
TOP_K = 8
D_EXPERT = 512
D_SHARED = 512
ROUTE_SCALE = 2.5
MOE_BLOCK = 128
EPS = 1e-6
OFF_K = 0
OFF_V = OFF_K + QK_W
OFF_G = OFF_V + MV_W
OFF_Q = OFF_G + 4 * N_HEADS
OFF_O = OFF_Q + QK_W
OFF_HY = OFF_O + MV_W
IN_COLS = OFF_HY + 3 * HY_W

kernel_name = 'hybrid_mlstm_hyena_moe_prefix_dit'

F32 = jnp.float32


def rmsnorm(x, g):
    xf = x.astype(F32)
    y = xf * lax.rsqrt(jnp.mean(xf * xf, axis=-1, keepdims=True) + EPS)
    return (y * g.astype(F32)).astype(x.dtype)


def modulate(h, shift, scale):
    return h * (1 + scale) + shift


def short_conv(x, w, b):
    L = x.shape[1]
    xp = jnp.pad(x, ((0, 0), (1, 1), (0, 0)))
    return xp[:, :L] * w[0] + xp[:, 1:L + 1] * w[1] + xp[:, 2:L + 2] * w[2] + b


def flip(a):
    return jnp.flip(a, axis=1)


def pos_embed_2d(n_tokens):
    rows = n_tokens // GRID_W
    quarter = D_MODEL // 4
    omega = 1.0 / (10000.0 ** (jnp.arange(quarter, dtype=F32) / quarter))

    def emb1d(pos):
        ang = pos[:, None] * omega[None]
        return jnp.concatenate([jnp.sin(ang), jnp.cos(ang)], axis=-1)

    e_row = emb1d(jnp.arange(rows, dtype=F32))
    e_col = emb1d(jnp.arange(GRID_W, dtype=F32))
    half = D_MODEL // 2
    grid = jnp.concatenate([jnp.broadcast_to(e_row[:, None], (rows, GRID_W, half)),
                            jnp.broadcast_to(e_col[None], (rows, GRID_W, half))], axis=-1)
    return grid.reshape(rows * GRID_W, D_MODEL)


def _to_chunks(a):
    B, L = a.shape[:2]
    a = a.reshape((B, L // CHUNK, CHUNK) + a.shape[2:])
    return jnp.moveaxis(a, 3, 1)


def _from_chunks(a):
    B, H, NC, CH = a.shape[:4]
    return jnp.moveaxis(a, 1, 3).reshape((B, NC * CH, H) + a.shape[4:])


def zero_state(b):
    return (jnp.zeros((b, N_HEADS, QK_HEAD, V_HEAD), F32),
            jnp.zeros((b, N_HEADS, QK_HEAD), F32),
            jnp.zeros((b, N_HEADS), F32))


def _chunk_summaries(kc, vc, ic, fc):
    b = jnp.cumsum(fc, axis=-1)
    g = b[..., -1]
    a = g[..., None] - b + ic
    m_loc = jnp.max(a, axis=-1)
    wgt = jnp.exp(a - m_loc[..., None])
    c_loc = jnp.einsum('bhncd,bhnc,bhnce->bhnde', kc, wgt, vc)
    n_loc = jnp.einsum('bhncd,bhnc->bhnd', kc, wgt)
    return b, g, m_loc, c_loc, n_loc


def _chunk_scan(g, m_loc, c_loc, n_loc, init):
    def step(state, inp):
        c_st, n_st, m_st = state
        g_c, m_l, c_l, n_l = inp
        m_new = jnp.maximum(g_c + m_st, m_l)
        s_prev = jnp.exp(g_c + m_st - m_new)
        s_loc = jnp.exp(m_l - m_new)
        c_new = s_prev[..., None, None] * c_st + s_loc[..., None, None] * c_l
        n_new = s_prev[..., None] * n_st + s_loc[..., None] * n_l
        return (c_new, n_new, m_new), (c_st, n_st, m_st)

    xs = (jnp.moveaxis(g, 2, 0), jnp.moveaxis(m_loc, 2, 0),
          jnp.moveaxis(c_loc, 2, 0), jnp.moveaxis(n_loc, 2, 0))
    final, incoming = lax.scan(step, init, xs)
    c_in, n_in, m_in = incoming
    return final, (jnp.moveaxis(c_in, 0, 2), jnp.moveaxis(n_in, 0, 2), jnp.moveaxis(m_in, 0, 2))


def mlstm_final_state(k, v, i_pre, logf, init):
    kc, vc = _to_chunks(k.astype(F32)), _to_chunks(v.astype(F32))
    ic, fc = _to_chunks(i_pre), _to_chunks(logf)
    _, g, m_loc, c_loc, n_loc = _chunk_summaries(kc, vc, ic, fc)
    final, _ = _chunk_scan(g, m_loc, c_loc, n_loc, init)
    return final


def mlstm_direction(q, k, v, i_pre, logf, init):
    qc, kc, vc = _to_chunks(q.astype(F32)), _to_chunks(k.astype(F32)), _to_chunks(v.astype(F32))
    ic, fc = _to_chunks(i_pre), _to_chunks(logf)
    b, g, m_loc, c_loc, n_loc = _chunk_summaries(kc, vc, ic, fc)
    final, (c_in, n_in, m_in) = _chunk_scan(g, m_loc, c_loc, n_loc, init)
    lower = jnp.tril(jnp.ones((CHUNK, CHUNK), bool))
    d_log = jnp.where(lower, b[..., :, None] - b[..., None, :] + ic[..., None, :], -jnp.inf)
    inter = b + m_in[..., None]
    m_t = jnp.maximum(inter, jnp.max(d_log, axis=-1))
    s = jnp.einsum('bhntd,bhnsd->bhnts', qc, kc) * jnp.exp(d_log - m_t[..., None])
    sc = jnp.exp(inter - m_t)
    num = jnp.einsum('bhnts,bhnse->bhnte', s, vc) + sc[..., None] * jnp.einsum('bhntd,bhnde->bhnte', qc, c_in)
    den = jnp.sum(s, axis=-1) + sc * jnp.einsum('bhntd,bhnd->bhnt', qc, n_in)
    h = num / jnp.maximum(jnp.abs(den), jnp.exp(-m_t))[..., None]
    return _from_chunks(h), final


def mlstm_kv_gates(z, p):
    B, L = z.shape[:2]
    k = jax.nn.silu(short_conv(z[..., OFF_K:OFF_V], p['conv_k_w'], p['conv_k_b'])).reshape(B, L, N_HEADS, QK_HEAD)
    v = z[..., OFF_V:OFF_G].reshape(B, L, N_HEADS, V_HEAD)
    gts = z[..., OFF_G:OFF_Q].astype(F32) + p['b_gates'].astype(F32)
    i_f, f_f, i_b, f_b = jnp.split(gts, 4, axis=-1)
    return k, v, (i_f, jax.nn.log_sigmoid(f_f)), (i_b, jax.nn.log_sigmoid(f_b))


def context_states(z, p):
    k, v, gf, gb = mlstm_kv_gates(z, p)
    init = zero_state(z.shape[0])
    st_f = mlstm_final_state(k, v, gf[0], gf[1], init)
    st_b = mlstm_final_state(flip(k), flip(v), flip(gb[0]), flip(gb[1]), init)
    return st_f, st_b


def hyena_filters(L, p):
    t = jnp.arange(L, dtype=F32)
    t01 = t / max(L - 1, 1)
    w = 2.0 * math.pi * t / L
    bands = jnp.linspace(1e-4, FILT_BANDS - 1, FILT_BANDS, dtype=F32)
    feats = jnp.concatenate([t01[:, None], jnp.cos(w[:, None] * bands), -jnp.sin(w[:, None] * bands)], axis=-1)
    hdn = jnp.sin(p['filt_freq1'] * (feats @ p['filt_w1'] + p['filt_b1']))
    hdn = jnp.sin(p['filt_freq2'] * (hdn @ p['filt_w2'] + p['filt_b2']))
    h = (hdn @ p['filt_w3'] + p['filt_b3']).astype(F32).reshape(L, 2, HY_W)
    rates = jnp.linspace(-math.log(DECAY_TARGET) / SLOW_DECAY_PCT, -math.log(DECAY_TARGET) / FAST_DECAY_PCT, HY_W, dtype=F32)
    h = h * jnp.exp(-t01[:, None] * rates[None])[:, None, :]
    h_f, h_b = h[:, 0], h[:, 1]
    l1 = jnp.sum(jnp.abs(h_f), axis=0) + jnp.sum(jnp.abs(h_b[1:]), axis=0)
    return h_f / l1, h_b / l1


def bidir_fftconv(u, h_f, h_b, dskip):
    L, C = h_f.shape
    k_full = jnp.concatenate([h_f, jnp.zeros((1, C), F32), h_b[1:][::-1]], axis=0)
    k_hat = jnp.fft.rfft(k_full, n=2 * L, axis=0)
    u_hat = jnp.fft.rfft(u.astype(F32), n=2 * L, axis=1)
    y = jnp.fft.irfft(u_hat * k_hat[None], n=2 * L, axis=1)[:, :L]
    return (y + u.astype(F32) * dskip.astype(F32)).astype(u.dtype)


def hyena(z_hy, p):
    L = z_hy.shape[1]
    u = short_conv(z_hy, p['conv_hy_w'], p['conv_hy_b'])
    x0, x1, v = jnp.split(u, 3, axis=-1)
    h_f, h_b = hyena_filters(L, p)
    return x0 * bidir_fftconv(x1 * v, h_f, h_b, p['hy_dskip'])


def mixer(z, p, init_f, init_b):
    B, L = z.shape[:2]
    k, v, gf, gb = mlstm_kv_gates(z, p)
    q = jax.nn.silu(short_conv(z[..., OFF_Q:OFF_O], p['conv_q_w'], p['conv_q_b'])).reshape(B, L, N_HEADS, QK_HEAD) * (QK_HEAD ** -0.5)
    h_f, st_f = mlstm_direction(q, k, v, gf[0], gf[1], init_f)
    h_b, st_b = mlstm_direction(flip(q), flip(k), flip(v), flip(gb[0]), flip(gb[1]), init_b)
    h = h_f + flip(h_b)
    h = h * lax.rsqrt(jnp.mean(h * h, axis=-1, keepdims=True) + EPS) * p['g_head'].astype(F32).reshape(N_HEADS, V_HEAD)
    y_m = h.reshape(B, L, MV_W).astype(z.dtype) * jax.nn.sigmoid(z[..., OFF_O:OFF_HY])
    y_h = hyena(z[..., OFF_HY:], p)
    y = jnp.concatenate([y_m, y_h], axis=-1) @ p['w_out']
    return y, st_f, st_b


def moe_ffn(h, p):
    B, L, D = h.shape
    xt = h.reshape(B * L, D)
    T = xt.shape[0]
    s = jax.nn.sigmoid((xt @ p['w_router']).astype(F32))
    sel = s + p['b_router'].astype(F32)
    gscore = jnp.sum(lax.top_k(sel.reshape(T, N_GROUPS, E_PER_GROUP), 2)[0], axis=-1)
    _, gidx = lax.top_k(gscore, TOPK_GROUPS)
    gmask = jnp.any(gidx[..., None] == jnp.arange(N_GROUPS), axis=1)
    masked = jnp.where(jnp.repeat(gmask, E_PER_GROUP, axis=1), sel, -jnp.inf)
    _, eidx = lax.top_k(masked, TOP_K)
    w = jnp.take_along_axis(s, eidx, axis=1)
    w = w / jnp.sum(w, axis=-1, keepdims=True) * ROUTE_SCALE
    M = T * TOP_K
    e_flat = eidx.reshape(M)
    tok_flat = jnp.arange(M, dtype=jnp.int32) // TOP_K
    w_flat = w.reshape(M)
    order = jnp.argsort(e_flat)
    e_sorted = e_flat[order]
    counts = jnp.zeros((N_EXPERTS,), jnp.int32).at[e_flat].add(1)
    starts = jnp.cumsum(counts) - counts
    pcounts = (counts + MOE_BLOCK - 1) // MOE_BLOCK * MOE_BLOCK
    pends = jnp.cumsum(pcounts)
    pstarts = pends - pcounts
    dest = pstarts[e_sorted] + (jnp.arange(M, dtype=jnp.int32) - starts[e_sorted])
    nb = -(-M // MOE_BLOCK) + N_EXPERTS
    buf_tok = jnp.zeros((nb * MOE_BLOCK,), jnp.int32).at[dest].set(tok_flat[order])
    buf_w = jnp.zeros((nb * MOE_BLOCK,), F32).at[dest].set(w_flat[order])
    blk_exp = jnp.minimum(jnp.searchsorted(pends, jnp.arange(nb, dtype=jnp.int32) * MOE_BLOCK, side='right'), N_EXPERTS - 1)
    w1_e, w3_e, w2_e = p['w1_e'], p['w3_e'], p['w2_e']

    def body(out, blk):
        tok, wt, e = blk
        xb = xt[tok]
        yb = (jax.nn.silu(xb @ w1_e[e]) * (xb @ w3_e[e])) @ w2_e[e]
        return out.at[tok].add(yb * wt.astype(yb.dtype)[:, None]), None

    routed, _ = lax.scan(body, jnp.zeros_like(xt),
                         (buf_tok.reshape(nb, MOE_BLOCK), buf_w.reshape(nb, MOE_BLOCK), blk_exp))
    shared = (jax.nn.silu(xt @ p['w1_s']) * (xt @ p['w3_s'])) @ p['w2_s']
    return (routed + shared).reshape(B, L, D)


def setup_inputs(seed: int = 0) -> dict:
    key = jax.random.key(seed)
    keys = iter(jax.random.split(key, 48))

    def nrm(shape, scale):
        return jax.random.normal(next(keys), shape, F32) * scale

    D = D_MODEL
    f_bias = jnp.broadcast_to(jnp.linspace(3.0, 6.0, N_HEADS, dtype=F32), (DEPTH, N_HEADS))
    b_gates = jnp.concatenate([nrm((DEPTH, N_HEADS), 0.1), f_bias + nrm((DEPTH, N_HEADS), 0.1),
                               nrm((DEPTH, N_HEADS), 0.1), f_bias + nrm((DEPTH, N_HEADS), 0.1)], axis=-1)
    return {
        'x': nrm((BATCH, SEQ, D), 1.0),
        'c': nrm((BATCH, D), 1.0),
        'ctx': nrm((BATCH, CTX_LEN, D), 1.0),
        'c_ctx': nrm((D,), 1.0),
        'w_ada': nrm((DEPTH, D, 6 * D), D ** -0.5),
        'b_ada': nrm((DEPTH, 6 * D), 0.02),
        'g_mix': 1.0 + nrm((DEPTH, D), 0.05),
        'g_ffn': 1.0 + nrm((DEPTH, D), 0.05),
        'w_in': nrm((DEPTH, D, IN_COLS), D ** -0.5),
        'b_gates': b_gates,
        'conv_k_w': nrm((DEPTH, 3, QK_W), 0.5),
        'conv_k_b': nrm((DEPTH, QK_W), 0.02),
        'conv_q_w': nrm((DEPTH, 3, QK_W), 0.5),
        'conv_q_b': nrm((DEPTH, QK_W), 0.02),
        'g_head': 1.0 + nrm((DEPTH, MV_W), 0.05),
        'conv_hy_w': nrm((DEPTH, 3, 3 * HY_W), 0.5),
        'conv_hy_b': nrm((DEPTH, 3 * HY_W), 0.02),
        'filt_w1': nrm((DEPTH, FILT_EMB, FILT_HIDDEN), FILT_EMB ** -0.5),
        'filt_b1': nrm((DEPTH, FILT_HIDDEN), 0.02),
        'filt_freq1': 1.0 + nrm((DEPTH, FILT_HIDDEN), 0.05),
        'filt_w2': nrm((DEPTH, FILT_HIDDEN, FILT_HIDDEN), FILT_HIDDEN ** -0.5),
        'filt_b2': nrm((DEPTH, FILT_HIDDEN), 0.02),
        'filt_freq2': 1.0 + nrm((DEPTH, FILT_HIDDEN), 0.05),
        'filt_w3': nrm((DEPTH, FILT_HIDDEN, 2 * HY_W), FILT_HIDDEN ** -0.5),
        'filt_b3': nrm((DEPTH, 2 * HY_W), 0.02),
        'hy_dskip': nrm((DEPTH, HY_W), 1.0),
        'w_out': nrm((DEPTH, D, D), D ** -0.5),
        'w_router': nrm((DEPTH, D, N_EXPERTS), D ** -0.5),
        'b_router': nrm((DEPTH, N_EXPERTS), 0.01),
        'w1_e': nrm((DEPTH, N_EXPERTS, D, D_EXPERT), D ** -0.5),
        'w3_e': nrm((DEPTH, N_EXPERTS, D, D_EXPERT), D ** -0.5),
        'w2_e': nrm((DEPTH, N_EXPERTS, D_EXPERT, D), D_EXPERT ** -0.5),
        'w1_s': nrm((DEPTH, D, D_SHARED), D ** -0.5),
        'w3_s': nrm((DEPTH, D, D_SHARED), D ** -0.5),
        'w2_s': nrm((DEPTH, D_SHARED, D), D_SHARED ** -0.5),
        'g_final': 1.0 + nrm((D,), 0.05),
    }


def reference(x, c, ctx, c_ctx, w_ada, b_ada, g_mix, g_ffn, w_in, b_gates, conv_k_w, conv_k_b,
              conv_q_w, conv_q_b, g_head, conv_hy_w, conv_hy_b, filt_w1, filt_b1, filt_freq1,
              filt_w2, filt_b2, filt_freq2, filt_w3, filt_b3, hy_dskip, w_out, w_router, b_router,
              w1_e, w3_e, w2_e, w1_s, w3_s, w2_s, g_final):
    B, L, _ = x.shape
    x = x + pos_embed_2d(L).astype(x.dtype)[None]
    x_ctx = ctx
    for li in range(DEPTH):
        p = {'b_gates': b_gates[li], 'conv_k_w': conv_k_w[li], 'conv_k_b': conv_k_b[li],
             'conv_q_w': conv_q_w[li], 'conv_q_b': conv_q_b[li], 'g_head': g_head[li],
             'conv_hy_w': conv_hy_w[li], 'conv_hy_b': conv_hy_b[li],
             'filt_w1': filt_w1[li], 'filt_b1': filt_b1[li], 'filt_freq1': filt_freq1[li],
             'filt_w2': filt_w2[li], 'filt_b2': filt_b2[li], 'filt_freq2': filt_freq2[li],
             'filt_w3': filt_w3[li], 'filt_b3': filt_b3[li], 'hy_dskip': hy_dskip[li],
             'w_out': w_out[li], 'w_router': w_router[li], 'b_router': b_router[li],
             'w1_e': w1_e[li], 'w3_e': w3_e[li], 'w2_e': w2_e[li],
             'w1_s': w1_s[li], 'w3_s': w3_s[li], 'w2_s': w2_s[li]}
        mod = jax.nn.silu(c) @ w_ada[li] + b_ada[li]
        sh1, sc1, g1, sh2, sc2, g2 = jnp.split(mod[:, None, :], 6, axis=-1)
        mod_c = jax.nn.silu(c_ctx) @ w_ada[li] + b_ada[li]
        csh1, csc1, cg1, csh2, csc2, cg2 = jnp.split(mod_c, 6, axis=-1)
        hc = modulate(rmsnorm(x_ctx, g_mix[li]), csh1, csc1)
        if li == DEPTH - 1:
            st_f, st_b = context_states(hc @ w_in[li][:, :OFF_Q], p)
        else:
            init = zero_state(B)
            y_c, st_f, st_b = mixer(hc @ w_in[li], p, init, init)
            x_ctx = x_ctx + cg1 * y_c
            x_ctx = x_ctx + cg2 * moe_ffn(modulate(rmsnorm(x_ctx, g_ffn[li]), csh2, csc2), p)
        h = modulate(rmsnorm(x, g_mix[li]), sh1, sc1)
        y, _, _ = mixer(h @ w_in[li], p, st_f, st_b)
        x = x + g1 * y
        x = x + g2 * moe_ffn(modulate(rmsnorm(x, g_ffn[li]), sh2, sc2), p)
    return rmsnorm(x, g_final)
```

```cpp
#include <hip/hip_runtime.h>
#include <cstdio>
#include <cstdint>

#ifndef MK_N_LAUNCHES
#define MK_N_LAUNCHES 1
#endif
#ifndef MK_STOP_AFTER
#define MK_STOP_AFTER 99
#endif

#define GAS __attribute__((address_space(1)))
#define LAS __attribute__((address_space(3)))
typedef unsigned short bf16;
typedef unsigned v4u __attribute__((ext_vector_type(4)));
typedef unsigned v2u __attribute__((ext_vector_type(2)));
typedef float f32x4 __attribute__((ext_vector_type(4)));
typedef float f32x2 __attribute__((ext_vector_type(2)));
typedef short bf16x8 __attribute__((ext_vector_type(8)));
#define LDS_WAIT() asm volatile("s_waitcnt lgkmcnt(0)" ::: "memory")
#define VM_WAIT() asm volatile("s_waitcnt vmcnt(0)" ::: "memory")

constexpr int NWAVES = 8, NT = NWAVES * 64;
constexpr int L = 16384, D = 2048, LC = 256, MROWS = L + LC;
constexpr int NIN = 6176, NINP = 6400;
constexpr int OFF_K = 0, OFF_V = 512, OFF_G = 1536, OFF_Q = 1568, OFF_O = 2080, OFF_HY = 3104;
constexpr int NH = 8, HYW = 1024, MVW = 1024;
constexpr int NE = 64, NE1 = 65, DE = 512;
constexpr int HALF_T = 8192;
constexpr int MAXROWS = 90112;
constexpr float EPS = 1e-6f;

constexpr size_t MiB = 1u << 20;
constexpr size_t WS_CTL = 0, CTL_ZERO_BYTES = 256 * 1024;
constexpr size_t WS_MOD = 1 * MiB;
constexpr size_t WS_POS = WS_MOD + 128 * 1024;
constexpr size_t WS_WIN = 3 * MiB;
constexpr size_t WS_WOUT = 28 * MiB;
constexpr size_t WS_W13 = 36 * MiB;
constexpr size_t WS_W2 = 296 * MiB;
constexpr size_t WS_HA = 426 * MiB;
constexpr size_t WS_Z = 491 * MiB;
constexpr size_t WS_CAT = 695 * MiB;
constexpr size_t WS_UIN = 759 * MiB;
constexpr size_t WS_KF = 823 * MiB;
constexpr size_t WS_KB = 887 * MiB;
constexpr size_t WS_HF = 951 * MiB;
constexpr size_t WS_HB = 983 * MiB;
constexpr size_t WS_RTOK = 1015 * MiB;
constexpr size_t WS_RW = WS_RTOK + 2 * MAXROWS * 4;
constexpr size_t WS_AEXP = 1017 * MiB;
constexpr size_t WS_ARANK = WS_AEXP + 512 * 1024;
constexpr size_t WS_AW = WS_ARANK + 512 * 1024;
constexpr size_t WS_L1P = 1019 * MiB;
constexpr size_t WS_END = 1021 * MiB;
constexpr size_t WS_HR = 491 * MiB;
constexpr size_t WS_Y2 = 579 * MiB;
static_assert(WS_Y2 + (size_t)MAXROWS * 2048 * 2 <= WS_HF, "overlay");
constexpr int CW_BAR = 4096;
constexpr int CW_CNT = 16384;

constexpr int RING_BYTES = 131072;
constexpr int LDSCTL_OFF = RING_BYTES;
constexpr int LDS_BYTES = 147456;

__device__ __forceinline__ unsigned cvt_pk_bf16(float lo, float hi) { unsigned r; asm volatile("v_cvt_pk_bf16_f32 %0, %1, %2" : "=v"(r) : "v"(lo), "v"(hi)); return r; }
__device__ __forceinline__ float bf2f(unsigned short b) { return __builtin_bit_cast(float, ((unsigned)b) << 16); }
__device__ __forceinline__ float bflo(unsigned u) { return __builtin_bit_cast(float, u << 16); }
__device__ __forceinline__ float bfhi(unsigned u) { return __builtin_bit_cast(float, u & 0xffff0000u); }
__device__ __forceinline__ float wave_sum(float v) {
#pragma unroll
    for (int o = 1; o < 64; o <<= 1) v += __shfl_xor(v, o);
    return v;
}
__device__ __forceinline__ float silu_f(float a) { return a / (1.f + __expf(-a)); }
__device__ __forceinline__ float sigmoid_f(float a) { return 1.f / (1.f + __expf(-a)); }

#define XB_TMO      128
#define XB_XCNT(j)  (256  + 64 * (j))
#define XB_XSUB(j)  (1280 + 64 * (j))
#define XB_XGEN(j)  (2304 + 64 * (j))
#define XB_TOP      3328
#define XB_TOPGEN   3392
#define XCD_BAR_WORDS 3456
#define XB_SPIN_CAP (1u << 18)

__device__ __forceinline__ unsigned xb_ld(unsigned* p)              { return __hip_atomic_load(p, __ATOMIC_RELAXED, __HIP_MEMORY_SCOPE_AGENT); }
__device__ __forceinline__ unsigned xb_add(unsigned* p, unsigned v) { return __hip_atomic_fetch_add(p, v, __ATOMIC_RELAXED, __HIP_MEMORY_SCOPE_AGENT); }
__device__ __forceinline__ unsigned xb_xcc_id() { return (unsigned)__builtin_amdgcn_s_getreg((3 << 11) | 20) & 0xFu; }
#define XB_SPIN(cond, bar) do { unsigned _sp = 0; while (cond) { __builtin_amdgcn_s_sleep(1); \
    if ((++_sp & 255u) == 0u) { if (xb_ld(&(bar)[XB_TMO])) break; if (_sp > XB_SPIN_CAP) { atomicAdd(&(bar)[XB_TMO], 1u); break; } } } } while (0)

struct XcdBarrier {
    unsigned* bar; unsigned x;
    volatile LAS unsigned* st;
};

__device__ __forceinline__ XcdBarrier xcd_barrier_post(unsigned* bar, volatile LAS unsigned* st) {
    XcdBarrier b; b.bar = bar; b.x = xb_xcc_id(); b.st = st;
    if (threadIdx.x == 0) (void)xb_add(&bar[XB_XCNT(b.x)], 1u);
    return b;
}
__device__ __forceinline__ void xcd_barrier_complete(unsigned* bar, unsigned x, unsigned& nloc, unsigned& nx) {
    const unsigned G = gridDim.x * gridDim.y * gridDim.z;
    unsigned sum, cnt, mine, sp = 0u;
    for (;;) {
        sum = 0u; cnt = 0u; mine = 0u;
#pragma unroll
        for (unsigned j = 0; j < 16; ++j) { const unsigned c = xb_ld(&bar[XB_XCNT(j)]); sum += c; cnt += (c > 0u) ? 1u : 0u; mine = (j == x) ? c : mine; }
        if (sum == G) break;
        __builtin_amdgcn_s_sleep(1);
        if ((++sp & 255u) == 0u) { if (xb_ld(&bar[XB_TMO])) break; if (sp > XB_SPIN_CAP) { atomicAdd(&bar[XB_TMO], 1u); break; } }
    }
    nloc = mine > 0u ? mine : 1u; nx = cnt > 0u ? cnt : 1u;
}

__device__ __forceinline__ void xcd_barrier(const XcdBarrier& b) {
    asm volatile("s_waitcnt vmcnt(0)" ::: "memory");
    __syncthreads();
    if (threadIdx.x == 0) {
        unsigned* bar = b.bar;
        __builtin_amdgcn_s_waitcnt(0);
        unsigned nloc = b.st[0], nx = b.st[1];
        if (nloc == 0u) { xcd_barrier_complete(bar, b.x, nloc, nx); b.st[0] = nloc; b.st[1] = nx; }
        const unsigned old = xb_add(&bar[XB_XSUB(b.x)], 1u);
        const unsigned gen = old / nloc;
        if (old + 1u == (gen + 1u) * nloc) {
            __builtin_amdgcn_fence(__ATOMIC_RELEASE, "agent");
            asm volatile("s_waitcnt vmcnt(0)" ::: "memory");
            const unsigned og = xb_add(&bar[XB_TOP], 1u);
            const unsigned tg = og / nx;
            if (og + 1u == (tg + 1u) * nx) xb_add(&bar[XB_TOPGEN], 1u);
            else XB_SPIN(xb_ld(&bar[XB_TOPGEN]) == tg, bar);
            __builtin_amdgcn_fence(__ATOMIC_ACQUIRE, "agent");
            xb_add(&bar[XB_XGEN(b.x)], 1u);
            asm volatile("s_waitcnt vmcnt(0)" ::: "memory");
        } else {
            XB_SPIN(xb_ld(&bar[XB_XGEN(b.x)]) == gen, bar);
            __builtin_amdgcn_fence(__ATOMIC_ACQUIRE, "agent");
            asm volatile("s_waitcnt vmcnt(0)" ::: "memory");
        }
    }
    __syncthreads();
}

namespace gk {
constexpr int BM = 256, BK = 64, HALF = 128, HTB = HALF * BK * 2, STAGE_BYTES = 8 * HTB, NXCD = 8, WGM = 8;
__host__ __device__ __forceinline__ int lds_byte(int r, int c) { const int st = (r >> 4) * 2 + (c >> 5), rr = r & 15, cc = c & 31, ob = rr * 64 + cc * 2; return st * 1024 + (ob ^ (((ob >> 9) & 1) << 5)); }
__host__ __device__ __forceinline__ void stage_rc(int b, int& R, int& C) { const int st = b / 1024, sb = b % 1024, swz = sb ^ (((sb >> 9) & 1) << 5); R = (st >> 1) * 16 + swz / 64; C = (st & 1) * 32 + (swz % 64) / 2; }
__host__ __device__ __forceinline__ int perm32(int rho) { const int n = rho >> 4, i = rho & 15; return 8 * (i >> 2) + 4 * n + (i & 3); }

struct Unit { int pm, pn, ex; };

template <class Epi, class Sched>
__device__ __forceinline__ void gemm_core(LAS unsigned char* lds, const char* Abase, const int K, const Sched& S, const Epi& E) {
    const int tid = threadIdx.x, wid = __builtin_amdgcn_readfirstlane(tid >> 6), lane = tid & 63, wr = wid >> 2, wc = wid & 3, fr = lane & 15, fq = lane >> 4;
    const int nt = K / BK;
    int RA[2], CA[2]; unsigned voffB[2];
#pragma unroll
    for (int i = 0; i < 2; ++i) { int R, C; stage_rc(tid * 16 + i * 8192, R, C); const int Rb = Epi::PERM ? ((R & ~31) + perm32(R & 31)) : R;
        RA[i] = R; CA[i] = C; voffB[i] = (unsigned)(Rb * K + C) * 2u; }
    const size_t kstep = (size_t)(BK * 2);
    const size_t hstepB = (size_t)HALF * K * 2;
    const unsigned ldsw = (unsigned)wid * 1024u;
    const int aoff = lds_byte(wr * 64 + fr, fq * 8), boff = lds_byte(wc * 32 + fr, fq * 8);
#define GK_SA(b, h) (((b) * 2 + (h)) * HTB)
#define GK_SB(b, h) ((4 + (b) * 2 + (h)) * HTB)
#define GK_STAGE(bufoff, gbase, v0, v1) do { \
        __builtin_amdgcn_global_load_lds((const unsigned*)((const char*)(gbase) + (v0)), (LAS unsigned*)(lds + (bufoff) + ldsw), 16, 0, 0); \
        __builtin_amdgcn_global_load_lds((const unsigned*)((const char*)(gbase) + (v1)), (LAS unsigned*)(lds + (bufoff) + ldsw + 8192), 16, 0, 0); } while (0)
#define GK_LDA(dst, b, h) do { _Pragma("unroll") for (int m = 0; m < 4; ++m) _Pragma("unroll") for (int k = 0; k < 2; ++k) dst[m][k] = *(const LAS bf16x8*)(lds + GK_SA(b, h) + aoff + m * 2048 + k * 1024); } while (0)
#define GK_LDB(dst, b, h) do { _Pragma("unroll") for (int n = 0; n < 2; ++n) _Pragma("unroll") for (int k = 0; k < 2; ++k) dst[n][k] = *(const LAS bf16x8*)(lds + GK_SB(b, h) + boff + n * 2048 + k * 1024); } while (0)
#define GK_MMA(ai, bj, At, Bt) do { __builtin_amdgcn_s_setprio(1); _Pragma("unroll") for (int m = 0; m < 4; ++m) _Pragma("unroll") for (int n = 0; n < 2; ++n) _Pragma("unroll") for (int k = 0; k < 2; ++k) \
        acc[ai][bj][m][n] = __builtin_amdgcn_mfma_f32_16x16x32_bf16(Bt[n][k], At[m][k], acc[ai][bj][m][n], 0, 0, 0); __builtin_amdgcn_s_setprio(0); } while (0)
#define GK_WAIT_V(n) asm volatile("s_waitcnt vmcnt(" #n ")" ::: "memory")
#define GK_WAIT_L(n) asm volatile("s_waitcnt lgkmcnt(" #n ")" ::: "memory")
#define GK_BAR __builtin_amdgcn_s_barrier()
#define GK_SCHED __builtin_amdgcn_sched_barrier(0)
    Unit cur, nxt; int ui = 0;
    if (!S.next(0, cur)) return;
    f32x4 acc[2][2][4][2];
#pragma unroll
    for (int a = 0; a < 2; ++a)
#pragma unroll
        for (int b = 0; b < 2; ++b)
#pragma unroll
            for (int m = 0; m < 4; ++m)
#pragma unroll
                for (int n = 0; n < 2; ++n) acc[a][b][m][n] = (f32x4){0.f, 0.f, 0.f, 0.f};
    bf16x8 At[4][2], B0[2][2], B1[2][2];
    unsigned c00, c01, c10, c11, n00, n01, n10, n11;
    S.a_offs(cur, RA, CA, c00, c01, c10, c11);
    asm volatile("" : "+v"(c00), "+v"(c01), "+v"(c10), "+v"(c11));
    const char* cB = S.b_base(cur);
    GK_STAGE(GK_SB(0, 0), cB, voffB[0], voffB[1]); GK_STAGE(GK_SB(0, 1), cB + hstepB, voffB[0], voffB[1]); GK_STAGE(GK_SA(0, 0), Abase, c00, c01); GK_STAGE(GK_SA(0, 1), Abase, c10, c11);
    if (wr == 1) GK_BAR;
    GK_WAIT_V(2); GK_BAR;
    GK_STAGE(GK_SB(1, 0), cB + kstep, voffB[0], voffB[1]); GK_STAGE(GK_SA(1, 0), Abase + kstep, c00, c01); GK_STAGE(GK_SB(1, 1), cB + hstepB + kstep, voffB[0], voffB[1]);
    GK_WAIT_V(6); GK_BAR;
    for (;;) {
        const bool has_next = S.next(ui + 1, nxt);
        const char* nB = cB;
        n00 = c00; n01 = c01; n10 = c10; n11 = c11;
        if (has_next) { S.a_offs(nxt, RA, CA, n00, n01, n10, n11); nB = S.b_base(nxt); }
        asm volatile("" : "+v"(n00), "+v"(n01), "+v"(n10), "+v"(n11));
        for (int t = 0; t < nt; t += 2) {
            const bool last = (t == nt - 2);
            const char* a1 = Abase + (size_t)(t + 1) * kstep;
            const char* a2 = last ? Abase : Abase + (size_t)(t + 2) * kstep; const char* b2 = last ? nB : cB + (size_t)(t + 2) * kstep;
            const char* a3 = a2 + kstep; const char* b3 = b2 + kstep;
            const unsigned x00 = last ? n00 : c00, x01 = last ? n01 : c01, x10 = last ? n10 : c10, x11 = last ? n11 : c11;
            GK_LDB(B0, 0, 0); GK_LDB(B1, 0, 1); GK_SCHED; GK_LDA(At, 0, 0); GK_STAGE(GK_SA(1, 1), a1, c10, c11);
            GK_WAIT_V(8); GK_WAIT_L(0); GK_BAR; GK_MMA(0, 0, At, B0); GK_MMA(0, 1, At, B1); GK_BAR; GK_SCHED;
            GK_LDA(At, 0, 1); GK_STAGE(GK_SB(0, 0), b2, voffB[0], voffB[1]); GK_STAGE(GK_SB(0, 1), b2 + hstepB, voffB[0], voffB[1]); GK_STAGE(GK_SA(0, 0), a2, x00, x01);
            GK_WAIT_V(8); GK_WAIT_L(0); GK_BAR; GK_MMA(1, 0, At, B0); GK_MMA(1, 1, At, B1); GK_BAR; GK_SCHED;
            GK_LDB(B0, 1, 0); GK_LDB(B1, 1, 1); GK_SCHED; GK_LDA(At, 1, 0); GK_STAGE(GK_SA(0, 1), a2, x10, x11);
            GK_WAIT_V(8); GK_WAIT_L(0); GK_BAR; GK_MMA(0, 0, At, B0); GK_MMA(0, 1, At, B1); GK_BAR; GK_SCHED;
            GK_LDA(At, 1, 1); GK_STAGE(GK_SB(1, 0), b3, voffB[0], voffB[1]); GK_STAGE(GK_SB(1, 1), b3 + hstepB, voffB[0], voffB[1]); GK_STAGE(GK_SA(1, 0), a3, x00, x01);
            GK_WAIT_V(8); GK_WAIT_L(0); GK_BAR; GK_MMA(1, 0, At, B0); GK_MMA(1, 1, At, B1); GK_BAR; GK_SCHED;
        }
        if (wr == 0) GK_BAR;
        E(acc, cur, wr, wc, fr, fq);
        if (!has_next) break;
#pragma unroll
        for (int a = 0; a < 2; ++a)
#pragma unroll
            for (int b = 0; b < 2; ++b)
#pragma unroll
                for (int m = 0; m < 4; ++m)
#pragma unroll
                    for (int n = 0; n < 2; ++n) acc[a][b][m][n] = (f32x4){0.f, 0.f, 0.f, 0.f};
        cur = nxt; cB = nB; c00 = n00; c01 = n01; c10 = n10; c11 = n11; ++ui;
        if (wr == 1) GK_BAR;
    }
    GK_WAIT_V(0);
    GK_BAR;
#undef GK_SA
#undef GK_SB
#undef GK_STAGE
#undef GK_LDA
#undef GK_LDB
#undef GK_MMA
#undef GK_WAIT_V
#undef GK_WAIT_L
#undef GK_BAR
#undef GK_SCHED
}

struct DenseOrder {
    int nM, nN, nwg, G, c, K;
    __device__ void init(int M, int N, int K_, int G_, int c_) { nM = M / BM; nN = N / BM; nwg = nM * nN; G = G_; c = c_; K = K_; }
    __device__ __forceinline__ bool next(int i, Unit& u) const {
        const long Lx = (long)i * G + c; if (Lx >= nwg) return false;
        int wgid = (int)Lx; { const int q = nwg / NXCD, r = nwg % NXCD, xcd = wgid % NXCD, off = wgid / NXCD; wgid = (xcd < r ? xcd * (q + 1) : r * (q + 1) + (xcd - r) * q) + off; }
        const int nig = WGM * nN, gid = wgid / nig, fm = gid * WGM, gsz = (nM - fm) < WGM ? (nM - fm) : WGM;
        u.pm = fm + ((wgid % nig) % gsz); u.pn = (wgid % nig) / gsz; u.ex = 0; return true;
    }
    const char* Bt;
    __device__ __forceinline__ void a_offs(const Unit& u, const int (&RA)[2], const int (&CA)[2], unsigned& o00, unsigned& o01, unsigned& o10, unsigned& o11) const {
        const unsigned r0 = (unsigned)(u.pm * BM);
        o00 = ((r0 + RA[0]) * (unsigned)K + CA[0]) * 2u; o01 = ((r0 + RA[1]) * (unsigned)K + CA[1]) * 2u;
        o10 = ((r0 + HALF + RA[0]) * (unsigned)K + CA[0]) * 2u; o11 = ((r0 + HALF + RA[1]) * (unsigned)K + CA[1]) * 2u;
    }
    __device__ __forceinline__ const char* b_base(const Unit& u) const { return Bt + (size_t)u.pn * BM * K * 2; }
};
template <int NPN, bool GATHER>
struct GroupOrder {
    int ntile, G, c, K;
    const LAS int* pstart;
    const int* rtok;
    const char* Bt; size_t bstride;
    __device__ __forceinline__ bool next(int i, Unit& u) const {
        const long Lx = (long)i * G + c; if (Lx >= (long)ntile * NPN) return false;
        u.pm = (int)(Lx / NPN); u.pn = (int)(Lx % NPN);
        const int row = u.pm * BM; int lo = 0, hi = NE1;
        while (hi - lo > 1) { const int mid = (lo + hi) >> 1; if (pstart[mid] <= row) lo = mid; else hi = mid; }
        u.ex = lo; return true;
    }
    __device__ __forceinline__ void a_offs(const Unit& u, const int (&RA)[2], const int (&CA)[2], unsigned& o00, unsigned& o01, unsigned& o10, unsigned& o11) const {
        const int r0 = u.pm * BM;
        if (GATHER) {
            const int t00 = rtok[r0 + RA[0]], t01 = rtok[r0 + RA[1]], t10 = rtok[r0 + HALF + RA[0]], t11 = rtok[r0 + HALF + RA[1]];
            o00 = ((unsigned)t00 * (unsigned)K + CA[0]) * 2u; o01 = ((unsigned)t01 * (unsigned)K + CA[1]) * 2u;
            o10 = ((unsigned)t10 * (unsigned)K + CA[0]) * 2u; o11 = ((unsigned)t11 * (unsigned)K + CA[1]) * 2u;
        } else {
            o00 = ((unsigned)(r0 + RA[0]) * (unsigned)K + CA[0]) * 2u; o01 = ((unsigned)(r0 + RA[1]) * (unsigned)K + CA[1]) * 2u;
            o10 = ((unsigned)(r0 + HALF + RA[0]) * (unsigned)K + CA[0]) * 2u; o11 = ((unsigned)(r0 + HALF + RA[1]) * (unsigned)K + CA[1]) * 2u;
        }
    }
    __device__ __forceinline__ const char* b_base(const Unit& u) const { return Bt + (size_t)u.ex * bstride + (size_t)u.pn * BM * K * 2; }
};

struct EpiBf16Store {
    static constexpr bool PERM = true;
    bf16* O; int ldc;
    __device__ __forceinline__ void operator()(const f32x4 (&acc)[2][2][4][2], const Unit& u, int wr, int wc, int fr, int fq) const {
        const int row0 = u.pm * BM + wr * 64 + fr, col0 = u.pn * BM + wc * 32 + 8 * fq;
#pragma unroll
        for (int ai = 0; ai < 2; ++ai)
#pragma unroll
            for (int m = 0; m < 4; ++m) { bf16* rowp = O + (size_t)(row0 + ai * HALF + m * 16) * ldc + col0;
#pragma unroll
                for (int bj = 0; bj < 2; ++bj) { const f32x4 v0 = acc[ai][bj][m][0], v1 = acc[ai][bj][m][1];
                    v4u w; w.x = cvt_pk_bf16(v0[0], v0[1]); w.y = cvt_pk_bf16(v0[2], v0[3]); w.z = cvt_pk_bf16(v1[0], v1[1]); w.w = cvt_pk_bf16(v1[2], v1[3]);
                    *(v4u*)(rowp + bj * HALF) = w; } }
    }
};
struct EpiResidual {
    static constexpr bool PERM = false;
    float* X; int ldc; const float* gate;
    __device__ __forceinline__ void operator()(const f32x4 (&acc)[2][2][4][2], const Unit& u, int wr, int wc, int fr, int fq) const {
        const int row0 = u.pm * BM + wr * 64 + fr, col0 = u.pn * BM + wc * 32 + 4 * fq;
        f32x4 gv[2][2];
#pragma unroll
        for (int bj = 0; bj < 2; ++bj)
#pragma unroll
            for (int n = 0; n < 2; ++n) gv[bj][n] = *(const f32x4*)(gate + col0 + bj * HALF + n * 16);
#pragma unroll
        for (int ai = 0; ai < 2; ++ai)
#pragma unroll
            for (int m = 0; m < 4; ++m) { float* rowp = X + (size_t)(row0 + ai * HALF + m * 16) * ldc + col0;
#pragma unroll
                for (int bj = 0; bj < 2; ++bj)
#pragma unroll
                    for (int n = 0; n < 2; ++n) { f32x4* p = (f32x4*)(rowp + bj * HALF + n * 16); *p = *p + gv[bj][n] * acc[ai][bj][m][n]; } }
    }
};
struct EpiGateUp {
    static constexpr bool PERM = true;
    bf16* O;
    __device__ __forceinline__ void operator()(const f32x4 (&acc)[2][2][4][2], const Unit& u, int wr, int wc, int fr, int fq) const {
        const int row0 = u.pm * BM + wr * 64 + fr, col0 = u.pn * HALF + wc * 32 + 8 * fq;
#pragma unroll
        for (int ai = 0; ai < 2; ++ai)
#pragma unroll
            for (int m = 0; m < 4; ++m) { bf16* rowp = O + (size_t)(row0 + ai * HALF + m * 16) * DE + col0;
                float h[8];
#pragma unroll
                for (int n = 0; n < 2; ++n)
#pragma unroll
                    for (int j = 0; j < 4; ++j) { const float g = acc[ai][0][m][n][j], up = acc[ai][1][m][n][j]; h[n * 4 + j] = silu_f(g) * up; }
                v4u w; w.x = cvt_pk_bf16(h[0], h[1]); w.y = cvt_pk_bf16(h[2], h[3]); w.z = cvt_pk_bf16(h[4], h[5]); w.w = cvt_pk_bf16(h[6], h[7]);
                *(v4u*)rowp = w; }
    }
};
struct EpiDown {
    static constexpr bool PERM = true;
    bf16* O; const float* rw;
    __device__ __forceinline__ void operator()(const f32x4 (&acc)[2][2][4][2], const Unit& u, int wr, int wc, int fr, int fq) const {
        const int row0 = u.pm * BM + wr * 64 + fr, col0 = u.pn * BM + wc * 32 + 8 * fq;
#pragma unroll
        for (int ai = 0; ai < 2; ++ai)
#pragma unroll
            for (int m = 0; m < 4; ++m) { const int row = row0 + ai * HALF + m * 16; const float s = rw[row]; bf16* rowp = O + (size_t)row * D + col0;
#pragma unroll
                for (int bj = 0; bj < 2; ++bj) { const f32x4 v0 = acc[ai][bj][m][0] * s, v1 = acc[ai][bj][m][1] * s;
                    v4u w; w.x = cvt_pk_bf16(v0[0], v0[1]); w.y = cvt_pk_bf16(v0[2], v0[3]); w.z = cvt_pk_bf16(v1[0], v1[1]); w.w = cvt_pk_bf16(v1[2], v1[3]);
                    *(v4u*)(rowp + bj * HALF) = w; } }
    }
};
}

struct Args { const float* in[36]; float* out; unsigned char* ws; int ph_lo, ph_hi; };
struct Frame {
    LAS unsigned char* lds;
    int tid, lane, wave, bid, G;
    const float* const* in; float* out; unsigned char* ws;
};
#define IN_X 0
#define IN_C 1
#define IN_CTX 2
#define IN_CCTX 3
#define IN_WADA 4
#define IN_BADA 5
#define IN_GMIX 6
#define IN_GFFN 7
#define IN_WIN 8
#define IN_BGATES 9
#define IN_CKW 10
#define IN_CKB 11
#define IN_CQW 12
#define IN_CQB 13
#define IN_GHEAD 14
#define IN_CHW 15
#define IN_CHB 16
#define IN_FW1 17
#define IN_FB1 18
#define IN_FF1 19
#define IN_FW2 20
#define IN_FB2 21
#define IN_FF2 22
#define IN_FW3 23
#define IN_FB3 24
#define IN_DSKIP 25
#define IN_WOUT 26
#define IN_WR 27
#define IN_BR 28
#define IN_W1E 29
#define IN_W3E 30
#define IN_W2E 31
#define IN_W1S 32
#define IN_W3S 33
#define IN_W2S 34
#define IN_GFIN 35

__device__ __forceinline__ void transpose_item(const float* W, int N, int k0, int n0, bf16* WT, int dstK, int dst_row0, LAS float* scr, int lane) {
#pragma unroll 8
    for (int i = 0; i < 32; ++i) { const int kk = 2 * i + (lane >> 5); scr[kk * 33 + (lane & 31)] = W[(size_t)(k0 + kk) * N + n0 + (lane & 31)]; }
    LDS_WAIT(); asm volatile("" ::: "memory");
    const int c = lane & 7;
#pragma unroll
    for (int j = 0; j < 4; ++j) { const int n = (lane >> 3) + 8 * j; const LAS float* s = scr + (8 * c) * 33 + n;
        v4u o; o.x = cvt_pk_bf16(s[0 * 33], s[1 * 33]); o.y = cvt_pk_bf16(s[2 * 33], s[3 * 33]); o.z = cvt_pk_bf16(s[4 * 33], s[5 * 33]); o.w = cvt_pk_bf16(s[6 * 33], s[7 * 33]);
        *(v4u*)(WT + (size_t)(dst_row0 + n) * dstK + k0 + 8 * c) = o; }
    LDS_WAIT(); asm volatile("" ::: "memory");
}
__device__ __forceinline__ void p0_prologue(Frame& F) {
    const float* const* in = F.in;
    {
        LAS float* sv = (LAS float*)F.lds;
        LAS float* red = sv + 4096;
        float* mod = (float*)(F.ws + WS_MOD);
        for (int job = F.bid; job < 192; job += F.G) {
            for (int i = F.tid; i < 2048; i += NT) { sv[i] = silu_f(in[IN_C][i]); sv[2048 + i] = silu_f(in[IN_CCTX][i]); }
            __syncthreads();
            const int col = job * 64 + F.lane, r0 = F.wave * 256;
            const float* W = in[IN_WADA] + col;
            float a0 = 0.f, a1 = 0.f;
            for (int i = r0; i < r0 + 256; i += 8) {
                float w[8];
#pragma unroll
                for (int j = 0; j < 8; ++j) w[j] = W[(size_t)(i + j) * 12288];
#pragma unroll
                for (int j = 0; j < 8; ++j) { a0 += sv[i + j] * w[j]; a1 += sv[2048 + i + j] * w[j]; }
            }
            red[(F.wave * 64 + F.lane) * 2 + 0] = a0; red[(F.wave * 64 + F.lane) * 2 + 1] = a1;
            __syncthreads();
            if (F.wave == 0) { float s0 = 0.f, s1 = 0.f;
#pragma unroll
                for (int w = 0; w < 8; ++w) { s0 += red[(w * 64 + F.lane) * 2 + 0]; s1 += red[(w * 64 + F.lane) * 2 + 1]; }
                const float b = in[IN_BADA][col]; mod[col] = s0 + b; mod[12288 + col] = s1 + b; }
            __syncthreads();
        }
    }
    const int gt = F.bid * NT + F.tid, NGT = F.G * NT;
    {
        float* pos = (float*)(F.ws + WS_POS);
        for (int i = gt; i < 320 * 1024; i += NGT) { const int p = i >> 10, j = i & 1023, jj = j & 511;
            const float pp = (float)(p < 256 ? p : p - 256);
            const float omega = 1.0f / powf(10000.0f, (float)jj * (1.0f / 512.0f)); const float ang = pp * omega;
            pos[i] = j < 512 ? sinf(ang) : cosf(ang); }
    }
    {
        v4u* z = (v4u*)(F.ws + WS_WIN + (size_t)NIN * D * 2); const int nz = (NINP - NIN) * D * 2 / 16;
        for (int i = gt; i < nz; i += NGT) z[i] = (v4u){0u, 0u, 0u, 0u};
        int* rt = (int*)(F.ws + WS_RTOK); float* rw = (float*)(F.ws + WS_RW);
        for (int i = gt; i < 2 * MAXROWS; i += NGT) { rt[i] = 0; rw[i] = 0.f; }
    }
    {
        LAS float* scr = (LAS float*)(F.lds + F.wave * 16384);
        const int gw = F.bid * NWAVES + F.wave, NGW = F.G * NWAVES;
        constexpr int I_IN = 32 * 193, I_OUT = 32 * 64, I_E = 512 * NE1;
        constexpr int NITEMS = I_IN + I_OUT + 3 * I_E;
        for (int it = gw; it < NITEMS; it += NGW) {
            int r = it;
            if (r < I_IN) { const int kb = r / 193, nb = r % 193; transpose_item(in[IN_WIN], NIN, 64 * kb, 32 * nb, (bf16*)(F.ws + WS_WIN), D, 32 * nb, scr, F.lane); continue; } r -= I_IN;
            if (r < I_OUT) { const int kb = r / 64, nb = r % 64; transpose_item(in[IN_WOUT], D, 64 * kb, 32 * nb, (bf16*)(F.ws + WS_WOUT), D, 32 * nb, scr, F.lane); continue; } r -= I_OUT;
            if (r < 2 * I_E) { const int which = r >= I_E; if (which) r -= I_E;
                const int e = r / 512, rr = r % 512, kb = rr / 16, nb = rr % 16, n0 = 32 * nb;
                const float* src = e < NE ? in[which ? IN_W3E : IN_W1E] + (size_t)e * D * DE : in[which ? IN_W3S : IN_W1S];
                transpose_item(src, DE, 64 * kb, n0, (bf16*)(F.ws + WS_W13) + (size_t)e * 1024 * D, D, (n0 >> 7) * 256 + which * 128 + (n0 & 127), scr, F.lane); continue; }
            r -= 2 * I_E;
            { const int e = r / 512, rr = r % 512, kb = rr / 64, nb = rr % 64;
                const float* src = e < NE ? in[IN_W2E] + (size_t)e * DE * D : in[IN_W2S];
                transpose_item(src, D, 64 * kb, 32 * nb, (bf16*)(F.ws + WS_W2) + (size_t)e * D * DE, DE, 32 * nb, scr, F.lane); }
        }
    }
}

__device__ __forceinline__ void p1_norm1(Frame& F) {
    const float* const* in = F.in;
    const int gw = F.bid * NWAVES + F.wave, NGW = F.G * NWAVES;
    const float* mod = (const float*)(F.ws + WS_MOD); const float* pos = (const float*)(F.ws + WS_POS);
    bf16* hA = (bf16*)(F.ws + WS_HA);
    for (int row = gw; row < MROWS; row += NGW) {
        f32x4 v[8]; float ss = 0.f;
        const bool mainrow = row < L;
        const float* src = mainrow ? in[IN_X] + (size_t)row * D : in[IN_CTX] + (size_t)(row - L) * D;
        const float* md = mainrow ? mod : mod + 12288;
#pragma unroll
        for (int j = 0; j < 8; ++j) { const int col = 4 * F.lane + 256 * j; v[j] = *(const f32x4*)(src + col);
            if (mainrow) { const float* pp = col < 1024 ? pos + (size_t)(row >> 6) * 1024 + col : pos + (size_t)(256 + (row & 63)) * 1024 + (col - 1024);
                v[j] = v[j] + *(const f32x4*)pp; *(f32x4*)(F.out + (size_t)row * D + col) = v[j]; }
            ss += (v[j].x * v[j].x + v[j].y * v[j].y) + (v[j].z * v[j].z + v[j].w * v[j].w); }
        const float rstd = rsqrtf(wave_sum(ss) * (1.0f / D) + EPS);
#pragma unroll
        for (int j = 0; j < 8; ++j) { const int col = 4 * F.lane + 256 * j;
            const f32x4 g = *(const f32x4*)(in[IN_GMIX] + col), sh = *(const f32x4*)(md + col), sc = *(const f32x4*)(md + 2048 + col);
            const f32x4 h = (v[j] * rstd * g) * (sc + 1.0f) + sh;
            v2u o; o.x = cvt_pk_bf16(h.x, h.y); o.y = cvt_pk_bf16(h.z, h.w);
            *(v2u*)(hA + (size_t)row * D + col) = o; }
    }
}

__device__ __forceinline__ void p3_scan_job(Frame& F, int job) {
    const float* const* in = F.in;
    const int hd = job & 7, dir = job >> 3, tid = F.tid;
    const bf16* z = (const bf16*)(F.ws + WS_Z);
    bf16* hout = (bf16*)(F.ws + (dir ? WS_HB : WS_HF));
    LAS float* sk = (LAS float*)F.lds;
    LAS float* sq = sk + 512;
    LAS float* sv = sq + 512;
    LAS float* sg = sv + 1024;
    LAS float* snum = sg + 16;
    LAS float* sden = snum + 4096;
    LAS float* sem = sden + 32;
    const int e = tid & 127, dg = tid >> 7, d0 = dg * 16;
    float C[16], n[16]; float m = 0.f;
#pragma unroll
    for (int i = 0; i < 16; ++i) { C[i] = 0.f; n[i] = 0.f; }
    const int ts = tid >> 6, j = tid & 63;
    const int kc = hd * 64 + j;
    const float kw0 = in[IN_CKW][kc], kw1 = in[IN_CKW][512 + kc], kw2 = in[IN_CKW][1024 + kc], kb = in[IN_CKB][kc];
    const float qw0 = in[IN_CQW][kc], qw1 = in[IN_CQW][512 + kc], qw2 = in[IN_CQW][1024 + kc], qb = in[IN_CQB][kc];
    const float bgi = in[IN_BGATES][dir * 16 + hd], bgf = in[IN_BGATES][dir * 16 + 8 + hd];
    for (int p0 = 0; p0 < LC + L; p0 += 8) {
        const bool isctx = p0 < LC;
        const int len = isctx ? LC : L, base = isctx ? L : 0, q0 = isctx ? p0 : p0 - LC;
        {
            const int pp = q0 + ts, tok = dir ? len - 1 - pp : pp;
            const bf16* zc = z + (size_t)(base + tok) * NINP;
            const bool hp = tok > 0, hn = tok < len - 1;
            const float kp = hp ? bf2f(zc[-NINP + OFF_K + kc]) : 0.f, kn = hn ? bf2f(zc[NINP + OFF_K + kc]) : 0.f, k0 = bf2f(zc[OFF_K + kc]);
            const float qp = hp ? bf2f(zc[-NINP + OFF_Q + kc]) : 0.f, qn = hn ? bf2f(zc[NINP + OFF_Q + kc]) : 0.f, qq = bf2f(zc[OFF_Q + kc]);
            sk[ts * 64 + j] = silu_f(kp * kw0 + k0 * kw1 + kn * kw2 + kb);
            sq[ts * 64 + j] = silu_f(qp * qw0 + qq * qw1 + qn * qw2 + qb) * 0.125f;
            sv[ts * 128 + j] = bf2f(zc[OFF_V + hd * 128 + j]); sv[ts * 128 + 64 + j] = bf2f(zc[OFF_V + hd * 128 + 64 + j]);
            if (j == 0) { const float gi = bf2f(zc[OFF_G + dir * 16 + hd]) + bgi, gf = bf2f(zc[OFF_G + dir * 16 + 8 + hd]) + bgf;
                sg[ts * 2] = gi; sg[ts * 2 + 1] = fminf(gf, 0.f) - log1pf(__expf(-fabsf(gf))); }
        }
        __syncthreads();
#pragma unroll 1
        for (int s = 0; s < 8; ++s) {
            const float gi = sg[s * 2], lf = sg[s * 2 + 1];
            const float mn = fmaxf(lf + m, gi), a = __expf(lf + m - mn), b = __expf(gi - mn); m = mn;
            const float bv = b * sv[s * 128 + e];
            float num = 0.f, den = 0.f;
#pragma unroll
            for (int i = 0; i < 16; ++i) { const float kd = sk[s * 64 + d0 + i], qd = sq[s * 64 + d0 + i];
                C[i] = a * C[i] + bv * kd; n[i] = a * n[i] + b * kd; num += qd * C[i]; den += qd * n[i]; }
            snum[(s * 4 + dg) * 128 + e] = num;
            if (e == 0) { sden[s * 4 + dg] = den; if (dg == 0) sem[s] = __expf(-m); }
        }
        __syncthreads();
        if (!isctx) {
            const int s = tid >> 6, pp = q0 + s, tok = dir ? L - 1 - pp : pp;
            const float den = (sden[s * 4] + sden[s * 4 + 1]) + (sden[s * 4 + 2] + sden[s * 4 + 3]);
            const float dd = 1.0f / fmaxf(fabsf(den), sem[s]);
#pragma unroll
            for (int h = 0; h < 2; ++h) { const int ee = j + 64 * h;
                const float num = (snum[(s * 4) * 128 + ee] + snum[(s * 4 + 1) * 128 + ee]) + (snum[(s * 4 + 2) * 128 + ee] + snum[(s * 4 + 3) * 128 + ee]);
                hout[(size_t)tok * MVW + hd * 128 + ee] = (bf16)(cvt_pk_bf16(num * dd, 0.f) & 0xffffu); }
        }
        __syncthreads();
    }
}

__device__ __forceinline__ void p3_filter_tile(Frame& F, int tile) {
    const float* const* in = F.in;
    const int tid = F.tid;
    LAS float* feat = (LAS float*)F.lds;
    LAS float* h1 = feat + 64 * 36;
    LAS float* h2 = h1 + 64 * 65;
    LAS float* w1s = h2 + 64 * 64;
    LAS float* w2s = w1s + 33 * 64;
    for (int i = tid; i < 33 * 64; i += NT) w1s[i] = in[IN_FW1][i];
    for (int i = tid; i < 64 * 64; i += NT) w2s[i] = in[IN_FW2][i];
    {
        const int tt = tid >> 3, sub = tid & 7; const float t = (float)(tile * 64 + tt);
        const float w = (6.2831855f * t) / (float)L;
        if (sub == 0) feat[tt * 36] = t / (float)(L - 1);
#pragma unroll
        for (int q = 0; q < 2; ++q) { const int bi = sub * 2 + q; const float band = 1e-4f + (float)bi * ((15.0f - 1e-4f) / 15.0f); const float ang = w * band;
            feat[tt * 36 + 1 + bi] = cosf(ang); feat[tt * 36 + 17 + bi] = -sinf(ang); }
    }
    __syncthreads();
    {
        const int tt = tid >> 3, j0 = (tid & 7) * 8;
        float a[8];
#pragma unroll
        for (int q = 0; q < 8; ++q) a[q] = in[IN_FB1][j0 + q];
#pragma unroll 1
        for (int i = 0; i < 33; ++i) { const float f = feat[tt * 36 + i];
#pragma unroll
            for (int q = 0; q < 8; ++q) a[q] += f * w1s[i * 64 + j0 + q]; }
#pragma unroll
        for (int q = 0; q < 8; ++q) h1[tt * 65 + j0 + q] = sinf(in[IN_FF1][j0 + q] * a[q]);
    }
    __syncthreads();
    {
        const int tt = tid >> 3, j0 = (tid & 7) * 8;
        float a[8];
#pragma unroll
        for (int q = 0; q < 8; ++q) a[q] = in[IN_FB2][j0 + q];
#pragma unroll 1
        for (int i = 0; i < 64; ++i) { const float f = h1[tt * 65 + i];
#pragma unroll
            for (int q = 0; q < 8; ++q) a[q] += f * w2s[i * 64 + j0 + q]; }
#pragma unroll
        for (int q = 0; q < 8; ++q) h2[tt * 64 + j0 + q] = sinf(in[IN_FF2][j0 + q] * a[q]);
    }
    __syncthreads();
    float* kf = (float*)(F.ws + WS_KF); float* kb = (float*)(F.ws + WS_KB); float* l1p = (float*)(F.ws + WS_L1P);
    const float r_slow = 3.0701134573253945f, r_fast = 15.350567286626972f;
#pragma unroll 1
    for (int r = 0; r < 4; ++r) {
        const int cc = tid + 512 * r, ch = cc & 1023; const bool isb = cc >= 1024;
        float w[64];
#pragma unroll
        for (int i = 0; i < 64; ++i) w[i] = in[IN_FW3][(size_t)i * 2048 + cc];
        const float b3 = in[IN_FB3][cc];
        const float rate = r_slow + (float)ch * ((r_fast - r_slow) / 1023.0f);
        float asum = 0.f; float* dst = isb ? kb : kf;
#pragma unroll 1
        for (int tt = 0; tt < 64; ++tt) { const int t = tile * 64 + tt; float acc = b3;
#pragma unroll
            for (int i = 0; i < 64; i += 4) { const f32x4 hv = *(const LAS f32x4*)(h2 + tt * 64 + i); acc += hv.x * w[i] + hv.y * w[i + 1] + hv.z * w[i + 2] + hv.w * w[i + 3]; }
            const float t01 = (float)t / (float)(L - 1); const float val = acc * __expf(-t01 * rate);
            if (!(isb && t == 0)) asum += fabsf(val);
            dst[(size_t)t * HYW + ch] = val; }
        l1p[(size_t)tile * 2048 + cc] = asum;
    }
    __syncthreads();
}
__device__ __forceinline__ void p3_uin_rows(Frame& F, int b2, int nb2) {
    const float* const* in = F.in;
    const bf16* z = (const bf16*)(F.ws + WS_Z); float* uin = (float*)(F.ws + WS_UIN);
    const int c0 = (F.tid & 127) * 8, rsub = F.tid >> 7;
    for (int t = b2 * 4 + rsub; t < L; t += nb2 * 4) {
        float o[8];
        float r1[8], r2[8];
#pragma unroll
        for (int part = 0; part < 2; ++part) {
            const int zc = OFF_HY + 1024 * (part + 1) + c0, wc = 1024 * (part + 1) + c0;
            const v4u cur = *(const v4u*)(z + (size_t)t * NINP + zc);
            const v4u prv = t > 0 ? *(const v4u*)(z + (size_t)(t - 1) * NINP + zc) : (v4u){0u, 0u, 0u, 0u};
            const v4u nxt = t < L - 1 ? *(const v4u*)(z + (size_t)(t + 1) * NINP + zc) : (v4u){0u, 0u, 0u, 0u};
            float* rr = part ? r2 : r1;
#pragma unroll
            for (int q = 0; q < 4; ++q) {
                const unsigned pc = q == 0 ? prv.x : q == 1 ? prv.y : q == 2 ? prv.z : prv.w, cc = q == 0 ? cur.x : q == 1 ? cur.y : q == 2 ? cur.z : cur.w, nc = q == 0 ? nxt.x : q == 1 ? nxt.y : q == 2 ? nxt.z : nxt.w;
                const int ch = wc + 2 * q;
                rr[2 * q] = bflo(pc) * in[IN_CHW][ch] + bflo(cc) * in[IN_CHW][3072 + ch] + bflo(nc) * in[IN_CHW][6144 + ch] + in[IN_CHB][ch];
                rr[2 * q + 1] = bfhi(pc) * in[IN_CHW][ch + 1] + bfhi(cc) * in[IN_CHW][3072 + ch + 1] + bfhi(nc) * in[IN_CHW][6144 + ch + 1] + in[IN_CHB][ch + 1];
            }
        }
#pragma unroll
        for (int q = 0; q < 8; ++q) o[q] = r1[q] * r2[q];
        *(f32x4*)(uin + (size_t)t * HYW + c0) = (f32x4){o[0], o[1], o[2], o[3]};
        *(f32x4*)(uin + (size_t)t * HYW + c0 + 4) = (f32x4){o[4], o[5], o[6], o[7]};
    }
}

__device__ __forceinline__ void p4_conv_item(Frame& F, int item) {
    const float* const* in = F.in;
    const int tid = F.tid, c = tid & 63, tg = tid >> 6;
    const int t0 = (item >> 4) * 64, cb = (item & 15) * 64;
    const float* kf = (const float*)(F.ws + WS_KF); const float* kbk = (const float*)(F.ws + WS_KB); const float* uin = (const float*)(F.ws + WS_UIN);
    LAS float* ul = (LAS float*)F.lds;
    LAS float* kl = ul + 4096;
    LAS float* l1s = kl + 127 * 64;
    if (tid < 64) { const float* l1p = (const float*)(F.ws + WS_L1P); float s = 0.f;
        for (int tl = 0; tl < 256; ++tl) s += l1p[(size_t)tl * 2048 + cb + tid] + l1p[(size_t)tl * 2048 + 1024 + cb + tid];
        l1s[tid] = s; }
    float acc[8];
#pragma unroll
    for (int i = 0; i < 8; ++i) acc[i] = 0.f;
    for (int s0 = 0; s0 < L; s0 += 64) {
        __syncthreads();
        for (int i = tid; i < 4096; i += NT) ul[i] = uin[(size_t)(s0 + (i >> 6)) * HYW + cb + (i & 63)];
        const int dmin = t0 - s0 - 63;
        for (int i = tid; i < 127 * 64; i += NT) { const int d = dmin + (i >> 6), cc = cb + (i & 63);
            kl[i] = d >= 0 ? kf[(size_t)d * HYW + cc] : kbk[(size_t)(-d) * HYW + cc]; }
        __syncthreads();
        float kr[8];
#pragma unroll
        for (int i = 0; i < 8; ++i) kr[i] = kl[(8 * tg + i + 63) * 64 + c];
#pragma unroll 8
        for (int ss = 0; ss < 64; ++ss) {
            const float u = ul[ss * 64 + c];
#pragma unroll
            for (int i = 0; i < 8; ++i) acc[i] += kr[i] * u;
#pragma unroll
            for (int i = 7; i > 0; --i) kr[i] = kr[i - 1];
            const int ni = 8 * tg - ss - 1 + 63;
            kr[0] = ni >= 0 ? kl[ni * 64 + c] : 0.f;
        }
    }
    const bf16* z = (const bf16*)(F.ws + WS_Z); bf16* cat = (bf16*)(F.ws + WS_CAT);
    const int ch = cb + c; const float il1 = 1.0f / l1s[c], dsk = in[IN_DSKIP][ch];
    const float w0 = in[IN_CHW][ch], w1 = in[IN_CHW][3072 + ch], w2 = in[IN_CHW][6144 + ch], bb = in[IN_CHB][ch];
#pragma unroll
    for (int i = 0; i < 8; ++i) { const int t = t0 + 8 * tg + i;
        const float y = acc[i] * il1 + dsk * uin[(size_t)t * HYW + ch];
        const float zp = t > 0 ? bf2f(z[(size_t)(t - 1) * NINP + OFF_HY + ch]) : 0.f, zc = bf2f(z[(size_t)t * NINP + OFF_HY + ch]), zn = t < L - 1 ? bf2f(z[(size_t)(t + 1) * NINP + OFF_HY + ch]) : 0.f;
        const float x0 = zp * w0 + zc * w1 + zn * w2 + bb;
        cat[(size_t)t * D + MVW + ch] = (bf16)(cvt_pk_bf16(x0 * y, 0.f) & 0xffffu); }
    __syncthreads();
}
__device__ __forceinline__ void p4_combine_rows(Frame& F) {
    const float* const* in = F.in;
    const int gw = F.bid * NWAVES + F.wave, NGW = F.G * NWAVES, c0 = F.lane * 16;
    const bf16* hf = (const bf16*)(F.ws + WS_HF); const bf16* hb = (const bf16*)(F.ws + WS_HB); const bf16* z = (const bf16*)(F.ws + WS_Z); bf16* cat = (bf16*)(F.ws + WS_CAT);
    for (int t = gw; t < L; t += NGW) {
        float h[16]; float ss = 0.f;
#pragma unroll
        for (int q = 0; q < 2; ++q) { const v4u a = *(const v4u*)(hf + (size_t)t * MVW + c0 + 8 * q), b = *(const v4u*)(hb + (size_t)t * MVW + c0 + 8 * q);
            h[8 * q + 0] = bflo(a.x) + bflo(b.x); h[8 * q + 1] = bfhi(a.x) + bfhi(b.x); h[8 * q + 2] = bflo(a.y) + bflo(b.y); h[8 * q + 3] = bfhi(a.y) + bfhi(b.y);
            h[8 * q + 4] = bflo(a.z) + bflo(b.z); h[8 * q + 5] = bfhi(a.z) + bfhi(b.z); h[8 * q + 6] = bflo(a.w) + bflo(b.w); h[8 * q + 7] = bfhi(a.w) + bfhi(b.w); }
#pragma unroll
        for (int i = 0; i < 16; ++i) ss += h[i] * h[i];
        ss += __shfl_xor(ss, 1); ss += __shfl_xor(ss, 2); ss += __shfl_xor(ss, 4);
        const float rstd = rsqrtf(ss * (1.0f / 128.0f) + EPS);
        float o[16];
#pragma unroll
        for (int q = 0; q < 2; ++q) { const v4u zo = *(const v4u*)(z + (size_t)t * NINP + OFF_O + c0 + 8 * q);
            const unsigned zz[4] = {zo.x, zo.y, zo.z, zo.w};
#pragma unroll
            for (int k = 0; k < 4; ++k) { const int i = 8 * q + 2 * k;
                o[i] = h[i] * rstd * in[IN_GHEAD][c0 + i] * sigmoid_f(bflo(zz[k])); o[i + 1] = h[i + 1] * rstd * in[IN_GHEAD][c0 + i + 1] * sigmoid_f(bfhi(zz[k])); } }
#pragma unroll
        for (int q = 0; q < 2; ++q) { v4u w; w.x = cvt_pk_bf16(o[8 * q], o[8 * q + 1]); w.y = cvt_pk_bf16(o[8 * q + 2], o[8 * q + 3]); w.z = cvt_pk_bf16(o[8 * q + 4], o[8 * q + 5]); w.w = cvt_pk_bf16(o[8 * q + 6], o[8 * q + 7]);
            *(v4u*)(cat + (size_t)t * D + c0 + 8 * q) = w; }
    }
}

__device__ __forceinline__ void p6_norm2_router(Frame& F) {
    const float* const* in = F.in;
    const float* mod = (const float*)(F.ws + WS_MOD);
    bf16* h2 = (bf16*)(F.ws + WS_HA);
    int* cnt = (int*)(F.ws + WS_CTL) + CW_CNT;
    int* aexp = (int*)(F.ws + WS_AEXP); int* arank = (int*)(F.ws + WS_ARANK); float* aw = (float*)(F.ws + WS_AW);
    LAS float* hrow = (LAS float*)F.lds + F.wave * 2048;
    LAS float* wch = (LAS float*)(F.lds + 65536);
    const int lane = F.lane;
    for (int t0 = F.bid * 8; t0 < L; t0 += F.G * 8) {
        const int t = t0 + F.wave;
        {
            f32x4 v[8]; float ss = 0.f;
#pragma unroll
            for (int j = 0; j < 8; ++j) { const int col = 4 * lane + 256 * j; v[j] = *(const f32x4*)(F.out + (size_t)t * D + col); ss += (v[j].x * v[j].x + v[j].y * v[j].y) + (v[j].z * v[j].z + v[j].w * v[j].w); }
            const float rstd = rsqrtf(wave_sum(ss) * (1.0f / D) + EPS);
#pragma unroll
            for (int j = 0; j < 8; ++j) { const int col = 4 * lane + 256 * j;
                const f32x4 g = *(const f32x4*)(in[IN_GFFN] + col), sh = *(const f32x4*)(mod + 6144 + col), sc = *(const f32x4*)(mod + 8192 + col);
                const f32x4 h = (v[j] * rstd * g) * (sc + 1.0f) + sh;
                *(LAS f32x4*)(hrow + col) = h;
                v2u o; o.x = cvt_pk_bf16(h.x, h.y); o.y = cvt_pk_bf16(h.z, h.w);
                *(v2u*)(h2 + (size_t)t * D + col) = o; }
        }
        float logit = 0.f;
        for (int ch = 0; ch < 8; ++ch) {
            __syncthreads();
            for (int i = F.tid; i < 4096; i += NT) *(LAS f32x4*)(wch + 4 * i) = *(const f32x4*)(in[IN_WR] + (size_t)ch * 16384 + 4 * i);
            __syncthreads();
            const LAS float* hr = hrow + ch * 256;
#pragma unroll 4
            for (int i = 0; i < 256; i += 4) { const f32x4 hv = *(const LAS f32x4*)(hr + i);
                logit += hv.x * wch[(i + 0) * 64 + lane]; logit += hv.y * wch[(i + 1) * 64 + lane]; logit += hv.z * wch[(i + 2) * 64 + lane]; logit += hv.w * wch[(i + 3) * 64 + lane]; }
        }
        const float s = 1.0f / (1.0f + expf(-logit)), sel = s + in[IN_BR][lane];
        const int grp = lane >> 3;
        float m1 = sel; m1 = fmaxf(m1, __shfl_xor(m1, 1)); m1 = fmaxf(m1, __shfl_xor(m1, 2)); m1 = fmaxf(m1, __shfl_xor(m1, 4));
        const unsigned long long gm = 0xFFull << (8 * grp);
        const unsigned long long b1 = __ballot(sel == m1) & gm;
        const int first = __ffsll((long long)b1) - 1;
        float m2 = (lane == first) ? -INFINITY : sel; m2 = fmaxf(m2, __shfl_xor(m2, 1)); m2 = fmaxf(m2, __shfl_xor(m2, 2)); m2 = fmaxf(m2, __shfl_xor(m2, 4));
        const float gs = m1 + m2;
        int grank = 0;
#pragma unroll
        for (int g = 0; g < 8; ++g) { const float og = __shfl(gs, 8 * g); grank += (og > gs || (og == gs && g < grp)) ? 1 : 0; }
        const float masked = grank < 4 ? sel : -INFINITY;
        int rank = 0;
        for (int e2 = 0; e2 < 64; ++e2) { const float om = __shfl(masked, e2); rank += (om > masked || (om == masked && e2 < lane)) ? 1 : 0; }
        const bool chosen = rank < 8;
        const float wsum = wave_sum(chosen ? s : 0.f);
        const unsigned long long cb = __ballot(chosen);
        if (chosen) {
            const int k = __popcll(cb & ((1ull << lane) - 1ull));
            const int half = t >= HALF_T ? 1 : 0;
            const int r = atomicAdd(cnt + half * 64 + lane, 1);
            aexp[t * 8 + k] = lane; arank[t * 8 + k] = r; aw[t * 8 + k] = s / wsum * 2.5f;
        }
    }
    __syncthreads();
}
__device__ __forceinline__ void build_pstart(Frame& F) {
    LAS int* ps = (LAS int*)(F.lds + LDSCTL_OFF);
    const int* cnt = (const int*)(F.ws + WS_CTL) + CW_CNT;
    __syncthreads();
    if (F.tid < 2) { int a = 0;
        for (int e = 0; e < NE; ++e) { ps[F.tid * 66 + e] = a; a += (__hip_atomic_load(cnt + F.tid * 64 + e, __ATOMIC_RELAXED, __HIP_MEMORY_SCOPE_AGENT) + 255) & ~255; }
        ps[F.tid * 66 + 64] = a; ps[F.tid * 66 + 65] = a + HALF_T; }
    __syncthreads();
}
__device__ __forceinline__ void p7_fill_rows(Frame& F) {
    build_pstart(F);
    const LAS int* ps = (const LAS int*)(F.lds + LDSCTL_OFF);
    const int* aexp = (const int*)(F.ws + WS_AEXP); const int* arank = (const int*)(F.ws + WS_ARANK); const float* aw = (const float*)(F.ws + WS_AW);
    int* rt = (int*)(F.ws + WS_RTOK); float* rw = (float*)(F.ws + WS_RW);
    const int gt = F.bid * NT + F.tid, NGT = F.G * NT;
    for (int i = gt; i < L * 8; i += NGT) { const int t = i >> 3, h = t >= HALF_T ? 1 : 0; const int row = ps[h * 66 + aexp[i]] + arank[i];
        rt[h * MAXROWS + row] = t; rw[h * MAXROWS + row] = aw[i]; }
    for (int t = gt; t < L; t += NGT) { const int h = t >= HALF_T ? 1 : 0; const int row = ps[h * 66 + 64] + (t - h * HALF_T);
        rt[h * MAXROWS + row] = t; rw[h * MAXROWS + row] = 1.0f; }
}
__device__ __forceinline__ void moe_combine(Frame& F, int half) {
    const float* const* in = F.in;
    const LAS int* ps = (const LAS int*)(F.lds + LDSCTL_OFF) + half * 66;
    const float* mod = (const float*)(F.ws + WS_MOD);
    const int* aexp = (const int*)(F.ws + WS_AEXP); const int* arank = (const int*)(F.ws + WS_ARANK);
    const bf16* Y2 = (const bf16*)(F.ws + WS_Y2);
    const int gw = F.bid * NWAVES + F.wave, NGW = F.G * NWAVES, lane = F.lane;
    for (int tt = gw; tt < HALF_T; tt += NGW) {
        const int t = half * HALF_T + tt;
        float a[32];
#pragma unroll
        for (int i = 0; i < 32; ++i) a[i] = 0.f;
#pragma unroll 1
        for (int k = 0; k < 9; ++k) {
            const int row = k < 8 ? ps[aexp[t * 8 + k]] + arank[t * 8 + k] : ps[64] + tt;
            const bf16* yr = Y2 + (size_t)row * D + 8 * lane;
#pragma unroll
            for (int j = 0; j < 4; ++j) { const v4u y = *(const v4u*)(yr + 512 * j);
                a[8 * j + 0] += bflo(y.x); a[8 * j + 1] += bfhi(y.x); a[8 * j + 2] += bflo(y.y); a[8 * j + 3] += bfhi(y.y);
                a[8 * j + 4] += bflo(y.z); a[8 * j + 5] += bfhi(y.z); a[8 * j + 6] += bflo(y.w); a[8 * j + 7] += bfhi(y.w); }
        }
        float ss = 0.f;
#pragma unroll
        for (int j = 0; j < 4; ++j)
#pragma unroll
            for (int q = 0; q < 2; ++q) { const int col = 8 * lane + 512 * j + 4 * q;
                const f32x4 x1 = *(const f32x4*)(F.out + (size_t)t * D + col), g2 = *(const f32x4*)(mod + 10240 + col);
                const int i = 8 * j + 4 * q;
                a[i] = x1.x + g2.x * a[i]; a[i + 1] = x1.y + g2.y * a[i + 1]; a[i + 2] = x1.z + g2.z * a[i + 2]; a[i + 3] = x1.w + g2.w * a[i + 3];
                ss += (a[i] * a[i] + a[i + 1] * a[i + 1]) + (a[i + 2] * a[i + 2] + a[i + 3] * a[i + 3]); }
        const float rstd = rsqrtf(wave_sum(ss) * (1.0f / D) + EPS);
#pragma unroll
        for (int j = 0; j < 4; ++j)
#pragma unroll
            for (int q = 0; q < 2; ++q) { const int col = 8 * lane + 512 * j + 4 * q; const int i = 8 * j + 4 * q;
                const f32x4 gf = *(const f32x4*)(in[IN_GFIN] + col);
                *(f32x4*)(F.out + (size_t)t * D + col) = (f32x4){a[i] * rstd * gf.x, a[i + 1] * rstd * gf.y, a[i + 2] * rstd * gf.z, a[i + 3] * rstd * gf.w}; }
    }
}

constexpr int N_PHASES = 13;
__global__ void __launch_bounds__(NT, 2) fwd_kernel(Args args) {
    extern __shared__ __attribute__((aligned(16))) unsigned char lds_raw[];
    Frame F;
    F.lds = (LAS unsigned char*)lds_raw;
    F.tid = threadIdx.x; F.lane = F.tid & 63; F.wave = __builtin_amdgcn_readfirstlane(F.tid >> 6);
    F.bid = blockIdx.x; F.G = gridDim.x;
    F.in = args.in; F.out = args.out; F.ws = args.ws;
    volatile LAS unsigned* MISC = (volatile LAS unsigned*)(F.lds + LDSCTL_OFF + 768);
    if (F.tid < 64) ((LAS unsigned*)(F.lds + LDSCTL_OFF))[F.tid + 192] = 0u;
    __syncthreads();
    unsigned* ctl = (unsigned*)(F.ws + WS_CTL);
    const int lo = args.ph_lo, hi = args.ph_hi;
    XcdBarrier bar; bar.bar = ctl + CW_BAR; bar.x = 0; bar.st = nullptr;
    if (hi - lo > 1) bar = xcd_barrier_post(ctl + CW_BAR, MISC + 8);
#ifndef PH_MASK
#define PH_MASK 0xFFFF
#endif
#define IN(k) (((PH_MASK >> (k)) & 1) && lo <= (k) && (k) < hi)
#define SEAM(k) do { if (IN(k) && IN((k) + 1)) xcd_barrier(bar); } while (0)
    LAS int* ps = (LAS int*)(F.lds + LDSCTL_OFF);

    if (IN(0)) { p0_prologue(F); } SEAM(0);
    if (IN(1)) { p1_norm1(F); } SEAM(1);
    if (IN(2)) {
        gk::DenseOrder S; S.init(MROWS, NINP, D, F.G, F.bid); S.Bt = (const char*)(F.ws + WS_WIN);
        gk::EpiBf16Store E{(bf16*)(F.ws + WS_Z), NINP};
        gk::gemm_core(F.lds, (const char*)(F.ws + WS_HA), D, S, E);
    } SEAM(2);
    if (IN(3)) {
        if (F.bid < 16) { for (int job = F.bid; job < 16; job += F.G) p3_scan_job(F, job); }
        else { const int b2 = F.bid - 16, nb2 = F.G - 16;
            for (int tile = b2; tile < 256; tile += nb2) p3_filter_tile(F, tile);
            p3_uin_rows(F, b2, nb2); }
    } SEAM(3);
    if (IN(4)) {
        for (int item = F.bid; item < 4096; item += F.G) p4_conv_item(F, item);
        p4_combine_rows(F);
    } SEAM(4);
    if (IN(5)) {
        gk::DenseOrder S; S.init(L, D, D, F.G, F.bid); S.Bt = (const char*)(F.ws + WS_WOUT);
        gk::EpiResidual E{F.out, D, (const float*)(F.ws + WS_MOD) + 4096};
        gk::gemm_core(F.lds, (const char*)(F.ws + WS_CAT), D, S, E);
    } SEAM(5);
    if (IN(6)) { p6_norm2_router(F); } SEAM(6);
    if (IN(7)) { p7_fill_rows(F); } SEAM(7);
#define MOE_GU(h) do { build_pstart(F); \
        gk::GroupOrder<4, true> S; S.ntile = ps[(h) * 66 + 65] >> 8; S.G = F.G; S.c = F.bid; S.K = D; S.pstart = ps + (h) * 66; S.rtok = (const int*)(F.ws + WS_RTOK) + (h) * MAXROWS; \
        S.Bt = (const char*)(F.ws + WS_W13); S.bstride = (size_t)1024 * D * 2; \
        gk::EpiGateUp E{(bf16*)(F.ws + WS_HR)}; \
        gk::gemm_core(F.lds, (const char*)(F.ws + WS_HA), D, S, E); } while (0)
#define MOE_DN(h) do { build_pstart(F); \
        gk::GroupOrder<8, false> S; S.ntile = ps[(h) * 66 + 65] >> 8; S.G = F.G; S.c = F.bid; S.K = DE; S.pstart = ps + (h) * 66; S.rtok = nullptr; \
        S.Bt = (const char*)(F.ws + WS_W2); S.bstride = (size_t)D * DE * 2; \
        gk::EpiDown E{(bf16*)(F.ws + WS_Y2), (const float*)(F.ws + WS_RW) + (h) * MAXROWS}; \
        gk::gemm_core(F.lds, (const char*)(F.ws + WS_HR), DE, S, E); } while (0)
    if (IN(8)) { MOE_GU(0); } SEAM(8);
    if (IN(9)) { MOE_DN(0); } SEAM(9);
    if (IN(10)) { MOE_GU(1); moe_combine(F, 0); } SEAM(10);
    if (IN(11)) { MOE_DN(1); } SEAM(11);
    if (IN(12)) { build_pstart(F); moe_combine(F, 1); }
#undef IN
#undef SEAM
}

extern "C" void kernel_launch(void* const* d_in, const int* in_sizes, int n_in, void* d_out, int out_size, void* d_ws, size_t ws_size, hipStream_t stream) {
    static int grid = 0;
    if (grid == 0) {
        if (n_in != 36 || out_size != L * D || ws_size < WS_END) { fprintf(stderr, "kernel_launch: unexpected shapes: n_in %d out %d ws %zu (need %zu)\n", n_in, out_size, ws_size, (size_t)WS_END); grid = -1; return; }
        int dev = 0, cus = 0, per_cu = 0;
        if (hipGetDevice(&dev) != hipSuccess || hipDeviceGetAttribute(&cus, hipDeviceAttributeMultiprocessorCount, dev) != hipSuccess) { grid = -1; return; }
        if (hipFuncSetAttribute((const void*)fwd_kernel, hipFuncAttributeMaxDynamicSharedMemorySize, LDS_BYTES) != hipSuccess) { fprintf(stderr, "kernel_launch: hipFuncSetAttribute failed\n"); grid = -1; return; }
        if (hipOccupancyMaxActiveBlocksPerMultiprocessor(&per_cu, (const void*)fwd_kernel, NT, LDS_BYTES) != hipSuccess || per_cu < 1) fprintf(stderr, "kernel_launch: occupancy query says %d\n", per_cu);
        (void)hipGetLastError();
        grid = cus;
    }
    if (grid < 0) return;
    if (hipMemsetAsync((char*)d_ws + WS_CTL, 0, CTL_ZERO_BYTES, stream) != hipSuccess) return;
    Args a{};
    for (int i = 0; i < 36; ++i) a.in[i] = (const float*)d_in[i];
    a.out = (float*)d_out; a.ws = (unsigned char*)d_ws;
    const int stop = MK_STOP_AFTER < N_PHASES ? MK_STOP_AFTER + 1 : N_PHASES;
#if MK_N_LAUNCHES == 1
    a.ph_lo = 0; a.ph_hi = stop;
    hipLaunchKernelGGL(fwd_kernel, dim3(grid), dim3(NT), LDS_BYTES, stream, a);
#else
    for (int p = 0; p < stop; ++p) { a.ph_lo = p; a.ph_hi = p + 1; hipLaunchKernelGGL(fwd_kernel, dim3(grid), dim3(NT), LDS_BYTES, stream, a); }
#endif
}
```

```cpp
#include <hip/hip_runtime.h>
#include <cstdio>
#include <cstdint>

#ifndef MK_N_LAUNCHES
#define MK_N_LAUNCHES 1
#endif
#ifndef MK_STOP_AFTER
#define MK_STOP_AFTER 99
#endif

#define GAS __attribute__((address_space(1)))
#define LAS __attribute__((address_space(3)))
typedef unsigned short bf16;
typedef unsigned v4u __attribute__((ext_vector_type(4)));
typedef unsigned v2u __attribute__((ext_vector_type(2)));
typedef float f32x4 __attribute__((ext_vector_type(4)));
typedef float f32x2 __attribute__((ext_vector_type(2)));
typedef short bf16x8 __attribute__((ext_vector_type(8)));
#define LDS_WAIT() asm volatile("s_waitcnt lgkmcnt(0)" ::: "memory")
#define VM_WAIT() asm volatile("s_waitcnt vmcnt(0)" ::: "memory")

constexpr int NWAVES = 8, NT = NWAVES * 64;
constexpr int L = 16384, D = 2048, LC = 256, MROWS = L + LC;
constexpr int NIN = 6176, NINP = 6400;
constexpr int OFF_K = 0, OFF_V = 512, OFF_G = 1536, OFF_Q = 1568, OFF_O = 2080, OFF_HY = 3104;
constexpr int NH = 8, HYW = 1024, MVW = 1024;
constexpr int NE = 64, NE1 = 65, DE = 512;
constexpr int HALF_T = 8192;
constexpr int MAXROWS = 90112;
constexpr float EPS = 1e-6f;

constexpr size_t MiB = 1u << 20;
constexpr size_t WS_CTL = 0, CTL_ZERO_BYTES = 256 * 1024;
constexpr size_t WS_MOD = 1 * MiB;
constexpr size_t WS_POS = WS_MOD + 128 * 1024;
constexpr size_t WS_WIN = 3 * MiB;
constexpr size_t WS_WOUT = 28 * MiB;
constexpr size_t WS_W13 = 36 * MiB;
constexpr size_t WS_W2 = 296 * MiB;
constexpr size_t WS_HA = 426 * MiB;
constexpr size_t WS_Z = 491 * MiB;
constexpr size_t WS_CAT = 695 * MiB;
constexpr size_t WS_UIN = 759 * MiB;
constexpr size_t WS_KF = 823 * MiB;
constexpr size_t WS_KB = 887 * MiB;
constexpr size_t WS_HF = 951 * MiB;
constexpr size_t WS_HB = 983 * MiB;
constexpr size_t WS_RTOK = 1015 * MiB;
constexpr size_t WS_RW = WS_RTOK + 2 * MAXROWS * 4;
constexpr size_t WS_AEXP = 1017 * MiB;
constexpr size_t WS_ARANK = WS_AEXP + 512 * 1024;
constexpr size_t WS_AW = WS_ARANK + 512 * 1024;
constexpr size_t WS_HDN = 1019 * MiB;
constexpr size_t WS_END = 1021 * MiB;
constexpr size_t WS_HR = 491 * MiB;
constexpr size_t WS_Y2 = 579 * MiB;
static_assert(WS_Y2 + (size_t)MAXROWS * 2048 * 2 <= WS_HF, "overlay");
constexpr int CW_BAR = 4096;
constexpr int CW_CNT = 16384;

constexpr int RING_BYTES = 131072;
constexpr int LDSCTL_OFF = 143360;
constexpr int FFTSCR_OFF = LDSCTL_OFF + 1024;
constexpr int LDS_BYTES = 147456;

__device__ __forceinline__ unsigned cvt_pk_bf16(float lo, float hi) { unsigned r; asm volatile("v_cvt_pk_bf16_f32 %0, %1, %2" : "=v"(r) : "v"(lo), "v"(hi)); return r; }
__device__ __forceinline__ float bf2f(unsigned short b) { return __builtin_bit_cast(float, ((unsigned)b) << 16); }
__device__ __forceinline__ float bflo(unsigned u) { return __builtin_bit_cast(float, u << 16); }
__device__ __forceinline__ float bfhi(unsigned u) { return __builtin_bit_cast(float, u & 0xffff0000u); }
__device__ __forceinline__ float wave_sum(float v) {
#pragma unroll
    for (int o = 1; o < 64; o <<= 1) v += __shfl_xor(v, o);
    return v;
}
__device__ __forceinline__ float silu_f(float a) { return a / (1.f + __expf(-a)); }
__device__ __forceinline__ float sigmoid_f(float a) { return 1.f / (1.f + __expf(-a)); }

#define XB_TMO      128
#define XB_XCNT(j)  (256  + 64 * (j))
#define XB_XSUB(j)  (1280 + 64 * (j))
#define XB_XGEN(j)  (2304 + 64 * (j))
#define XB_TOP      3328
#define XB_TOPGEN   3392
#define XCD_BAR_WORDS 3456
#define XB_SPIN_CAP (1u << 18)

__device__ __forceinline__ unsigned xb_ld(unsigned* p)              { return __hip_atomic_load(p, __ATOMIC_RELAXED, __HIP_MEMORY_SCOPE_AGENT); }
__device__ __forceinline__ unsigned xb_add(unsigned* p, unsigned v) { return __hip_atomic_fetch_add(p, v, __ATOMIC_RELAXED, __HIP_MEMORY_SCOPE_AGENT); }
__device__ __forceinline__ unsigned xb_xcc_id() { return (unsigned)__builtin_amdgcn_s_getreg((3 << 11) | 20) & 0xFu; }
#define XB_SPIN(cond, bar) do { unsigned _sp = 0; while (cond) { __builtin_amdgcn_s_sleep(1); \
    if ((++_sp & 255u) == 0u) { if (xb_ld(&(bar)[XB_TMO])) break; if (_sp > XB_SPIN_CAP) { atomicAdd(&(bar)[XB_TMO], 1u); break; } } } } while (0)

struct XcdBarrier {
    unsigned* bar; unsigned x;
    volatile LAS unsigned* st;
};

__device__ __forceinline__ XcdBarrier xcd_barrier_post(unsigned* bar, volatile LAS unsigned* st) {
    XcdBarrier b; b.bar = bar; b.x = xb_xcc_id(); b.st = st;
    if (threadIdx.x == 0) (void)xb_add(&bar[XB_XCNT(b.x)], 1u);
    return b;
}
__device__ __forceinline__ void xcd_barrier_complete(unsigned* bar, unsigned x, unsigned& nloc, unsigned& nx) {
    const unsigned G = gridDim.x * gridDim.y * gridDim.z;
    unsigned sum, cnt, mine, sp = 0u;
    for (;;) {
        sum = 0u; cnt = 0u; mine = 0u;
#pragma unroll
        for (unsigned j = 0; j < 16; ++j) { const unsigned c = xb_ld(&bar[XB_XCNT(j)]); sum += c; cnt += (c > 0u) ? 1u : 0u; mine = (j == x) ? c : mine; }
        if (sum == G) break;
        __builtin_amdgcn_s_sleep(1);
        if ((++sp & 255u) == 0u) { if (xb_ld(&bar[XB_TMO])) break; if (sp > XB_SPIN_CAP) { atomicAdd(&bar[XB_TMO], 1u); break; } }
    }
    nloc = mine > 0u ? mine : 1u; nx = cnt > 0u ? cnt : 1u;
}

__device__ __forceinline__ void xcd_barrier(const XcdBarrier& b) {
    asm volatile("s_waitcnt vmcnt(0)" ::: "memory");
    __syncthreads();
    if (threadIdx.x == 0) {
        unsigned* bar = b.bar;
        __builtin_amdgcn_s_waitcnt(0);
        unsigned nloc = b.st[0], nx = b.st[1];
        if (nloc == 0u) { xcd_barrier_complete(bar, b.x, nloc, nx); b.st[0] = nloc; b.st[1] = nx; }
        const unsigned old = xb_add(&bar[XB_XSUB(b.x)], 1u);
        const unsigned gen = old / nloc;
        if (old + 1u == (gen + 1u) * nloc) {
            __builtin_amdgcn_fence(__ATOMIC_RELEASE, "agent");
            asm volatile("s_waitcnt vmcnt(0)" ::: "memory");
            const unsigned og = xb_add(&bar[XB_TOP], 1u);
            const unsigned tg = og / nx;
            if (og + 1u == (tg + 1u) * nx) xb_add(&bar[XB_TOPGEN], 1u);
            else XB_SPIN(xb_ld(&bar[XB_TOPGEN]) == tg, bar);
            __builtin_amdgcn_fence(__ATOMIC_ACQUIRE, "agent");
            xb_add(&bar[XB_XGEN(b.x)], 1u);
            asm volatile("s_waitcnt vmcnt(0)" ::: "memory");
        } else {
            XB_SPIN(xb_ld(&bar[XB_XGEN(b.x)]) == gen, bar);
            __builtin_amdgcn_fence(__ATOMIC_ACQUIRE, "agent");
            asm volatile("s_waitcnt vmcnt(0)" ::: "memory");
        }
    }
    __syncthreads();
}

namespace gk {
constexpr int BM = 256, BK = 64, HALF = 128, HTB = HALF * BK * 2, STAGE_BYTES = 8 * HTB, NXCD = 8, WGM = 8;
__host__ __device__ __forceinline__ int lds_byte(int r, int c) { const int st = (r >> 4) * 2 + (c >> 5), rr = r & 15, cc = c & 31, ob = rr * 64 + cc * 2; return st * 1024 + (ob ^ (((ob >> 9) & 1) << 5)); }
__host__ __device__ __forceinline__ void stage_rc(int b, int& R, int& C) { const int st = b / 1024, sb = b % 1024, swz = sb ^ (((sb >> 9) & 1) << 5); R = (st >> 1) * 16 + swz / 64; C = (st & 1) * 32 + (swz % 64) / 2; }
__host__ __device__ __forceinline__ int perm32(int rho) { const int n = rho >> 4, i = rho & 15; return 8 * (i >> 2) + 4 * n + (i & 3); }

struct Unit { int pm, pn, ex; };

template <class Epi, class Sched>
__device__ __forceinline__ void gemm_core(LAS unsigned char* lds, const char* Abase, const int K, const Sched& S, const Epi& E) {
    const int tid = threadIdx.x, wid = __builtin_amdgcn_readfirstlane(tid >> 6), lane = tid & 63, wr = wid >> 2, wc = wid & 3, fr = lane & 15, fq = lane >> 4;
    const int nt = K / BK;
    int RA[2], CA[2]; unsigned voffB[2];
#pragma unroll
    for (int i = 0; i < 2; ++i) { int R, C; stage_rc(tid * 16 + i * 8192, R, C); const int Rb = Epi::PERM ? ((R & ~31) + perm32(R & 31)) : R;
        RA[i] = R; CA[i] = C; voffB[i] = (unsigned)(Rb * K + C) * 2u; }
    const size_t kstep = (size_t)(BK * 2);
    const size_t hstepB = (size_t)HALF * K * 2;
    const unsigned ldsw = (unsigned)wid * 1024u;
    const int aoff = lds_byte(wr * 64 + fr, fq * 8), boff = lds_byte(wc * 32 + fr, fq * 8);
#define GK_SA(b, h) (((b) * 2 + (h)) * HTB)
#define GK_SB(b, h) ((4 + (b) * 2 + (h)) * HTB)
#define GK_STAGE(bufoff, gbase, v0, v1) do { \
        __builtin_amdgcn_global_load_lds((const unsigned*)((const char*)(gbase) + (v0)), (LAS unsigned*)(lds + (bufoff) + ldsw), 16, 0, 0); \
        __builtin_amdgcn_global_load_lds((const unsigned*)((const char*)(gbase) + (v1)), (LAS unsigned*)(lds + (bufoff) + ldsw + 8192), 16, 0, 0); } while (0)
#define GK_LDA(dst, b, h) do { _Pragma("unroll") for (int m = 0; m < 4; ++m) _Pragma("unroll") for (int k = 0; k < 2; ++k) dst[m][k] = *(const LAS bf16x8*)(lds + GK_SA(b, h) + aoff + m * 2048 + k * 1024); } while (0)
#define GK_LDB(dst, b, h) do { _Pragma("unroll") for (int n = 0; n < 2; ++n) _Pragma("unroll") for (int k = 0; k < 2; ++k) dst[n][k] = *(const LAS bf16x8*)(lds + GK_SB(b, h) + boff + n * 2048 + k * 1024); } while (0)
#define GK_MMA(ai, bj, At, Bt) do { __builtin_amdgcn_s_setprio(1); _Pragma("unroll") for (int m = 0; m < 4; ++m) _Pragma("unroll") for (int n = 0; n < 2; ++n) _Pragma("unroll") for (int k = 0; k < 2; ++k) \
        acc[ai][bj][m][n] = __builtin_amdgcn_mfma_f32_16x16x32_bf16(Bt[n][k], At[m][k], acc[ai][bj][m][n], 0, 0, 0); __builtin_amdgcn_s_setprio(0); } while (0)
#define GK_WAIT_V(n) asm volatile("s_waitcnt vmcnt(" #n ")" ::: "memory")
#define GK_WAIT_L(n) asm volatile("s_waitcnt lgkmcnt(" #n ")" ::: "memory")
#define GK_BAR __builtin_amdgcn_s_barrier()
#define GK_SCHED __builtin_amdgcn_sched_barrier(0)
    Unit cur, nxt; int ui = 0;
    if (!S.next(0, cur)) return;
    f32x4 acc[2][2][4][2];
#pragma unroll
    for (int a = 0; a < 2; ++a)
#pragma unroll
        for (int b = 0; b < 2; ++b)
#pragma unroll
            for (int m = 0; m < 4; ++m)
#pragma unroll
                for (int n = 0; n < 2; ++n) acc[a][b][m][n] = (f32x4){0.f, 0.f, 0.f, 0.f};
    bf16x8 At[4][2], B0[2][2], B1[2][2];
    unsigned c00, c01, c10, c11, n00, n01, n10, n11;
    S.a_offs(cur, RA, CA, c00, c01, c10, c11);
    asm volatile("" : "+v"(c00), "+v"(c01), "+v"(c10), "+v"(c11));
    const char* cB = S.b_base(cur);
    GK_STAGE(GK_SB(0, 0), cB, voffB[0], voffB[1]); GK_STAGE(GK_SB(0, 1), cB + hstepB, voffB[0], voffB[1]); GK_STAGE(GK_SA(0, 0), Abase, c00, c01); GK_STAGE(GK_SA(0, 1), Abase, c10, c11);
    if (wr == 1) GK_BAR;
    GK_WAIT_V(2); GK_BAR;
    GK_STAGE(GK_SB(1, 0), cB + kstep, voffB[0], voffB[1]); GK_STAGE(GK_SA(1, 0), Abase + kstep, c00, c01); GK_STAGE(GK_SB(1, 1), cB + hstepB + kstep, voffB[0], voffB[1]);
    GK_WAIT_V(6); GK_BAR;
    for (;;) {
        const bool has_next = S.next(ui + 1, nxt);
        const char* nB = cB;
        n00 = c00; n01 = c01; n10 = c10; n11 = c11;
        if (has_next) { S.a_offs(nxt, RA, CA, n00, n01, n10, n11); nB = S.b_base(nxt); }
        asm volatile("" : "+v"(n00), "+v"(n01), "+v"(n10), "+v"(n11));
        for (int t = 0; t < nt; t += 2) {
            const bool last = (t == nt - 2);
            const char* a1 = Abase + (size_t)(t + 1) * kstep;
            const char* a2 = last ? Abase : Abase + (size_t)(t + 2) * kstep; const char* b2 = last ? nB : cB + (size_t)(t + 2) * kstep;
            const char* a3 = a2 + kstep; const char* b3 = b2 + kstep;
            const unsigned x00 = last ? n00 : c00, x01 = last ? n01 : c01, x10 = last ? n10 : c10, x11 = last ? n11 : c11;
            GK_LDB(B0, 0, 0); GK_LDB(B1, 0, 1); GK_SCHED; GK_LDA(At, 0, 0); GK_STAGE(GK_SA(1, 1), a1, c10, c11);
            GK_WAIT_V(8); GK_WAIT_L(0); GK_BAR; GK_MMA(0, 0, At, B0); GK_MMA(0, 1, At, B1); GK_BAR; GK_SCHED;
            GK_LDA(At, 0, 1); GK_STAGE(GK_SB(0, 0), b2, voffB[0], voffB[1]); GK_STAGE(GK_SB(0, 1), b2 + hstepB, voffB[0], voffB[1]); GK_STAGE(GK_SA(0, 0), a2, x00, x01);
            GK_WAIT_V(8); GK_WAIT_L(0); GK_BAR; GK_MMA(1, 0, At, B0); GK_MMA(1, 1, At, B1); GK_BAR; GK_SCHED;
            GK_LDB(B0, 1, 0); GK_LDB(B1, 1, 1); GK_SCHED; GK_LDA(At, 1, 0); GK_STAGE(GK_SA(0, 1), a2, x10, x11);
            GK_WAIT_V(8); GK_WAIT_L(0); GK_BAR; GK_MMA(0, 0, At, B0); GK_MMA(0, 1, At, B1); GK_BAR; GK_SCHED;
            GK_LDA(At, 1, 1); GK_STAGE(GK_SB(1, 0), b3, voffB[0], voffB[1]); GK_STAGE(GK_SB(1, 1), b3 + hstepB, voffB[0], voffB[1]); GK_STAGE(GK_SA(1, 0), a3, x00, x01);
            GK_WAIT_V(8); GK_WAIT_L(0); GK_BAR; GK_MMA(1, 0, At, B0); GK_MMA(1, 1, At, B1); GK_BAR; GK_SCHED;
        }
        if (wr == 0) GK_BAR;
        E(acc, cur, wr, wc, fr, fq);
        if (!has_next) break;
#pragma unroll
        for (int a = 0; a < 2; ++a)
#pragma unroll
            for (int b = 0; b < 2; ++b)
#pragma unroll
                for (int m = 0; m < 4; ++m)
#pragma unroll
                    for (int n = 0; n < 2; ++n) acc[a][b][m][n] = (f32x4){0.f, 0.f, 0.f, 0.f};
        cur = nxt; cB = nB; c00 = n00; c01 = n01; c10 = n10; c11 = n11; ++ui;
        if (wr == 1) GK_BAR;
    }
    GK_WAIT_V(0);
    GK_BAR;
#undef GK_SA
#undef GK_SB
#undef GK_STAGE
#undef GK_LDA
#undef GK_LDB
#undef GK_MMA
#undef GK_WAIT_V
#undef GK_WAIT_L
#undef GK_BAR
#undef GK_SCHED
}

struct DenseOrder {
    int nM, nN, nwg, G, c, K;
    __device__ void init(int M, int N, int K_, int G_, int c_) { nM = M / BM; nN = N / BM; nwg = nM * nN; G = G_; c = c_; K = K_; }
    __device__ __forceinline__ bool next(int i, Unit& u) const {
        const long Lx = (long)i * G + c; if (Lx >= nwg) return false;
        int wgid = (int)Lx; { const int q = nwg / NXCD, r = nwg % NXCD, xcd = wgid % NXCD, off = wgid / NXCD; wgid = (xcd < r ? xcd * (q + 1) : r * (q + 1) + (xcd - r) * q) + off; }
        const int nig = WGM * nN, gid = wgid / nig, fm = gid * WGM, gsz = (nM - fm) < WGM ? (nM - fm) : WGM;
        u.pm = fm + ((wgid % nig) % gsz); u.pn = (wgid % nig) / gsz; u.ex = 0; return true;
    }
    const char* Bt;
    __device__ __forceinline__ void a_offs(const Unit& u, const int (&RA)[2], const int (&CA)[2], unsigned& o00, unsigned& o01, unsigned& o10, unsigned& o11) const {
        const unsigned r0 = (unsigned)(u.pm * BM);
        o00 = ((r0 + RA[0]) * (unsigned)K + CA[0]) * 2u; o01 = ((r0 + RA[1]) * (unsigned)K + CA[1]) * 2u;
        o10 = ((r0 + HALF + RA[0]) * (unsigned)K + CA[0]) * 2u; o11 = ((r0 + HALF + RA[1]) * (unsigned)K + CA[1]) * 2u;
    }
    __device__ __forceinline__ const char* b_base(const Unit& u) const { return Bt + (size_t)u.pn * BM * K * 2; }
};
template <int NPN, bool GATHER>
struct GroupOrder {
    int ntile, G, c, K;
    const LAS int* pstart;
    const int* rtok;
    const char* Bt; size_t bstride;
    __device__ __forceinline__ bool next(int i, Unit& u) const {
        const long Lx = (long)i * G + c; if (Lx >= (long)ntile * NPN) return false;
        u.pm = (int)(Lx / NPN); u.pn = (int)(Lx % NPN);
        const int row = u.pm * BM; int lo = 0, hi = NE1;
        while (hi - lo > 1) { const int mid = (lo + hi) >> 1; if (pstart[mid] <= row) lo = mid; else hi = mid; }
        u.ex = lo; return true;
    }
    __device__ __forceinline__ void a_offs(const Unit& u, const int (&RA)[2], const int (&CA)[2], unsigned& o00, unsigned& o01, unsigned& o10, unsigned& o11) const {
        const int r0 = u.pm * BM;
        if (GATHER) {
            const int t00 = rtok[r0 + RA[0]], t01 = rtok[r0 + RA[1]], t10 = rtok[r0 + HALF + RA[0]], t11 = rtok[r0 + HALF + RA[1]];
            o00 = ((unsigned)t00 * (unsigned)K + CA[0]) * 2u; o01 = ((unsigned)t01 * (unsigned)K + CA[1]) * 2u;
            o10 = ((unsigned)t10 * (unsigned)K + CA[0]) * 2u; o11 = ((unsigned)t11 * (unsigned)K + CA[1]) * 2u;
        } else {
            o00 = ((unsigned)(r0 + RA[0]) * (unsigned)K + CA[0]) * 2u; o01 = ((unsigned)(r0 + RA[1]) * (unsigned)K + CA[1]) * 2u;
            o10 = ((unsigned)(r0 + HALF + RA[0]) * (unsigned)K + CA[0]) * 2u; o11 = ((unsigned)(r0 + HALF + RA[1]) * (unsigned)K + CA[1]) * 2u;
        }
    }
    __device__ __forceinline__ const char* b_base(const Unit& u) const { return Bt + (size_t)u.ex * bstride + (size_t)u.pn * BM * K * 2; }
};

struct EpiBf16Store {
    static constexpr bool PERM = true;
    bf16* O; int ldc;
    __device__ __forceinline__ void operator()(const f32x4 (&acc)[2][2][4][2], const Unit& u, int wr, int wc, int fr, int fq) const {
        const int row0 = u.pm * BM + wr * 64 + fr, col0 = u.pn * BM + wc * 32 + 8 * fq;
#pragma unroll
        for (int ai = 0; ai < 2; ++ai)
#pragma unroll
            for (int m = 0; m < 4; ++m) { bf16* rowp = O + (size_t)(row0 + ai * HALF + m * 16) * ldc + col0;
#pragma unroll
                for (int bj = 0; bj < 2; ++bj) { const f32x4 v0 = acc[ai][bj][m][0], v1 = acc[ai][bj][m][1];
                    v4u w; w.x = cvt_pk_bf16(v0[0], v0[1]); w.y = cvt_pk_bf16(v0[2], v0[3]); w.z = cvt_pk_bf16(v1[0], v1[1]); w.w = cvt_pk_bf16(v1[2], v1[3]);
                    *(v4u*)(rowp + bj * HALF) = w; } }
    }
};
struct EpiResidual {
    static constexpr bool PERM = false;
    float* X; int ldc; const float* gate;
    __device__ __forceinline__ void operator()(const f32x4 (&acc)[2][2][4][2], const Unit& u, int wr, int wc, int fr, int fq) const {
        const int row0 = u.pm * BM + wr * 64 + fr, col0 = u.pn * BM + wc * 32 + 4 * fq;
        f32x4 gv[2][2];
#pragma unroll
        for (int bj = 0; bj < 2; ++bj)
#pragma unroll
            for (int n = 0; n < 2; ++n) gv[bj][n] = *(const f32x4*)(gate + col0 + bj * HALF + n * 16);
#pragma unroll
        for (int ai = 0; ai < 2; ++ai)
#pragma unroll
            for (int m = 0; m < 4; ++m) { float* rowp = X + (size_t)(row0 + ai * HALF + m * 16) * ldc + col0;
#pragma unroll
                for (int bj = 0; bj < 2; ++bj)
#pragma unroll
                    for (int n = 0; n < 2; ++n) { f32x4* p = (f32x4*)(rowp + bj * HALF + n * 16); *p = *p + gv[bj][n] * acc[ai][bj][m][n]; } }
    }
};
struct EpiGateUp {
    static constexpr bool PERM = true;
    bf16* O;
    __device__ __forceinline__ void operator()(const f32x4 (&acc)[2][2][4][2], const Unit& u, int wr, int wc, int fr, int fq) const {
        const int row0 = u.pm * BM + wr * 64 + fr, col0 = u.pn * HALF + wc * 32 + 8 * fq;
#pragma unroll
        for (int ai = 0; ai < 2; ++ai)
#pragma unroll
            for (int m = 0; m < 4; ++m) { bf16* rowp = O + (size_t)(row0 + ai * HALF + m * 16) * DE + col0;
                float h[8];
#pragma unroll
                for (int n = 0; n < 2; ++n)
#pragma unroll
                    for (int j = 0; j < 4; ++j) { const float g = acc[ai][0][m][n][j], up = acc[ai][1][m][n][j]; h[n * 4 + j] = silu_f(g) * up; }
                v4u w; w.x = cvt_pk_bf16(h[0], h[1]); w.y = cvt_pk_bf16(h[2], h[3]); w.z = cvt_pk_bf16(h[4], h[5]); w.w = cvt_pk_bf16(h[6], h[7]);
                *(v4u*)rowp = w; }
    }
};
struct EpiDown {
    static constexpr bool PERM = true;
    bf16* O; const float* rw;
    __device__ __forceinline__ void operator()(const f32x4 (&acc)[2][2][4][2], const Unit& u, int wr, int wc, int fr, int fq) const {
        const int row0 = u.pm * BM + wr * 64 + fr, col0 = u.pn * BM + wc * 32 + 8 * fq;
#pragma unroll
        for (int ai = 0; ai < 2; ++ai)
#pragma unroll
            for (int m = 0; m < 4; ++m) { const int row = row0 + ai * HALF + m * 16; const float s = rw[row]; bf16* rowp = O + (size_t)row * D + col0;
#pragma unroll
                for (int bj = 0; bj < 2; ++bj) { const f32x4 v0 = acc[ai][bj][m][0] * s, v1 = acc[ai][bj][m][1] * s;
                    v4u w; w.x = cvt_pk_bf16(v0[0], v0[1]); w.y = cvt_pk_bf16(v0[2], v0[3]); w.z = cvt_pk_bf16(v1[0], v1[1]); w.w = cvt_pk_bf16(v1[2], v1[3]);
                    *(v4u*)(rowp + bj * HALF) = w; } }
    }
};
}

struct Args { const float* in[36]; float* out; unsigned char* ws; int ph_lo, ph_hi; };
struct Frame {
    LAS unsigned char* lds;
    int tid, lane, wave, bid, G;
    const float* const* in; float* out; unsigned char* ws;
};
#define IN_X 0
#define IN_C 1
#define IN_CTX 2
#define IN_CCTX 3
#define IN_WADA 4
#define IN_BADA 5
#define IN_GMIX 6
#define IN_GFFN 7
#define IN_WIN 8
#define IN_BGATES 9
#define IN_CKW 10
#define IN_CKB 11
#define IN_CQW 12
#define IN_CQB 13
#define IN_GHEAD 14
#define IN_CHW 15
#define IN_CHB 16
#define IN_FW1 17
#define IN_FB1 18
#define IN_FF1 19
#define IN_FW2 20
#define IN_FB2 21
#define IN_FF2 22
#define IN_FW3 23
#define IN_FB3 24
#define IN_DSKIP 25
#define IN_WOUT 26
#define IN_WR 27
#define IN_BR 28
#define IN_W1E 29
#define IN_W3E 30
#define IN_W2E 31
#define IN_W1S 32
#define IN_W3S 33
#define IN_W2S 34
#define IN_GFIN 35

__device__ __forceinline__ void transpose_item(const float* W, int N, int k0, int n0, bf16* WT, int dstK, int dst_row0, LAS float* scr, int lane) {
#pragma unroll 8
    for (int i = 0; i < 32; ++i) { const int kk = 2 * i + (lane >> 5); scr[kk * 33 + (lane & 31)] = W[(size_t)(k0 + kk) * N + n0 + (lane & 31)]; }
    LDS_WAIT(); asm volatile("" ::: "memory");
    const int c = lane & 7;
#pragma unroll
    for (int j = 0; j < 4; ++j) { const int n = (lane >> 3) + 8 * j; const LAS float* s = scr + (8 * c) * 33 + n;
        v4u o; o.x = cvt_pk_bf16(s[0 * 33], s[1 * 33]); o.y = cvt_pk_bf16(s[2 * 33], s[3 * 33]); o.z = cvt_pk_bf16(s[4 * 33], s[5 * 33]); o.w = cvt_pk_bf16(s[6 * 33], s[7 * 33]);
        *(v4u*)(WT + (size_t)(dst_row0 + n) * dstK + k0 + 8 * c) = o; }
    LDS_WAIT(); asm volatile("" ::: "memory");
}
__device__ __forceinline__ void p0_prologue(Frame& F) {
    const float* const* in = F.in;
    {
        LAS float* sv = (LAS float*)F.lds;
        LAS float* red = sv + 4096;
        float* mod = (float*)(F.ws + WS_MOD);
        for (int job = F.bid; job < 192; job += F.G) {
            for (int i = F.tid; i < 2048; i += NT) { sv[i] = silu_f(in[IN_C][i]); sv[2048 + i] = silu_f(in[IN_CCTX][i]); }
            __syncthreads();
            const int col = job * 64 + F.lane, r0 = F.wave * 256;
            const float* W = in[IN_WADA] + col;
            float a0 = 0.f, a1 = 0.f;
            for (int i = r0; i < r0 + 256; i += 8) {
                float w[8];
#pragma unroll
                for (int j = 0; j < 8; ++j) w[j] = W[(size_t)(i + j) * 12288];
#pragma unroll
                for (int j = 0; j < 8; ++j) { a0 += sv[i + j] * w[j]; a1 += sv[2048 + i + j] * w[j]; }
            }
            red[(F.wave * 64 + F.lane) * 2 + 0] = a0; red[(F.wave * 64 + F.lane) * 2 + 1] = a1;
            __syncthreads();
            if (F.wave == 0) { float s0 = 0.f, s1 = 0.f;
#pragma unroll
                for (int w = 0; w < 8; ++w) { s0 += red[(w * 64 + F.lane) * 2 + 0]; s1 += red[(w * 64 + F.lane) * 2 + 1]; }
                const float b = in[IN_BADA][col]; mod[col] = s0 + b; mod[12288 + col] = s1 + b; }
            __syncthreads();
        }
    }
    const int gt = F.bid * NT + F.tid, NGT = F.G * NT;
    {
        float* pos = (float*)(F.ws + WS_POS);
        for (int i = gt; i < 320 * 1024; i += NGT) { const int p = i >> 10, j = i & 1023, jj = j & 511;
            const float pp = (float)(p < 256 ? p : p - 256);
            const float omega = 1.0f / powf(10000.0f, (float)jj * (1.0f / 512.0f)); const float ang = pp * omega;
            pos[i] = j < 512 ? sinf(ang) : cosf(ang); }
    }
    {
        v4u* z = (v4u*)(F.ws + WS_WIN + (size_t)NIN * D * 2); const int nz = (NINP - NIN) * D * 2 / 16;
        for (int i = gt; i < nz; i += NGT) z[i] = (v4u){0u, 0u, 0u, 0u};
        int* rt = (int*)(F.ws + WS_RTOK); float* rw = (float*)(F.ws + WS_RW);
        for (int i = gt; i < 2 * MAXROWS; i += NGT) { rt[i] = 0; rw[i] = 0.f; }
    }
    {
        LAS float* scr = (LAS float*)(F.lds + F.wave * 16384);
        const int gw = F.bid * NWAVES + F.wave, NGW = F.G * NWAVES;
        constexpr int I_IN = 32 * 193, I_OUT = 32 * 64, I_E = 512 * NE1;
        constexpr int NITEMS = I_IN + I_OUT + 3 * I_E;
        for (int it = gw; it < NITEMS; it += NGW) {
            int r = it;
            if (r < I_IN) { const int kb = r / 193, nb = r % 193; transpose_item(in[IN_WIN], NIN, 64 * kb, 32 * nb, (bf16*)(F.ws + WS_WIN), D, 32 * nb, scr, F.lane); continue; } r -= I_IN;
            if (r < I_OUT) { const int kb = r / 64, nb = r % 64; transpose_item(in[IN_WOUT], D, 64 * kb, 32 * nb, (bf16*)(F.ws + WS_WOUT), D, 32 * nb, scr, F.lane); continue; } r -= I_OUT;
            if (r < 2 * I_E) { const int which = r >= I_E; if (which) r -= I_E;
                const int e = r / 512, rr = r % 512, kb = rr / 16, nb = rr % 16, n0 = 32 * nb;
                const float* src = e < NE ? in[which ? IN_W3E : IN_W1E] + (size_t)e * D * DE : in[which ? IN_W3S : IN_W1S];
                transpose_item(src, DE, 64 * kb, n0, (bf16*)(F.ws + WS_W13) + (size_t)e * 1024 * D, D, (n0 >> 7) * 256 + which * 128 + (n0 & 127), scr, F.lane); continue; }
            r -= 2 * I_E;
            { const int e = r / 512, rr = r % 512, kb = rr / 64, nb = rr % 64;
                const float* src = e < NE ? in[IN_W2E] + (size_t)e * DE * D : in[IN_W2S];
                transpose_item(src, D, 64 * kb, 32 * nb, (bf16*)(F.ws + WS_W2) + (size_t)e * D * DE, DE, 32 * nb, scr, F.lane); }
        }
    }
}

__device__ __forceinline__ void p1_norm1(Frame& F) {
    const float* const* in = F.in;
    const int gw = F.bid * NWAVES + F.wave, NGW = F.G * NWAVES;
    const float* mod = (const float*)(F.ws + WS_MOD); const float* pos = (const float*)(F.ws + WS_POS);
    bf16* hA = (bf16*)(F.ws + WS_HA);
    for (int row = gw; row < MROWS; row += NGW) {
        f32x4 v[8]; float ss = 0.f;
        const bool mainrow = row < L;
        const float* src = mainrow ? in[IN_X] + (size_t)row * D : in[IN_CTX] + (size_t)(row - L) * D;
        const float* md = mainrow ? mod : mod + 12288;
#pragma unroll
        for (int j = 0; j < 8; ++j) { const int col = 4 * F.lane + 256 * j; v[j] = *(const f32x4*)(src + col);
            if (mainrow) { const float* pp = col < 1024 ? pos + (size_t)(row >> 6) * 1024 + col : pos + (size_t)(256 + (row & 63)) * 1024 + (col - 1024);
                v[j] = v[j] + *(const f32x4*)pp; *(f32x4*)(F.out + (size_t)row * D + col) = v[j]; }
            ss += (v[j].x * v[j].x + v[j].y * v[j].y) + (v[j].z * v[j].z + v[j].w * v[j].w); }
        const float rstd = rsqrtf(wave_sum(ss) * (1.0f / D) + EPS);
#pragma unroll
        for (int j = 0; j < 8; ++j) { const int col = 4 * F.lane + 256 * j;
            const f32x4 g = *(const f32x4*)(in[IN_GMIX] + col), sh = *(const f32x4*)(md + col), sc = *(const f32x4*)(md + 2048 + col);
            const f32x4 h = (v[j] * rstd * g) * (sc + 1.0f) + sh;
            v2u o; o.x = cvt_pk_bf16(h.x, h.y); o.y = cvt_pk_bf16(h.z, h.w);
            *(v2u*)(hA + (size_t)row * D + col) = o; }
    }
}

__device__ __forceinline__ void p3_scan_job(Frame& F, int job) {
    const float* const* in = F.in;
    const int hd = job & 7, dir = job >> 3, tid = F.tid;
    const bf16* z = (const bf16*)(F.ws + WS_Z);
    bf16* hout = (bf16*)(F.ws + (dir ? WS_HB : WS_HF));
    LAS float* sk = (LAS float*)F.lds;
    LAS float* sq = sk + 512;
    LAS float* sv = sq + 512;
    LAS float* sg = sv + 1024;
    LAS float* snum = sg + 16;
    LAS float* sden = snum + 4096;
    LAS float* sem = sden + 32;
    const int e = tid & 127, dg = tid >> 7, d0 = dg * 16;
    float C[16], n[16]; float m = 0.f;
#pragma unroll
    for (int i = 0; i < 16; ++i) { C[i] = 0.f; n[i] = 0.f; }
    const int ts = tid >> 6, j = tid & 63;
    const int kc = hd * 64 + j;
    const float kw0 = in[IN_CKW][kc], kw1 = in[IN_CKW][512 + kc], kw2 = in[IN_CKW][1024 + kc], kb = in[IN_CKB][kc];
    const float qw0 = in[IN_CQW][kc], qw1 = in[IN_CQW][512 + kc], qw2 = in[IN_CQW][1024 + kc], qb = in[IN_CQB][kc];
    const float bgi = in[IN_BGATES][dir * 16 + hd], bgf = in[IN_BGATES][dir * 16 + 8 + hd];
    for (int p0 = 0; p0 < LC + L; p0 += 8) {
        const bool isctx = p0 < LC;
        const int len = isctx ? LC : L, base = isctx ? L : 0, q0 = isctx ? p0 : p0 - LC;
        {
            const int pp = q0 + ts, tok = dir ? len - 1 - pp : pp;
            const bf16* zc = z + (size_t)(base + tok) * NINP;
            const bool hp = tok > 0, hn = tok < len - 1;
            const float kp = hp ? bf2f(zc[-NINP + OFF_K + kc]) : 0.f, kn = hn ? bf2f(zc[NINP + OFF_K + kc]) : 0.f, k0 = bf2f(zc[OFF_K + kc]);
            const float qp = hp ? bf2f(zc[-NINP + OFF_Q + kc]) : 0.f, qn = hn ? bf2f(zc[NINP + OFF_Q + kc]) : 0.f, qq = bf2f(zc[OFF_Q + kc]);
            sk[ts * 64 + j] = silu_f(kp * kw0 + k0 * kw1 + kn * kw2 + kb);
            sq[ts * 64 + j] = silu_f(qp * qw0 + qq * qw1 + qn * qw2 + qb) * 0.125f;
            sv[ts * 128 + j] = bf2f(zc[OFF_V + hd * 128 + j]); sv[ts * 128 + 64 + j] = bf2f(zc[OFF_V + hd * 128 + 64 + j]);
            if (j == 0) { const float gi = bf2f(zc[OFF_G + dir * 16 + hd]) + bgi, gf = bf2f(zc[OFF_G + dir * 16 + 8 + hd]) + bgf;
                sg[ts * 2] = gi; sg[ts * 2 + 1] = fminf(gf, 0.f) - log1pf(__expf(-fabsf(gf))); }
        }
        __syncthreads();
#pragma unroll 1
        for (int s = 0; s < 8; ++s) {
            const float gi = sg[s * 2], lf = sg[s * 2 + 1];
            const float mn = fmaxf(lf + m, gi), a = __expf(lf + m - mn), b = __expf(gi - mn); m = mn;
            const float bv = b * sv[s * 128 + e];
            float num = 0.f, den = 0.f;
#pragma unroll
            for (int i = 0; i < 16; ++i) { const float kd = sk[s * 64 + d0 + i], qd = sq[s * 64 + d0 + i];
                C[i] = a * C[i] + bv * kd; n[i] = a * n[i] + b * kd; num += qd * C[i]; den += qd * n[i]; }
            snum[(s * 4 + dg) * 128 + e] = num;
            if (e == 0) { sden[s * 4 + dg] = den; if (dg == 0) sem[s] = __expf(-m); }
        }
        __syncthreads();
        if (!isctx) {
            const int s = tid >> 6, pp = q0 + s, tok = dir ? L - 1 - pp : pp;
            const float den = (sden[s * 4] + sden[s * 4 + 1]) + (sden[s * 4 + 2] + sden[s * 4 + 3]);
            const float dd = 1.0f / fmaxf(fabsf(den), sem[s]);
#pragma unroll
            for (int h = 0; h < 2; ++h) { const int ee = j + 64 * h;
                const float num = (snum[(s * 4) * 128 + ee] + snum[(s * 4 + 1) * 128 + ee]) + (snum[(s * 4 + 2) * 128 + ee] + snum[(s * 4 + 3) * 128 + ee]);
                hout[(size_t)tok * MVW + hd * 128 + ee] = (bf16)(cvt_pk_bf16(num * dd, 0.f) & 0xffffu); }
        }
        __syncthreads();
    }
}

__device__ __forceinline__ void p3_filter_tile(Frame& F, int tile) {
    const float* const* in = F.in;
    const int tid = F.tid;
    LAS float* feat = (LAS float*)F.lds;
    LAS float* h1 = feat + 64 * 36;
    LAS float* h2 = h1 + 64 * 65;
    LAS float* w1s = h2 + 64 * 64;
    LAS float* w2s = w1s + 33 * 64;
    for (int i = tid; i < 33 * 64; i += NT) w1s[i] = in[IN_FW1][i];
    for (int i = tid; i < 64 * 64; i += NT) w2s[i] = in[IN_FW2][i];
    {
        const int tt = tid >> 3, sub = tid & 7; const float t = (float)(tile * 64 + tt);
        const float w = (6.2831855f * t) / (float)L;
        if (sub == 0) feat[tt * 36] = t / (float)(L - 1);
#pragma unroll
        for (int q = 0; q < 2; ++q) { const int bi = sub * 2 + q; const float band = 1e-4f + (float)bi * ((15.0f - 1e-4f) / 15.0f); const float ang = w * band;
            feat[tt * 36 + 1 + bi] = cosf(ang); feat[tt * 36 + 17 + bi] = -sinf(ang); }
    }
    __syncthreads();
    {
        const int tt = tid >> 3, j0 = (tid & 7) * 8;
        float a[8];
#pragma unroll
        for (int q = 0; q < 8; ++q) a[q] = in[IN_FB1][j0 + q];
#pragma unroll 1
        for (int i = 0; i < 33; ++i) { const float f = feat[tt * 36 + i];
#pragma unroll
            for (int q = 0; q < 8; ++q) a[q] += f * w1s[i * 64 + j0 + q]; }
#pragma unroll
        for (int q = 0; q < 8; ++q) h1[tt * 65 + j0 + q] = sinf(in[IN_FF1][j0 + q] * a[q]);
    }
    __syncthreads();
    {
        const int tt = tid >> 3, j0 = (tid & 7) * 8;
        float a[8];
#pragma unroll
        for (int q = 0; q < 8; ++q) a[q] = in[IN_FB2][j0 + q];
#pragma unroll 1
        for (int i = 0; i < 64; ++i) { const float f = h1[tt * 65 + i];
#pragma unroll
            for (int q = 0; q < 8; ++q) a[q] += f * w2s[i * 64 + j0 + q]; }
#pragma unroll
        for (int q = 0; q < 8; ++q) h2[tt * 64 + j0 + q] = sinf(in[IN_FF2][j0 + q] * a[q]);
    }
    __syncthreads();
    {
        bf16* hd = (bf16*)(F.ws + WS_HDN);
        for (int i = tid; i < 64 * 32; i += NT) { const int tt = i >> 5, j = (i & 31) * 2; *(unsigned*)(hd + (size_t)(tile * 64 + tt) * 64 + j) = cvt_pk_bf16(h2[tt * 64 + j], h2[tt * 64 + j + 1]); }
    }
    __syncthreads();
}
__device__ __forceinline__ void p3_uin_tile(Frame& F, int tile) {
    const float* const* in = F.in;
    const bf16* z = (const bf16*)(F.ws + WS_Z); float* uT = (float*)(F.ws + WS_UIN);
    LAS float* tl = (LAS float*)F.lds;
    const int t0 = (tile >> 2) * 64, cb = (tile & 3) * 256;
    const int cg = F.tid & 31, c0 = cb + cg * 8, rsub = F.tid >> 5;
    for (int pass = 0; pass < 4; ++pass) {
        const int tt = pass * 16 + rsub, t = t0 + tt;
        float r1[8], r2[8];
#pragma unroll
        for (int part = 0; part < 2; ++part) {
            const int zc = OFF_HY + 1024 * (part + 1) + c0, wc = 1024 * (part + 1) + c0;
            const v4u cur = *(const v4u*)(z + (size_t)t * NINP + zc);
            const v4u prv = t > 0 ? *(const v4u*)(z + (size_t)(t - 1) * NINP + zc) : (v4u){0u, 0u, 0u, 0u};
            const v4u nxt = t < L - 1 ? *(const v4u*)(z + (size_t)(t + 1) * NINP + zc) : (v4u){0u, 0u, 0u, 0u};
            float* rr = part ? r2 : r1;
#pragma unroll
            for (int q = 0; q < 4; ++q) {
                const unsigned pc = q == 0 ? prv.x : q == 1 ? prv.y : q == 2 ? prv.z : prv.w, cc = q == 0 ? cur.x : q == 1 ? cur.y : q == 2 ? cur.z : cur.w, nc = q == 0 ? nxt.x : q == 1 ? nxt.y : q == 2 ? nxt.z : nxt.w;
                const int ch = wc + 2 * q;
                rr[2 * q] = bflo(pc) * in[IN_CHW][ch] + bflo(cc) * in[IN_CHW][3072 + ch] + bflo(nc) * in[IN_CHW][6144 + ch] + in[IN_CHB][ch];
                rr[2 * q + 1] = bfhi(pc) * in[IN_CHW][ch + 1] + bfhi(cc) * in[IN_CHW][3072 + ch + 1] + bfhi(nc) * in[IN_CHW][6144 + ch + 1] + in[IN_CHB][ch + 1];
            }
        }
#pragma unroll
        for (int q = 0; q < 8; ++q) tl[(cg * 8 + q) * 65 + tt] = r1[q] * r2[q];
    }
    __syncthreads();
    for (int i = F.tid; i < 256 * 16; i += NT) { const int c = i >> 4, tq = (i & 15) * 4; const LAS float* s = tl + c * 65 + tq;
        *(f32x4*)(uT + (size_t)(cb + c) * L + t0 + tq) = (f32x4){s[0], s[1], s[2], s[3]}; }
    __syncthreads();
}

#ifndef FFT_LAS
#define FFT_LAS LAS
#endif
#if defined(__HIP_DEVICE_COMPILE__)
#define FFT_OPAQUE(v) asm volatile("" : "+v"(v))
#else
#define FFT_OPAQUE(v)
#endif
constexpr int FN = 16384;
constexpr int FFT_SLOTS = 17920;
__host__ __device__ __forceinline__ int fphys(int p) { return p + (p >> 4) + ((p >> 9) << 4); }
__host__ __device__ __forceinline__ float fcos32(int k) {
    constexpr float T[16] = {1.0f, 0.98078528040323043f, 0.92387953251128674f, 0.83146961230254524f, 0.70710678118654752f, 0.55557023301960218f, 0.38268343236508977f, 0.19509032201612825f,
                             0.0f, -0.19509032201612825f, -0.38268343236508977f, -0.55557023301960218f, -0.70710678118654752f, -0.83146961230254524f, -0.92387953251128674f, -0.98078528040323043f};
    return T[k]; }
__host__ __device__ __forceinline__ float fsin32(int k) {
    constexpr float T[16] = {0.0f, 0.19509032201612825f, 0.38268343236508977f, 0.55557023301960218f, 0.70710678118654752f, 0.83146961230254524f, 0.92387953251128674f, 0.98078528040323043f,
                             1.0f, 0.98078528040323043f, 0.92387953251128674f, 0.83146961230254524f, 0.70710678118654752f, 0.55557023301960218f, 0.38268343236508977f, 0.19509032201612825f};
    return T[k]; }
template <int R> __host__ __device__ __forceinline__ constexpr int fbrev(int x) { int r = 0; for (int b = 1; b < R; b <<= 1) { r = (r << 1) | (x & 1); x >>= 1; } return r; }
template <int R, bool INV>
__host__ __device__ __forceinline__ void fft_reg(float (&xr)[R], float (&xi)[R]) {
#pragma unroll
    for (int len = R; len >= 2; len >>= 1) {
        const int half = len >> 1;
#pragma unroll
        for (int blk = 0; blk < R; blk += len)
#pragma unroll
            for (int k = 0; k < half; ++k) {
                const int i0 = blk + k, i1 = i0 + half;
                const float ar = xr[i0], ai = xi[i0], br = xr[i1], bi = xi[i1];
                xr[i0] = ar + br; xi[i0] = ai + bi;
                const float dr = ar - br, di = ai - bi;
                if (k == 0) { xr[i1] = dr; xi[i1] = di; }
                else if (4 * k == len) { if (!INV) { xr[i1] = di; xi[i1] = -dr; } else { xr[i1] = -di; xi[i1] = dr; } }
                else { const float c = fcos32(k * (32 / len)), s = fsin32(k * (32 / len));
                    if (!INV) { xr[i1] = dr * c + di * s; xi[i1] = di * c - dr * s; } else { xr[i1] = dr * c - di * s; xi[i1] = di * c + dr * s; } }
            }
    }
}
__host__ __device__ __forceinline__ void ftw(int num, int den, float& c, float& s) {
#if defined(__HIP_DEVICE_COMPILE__)
    sincospif(2.0f * (float)num / (float)den, &s, &c);
#else
    const double a = 6.283185307179586476925 * (double)num / (double)den; c = (float)cos(a); s = (float)sin(a);
#endif
}
template <int R, int M>
__host__ __device__ __forceinline__ void fft_fwd_bfly(FFT_LAS float* buf, int B, int j) {
    constexpr int S = M / R;
    float xr[R], xi[R];
#pragma unroll
    for (int q = 0; q < R; ++q) { const f32x2 v = *(const FFT_LAS f32x2*)(buf + 2 * fphys(B + j + q * S)); xr[q] = v.x; xi[q] = v.y; }
    fft_reg<R, false>(xr, xi);
    if (S > 1) { float c1, s1; ftw(j, M, c1, s1); float wr = c1, wi = -s1;
#pragma unroll
        for (int r = 1; r < R; ++r) { const int ix = fbrev<R>(r); const float tr = xr[ix] * wr - xi[ix] * wi, ti = xr[ix] * wi + xi[ix] * wr; xr[ix] = tr; xi[ix] = ti;
            const float nr = wr * c1 + wi * s1, ni = wi * c1 - wr * s1; wr = nr; wi = ni; } }
    int j2 = B + j; FFT_OPAQUE(j2);
#pragma unroll
    for (int r = 0; r < R; ++r) { const int ix = fbrev<R>(r); *(FFT_LAS f32x2*)(buf + 2 * fphys(j2 + r * S)) = (f32x2){xr[ix], xi[ix]}; }
}
template <int R, int M>
__host__ __device__ __forceinline__ void fft_inv_bfly(FFT_LAS float* buf, int B, int j) {
    constexpr int S = M / R;
    float xr[R], xi[R];
    if (S > 1) { float c1, s1; ftw(j, M, c1, s1); float wr = 1.0f, wi = 0.0f;
#pragma unroll
        for (int g = 0; g < R; g += 8) {
#pragma unroll
            for (int r = g; r < g + 8; ++r) { const f32x2 v = *(const FFT_LAS f32x2*)(buf + 2 * fphys(B + j + r * S)); xr[r] = v.x; xi[r] = v.y; }
#pragma unroll
            for (int r = g; r < g + 8; ++r) { const float tr = xr[r] * wr - xi[r] * wi, ti = xr[r] * wi + xi[r] * wr; xr[r] = tr; xi[r] = ti;
                const float nr = wr * c1 - wi * s1, ni = wi * c1 + wr * s1; wr = nr; wi = ni; }
#if defined(__HIP_DEVICE_COMPILE__)
            __builtin_amdgcn_sched_barrier(0);
#endif
        } }
    else {
#pragma unroll
        for (int r = 0; r < R; ++r) { const f32x2 v = *(const FFT_LAS f32x2*)(buf + 2 * fphys(B + j + r * S)); xr[r] = v.x; xi[r] = v.y; } }
    fft_reg<R, true>(xr, xi);
    int j2 = B + j; FFT_OPAQUE(j2);
#pragma unroll
    for (int q = 0; q < R; ++q) { const int ix = fbrev<R>(q); *(FFT_LAS f32x2*)(buf + 2 * fphys(j2 + q * S)) = (f32x2){xr[ix], xi[ix]}; }
}
__host__ __device__ __forceinline__ void fft_fwd_pass(FFT_LAS float* buf, int pass, int tid) {
    FFT_OPAQUE(tid);
    if (pass == 0) fft_fwd_bfly<32, 16384>(buf, 0, tid);
    else if (pass == 1) fft_fwd_bfly<32, 512>(buf, (tid >> 4) * 512, tid & 15);
    else { fft_fwd_bfly<16, 16>(buf, tid * 16, 0); fft_fwd_bfly<16, 16>(buf, (tid + 512) * 16, 0); }
}
__host__ __device__ __forceinline__ void fft_inv_pass(FFT_LAS float* buf, int pass, int tid) {
    FFT_OPAQUE(tid);
    if (pass == 0) { fft_inv_bfly<16, 16>(buf, tid * 16, 0); fft_inv_bfly<16, 16>(buf, (tid + 512) * 16, 0); }
    else if (pass == 1) fft_inv_bfly<32, 512>(buf, (tid >> 4) * 512, tid & 15);
    else fft_inv_bfly<32, 16384>(buf, 0, tid);
}
__host__ __device__ __forceinline__ int fpos(int k) { return ((k & 31) << 9) | (((k >> 5) & 31) << 4) | (k >> 10); }
__host__ __device__ __forceinline__ void fft_grab_spectrum(const FFT_LAS float* buf, int tid, float (&kr)[33], float (&ki)[33]) {
    FFT_OPAQUE(tid);
#pragma unroll
    for (int m = 0; m < 16; ++m) { const int k = tid + 512 * m, k2 = (FN - k) & (FN - 1);
        const f32x2 a = *(const FFT_LAS f32x2*)(buf + 2 * fphys(fpos(k))), b = *(const FFT_LAS f32x2*)(buf + 2 * fphys(fpos(k2)));
        kr[2 * m] = a.x; ki[2 * m] = a.y; kr[2 * m + 1] = b.x; ki[2 * m + 1] = b.y; }
    const f32x2 h = *(const FFT_LAS f32x2*)(buf + 2 * fphys(fpos(FN / 2))); kr[32] = h.x; ki[32] = h.y;
}
__host__ __device__ __forceinline__ void fft_mul_one(FFT_LAS float* buf, int k, float cr, float ci, float dr_, float di_, float wc, float ws) {
    const int k2 = (FN - k) & (FN - 1);
    FFT_LAS f32x2* pa = (FFT_LAS f32x2*)(buf + 2 * fphys(fpos(k))); FFT_LAS f32x2* pb = (FFT_LAS f32x2*)(buf + 2 * fphys(fpos(k2)));
    const f32x2 A = *pa, Bm = *pb;
    const float ar = A.x, ai = A.y, br = Bm.x, bi = -Bm.y, dr = dr_, di = -di_;
    const float uer = 0.5f * (ar + br), uei = 0.5f * (ai + bi), uor = 0.5f * (ai - bi), uoi = -0.5f * (ar - br);
    const float ker = 0.5f * (cr + dr), kei = 0.5f * (ci + di), kor = 0.5f * (ci - di), koi = -0.5f * (cr - dr);
    const float pr = uor * kor - uoi * koi, pi = uor * koi + uoi * kor;
    const float yer = (uer * ker - uei * kei) + (pr * wc + pi * ws), yei = (uer * kei + uei * ker) + (pi * wc - pr * ws);
    const float yor = (uer * kor - uei * koi) + (uor * ker - uoi * kei), yoi = (uer * koi + uei * kor) + (uor * kei + uoi * ker);
    *pa = (f32x2){yer - yoi, yei + yor};
    *pb = (f32x2){yer + yoi, -yei + yor};
}
__host__ __device__ __forceinline__ void fft_multiply(FFT_LAS float* buf, int tid, const float (&kr)[33], const float (&ki)[33]) {
    FFT_OPAQUE(tid);
    float c1, s1; ftw(tid, FN, c1, s1);
#pragma unroll
    for (int m = 0; m < 16; ++m) { const float cm = fcos32(m), sm = fsin32(m); const float wc = c1 * cm - s1 * sm, ws = s1 * cm + c1 * sm;
        fft_mul_one(buf, tid + 512 * m, kr[2 * m], ki[2 * m], kr[2 * m + 1], ki[2 * m + 1], wc, ws); }
    if (tid == 0) fft_mul_one(buf, FN / 2, kr[32], ki[32], kr[32], ki[32], -1.0f, 0.0f);
}

__device__ __forceinline__ void p4_fft_job(Frame& F, int job) {
    const float* const* in = F.in;
    int tid_ = F.tid, lane_ = F.lane; FFT_OPAQUE(tid_); FFT_OPAQUE(lane_);
    const int tid = tid_, lane = lane_, wave = F.wave, c0 = job * 4;
    LAS float* buf = (LAS float*)F.lds;
    LAS float* scr = (LAS float*)(F.lds + FFTSCR_OFF);
    float* hfT = (float*)(F.ws + WS_KF); float* hbT = (float*)(F.ws + WS_KB); const float* uT = (const float*)(F.ws + WS_UIN);
    {
        const bf16* hd = (const bf16*)(F.ws + WS_HDN);
        const int n = lane & 15, kq = lane >> 4, ch = (n >> 1) & 3, dir = n & 1, col = dir * 1024 + c0 + ch; const bool valid = n < 8;
        bf16x8 bfr[2];
#pragma unroll
        for (int ks = 0; ks < 2; ++ks) { unsigned w[4];
#pragma unroll
            for (int j = 0; j < 4; ++j) { const int k = ks * 32 + kq * 8 + 2 * j; const float a = valid ? in[IN_FW3][(size_t)k * 2048 + col] : 0.f, b = valid ? in[IN_FW3][(size_t)(k + 1) * 2048 + col] : 0.f; w[j] = cvt_pk_bf16(a, b); }
            bfr[ks] = __builtin_bit_cast(bf16x8, (v4u){w[0], w[1], w[2], w[3]}); }
        const float b3 = valid ? in[IN_FB3][col] : 0.f;
        const float r_slow = 3.0701134573253945f, r_fast = 15.350567286626972f;
        const float rate = r_slow + (float)(c0 + ch) * ((r_fast - r_slow) / 1023.0f);
        float asum = 0.f; float* dst = (dir ? hbT : hfT) + (size_t)(c0 + ch) * L;
        for (int tile = wave; tile < L / 16; tile += NWAVES) {
            const int t0 = tile * 16;
            const bf16x8 a0 = *(const bf16x8*)(hd + (size_t)(t0 + n) * 64 + kq * 8), a1 = *(const bf16x8*)(hd + (size_t)(t0 + n) * 64 + 32 + kq * 8);
            f32x4 acc = (f32x4){b3, b3, b3, b3};
            acc = __builtin_amdgcn_mfma_f32_16x16x32_bf16(a0, bfr[0], acc, 0, 0, 0);
            acc = __builtin_amdgcn_mfma_f32_16x16x32_bf16(a1, bfr[1], acc, 0, 0, 0);
            if (valid) { f32x4 o;
#pragma unroll
                for (int r = 0; r < 4; ++r) { const int t = t0 + 4 * kq + r; const float t01 = (float)t / (float)(L - 1); const float v = acc[r] * __expf(-t01 * rate); o[r] = v; if (!(dir && t == 0)) asum += fabsf(v); }
                *(f32x4*)(dst + t0 + 4 * kq) = o; }
        }
        asum += __shfl_xor(asum, 16); asum += __shfl_xor(asum, 32);
        if (lane < 8) scr[wave * 8 + lane] = asum;
        VM_WAIT(); __syncthreads();
        float tot = 0.f;
        if (tid < 4) { for (int w = 0; w < 8; ++w) tot += scr[w * 8 + 2 * tid] + scr[w * 8 + 2 * tid + 1]; }
        __syncthreads();
        if (tid < 4) scr[tid] = 1.0f / (tot * (float)FN);
        __syncthreads();
    }
#pragma unroll 1
    for (int ch = 0; ch < 4; ++ch) {
        const int c = c0 + ch;
        const float* hf = hfT + (size_t)c * L; const float* hb = hbT + (size_t)c * L; const float* uc = uT + (size_t)c * L;
#pragma unroll 1
        for (int a = tid; a < FN; a += NT) { float ke, ko;
            if (a < FN / 2) { const f32x2 v = *(const f32x2*)(hf + 2 * a); ke = v.x; ko = v.y; }
            else if (a == FN / 2) { ke = 0.f; ko = hb[L - 1]; }
            else { ke = hb[2 * FN - 2 * a]; ko = hb[2 * FN - 2 * a - 1]; }
            *(LAS f32x2*)(buf + 2 * fphys(a)) = (f32x2){ke, ko}; }
        __syncthreads();
        fft_fwd_pass(buf, 0, tid); __syncthreads(); fft_fwd_pass(buf, 1, tid); __syncthreads(); fft_fwd_pass(buf, 2, tid); __syncthreads();
        {
            int tq = tid; FFT_OPAQUE(tq);
            f32x2* sa = (f32x2*)(hfT + (size_t)c * L); f32x2* sb = (f32x2*)(hbT + (size_t)c * L);
#pragma unroll 4
            for (int m = 0; m < 16; ++m) { const int k = tq + 512 * m, k2 = (FN - k) & (FN - 1);
                sa[m * 512 + tq] = *(const LAS f32x2*)(buf + 2 * fphys(fpos(k))); sb[m * 512 + tq] = *(const LAS f32x2*)(buf + 2 * fphys(fpos(k2))); }
            if (tid == 0) { const f32x2 h = *(const LAS f32x2*)(buf + 2 * fphys(fpos(FN / 2))); scr[8] = h.x; scr[9] = h.y; }
        }
        __syncthreads();
#pragma unroll 2
        for (int a = tid; a < FN; a += NT) { f32x2 v = (f32x2){0.f, 0.f}; if (a < FN / 2) v = *(const f32x2*)(uc + 2 * a); *(LAS f32x2*)(buf + 2 * fphys(a)) = v; }
        __syncthreads();
        fft_fwd_pass(buf, 0, tid); __syncthreads(); fft_fwd_pass(buf, 1, tid); __syncthreads(); fft_fwd_pass(buf, 2, tid); __syncthreads();
        {   int tq = tid; FFT_OPAQUE(tq);
            const f32x2* sa = (const f32x2*)(hfT + (size_t)c * L); const f32x2* sb = (const f32x2*)(hbT + (size_t)c * L);
            float c1, s1; ftw(tq, FN, c1, s1);
#pragma unroll 4
            for (int m = 0; m < 16; ++m) { const float cm = fcos32(m), sm = fsin32(m); const float wc = c1 * cm - s1 * sm, ws = s1 * cm + c1 * sm;
                const f32x2 ka = sa[m * 512 + tq], kb = sb[m * 512 + tq];
                fft_mul_one(buf, tq + 512 * m, ka.x, ka.y, kb.x, kb.y, wc, ws); }
            if (tid == 0) fft_mul_one(buf, FN / 2, scr[8], scr[9], scr[8], scr[9], -1.0f, 0.0f);
        }
        VM_WAIT(); __syncthreads();
        fft_inv_pass(buf, 0, tid); __syncthreads(); fft_inv_pass(buf, 1, tid); __syncthreads(); fft_inv_pass(buf, 2, tid); __syncthreads();
        { const float sc = scr[ch]; float* yT = hfT + (size_t)c * L;
#pragma unroll 2
            for (int nn = tid; nn < FN / 2; nn += NT) { const f32x2 v = *(const LAS f32x2*)(buf + 2 * fphys(nn)); *(f32x2*)(yT + 2 * nn) = (f32x2){v.x * sc, v.y * sc}; } }
        __syncthreads();
    }
    VM_WAIT(); __syncthreads();
    {
        const bf16* z = (const bf16*)(F.ws + WS_Z); bf16* cat = (bf16*)(F.ws + WS_CAT);
        float w0[4], w1[4], w2[4], bb[4], dsk[4];
#pragma unroll
        for (int q = 0; q < 4; ++q) { w0[q] = in[IN_CHW][c0 + q]; w1[q] = in[IN_CHW][3072 + c0 + q]; w2[q] = in[IN_CHW][6144 + c0 + q]; bb[q] = in[IN_CHB][c0 + q]; dsk[q] = in[IN_DSKIP][c0 + q]; }
#pragma unroll 1
        for (int t = tid; t < L; t += NT) {
            const v2u zc = *(const v2u*)(z + (size_t)t * NINP + OFF_HY + c0);
            const v2u zp = t > 0 ? *(const v2u*)(z + (size_t)(t - 1) * NINP + OFF_HY + c0) : (v2u){0u, 0u};
            const v2u zn = t < L - 1 ? *(const v2u*)(z + (size_t)(t + 1) * NINP + OFF_HY + c0) : (v2u){0u, 0u};
            const float pv[4] = {bflo(zp.x), bfhi(zp.x), bflo(zp.y), bfhi(zp.y)}, cv[4] = {bflo(zc.x), bfhi(zc.x), bflo(zc.y), bfhi(zc.y)}, nv[4] = {bflo(zn.x), bfhi(zn.x), bflo(zn.y), bfhi(zn.y)};
            float o[4];
#pragma unroll
            for (int q = 0; q < 4; ++q) { const float y = hfT[(size_t)(c0 + q) * L + t] + dsk[q] * uT[(size_t)(c0 + q) * L + t];
                o[q] = (pv[q] * w0[q] + cv[q] * w1[q] + nv[q] * w2[q] + bb[q]) * y; }
            v2u w; w.x = cvt_pk_bf16(o[0], o[1]); w.y = cvt_pk_bf16(o[2], o[3]);
            *(v2u*)(cat + (size_t)t * D + MVW + c0) = w;
        }
    }
    __syncthreads();
}
__device__ __forceinline__ void p4_combine_rows(Frame& F) {
    const float* const* in = F.in;
    const int gw = F.bid * NWAVES + F.wave, NGW = F.G * NWAVES, c0 = F.lane * 16;
    const bf16* hf = (const bf16*)(F.ws + WS_HF); const bf16* hb = (const bf16*)(F.ws + WS_HB); const bf16* z = (const bf16*)(F.ws + WS_Z); bf16* cat = (bf16*)(F.ws + WS_CAT);
    for (int t = gw; t < L; t += NGW) {
        float h[16]; float ss = 0.f;
#pragma unroll
        for (int q = 0; q < 2; ++q) { const v4u a = *(const v4u*)(hf + (size_t)t * MVW + c0 + 8 * q), b = *(const v4u*)(hb + (size_t)t * MVW + c0 + 8 * q);
            h[8 * q + 0] = bflo(a.x) + bflo(b.x); h[8 * q + 1] = bfhi(a.x) + bfhi(b.x); h[8 * q + 2] = bflo(a.y) + bflo(b.y); h[8 * q + 3] = bfhi(a.y) + bfhi(b.y);
            h[8 * q + 4] = bflo(a.z) + bflo(b.z); h[8 * q + 5] = bfhi(a.z) + bfhi(b.z); h[8 * q + 6] = bflo(a.w) + bflo(b.w); h[8 * q + 7] = bfhi(a.w) + bfhi(b.w); }
#pragma unroll
        for (int i = 0; i < 16; ++i) ss += h[i] * h[i];
        ss += __shfl_xor(ss, 1); ss += __shfl_xor(ss, 2); ss += __shfl_xor(ss, 4);
        const float rstd = rsqrtf(ss * (1.0f / 128.0f) + EPS);
        float o[16];
#pragma unroll
        for (int q = 0; q < 2; ++q) { const v4u zo = *(const v4u*)(z + (size_t)t * NINP + OFF_O + c0 + 8 * q);
            const unsigned zz[4] = {zo.x, zo.y, zo.z, zo.w};
#pragma unroll
            for (int k = 0; k < 4; ++k) { const int i = 8 * q + 2 * k;
                o[i] = h[i] * rstd * in[IN_GHEAD][c0 + i] * sigmoid_f(bflo(zz[k])); o[i + 1] = h[i + 1] * rstd * in[IN_GHEAD][c0 + i + 1] * sigmoid_f(bfhi(zz[k])); } }
#pragma unroll
        for (int q = 0; q < 2; ++q) { v4u w; w.x = cvt_pk_bf16(o[8 * q], o[8 * q + 1]); w.y = cvt_pk_bf16(o[8 * q + 2], o[8 * q + 3]); w.z = cvt_pk_bf16(o[8 * q + 4], o[8 * q + 5]); w.w = cvt_pk_bf16(o[8 * q + 6], o[8 * q + 7]);
            *(v4u*)(cat + (size_t)t * D + c0 + 8 * q) = w; }
    }
}

__device__ __forceinline__ void p6_norm2_router(Frame& F) {
    const float* const* in = F.in;
    const float* mod = (const float*)(F.ws + WS_MOD);
    bf16* h2 = (bf16*)(F.ws + WS_HA);
    int* cnt = (int*)(F.ws + WS_CTL) + CW_CNT;
    int* aexp = (int*)(F.ws + WS_AEXP); int* arank = (int*)(F.ws + WS_ARANK); float* aw = (float*)(F.ws + WS_AW);
    LAS float* hrow = (LAS float*)F.lds + F.wave * 2048;
    LAS float* wch = (LAS float*)(F.lds + 65536);
    const int lane = F.lane;
    for (int t0 = F.bid * 8; t0 < L; t0 += F.G * 8) {
        const int t = t0 + F.wave;
        {
            f32x4 v[8]; float ss = 0.f;
#pragma unroll
            for (int j = 0; j < 8; ++j) { const int col = 4 * lane + 256 * j; v[j] = *(const f32x4*)(F.out + (size_t)t * D + col); ss += (v[j].x * v[j].x + v[j].y * v[j].y) + (v[j].z * v[j].z + v[j].w * v[j].w); }
            const float rstd = rsqrtf(wave_sum(ss) * (1.0f / D) + EPS);
#pragma unroll
            for (int j = 0; j < 8; ++j) { const int col = 4 * lane + 256 * j;
                const f32x4 g = *(const f32x4*)(in[IN_GFFN] + col), sh = *(const f32x4*)(mod + 6144 + col), sc = *(const f32x4*)(mod + 8192 + col);
                const f32x4 h = (v[j] * rstd * g) * (sc + 1.0f) + sh;
                *(LAS f32x4*)(hrow + col) = h;
                v2u o; o.x = cvt_pk_bf16(h.x, h.y); o.y = cvt_pk_bf16(h.z, h.w);
                *(v2u*)(h2 + (size_t)t * D + col) = o; }
        }
        float logit = 0.f;
        for (int ch = 0; ch < 8; ++ch) {
            __syncthreads();
            for (int i = F.tid; i < 4096; i += NT) *(LAS f32x4*)(wch + 4 * i) = *(const f32x4*)(in[IN_WR] + (size_t)ch * 16384 + 4 * i);
            __syncthreads();
            const LAS float* hr = hrow + ch * 256;
#pragma unroll 4
            for (int i = 0; i < 256; i += 4) { const f32x4 hv = *(const LAS f32x4*)(hr + i);
                logit += hv.x * wch[(i + 0) * 64 + lane]; logit += hv.y * wch[(i + 1) * 64 + lane]; logit += hv.z * wch[(i + 2) * 64 + lane]; logit += hv.w * wch[(i + 3) * 64 + lane]; }
        }
        const float s = 1.0f / (1.0f + expf(-logit)), sel = s + in[IN_BR][lane];
        const int grp = lane >> 3;
        float m1 = sel; m1 = fmaxf(m1, __shfl_xor(m1, 1)); m1 = fmaxf(m1, __shfl_xor(m1, 2)); m1 = fmaxf(m1, __shfl_xor(m1, 4));
        const unsigned long long gm = 0xFFull << (8 * grp);
        const unsigned long long b1 = __ballot(sel == m1) & gm;
        const int first = __ffsll((long long)b1) - 1;
        float m2 = (lane == first) ? -INFINITY : sel; m2 = fmaxf(m2, __shfl_xor(m2, 1)); m2 = fmaxf(m2, __shfl_xor(m2, 2)); m2 = fmaxf(m2, __shfl_xor(m2, 4));
        const float gs = m1 + m2;
        int grank = 0;
#pragma unroll
        for (int g = 0; g < 8; ++g) { const float og = __shfl(gs, 8 * g); grank += (og > gs || (og == gs && g < grp)) ? 1 : 0; }
        const float masked = grank < 4 ? sel : -INFINITY;
        int rank = 0;
        for (int e2 = 0; e2 < 64; ++e2) { const float om = __shfl(masked, e2); rank += (om > masked || (om == masked && e2 < lane)) ? 1 : 0; }
        const bool chosen = rank < 8;
        const float wsum = wave_sum(chosen ? s : 0.f);
        const unsigned long long cb = __ballot(chosen);
        if (chosen) {
            const int k = __popcll(cb & ((1ull << lane) - 1ull));
            const int half = t >= HALF_T ? 1 : 0;
            const int r = atomicAdd(cnt + half * 64 + lane, 1);
            aexp[t * 8 + k] = lane; arank[t * 8 + k] = r; aw[t * 8 + k] = s / wsum * 2.5f;
        }
    }
    __syncthreads();
}
__device__ __forceinline__ void build_pstart(Frame& F) {
    LAS int* ps = (LAS int*)(F.lds + LDSCTL_OFF);
    const int* cnt = (const int*)(F.ws + WS_CTL) + CW_CNT;
    __syncthreads();
    if (F.tid < 2) { int a = 0;
        for (int e = 0; e < NE; ++e) { ps[F.tid * 66 + e] = a; a += (__hip_atomic_load(cnt + F.tid * 64 + e, __ATOMIC_RELAXED, __HIP_MEMORY_SCOPE_AGENT) + 255) & ~255; }
        ps[F.tid * 66 + 64] = a; ps[F.tid * 66 + 65] = a + HALF_T; }
    __syncthreads();
}
__device__ __forceinline__ void p7_fill_rows(Frame& F) {
    build_pstart(F);
    const LAS int* ps = (const LAS int*)(F.lds + LDSCTL_OFF);
    const int* aexp = (const int*)(F.ws + WS_AEXP); const int* arank = (const int*)(F.ws + WS_ARANK); const float* aw = (const float*)(F.ws + WS_AW);
    int* rt = (int*)(F.ws + WS_RTOK); float* rw = (float*)(F.ws + WS_RW);
    const int gt = F.bid * NT + F.tid, NGT = F.G * NT;
    for (int i = gt; i < L * 8; i += NGT) { const int t = i >> 3, h = t >= HALF_T ? 1 : 0; const int row = ps[h * 66 + aexp[i]] + arank[i];
        rt[h * MAXROWS + row] = t; rw[h * MAXROWS + row] = aw[i]; }
    for (int t = gt; t < L; t += NGT) { const int h = t >= HALF_T ? 1 : 0; const int row = ps[h * 66 + 64] + (t - h * HALF_T);
        rt[h * MAXROWS + row] = t; rw[h * MAXROWS + row] = 1.0f; }
}
__device__ __forceinline__ void moe_combine(Frame& F, int half) {
    const float* const* in = F.in;
    const LAS int* ps = (const LAS int*)(F.lds + LDSCTL_OFF) + half * 66;
    const float* mod = (const float*)(F.ws + WS_MOD);
    const int* aexp = (const int*)(F.ws + WS_AEXP); const int* arank = (const int*)(F.ws + WS_ARANK);
    const bf16* Y2 = (const bf16*)(F.ws + WS_Y2);
    const int gw = F.bid * NWAVES + F.wave, NGW = F.G * NWAVES, lane = F.lane;
    for (int tt = gw; tt < HALF_T; tt += NGW) {
        const int t = half * HALF_T + tt;
        float a[32];
#pragma unroll
        for (int i = 0; i < 32; ++i) a[i] = 0.f;
#pragma unroll 1
        for (int k = 0; k < 9; ++k) {
            const int row = k < 8 ? ps[aexp[t * 8 + k]] + arank[t * 8 + k] : ps[64] + tt;
            const bf16* yr = Y2 + (size_t)row * D + 8 * lane;
#pragma unroll
            for (int j = 0; j < 4; ++j) { const v4u y = *(const v4u*)(yr + 512 * j);
                a[8 * j + 0] += bflo(y.x); a[8 * j + 1] += bfhi(y.x); a[8 * j + 2] += bflo(y.y); a[8 * j + 3] += bfhi(y.y);
                a[8 * j + 4] += bflo(y.z); a[8 * j + 5] += bfhi(y.z); a[8 * j + 6] += bflo(y.w); a[8 * j + 7] += bfhi(y.w); }
        }
        float ss = 0.f;
#pragma unroll
        for (int j = 0; j < 4; ++j)
#pragma unroll
            for (int q = 0; q < 2; ++q) { const int col = 8 * lane + 512 * j + 4 * q;
                const f32x4 x1 = *(const f32x4*)(F.out + (size_t)t * D + col), g2 = *(const f32x4*)(mod + 10240 + col);
                const int i = 8 * j + 4 * q;
                a[i] = x1.x + g2.x * a[i]; a[i + 1] = x1.y + g2.y * a[i + 1]; a[i + 2] = x1.z + g2.z * a[i + 2]; a[i + 3] = x1.w + g2.w * a[i + 3];
                ss += (a[i] * a[i] + a[i + 1] * a[i + 1]) + (a[i + 2] * a[i + 2] + a[i + 3] * a[i + 3]); }
        const float rstd = rsqrtf(wave_sum(ss) * (1.0f / D) + EPS);
#pragma unroll
        for (int j = 0; j < 4; ++j)
#pragma unroll
            for (int q = 0; q < 2; ++q) { const int col = 8 * lane + 512 * j + 4 * q; const int i = 8 * j + 4 * q;
                const f32x4 gf = *(const f32x4*)(in[IN_GFIN] + col);
                *(f32x4*)(F.out + (size_t)t * D + col) = (f32x4){a[i] * rstd * gf.x, a[i + 1] * rstd * gf.y, a[i + 2] * rstd * gf.z, a[i + 3] * rstd * gf.w}; }
    }
}

constexpr int N_PHASES = 13;
__global__ void __launch_bounds__(NT, 2) fwd_kernel(Args args) {
    extern __shared__ __attribute__((aligned(16))) unsigned char lds_raw[];
    Frame F;
    F.lds = (LAS unsigned char*)lds_raw;
    F.tid = threadIdx.x; F.lane = F.tid & 63; F.wave = __builtin_amdgcn_readfirstlane(F.tid >> 6);
    F.bid = blockIdx.x; F.G = gridDim.x;
    F.in = args.in; F.out = args.out; F.ws = args.ws;
    volatile LAS unsigned* MISC = (volatile LAS unsigned*)(F.lds + LDSCTL_OFF + 768);
    if (F.tid < 64) ((LAS unsigned*)(F.lds + LDSCTL_OFF))[F.tid + 192] = 0u;
    __syncthreads();
    unsigned* ctl = (unsigned*)(F.ws + WS_CTL);
    const int lo = args.ph_lo, hi = args.ph_hi;
    XcdBarrier bar; bar.bar = ctl + CW_BAR; bar.x = 0; bar.st = nullptr;
    if (hi - lo > 1) bar = xcd_barrier_post(ctl + CW_BAR, MISC + 8);
#ifndef PH_MASK
#define PH_MASK 0xFFFF
#endif
#define IN(k) (((PH_MASK >> (k)) & 1) && lo <= (k) && (k) < hi)
#define SEAM(k) do { if (IN(k) && IN((k) + 1)) xcd_barrier(bar); } while (0)
    LAS int* ps = (LAS int*)(F.lds + LDSCTL_OFF);

    if (IN(0)) { p0_prologue(F); } SEAM(0);
    if (IN(1)) { p1_norm1(F); } SEAM(1);
    if (IN(2)) {
        gk::DenseOrder S; S.init(MROWS, NINP, D, F.G, F.bid); S.Bt = (const char*)(F.ws + WS_WIN);
        gk::EpiBf16Store E{(bf16*)(F.ws + WS_Z), NINP};
        gk::gemm_core(F.lds, (const char*)(F.ws + WS_HA), D, S, E);
    } SEAM(2);
    if (IN(3)) {
        if (F.bid < 16) { for (int job = F.bid; job < 16; job += F.G) p3_scan_job(F, job); }
        else { const int b2 = F.bid - 16, nb2 = F.G - 16;
            for (int tile = b2; tile < 256; tile += nb2) p3_filter_tile(F, tile);
            for (int tile = b2; tile < 1024; tile += nb2) p3_uin_tile(F, tile); }
    } SEAM(3);
    if (IN(4)) {
        for (int job = F.bid; job < 256; job += F.G) p4_fft_job(F, job);
        p4_combine_rows(F);
    } SEAM(4);
    if (IN(5)) {
        gk::DenseOrder S; S.init(L, D, D, F.G, F.bid); S.Bt = (const char*)(F.ws + WS_WOUT);
        gk::EpiResidual E{F.out, D, (const float*)(F.ws + WS_MOD) + 4096};
        gk::gemm_core(F.lds, (const char*)(F.ws + WS_CAT), D, S, E);
    } SEAM(5);
    if (IN(6)) { p6_norm2_router(F); } SEAM(6);
    if (IN(7)) { p7_fill_rows(F); } SEAM(7);
#define MOE_GU(h) do { build_pstart(F); \
        gk::GroupOrder<4, true> S; S.ntile = ps[(h) * 66 + 65] >> 8; S.G = F.G; S.c = F.bid; S.K = D; S.pstart = ps + (h) * 66; S.rtok = (const int*)(F.ws + WS_RTOK) + (h) * MAXROWS; \
        S.Bt = (const char*)(F.ws + WS_W13); S.bstride = (size_t)1024 * D * 2; \
        gk::EpiGateUp E{(bf16*)(F.ws + WS_HR)}; \
        gk::gemm_core(F.lds, (const char*)(F.ws + WS_HA), D, S, E); } while (0)
#define MOE_DN(h) do { build_pstart(F); \
        gk::GroupOrder<8, false> S; S.ntile = ps[(h) * 66 + 65] >> 8; S.G = F.G; S.c = F.bid; S.K = DE; S.pstart = ps + (h) * 66; S.rtok = nullptr; \
        S.Bt = (const char*)(F.ws + WS_W2); S.bstride = (size_t)D * DE * 2; \
        gk::EpiDown E{(bf16*)(F.ws + WS_Y2), (const float*)(F.ws + WS_RW) + (h) * MAXROWS}; \
        gk::gemm_core(F.lds, (const char*)(F.ws + WS_HR), DE, S, E); } while (0)
    if (IN(8)) { MOE_GU(0); } SEAM(8);
    if (IN(9)) { MOE_DN(0); } SEAM(9);
    if (IN(10)) { MOE_GU(1); moe_combine(F, 0); } SEAM(10);
    if (IN(11)) { MOE_DN(1); } SEAM(11);
    if (IN(12)) { build_pstart(F); moe_combine(F, 1); }
#undef IN
#undef SEAM
}

extern "C" void kernel_launch(void* const* d_in, const int* in_sizes, int n_in, void* d_out, int out_size, void* d_ws, size_t ws_size, hipStream_t stream) {
    static int grid = 0;
    if (grid == 0) {
        if (n_in != 36 || out_size != L * D || ws_size < WS_END) { fprintf(stderr, "kernel_launch: unexpected shapes: n_in %d out %d ws %zu (need %zu)\n", n_in, out_size, ws_size, (size_t)WS_END); grid = -1; return; }
        int dev = 0, cus = 0, per_cu = 0;
        if (hipGetDevice(&dev) != hipSuccess || hipDeviceGetAttribute(&cus, hipDeviceAttributeMultiprocessorCount, dev) != hipSuccess) { grid = -1; return; }
        if (hipFuncSetAttribute((const void*)fwd_kernel, hipFuncAttributeMaxDynamicSharedMemorySize, LDS_BYTES) != hipSuccess) { fprintf(stderr, "kernel_launch: hipFuncSetAttribute failed\n"); grid = -1; return; }
        if (hipOccupancyMaxActiveBlocksPerMultiprocessor(&per_cu, (const void*)fwd_kernel, NT, LDS_BYTES) != hipSuccess || per_cu < 1) fprintf(stderr, "kernel_launch: occupancy query says %d\n", per_cu);
        (void)hipGetLastError();
        grid = cus;
    }
    if (grid < 0) return;
    if (hipMemsetAsync((char*)d_ws + WS_CTL, 0, CTL_ZERO_BYTES, stream) != hipSuccess) return;
    Args a{};
    for (int i = 0; i < 36; ++i) a.in[i] = (const float*)d_in[i];
    a.out = (float*)d_out; a.ws = (unsigned char*)d_ws;
    const int stop = MK_STOP_AFTER < N_PHASES ? MK_STOP_AFTER + 1 : N_PHASES;
#if MK_N_LAUNCHES == 1
    a.ph_lo = 0; a.ph_hi = stop;
    hipLaunchKernelGGL(fwd_kernel, dim3(grid), dim3(NT), LDS_BYTES, stream, a);
#else
    for (int p = 0; p < stop; ++p) { a.ph_lo = p; a.ph_hi = p + 1; hipLaunchKernelGGL(fwd_kernel, dim3(grid), dim3(NT), LDS_BYTES, stream, a); }
#endif
}
```

```cpp
#include <hip/hip_runtime.h>
#include <cstdio>
#include <cstdint>

#ifndef MK_N_LAUNCHES
#define MK_N_LAUNCHES 1
#endif
#ifndef MK_STOP_AFTER
#define MK_STOP_AFTER 99
#endif

#define GAS __attribute__((address_space(1)))
#define LAS __attribute__((address_space(3)))
typedef unsigned short bf16;
typedef unsigned v4u __attribute__((ext_vector_type(4)));
typedef unsigned v2u __attribute__((ext_vector_type(2)));
typedef float f32x4 __attribute__((ext_vector_type(4)));
typedef float f32x2 __attribute__((ext_vector_type(2)));
typedef short bf16x8 __attribute__((ext_vector_type(8)));
#define LDS_WAIT() asm volatile("s_waitcnt lgkmcnt(0)" ::: "memory")
#define VM_WAIT() asm volatile("s_waitcnt vmcnt(0)" ::: "memory")

constexpr int NWAVES = 8, NT = NWAVES * 64;
constexpr int L = 16384, D = 2048, LC = 256, MROWS = L + LC;
constexpr int NIN = 6176, NINP = 6400;
constexpr int OFF_K = 0, OFF_V = 512, OFF_G = 1536, OFF_Q = 1568, OFF_O = 2080, OFF_HY = 3104;
constexpr int NH = 8, HYW = 1024, MVW = 1024;
constexpr int NE = 64, NE1 = 65, DE = 512;
constexpr int HALF_T = 8192;
constexpr int MAXROWS = 90112;
constexpr float EPS = 1e-6f;

constexpr size_t MiB = 1u << 20;
constexpr size_t WS_CTL = 0, CTL_ZERO_BYTES = 256 * 1024;
constexpr size_t WS_MOD = 1 * MiB;
constexpr size_t WS_POS = WS_MOD + 128 * 1024;
constexpr size_t WS_WIN = 3 * MiB;
constexpr size_t WS_WOUT = 28 * MiB;
constexpr size_t WS_W13 = 36 * MiB;
constexpr size_t WS_W2 = 296 * MiB;
constexpr size_t WS_HA = 426 * MiB;
constexpr size_t WS_Z = 491 * MiB;
constexpr size_t WS_CAT = 695 * MiB;
constexpr size_t WS_UIN = 759 * MiB;
constexpr size_t WS_KF = 823 * MiB;
constexpr size_t WS_KB = 887 * MiB;
constexpr size_t WS_CL = 426 * MiB;
constexpr size_t WS_CI = 951 * MiB;
constexpr size_t WS_Q = 983 * MiB;
constexpr size_t WS_K = 999 * MiB;
constexpr size_t WS_RTOK = 1015 * MiB;
constexpr size_t WS_RW = WS_RTOK + 2 * MAXROWS * 4;
constexpr size_t WS_AEXP = 1017 * MiB;
constexpr size_t WS_ARANK = WS_AEXP + 512 * 1024;
constexpr size_t WS_AW = WS_ARANK + 512 * 1024;
constexpr size_t WS_HDN = 1019 * MiB;
constexpr size_t WS_SC = 1021 * MiB;
constexpr size_t WS_NL = WS_SC + 32 * 1024;
constexpr size_t WS_NI = WS_NL + 640 * 1024;
constexpr size_t WS_MI = WS_NI + 640 * 1024;
constexpr size_t WS_END = 1023 * MiB;
constexpr size_t WS_HR = 491 * MiB;
constexpr size_t WS_Y2 = 579 * MiB;
static_assert(WS_Y2 + (size_t)MAXROWS * 2048 * 2 <= WS_CI, "overlay");
constexpr int CW_BAR = 4096;
constexpr int CW_CNT = 16384;

constexpr int RING_BYTES = 131072;
constexpr int LDSCTL_OFF = 143360;
constexpr int FFTSCR_OFF = LDSCTL_OFF + 1024;
constexpr int LDS_BYTES = 147456;

__device__ __forceinline__ unsigned cvt_pk_bf16(float lo, float hi) { unsigned r; asm volatile("v_cvt_pk_bf16_f32 %0, %1, %2" : "=v"(r) : "v"(lo), "v"(hi)); return r; }
__device__ __forceinline__ float bf2f(unsigned short b) { return __builtin_bit_cast(float, ((unsigned)b) << 16); }
__device__ __forceinline__ float bflo(unsigned u) { return __builtin_bit_cast(float, u << 16); }
__device__ __forceinline__ float bfhi(unsigned u) { return __builtin_bit_cast(float, u & 0xffff0000u); }
__device__ __forceinline__ float wave_sum(float v) {
#pragma unroll
    for (int o = 1; o < 64; o <<= 1) v += __shfl_xor(v, o);
    return v;
}
__device__ __forceinline__ float silu_f(float a) { return a / (1.f + __expf(-a)); }
__device__ __forceinline__ float sigmoid_f(float a) { return 1.f / (1.f + __expf(-a)); }

#define XB_TMO      128
#define XB_XCNT(j)  (256  + 64 * (j))
#define XB_XSUB(j)  (1280 + 64 * (j))
#define XB_XGEN(j)  (2304 + 64 * (j))
#define XB_TOP      3328
#define XB_TOPGEN   3392
#define XCD_BAR_WORDS 3456
#define XB_SPIN_CAP (1u << 18)

__device__ __forceinline__ unsigned xb_ld(unsigned* p)              { return __hip_atomic_load(p, __ATOMIC_RELAXED, __HIP_MEMORY_SCOPE_AGENT); }
__device__ __forceinline__ unsigned xb_add(unsigned* p, unsigned v) { return __hip_atomic_fetch_add(p, v, __ATOMIC_RELAXED, __HIP_MEMORY_SCOPE_AGENT); }
__device__ __forceinline__ unsigned xb_xcc_id() { return (unsigned)__builtin_amdgcn_s_getreg((3 << 11) | 20) & 0xFu; }
#define XB_SPIN(cond, bar) do { unsigned _sp = 0; while (cond) { __builtin_amdgcn_s_sleep(1); \
    if ((++_sp & 255u) == 0u) { if (xb_ld(&(bar)[XB_TMO])) break; if (_sp > XB_SPIN_CAP) { atomicAdd(&(bar)[XB_TMO], 1u); break; } } } } while (0)

struct XcdBarrier {
    unsigned* bar; unsigned x;
    volatile LAS unsigned* st;
};

__device__ __forceinline__ XcdBarrier xcd_barrier_post(unsigned* bar, volatile LAS unsigned* st) {
    XcdBarrier b; b.bar = bar; b.x = xb_xcc_id(); b.st = st;
    if (threadIdx.x == 0) (void)xb_add(&bar[XB_XCNT(b.x)], 1u);
    return b;
}
__device__ __forceinline__ void xcd_barrier_complete(unsigned* bar, unsigned x, unsigned& nloc, unsigned& nx) {
    const unsigned G = gridDim.x * gridDim.y * gridDim.z;
    unsigned sum, cnt, mine, sp = 0u;
    for (;;) {
        sum = 0u; cnt = 0u; mine = 0u;
#pragma unroll
        for (unsigned j = 0; j < 16; ++j) { const unsigned c = xb_ld(&bar[XB_XCNT(j)]); sum += c; cnt += (c > 0u) ? 1u : 0u; mine = (j == x) ? c : mine; }
        if (sum == G) break;
        __builtin_amdgcn_s_sleep(1);
        if ((++sp & 255u) == 0u) { if (xb_ld(&bar[XB_TMO])) break; if (sp > XB_SPIN_CAP) { atomicAdd(&bar[XB_TMO], 1u); break; } }
    }
    nloc = mine > 0u ? mine : 1u; nx = cnt > 0u ? cnt : 1u;
}

__device__ __forceinline__ void xcd_barrier(const XcdBarrier& b) {
    asm volatile("s_waitcnt vmcnt(0)" ::: "memory");
    __syncthreads();
    if (threadIdx.x == 0) {
        unsigned* bar = b.bar;
        __builtin_amdgcn_s_waitcnt(0);
        unsigned nloc = b.st[0], nx = b.st[1];
        if (nloc == 0u) { xcd_barrier_complete(bar, b.x, nloc, nx); b.st[0] = nloc; b.st[1] = nx; }
        const unsigned old = xb_add(&bar[XB_XSUB(b.x)], 1u);
        const unsigned gen = old / nloc;
        if (old + 1u == (gen + 1u) * nloc) {
            __builtin_amdgcn_fence(__ATOMIC_RELEASE, "agent");
            asm volatile("s_waitcnt vmcnt(0)" ::: "memory");
            const unsigned og = xb_add(&bar[XB_TOP], 1u);
            const unsigned tg = og / nx;
            if (og + 1u == (tg + 1u) * nx) xb_add(&bar[XB_TOPGEN], 1u);
            else XB_SPIN(xb_ld(&bar[XB_TOPGEN]) == tg, bar);
            __builtin_amdgcn_fence(__ATOMIC_ACQUIRE, "agent");
            xb_add(&bar[XB_XGEN(b.x)], 1u);
            asm volatile("s_waitcnt vmcnt(0)" ::: "memory");
        } else {
            XB_SPIN(xb_ld(&bar[XB_XGEN(b.x)]) == gen, bar);
            __builtin_amdgcn_fence(__ATOMIC_ACQUIRE, "agent");
            asm volatile("s_waitcnt vmcnt(0)" ::: "memory");
        }
    }
    __syncthreads();
}

namespace gk {
constexpr int BM = 256, BK = 64, HALF = 128, HTB = HALF * BK * 2, STAGE_BYTES = 8 * HTB, NXCD = 8, WGM = 8;
__host__ __device__ __forceinline__ int lds_byte(int r, int c) { const int st = (r >> 4) * 2 + (c >> 5), rr = r & 15, cc = c & 31, ob = rr * 64 + cc * 2; return st * 1024 + (ob ^ (((ob >> 9) & 1) << 5)); }
__host__ __device__ __forceinline__ void stage_rc(int b, int& R, int& C) { const int st = b / 1024, sb = b % 1024, swz = sb ^ (((sb >> 9) & 1) << 5); R = (st >> 1) * 16 + swz / 64; C = (st & 1) * 32 + (swz % 64) / 2; }
__host__ __device__ __forceinline__ int perm32(int rho) { const int n = rho >> 4, i = rho & 15; return 8 * (i >> 2) + 4 * n + (i & 3); }

struct Unit { int pm, pn, ex; };

template <class Epi, class Sched>
__device__ __forceinline__ void gemm_core(LAS unsigned char* lds, const char* Abase, const int K, const Sched& S, const Epi& E) {
    const int tid = threadIdx.x, wid = __builtin_amdgcn_readfirstlane(tid >> 6), lane = tid & 63, wr = wid >> 2, wc = wid & 3, fr = lane & 15, fq = lane >> 4;
    const int nt = K / BK;
    int RA[2], CA[2]; unsigned voffB[2];
#pragma unroll
    for (int i = 0; i < 2; ++i) { int R, C; stage_rc(tid * 16 + i * 8192, R, C); const int Rb = Epi::PERM ? ((R & ~31) + perm32(R & 31)) : R;
        RA[i] = R; CA[i] = C; voffB[i] = (unsigned)(Rb * K + C) * 2u; }
    const size_t kstep = (size_t)(BK * 2);
    const size_t hstepB = (size_t)HALF * K * 2;
    const unsigned ldsw = (unsigned)wid * 1024u;
    const int aoff = lds_byte(wr * 64 + fr, fq * 8), boff = lds_byte(wc * 32 + fr, fq * 8);
#define GK_SA(b, h) (((b) * 2 + (h)) * HTB)
#define GK_SB(b, h) ((4 + (b) * 2 + (h)) * HTB)
#define GK_STAGE(bufoff, gbase, v0, v1) do { \
        __builtin_amdgcn_global_load_lds((const unsigned*)((const char*)(gbase) + (v0)), (LAS unsigned*)(lds + (bufoff) + ldsw), 16, 0, 0); \
        __builtin_amdgcn_global_load_lds((const unsigned*)((const char*)(gbase) + (v1)), (LAS unsigned*)(lds + (bufoff) + ldsw + 8192), 16, 0, 0); } while (0)
#define GK_LDA(dst, b, h) do { _Pragma("unroll") for (int m = 0; m < 4; ++m) _Pragma("unroll") for (int k = 0; k < 2; ++k) dst[m][k] = *(const LAS bf16x8*)(lds + GK_SA(b, h) + aoff + m * 2048 + k * 1024); } while (0)
#define GK_LDB(dst, b, h) do { _Pragma("unroll") for (int n = 0; n < 2; ++n) _Pragma("unroll") for (int k = 0; k < 2; ++k) dst[n][k] = *(const LAS bf16x8*)(lds + GK_SB(b, h) + boff + n * 2048 + k * 1024); } while (0)
#define GK_MMA(ai, bj, At, Bt) do { __builtin_amdgcn_s_setprio(1); _Pragma("unroll") for (int m = 0; m < 4; ++m) _Pragma("unroll") for (int n = 0; n < 2; ++n) _Pragma("unroll") for (int k = 0; k < 2; ++k) \
        acc[ai][bj][m][n] = __builtin_amdgcn_mfma_f32_16x16x32_bf16(Bt[n][k], At[m][k], acc[ai][bj][m][n], 0, 0, 0); __builtin_amdgcn_s_setprio(0); } while (0)
#define GK_WAIT_V(n) asm volatile("s_waitcnt vmcnt(" #n ")" ::: "memory")
#define GK_WAIT_L(n) asm volatile("s_waitcnt lgkmcnt(" #n ")" ::: "memory")
#define GK_BAR __builtin_amdgcn_s_barrier()
#define GK_SCHED __builtin_amdgcn_sched_barrier(0)
    Unit cur, nxt; int ui = 0;
    if (!S.next(0, cur)) return;
    f32x4 acc[2][2][4][2];
#pragma unroll
    for (int a = 0; a < 2; ++a)
#pragma unroll
        for (int b = 0; b < 2; ++b)
#pragma unroll
            for (int m = 0; m < 4; ++m)
#pragma unroll
                for (int n = 0; n < 2; ++n) acc[a][b][m][n] = (f32x4){0.f, 0.f, 0.f, 0.f};
    bf16x8 At[4][2], B0[2][2], B1[2][2];
    unsigned c00, c01, c10, c11, n00, n01, n10, n11;
    S.a_offs(cur, RA, CA, c00, c01, c10, c11);
    asm volatile("" : "+v"(c00), "+v"(c01), "+v"(c10), "+v"(c11));
    const char* cB = S.b_base(cur);
    GK_STAGE(GK_SB(0, 0), cB, voffB[0], voffB[1]); GK_STAGE(GK_SB(0, 1), cB + hstepB, voffB[0], voffB[1]); GK_STAGE(GK_SA(0, 0), Abase, c00, c01); GK_STAGE(GK_SA(0, 1), Abase, c10, c11);
    if (wr == 1) GK_BAR;
    GK_WAIT_V(2); GK_BAR;
    GK_STAGE(GK_SB(1, 0), cB + kstep, voffB[0], voffB[1]); GK_STAGE(GK_SA(1, 0), Abase + kstep, c00, c01); GK_STAGE(GK_SB(1, 1), cB + hstepB + kstep, voffB[0], voffB[1]);
    GK_WAIT_V(6); GK_BAR;
    for (;;) {
        const bool has_next = S.next(ui + 1, nxt);
        const char* nB = cB;
        n00 = c00; n01 = c01; n10 = c10; n11 = c11;
        if (has_next) { S.a_offs(nxt, RA, CA, n00, n01, n10, n11); nB = S.b_base(nxt); }
        asm volatile("" : "+v"(n00), "+v"(n01), "+v"(n10), "+v"(n11));
        for (int t = 0; t < nt; t += 2) {
            const bool last = (t == nt - 2);
            const char* a1 = Abase + (size_t)(t + 1) * kstep;
            const char* a2 = last ? Abase : Abase + (size_t)(t + 2) * kstep; const char* b2 = last ? nB : cB + (size_t)(t + 2) * kstep;
            const char* a3 = a2 + kstep; const char* b3 = b2 + kstep;
            const unsigned x00 = last ? n00 : c00, x01 = last ? n01 : c01, x10 = last ? n10 : c10, x11 = last ? n11 : c11;
            GK_LDB(B0, 0, 0); GK_LDB(B1, 0, 1); GK_SCHED; GK_LDA(At, 0, 0); GK_STAGE(GK_SA(1, 1), a1, c10, c11);
            GK_WAIT_V(8); GK_WAIT_L(0); GK_BAR; GK_MMA(0, 0, At, B0); GK_MMA(0, 1, At, B1); GK_BAR; GK_SCHED;
            GK_LDA(At, 0, 1); GK_STAGE(GK_SB(0, 0), b2, voffB[0], voffB[1]); GK_STAGE(GK_SB(0, 1), b2 + hstepB, voffB[0], voffB[1]); GK_STAGE(GK_SA(0, 0), a2, x00, x01);
            GK_WAIT_V(8); GK_WAIT_L(0); GK_BAR; GK_MMA(1, 0, At, B0); GK_MMA(1, 1, At, B1); GK_BAR; GK_SCHED;
            GK_LDB(B0, 1, 0); GK_LDB(B1, 1, 1); GK_SCHED; GK_LDA(At, 1, 0); GK_STAGE(GK_SA(0, 1), a2, x10, x11);
            GK_WAIT_V(8); GK_WAIT_L(0); GK_BAR; GK_MMA(0, 0, At, B0); GK_MMA(0, 1, At, B1); GK_BAR; GK_SCHED;
            GK_LDA(At, 1, 1); GK_STAGE(GK_SB(1, 0), b3, voffB[0], voffB[1]); GK_STAGE(GK_SB(1, 1), b3 + hstepB, voffB[0], voffB[1]); GK_STAGE(GK_SA(1, 0), a3, x00, x01);
            GK_WAIT_V(8); GK_WAIT_L(0); GK_BAR; GK_MMA(1, 0, At, B0); GK_MMA(1, 1, At, B1); GK_BAR; GK_SCHED;
        }
        if (wr == 0) GK_BAR;
        E(acc, cur, wr, wc, fr, fq);
        if (!has_next) break;
#pragma unroll
        for (int a = 0; a < 2; ++a)
#pragma unroll
            for (int b = 0; b < 2; ++b)
#pragma unroll
                for (int m = 0; m < 4; ++m)
#pragma unroll
                    for (int n = 0; n < 2; ++n) acc[a][b][m][n] = (f32x4){0.f, 0.f, 0.f, 0.f};
        cur = nxt; cB = nB; c00 = n00; c01 = n01; c10 = n10; c11 = n11; ++ui;
        if (wr == 1) GK_BAR;
    }
    GK_WAIT_V(0);
    GK_BAR;
#undef GK_SA
#undef GK_SB
#undef GK_STAGE
#undef GK_LDA
#undef GK_LDB
#undef GK_MMA
#undef GK_WAIT_V
#undef GK_WAIT_L
#undef GK_BAR
#undef GK_SCHED
}

struct DenseOrder {
    int nM, nN, nwg, G, c, K;
    __device__ void init(int M, int N, int K_, int G_, int c_) { nM = M / BM; nN = N / BM; nwg = nM * nN; G = G_; c = c_; K = K_; }
    __device__ __forceinline__ bool next(int i, Unit& u) const {
        const long Lx = (long)i * G + c; if (Lx >= nwg) return false;
        int wgid = (int)Lx; { const int q = nwg / NXCD, r = nwg % NXCD, xcd = wgid % NXCD, off = wgid / NXCD; wgid = (xcd < r ? xcd * (q + 1) : r * (q + 1) + (xcd - r) * q) + off; }
        const int nig = WGM * nN, gid = wgid / nig, fm = gid * WGM, gsz = (nM - fm) < WGM ? (nM - fm) : WGM;
        u.pm = fm + ((wgid % nig) % gsz); u.pn = (wgid % nig) / gsz; u.ex = 0; return true;
    }
    const char* Bt;
    __device__ __forceinline__ void a_offs(const Unit& u, const int (&RA)[2], const int (&CA)[2], unsigned& o00, unsigned& o01, unsigned& o10, unsigned& o11) const {
        const unsigned r0 = (unsigned)(u.pm * BM);
        o00 = ((r0 + RA[0]) * (unsigned)K + CA[0]) * 2u; o01 = ((r0 + RA[1]) * (unsigned)K + CA[1]) * 2u;
        o10 = ((r0 + HALF + RA[0]) * (unsigned)K + CA[0]) * 2u; o11 = ((r0 + HALF + RA[1]) * (unsigned)K + CA[1]) * 2u;
    }
    __device__ __forceinline__ const char* b_base(const Unit& u) const { return Bt + (size_t)u.pn * BM * K * 2; }
};
template <int NPN, bool GATHER>
struct GroupOrder {
    int ntile, G, c, K;
    const LAS int* pstart;
    const int* rtok;
    const char* Bt; size_t bstride;
    __device__ __forceinline__ bool next(int i, Unit& u) const {
        const long Lx = (long)i * G + c; if (Lx >= (long)ntile * NPN) return false;
        u.pm = (int)(Lx / NPN); u.pn = (int)(Lx % NPN);
        const int row = u.pm * BM; int lo = 0, hi = NE1;
        while (hi - lo > 1) { const int mid = (lo + hi) >> 1; if (pstart[mid] <= row) lo = mid; else hi = mid; }
        u.ex = lo; return true;
    }
    __device__ __forceinline__ void a_offs(const Unit& u, const int (&RA)[2], const int (&CA)[2], unsigned& o00, unsigned& o01, unsigned& o10, unsigned& o11) const {
        const int r0 = u.pm * BM;
        if (GATHER) {
            const int t00 = rtok[r0 + RA[0]], t01 = rtok[r0 + RA[1]], t10 = rtok[r0 + HALF + RA[0]], t11 = rtok[r0 + HALF + RA[1]];
            o00 = ((unsigned)t00 * (unsigned)K + CA[0]) * 2u; o01 = ((unsigned)t01 * (unsigned)K + CA[1]) * 2u;
            o10 = ((unsigned)t10 * (unsigned)K + CA[0]) * 2u; o11 = ((unsigned)t11 * (unsigned)K + CA[1]) * 2u;
        } else {
            o00 = ((unsigned)(r0 + RA[0]) * (unsigned)K + CA[0]) * 2u; o01 = ((unsigned)(r0 + RA[1]) * (unsigned)K + CA[1]) * 2u;
            o10 = ((unsigned)(r0 + HALF + RA[0]) * (unsigned)K + CA[0]) * 2u; o11 = ((unsigned)(r0 + HALF + RA[1]) * (unsigned)K + CA[1]) * 2u;
        }
    }
    __device__ __forceinline__ const char* b_base(const Unit& u) const { return Bt + (size_t)u.ex * bstride + (size_t)u.pn * BM * K * 2; }
};

struct EpiBf16Store {
    static constexpr bool PERM = true;
    bf16* O; int ldc;
    __device__ __forceinline__ void operator()(const f32x4 (&acc)[2][2][4][2], const Unit& u, int wr, int wc, int fr, int fq) const {
        const int row0 = u.pm * BM + wr * 64 + fr, col0 = u.pn * BM + wc * 32 + 8 * fq;
#pragma unroll
        for (int ai = 0; ai < 2; ++ai)
#pragma unroll
            for (int m = 0; m < 4; ++m) { bf16* rowp = O + (size_t)(row0 + ai * HALF + m * 16) * ldc + col0;
#pragma unroll
                for (int bj = 0; bj < 2; ++bj) { const f32x4 v0 = acc[ai][bj][m][0], v1 = acc[ai][bj][m][1];
                    v4u w; w.x = cvt_pk_bf16(v0[0], v0[1]); w.y = cvt_pk_bf16(v0[2], v0[3]); w.z = cvt_pk_bf16(v1[0], v1[1]); w.w = cvt_pk_bf16(v1[2], v1[3]);
                    *(v4u*)(rowp + bj * HALF) = w; } }
    }
};
struct EpiResidual {
    static constexpr bool PERM = false;
    float* X; int ldc; const float* gate;
    __device__ __forceinline__ void operator()(const f32x4 (&acc)[2][2][4][2], const Unit& u, int wr, int wc, int fr, int fq) const {
        const int row0 = u.pm * BM + wr * 64 + fr, col0 = u.pn * BM + wc * 32 + 4 * fq;
        f32x4 gv[2][2];
#pragma unroll
        for (int bj = 0; bj < 2; ++bj)
#pragma unroll
            for (int n = 0; n < 2; ++n) gv[bj][n] = *(const f32x4*)(gate + col0 + bj * HALF + n * 16);
#pragma unroll
        for (int ai = 0; ai < 2; ++ai)
#pragma unroll
            for (int m = 0; m < 4; ++m) { float* rowp = X + (size_t)(row0 + ai * HALF + m * 16) * ldc + col0;
#pragma unroll
                for (int bj = 0; bj < 2; ++bj)
#pragma unroll
                    for (int n = 0; n < 2; ++n) { f32x4* p = (f32x4*)(rowp + bj * HALF + n * 16); *p = *p + gv[bj][n] * acc[ai][bj][m][n]; } }
    }
};
struct EpiGateUp {
    static constexpr bool PERM = true;
    bf16* O;
    __device__ __forceinline__ void operator()(const f32x4 (&acc)[2][2][4][2], const Unit& u, int wr, int wc, int fr, int fq) const {
        const int row0 = u.pm * BM + wr * 64 + fr, col0 = u.pn * HALF + wc * 32 + 8 * fq;
#pragma unroll
        for (int ai = 0; ai < 2; ++ai)
#pragma unroll
            for (int m = 0; m < 4; ++m) { bf16* rowp = O + (size_t)(row0 + ai * HALF + m * 16) * DE + col0;
                float h[8];
#pragma unroll
                for (int n = 0; n < 2; ++n)
#pragma unroll
                    for (int j = 0; j < 4; ++j) { const float g = acc[ai][0][m][n][j], up = acc[ai][1][m][n][j]; h[n * 4 + j] = silu_f(g) * up; }
                v4u w; w.x = cvt_pk_bf16(h[0], h[1]); w.y = cvt_pk_bf16(h[2], h[3]); w.z = cvt_pk_bf16(h[4], h[5]); w.w = cvt_pk_bf16(h[6], h[7]);
                *(v4u*)rowp = w; }
    }
};
struct EpiDown {
    static constexpr bool PERM = true;
    bf16* O; const float* rw;
    __device__ __forceinline__ void operator()(const f32x4 (&acc)[2][2][4][2], const Unit& u, int wr, int wc, int fr, int fq) const {
        const int row0 = u.pm * BM + wr * 64 + fr, col0 = u.pn * BM + wc * 32 + 8 * fq;
#pragma unroll
        for (int ai = 0; ai < 2; ++ai)
#pragma unroll
            for (int m = 0; m < 4; ++m) { const int row = row0 + ai * HALF + m * 16; const float s = rw[row]; bf16* rowp = O + (size_t)row * D + col0;
#pragma unroll
                for (int bj = 0; bj < 2; ++bj) { const f32x4 v0 = acc[ai][bj][m][0] * s, v1 = acc[ai][bj][m][1] * s;
                    v4u w; w.x = cvt_pk_bf16(v0[0], v0[1]); w.y = cvt_pk_bf16(v0[2], v0[3]); w.z = cvt_pk_bf16(v1[0], v1[1]); w.w = cvt_pk_bf16(v1[2], v1[3]);
                    *(v4u*)(rowp + bj * HALF) = w; } }
    }
};
}

struct Args { const float* in[36]; float* out; unsigned char* ws; int ph_lo, ph_hi; };
struct Frame {
    LAS unsigned char* lds;
    int tid, lane, wave, bid, G;
    const float* const* in; float* out; unsigned char* ws;
};
#define IN_X 0
#define IN_C 1
#define IN_CTX 2
#define IN_CCTX 3
#define IN_WADA 4
#define IN_BADA 5
#define IN_GMIX 6
#define IN_GFFN 7
#define IN_WIN 8
#define IN_BGATES 9
#define IN_CKW 10
#define IN_CKB 11
#define IN_CQW 12
#define IN_CQB 13
#define IN_GHEAD 14
#define IN_CHW 15
#define IN_CHB 16
#define IN_FW1 17
#define IN_FB1 18
#define IN_FF1 19
#define IN_FW2 20
#define IN_FB2 21
#define IN_FF2 22
#define IN_FW3 23
#define IN_FB3 24
#define IN_DSKIP 25
#define IN_WOUT 26
#define IN_WR 27
#define IN_BR 28
#define IN_W1E 29
#define IN_W3E 30
#define IN_W2E 31
#define IN_W1S 32
#define IN_W3S 33
#define IN_W2S 34
#define IN_GFIN 35

__device__ __forceinline__ void transpose_item(const float* W, int N, int k0, int n0, bf16* WT, int dstK, int dst_row0, LAS float* scr, int lane) {
#pragma unroll 8
    for (int i = 0; i < 32; ++i) { const int kk = 2 * i + (lane >> 5); scr[kk * 33 + (lane & 31)] = W[(size_t)(k0 + kk) * N + n0 + (lane & 31)]; }
    LDS_WAIT(); asm volatile("" ::: "memory");
    const int c = lane & 7;
#pragma unroll
    for (int j = 0; j < 4; ++j) { const int n = (lane >> 3) + 8 * j; const LAS float* s = scr + (8 * c) * 33 + n;
        v4u o; o.x = cvt_pk_bf16(s[0 * 33], s[1 * 33]); o.y = cvt_pk_bf16(s[2 * 33], s[3 * 33]); o.z = cvt_pk_bf16(s[4 * 33], s[5 * 33]); o.w = cvt_pk_bf16(s[6 * 33], s[7 * 33]);
        *(v4u*)(WT + (size_t)(dst_row0 + n) * dstK + k0 + 8 * c) = o; }
    LDS_WAIT(); asm volatile("" ::: "memory");
}
__device__ __forceinline__ void p0_prologue(Frame& F) {
    const float* const* in = F.in;
    {
        LAS float* sv = (LAS float*)F.lds;
        LAS float* red = sv + 4096;
        float* mod = (float*)(F.ws + WS_MOD);
        for (int job = F.bid; job < 192; job += F.G) {
            for (int i = F.tid; i < 2048; i += NT) { sv[i] = silu_f(in[IN_C][i]); sv[2048 + i] = silu_f(in[IN_CCTX][i]); }
            __syncthreads();
            const int col = job * 64 + F.lane, r0 = F.wave * 256;
            const float* W = in[IN_WADA] + col;
            float a0 = 0.f, a1 = 0.f;
            for (int i = r0; i < r0 + 256; i += 8) {
                float w[8];
#pragma unroll
                for (int j = 0; j < 8; ++j) w[j] = W[(size_t)(i + j) * 12288];
#pragma unroll
                for (int j = 0; j < 8; ++j) { a0 += sv[i + j] * w[j]; a1 += sv[2048 + i + j] * w[j]; }
            }
            red[(F.wave * 64 + F.lane) * 2 + 0] = a0; red[(F.wave * 64 + F.lane) * 2 + 1] = a1;
            __syncthreads();
            if (F.wave == 0) { float s0 = 0.f, s1 = 0.f;
#pragma unroll
                for (int w = 0; w < 8; ++w) { s0 += red[(w * 64 + F.lane) * 2 + 0]; s1 += red[(w * 64 + F.lane) * 2 + 1]; }
                const float b = in[IN_BADA][col]; mod[col] = s0 + b; mod[12288 + col] = s1 + b; }
            __syncthreads();
        }
    }
    const int gt = F.bid * NT + F.tid, NGT = F.G * NT;
    {
        float* pos = (float*)(F.ws + WS_POS);
        for (int i = gt; i < 320 * 1024; i += NGT) { const int p = i >> 10, j = i & 1023, jj = j & 511;
            const float pp = (float)(p < 256 ? p : p - 256);
            const float omega = 1.0f / powf(10000.0f, (float)jj * (1.0f / 512.0f)); const float ang = pp * omega;
            pos[i] = j < 512 ? sinf(ang) : cosf(ang); }
    }
    {
        v4u* z = (v4u*)(F.ws + WS_WIN + (size_t)NIN * D * 2); const int nz = (NINP - NIN) * D * 2 / 16;
        for (int i = gt; i < nz; i += NGT) z[i] = (v4u){0u, 0u, 0u, 0u};
        int* rt = (int*)(F.ws + WS_RTOK); float* rw = (float*)(F.ws + WS_RW);
        for (int i = gt; i < 2 * MAXROWS; i += NGT) { rt[i] = 0; rw[i] = 0.f; }
    }
    {
        LAS float* scr = (LAS float*)(F.lds + F.wave * 16384);
        const int gw = F.bid * NWAVES + F.wave, NGW = F.G * NWAVES;
        constexpr int I_IN = 32 * 193, I_OUT = 32 * 64, I_E = 512 * NE1;
        constexpr int NITEMS = I_IN + I_OUT + 3 * I_E;
        for (int it = gw; it < NITEMS; it += NGW) {
            int r = it;
            if (r < I_IN) { const int kb = r / 193, nb = r % 193; transpose_item(in[IN_WIN], NIN, 64 * kb, 32 * nb, (bf16*)(F.ws + WS_WIN), D, 32 * nb, scr, F.lane); continue; } r -= I_IN;
            if (r < I_OUT) { const int kb = r / 64, nb = r % 64; transpose_item(in[IN_WOUT], D, 64 * kb, 32 * nb, (bf16*)(F.ws + WS_WOUT), D, 32 * nb, scr, F.lane); continue; } r -= I_OUT;
            if (r < 2 * I_E) { const int which = r >= I_E; if (which) r -= I_E;
                const int e = r / 512, rr = r % 512, kb = rr / 16, nb = rr % 16, n0 = 32 * nb;
                const float* src = e < NE ? in[which ? IN_W3E : IN_W1E] + (size_t)e * D * DE : in[which ? IN_W3S : IN_W1S];
                transpose_item(src, DE, 64 * kb, n0, (bf16*)(F.ws + WS_W13) + (size_t)e * 1024 * D, D, (n0 >> 7) * 256 + which * 128 + (n0 & 127), scr, F.lane); continue; }
            r -= 2 * I_E;
            { const int e = r / 512, rr = r % 512, kb = rr / 64, nb = rr % 64;
                const float* src = e < NE ? in[IN_W2E] + (size_t)e * DE * D : in[IN_W2S];
                transpose_item(src, D, 64 * kb, 32 * nb, (bf16*)(F.ws + WS_W2) + (size_t)e * D * DE, DE, 32 * nb, scr, F.lane); }
        }
    }
}

__device__ __forceinline__ void p1_norm1(Frame& F) {
    const float* const* in = F.in;
    const int gw = F.bid * NWAVES + F.wave, NGW = F.G * NWAVES;
    const float* mod = (const float*)(F.ws + WS_MOD); const float* pos = (const float*)(F.ws + WS_POS);
    bf16* hA = (bf16*)(F.ws + WS_HA);
    for (int row = gw; row < MROWS; row += NGW) {
        f32x4 v[8]; float ss = 0.f;
        const bool mainrow = row < L;
        const float* src = mainrow ? in[IN_X] + (size_t)row * D : in[IN_CTX] + (size_t)(row - L) * D;
        const float* md = mainrow ? mod : mod + 12288;
#pragma unroll
        for (int j = 0; j < 8; ++j) { const int col = 4 * F.lane + 256 * j; v[j] = *(const f32x4*)(src + col);
            if (mainrow) { const float* pp = col < 1024 ? pos + (size_t)(row >> 6) * 1024 + col : pos + (size_t)(256 + (row & 63)) * 1024 + (col - 1024);
                v[j] = v[j] + *(const f32x4*)pp; *(f32x4*)(F.out + (size_t)row * D + col) = v[j]; }
            ss += (v[j].x * v[j].x + v[j].y * v[j].y) + (v[j].z * v[j].z + v[j].w * v[j].w); }
        const float rstd = rsqrtf(wave_sum(ss) * (1.0f / D) + EPS);
#pragma unroll
        for (int j = 0; j < 8; ++j) { const int col = 4 * F.lane + 256 * j;
            const f32x4 g = *(const f32x4*)(in[IN_GMIX] + col), sh = *(const f32x4*)(md + col), sc = *(const f32x4*)(md + 2048 + col);
            const f32x4 h = (v[j] * rstd * g) * (sc + 1.0f) + sh;
            v2u o; o.x = cvt_pk_bf16(h.x, h.y); o.y = cvt_pk_bf16(h.z, h.w);
            *(v2u*)(hA + (size_t)row * D + col) = o; }
    }
}

constexpr int VT_PITCH = 136;
__device__ __forceinline__ float wave_incl_add(float x, int lane) {
#pragma unroll
    for (int o = 1; o < 64; o <<= 1) { const float y = __shfl_up(x, o); if (lane >= o) x += y; }
    return x;
}
__device__ __forceinline__ float wave_incl_max(float x, int lane) {
#pragma unroll
    for (int o = 1; o < 64; o <<= 1) { const float y = __shfl_up(x, o); if (lane >= o) x = fmaxf(x, y); }
    return x;
}
__device__ __forceinline__ void ml_gates(Frame& F, int dir, int h, int rowbase, LAS float* bb, LAS float* al, LAS float* mx, float& g, float& mtot) {
    const bf16* z = (const bf16*)(F.ws + WS_Z);
    const int lane = F.lane, pi0 = 2 * lane, p0 = dir ? 127 - pi0 : pi0, p1 = dir ? p0 - 1 : p0 + 1;
    const float bgi = F.in[IN_BGATES][dir * 16 + h], bgf = F.in[IN_BGATES][dir * 16 + 8 + h];
    const bf16* z0 = z + (size_t)(rowbase + p0) * NINP + OFF_G + dir * 16 + h; const bf16* z1 = z + (size_t)(rowbase + p1) * NINP + OFF_G + dir * 16 + h;
    const float i0 = bf2f(z0[0]) + bgi, f0 = bf2f(z0[8]) + bgf, i1 = bf2f(z1[0]) + bgi, f1 = bf2f(z1[8]) + bgf;
    const float l0 = fminf(f0, 0.f) - log1pf(__expf(-fabsf(f0))), l1 = fminf(f1, 0.f) - log1pf(__expf(-fabsf(f1)));
    const float incl = wave_incl_add(l0 + l1, lane);
    const float b1 = incl, b0 = incl - l1;
    const float a0 = i0 - b0, a1 = i1 - b1;
    const float mi = wave_incl_max(fmaxf(a0, a1), lane);
    float mprev = __shfl_up(mi, 1); if (lane == 0) mprev = -INFINITY;
    const float M0 = fmaxf(mprev, a0), M1 = mi;
    bb[p0] = b0; bb[p1] = b1; al[p0] = a0; al[p1] = a1; mx[p0] = M0; mx[p1] = M1;
    g = __shfl(incl, 63); mtot = __shfl(mi, 63);
}
__device__ __forceinline__ void ml_stage_vT(Frame& F, int h, int rowbase, LAS bf16* vT) {
    const bf16* z = (const bf16*)(F.ws + WS_Z);
    const int s = F.tid >> 2, eg = F.tid & 3;
#pragma unroll
    for (int i = 0; i < 4; ++i) { const int e0 = 32 * eg + 8 * i; const v4u v = *(const v4u*)(z + (size_t)(rowbase + s) * NINP + OFF_V + h * 128 + e0);
        const unsigned w[4] = {v.x, v.y, v.z, v.w};
#pragma unroll
        for (int q = 0; q < 4; ++q) { vT[(e0 + 2 * q) * VT_PITCH + s] = (bf16)(w[q] & 0xffffu); vT[(e0 + 2 * q + 1) * VT_PITCH + s] = (bf16)(w[q] >> 16); } }
}
__device__ __forceinline__ void ml_prep_item(Frame& F, int item) {
    const float* const* in = F.in;
    const int n = item >> 3, h = item & 7, tid = F.tid, lane = F.lane, wave = F.wave;
    const bool isctx = n >= 128;
    const int rowbase = isctx ? L + 128 * (n - 128) : 128 * n, seqlo = isctx ? L : 0, seqhi = isctx ? L + LC - 1 : L - 1;
    LAS bf16* vT = (LAS bf16*)F.lds;
    LAS bf16* kw0 = vT + 128 * VT_PITCH;
    LAS bf16* kw1 = kw0 + 64 * VT_PITCH;
    LAS float* fs = (LAS float*)(kw1 + 64 * VT_PITCH);
    const bf16* z = (const bf16*)(F.ws + WS_Z);
    if (wave < 2) { float g, mtot; LAS float* bbp = fs + 256 + wave * 384; ml_gates(F, wave, h, rowbase, bbp, bbp + 128, bbp + 256, g, mtot);
        LDS_WAIT();
        fs[wave * 128 + 2 * lane] = __expf(bbp[128 + 2 * lane] - mtot); fs[wave * 128 + 2 * lane + 1] = __expf(bbp[128 + 2 * lane + 1] - mtot);
        if (lane == 0) { float* sc = (float*)(F.ws + WS_SC) + ((size_t)(wave * 8 + h) * 130 + n) * 2; sc[0] = g; sc[1] = g + mtot; } }
    ml_stage_vT(F, h, rowbase, vT);
    __syncthreads();
    {
        const int s = tid >> 2, d0 = (tid & 3) * 16, R = rowbase + s; const bool hp = R > seqlo, hn = R < seqhi;
        float kv[16], qv[16];
#pragma unroll
        for (int part = 0; part < 2; ++part) {
            const int zc = (part ? OFF_Q : OFF_K) + h * 64 + d0; const float* cw = in[part ? IN_CQW : IN_CKW] + h * 64 + d0; const float* cb = in[part ? IN_CQB : IN_CKB] + h * 64 + d0;
#pragma unroll
            for (int hv = 0; hv < 2; ++hv) {
                const v4u c = *(const v4u*)(z + (size_t)R * NINP + zc + 8 * hv);
                const v4u p = hp ? *(const v4u*)(z + (size_t)(R - 1) * NINP + zc + 8 * hv) : (v4u){0u, 0u, 0u, 0u};
                const v4u nx = hn ? *(const v4u*)(z + (size_t)(R + 1) * NINP + zc + 8 * hv) : (v4u){0u, 0u, 0u, 0u};
                const unsigned cc[4] = {c.x, c.y, c.z, c.w}, pp[4] = {p.x, p.y, p.z, p.w}, nn[4] = {nx.x, nx.y, nx.z, nx.w};
#pragma unroll
                for (int q = 0; q < 4; ++q) { const int d = 8 * hv + 2 * q;
                    const float v0 = silu_f(bflo(pp[q]) * cw[d] + bflo(cc[q]) * cw[512 + d] + bflo(nn[q]) * cw[1024 + d] + cb[d]);
                    const float v1 = silu_f(bfhi(pp[q]) * cw[d + 1] + bfhi(cc[q]) * cw[512 + d + 1] + bfhi(nn[q]) * cw[1024 + d + 1] + cb[d + 1]);
                    if (part) { qv[d] = v0 * 0.125f; qv[d + 1] = v1 * 0.125f; } else { kv[d] = v0; kv[d + 1] = v1; } }
            }
        }
        if (!isctx) {
            bf16* Qg = (bf16*)(F.ws + WS_Q) + ((size_t)h * L + R) * 64 + d0; bf16* Kg = (bf16*)(F.ws + WS_K) + ((size_t)h * L + R) * 64 + d0;
#pragma unroll
            for (int hv = 0; hv < 2; ++hv) { v4u w;
                w.x = cvt_pk_bf16(qv[8 * hv], qv[8 * hv + 1]); w.y = cvt_pk_bf16(qv[8 * hv + 2], qv[8 * hv + 3]); w.z = cvt_pk_bf16(qv[8 * hv + 4], qv[8 * hv + 5]); w.w = cvt_pk_bf16(qv[8 * hv + 6], qv[8 * hv + 7]); *(v4u*)(Qg + 8 * hv) = w;
                w.x = cvt_pk_bf16(kv[8 * hv], kv[8 * hv + 1]); w.y = cvt_pk_bf16(kv[8 * hv + 2], kv[8 * hv + 3]); w.z = cvt_pk_bf16(kv[8 * hv + 4], kv[8 * hv + 5]); w.w = cvt_pk_bf16(kv[8 * hv + 6], kv[8 * hv + 7]); *(v4u*)(Kg + 8 * hv) = w; }
        }
        const float w0 = fs[s], w1 = fs[128 + s];
#pragma unroll
        for (int d = 0; d < 16; ++d) { const float kr = bf2f((bf16)(cvt_pk_bf16(kv[d], 0.f) & 0xffffu));
            kw0[(d0 + d) * VT_PITCH + s] = (bf16)(cvt_pk_bf16(kr * w0, 0.f) & 0xffffu); kw1[(d0 + d) * VT_PITCH + s] = (bf16)(cvt_pk_bf16(kr * w1, 0.f) & 0xffffu); }
    }
    __syncthreads();
    {
        const int fr = lane & 15, fq = lane >> 4;
        bf16x8 a[4];
#pragma unroll
        for (int kk = 0; kk < 4; ++kk) a[kk] = *(const LAS bf16x8*)(vT + (16 * wave + fr) * VT_PITCH + 32 * kk + 8 * fq);
#pragma unroll
        for (int dir = 0; dir < 2; ++dir) { const LAS bf16* kw = dir ? kw1 : kw0;
            float* cl = (float*)(F.ws + WS_CL) + ((size_t)((dir * 8 + h) * 130 + n)) * 8192;
#pragma unroll
            for (int dt = 0; dt < 4; ++dt) { f32x4 acc = (f32x4){0.f, 0.f, 0.f, 0.f};
#pragma unroll
                for (int kk = 0; kk < 4; ++kk) { const bf16x8 b = *(const LAS bf16x8*)(kw + (16 * dt + fr) * VT_PITCH + 32 * kk + 8 * fq); acc = __builtin_amdgcn_mfma_f32_16x16x32_bf16(a[kk], b, acc, 0, 0, 0); }
#pragma unroll
                for (int r = 0; r < 4; ++r) cl[(16 * wave + 4 * fq + r) * 64 + 16 * dt + fr] = acc[r]; } }
        if (tid < 128) { const int dir = tid >> 6, d = tid & 63; const LAS bf16* kw = (dir ? kw1 : kw0) + d * VT_PITCH; float s = 0.f;
            for (int i = 0; i < 128; ++i) s += bf2f(kw[i]);
            ((float*)(F.ws + WS_NL))[((size_t)((dir * 8 + h) * 130 + n)) * 64 + d] = s; }
    }
    __syncthreads();
}
__device__ __forceinline__ int ml_order(int dir, int step) { return step < 2 ? (dir ? 129 - step : 128 + step) : (dir ? 129 - step : step - 2); }
__device__ __forceinline__ void ml_scan(Frame& F) {
    const float* CL = (const float*)(F.ws + WS_CL); const float* SC = (const float*)(F.ws + WS_SC); const float* NLp = (const float*)(F.ws + WS_NL);
    bf16* CI = (bf16*)(F.ws + WS_CI); float* NI = (float*)(F.ws + WS_NI); float* MI = (float*)(F.ws + WS_MI);
    for (int idx = F.bid * NT + F.tid; idx < 16 * 8192; idx += F.G * NT) {
        const int dh = idx >> 13, rem = idx & 8191, dir = dh >> 3; const bool don = rem < 64;
        float c = 0.f, nn = 0.f, m = 0.f;
        for (int s0 = 0; s0 < 130; s0 += 10) {
            float cl[10], nl[10], gg[10], ml[10];
#pragma unroll
            for (int i = 0; i < 10; ++i) { const int ch = ml_order(dir, s0 + i); cl[i] = CL[((size_t)(dh * 130 + ch)) * 8192 + rem]; gg[i] = SC[(dh * 130 + ch) * 2]; ml[i] = SC[(dh * 130 + ch) * 2 + 1];
                nl[i] = don ? NLp[(size_t)(dh * 130 + ch) * 64 + rem] : 0.f; }
#pragma unroll
            for (int i = 0; i < 10; ++i) { const int ch = ml_order(dir, s0 + i);
                if (ch < 128) { CI[((size_t)(dh * 128 + ch)) * 8192 + rem] = (bf16)(cvt_pk_bf16(c, 0.f) & 0xffffu); if (don) NI[(size_t)(dh * 128 + ch) * 64 + rem] = nn; if (rem == 0) MI[dh * 128 + ch] = m; }
                const float mn = fmaxf(gg[i] + m, ml[i]), sp = __expf(gg[i] + m - mn), sl = __expf(ml[i] - mn);
                c = sp * c + sl * cl[i]; nn = sp * nn + sl * nl[i]; m = mn; }
        }
    }
}
__device__ __forceinline__ void ml_out_item(Frame& F, int item) {
    const float* const* in = F.in;
    const int n = item >> 3, h = item & 7, tid = F.tid, lane = F.lane, wave = F.wave, fr = lane & 15, fq = lane >> 4;
    const int rowbase = 128 * n;
    LAS bf16* vT = (LAS bf16*)F.lds;
    LAS float* fs = (LAS float*)(vT + 128 * VT_PITCH);
    const bf16* z = (const bf16*)(F.ws + WS_Z);
    if (wave < 2) { float g, mtot; LAS float* bbp = fs + wave * 384; ml_gates(F, wave, h, rowbase, bbp, bbp + 128, bbp + 256, g, mtot);
        if (lane == 0) fs[768 + wave] = ((const float*)(F.ws + WS_MI))[(wave * 8 + h) * 128 + n]; }
    ml_stage_vT(F, h, rowbase, vT);
    __syncthreads();
    const bf16* Qg = (const bf16*)(F.ws + WS_Q) + ((size_t)h * L + rowbase) * 64; const bf16* Kg = (const bf16*)(F.ws + WS_K) + ((size_t)h * L + rowbase) * 64;
    const int tl = 16 * wave + fr;
    bf16x8 qf[2];
#pragma unroll
    for (int kk = 0; kk < 2; ++kk) qf[kk] = *(const bf16x8*)(Qg + (size_t)tl * 64 + 32 * kk + 8 * fq);
    f32x4 st[8];
#pragma unroll
    for (int j = 0; j < 8; ++j) { f32x4 acc = (f32x4){0.f, 0.f, 0.f, 0.f};
#pragma unroll
        for (int kk = 0; kk < 2; ++kk) { const bf16x8 kf = *(const bf16x8*)(Kg + (size_t)(16 * j + fr) * 64 + 32 * kk + 8 * fq); acc = __builtin_amdgcn_mfma_f32_16x16x32_bf16(kf, qf[kk], acc, 0, 0, 0); }
        st[j] = acc; }
    f32x4 hs[8];
#pragma unroll
    for (int et = 0; et < 8; ++et) hs[et] = (f32x4){0.f, 0.f, 0.f, 0.f};
#pragma unroll 1
    for (int dir = 0; dir < 2; ++dir) {
        const LAS float* bbp = fs + dir * 384; const LAS float* alp = bbp + 128; const LAS float* mxp = bbp + 256;
        const float m_in = fs[768 + dir];
        const float beta = fmaxf(m_in, mxp[tl]);
        const int dh = dir * 8 + h;
        bf16x8 pf[4]; float dsum = 0.f;
#pragma unroll
        for (int kk = 0; kk < 4; ++kk) { float pv[8];
#pragma unroll
            for (int hh = 0; hh < 2; ++hh)
#pragma unroll
                for (int r = 0; r < 4; ++r) { const int s = 32 * kk + 16 * hh + 4 * fq + r; const bool ok = dir ? (s >= tl) : (s <= tl);
                    const float e = __expf(fminf(alp[s] - beta, 0.f)); const float v = ok ? st[2 * kk + hh][r] * e : 0.f; pv[4 * hh + r] = v; dsum += v; }
            pf[kk] = __builtin_bit_cast(bf16x8, (v4u){cvt_pk_bf16(pv[0], pv[1]), cvt_pk_bf16(pv[2], pv[3]), cvt_pk_bf16(pv[4], pv[5]), cvt_pk_bf16(pv[6], pv[7])}); }
        dsum += __shfl_xor(dsum, 16); dsum += __shfl_xor(dsum, 32);
        const float* nip = (const float*)(F.ws + WS_NI) + (size_t)(dh * 128 + n) * 64; float qn = 0.f;
#pragma unroll
        for (int kk = 0; kk < 2; ++kk) { const v4u qq = __builtin_bit_cast(v4u, qf[kk]); const unsigned w[4] = {qq.x, qq.y, qq.z, qq.w};
#pragma unroll
            for (int q = 0; q < 4; ++q) { const int d = 32 * kk + 8 * fq + 2 * q; qn += bflo(w[q]) * nip[d] + bfhi(w[q]) * nip[d + 1]; } }
        qn += __shfl_xor(qn, 16); qn += __shfl_xor(qn, 32);
        const float sc_t = __expf(m_in - beta);
        const float den = dsum + sc_t * qn, dn = fmaxf(fabsf(den), __expf(-(bbp[tl] + beta)));
        LAS float* xinv = fs + 772 + (wave * 2 + dir) * 32;
        if (fq == 0) { xinv[fr] = 1.0f / dn; xinv[16 + fr] = sc_t; }
        LDS_WAIT();
        float inv_r[4], sc_r[4];
#pragma unroll
        for (int r = 0; r < 4; ++r) { inv_r[r] = xinv[4 * fq + r]; sc_r[r] = xinv[16 + 4 * fq + r]; }
        const bf16* cip = (const bf16*)(F.ws + WS_CI) + (size_t)(dh * 128 + n) * 8192;
#pragma unroll
        for (int et = 0; et < 8; ++et) {
            f32x4 acc = (f32x4){0.f, 0.f, 0.f, 0.f}, acci = (f32x4){0.f, 0.f, 0.f, 0.f};
#pragma unroll
            for (int kk = 0; kk < 4; ++kk) {
                const bool live = dir ? (2 * kk + 1 >= wave) : (2 * kk <= wave);
                if (live) { const LAS bf16* vr = vT + (16 * et + fr) * VT_PITCH + 32 * kk + 4 * fq;
                    const v2u lo = *(const LAS v2u*)vr, hi = *(const LAS v2u*)(vr + 16);
                    const bf16x8 vb = __builtin_bit_cast(bf16x8, (v4u){lo.x, lo.y, hi.x, hi.y});
                    acc = __builtin_amdgcn_mfma_f32_16x16x32_bf16(pf[kk], vb, acc, 0, 0, 0); } }
#pragma unroll
            for (int kk = 0; kk < 2; ++kk) { const bf16x8 cb = *(const bf16x8*)(cip + (size_t)(16 * et + fr) * 64 + 32 * kk + 8 * fq); acci = __builtin_amdgcn_mfma_f32_16x16x32_bf16(qf[kk], cb, acci, 0, 0, 0); }
#pragma unroll
            for (int r = 0; r < 4; ++r) hs[et][r] += (acc[r] + sc_r[r] * acci[r]) * inv_r[r];
        }
    }
    float rs[4];
#pragma unroll
    for (int r = 0; r < 4; ++r) { float ss = 0.f;
#pragma unroll
        for (int et = 0; et < 8; ++et) ss += hs[et][r] * hs[et][r];
        ss += __shfl_xor(ss, 1); ss += __shfl_xor(ss, 2); ss += __shfl_xor(ss, 4); ss += __shfl_xor(ss, 8);
        rs[r] = rsqrtf(ss * (1.0f / 128.0f) + EPS); }
    bf16* cat = (bf16*)(F.ws + WS_CAT);
#pragma unroll
    for (int et = 0; et < 8; ++et) { const int col = h * 128 + 16 * et + fr; const float gh = in[IN_GHEAD][col];
#pragma unroll
        for (int r = 0; r < 4; ++r) { const int t = rowbase + 16 * wave + 4 * fq + r;
            const float o = hs[et][r] * rs[r] * gh * sigmoid_f(bf2f(z[(size_t)t * NINP + OFF_O + col]));
            cat[(size_t)t * D + col] = (bf16)(cvt_pk_bf16(o, 0.f) & 0xffffu); } }
    __syncthreads();
}

__device__ __forceinline__ void p3_filter_tile(Frame& F, int tile) {
    const float* const* in = F.in;
    const int tid = F.tid;
    LAS float* feat = (LAS float*)F.lds;
    LAS float* h1 = feat + 64 * 36;
    LAS float* h2 = h1 + 64 * 65;
    LAS float* w1s = h2 + 64 * 64;
    LAS float* w2s = w1s + 33 * 64;
    for (int i = tid; i < 33 * 64; i += NT) w1s[i] = in[IN_FW1][i];
    for (int i = tid; i < 64 * 64; i += NT) w2s[i] = in[IN_FW2][i];
    {
        const int tt = tid >> 3, sub = tid & 7; const float t = (float)(tile * 64 + tt);
        const float w = (6.2831855f * t) / (float)L;
        if (sub == 0) feat[tt * 36] = t / (float)(L - 1);
#pragma unroll
        for (int q = 0; q < 2; ++q) { const int bi = sub * 2 + q; const float band = 1e-4f + (float)bi * ((15.0f - 1e-4f) / 15.0f); const float ang = w * band;
            feat[tt * 36 + 1 + bi] = cosf(ang); feat[tt * 36 + 17 + bi] = -sinf(ang); }
    }
    __syncthreads();
    {
        const int tt = tid >> 3, j0 = (tid & 7) * 8;
        float a[8];
#pragma unroll
        for (int q = 0; q < 8; ++q) a[q] = in[IN_FB1][j0 + q];
#pragma unroll 1
        for (int i = 0; i < 33; ++i) { const float f = feat[tt * 36 + i];
#pragma unroll
            for (int q = 0; q < 8; ++q) a[q] += f * w1s[i * 64 + j0 + q]; }
#pragma unroll
        for (int q = 0; q < 8; ++q) h1[tt * 65 + j0 + q] = sinf(in[IN_FF1][j0 + q] * a[q]);
    }
    __syncthreads();
    {
        const int tt = tid >> 3, j0 = (tid & 7) * 8;
        float a[8];
#pragma unroll
        for (int q = 0; q < 8; ++q) a[q] = in[IN_FB2][j0 + q];
#pragma unroll 1
        for (int i = 0; i < 64; ++i) { const float f = h1[tt * 65 + i];
#pragma unroll
            for (int q = 0; q < 8; ++q) a[q] += f * w2s[i * 64 + j0 + q]; }
#pragma unroll
        for (int q = 0; q < 8; ++q) h2[tt * 64 + j0 + q] = sinf(in[IN_FF2][j0 + q] * a[q]);
    }
    __syncthreads();
    {
        bf16* hd = (bf16*)(F.ws + WS_HDN);
        for (int i = tid; i < 64 * 32; i += NT) { const int tt = i >> 5, j = (i & 31) * 2; *(unsigned*)(hd + (size_t)(tile * 64 + tt) * 64 + j) = cvt_pk_bf16(h2[tt * 64 + j], h2[tt * 64 + j + 1]); }
    }
    __syncthreads();
}
__device__ __forceinline__ void p3_uin_tile(Frame& F, int tile) {
    const float* const* in = F.in;
    const bf16* z = (const bf16*)(F.ws + WS_Z); float* uT = (float*)(F.ws + WS_UIN);
    LAS float* tl = (LAS float*)F.lds;
    const int t0 = (tile >> 2) * 64, cb = (tile & 3) * 256;
    const int cg = F.tid & 31, c0 = cb + cg * 8, rsub = F.tid >> 5;
    for (int pass = 0; pass < 4; ++pass) {
        const int tt = pass * 16 + rsub, t = t0 + tt;
        float r1[8], r2[8];
#pragma unroll
        for (int part = 0; part < 2; ++part) {
            const int zc = OFF_HY + 1024 * (part + 1) + c0, wc = 1024 * (part + 1) + c0;
            const v4u cur = *(const v4u*)(z + (size_t)t * NINP + zc);
            const v4u prv = t > 0 ? *(const v4u*)(z + (size_t)(t - 1) * NINP + zc) : (v4u){0u, 0u, 0u, 0u};
            const v4u nxt = t < L - 1 ? *(const v4u*)(z + (size_t)(t + 1) * NINP + zc) : (v4u){0u, 0u, 0u, 0u};
            float* rr = part ? r2 : r1;
#pragma unroll
            for (int q = 0; q < 4; ++q) {
                const unsigned pc = q == 0 ? prv.x : q == 1 ? prv.y : q == 2 ? prv.z : prv.w, cc = q == 0 ? cur.x : q == 1 ? cur.y : q == 2 ? cur.z : cur.w, nc = q == 0 ? nxt.x : q == 1 ? nxt.y : q == 2 ? nxt.z : nxt.w;
                const int ch = wc + 2 * q;
                rr[2 * q] = bflo(pc) * in[IN_CHW][ch] + bflo(cc) * in[IN_CHW][3072 + ch] + bflo(nc) * in[IN_CHW][6144 + ch] + in[IN_CHB][ch];
                rr[2 * q + 1] = bfhi(pc) * in[IN_CHW][ch + 1] + bfhi(cc) * in[IN_CHW][3072 + ch + 1] + bfhi(nc) * in[IN_CHW][6144 + ch + 1] + in[IN_CHB][ch + 1];
            }
        }
#pragma unroll
        for (int q = 0; q < 8; ++q) tl[(cg * 8 + q) * 65 + tt] = r1[q] * r2[q];
    }
    __syncthreads();
    for (int i = F.tid; i < 256 * 16; i += NT) { const int c = i >> 4, tq = (i & 15) * 4; const LAS float* s = tl + c * 65 + tq;
        *(f32x4*)(uT + (size_t)(cb + c) * L + t0 + tq) = (f32x4){s[0], s[1], s[2], s[3]}; }
    __syncthreads();
}

#ifndef FFT_LAS
#define FFT_LAS LAS
#endif
#if defined(__HIP_DEVICE_COMPILE__)
#define FFT_OPAQUE(v) asm volatile("" : "+v"(v))
#else
#define FFT_OPAQUE(v)
#endif
constexpr int FN = 16384;
constexpr int FFT_SLOTS = 17920;
__host__ __device__ __forceinline__ int fphys(int p) { return p + (p >> 4) + ((p >> 9) << 4); }
__host__ __device__ __forceinline__ float fcos32(int k) {
    constexpr float T[16] = {1.0f, 0.98078528040323043f, 0.92387953251128674f, 0.83146961230254524f, 0.70710678118654752f, 0.55557023301960218f, 0.38268343236508977f, 0.19509032201612825f,
                             0.0f, -0.19509032201612825f, -0.38268343236508977f, -0.55557023301960218f, -0.70710678118654752f, -0.83146961230254524f, -0.92387953251128674f, -0.98078528040323043f};
    return T[k]; }
__host__ __device__ __forceinline__ float fsin32(int k) {
    constexpr float T[16] = {0.0f, 0.19509032201612825f, 0.38268343236508977f, 0.55557023301960218f, 0.70710678118654752f, 0.83146961230254524f, 0.92387953251128674f, 0.98078528040323043f,
                             1.0f, 0.98078528040323043f, 0.92387953251128674f, 0.83146961230254524f, 0.70710678118654752f, 0.55557023301960218f, 0.38268343236508977f, 0.19509032201612825f};
    return T[k]; }
template <int R> __host__ __device__ __forceinline__ constexpr int fbrev(int x) { int r = 0; for (int b = 1; b < R; b <<= 1) { r = (r << 1) | (x & 1); x >>= 1; } return r; }
template <int R, bool INV>
__host__ __device__ __forceinline__ void fft_reg(float (&xr)[R], float (&xi)[R]) {
#pragma unroll
    for (int len = R; len >= 2; len >>= 1) {
        const int half = len >> 1;
#pragma unroll
        for (int blk = 0; blk < R; blk += len)
#pragma unroll
            for (int k = 0; k < half; ++k) {
                const int i0 = blk + k, i1 = i0 + half;
                const float ar = xr[i0], ai = xi[i0], br = xr[i1], bi = xi[i1];
                xr[i0] = ar + br; xi[i0] = ai + bi;
                const float dr = ar - br, di = ai - bi;
                if (k == 0) { xr[i1] = dr; xi[i1] = di; }
                else if (4 * k == len) { if (!INV) { xr[i1] = di; xi[i1] = -dr; } else { xr[i1] = -di; xi[i1] = dr; } }
                else { const float c = fcos32(k * (32 / len)), s = fsin32(k * (32 / len));
                    if (!INV) { xr[i1] = dr * c + di * s; xi[i1] = di * c - dr * s; } else { xr[i1] = dr * c - di * s; xi[i1] = di * c + dr * s; } }
            }
    }
}
__host__ __device__ __forceinline__ void ftw(int num, int den, float& c, float& s) {
#if defined(__HIP_DEVICE_COMPILE__)
    sincospif(2.0f * (float)num / (float)den, &s, &c);
#else
    const double a = 6.283185307179586476925 * (double)num / (double)den; c = (float)cos(a); s = (float)sin(a);
#endif
}
template <int R, int M>
__host__ __device__ __forceinline__ void fft_fwd_bfly(FFT_LAS float* buf, int B, int j) {
    constexpr int S = M / R;
    float xr[R], xi[R];
#pragma unroll
    for (int q = 0; q < R; ++q) { const f32x2 v = *(const FFT_LAS f32x2*)(buf + 2 * fphys(B + j + q * S)); xr[q] = v.x; xi[q] = v.y; }
    fft_reg<R, false>(xr, xi);
    if (S > 1) { float c1, s1; ftw(j, M, c1, s1); float wr = c1, wi = -s1;
#pragma unroll
        for (int r = 1; r < R; ++r) { const int ix = fbrev<R>(r); const float tr = xr[ix] * wr - xi[ix] * wi, ti = xr[ix] * wi + xi[ix] * wr; xr[ix] = tr; xi[ix] = ti;
            const float nr = wr * c1 + wi * s1, ni = wi * c1 - wr * s1; wr = nr; wi = ni; } }
    int j2 = B + j; FFT_OPAQUE(j2);
#pragma unroll
    for (int r = 0; r < R; ++r) { const int ix = fbrev<R>(r); *(FFT_LAS f32x2*)(buf + 2 * fphys(j2 + r * S)) = (f32x2){xr[ix], xi[ix]}; }
}
template <int R, int M>
__host__ __device__ __forceinline__ void fft_inv_bfly(FFT_LAS float* buf, int B, int j) {
    constexpr int S = M / R;
    float xr[R], xi[R];
    if (S > 1) { float c1, s1; ftw(j, M, c1, s1); float wr = 1.0f, wi = 0.0f;
#pragma unroll
        for (int g = 0; g < R; g += 8) {
#pragma unroll
            for (int r = g; r < g + 8; ++r) { const f32x2 v = *(const FFT_LAS f32x2*)(buf + 2 * fphys(B + j + r * S)); xr[r] = v.x; xi[r] = v.y; }
#pragma unroll
            for (int r = g; r < g + 8; ++r) { const float tr = xr[r] * wr - xi[r] * wi, ti = xr[r] * wi + xi[r] * wr; xr[r] = tr; xi[r] = ti;
                const float nr = wr * c1 - wi * s1, ni = wi * c1 + wr * s1; wr = nr; wi = ni; }
#if defined(__HIP_DEVICE_COMPILE__)
            __builtin_amdgcn_sched_barrier(0);
#endif
        } }
    else {
#pragma unroll
        for (int r = 0; r < R; ++r) { const f32x2 v = *(const FFT_LAS f32x2*)(buf + 2 * fphys(B + j + r * S)); xr[r] = v.x; xi[r] = v.y; } }
    fft_reg<R, true>(xr, xi);
    int j2 = B + j; FFT_OPAQUE(j2);
#pragma unroll
    for (int q = 0; q < R; ++q) { const int ix = fbrev<R>(q); *(FFT_LAS f32x2*)(buf + 2 * fphys(j2 + q * S)) = (f32x2){xr[ix], xi[ix]}; }
}
__host__ __device__ __forceinline__ void fft_fwd_pass(FFT_LAS float* buf, int pass, int tid) {
    FFT_OPAQUE(tid);
    if (pass == 0) fft_fwd_bfly<32, 16384>(buf, 0, tid);
    else if (pass == 1) fft_fwd_bfly<32, 512>(buf, (tid >> 4) * 512, tid & 15);
    else { fft_fwd_bfly<16, 16>(buf, tid * 16, 0); fft_fwd_bfly<16, 16>(buf, (tid + 512) * 16, 0); }
}
__host__ __device__ __forceinline__ void fft_inv_pass(FFT_LAS float* buf, int pass, int tid) {
    FFT_OPAQUE(tid);
    if (pass == 0) { fft_inv_bfly<16, 16>(buf, tid * 16, 0); fft_inv_bfly<16, 16>(buf, (tid + 512) * 16, 0); }
    else if (pass == 1) fft_inv_bfly<32, 512>(buf, (tid >> 4) * 512, tid & 15);
    else fft_inv_bfly<32, 16384>(buf, 0, tid);
}
__host__ __device__ __forceinline__ int fpos(int k) { return ((k & 31) << 9) | (((k >> 5) & 31) << 4) | (k >> 10); }
__host__ __device__ __forceinline__ void fft_grab_spectrum(const FFT_LAS float* buf, int tid, float (&kr)[33], float (&ki)[33]) {
    FFT_OPAQUE(tid);
#pragma unroll
    for (int m = 0; m < 16; ++m) { const int k = tid + 512 * m, k2 = (FN - k) & (FN - 1);
        const f32x2 a = *(const FFT_LAS f32x2*)(buf + 2 * fphys(fpos(k))), b = *(const FFT_LAS f32x2*)(buf + 2 * fphys(fpos(k2)));
        kr[2 * m] = a.x; ki[2 * m] = a.y; kr[2 * m + 1] = b.x; ki[2 * m + 1] = b.y; }
    const f32x2 h = *(const FFT_LAS f32x2*)(buf + 2 * fphys(fpos(FN / 2))); kr[32] = h.x; ki[32] = h.y;
}
__host__ __device__ __forceinline__ void fft_mul_one(FFT_LAS float* buf, int k, float cr, float ci, float dr_, float di_, float wc, float ws) {
    const int k2 = (FN - k) & (FN - 1);
    FFT_LAS f32x2* pa = (FFT_LAS f32x2*)(buf + 2 * fphys(fpos(k))); FFT_LAS f32x2* pb = (FFT_LAS f32x2*)(buf + 2 * fphys(fpos(k2)));
    const f32x2 A = *pa, Bm = *pb;
    const float ar = A.x, ai = A.y, br = Bm.x, bi = -Bm.y, dr = dr_, di = -di_;
    const float uer = 0.5f * (ar + br), uei = 0.5f * (ai + bi), uor = 0.5f * (ai - bi), uoi = -0.5f * (ar - br);
    const float ker = 0.5f * (cr + dr), kei = 0.5f * (ci + di), kor = 0.5f * (ci - di), koi = -0.5f * (cr - dr);
    const float pr = uor * kor - uoi * koi, pi = uor * koi + uoi * kor;
    const float yer = (uer * ker - uei * kei) + (pr * wc + pi * ws), yei = (uer * kei + uei * ker) + (pi * wc - pr * ws);
    const float yor = (uer * kor - uei * koi) + (uor * ker - uoi * kei), yoi = (uer * koi + uei * kor) + (uor * kei + uoi * ker);
    *pa = (f32x2){yer - yoi, yei + yor};
    *pb = (f32x2){yer + yoi, -yei + yor};
}
__host__ __device__ __forceinline__ void fft_multiply(FFT_LAS float* buf, int tid, const float (&kr)[33], const float (&ki)[33]) {
    FFT_OPAQUE(tid);
    float c1, s1; ftw(tid, FN, c1, s1);
#pragma unroll
    for (int m = 0; m < 16; ++m) { const float cm = fcos32(m), sm = fsin32(m); const float wc = c1 * cm - s1 * sm, ws = s1 * cm + c1 * sm;
        fft_mul_one(buf, tid + 512 * m, kr[2 * m], ki[2 * m], kr[2 * m + 1], ki[2 * m + 1], wc, ws); }
    if (tid == 0) fft_mul_one(buf, FN / 2, kr[32], ki[32], kr[32], ki[32], -1.0f, 0.0f);
}

__device__ __forceinline__ void p4_fft_job(Frame& F, int job) {
    const float* const* in = F.in;
    int tid_ = F.tid, lane_ = F.lane; FFT_OPAQUE(tid_); FFT_OPAQUE(lane_);
    const int tid = tid_, lane = lane_, wave = F.wave, c0 = job * 4;
    LAS float* buf = (LAS float*)F.lds;
    LAS float* scr = (LAS float*)(F.lds + FFTSCR_OFF);
    float* hfT = (float*)(F.ws + WS_KF); float* hbT = (float*)(F.ws + WS_KB); const float* uT = (const float*)(F.ws + WS_UIN);
    {
        const bf16* hd = (const bf16*)(F.ws + WS_HDN);
        const int n = lane & 15, kq = lane >> 4, ch = (n >> 1) & 3, dir = n & 1, col = dir * 1024 + c0 + ch; const bool valid = n < 8;
        bf16x8 bfr[2];
#pragma unroll
        for (int ks = 0; ks < 2; ++ks) { unsigned w[4];
#pragma unroll
            for (int j = 0; j < 4; ++j) { const int k = ks * 32 + kq * 8 + 2 * j; const float a = valid ? in[IN_FW3][(size_t)k * 2048 + col] : 0.f, b = valid ? in[IN_FW3][(size_t)(k + 1) * 2048 + col] : 0.f; w[j] = cvt_pk_bf16(a, b); }
            bfr[ks] = __builtin_bit_cast(bf16x8, (v4u){w[0], w[1], w[2], w[3]}); }
        const float b3 = valid ? in[IN_FB3][col] : 0.f;
        const float r_slow = 3.0701134573253945f, r_fast = 15.350567286626972f;
        const float rate = r_slow + (float)(c0 + ch) * ((r_fast - r_slow) / 1023.0f);
        float asum = 0.f; float* dst = (dir ? hbT : hfT) + (size_t)(c0 + ch) * L;
        for (int tile = wave; tile < L / 16; tile += NWAVES) {
            const int t0 = tile * 16;
            const bf16x8 a0 = *(const bf16x8*)(hd + (size_t)(t0 + n) * 64 + kq * 8), a1 = *(const bf16x8*)(hd + (size_t)(t0 + n) * 64 + 32 + kq * 8);
            f32x4 acc = (f32x4){b3, b3, b3, b3};
            acc = __builtin_amdgcn_mfma_f32_16x16x32_bf16(a0, bfr[0], acc, 0, 0, 0);
            acc = __builtin_amdgcn_mfma_f32_16x16x32_bf16(a1, bfr[1], acc, 0, 0, 0);
            if (valid) { f32x4 o;
#pragma unroll
                for (int r = 0; r < 4; ++r) { const int t = t0 + 4 * kq + r; const float t01 = (float)t / (float)(L - 1); const float v = acc[r] * __expf(-t01 * rate); o[r] = v; if (!(dir && t == 0)) asum += fabsf(v); }
                *(f32x4*)(dst + t0 + 4 * kq) = o; }
        }
        asum += __shfl_xor(asum, 16); asum += __shfl_xor(asum, 32);
        if (lane < 8) scr[wave * 8 + lane] = asum;
        VM_WAIT(); __syncthreads();
        float tot = 0.f;
        if (tid < 4) { for (int w = 0; w < 8; ++w) tot += scr[w * 8 + 2 * tid] + scr[w * 8 + 2 * tid + 1]; }
        __syncthreads();
        if (tid < 4) scr[tid] = 1.0f / (tot * (float)FN);
        __syncthreads();
    }
#pragma unroll 1
    for (int ch = 0; ch < 4; ++ch) {
        const int c = c0 + ch;
        const float* hf = hfT + (size_t)c * L; const float* hb = hbT + (size_t)c * L; const float* uc = uT + (size_t)c * L;
#pragma unroll 1
        for (int a = tid; a < FN; a += NT) { float ke, ko;
            if (a < FN / 2) { const f32x2 v = *(const f32x2*)(hf + 2 * a); ke = v.x; ko = v.y; }
            else if (a == FN / 2) { ke = 0.f; ko = hb[L - 1]; }
            else { ke = hb[2 * FN - 2 * a]; ko = hb[2 * FN - 2 * a - 1]; }
            *(LAS f32x2*)(buf + 2 * fphys(a)) = (f32x2){ke, ko}; }
        __syncthreads();
        fft_fwd_pass(buf, 0, tid); __syncthreads(); fft_fwd_pass(buf, 1, tid); __syncthreads(); fft_fwd_pass(buf, 2, tid); __syncthreads();
        {
            int tq = tid; FFT_OPAQUE(tq);
            f32x2* sa = (f32x2*)(hfT + (size_t)c * L); f32x2* sb = (f32x2*)(hbT + (size_t)c * L);
#pragma unroll 4
            for (int m = 0; m < 16; ++m) { const int k = tq + 512 * m, k2 = (FN - k) & (FN - 1);
                sa[m * 512 + tq] = *(const LAS f32x2*)(buf + 2 * fphys(fpos(k))); sb[m * 512 + tq] = *(const LAS f32x2*)(buf + 2 * fphys(fpos(k2))); }
            if (tid == 0) { const f32x2 h = *(const LAS f32x2*)(buf + 2 * fphys(fpos(FN / 2))); scr[8] = h.x; scr[9] = h.y; }
        }
        __syncthreads();
#pragma unroll 2
        for (int a = tid; a < FN; a += NT) { f32x2 v = (f32x2){0.f, 0.f}; if (a < FN / 2) v = *(const f32x2*)(uc + 2 * a); *(LAS f32x2*)(buf + 2 * fphys(a)) = v; }
        __syncthreads();
        fft_fwd_pass(buf, 0, tid); __syncthreads(); fft_fwd_pass(buf, 1, tid); __syncthreads(); fft_fwd_pass(buf, 2, tid); __syncthreads();
        {   int tq = tid; FFT_OPAQUE(tq);
            const f32x2* sa = (const f32x2*)(hfT + (size_t)c * L); const f32x2* sb = (const f32x2*)(hbT + (size_t)c * L);
            float c1, s1; ftw(tq, FN, c1, s1);
#pragma unroll 4
            for (int m = 0; m < 16; ++m) { const float cm = fcos32(m), sm = fsin32(m); const float wc = c1 * cm - s1 * sm, ws = s1 * cm + c1 * sm;
                const f32x2 ka = sa[m * 512 + tq], kb = sb[m * 512 + tq];
                fft_mul_one(buf, tq + 512 * m, ka.x, ka.y, kb.x, kb.y, wc, ws); }
            if (tid == 0) fft_mul_one(buf, FN / 2, scr[8], scr[9], scr[8], scr[9], -1.0f, 0.0f);
        }
        VM_WAIT(); __syncthreads();
        fft_inv_pass(buf, 0, tid); __syncthreads(); fft_inv_pass(buf, 1, tid); __syncthreads(); fft_inv_pass(buf, 2, tid); __syncthreads();
        { const float sc = scr[ch]; float* yT = hfT + (size_t)c * L;
#pragma unroll 2
            for (int nn = tid; nn < FN / 2; nn += NT) { const f32x2 v = *(const LAS f32x2*)(buf + 2 * fphys(nn)); *(f32x2*)(yT + 2 * nn) = (f32x2){v.x * sc, v.y * sc}; } }
        __syncthreads();
    }
    VM_WAIT(); __syncthreads();
    {
        const bf16* z = (const bf16*)(F.ws + WS_Z); bf16* cat = (bf16*)(F.ws + WS_CAT);
        float w0[4], w1[4], w2[4], bb[4], dsk[4];
#pragma unroll
        for (int q = 0; q < 4; ++q) { w0[q] = in[IN_CHW][c0 + q]; w1[q] = in[IN_CHW][3072 + c0 + q]; w2[q] = in[IN_CHW][6144 + c0 + q]; bb[q] = in[IN_CHB][c0 + q]; dsk[q] = in[IN_DSKIP][c0 + q]; }
#pragma unroll 1
        for (int t = tid; t < L; t += NT) {
            const v2u zc = *(const v2u*)(z + (size_t)t * NINP + OFF_HY + c0);
            const v2u zp = t > 0 ? *(const v2u*)(z + (size_t)(t - 1) * NINP + OFF_HY + c0) : (v2u){0u, 0u};
            const v2u zn = t < L - 1 ? *(const v2u*)(z + (size_t)(t + 1) * NINP + OFF_HY + c0) : (v2u){0u, 0u};
            const float pv[4] = {bflo(zp.x), bfhi(zp.x), bflo(zp.y), bfhi(zp.y)}, cv[4] = {bflo(zc.x), bfhi(zc.x), bflo(zc.y), bfhi(zc.y)}, nv[4] = {bflo(zn.x), bfhi(zn.x), bflo(zn.y), bfhi(zn.y)};
            float o[4];
#pragma unroll
            for (int q = 0; q < 4; ++q) { const float y = hfT[(size_t)(c0 + q) * L + t] + dsk[q] * uT[(size_t)(c0 + q) * L + t];
                o[q] = (pv[q] * w0[q] + cv[q] * w1[q] + nv[q] * w2[q] + bb[q]) * y; }
            v2u w; w.x = cvt_pk_bf16(o[0], o[1]); w.y = cvt_pk_bf16(o[2], o[3]);
            *(v2u*)(cat + (size_t)t * D + MVW + c0) = w;
        }
    }
    __syncthreads();
}
__device__ __forceinline__ void p6_norm2_router(Frame& F) {
    const float* const* in = F.in;
    const float* mod = (const float*)(F.ws + WS_MOD);
    bf16* h2 = (bf16*)(F.ws + WS_HA);
    int* cnt = (int*)(F.ws + WS_CTL) + CW_CNT;
    int* aexp = (int*)(F.ws + WS_AEXP); int* arank = (int*)(F.ws + WS_ARANK); float* aw = (float*)(F.ws + WS_AW);
    LAS float* hrow = (LAS float*)F.lds + F.wave * 2048;
    LAS float* wch = (LAS float*)(F.lds + 65536);
    const int lane = F.lane;
    for (int t0 = F.bid * 8; t0 < L; t0 += F.G * 8) {
        const int t = t0 + F.wave;
        {
            f32x4 v[8]; float ss = 0.f;
#pragma unroll
            for (int j = 0; j < 8; ++j) { const int col = 4 * lane + 256 * j; v[j] = *(const f32x4*)(F.out + (size_t)t * D + col); ss += (v[j].x * v[j].x + v[j].y * v[j].y) + (v[j].z * v[j].z + v[j].w * v[j].w); }
            const float rstd = rsqrtf(wave_sum(ss) * (1.0f / D) + EPS);
#pragma unroll
            for (int j = 0; j < 8; ++j) { const int col = 4 * lane + 256 * j;
                const f32x4 g = *(const f32x4*)(in[IN_GFFN] + col), sh = *(const f32x4*)(mod + 6144 + col), sc = *(const f32x4*)(mod + 8192 + col);
                const f32x4 h = (v[j] * rstd * g) * (sc + 1.0f) + sh;
                *(LAS f32x4*)(hrow + col) = h;
                v2u o; o.x = cvt_pk_bf16(h.x, h.y); o.y = cvt_pk_bf16(h.z, h.w);
                *(v2u*)(h2 + (size_t)t * D + col) = o; }
        }
        float logit = 0.f;
        for (int ch = 0; ch < 8; ++ch) {
            __syncthreads();
            for (int i = F.tid; i < 4096; i += NT) *(LAS f32x4*)(wch + 4 * i) = *(const f32x4*)(in[IN_WR] + (size_t)ch * 16384 + 4 * i);
            __syncthreads();
            const LAS float* hr = hrow + ch * 256;
#pragma unroll 4
            for (int i = 0; i < 256; i += 4) { const f32x4 hv = *(const LAS f32x4*)(hr + i);
                logit += hv.x * wch[(i + 0) * 64 + lane]; logit += hv.y * wch[(i + 1) * 64 + lane]; logit += hv.z * wch[(i + 2) * 64 + lane]; logit += hv.w * wch[(i + 3) * 64 + lane]; }
        }
        const float s = 1.0f / (1.0f + expf(-logit)), sel = s + in[IN_BR][lane];
        const int grp = lane >> 3;
        float m1 = sel; m1 = fmaxf(m1, __shfl_xor(m1, 1)); m1 = fmaxf(m1, __shfl_xor(m1, 2)); m1 = fmaxf(m1, __shfl_xor(m1, 4));
        const unsigned long long gm = 0xFFull << (8 * grp);
        const unsigned long long b1 = __ballot(sel == m1) & gm;
        const int first = __ffsll((long long)b1) - 1;
        float m2 = (lane == first) ? -INFINITY : sel; m2 = fmaxf(m2, __shfl_xor(m2, 1)); m2 = fmaxf(m2, __shfl_xor(m2, 2)); m2 = fmaxf(m2, __shfl_xor(m2, 4));
        const float gs = m1 + m2;
        int grank = 0;
#pragma unroll
        for (int g = 0; g < 8; ++g) { const float og = __shfl(gs, 8 * g); grank += (og > gs || (og == gs && g < grp)) ? 1 : 0; }
        const float masked = grank < 4 ? sel : -INFINITY;
        int rank = 0;
        for (int e2 = 0; e2 < 64; ++e2) { const float om = __shfl(masked, e2); rank += (om > masked || (om == masked && e2 < lane)) ? 1 : 0; }
        const bool chosen = rank < 8;
        const float wsum = wave_sum(chosen ? s : 0.f);
        const unsigned long long cb = __ballot(chosen);
        if (chosen) {
            const int k = (int)__builtin_amdgcn_mbcnt_hi((unsigned)(cb >> 32), __builtin_amdgcn_mbcnt_lo((unsigned)cb, 0u));
            const int half = t >= HALF_T ? 1 : 0;
            const int r = atomicAdd(cnt + half * 64 + lane, 1);
            aexp[t * 8 + k] = lane; arank[t * 8 + k] = r; aw[t * 8 + k] = s / wsum * 2.5f;
        }
    }
    __syncthreads();
}
__device__ __forceinline__ void build_pstart(Frame& F) {
    LAS int* ps = (LAS int*)(F.lds + LDSCTL_OFF);
    const int* cnt = (const int*)(F.ws + WS_CTL) + CW_CNT;
    __syncthreads();
    if (F.tid < 2) { int a = 0;
        for (int e = 0; e < NE; ++e) { ps[F.tid * 66 + e] = a; a += (__hip_atomic_load(cnt + F.tid * 64 + e, __ATOMIC_RELAXED, __HIP_MEMORY_SCOPE_AGENT) + 255) & ~255; }
        ps[F.tid * 66 + 64] = a; ps[F.tid * 66 + 65] = a + HALF_T; }
    __syncthreads();
}
__device__ __forceinline__ void p7_fill_rows(Frame& F) {
    build_pstart(F);
    const LAS int* ps = (const LAS int*)(F.lds + LDSCTL_OFF);
    const int* aexp = (const int*)(F.ws + WS_AEXP); const int* arank = (const int*)(F.ws + WS_ARANK); const float* aw = (const float*)(F.ws + WS_AW);
    int* rt = (int*)(F.ws + WS_RTOK); float* rw = (float*)(F.ws + WS_RW);
    const int gt = F.bid * NT + F.tid, NGT = F.G * NT;
    for (int i = gt; i < L * 8; i += NGT) { const int t = i >> 3, h = t >= HALF_T ? 1 : 0; const int row = ps[h * 66 + aexp[i]] + arank[i];
        rt[h * MAXROWS + row] = t; rw[h * MAXROWS + row] = aw[i]; }
    for (int t = gt; t < L; t += NGT) { const int h = t >= HALF_T ? 1 : 0; const int row = ps[h * 66 + 64] + (t - h * HALF_T);
        rt[h * MAXROWS + row] = t; rw[h * MAXROWS + row] = 1.0f; }
}
__device__ __forceinline__ void moe_combine(Frame& F, int half) {
    const float* const* in = F.in;
    const LAS int* ps = (const LAS int*)(F.lds + LDSCTL_OFF) + half * 66;
    const float* mod = (const float*)(F.ws + WS_MOD);
    const int* aexp = (const int*)(F.ws + WS_AEXP); const int* arank = (const int*)(F.ws + WS_ARANK);
    const bf16* Y2 = (const bf16*)(F.ws + WS_Y2);
    const int gw = F.bid * NWAVES + F.wave, NGW = F.G * NWAVES, lane = F.lane;
    for (int tt = gw; tt < HALF_T; tt += NGW) {
        const int t = half * HALF_T + tt;
        float a[32];
#pragma unroll
        for (int i = 0; i < 32; ++i) a[i] = 0.f;
#pragma unroll 1
        for (int k = 0; k < 9; ++k) {
            const int row = k < 8 ? ps[aexp[t * 8 + k]] + arank[t * 8 + k] : ps[64] + tt;
            const bf16* yr = Y2 + (size_t)row * D + 8 * lane;
#pragma unroll
            for (int j = 0; j < 4; ++j) { const v4u y = *(const v4u*)(yr + 512 * j);
                a[8 * j + 0] += bflo(y.x); a[8 * j + 1] += bfhi(y.x); a[8 * j + 2] += bflo(y.y); a[8 * j + 3] += bfhi(y.y);
                a[8 * j + 4] += bflo(y.z); a[8 * j + 5] += bfhi(y.z); a[8 * j + 6] += bflo(y.w); a[8 * j + 7] += bfhi(y.w); }
        }
        float ss = 0.f;
#pragma unroll
        for (int j = 0; j < 4; ++j)
#pragma unroll
            for (int q = 0; q < 2; ++q) { const int col = 8 * lane + 512 * j + 4 * q;
                const f32x4 x1 = *(const f32x4*)(F.out + (size_t)t * D + col), g2 = *(const f32x4*)(mod + 10240 + col);
                const int i = 8 * j + 4 * q;
                a[i] = x1.x + g2.x * a[i]; a[i + 1] = x1.y + g2.y * a[i + 1]; a[i + 2] = x1.z + g2.z * a[i + 2]; a[i + 3] = x1.w + g2.w * a[i + 3];
                ss += (a[i] * a[i] + a[i + 1] * a[i + 1]) + (a[i + 2] * a[i + 2] + a[i + 3] * a[i + 3]); }
        const float rstd = rsqrtf(wave_sum(ss) * (1.0f / D) + EPS);
#pragma unroll
        for (int j = 0; j < 4; ++j)
#pragma unroll
            for (int q = 0; q < 2; ++q) { const int col = 8 * lane + 512 * j + 4 * q; const int i = 8 * j + 4 * q;
                const f32x4 gf = *(const f32x4*)(in[IN_GFIN] + col);
                *(f32x4*)(F.out + (size_t)t * D + col) = (f32x4){a[i] * rstd * gf.x, a[i + 1] * rstd * gf.y, a[i + 2] * rstd * gf.z, a[i + 3] * rstd * gf.w}; }
    }
}

constexpr int N_PHASES = 14;
__global__ void __launch_bounds__(NT, 2) fwd_kernel(Args args) {
    extern __shared__ __attribute__((aligned(16))) unsigned char lds_raw[];
    Frame F;
    F.lds = (LAS unsigned char*)lds_raw;
    F.tid = threadIdx.x; F.lane = F.tid & 63; F.wave = __builtin_amdgcn_readfirstlane(F.tid >> 6);
    F.bid = blockIdx.x; F.G = gridDim.x;
    F.in = args.in; F.out = args.out; F.ws = args.ws;
    volatile LAS unsigned* MISC = (volatile LAS unsigned*)(F.lds + LDSCTL_OFF + 768);
    if (F.tid < 64) ((LAS unsigned*)(F.lds + LDSCTL_OFF))[F.tid + 192] = 0u;
    __syncthreads();
    unsigned* ctl = (unsigned*)(F.ws + WS_CTL);
    const int lo = args.ph_lo, hi = args.ph_hi;
    XcdBarrier bar; bar.bar = ctl + CW_BAR; bar.x = 0; bar.st = nullptr;
    if (hi - lo > 1) bar = xcd_barrier_post(ctl + CW_BAR, MISC + 8);
#ifndef PH_MASK
#define PH_MASK 0xFFFF
#endif
#define IN(k) (((PH_MASK >> (k)) & 1) && lo <= (k) && (k) < hi)
#define SEAM(k) do { if (IN(k) && IN((k) + 1)) xcd_barrier(bar); } while (0)
    LAS int* ps = (LAS int*)(F.lds + LDSCTL_OFF);

    if (IN(0)) { p0_prologue(F); } SEAM(0);
    if (IN(1)) { p1_norm1(F); } SEAM(1);
    if (IN(2)) {
        gk::DenseOrder S; S.init(MROWS, NINP, D, F.G, F.bid); S.Bt = (const char*)(F.ws + WS_WIN);
        gk::EpiBf16Store E{(bf16*)(F.ws + WS_Z), NINP};
        gk::gemm_core(F.lds, (const char*)(F.ws + WS_HA), D, S, E);
    } SEAM(2);
    if (IN(3)) {
        for (int it = F.bid; it < 1040; it += F.G) ml_prep_item(F, it);
        for (int tile = F.bid; tile < 256; tile += F.G) p3_filter_tile(F, tile);
        for (int tile = F.bid; tile < 1024; tile += F.G) p3_uin_tile(F, tile);
    } SEAM(3);
    if (IN(4)) { ml_scan(F); } SEAM(4);
    if (IN(5)) {
        for (int job = F.bid; job < 256; job += F.G) p4_fft_job(F, job);
        for (int it = F.bid; it < 1024; it += F.G) ml_out_item(F, it);
    } SEAM(5);
    if (IN(6)) {
        gk::DenseOrder S; S.init(L, D, D, F.G, F.bid); S.Bt = (const char*)(F.ws + WS_WOUT);
        gk::EpiResidual E{F.out, D, (const float*)(F.ws + WS_MOD) + 4096};
        gk::gemm_core(F.lds, (const char*)(F.ws + WS_CAT), D, S, E);
    } SEAM(6);
    if (IN(7)) { p6_norm2_router(F); } SEAM(7);
    if (IN(8)) { p7_fill_rows(F); } SEAM(8);
#define MOE_GU(h) do { build_pstart(F); \
        gk::GroupOrder<4, true> S; S.ntile = ps[(h) * 66 + 65] >> 8; S.G = F.G; S.c = F.bid; S.K = D; S.pstart = ps + (h) * 66; S.rtok = (const int*)(F.ws + WS_RTOK) + (h) * MAXROWS; \
        S.Bt = (const char*)(F.ws + WS_W13); S.bstride = (size_t)1024 * D * 2; \
        gk::EpiGateUp E{(bf16*)(F.ws + WS_HR)}; \
        gk::gemm_core(F.lds, (const char*)(F.ws + WS_HA), D, S, E); } while (0)
#define MOE_DN(h) do { build_pstart(F); \
        gk::GroupOrder<8, false> S; S.ntile = ps[(h) * 66 + 65] >> 8; S.G = F.G; S.c = F.bid; S.K = DE; S.pstart = ps + (h) * 66; S.rtok = nullptr; \
        S.Bt = (const char*)(F.ws + WS_W2); S.bstride = (size_t)D * DE * 2; \
        gk::EpiDown E{(bf16*)(F.ws + WS_Y2), (const float*)(F.ws + WS_RW) + (h) * MAXROWS}; \
        gk::gemm_core(F.lds, (const char*)(F.ws + WS_HR), DE, S, E); } while (0)
    if (IN(9)) { MOE_GU(0); } SEAM(9);
    if (IN(10)) { MOE_DN(0); } SEAM(10);
    if (IN(11)) { MOE_GU(1); moe_combine(F, 0); } SEAM(11);
    if (IN(12)) { MOE_DN(1); } SEAM(12);
    if (IN(13)) { build_pstart(F); moe_combine(F, 1); }
#undef IN
#undef SEAM
}

extern "C" void kernel_launch(void* const* d_in, const int* in_sizes, int n_in, void* d_out, int out_size, void* d_ws, size_t ws_size, hipStream_t stream) {
    static int grid = 0;
    if (grid == 0) {
        if (n_in != 36 || out_size != L * D || ws_size < WS_END) { fprintf(stderr, "kernel_launch: unexpected shapes: n_in %d out %d ws %zu (need %zu)\n", n_in, out_size, ws_size, (size_t)WS_END); grid = -1; return; }
        int dev = 0, cus = 0, per_cu = 0;
        if (hipGetDevice(&dev) != hipSuccess || hipDeviceGetAttribute(&cus, hipDeviceAttributeMultiprocessorCount, dev) != hipSuccess) { grid = -1; return; }
        if (hipFuncSetAttribute((const void*)fwd_kernel, hipFuncAttributeMaxDynamicSharedMemorySize, LDS_BYTES) != hipSuccess) { fprintf(stderr, "kernel_launch: hipFuncSetAttribute failed\n"); grid = -1; return; }
        if (hipOccupancyMaxActiveBlocksPerMultiprocessor(&per_cu, (const void*)fwd_kernel, NT, LDS_BYTES) != hipSuccess || per_cu < 1) fprintf(stderr, "kernel_launch: occupancy query says %d\n", per_cu);
        (void)hipGetLastError();
        grid = cus;
    }
    if (grid < 0) return;
    if (hipMemsetAsync((char*)d_ws + WS_CTL, 0, CTL_ZERO_BYTES, stream) != hipSuccess) return;
    Args a{};
    for (int i = 0; i < 36; ++i) a.in[i] = (const float*)d_in[i];
    a.out = (float*)d_out; a.ws = (unsigned char*)d_ws;
    const int stop = MK_STOP_AFTER < N_PHASES ? MK_STOP_AFTER + 1 : N_PHASES;
#if MK_N_LAUNCHES == 1
    a.ph_lo = 0; a.ph_hi = stop;
    hipLaunchKernelGGL(fwd_kernel, dim3(grid), dim3(NT), LDS_BYTES, stream, a);
#else
    for (int p = 0; p < stop; ++p) { a.ph_lo = p; a.ph_hi = p + 1; hipLaunchKernelGGL(fwd_kernel, dim3(grid), dim3(NT), LDS_BYTES, stream, a); }
#endif
}
```

```cpp
#include <hip/hip_runtime.h>
#include <cstdio>
#include <cstdint>

#ifndef MK_N_LAUNCHES
#define MK_N_LAUNCHES 1
#endif
#ifndef PROBE_DUP
#define PROBE_DUP -1
#endif
#ifndef MK_STOP_AFTER
#define MK_STOP_AFTER 99
#endif

#define GAS __attribute__((address_space(1)))
#define LAS __attribute__((address_space(3)))
typedef unsigned short bf16;
typedef unsigned v4u __attribute__((ext_vector_type(4)));
typedef unsigned v2u __attribute__((ext_vector_type(2)));
typedef float f32x4 __attribute__((ext_vector_type(4)));
typedef float f32x2 __attribute__((ext_vector_type(2)));
typedef short bf16x8 __attribute__((ext_vector_type(8)));
#define LDS_WAIT() asm volatile("s_waitcnt lgkmcnt(0)" ::: "memory")
#define VM_WAIT() asm volatile("s_waitcnt vmcnt(0)" ::: "memory")

constexpr int NWAVES = 8, NT = NWAVES * 64;
constexpr int L = 16384, D = 2048, LC = 256, MROWS = L + LC;
constexpr int NIN = 6176, NINP = 6400;
constexpr int OFF_K = 0, OFF_V = 512, OFF_G = 1536, OFF_Q = 1568, OFF_O = 2080, OFF_HY = 3104;
constexpr int NH = 8, HYW = 1024, MVW = 1024;
constexpr int NE = 64, NE1 = 65, DE = 512;
constexpr int HALF_T = 8192;
constexpr int MAXROWS = 90112;
constexpr float EPS = 1e-6f;

constexpr size_t MiB = 1u << 20;
constexpr size_t WS_CTL = 0, CTL_ZERO_BYTES = 256 * 1024;
constexpr size_t WS_MOD = 1 * MiB;
constexpr size_t WS_POS = WS_MOD + 128 * 1024;
constexpr size_t WS_WIN = 3 * MiB;
constexpr size_t WS_WOUT = 28 * MiB;
constexpr size_t WS_W13 = 36 * MiB;
constexpr size_t WS_W2 = 296 * MiB;
constexpr size_t WS_HA = 426 * MiB;
constexpr size_t WS_Z = 491 * MiB;
constexpr size_t WS_CAT = 695 * MiB;
constexpr size_t WS_UIN = 759 * MiB;
constexpr size_t WS_KF = 823 * MiB;
constexpr size_t WS_KB = 887 * MiB;
constexpr size_t WS_CL = 426 * MiB;
constexpr size_t WS_CI = 951 * MiB;
constexpr size_t WS_Q = 983 * MiB;
constexpr size_t WS_K = 999 * MiB;
constexpr size_t WS_RTOK = 1015 * MiB;
constexpr size_t WS_RW = WS_RTOK + 2 * MAXROWS * 4;
constexpr size_t WS_AEXP = 1017 * MiB;
constexpr size_t WS_ARANK = WS_AEXP + 512 * 1024;
constexpr size_t WS_AW = WS_ARANK + 512 * 1024;
constexpr size_t WS_HDN = 1019 * MiB;
constexpr size_t WS_SC = 1021 * MiB;
constexpr size_t WS_NL = WS_SC + 32 * 1024;
constexpr size_t WS_NI = WS_NL + 640 * 1024;
constexpr size_t WS_MI = WS_NI + 640 * 1024;
constexpr size_t WS_END = 1023 * MiB;
constexpr size_t WS_HR = 491 * MiB;
constexpr size_t WS_Y2 = 579 * MiB;
static_assert(WS_Y2 + (size_t)MAXROWS * 2048 * 2 <= WS_CI, "overlay");
constexpr int CW_BAR = 4096;
constexpr int CW_CNT = 16384;

constexpr int RING_BYTES = 131072;
constexpr int LDSCTL_OFF = 143360;
constexpr int FFTSCR_OFF = LDSCTL_OFF + 1024;
constexpr int LDS_BYTES = 147456;

__device__ __forceinline__ unsigned cvt_pk_bf16(float lo, float hi) { unsigned r; asm volatile("v_cvt_pk_bf16_f32 %0, %1, %2" : "=v"(r) : "v"(lo), "v"(hi)); return r; }
__device__ __forceinline__ float bf2f(unsigned short b) { return __builtin_bit_cast(float, ((unsigned)b) << 16); }
__device__ __forceinline__ float bflo(unsigned u) { return __builtin_bit_cast(float, u << 16); }
__device__ __forceinline__ float bfhi(unsigned u) { return __builtin_bit_cast(float, u & 0xffff0000u); }
__device__ __forceinline__ float wave_sum(float v) {
#pragma unroll
    for (int o = 1; o < 64; o <<= 1) v += __shfl_xor(v, o);
    return v;
}
__device__ __forceinline__ float silu_f(float a) { return a / (1.f + __expf(-a)); }
__device__ __forceinline__ float sigmoid_f(float a) { return 1.f / (1.f + __expf(-a)); }

#define XB_TMO      128
#define XB_XCNT(j)  (256  + 64 * (j))
#define XB_XSUB(j)  (1280 + 64 * (j))
#define XB_XGEN(j)  (2304 + 64 * (j))
#define XB_TOP      3328
#define XB_TOPGEN   3392
#define XCD_BAR_WORDS 3456
#define XB_SPIN_CAP (1u << 18)

__device__ __forceinline__ unsigned xb_ld(unsigned* p)              { return __hip_atomic_load(p, __ATOMIC_RELAXED, __HIP_MEMORY_SCOPE_AGENT); }
__device__ __forceinline__ unsigned xb_add(unsigned* p, unsigned v) { return __hip_atomic_fetch_add(p, v, __ATOMIC_RELAXED, __HIP_MEMORY_SCOPE_AGENT); }
__device__ __forceinline__ unsigned xb_xcc_id() { return (unsigned)__builtin_amdgcn_s_getreg((3 << 11) | 20) & 0xFu; }
#define XB_SPIN(cond, bar) do { unsigned _sp = 0; while (cond) { __builtin_amdgcn_s_sleep(1); \
    if ((++_sp & 255u) == 0u) { if (xb_ld(&(bar)[XB_TMO])) break; if (_sp > XB_SPIN_CAP) { atomicAdd(&(bar)[XB_TMO], 1u); break; } } } } while (0)

struct XcdBarrier {
    unsigned* bar; unsigned x;
    volatile LAS unsigned* st;
};

__device__ __forceinline__ XcdBarrier xcd_barrier_post(unsigned* bar, volatile LAS unsigned* st) {
    XcdBarrier b; b.bar = bar; b.x = xb_xcc_id(); b.st = st;
    if (threadIdx.x == 0) (void)xb_add(&bar[XB_XCNT(b.x)], 1u);
    return b;
}
__device__ __forceinline__ void xcd_barrier_complete(unsigned* bar, unsigned x, unsigned& nloc, unsigned& nx) {
    const unsigned G = gridDim.x * gridDim.y * gridDim.z;
    unsigned sum, cnt, mine, sp = 0u;
    for (;;) {
        sum = 0u; cnt = 0u; mine = 0u;
#pragma unroll
        for (unsigned j = 0; j < 16; ++j) { const unsigned c = xb_ld(&bar[XB_XCNT(j)]); sum += c; cnt += (c > 0u) ? 1u : 0u; mine = (j == x) ? c : mine; }
        if (sum == G) break;
        __builtin_amdgcn_s_sleep(1);
        if ((++sp & 255u) == 0u) { if (xb_ld(&bar[XB_TMO])) break; if (sp > XB_SPIN_CAP) { atomicAdd(&bar[XB_TMO], 1u); break; } }
    }
    nloc = mine > 0u ? mine : 1u; nx = cnt > 0u ? cnt : 1u;
}

__device__ __forceinline__ void xcd_barrier(const XcdBarrier& b) {
    asm volatile("s_waitcnt vmcnt(0)" ::: "memory");
    __syncthreads();
    if (threadIdx.x == 0) {
        unsigned* bar = b.bar;
        __builtin_amdgcn_s_waitcnt(0);
        unsigned nloc = b.st[0], nx = b.st[1];
        if (nloc == 0u) { xcd_barrier_complete(bar, b.x, nloc, nx); b.st[0] = nloc; b.st[1] = nx; }
        const unsigned old = xb_add(&bar[XB_XSUB(b.x)], 1u);
        const unsigned gen = old / nloc;
        if (old + 1u == (gen + 1u) * nloc) {
            __builtin_amdgcn_fence(__ATOMIC_RELEASE, "agent");
            asm volatile("s_waitcnt vmcnt(0)" ::: "memory");
            const unsigned og = xb_add(&bar[XB_TOP], 1u);
            const unsigned tg = og / nx;
            if (og + 1u == (tg + 1u) * nx) xb_add(&bar[XB_TOPGEN], 1u);
            else XB_SPIN(xb_ld(&bar[XB_TOPGEN]) == tg, bar);
            __builtin_amdgcn_fence(__ATOMIC_ACQUIRE, "agent");
            xb_add(&bar[XB_XGEN(b.x)], 1u);
            asm volatile("s_waitcnt vmcnt(0)" ::: "memory");
        } else {
            XB_SPIN(xb_ld(&bar[XB_XGEN(b.x)]) == gen, bar);
            __builtin_amdgcn_fence(__ATOMIC_ACQUIRE, "agent");
            asm volatile("s_waitcnt vmcnt(0)" ::: "memory");
        }
    }
    __syncthreads();
}

namespace gk {
constexpr int BM = 256, BK = 64, HALF = 128, HTB = HALF * BK * 2, STAGE_BYTES = 8 * HTB, NXCD = 8, WGM = 8;
__host__ __device__ __forceinline__ int lds_byte(int r, int c) { const int st = (r >> 4) * 2 + (c >> 5), rr = r & 15, cc = c & 31, ob = rr * 64 + cc * 2; return st * 1024 + (ob ^ (((ob >> 9) & 1) << 5)); }
__host__ __device__ __forceinline__ void stage_rc(int b, int& R, int& C) { const int st = b / 1024, sb = b % 1024, swz = sb ^ (((sb >> 9) & 1) << 5); R = (st >> 1) * 16 + swz / 64; C = (st & 1) * 32 + (swz % 64) / 2; }
__host__ __device__ __forceinline__ int perm32(int rho) { const int n = rho >> 4, i = rho & 15; return 8 * (i >> 2) + 4 * n + (i & 3); }

struct Unit { int pm, pn, ex; };

template <class Epi, class Sched>
__device__ __forceinline__ void gemm_core(LAS unsigned char* lds, const char* Abase, const int K, const Sched& S, const Epi& E) {
    const int tid = threadIdx.x, wid = __builtin_amdgcn_readfirstlane(tid >> 6), lane = tid & 63, wr = wid >> 2, wc = wid & 3, fr = lane & 15, fq = lane >> 4;
    const int nt = K / BK;
    int RA[2], CA[2]; unsigned voffB[2];
#pragma unroll
    for (int i = 0; i < 2; ++i) { int R, C; stage_rc(tid * 16 + i * 8192, R, C); const int Rb = Epi::PERM ? ((R & ~31) + perm32(R & 31)) : R;
        RA[i] = R; CA[i] = C; voffB[i] = (unsigned)(Rb * K + C) * 2u; }
    const size_t kstep = (size_t)(BK * 2);
    const size_t hstepB = (size_t)HALF * K * 2;
    const unsigned ldsw = (unsigned)wid * 1024u;
    const int aoff = lds_byte(wr * 64 + fr, fq * 8), boff = lds_byte(wc * 32 + fr, fq * 8);
#define GK_SA(b, h) (((b) * 2 + (h)) * HTB)
#define GK_SB(b, h) ((4 + (b) * 2 + (h)) * HTB)
#define GK_STAGE(bufoff, gbase, v0, v1) do { \
        __builtin_amdgcn_global_load_lds((const unsigned*)((const char*)(gbase) + (v0)), (LAS unsigned*)(lds + (bufoff) + ldsw), 16, 0, 0); \
        __builtin_amdgcn_global_load_lds((const unsigned*)((const char*)(gbase) + (v1)), (LAS unsigned*)(lds + (bufoff) + ldsw + 8192), 16, 0, 0); } while (0)
#define GK_LDA(dst, b, h) do { _Pragma("unroll") for (int m = 0; m < 4; ++m) _Pragma("unroll") for (int k = 0; k < 2; ++k) dst[m][k] = *(const LAS bf16x8*)(lds + GK_SA(b, h) + aoff + m * 2048 + k * 1024); } while (0)
#define GK_LDB(dst, b, h) do { _Pragma("unroll") for (int n = 0; n < 2; ++n) _Pragma("unroll") for (int k = 0; k < 2; ++k) dst[n][k] = *(const LAS bf16x8*)(lds + GK_SB(b, h) + boff + n * 2048 + k * 1024); } while (0)
#define GK_MMA(ai, bj, At, Bt) do { __builtin_amdgcn_s_setprio(1); _Pragma("unroll") for (int m = 0; m < 4; ++m) _Pragma("unroll") for (int n = 0; n < 2; ++n) _Pragma("unroll") for (int k = 0; k < 2; ++k) \
        acc[ai][bj][m][n] = __builtin_amdgcn_mfma_f32_16x16x32_bf16(Bt[n][k], At[m][k], acc[ai][bj][m][n], 0, 0, 0); __builtin_amdgcn_s_setprio(0); } while (0)
#define GK_WAIT_V(n) asm volatile("s_waitcnt vmcnt(" #n ")" ::: "memory")
#define GK_WAIT_L(n) asm volatile("s_waitcnt lgkmcnt(" #n ")" ::: "memory")
#define GK_BAR __builtin_amdgcn_s_barrier()
#define GK_SCHED __builtin_amdgcn_sched_barrier(0)
    Unit cur, nxt; int ui = 0;
    if (!S.next(0, cur)) return;
    f32x4 acc[2][2][4][2];
#pragma unroll
    for (int a = 0; a < 2; ++a)
#pragma unroll
        for (int b = 0; b < 2; ++b)
#pragma unroll
            for (int m = 0; m < 4; ++m)
#pragma unroll
                for (int n = 0; n < 2; ++n) acc[a][b][m][n] = (f32x4){0.f, 0.f, 0.f, 0.f};
    bf16x8 At[4][2], B0[2][2], B1[2][2];
    unsigned c00, c01, c10, c11, n00, n01, n10, n11;
    S.a_offs(cur, RA, CA, c00, c01, c10, c11);
    asm volatile("" : "+v"(c00), "+v"(c01), "+v"(c10), "+v"(c11));
    const char* cB = S.b_base(cur);
    GK_STAGE(GK_SB(0, 0), cB, voffB[0], voffB[1]); GK_STAGE(GK_SB(0, 1), cB + hstepB, voffB[0], voffB[1]); GK_STAGE(GK_SA(0, 0), Abase, c00, c01); GK_STAGE(GK_SA(0, 1), Abase, c10, c11);
    if (wr == 1) GK_BAR;
    GK_WAIT_V(2); GK_BAR;
    GK_STAGE(GK_SB(1, 0), cB + kstep, voffB[0], voffB[1]); GK_STAGE(GK_SA(1, 0), Abase + kstep, c00, c01); GK_STAGE(GK_SB(1, 1), cB + hstepB + kstep, voffB[0], voffB[1]);
    GK_WAIT_V(6); GK_BAR;
    for (;;) {
        const bool has_next = S.next(ui + 1, nxt);
        const char* nB = cB;
        n00 = c00; n01 = c01; n10 = c10; n11 = c11;
        if (has_next) { S.a_offs(nxt, RA, CA, n00, n01, n10, n11); nB = S.b_base(nxt); }
        asm volatile("" : "+v"(n00), "+v"(n01), "+v"(n10), "+v"(n11));
        for (int t = 0; t < nt; t += 2) {
            const bool last = (t == nt - 2);
            const char* a1 = Abase + (size_t)(t + 1) * kstep;
            const char* a2 = last ? Abase : Abase + (size_t)(t + 2) * kstep; const char* b2 = last ? nB : cB + (size_t)(t + 2) * kstep;
            const char* a3 = a2 + kstep; const char* b3 = b2 + kstep;
            const unsigned x00 = last ? n00 : c00, x01 = last ? n01 : c01, x10 = last ? n10 : c10, x11 = last ? n11 : c11;
            GK_LDB(B0, 0, 0); GK_LDB(B1, 0, 1); GK_SCHED; GK_LDA(At, 0, 0); GK_STAGE(GK_SA(1, 1), a1, c10, c11);
            GK_WAIT_V(8); GK_WAIT_L(0); GK_BAR; GK_MMA(0, 0, At, B0); GK_MMA(0, 1, At, B1); GK_BAR; GK_SCHED;
            GK_LDA(At, 0, 1); GK_STAGE(GK_SB(0, 0), b2, voffB[0], voffB[1]); GK_STAGE(GK_SB(0, 1), b2 + hstepB, voffB[0], voffB[1]); GK_STAGE(GK_SA(0, 0), a2, x00, x01);
            GK_WAIT_V(8); GK_WAIT_L(0); GK_BAR; GK_MMA(1, 0, At, B0); GK_MMA(1, 1, At, B1); GK_BAR; GK_SCHED;
            GK_LDB(B0, 1, 0); GK_LDB(B1, 1, 1); GK_SCHED; GK_LDA(At, 1, 0); GK_STAGE(GK_SA(0, 1), a2, x10, x11);
            GK_WAIT_V(8); GK_WAIT_L(0); GK_BAR; GK_MMA(0, 0, At, B0); GK_MMA(0, 1, At, B1); GK_BAR; GK_SCHED;
            GK_LDA(At, 1, 1); GK_STAGE(GK_SB(1, 0), b3, voffB[0], voffB[1]); GK_STAGE(GK_SB(1, 1), b3 + hstepB, voffB[0], voffB[1]); GK_STAGE(GK_SA(1, 0), a3, x00, x01);
            GK_WAIT_V(8); GK_WAIT_L(0); GK_BAR; GK_MMA(1, 0, At, B0); GK_MMA(1, 1, At, B1); GK_BAR; GK_SCHED;
        }
        if (wr == 0) GK_BAR;
        E(acc, cur, wr, wc, fr, fq);
        if (!has_next) break;
#pragma unroll
        for (int a = 0; a < 2; ++a)
#pragma unroll
            for (int b = 0; b < 2; ++b)
#pragma unroll
                for (int m = 0; m < 4; ++m)
#pragma unroll
                    for (int n = 0; n < 2; ++n) acc[a][b][m][n] = (f32x4){0.f, 0.f, 0.f, 0.f};
        cur = nxt; cB = nB; c00 = n00; c01 = n01; c10 = n10; c11 = n11; ++ui;
        if (wr == 1) GK_BAR;
    }
    GK_WAIT_V(0);
    GK_BAR;
#undef GK_SA
#undef GK_SB
#undef GK_STAGE
#undef GK_LDA
#undef GK_LDB
#undef GK_MMA
#undef GK_WAIT_V
#undef GK_WAIT_L
#undef GK_BAR
#undef GK_SCHED
}

struct DenseOrder {
    int nM, nN, nwg, G, c, K;
    __device__ void init(int M, int N, int K_, int G_, int c_) { nM = M / BM; nN = N / BM; nwg = nM * nN; G = G_; c = c_; K = K_; }
    __device__ __forceinline__ bool next(int i, Unit& u) const {
        const long Lx = (long)i * G + c; if (Lx >= nwg) return false;
        int wgid = (int)Lx; { const int q = nwg / NXCD, r = nwg % NXCD, xcd = wgid % NXCD, off = wgid / NXCD; wgid = (xcd < r ? xcd * (q + 1) : r * (q + 1) + (xcd - r) * q) + off; }
        const int nig = WGM * nN, gid = wgid / nig, fm = gid * WGM, gsz = (nM - fm) < WGM ? (nM - fm) : WGM;
        u.pm = fm + ((wgid % nig) % gsz); u.pn = (wgid % nig) / gsz; u.ex = 0; return true;
    }
    const char* Bt;
    __device__ __forceinline__ void a_offs(const Unit& u, const int (&RA)[2], const int (&CA)[2], unsigned& o00, unsigned& o01, unsigned& o10, unsigned& o11) const {
        const unsigned r0 = (unsigned)(u.pm * BM);
        o00 = ((r0 + RA[0]) * (unsigned)K + CA[0]) * 2u; o01 = ((r0 + RA[1]) * (unsigned)K + CA[1]) * 2u;
        o10 = ((r0 + HALF + RA[0]) * (unsigned)K + CA[0]) * 2u; o11 = ((r0 + HALF + RA[1]) * (unsigned)K + CA[1]) * 2u;
    }
    __device__ __forceinline__ const char* b_base(const Unit& u) const { return Bt + (size_t)u.pn * BM * K * 2; }
};
template <int NPN, bool GATHER>
struct GroupOrder {
    int ntile, G, c, K;
    const LAS int* pstart;
    const int* rtok;
    const char* Bt; size_t bstride;
    __device__ __forceinline__ bool next(int i, Unit& u) const {
        const long Lx = (long)i * G + c; if (Lx >= (long)ntile * NPN) return false;
        u.pm = (int)(Lx / NPN); u.pn = (int)(Lx % NPN);
        const int row = u.pm * BM; int lo = 0, hi = NE1;
        while (hi - lo > 1) { const int mid = (lo + hi) >> 1; if (pstart[mid] <= row) lo = mid; else hi = mid; }
        u.ex = lo; return true;
    }
    __device__ __forceinline__ void a_offs(const Unit& u, const int (&RA)[2], const int (&CA)[2], unsigned& o00, unsigned& o01, unsigned& o10, unsigned& o11) const {
        const int r0 = u.pm * BM;
        if (GATHER) {
            const int t00 = rtok[r0 + RA[0]], t01 = rtok[r0 + RA[1]], t10 = rtok[r0 + HALF + RA[0]], t11 = rtok[r0 + HALF + RA[1]];
            o00 = ((unsigned)t00 * (unsigned)K + CA[0]) * 2u; o01 = ((unsigned)t01 * (unsigned)K + CA[1]) * 2u;
            o10 = ((unsigned)t10 * (unsigned)K + CA[0]) * 2u; o11 = ((unsigned)t11 * (unsigned)K + CA[1]) * 2u;
        } else {
            o00 = ((unsigned)(r0 + RA[0]) * (unsigned)K + CA[0]) * 2u; o01 = ((unsigned)(r0 + RA[1]) * (unsigned)K + CA[1]) * 2u;
            o10 = ((unsigned)(r0 + HALF + RA[0]) * (unsigned)K + CA[0]) * 2u; o11 = ((unsigned)(r0 + HALF + RA[1]) * (unsigned)K + CA[1]) * 2u;
        }
    }
    __device__ __forceinline__ const char* b_base(const Unit& u) const { return Bt + (size_t)u.ex * bstride + (size_t)u.pn * BM * K * 2; }
};

struct EpiBf16Store {
    static constexpr bool PERM = true;
    bf16* O; int ldc;
    __device__ __forceinline__ void operator()(const f32x4 (&acc)[2][2][4][2], const Unit& u, int wr, int wc, int fr, int fq) const {
        const int row0 = u.pm * BM + wr * 64 + fr, col0 = u.pn * BM + wc * 32 + 8 * fq;
#pragma unroll
        for (int ai = 0; ai < 2; ++ai)
#pragma unroll
            for (int m = 0; m < 4; ++m) { bf16* rowp = O + (size_t)(row0 + ai * HALF + m * 16) * ldc + col0;
#pragma unroll
                for (int bj = 0; bj < 2; ++bj) { const f32x4 v0 = acc[ai][bj][m][0], v1 = acc[ai][bj][m][1];
                    v4u w; w.x = cvt_pk_bf16(v0[0], v0[1]); w.y = cvt_pk_bf16(v0[2], v0[3]); w.z = cvt_pk_bf16(v1[0], v1[1]); w.w = cvt_pk_bf16(v1[2], v1[3]);
                    *(v4u*)(rowp + bj * HALF) = w; } }
    }
};
struct EpiResidual {
    static constexpr bool PERM = false;
    float* X; int ldc; const float* gate;
    __device__ __forceinline__ void operator()(const f32x4 (&acc)[2][2][4][2], const Unit& u, int wr, int wc, int fr, int fq) const {
        const int row0 = u.pm * BM + wr * 64 + fr, col0 = u.pn * BM + wc * 32 + 4 * fq;
        f32x4 gv[2][2];
#pragma unroll
        for (int bj = 0; bj < 2; ++bj)
#pragma unroll
            for (int n = 0; n < 2; ++n) gv[bj][n] = *(const f32x4*)(gate + col0 + bj * HALF + n * 16);
#pragma unroll
        for (int ai = 0; ai < 2; ++ai)
#pragma unroll
            for (int m = 0; m < 4; ++m) { float* rowp = X + (size_t)(row0 + ai * HALF + m * 16) * ldc + col0;
#pragma unroll
                for (int bj = 0; bj < 2; ++bj)
#pragma unroll
                    for (int n = 0; n < 2; ++n) { f32x4* p = (f32x4*)(rowp + bj * HALF + n * 16); *p = *p + gv[bj][n] * acc[ai][bj][m][n]; } }
    }
};
struct EpiGateUp {
    static constexpr bool PERM = true;
    bf16* O;
    __device__ __forceinline__ void operator()(const f32x4 (&acc)[2][2][4][2], const Unit& u, int wr, int wc, int fr, int fq) const {
        const int row0 = u.pm * BM + wr * 64 + fr, col0 = u.pn * HALF + wc * 32 + 8 * fq;
#pragma unroll
        for (int ai = 0; ai < 2; ++ai)
#pragma unroll
            for (int m = 0; m < 4; ++m) { bf16* rowp = O + (size_t)(row0 + ai * HALF + m * 16) * DE + col0;
                float h[8];
#pragma unroll
                for (int n = 0; n < 2; ++n)
#pragma unroll
                    for (int j = 0; j < 4; ++j) { const float g = acc[ai][0][m][n][j], up = acc[ai][1][m][n][j]; h[n * 4 + j] = silu_f(g) * up; }
                v4u w; w.x = cvt_pk_bf16(h[0], h[1]); w.y = cvt_pk_bf16(h[2], h[3]); w.z = cvt_pk_bf16(h[4], h[5]); w.w = cvt_pk_bf16(h[6], h[7]);
                *(v4u*)rowp = w; }
    }
};
struct EpiDown {
    static constexpr bool PERM = true;
    bf16* O; const float* rw;
    __device__ __forceinline__ void operator()(const f32x4 (&acc)[2][2][4][2], const Unit& u, int wr, int wc, int fr, int fq) const {
        const int row0 = u.pm * BM + wr * 64 + fr, col0 = u.pn * BM + wc * 32 + 8 * fq;
#pragma unroll
        for (int ai = 0; ai < 2; ++ai)
#pragma unroll
            for (int m = 0; m < 4; ++m) { const int row = row0 + ai * HALF + m * 16; const float s = rw[row]; bf16* rowp = O + (size_t)row * D + col0;
#pragma unroll
                for (int bj = 0; bj < 2; ++bj) { const f32x4 v0 = acc[ai][bj][m][0] * s, v1 = acc[ai][bj][m][1] * s;
                    v4u w; w.x = cvt_pk_bf16(v0[0], v0[1]); w.y = cvt_pk_bf16(v0[2], v0[3]); w.z = cvt_pk_bf16(v1[0], v1[1]); w.w = cvt_pk_bf16(v1[2], v1[3]);
                    *(v4u*)(rowp + bj * HALF) = w; } }
    }
};
}

struct Args { const float* in[36]; float* out; unsigned char* ws; int ph_lo, ph_hi; };
struct Frame {
    LAS unsigned char* lds;
    int tid, lane, wave, bid, G;
    const float* const* in; float* out; unsigned char* ws;
};
#define IN_X 0
#define IN_C 1
#define IN_CTX 2
#define IN_CCTX 3
#define IN_WADA 4
#define IN_BADA 5
#define IN_GMIX 6
#define IN_GFFN 7
#define IN_WIN 8
#define IN_BGATES 9
#define IN_CKW 10
#define IN_CKB 11
#define IN_CQW 12
#define IN_CQB 13
#define IN_GHEAD 14
#define IN_CHW 15
#define IN_CHB 16
#define IN_FW1 17
#define IN_FB1 18
#define IN_FF1 19
#define IN_FW2 20
#define IN_FB2 21
#define IN_FF2 22
#define IN_FW3 23
#define IN_FB3 24
#define IN_DSKIP 25
#define IN_WOUT 26
#define IN_WR 27
#define IN_BR 28
#define IN_W1E 29
#define IN_W3E 30
#define IN_W2E 31
#define IN_W1S 32
#define IN_W3S 33
#define IN_W2S 34
#define IN_GFIN 35

__device__ __forceinline__ void transpose_item(const float* W, int N, int k0, int n0, bf16* WT, int dstK, int dst_row0, LAS float* scr, int lane) {
#pragma unroll 8
    for (int i = 0; i < 32; ++i) { const int kk = 2 * i + (lane >> 5); scr[kk * 33 + (lane & 31)] = W[(size_t)(k0 + kk) * N + n0 + (lane & 31)]; }
    LDS_WAIT(); asm volatile("" ::: "memory");
    const int c = lane & 7;
#pragma unroll
    for (int j = 0; j < 4; ++j) { const int n = (lane >> 3) + 8 * j; const LAS float* s = scr + (8 * c) * 33 + n;
        v4u o; o.x = cvt_pk_bf16(s[0 * 33], s[1 * 33]); o.y = cvt_pk_bf16(s[2 * 33], s[3 * 33]); o.z = cvt_pk_bf16(s[4 * 33], s[5 * 33]); o.w = cvt_pk_bf16(s[6 * 33], s[7 * 33]);
        *(v4u*)(WT + (size_t)(dst_row0 + n) * dstK + k0 + 8 * c) = o; }
    LDS_WAIT(); asm volatile("" ::: "memory");
}
__device__ __forceinline__ void p0_prologue(Frame& F) {
    const float* const* in = F.in;
    {
        LAS float* sv = (LAS float*)F.lds;
        LAS float* red = sv + 4096;
        float* mod = (float*)(F.ws + WS_MOD);
        for (int job = F.bid; job < 192; job += F.G) {
            for (int i = F.tid; i < 2048; i += NT) { sv[i] = silu_f(in[IN_C][i]); sv[2048 + i] = silu_f(in[IN_CCTX][i]); }
            __syncthreads();
            const int col = job * 64 + F.lane, r0 = F.wave * 256;
            const float* W = in[IN_WADA] + col;
            float a0 = 0.f, a1 = 0.f;
            for (int i = r0; i < r0 + 256; i += 8) {
                float w[8];
#pragma unroll
                for (int j = 0; j < 8; ++j) w[j] = W[(size_t)(i + j) * 12288];
#pragma unroll
                for (int j = 0; j < 8; ++j) { a0 += sv[i + j] * w[j]; a1 += sv[2048 + i + j] * w[j]; }
            }
            red[(F.wave * 64 + F.lane) * 2 + 0] = a0; red[(F.wave * 64 + F.lane) * 2 + 1] = a1;
            __syncthreads();
            if (F.wave == 0) { float s0 = 0.f, s1 = 0.f;
#pragma unroll
                for (int w = 0; w < 8; ++w) { s0 += red[(w * 64 + F.lane) * 2 + 0]; s1 += red[(w * 64 + F.lane) * 2 + 1]; }
                const float b = in[IN_BADA][col]; mod[col] = s0 + b; mod[12288 + col] = s1 + b; }
            __syncthreads();
        }
    }
    const int gt = F.bid * NT + F.tid, NGT = F.G * NT;
    {
        float* pos = (float*)(F.ws + WS_POS);
        for (int i = gt; i < 320 * 1024; i += NGT) { const int p = i >> 10, j = i & 1023, jj = j & 511;
            const float pp = (float)(p < 256 ? p : p - 256);
            const float omega = 1.0f / powf(10000.0f, (float)jj * (1.0f / 512.0f)); const float ang = pp * omega;
            pos[i] = j < 512 ? sinf(ang) : cosf(ang); }
    }
    {
        v4u* z = (v4u*)(F.ws + WS_WIN + (size_t)NIN * D * 2); const int nz = (NINP - NIN) * D * 2 / 16;
        for (int i = gt; i < nz; i += NGT) z[i] = (v4u){0u, 0u, 0u, 0u};
        int* rt = (int*)(F.ws + WS_RTOK); float* rw = (float*)(F.ws + WS_RW);
        for (int i = gt; i < 2 * MAXROWS; i += NGT) { rt[i] = 0; rw[i] = 0.f; }
    }
    {
        LAS float* scr = (LAS float*)(F.lds + F.wave * 16384);
        const int gw = F.bid * NWAVES + F.wave, NGW = F.G * NWAVES;
        constexpr int I_IN = 32 * 193, I_OUT = 32 * 64, I_E = 512 * NE1;
        constexpr int NITEMS = I_IN + I_OUT + 3 * I_E;
        for (int it = gw; it < NITEMS; it += NGW) {
            int r = it;
            if (r < I_IN) { const int kb = r / 193, nb = r % 193; transpose_item(in[IN_WIN], NIN, 64 * kb, 32 * nb, (bf16*)(F.ws + WS_WIN), D, 32 * nb, scr, F.lane); continue; } r -= I_IN;
            if (r < I_OUT) { const int kb = r / 64, nb = r % 64; transpose_item(in[IN_WOUT], D, 64 * kb, 32 * nb, (bf16*)(F.ws + WS_WOUT), D, 32 * nb, scr, F.lane); continue; } r -= I_OUT;
            if (r < 2 * I_E) { const int which = r >= I_E; if (which) r -= I_E;
                const int e = r / 512, rr = r % 512, kb = rr / 16, nb = rr % 16, n0 = 32 * nb;
                const float* src = e < NE ? in[which ? IN_W3E : IN_W1E] + (size_t)e * D * DE : in[which ? IN_W3S : IN_W1S];
                transpose_item(src, DE, 64 * kb, n0, (bf16*)(F.ws + WS_W13) + (size_t)e * 1024 * D, D, (n0 >> 7) * 256 + which * 128 + (n0 & 127), scr, F.lane); continue; }
            r -= 2 * I_E;
            { const int e = r / 512, rr = r % 512, kb = rr / 64, nb = rr % 64;
                const float* src = e < NE ? in[IN_W2E] + (size_t)e * DE * D : in[IN_W2S];
                transpose_item(src, D, 64 * kb, 32 * nb, (bf16*)(F.ws + WS_W2) + (size_t)e * D * DE, DE, 32 * nb, scr, F.lane); }
        }
    }
}

__device__ __forceinline__ void p1_norm1(Frame& F) {
    const float* const* in = F.in;
    const int gw = F.bid * NWAVES + F.wave, NGW = F.G * NWAVES;
    const float* mod = (const float*)(F.ws + WS_MOD); const float* pos = (const float*)(F.ws + WS_POS);
    bf16* hA = (bf16*)(F.ws + WS_HA);
    for (int row = gw; row < MROWS; row += NGW) {
        f32x4 v[8]; float ss = 0.f;
        const bool mainrow = row < L;
        const float* src = mainrow ? in[IN_X] + (size_t)row * D : in[IN_CTX] + (size_t)(row - L) * D;
        const float* md = mainrow ? mod : mod + 12288;
#pragma unroll
        for (int j = 0; j < 8; ++j) { const int col = 4 * F.lane + 256 * j; v[j] = *(const f32x4*)(src + col);
            if (mainrow) { const float* pp = col < 1024 ? pos + (size_t)(row >> 6) * 1024 + col : pos + (size_t)(256 + (row & 63)) * 1024 + (col - 1024);
                v[j] = v[j] + *(const f32x4*)pp; *(f32x4*)(F.out + (size_t)row * D + col) = v[j]; }
            ss += (v[j].x * v[j].x + v[j].y * v[j].y) + (v[j].z * v[j].z + v[j].w * v[j].w); }
        const float rstd = rsqrtf(wave_sum(ss) * (1.0f / D) + EPS);
#pragma unroll
        for (int j = 0; j < 8; ++j) { const int col = 4 * F.lane + 256 * j;
            const f32x4 g = *(const f32x4*)(in[IN_GMIX] + col), sh = *(const f32x4*)(md + col), sc = *(const f32x4*)(md + 2048 + col);
            const f32x4 h = (v[j] * rstd * g) * (sc + 1.0f) + sh;
            v2u o; o.x = cvt_pk_bf16(h.x, h.y); o.y = cvt_pk_bf16(h.z, h.w);
            *(v2u*)(hA + (size_t)row * D + col) = o; }
    }
}

constexpr int VT_PITCH = 136;
__device__ __forceinline__ float wave_incl_add(float x, int lane) {
#pragma unroll
    for (int o = 1; o < 64; o <<= 1) { const float y = __shfl_up(x, o); if (lane >= o) x += y; }
    return x;
}
__device__ __forceinline__ float wave_incl_max(float x, int lane) {
#pragma unroll
    for (int o = 1; o < 64; o <<= 1) { const float y = __shfl_up(x, o); if (lane >= o) x = fmaxf(x, y); }
    return x;
}
__device__ __forceinline__ void ml_gates(Frame& F, int dir, int h, int rowbase, LAS float* bb, LAS float* al, LAS float* mx, float& g, float& mtot) {
    const bf16* z = (const bf16*)(F.ws + WS_Z);
    const int lane = F.lane, pi0 = 2 * lane, p0 = dir ? 127 - pi0 : pi0, p1 = dir ? p0 - 1 : p0 + 1;
    const float bgi = F.in[IN_BGATES][dir * 16 + h], bgf = F.in[IN_BGATES][dir * 16 + 8 + h];
    const bf16* z0 = z + (size_t)(rowbase + p0) * NINP + OFF_G + dir * 16 + h; const bf16* z1 = z + (size_t)(rowbase + p1) * NINP + OFF_G + dir * 16 + h;
    const float i0 = bf2f(z0[0]) + bgi, f0 = bf2f(z0[8]) + bgf, i1 = bf2f(z1[0]) + bgi, f1 = bf2f(z1[8]) + bgf;
    const float l0 = fminf(f0, 0.f) - log1pf(__expf(-fabsf(f0))), l1 = fminf(f1, 0.f) - log1pf(__expf(-fabsf(f1)));
    const float incl = wave_incl_add(l0 + l1, lane);
    const float b1 = incl, b0 = incl - l1;
    const float a0 = i0 - b0, a1 = i1 - b1;
    const float mi = wave_incl_max(fmaxf(a0, a1), lane);
    float mprev = __shfl_up(mi, 1); if (lane == 0) mprev = -INFINITY;
    const float M0 = fmaxf(mprev, a0), M1 = mi;
    bb[p0] = b0; bb[p1] = b1; al[p0] = a0; al[p1] = a1; mx[p0] = M0; mx[p1] = M1;
    g = __shfl(incl, 63); mtot = __shfl(mi, 63);
}
__device__ __forceinline__ void ml_stage_vT(Frame& F, int h, int rowbase, LAS bf16* vT) {
    const bf16* z = (const bf16*)(F.ws + WS_Z);
    const int s = F.tid >> 2, eg = F.tid & 3;
#pragma unroll
    for (int i = 0; i < 4; ++i) { const int e0 = 32 * eg + 8 * i; const v4u v = *(const v4u*)(z + (size_t)(rowbase + s) * NINP + OFF_V + h * 128 + e0);
        const unsigned w[4] = {v.x, v.y, v.z, v.w};
#pragma unroll
        for (int q = 0; q < 4; ++q) { vT[(e0 + 2 * q) * VT_PITCH + s] = (bf16)(w[q] & 0xffffu); vT[(e0 + 2 * q + 1) * VT_PITCH + s] = (bf16)(w[q] >> 16); } }
}
__device__ __forceinline__ void ml_prep_item(Frame& F, int item) {
    const float* const* in = F.in;
    const int n = item >> 3, h = item & 7, tid = F.tid, lane = F.lane, wave = F.wave;
    const bool isctx = n >= 128;
    const int rowbase = isctx ? L + 128 * (n - 128) : 128 * n, seqlo = isctx ? L : 0, seqhi = isctx ? L + LC - 1 : L - 1;
    LAS bf16* vT = (LAS bf16*)F.lds;
    LAS bf16* kw0 = vT + 128 * VT_PITCH;
    LAS bf16* kw1 = kw0 + 64 * VT_PITCH;
    LAS float* fs = (LAS float*)(kw1 + 64 * VT_PITCH);
    const bf16* z = (const bf16*)(F.ws + WS_Z);
    if (wave < 2) { float g, mtot; LAS float* bbp = fs + 256 + wave * 384; ml_gates(F, wave, h, rowbase, bbp, bbp + 128, bbp + 256, g, mtot);
        LDS_WAIT();
        fs[wave * 128 + 2 * lane] = __expf(bbp[128 + 2 * lane] - mtot); fs[wave * 128 + 2 * lane + 1] = __expf(bbp[128 + 2 * lane + 1] - mtot);
        if (lane == 0) { float* sc = (float*)(F.ws + WS_SC) + ((size_t)(wave * 8 + h) * 130 + n) * 2; sc[0] = g; sc[1] = g + mtot; } }
    ml_stage_vT(F, h, rowbase, vT);
    __syncthreads();
    {
        const int s = tid >> 2, d0 = (tid & 3) * 16, R = rowbase + s; const bool hp = R > seqlo, hn = R < seqhi;
        float kv[16], qv[16];
#pragma unroll
        for (int part = 0; part < 2; ++part) {
            const int zc = (part ? OFF_Q : OFF_K) + h * 64 + d0; const float* cw = in[part ? IN_CQW : IN_CKW] + h * 64 + d0; const float* cb = in[part ? IN_CQB : IN_CKB] + h * 64 + d0;
#pragma unroll
            for (int hv = 0; hv < 2; ++hv) {
                const v4u c = *(const v4u*)(z + (size_t)R * NINP + zc + 8 * hv);
                const v4u p = hp ? *(const v4u*)(z + (size_t)(R - 1) * NINP + zc + 8 * hv) : (v4u){0u, 0u, 0u, 0u};
                const v4u nx = hn ? *(const v4u*)(z + (size_t)(R + 1) * NINP + zc + 8 * hv) : (v4u){0u, 0u, 0u, 0u};
                const unsigned cc[4] = {c.x, c.y, c.z, c.w}, pp[4] = {p.x, p.y, p.z, p.w}, nn[4] = {nx.x, nx.y, nx.z, nx.w};
#pragma unroll
                for (int q = 0; q < 4; ++q) { const int d = 8 * hv + 2 * q;
                    const float v0 = silu_f(bflo(pp[q]) * cw[d] + bflo(cc[q]) * cw[512 + d] + bflo(nn[q]) * cw[1024 + d] + cb[d]);
                    const float v1 = silu_f(bfhi(pp[q]) * cw[d + 1] + bfhi(cc[q]) * cw[512 + d + 1] + bfhi(nn[q]) * cw[1024 + d + 1] + cb[d + 1]);
                    if (part) { qv[d] = v0 * 0.125f; qv[d + 1] = v1 * 0.125f; } else { kv[d] = v0; kv[d + 1] = v1; } }
            }
        }
        if (!isctx) {
            bf16* Qg = (bf16*)(F.ws + WS_Q) + ((size_t)h * L + R) * 64 + d0; bf16* Kg = (bf16*)(F.ws + WS_K) + ((size_t)h * L + R) * 64 + d0;
#pragma unroll
            for (int hv = 0; hv < 2; ++hv) { v4u w;
                w.x = cvt_pk_bf16(qv[8 * hv], qv[8 * hv + 1]); w.y = cvt_pk_bf16(qv[8 * hv + 2], qv[8 * hv + 3]); w.z = cvt_pk_bf16(qv[8 * hv + 4], qv[8 * hv + 5]); w.w = cvt_pk_bf16(qv[8 * hv + 6], qv[8 * hv + 7]); *(v4u*)(Qg + 8 * hv) = w;
                w.x = cvt_pk_bf16(kv[8 * hv], kv[8 * hv + 1]); w.y = cvt_pk_bf16(kv[8 * hv + 2], kv[8 * hv + 3]); w.z = cvt_pk_bf16(kv[8 * hv + 4], kv[8 * hv + 5]); w.w = cvt_pk_bf16(kv[8 * hv + 6], kv[8 * hv + 7]); *(v4u*)(Kg + 8 * hv) = w; }
        }
        const float w0 = fs[s], w1 = fs[128 + s];
#pragma unroll
        for (int d = 0; d < 16; ++d) { const float kr = bf2f((bf16)(cvt_pk_bf16(kv[d], 0.f) & 0xffffu));
            kw0[(d0 + d) * VT_PITCH + s] = (bf16)(cvt_pk_bf16(kr * w0, 0.f) & 0xffffu); kw1[(d0 + d) * VT_PITCH + s] = (bf16)(cvt_pk_bf16(kr * w1, 0.f) & 0xffffu); }
    }
    __syncthreads();
    {
        const int fr = lane & 15, fq = lane >> 4;
        bf16x8 a[4];
#pragma unroll
        for (int kk = 0; kk < 4; ++kk) a[kk] = *(const LAS bf16x8*)(vT + (16 * wave + fr) * VT_PITCH + 32 * kk + 8 * fq);
#pragma unroll
        for (int dir = 0; dir < 2; ++dir) { const LAS bf16* kw = dir ? kw1 : kw0;
            float* cl = (float*)(F.ws + WS_CL) + ((size_t)((dir * 8 + h) * 130 + n)) * 8192;
#pragma unroll
            for (int dt = 0; dt < 4; ++dt) { f32x4 acc = (f32x4){0.f, 0.f, 0.f, 0.f};
#pragma unroll
                for (int kk = 0; kk < 4; ++kk) { const bf16x8 b = *(const LAS bf16x8*)(kw + (16 * dt + fr) * VT_PITCH + 32 * kk + 8 * fq); acc = __builtin_amdgcn_mfma_f32_16x16x32_bf16(a[kk], b, acc, 0, 0, 0); }
#pragma unroll
                for (int r = 0; r < 4; ++r) cl[(16 * wave + 4 * fq + r) * 64 + 16 * dt + fr] = acc[r]; } }
        if (tid < 128) { const int dir = tid >> 6, d = tid & 63; const LAS bf16* kw = (dir ? kw1 : kw0) + d * VT_PITCH; float s = 0.f;
            for (int i = 0; i < 128; ++i) s += bf2f(kw[i]);
            ((float*)(F.ws + WS_NL))[((size_t)((dir * 8 + h) * 130 + n)) * 64 + d] = s; }
    }
    __syncthreads();
}
__device__ __forceinline__ int ml_order(int dir, int step) { return step < 2 ? (dir ? 129 - step : 128 + step) : (dir ? 129 - step : step - 2); }
__device__ __forceinline__ void ml_scan(Frame& F) {
    const float* CL = (const float*)(F.ws + WS_CL); const float* SC = (const float*)(F.ws + WS_SC); const float* NLp = (const float*)(F.ws + WS_NL);
    bf16* CI = (bf16*)(F.ws + WS_CI); float* NI = (float*)(F.ws + WS_NI); float* MI = (float*)(F.ws + WS_MI);
    for (int idx = F.bid * NT + F.tid; idx < 16 * 8192; idx += F.G * NT) {
        const int dh = idx >> 13, rem = idx & 8191, dir = dh >> 3; const bool don = rem < 64;
        float c = 0.f, nn = 0.f, m = 0.f;
        for (int s0 = 0; s0 < 130; s0 += 10) {
            float cl[10], nl[10], gg[10], ml[10];
#pragma unroll
            for (int i = 0; i < 10; ++i) { const int ch = ml_order(dir, s0 + i); cl[i] = CL[((size_t)(dh * 130 + ch)) * 8192 + rem]; gg[i] = SC[(dh * 130 + ch) * 2]; ml[i] = SC[(dh * 130 + ch) * 2 + 1];
                nl[i] = don ? NLp[(size_t)(dh * 130 + ch) * 64 + rem] : 0.f; }
#pragma unroll
            for (int i = 0; i < 10; ++i) { const int ch = ml_order(dir, s0 + i);
                if (ch < 128) { CI[((size_t)(dh * 128 + ch)) * 8192 + rem] = (bf16)(cvt_pk_bf16(c, 0.f) & 0xffffu); if (don) NI[(size_t)(dh * 128 + ch) * 64 + rem] = nn; if (rem == 0) MI[dh * 128 + ch] = m; }
                const float mn = fmaxf(gg[i] + m, ml[i]), sp = __expf(gg[i] + m - mn), sl = __expf(ml[i] - mn);
                c = sp * c + sl * cl[i]; nn = sp * nn + sl * nl[i]; m = mn; }
        }
    }
}
__device__ __forceinline__ void ml_out_item(Frame& F, int item) {
    const float* const* in = F.in;
    const int n = item >> 3, h = item & 7, tid = F.tid, lane = F.lane, wave = F.wave, fr = lane & 15, fq = lane >> 4;
    const int rowbase = 128 * n;
    LAS bf16* vT = (LAS bf16*)F.lds;
    LAS float* fs = (LAS float*)(vT + 128 * VT_PITCH);
    const bf16* z = (const bf16*)(F.ws + WS_Z);
    if (wave < 2) { float g, mtot; LAS float* bbp = fs + wave * 384; ml_gates(F, wave, h, rowbase, bbp, bbp + 128, bbp + 256, g, mtot);
        if (lane == 0) fs[768 + wave] = ((const float*)(F.ws + WS_MI))[(wave * 8 + h) * 128 + n]; }
    ml_stage_vT(F, h, rowbase, vT);
    __syncthreads();
    const bf16* Qg = (const bf16*)(F.ws + WS_Q) + ((size_t)h * L + rowbase) * 64; const bf16* Kg = (const bf16*)(F.ws + WS_K) + ((size_t)h * L + rowbase) * 64;
    const int tl = 16 * wave + fr;
    bf16x8 qf[2];
#pragma unroll
    for (int kk = 0; kk < 2; ++kk) qf[kk] = *(const bf16x8*)(Qg + (size_t)tl * 64 + 32 * kk + 8 * fq);
    f32x4 st[8];
#pragma unroll
    for (int j = 0; j < 8; ++j) { f32x4 acc = (f32x4){0.f, 0.f, 0.f, 0.f};
#pragma unroll
        for (int kk = 0; kk < 2; ++kk) { const bf16x8 kf = *(const bf16x8*)(Kg + (size_t)(16 * j + fr) * 64 + 32 * kk + 8 * fq); acc = __builtin_amdgcn_mfma_f32_16x16x32_bf16(kf, qf[kk], acc, 0, 0, 0); }
        st[j] = acc; }
    f32x4 hs[8];
#pragma unroll
    for (int et = 0; et < 8; ++et) hs[et] = (f32x4){0.f, 0.f, 0.f, 0.f};
#pragma unroll 1
    for (int dir = 0; dir < 2; ++dir) {
        const LAS float* bbp = fs + dir * 384; const LAS float* alp = bbp + 128; const LAS float* mxp = bbp + 256;
        const float m_in = fs[768 + dir];
        const float beta = fmaxf(m_in, mxp[tl]);
        const int dh = dir * 8 + h;
        bf16x8 pf[4]; float dsum = 0.f;
#pragma unroll
        for (int kk = 0; kk < 4; ++kk) { float pv[8];
#pragma unroll
            for (int hh = 0; hh < 2; ++hh)
#pragma unroll
                for (int r = 0; r < 4; ++r) { const int s = 32 * kk + 16 * hh + 4 * fq + r; const bool ok = dir ? (s >= tl) : (s <= tl);
                    const float e = __expf(fminf(alp[s] - beta, 0.f)); const float v = ok ? st[2 * kk + hh][r] * e : 0.f; pv[4 * hh + r] = v; dsum += v; }
            pf[kk] = __builtin_bit_cast(bf16x8, (v4u){cvt_pk_bf16(pv[0], pv[1]), cvt_pk_bf16(pv[2], pv[3]), cvt_pk_bf16(pv[4], pv[5]), cvt_pk_bf16(pv[6], pv[7])}); }
        dsum += __shfl_xor(dsum, 16); dsum += __shfl_xor(dsum, 32);
        const float* nip = (const float*)(F.ws + WS_NI) + (size_t)(dh * 128 + n) * 64; float qn = 0.f;
#pragma unroll
        for (int kk = 0; kk < 2; ++kk) { const v4u qq = __builtin_bit_cast(v4u, qf[kk]); const unsigned w[4] = {qq.x, qq.y, qq.z, qq.w};
#pragma unroll
            for (int q = 0; q < 4; ++q) { const int d = 32 * kk + 8 * fq + 2 * q; qn += bflo(w[q]) * nip[d] + bfhi(w[q]) * nip[d + 1]; } }
        qn += __shfl_xor(qn, 16); qn += __shfl_xor(qn, 32);
        const float sc_t = __expf(m_in - beta);
        const float den = dsum + sc_t * qn, dn = fmaxf(fabsf(den), __expf(-(bbp[tl] + beta)));
        LAS float* xinv = fs + 772 + (wave * 2 + dir) * 32;
        if (fq == 0) { xinv[fr] = 1.0f / dn; xinv[16 + fr] = sc_t; }
        LDS_WAIT();
        float inv_r[4], sc_r[4];
#pragma unroll
        for (int r = 0; r < 4; ++r) { inv_r[r] = xinv[4 * fq + r]; sc_r[r] = xinv[16 + 4 * fq + r]; }
        const bf16* cip = (const bf16*)(F.ws + WS_CI) + (size_t)(dh * 128 + n) * 8192;
#pragma unroll
        for (int et = 0; et < 8; ++et) {
            f32x4 acc = (f32x4){0.f, 0.f, 0.f, 0.f}, acci = (f32x4){0.f, 0.f, 0.f, 0.f};
#pragma unroll
            for (int kk = 0; kk < 4; ++kk) {
                const bool live = dir ? (2 * kk + 1 >= wave) : (2 * kk <= wave);
                if (live) { const LAS bf16* vr = vT + (16 * et + fr) * VT_PITCH + 32 * kk + 4 * fq;
                    const v2u lo = *(const LAS v2u*)vr, hi = *(const LAS v2u*)(vr + 16);
                    const bf16x8 vb = __builtin_bit_cast(bf16x8, (v4u){lo.x, lo.y, hi.x, hi.y});
                    acc = __builtin_amdgcn_mfma_f32_16x16x32_bf16(pf[kk], vb, acc, 0, 0, 0); } }
#pragma unroll
            for (int kk = 0; kk < 2; ++kk) { const bf16x8 cb = *(const bf16x8*)(cip + (size_t)(16 * et + fr) * 64 + 32 * kk + 8 * fq); acci = __builtin_amdgcn_mfma_f32_16x16x32_bf16(qf[kk], cb, acci, 0, 0, 0); }
#pragma unroll
            for (int r = 0; r < 4; ++r) hs[et][r] += (acc[r] + sc_r[r] * acci[r]) * inv_r[r];
        }
    }
    float rs[4];
#pragma unroll
    for (int r = 0; r < 4; ++r) { float ss = 0.f;
#pragma unroll
        for (int et = 0; et < 8; ++et) ss += hs[et][r] * hs[et][r];
        ss += __shfl_xor(ss, 1); ss += __shfl_xor(ss, 2); ss += __shfl_xor(ss, 4); ss += __shfl_xor(ss, 8);
        rs[r] = rsqrtf(ss * (1.0f / 128.0f) + EPS); }
    bf16* cat = (bf16*)(F.ws + WS_CAT);
#pragma unroll
    for (int et = 0; et < 8; ++et) { const int col = h * 128 + 16 * et + fr; const float gh = in[IN_GHEAD][col];
#pragma unroll
        for (int r = 0; r < 4; ++r) { const int t = rowbase + 16 * wave + 4 * fq + r;
            const float o = hs[et][r] * rs[r] * gh * sigmoid_f(bf2f(z[(size_t)t * NINP + OFF_O + col]));
            cat[(size_t)t * D + col] = (bf16)(cvt_pk_bf16(o, 0.f) & 0xffffu); } }
    __syncthreads();
}

__device__ __forceinline__ void p3_filter_tile(Frame& F, int tile) {
    const float* const* in = F.in;
    const int tid = F.tid;
    LAS float* feat = (LAS float*)F.lds;
    LAS float* h1 = feat + 64 * 36;
    LAS float* h2 = h1 + 64 * 65;
    LAS float* w1s = h2 + 64 * 64;
    LAS float* w2s = w1s + 33 * 64;
    for (int i = tid; i < 33 * 64; i += NT) w1s[i] = in[IN_FW1][i];
    for (int i = tid; i < 64 * 64; i += NT) w2s[i] = in[IN_FW2][i];
    {
        const int tt = tid >> 3, sub = tid & 7; const float t = (float)(tile * 64 + tt);
        const float w = (6.2831855f * t) / (float)L;
        if (sub == 0) feat[tt * 36] = t / (float)(L - 1);
#pragma unroll
        for (int q = 0; q < 2; ++q) { const int bi = sub * 2 + q; const float band = 1e-4f + (float)bi * ((15.0f - 1e-4f) / 15.0f); const float ang = w * band;
            feat[tt * 36 + 1 + bi] = cosf(ang); feat[tt * 36 + 17 + bi] = -sinf(ang); }
    }
    __syncthreads();
    {
        const int tt = tid >> 3, j0 = (tid & 7) * 8;
        float a[8];
#pragma unroll
        for (int q = 0; q < 8; ++q) a[q] = in[IN_FB1][j0 + q];
#pragma unroll 1
        for (int i = 0; i < 33; ++i) { const float f = feat[tt * 36 + i];
#pragma unroll
            for (int q = 0; q < 8; ++q) a[q] += f * w1s[i * 64 + j0 + q]; }
#pragma unroll
        for (int q = 0; q < 8; ++q) h1[tt * 65 + j0 + q] = sinf(in[IN_FF1][j0 + q] * a[q]);
    }
    __syncthreads();
    {
        const int tt = tid >> 3, j0 = (tid & 7) * 8;
        float a[8];
#pragma unroll
        for (int q = 0; q < 8; ++q) a[q] = in[IN_FB2][j0 + q];
#pragma unroll 1
        for (int i = 0; i < 64; ++i) { const float f = h1[tt * 65 + i];
#pragma unroll
            for (int q = 0; q < 8; ++q) a[q] += f * w2s[i * 64 + j0 + q]; }
#pragma unroll
        for (int q = 0; q < 8; ++q) h2[tt * 64 + j0 + q] = sinf(in[IN_FF2][j0 + q] * a[q]);
    }
    __syncthreads();
    {
        bf16* hd = (bf16*)(F.ws + WS_HDN);
        for (int i = tid; i < 64 * 32; i += NT) { const int tt = i >> 5, j = (i & 31) * 2; *(unsigned*)(hd + (size_t)(tile * 64 + tt) * 64 + j) = cvt_pk_bf16(h2[tt * 64 + j], h2[tt * 64 + j + 1]); }
    }
    __syncthreads();
}
__device__ __forceinline__ void p3_uin_tile(Frame& F, int tile) {
    const float* const* in = F.in;
    const bf16* z = (const bf16*)(F.ws + WS_Z); float* uT = (float*)(F.ws + WS_UIN);
    LAS float* tl = (LAS float*)F.lds;
    const int t0 = (tile >> 2) * 64, cb = (tile & 3) * 256;
    const int cg = F.tid & 31, c0 = cb + cg * 8, rsub = F.tid >> 5;
    for (int pass = 0; pass < 4; ++pass) {
        const int tt = pass * 16 + rsub, t = t0 + tt;
        float r1[8], r2[8];
#pragma unroll
        for (int part = 0; part < 2; ++part) {
            const int zc = OFF_HY + 1024 * (part + 1) + c0, wc = 1024 * (part + 1) + c0;
            const v4u cur = *(const v4u*)(z + (size_t)t * NINP + zc);
            const v4u prv = t > 0 ? *(const v4u*)(z + (size_t)(t - 1) * NINP + zc) : (v4u){0u, 0u, 0u, 0u};
            const v4u nxt = t < L - 1 ? *(const v4u*)(z + (size_t)(t + 1) * NINP + zc) : (v4u){0u, 0u, 0u, 0u};
            float* rr = part ? r2 : r1;
#pragma unroll
            for (int q = 0; q < 4; ++q) {
                const unsigned pc = q == 0 ? prv.x : q == 1 ? prv.y : q == 2 ? prv.z : prv.w, cc = q == 0 ? cur.x : q == 1 ? cur.y : q == 2 ? cur.z : cur.w, nc = q == 0 ? nxt.x : q == 1 ? nxt.y : q == 2 ? nxt.z : nxt.w;
                const int ch = wc + 2 * q;
                rr[2 * q] = bflo(pc) * in[IN_CHW][ch] + bflo(cc) * in[IN_CHW][3072 + ch] + bflo(nc) * in[IN_CHW][6144 + ch] + in[IN_CHB][ch];
                rr[2 * q + 1] = bfhi(pc) * in[IN_CHW][ch + 1] + bfhi(cc) * in[IN_CHW][3072 + ch + 1] + bfhi(nc) * in[IN_CHW][6144 + ch + 1] + in[IN_CHB][ch + 1];
            }
        }
#pragma unroll
        for (int q = 0; q < 8; ++q) tl[(cg * 8 + q) * 65 + tt] = r1[q] * r2[q];
    }
    __syncthreads();
    for (int i = F.tid; i < 256 * 16; i += NT) { const int c = i >> 4, tq = (i & 15) * 4; const LAS float* s = tl + c * 65 + tq;
        *(f32x4*)(uT + (size_t)(cb + c) * L + t0 + tq) = (f32x4){s[0], s[1], s[2], s[3]}; }
    __syncthreads();
}

#ifndef FFT_LAS
#define FFT_LAS LAS
#endif
#if defined(__HIP_DEVICE_COMPILE__)
#define FFT_OPAQUE(v) asm volatile("" : "+v"(v))
#else
#define FFT_OPAQUE(v)
#endif
constexpr int FN = 16384;
constexpr int FFT_SLOTS = 17920;
__host__ __device__ __forceinline__ int fphys(int p) { return p + (p >> 4) + ((p >> 9) << 4); }
__host__ __device__ __forceinline__ float fcos32(int k) {
    constexpr float T[16] = {1.0f, 0.98078528040323043f, 0.92387953251128674f, 0.83146961230254524f, 0.70710678118654752f, 0.55557023301960218f, 0.38268343236508977f, 0.19509032201612825f,
                             0.0f, -0.19509032201612825f, -0.38268343236508977f, -0.55557023301960218f, -0.70710678118654752f, -0.83146961230254524f, -0.92387953251128674f, -0.98078528040323043f};
    return T[k]; }
__host__ __device__ __forceinline__ float fsin32(int k) {
    constexpr float T[16] = {0.0f, 0.19509032201612825f, 0.38268343236508977f, 0.55557023301960218f, 0.70710678118654752f, 0.83146961230254524f, 0.92387953251128674f, 0.98078528040323043f,
                             1.0f, 0.98078528040323043f, 0.92387953251128674f, 0.83146961230254524f, 0.70710678118654752f, 0.55557023301960218f, 0.38268343236508977f, 0.19509032201612825f};
    return T[k]; }
template <int R> __host__ __device__ __forceinline__ constexpr int fbrev(int x) { int r = 0; for (int b = 1; b < R; b <<= 1) { r = (r << 1) | (x & 1); x >>= 1; } return r; }
template <int R, bool INV>
__host__ __device__ __forceinline__ void fft_reg(float (&xr)[R], float (&xi)[R]) {
#pragma unroll
    for (int len = R; len >= 2; len >>= 1) {
        const int half = len >> 1;
#pragma unroll
        for (int blk = 0; blk < R; blk += len)
#pragma unroll
            for (int k = 0; k < half; ++k) {
                const int i0 = blk + k, i1 = i0 + half;
                const float ar = xr[i0], ai = xi[i0], br = xr[i1], bi = xi[i1];
                xr[i0] = ar + br; xi[i0] = ai + bi;
                const float dr = ar - br, di = ai - bi;
                if (k == 0) { xr[i1] = dr; xi[i1] = di; }
                else if (4 * k == len) { if (!INV) { xr[i1] = di; xi[i1] = -dr; } else { xr[i1] = -di; xi[i1] = dr; } }
                else { const float c = fcos32(k * (32 / len)), s = fsin32(k * (32 / len));
                    if (!INV) { xr[i1] = dr * c + di * s; xi[i1] = di * c - dr * s; } else { xr[i1] = dr * c - di * s; xi[i1] = di * c + dr * s; } }
            }
    }
}
__host__ __device__ __forceinline__ void ftw(int num, int den, float& c, float& s) {
#if defined(__HIP_DEVICE_COMPILE__)
    sincospif(2.0f * (float)num / (float)den, &s, &c);
#else
    const double a = 6.283185307179586476925 * (double)num / (double)den; c = (float)cos(a); s = (float)sin(a);
#endif
}
template <int R, int M>
__host__ __device__ __forceinline__ void fft_fwd_bfly(FFT_LAS float* buf, int B, int j) {
    constexpr int S = M / R;
    float xr[R], xi[R];
#pragma unroll
    for (int q = 0; q < R; ++q) { const f32x2 v = *(const FFT_LAS f32x2*)(buf + 2 * fphys(B + j + q * S)); xr[q] = v.x; xi[q] = v.y; }
    fft_reg<R, false>(xr, xi);
    if (S > 1) { float c1, s1; ftw(j, M, c1, s1); float wr = c1, wi = -s1;
#pragma unroll
        for (int r = 1; r < R; ++r) { const int ix = fbrev<R>(r); const float tr = xr[ix] * wr - xi[ix] * wi, ti = xr[ix] * wi + xi[ix] * wr; xr[ix] = tr; xi[ix] = ti;
            const float nr = wr * c1 + wi * s1, ni = wi * c1 - wr * s1; wr = nr; wi = ni; } }
    int j2 = B + j; FFT_OPAQUE(j2);
#pragma unroll
    for (int r = 0; r < R; ++r) { const int ix = fbrev<R>(r); *(FFT_LAS f32x2*)(buf + 2 * fphys(j2 + r * S)) = (f32x2){xr[ix], xi[ix]}; }
}
template <int R, int M>
__host__ __device__ __forceinline__ void fft_inv_bfly(FFT_LAS float* buf, int B, int j) {
    constexpr int S = M / R;
    float xr[R], xi[R];
    if (S > 1) { float c1, s1; ftw(j, M, c1, s1); float wr = 1.0f, wi = 0.0f;
#pragma unroll
        for (int g = 0; g < R; g += 8) {
#pragma unroll
            for (int r = g; r < g + 8; ++r) { const f32x2 v = *(const FFT_LAS f32x2*)(buf + 2 * fphys(B + j + r * S)); xr[r] = v.x; xi[r] = v.y; }
#pragma unroll
            for (int r = g; r < g + 8; ++r) { const float tr = xr[r] * wr - xi[r] * wi, ti = xr[r] * wi + xi[r] * wr; xr[r] = tr; xi[r] = ti;
                const float nr = wr * c1 - wi * s1, ni = wi * c1 + wr * s1; wr = nr; wi = ni; }
#if defined(__HIP_DEVICE_COMPILE__)
            __builtin_amdgcn_sched_barrier(0);
#endif
        } }
    else {
#pragma unroll
        for (int r = 0; r < R; ++r) { const f32x2 v = *(const FFT_LAS f32x2*)(buf + 2 * fphys(B + j + r * S)); xr[r] = v.x; xi[r] = v.y; } }
    fft_reg<R, true>(xr, xi);
    int j2 = B + j; FFT_OPAQUE(j2);
#pragma unroll
    for (int q = 0; q < R; ++q) { const int ix = fbrev<R>(q); *(FFT_LAS f32x2*)(buf + 2 * fphys(j2 + q * S)) = (f32x2){xr[ix], xi[ix]}; }
}
__host__ __device__ __forceinline__ void fft_fwd_pass(FFT_LAS float* buf, int pass, int tid) {
    FFT_OPAQUE(tid);
    if (pass == 0) fft_fwd_bfly<32, 16384>(buf, 0, tid);
    else if (pass == 1) fft_fwd_bfly<32, 512>(buf, (tid >> 4) * 512, tid & 15);
    else { fft_fwd_bfly<16, 16>(buf, tid * 16, 0); fft_fwd_bfly<16, 16>(buf, (tid + 512) * 16, 0); }
}
__host__ __device__ __forceinline__ void fft_inv_pass(FFT_LAS float* buf, int pass, int tid) {
    FFT_OPAQUE(tid);
    if (pass == 0) { fft_inv_bfly<16, 16>(buf, tid * 16, 0); fft_inv_bfly<16, 16>(buf, (tid + 512) * 16, 0); }
    else if (pass == 1) fft_inv_bfly<32, 512>(buf, (tid >> 4) * 512, tid & 15);
    else fft_inv_bfly<32, 16384>(buf, 0, tid);
}
__host__ __device__ __forceinline__ int fpos(int k) { return ((k & 31) << 9) | (((k >> 5) & 31) << 4) | (k >> 10); }
__host__ __device__ __forceinline__ void fft_grab_spectrum(const FFT_LAS float* buf, int tid, float (&kr)[33], float (&ki)[33]) {
    FFT_OPAQUE(tid);
#pragma unroll
    for (int m = 0; m < 16; ++m) { const int k = tid + 512 * m, k2 = (FN - k) & (FN - 1);
        const f32x2 a = *(const FFT_LAS f32x2*)(buf + 2 * fphys(fpos(k))), b = *(const FFT_LAS f32x2*)(buf + 2 * fphys(fpos(k2)));
        kr[2 * m] = a.x; ki[2 * m] = a.y; kr[2 * m + 1] = b.x; ki[2 * m + 1] = b.y; }
    const f32x2 h = *(const FFT_LAS f32x2*)(buf + 2 * fphys(fpos(FN / 2))); kr[32] = h.x; ki[32] = h.y;
}
__host__ __device__ __forceinline__ void fft_mul_one(FFT_LAS float* buf, int k, float cr, float ci, float dr_, float di_, float wc, float ws) {
    const int k2 = (FN - k) & (FN - 1);
    FFT_LAS f32x2* pa = (FFT_LAS f32x2*)(buf + 2 * fphys(fpos(k))); FFT_LAS f32x2* pb = (FFT_LAS f32x2*)(buf + 2 * fphys(fpos(k2)));
    const f32x2 A = *pa, Bm = *pb;
    const float ar = A.x, ai = A.y, br = Bm.x, bi = -Bm.y, dr = dr_, di = -di_;
    const float uer = 0.5f * (ar + br), uei = 0.5f * (ai + bi), uor = 0.5f * (ai - bi), uoi = -0.5f * (ar - br);
    const float ker = 0.5f * (cr + dr), kei = 0.5f * (ci + di), kor = 0.5f * (ci - di), koi = -0.5f * (cr - dr);
    const float pr = uor * kor - uoi * koi, pi = uor * koi + uoi * kor;
    const float yer = (uer * ker - uei * kei) + (pr * wc + pi * ws), yei = (uer * kei + uei * ker) + (pi * wc - pr * ws);
    const float yor = (uer * kor - uei * koi) + (uor * ker - uoi * kei), yoi = (uer * koi + uei * kor) + (uor * kei + uoi * ker);
    *pa = (f32x2){yer - yoi, yei + yor};
    *pb = (f32x2){yer + yoi, -yei + yor};
}
__host__ __device__ __forceinline__ void fft_multiply(FFT_LAS float* buf, int tid, const float (&kr)[33], const float (&ki)[33]) {
    FFT_OPAQUE(tid);
    float c1, s1; ftw(tid, FN, c1, s1);
#pragma unroll
    for (int m = 0; m < 16; ++m) { const float cm = fcos32(m), sm = fsin32(m); const float wc = c1 * cm - s1 * sm, ws = s1 * cm + c1 * sm;
        fft_mul_one(buf, tid + 512 * m, kr[2 * m], ki[2 * m], kr[2 * m + 1], ki[2 * m + 1], wc, ws); }
    if (tid == 0) fft_mul_one(buf, FN / 2, kr[32], ki[32], kr[32], ki[32], -1.0f, 0.0f);
}

__device__ __forceinline__ void p4_fft_job(Frame& F, int job) {
    const float* const* in = F.in;
    int tid_ = F.tid, lane_ = F.lane; FFT_OPAQUE(tid_); FFT_OPAQUE(lane_);
    const int tid = tid_, lane = lane_, wave = F.wave, c0 = job * 4;
    LAS float* buf = (LAS float*)F.lds;
    LAS float* scr = (LAS float*)(F.lds + FFTSCR_OFF);
    float* hfT = (float*)(F.ws + WS_KF); float* hbT = (float*)(F.ws + WS_KB); const float* uT = (const float*)(F.ws + WS_UIN);
    {
        const bf16* hd = (const bf16*)(F.ws + WS_HDN);
        const int n = lane & 15, kq = lane >> 4, ch = (n >> 1) & 3, dir = n & 1, col = dir * 1024 + c0 + ch; const bool valid = n < 8;
        bf16x8 bfr[2];
#pragma unroll
        for (int ks = 0; ks < 2; ++ks) { unsigned w[4];
#pragma unroll
            for (int j = 0; j < 4; ++j) { const int k = ks * 32 + kq * 8 + 2 * j; const float a = valid ? in[IN_FW3][(size_t)k * 2048 + col] : 0.f, b = valid ? in[IN_FW3][(size_t)(k + 1) * 2048 + col] : 0.f; w[j] = cvt_pk_bf16(a, b); }
            bfr[ks] = __builtin_bit_cast(bf16x8, (v4u){w[0], w[1], w[2], w[3]}); }
        const float b3 = valid ? in[IN_FB3][col] : 0.f;
        const float r_slow = 3.0701134573253945f, r_fast = 15.350567286626972f;
        const float rate = r_slow + (float)(c0 + ch) * ((r_fast - r_slow) / 1023.0f);
        float asum = 0.f; float* dst = (dir ? hbT : hfT) + (size_t)(c0 + ch) * L;
#pragma unroll 1
        for (int tb = wave * 8; tb < L / 16; tb += NWAVES * 8) {
            bf16x8 a0[8], a1[8];
#pragma unroll
            for (int i = 0; i < 8; ++i) { const bf16* hp = hd + (size_t)((tb + i) * 16 + n) * 64 + kq * 8; a0[i] = *(const bf16x8*)hp; a1[i] = *(const bf16x8*)(hp + 32); }
#pragma unroll
            for (int i = 0; i < 8; ++i) { const int t0 = (tb + i) * 16;
                f32x4 acc = (f32x4){b3, b3, b3, b3};
                acc = __builtin_amdgcn_mfma_f32_16x16x32_bf16(a0[i], bfr[0], acc, 0, 0, 0);
                acc = __builtin_amdgcn_mfma_f32_16x16x32_bf16(a1[i], bfr[1], acc, 0, 0, 0);
                if (valid) { f32x4 o;
#pragma unroll
                    for (int r = 0; r < 4; ++r) { const int t = t0 + 4 * kq + r; const float t01 = (float)t / (float)(L - 1); const float v = acc[r] * __expf(-t01 * rate); o[r] = v; if (!(dir && t == 0)) asum += fabsf(v); }
                    *(f32x4*)(dst + t0 + 4 * kq) = o; } }
        }
        asum += __shfl_xor(asum, 16); asum += __shfl_xor(asum, 32);
        if (lane < 8) scr[wave * 8 + lane] = asum;
        VM_WAIT(); __syncthreads();
        float tot = 0.f;
        if (tid < 4) { for (int w = 0; w < 8; ++w) tot += scr[w * 8 + 2 * tid] + scr[w * 8 + 2 * tid + 1]; }
        __syncthreads();
        if (tid < 4) scr[tid] = 1.0f / (tot * (float)FN);
        __syncthreads();
    }
#pragma unroll 1
    for (int ch = 0; ch < 4; ++ch) {
        const int c = c0 + ch;
        const float* hf = hfT + (size_t)c * L; const float* hb = hbT + (size_t)c * L; const float* uc = uT + (size_t)c * L;
#pragma unroll 8
        for (int i = 0; i < 16; ++i) { const int a = tid + NT * i; const f32x2 v = *(const f32x2*)(hf + 2 * a); *(LAS f32x2*)(buf + 2 * fphys(a)) = v; }
#pragma unroll 8
        for (int i = 0; i < 16; ++i) { const int a = FN / 2 + tid + NT * i; const float ko = hb[2 * FN - 2 * a - 1]; float ke = hb[2 * FN - 2 * a]; if (a == FN / 2) ke = 0.f;
            *(LAS f32x2*)(buf + 2 * fphys(a)) = (f32x2){ke, ko}; }
        __syncthreads();
        fft_fwd_pass(buf, 0, tid); __syncthreads(); fft_fwd_pass(buf, 1, tid); __syncthreads(); fft_fwd_pass(buf, 2, tid); __syncthreads();
        {
            int tq = tid; FFT_OPAQUE(tq);
            f32x2* sa = (f32x2*)(hfT + (size_t)c * L); f32x2* sb = (f32x2*)(hbT + (size_t)c * L);
#pragma unroll 4
            for (int m = 0; m < 16; ++m) { const int k = tq + 512 * m, k2 = (FN - k) & (FN - 1);
                sa[m * 512 + tq] = *(const LAS f32x2*)(buf + 2 * fphys(fpos(k))); sb[m * 512 + tq] = *(const LAS f32x2*)(buf + 2 * fphys(fpos(k2))); }
            if (tid == 0) { const f32x2 h = *(const LAS f32x2*)(buf + 2 * fphys(fpos(FN / 2))); scr[8] = h.x; scr[9] = h.y; }
        }
        __syncthreads();
#pragma unroll 8
        for (int i = 0; i < 16; ++i) { const int a = tid + NT * i; const f32x2 v = *(const f32x2*)(uc + 2 * a); *(LAS f32x2*)(buf + 2 * fphys(a)) = v; }
#pragma unroll 4
        for (int i = 0; i < 16; ++i) { const int a = FN / 2 + tid + NT * i; *(LAS f32x2*)(buf + 2 * fphys(a)) = (f32x2){0.f, 0.f}; }
        __syncthreads();
        fft_fwd_pass(buf, 0, tid); __syncthreads(); fft_fwd_pass(buf, 1, tid); __syncthreads(); fft_fwd_pass(buf, 2, tid); __syncthreads();
        {   int tq = tid; FFT_OPAQUE(tq);
            const f32x2* sa = (const f32x2*)(hfT + (size_t)c * L); const f32x2* sb = (const f32x2*)(hbT + (size_t)c * L);
            float c1, s1; ftw(tq, FN, c1, s1);
#pragma unroll 8
            for (int m = 0; m < 16; ++m) { const float cm = fcos32(m), sm = fsin32(m); const float wc = c1 * cm - s1 * sm, ws = s1 * cm + c1 * sm;
                const f32x2 ka = sa[m * 512 + tq], kb = sb[m * 512 + tq];
                fft_mul_one(buf, tq + 512 * m, ka.x, ka.y, kb.x, kb.y, wc, ws); }
            if (tid == 0) fft_mul_one(buf, FN / 2, scr[8], scr[9], scr[8], scr[9], -1.0f, 0.0f);
        }
        VM_WAIT(); __syncthreads();
        fft_inv_pass(buf, 0, tid); __syncthreads(); fft_inv_pass(buf, 1, tid); __syncthreads(); fft_inv_pass(buf, 2, tid); __syncthreads();
        { const float sc = scr[ch]; float* yT = hfT + (size_t)c * L;
#pragma unroll 2
            for (int nn = tid; nn < FN / 2; nn += NT) { const f32x2 v = *(const LAS f32x2*)(buf + 2 * fphys(nn)); *(f32x2*)(yT + 2 * nn) = (f32x2){v.x * sc, v.y * sc}; } }
        __syncthreads();
    }
    VM_WAIT(); __syncthreads();
    {
        const bf16* z = (const bf16*)(F.ws + WS_Z); bf16* cat = (bf16*)(F.ws + WS_CAT);
        float w0[4], w1[4], w2[4], bb[4], dsk[4];
#pragma unroll
        for (int q = 0; q < 4; ++q) { w0[q] = in[IN_CHW][c0 + q]; w1[q] = in[IN_CHW][3072 + c0 + q]; w2[q] = in[IN_CHW][6144 + c0 + q]; bb[q] = in[IN_CHB][c0 + q]; dsk[q] = in[IN_DSKIP][c0 + q]; }
#pragma unroll 4
        for (int t = tid; t < L; t += NT) {
            const v2u zc = *(const v2u*)(z + (size_t)t * NINP + OFF_HY + c0);
            const v2u zp = t > 0 ? *(const v2u*)(z + (size_t)(t - 1) * NINP + OFF_HY + c0) : (v2u){0u, 0u};
            const v2u zn = t < L - 1 ? *(const v2u*)(z + (size_t)(t + 1) * NINP + OFF_HY + c0) : (v2u){0u, 0u};
            const float pv[4] = {bflo(zp.x), bfhi(zp.x), bflo(zp.y), bfhi(zp.y)}, cv[4] = {bflo(zc.x), bfhi(zc.x), bflo(zc.y), bfhi(zc.y)}, nv[4] = {bflo(zn.x), bfhi(zn.x), bflo(zn.y), bfhi(zn.y)};
            float o[4];
#pragma unroll
            for (int q = 0; q < 4; ++q) { const float y = hfT[(size_t)(c0 + q) * L + t] + dsk[q] * uT[(size_t)(c0 + q) * L + t];
                o[q] = (pv[q] * w0[q] + cv[q] * w1[q] + nv[q] * w2[q] + bb[q]) * y; }
            v2u w; w.x = cvt_pk_bf16(o[0], o[1]); w.y = cvt_pk_bf16(o[2], o[3]);
            *(v2u*)(cat + (size_t)t * D + MVW + c0) = w;
        }
    }
    __syncthreads();
}
__device__ __forceinline__ void p6_norm2_router(Frame& F) {
    const float* const* in = F.in;
    const float* mod = (const float*)(F.ws + WS_MOD);
    bf16* h2 = (bf16*)(F.ws + WS_HA);
    int* cnt = (int*)(F.ws + WS_CTL) + CW_CNT;
    int* aexp = (int*)(F.ws + WS_AEXP); int* arank = (int*)(F.ws + WS_ARANK); float* aw = (float*)(F.ws + WS_AW);
    LAS float* hrow = (LAS float*)F.lds + F.wave * 2048;
    LAS float* wch = (LAS float*)(F.lds + 65536);
    const int lane = F.lane;
    for (int t0 = F.bid * 8; t0 < L; t0 += F.G * 8) {
        const int t = t0 + F.wave;
        {
            f32x4 v[8]; float ss = 0.f;
#pragma unroll
            for (int j = 0; j < 8; ++j) { const int col = 4 * lane + 256 * j; v[j] = *(const f32x4*)(F.out + (size_t)t * D + col); ss += (v[j].x * v[j].x + v[j].y * v[j].y) + (v[j].z * v[j].z + v[j].w * v[j].w); }
            const float rstd = rsqrtf(wave_sum(ss) * (1.0f / D) + EPS);
#pragma unroll
            for (int j = 0; j < 8; ++j) { const int col = 4 * lane + 256 * j;
                const f32x4 g = *(const f32x4*)(in[IN_GFFN] + col), sh = *(const f32x4*)(mod + 6144 + col), sc = *(const f32x4*)(mod + 8192 + col);
                const f32x4 h = (v[j] * rstd * g) * (sc + 1.0f) + sh;
                *(LAS f32x4*)(hrow + col) = h;
                v2u o; o.x = cvt_pk_bf16(h.x, h.y); o.y = cvt_pk_bf16(h.z, h.w);
                *(v2u*)(h2 + (size_t)t * D + col) = o; }
        }
        float logit = 0.f;
        for (int ch = 0; ch < 8; ++ch) {
            __syncthreads();
            for (int i = F.tid; i < 4096; i += NT) *(LAS f32x4*)(wch + 4 * i) = *(const f32x4*)(in[IN_WR] + (size_t)ch * 16384 + 4 * i);
            __syncthreads();
            const LAS float* hr = hrow + ch * 256;
#pragma unroll 4
            for (int i = 0; i < 256; i += 4) { const f32x4 hv = *(const LAS f32x4*)(hr + i);
                logit += hv.x * wch[(i + 0) * 64 + lane]; logit += hv.y * wch[(i + 1) * 64 + lane]; logit += hv.z * wch[(i + 2) * 64 + lane]; logit += hv.w * wch[(i + 3) * 64 + lane]; }
        }
        const float s = 1.0f / (1.0f + expf(-logit)), sel = s + in[IN_BR][lane];
        const int grp = lane >> 3;
        float m1 = sel; m1 = fmaxf(m1, __shfl_xor(m1, 1)); m1 = fmaxf(m1, __shfl_xor(m1, 2)); m1 = fmaxf(m1, __shfl_xor(m1, 4));
        const unsigned long long gm = 0xFFull << (8 * grp);
        const unsigned long long b1 = __ballot(sel == m1) & gm;
        const int first = __ffsll((long long)b1) - 1;
        float m2 = (lane == first) ? -INFINITY : sel; m2 = fmaxf(m2, __shfl_xor(m2, 1)); m2 = fmaxf(m2, __shfl_xor(m2, 2)); m2 = fmaxf(m2, __shfl_xor(m2, 4));
        const float gs = m1 + m2;
        int grank = 0;
#pragma unroll
        for (int g = 0; g < 8; ++g) { const float og = __shfl(gs, 8 * g); grank += (og > gs || (og == gs && g < grp)) ? 1 : 0; }
        const float masked = grank < 4 ? sel : -INFINITY;
        int rank = 0;
        for (int e2 = 0; e2 < 64; ++e2) { const float om = __shfl(masked, e2); rank += (om > masked || (om == masked && e2 < lane)) ? 1 : 0; }
        const bool chosen = rank < 8;
        const float wsum = wave_sum(chosen ? s : 0.f);
        const unsigned long long cb = __ballot(chosen);
        if (chosen) {
            const int k = (int)__builtin_amdgcn_mbcnt_hi((unsigned)(cb >> 32), __builtin_amdgcn_mbcnt_lo((unsigned)cb, 0u));
            const int half = t >= HALF_T ? 1 : 0;
            const int r = atomicAdd(cnt + half * 64 + lane, 1);
            aexp[t * 8 + k] = lane; arank[t * 8 + k] = r; aw[t * 8 + k] = s / wsum * 2.5f;
        }
    }
    __syncthreads();
}
__device__ __forceinline__ void build_pstart(Frame& F) {
    LAS int* ps = (LAS int*)(F.lds + LDSCTL_OFF);
    const int* cnt = (const int*)(F.ws + WS_CTL) + CW_CNT;
    __syncthreads();
    if (F.tid < 2) { int a = 0;
        for (int e = 0; e < NE; ++e) { ps[F.tid * 66 + e] = a; a += (__hip_atomic_load(cnt + F.tid * 64 + e, __ATOMIC_RELAXED, __HIP_MEMORY_SCOPE_AGENT) + 255) & ~255; }
        ps[F.tid * 66 + 64] = a; ps[F.tid * 66 + 65] = a + HALF_T; }
    __syncthreads();
}
__device__ __forceinline__ void p7_fill_rows(Frame& F) {
    build_pstart(F);
    const LAS int* ps = (const LAS int*)(F.lds + LDSCTL_OFF);
    const int* aexp = (const int*)(F.ws + WS_AEXP); const int* arank = (const int*)(F.ws + WS_ARANK); const float* aw = (const float*)(F.ws + WS_AW);
    int* rt = (int*)(F.ws + WS_RTOK); float* rw = (float*)(F.ws + WS_RW);
    const int gt = F.bid * NT + F.tid, NGT = F.G * NT;
    for (int i = gt; i < L * 8; i += NGT) { const int t = i >> 3, h = t >= HALF_T ? 1 : 0; const int row = ps[h * 66 + aexp[i]] + arank[i];
        rt[h * MAXROWS + row] = t; rw[h * MAXROWS + row] = aw[i]; }
    for (int t = gt; t < L; t += NGT) { const int h = t >= HALF_T ? 1 : 0; const int row = ps[h * 66 + 64] + (t - h * HALF_T);
        rt[h * MAXROWS + row] = t; rw[h * MAXROWS + row] = 1.0f; }
}
__device__ __forceinline__ void moe_combine(Frame& F, int half) {
    const float* const* in = F.in;
    const LAS int* ps = (const LAS int*)(F.lds + LDSCTL_OFF) + half * 66;
    const float* mod = (const float*)(F.ws + WS_MOD);
    const int* aexp = (const int*)(F.ws + WS_AEXP); const int* arank = (const int*)(F.ws + WS_ARANK);
    const bf16* Y2 = (const bf16*)(F.ws + WS_Y2);
    const int gw = F.bid * NWAVES + F.wave, NGW = F.G * NWAVES, lane = F.lane;
    for (int tt = gw; tt < HALF_T; tt += NGW) {
        const int t = half * HALF_T + tt;
        float a[32];
#pragma unroll
        for (int i = 0; i < 32; ++i) a[i] = 0.f;
#pragma unroll 3
        for (int k = 0; k < 9; ++k) {
            const int row = k < 8 ? ps[aexp[t * 8 + k]] + arank[t * 8 + k] : ps[64] + tt;
            const bf16* yr = Y2 + (size_t)row * D + 8 * lane;
#pragma unroll
            for (int j = 0; j < 4; ++j) { const v4u y = *(const v4u*)(yr + 512 * j);
                a[8 * j + 0] += bflo(y.x); a[8 * j + 1] += bfhi(y.x); a[8 * j + 2] += bflo(y.y); a[8 * j + 3] += bfhi(y.y);
                a[8 * j + 4] += bflo(y.z); a[8 * j + 5] += bfhi(y.z); a[8 * j + 6] += bflo(y.w); a[8 * j + 7] += bfhi(y.w); }
        }
        float ss = 0.f;
#pragma unroll
        for (int j = 0; j < 4; ++j)
#pragma unroll
            for (int q = 0; q < 2; ++q) { const int col = 8 * lane + 512 * j + 4 * q;
                const f32x4 x1 = *(const f32x4*)(F.out + (size_t)t * D + col), g2 = *(const f32x4*)(mod + 10240 + col);
                const int i = 8 * j + 4 * q;
                a[i] = x1.x + g2.x * a[i]; a[i + 1] = x1.y + g2.y * a[i + 1]; a[i + 2] = x1.z + g2.z * a[i + 2]; a[i + 3] = x1.w + g2.w * a[i + 3];
                ss += (a[i] * a[i] + a[i + 1] * a[i + 1]) + (a[i + 2] * a[i + 2] + a[i + 3] * a[i + 3]); }
        const float rstd = rsqrtf(wave_sum(ss) * (1.0f / D) + EPS);
#pragma unroll
        for (int j = 0; j < 4; ++j)
#pragma unroll
            for (int q = 0; q < 2; ++q) { const int col = 8 * lane + 512 * j + 4 * q; const int i = 8 * j + 4 * q;
                const f32x4 gf = *(const f32x4*)(in[IN_GFIN] + col);
                *(f32x4*)(F.out + (size_t)t * D + col) = (f32x4){a[i] * rstd * gf.x, a[i + 1] * rstd * gf.y, a[i + 2] * rstd * gf.z, a[i + 3] * rstd * gf.w}; }
    }
}

constexpr int N_PHASES = 14;
__global__ void __launch_bounds__(NT, 2) fwd_kernel(Args args) {
    extern __shared__ __attribute__((aligned(16))) unsigned char lds_raw[];
    Frame F;
    F.lds = (LAS unsigned char*)lds_raw;
    F.tid = threadIdx.x; F.lane = F.tid & 63; F.wave = __builtin_amdgcn_readfirstlane(F.tid >> 6);
    F.bid = blockIdx.x; F.G = gridDim.x;
    F.in = args.in; F.out = args.out; F.ws = args.ws;
    volatile LAS unsigned* MISC = (volatile LAS unsigned*)(F.lds + LDSCTL_OFF + 768);
    if (F.tid < 64) ((LAS unsigned*)(F.lds + LDSCTL_OFF))[F.tid + 192] = 0u;
    __syncthreads();
    unsigned* ctl = (unsigned*)(F.ws + WS_CTL);
    const int lo = args.ph_lo, hi = args.ph_hi;
    XcdBarrier bar; bar.bar = ctl + CW_BAR; bar.x = 0; bar.st = nullptr;
    if (hi - lo > 1) bar = xcd_barrier_post(ctl + CW_BAR, MISC + 8);
#ifndef PH_MASK
#define PH_MASK 0xFFFF
#endif
#define IN(k) (((PH_MASK >> (k)) & 1) && lo <= (k) && (k) < hi)
#define SEAM(k) do { if (IN(k) && IN((k) + 1)) xcd_barrier(bar); } while (0)
#define REP(k) for (int rep_ = 0; rep_ < ((PROBE_DUP) == (k) ? 2 : 1); ++rep_) if ((rep_ ? __syncthreads() : (void)0), true)
    LAS int* ps = (LAS int*)(F.lds + LDSCTL_OFF);

    if (IN(0)) REP(0) { p0_prologue(F); } SEAM(0);
    if (IN(1)) REP(1) { p1_norm1(F); } SEAM(1);
    if (IN(2)) {
        gk::DenseOrder S; S.init(MROWS, NINP, D, F.G, F.bid); S.Bt = (const char*)(F.ws + WS_WIN);
        gk::EpiBf16Store E{(bf16*)(F.ws + WS_Z), NINP};
        gk::gemm_core(F.lds, (const char*)(F.ws + WS_HA), D, S, E);
    }
#if PROBE_DUP == 2
    if (IN(2)) { __syncthreads(); } if (IN(2)) {
        gk::DenseOrder S; S.init(MROWS, NINP, D, F.G, F.bid); S.Bt = (const char*)(F.ws + WS_WIN);
        gk::EpiBf16Store E{(bf16*)(F.ws + WS_Z), NINP};
        gk::gemm_core(F.lds, (const char*)(F.ws + WS_HA), D, S, E);
    }
#endif
    SEAM(2);
    if (IN(3)) REP(3) {
        for (int it = F.bid; it < 1040; it += F.G) ml_prep_item(F, it);
        for (int tile = F.bid; tile < 256; tile += F.G) p3_filter_tile(F, tile);
        for (int tile = F.bid; tile < 1024; tile += F.G) p3_uin_tile(F, tile);
    } SEAM(3);
    if (IN(4)) REP(4) { ml_scan(F); } SEAM(4);
    if (IN(5)) {
        for (int job = F.bid; job < 256; job += F.G) p4_fft_job(F, job);
#if PROBE_DUP == 50
        __syncthreads(); for (int job = F.bid; job < 256; job += F.G) p4_fft_job(F, job);
#endif
        for (int it = F.bid; it < 1024; it += F.G) ml_out_item(F, it);
#if PROBE_DUP == 51
        __syncthreads(); for (int it = F.bid; it < 1024; it += F.G) ml_out_item(F, it);
#endif
    } SEAM(5);
    if (IN(6)) {
        gk::DenseOrder S; S.init(L, D, D, F.G, F.bid); S.Bt = (const char*)(F.ws + WS_WOUT);
        gk::EpiResidual E{F.out, D, (const float*)(F.ws + WS_MOD) + 4096};
        gk::gemm_core(F.lds, (const char*)(F.ws + WS_CAT), D, S, E);
    } SEAM(6);
    if (IN(7)) { p6_norm2_router(F); } SEAM(7);
    if (IN(8)) { p7_fill_rows(F); } SEAM(8);
#define MOE_GU(h) do { build_pstart(F); \
        gk::GroupOrder<4, true> S; S.ntile = ps[(h) * 66 + 65] >> 8; S.G = F.G; S.c = F.bid; S.K = D; S.pstart = ps + (h) * 66; S.rtok = (const int*)(F.ws + WS_RTOK) + (h) * MAXROWS; \
        S.Bt = (const char*)(F.ws + WS_W13); S.bstride = (size_t)1024 * D * 2; \
        gk::EpiGateUp E{(bf16*)(F.ws + WS_HR)}; \
        gk::gemm_core(F.lds, (const char*)(F.ws + WS_HA), D, S, E); } while (0)
#define MOE_DN(h) do { build_pstart(F); \
        gk::GroupOrder<8, false> S; S.ntile = ps[(h) * 66 + 65] >> 8; S.G = F.G; S.c = F.bid; S.K = DE; S.pstart = ps + (h) * 66; S.rtok = nullptr; \
        S.Bt = (const char*)(F.ws + WS_W2); S.bstride = (size_t)D * DE * 2; \
        gk::EpiDown E{(bf16*)(F.ws + WS_Y2), (const float*)(F.ws + WS_RW) + (h) * MAXROWS}; \
        gk::gemm_core(F.lds, (const char*)(F.ws + WS_HR), DE, S, E); } while (0)
    if (IN(9)) REP(9) { MOE_GU(0); } SEAM(9);
    if (IN(10)) REP(10) { MOE_DN(0); } SEAM(10);
    if (IN(11)) { MOE_GU(1); moe_combine(F, 0); } SEAM(11);
    if (IN(12)) REP(12) { MOE_DN(1); } SEAM(12);
    if (IN(13)) { build_pstart(F); moe_combine(F, 1); }
#undef IN
#undef SEAM
}

extern "C" void kernel_launch(void* const* d_in, const int* in_sizes, int n_in, void* d_out, int out_size, void* d_ws, size_t ws_size, hipStream_t stream) {
    static int grid = 0;
    if (grid == 0) {
        if (n_in != 36 || out_size != L * D || ws_size < WS_END) { fprintf(stderr, "kernel_launch: unexpected shapes: n_in %d out %d ws %zu (need %zu)\n", n_in, out_size, ws_size, (size_t)WS_END); grid = -1; return; }
        int dev = 0, cus = 0, per_cu = 0;
        if (hipGetDevice(&dev) != hipSuccess || hipDeviceGetAttribute(&cus, hipDeviceAttributeMultiprocessorCount, dev) != hipSuccess) { grid = -1; return; }
        if (hipFuncSetAttribute((const void*)fwd_kernel, hipFuncAttributeMaxDynamicSharedMemorySize, LDS_BYTES) != hipSuccess) { fprintf(stderr, "kernel_launch: hipFuncSetAttribute failed\n"); grid = -1; return; }
        if (hipOccupancyMaxActiveBlocksPerMultiprocessor(&per_cu, (const void*)fwd_kernel, NT, LDS_BYTES) != hipSuccess || per_cu < 1) fprintf(stderr, "kernel_launch: occupancy query says %d\n", per_cu);
        (void)hipGetLastError();
        grid = cus;
    }
    if (grid < 0) return;
    if (hipMemsetAsync((char*)d_ws + WS_CTL, 0, CTL_ZERO_BYTES, stream) != hipSuccess) return;
    Args a{};
    for (int i = 0; i < 36; ++i) a.in[i] = (const float*)d_in[i];
    a.out = (float*)d_out; a.ws = (unsigned char*)d_ws;
    const int stop = MK_STOP_AFTER < N_PHASES ? MK_STOP_AFTER + 1 : N_PHASES;
#if MK_N_LAUNCHES == 1
    a.ph_lo = 0; a.ph_hi = stop;
    hipLaunchKernelGGL(fwd_kernel, dim3(grid), dim3(NT), LDS_BYTES, stream, a);
#else
    for (int p = 0; p < stop; ++p) { a.ph_lo = p; a.ph_hi = p + 1; hipLaunchKernelGGL(fwd_kernel, dim3(grid), dim3(NT), LDS_BYTES, stream, a); }
#endif
}
```

```cpp
#include <hip/hip_runtime.h>
#include <cstdio>
#include <cstdint>

#ifndef MK_N_LAUNCHES
#define MK_N_LAUNCHES 1
#endif
#ifndef PROBE_DUP
#define PROBE_DUP -1
#endif
#ifndef MK_STOP_AFTER
#define MK_STOP_AFTER 99
#endif

#define GAS __attribute__((address_space(1)))
#define LAS __attribute__((address_space(3)))
typedef unsigned short bf16;
typedef unsigned v4u __attribute__((ext_vector_type(4)));
typedef unsigned v2u __attribute__((ext_vector_type(2)));
typedef float f32x4 __attribute__((ext_vector_type(4)));
typedef float f32x2 __attribute__((ext_vector_type(2)));
typedef short bf16x8 __attribute__((ext_vector_type(8)));
#define LDS_WAIT() asm volatile("s_waitcnt lgkmcnt(0)" ::: "memory")
#define VM_WAIT() asm volatile("s_waitcnt vmcnt(0)" ::: "memory")

constexpr int NWAVES = 8, NT = NWAVES * 64;
constexpr int L = 16384, D = 2048, LC = 256, MROWS = L + LC;
constexpr int NIN = 6176, NINP = 6400;
constexpr int OFF_K = 0, OFF_V = 512, OFF_G = 1536, OFF_Q = 1568, OFF_O = 2080, OFF_HY = 3104;
constexpr int NH = 8, HYW = 1024, MVW = 1024;
constexpr int NE = 64, NE1 = 65, DE = 512;
constexpr int HALF_T = 8192;
constexpr int MAXROWS = 90112;
constexpr float EPS = 1e-6f;

constexpr size_t MiB = 1u << 20;
constexpr size_t WS_CTL = 0, CTL_ZERO_BYTES = 256 * 1024;
constexpr size_t WS_MOD = 1 * MiB;
constexpr size_t WS_POS = WS_MOD + 128 * 1024;
constexpr size_t WS_WIN = 3 * MiB;
constexpr size_t WS_WOUT = 28 * MiB;
constexpr size_t WS_W13 = 36 * MiB;
constexpr size_t WS_W2 = 296 * MiB;
constexpr size_t WS_HA = 426 * MiB;
constexpr size_t WS_Z = 491 * MiB;
constexpr size_t WS_CAT = 695 * MiB;
constexpr size_t WS_UIN = 759 * MiB;
constexpr size_t WS_KF = 823 * MiB;
constexpr size_t WS_KB = 887 * MiB;
constexpr size_t WS_CL = 426 * MiB;
constexpr size_t WS_CI = 951 * MiB;
constexpr size_t WS_Q = 983 * MiB;
constexpr size_t WS_K = 999 * MiB;
constexpr size_t WS_RTOK = 1015 * MiB;
constexpr size_t WS_RW = WS_RTOK + 2 * MAXROWS * 4;
constexpr size_t WS_AEXP = 1017 * MiB;
constexpr size_t WS_ARANK = WS_AEXP + 512 * 1024;
constexpr size_t WS_AW = WS_ARANK + 512 * 1024;
constexpr size_t WS_HDN = 1019 * MiB;
constexpr size_t WS_SC = 1021 * MiB;
constexpr size_t WS_NL = WS_SC + 32 * 1024;
constexpr size_t WS_NI = WS_NL + 640 * 1024;
constexpr size_t WS_MI = WS_NI + 640 * 1024;
constexpr size_t WS_END = 1023 * MiB;
constexpr size_t WS_HR = 491 * MiB;
constexpr size_t WS_Y2 = 579 * MiB;
static_assert(WS_Y2 + (size_t)MAXROWS * 2048 * 2 <= WS_CI, "overlay");
constexpr int CW_BAR = 4096;
constexpr int CW_CNT = 16384;

constexpr int RING_BYTES = 131072;
constexpr int LDSCTL_OFF = 147456;
constexpr int FFTSCR_OFF = LDSCTL_OFF + 1024;
constexpr int LDS_BYTES = 151552;

__device__ __forceinline__ unsigned cvt_pk_bf16(float lo, float hi) { unsigned r; asm volatile("v_cvt_pk_bf16_f32 %0, %1, %2" : "=v"(r) : "v"(lo), "v"(hi)); return r; }
__device__ __forceinline__ float bf2f(unsigned short b) { return __builtin_bit_cast(float, ((unsigned)b) << 16); }
__device__ __forceinline__ float bflo(unsigned u) { return __builtin_bit_cast(float, u << 16); }
__device__ __forceinline__ float bfhi(unsigned u) { return __builtin_bit_cast(float, u & 0xffff0000u); }
__device__ __forceinline__ float wave_sum(float v) {
#pragma unroll
    for (int o = 1; o < 64; o <<= 1) v += __shfl_xor(v, o);
    return v;
}
__device__ __forceinline__ float silu_f(float a) { return a / (1.f + __expf(-a)); }
__device__ __forceinline__ float sigmoid_f(float a) { return 1.f / (1.f + __expf(-a)); }

#define XB_TMO      128
#define XB_XCNT(j)  (256  + 64 * (j))
#define XB_XSUB(j)  (1280 + 64 * (j))
#define XB_XGEN(j)  (2304 + 64 * (j))
#define XB_TOP      3328
#define XB_TOPGEN   3392
#define XCD_BAR_WORDS 3456
#define XB_SPIN_CAP (1u << 18)

__device__ __forceinline__ unsigned xb_ld(unsigned* p)              { return __hip_atomic_load(p, __ATOMIC_RELAXED, __HIP_MEMORY_SCOPE_AGENT); }
__device__ __forceinline__ unsigned xb_add(unsigned* p, unsigned v) { return __hip_atomic_fetch_add(p, v, __ATOMIC_RELAXED, __HIP_MEMORY_SCOPE_AGENT); }
__device__ __forceinline__ unsigned xb_xcc_id() { return (unsigned)__builtin_amdgcn_s_getreg((3 << 11) | 20) & 0xFu; }
#define XB_SPIN(cond, bar) do { unsigned _sp = 0; while (cond) { __builtin_amdgcn_s_sleep(1); \
    if ((++_sp & 255u) == 0u) { if (xb_ld(&(bar)[XB_TMO])) break; if (_sp > XB_SPIN_CAP) { atomicAdd(&(bar)[XB_TMO], 1u); break; } } } } while (0)

struct XcdBarrier {
    unsigned* bar; unsigned x;
    volatile LAS unsigned* st;
};

__device__ __forceinline__ XcdBarrier xcd_barrier_post(unsigned* bar, volatile LAS unsigned* st) {
    XcdBarrier b; b.bar = bar; b.x = xb_xcc_id(); b.st = st;
    if (threadIdx.x == 0) (void)xb_add(&bar[XB_XCNT(b.x)], 1u);
    return b;
}
__device__ __forceinline__ void xcd_barrier_complete(unsigned* bar, unsigned x, unsigned& nloc, unsigned& nx) {
    const unsigned G = gridDim.x * gridDim.y * gridDim.z;
    unsigned sum, cnt, mine, sp = 0u;
    for (;;) {
        sum = 0u; cnt = 0u; mine = 0u;
#pragma unroll
        for (unsigned j = 0; j < 16; ++j) { const unsigned c = xb_ld(&bar[XB_XCNT(j)]); sum += c; cnt += (c > 0u) ? 1u : 0u; mine = (j == x) ? c : mine; }
        if (sum == G) break;
        __builtin_amdgcn_s_sleep(1);
        if ((++sp & 255u) == 0u) { if (xb_ld(&bar[XB_TMO])) break; if (sp > XB_SPIN_CAP) { atomicAdd(&bar[XB_TMO], 1u); break; } }
    }
    nloc = mine > 0u ? mine : 1u; nx = cnt > 0u ? cnt : 1u;
}

__device__ __forceinline__ void xcd_barrier(const XcdBarrier& b) {
    asm volatile("s_waitcnt vmcnt(0)" ::: "memory");
    __syncthreads();
    if (threadIdx.x == 0) {
        unsigned* bar = b.bar;
        __builtin_amdgcn_s_waitcnt(0);
        unsigned nloc = b.st[0], nx = b.st[1];
        if (nloc == 0u) { xcd_barrier_complete(bar, b.x, nloc, nx); b.st[0] = nloc; b.st[1] = nx; }
        const unsigned old = xb_add(&bar[XB_XSUB(b.x)], 1u);
        const unsigned gen = old / nloc;
        if (old + 1u == (gen + 1u) * nloc) {
            __builtin_amdgcn_fence(__ATOMIC_RELEASE, "agent");
            asm volatile("s_waitcnt vmcnt(0)" ::: "memory");
            const unsigned og = xb_add(&bar[XB_TOP], 1u);
            const unsigned tg = og / nx;
            if (og + 1u == (tg + 1u) * nx) xb_add(&bar[XB_TOPGEN], 1u);
            else XB_SPIN(xb_ld(&bar[XB_TOPGEN]) == tg, bar);
            __builtin_amdgcn_fence(__ATOMIC_ACQUIRE, "agent");
            xb_add(&bar[XB_XGEN(b.x)], 1u);
            asm volatile("s_waitcnt vmcnt(0)" ::: "memory");
        } else {
            XB_SPIN(xb_ld(&bar[XB_XGEN(b.x)]) == gen, bar);
            __builtin_amdgcn_fence(__ATOMIC_ACQUIRE, "agent");
            asm volatile("s_waitcnt vmcnt(0)" ::: "memory");
        }
    }
    __syncthreads();
}

namespace gk {
constexpr int BM = 256, BK = 64, HALF = 128, HTB = HALF * BK * 2, STAGE_BYTES = 8 * HTB, NXCD = 8, WGM = 8;
__host__ __device__ __forceinline__ int lds_byte(int r, int c) { const int st = (r >> 4) * 2 + (c >> 5), rr = r & 15, cc = c & 31, ob = rr * 64 + cc * 2; return st * 1024 + (ob ^ (((ob >> 9) & 1) << 5)); }
__host__ __device__ __forceinline__ void stage_rc(int b, int& R, int& C) { const int st = b / 1024, sb = b % 1024, swz = sb ^ (((sb >> 9) & 1) << 5); R = (st >> 1) * 16 + swz / 64; C = (st & 1) * 32 + (swz % 64) / 2; }
__host__ __device__ __forceinline__ int perm32(int rho) { const int n = rho >> 4, i = rho & 15; return 8 * (i >> 2) + 4 * n + (i & 3); }

struct Unit { int pm, pn, ex; };

template <class Epi, class Sched>
__device__ __forceinline__ void gemm_core(LAS unsigned char* lds, const char* Abase, const int K, const Sched& S, const Epi& E) {
    const int tid = threadIdx.x, wid = __builtin_amdgcn_readfirstlane(tid >> 6), lane = tid & 63, wr = wid >> 2, wc = wid & 3, fr = lane & 15, fq = lane >> 4;
    const int nt = K / BK;
    int RA[2], CA[2]; unsigned voffB[2];
#pragma unroll
    for (int i = 0; i < 2; ++i) { int R, C; stage_rc(tid * 16 + i * 8192, R, C); const int Rb = Epi::PERM ? ((R & ~31) + perm32(R & 31)) : R;
        RA[i] = R; CA[i] = C; voffB[i] = (unsigned)(Rb * K + C) * 2u; }
    const size_t kstep = (size_t)(BK * 2);
    const size_t hstepB = (size_t)HALF * K * 2;
    const unsigned ldsw = (unsigned)wid * 1024u;
    const int aoff = lds_byte(wr * 64 + fr, fq * 8), boff = lds_byte(wc * 32 + fr, fq * 8);
#define GK_SA(b, h) (((b) * 2 + (h)) * HTB)
#define GK_SB(b, h) ((4 + (b) * 2 + (h)) * HTB)
#define GK_STAGE(bufoff, gbase, v0, v1) do { \
        __builtin_amdgcn_global_load_lds((const unsigned*)((const char*)(gbase) + (v0)), (LAS unsigned*)(lds + (bufoff) + ldsw), 16, 0, 0); \
        __builtin_amdgcn_global_load_lds((const unsigned*)((const char*)(gbase) + (v1)), (LAS unsigned*)(lds + (bufoff) + ldsw + 8192), 16, 0, 0); } while (0)
#define GK_LDA(dst, b, h) do { _Pragma("unroll") for (int m = 0; m < 4; ++m) _Pragma("unroll") for (int k = 0; k < 2; ++k) dst[m][k] = *(const LAS bf16x8*)(lds + GK_SA(b, h) + aoff + m * 2048 + k * 1024); } while (0)
#define GK_LDB(dst, b, h) do { _Pragma("unroll") for (int n = 0; n < 2; ++n) _Pragma("unroll") for (int k = 0; k < 2; ++k) dst[n][k] = *(const LAS bf16x8*)(lds + GK_SB(b, h) + boff + n * 2048 + k * 1024); } while (0)
#define GK_MMA(ai, bj, At, Bt) do { __builtin_amdgcn_s_setprio(1); _Pragma("unroll") for (int m = 0; m < 4; ++m) _Pragma("unroll") for (int n = 0; n < 2; ++n) _Pragma("unroll") for (int k = 0; k < 2; ++k) \
        acc[ai][bj][m][n] = __builtin_amdgcn_mfma_f32_16x16x32_bf16(Bt[n][k], At[m][k], acc[ai][bj][m][n], 0, 0, 0); __builtin_amdgcn_s_setprio(0); } while (0)
#define GK_WAIT_V(n) asm volatile("s_waitcnt vmcnt(" #n ")" ::: "memory")
#define GK_WAIT_L(n) asm volatile("s_waitcnt lgkmcnt(" #n ")" ::: "memory")
#define GK_BAR __builtin_amdgcn_s_barrier()
#define GK_SCHED __builtin_amdgcn_sched_barrier(0)
    Unit cur, nxt; int ui = 0;
    if (!S.next(0, cur)) return;
    f32x4 acc[2][2][4][2];
#pragma unroll
    for (int a = 0; a < 2; ++a)
#pragma unroll
        for (int b = 0; b < 2; ++b)
#pragma unroll
            for (int m = 0; m < 4; ++m)
#pragma unroll
                for (int n = 0; n < 2; ++n) acc[a][b][m][n] = (f32x4){0.f, 0.f, 0.f, 0.f};
    bf16x8 At[4][2], B0[2][2], B1[2][2];
    unsigned c00, c01, c10, c11, n00, n01, n10, n11;
    S.a_offs(cur, RA, CA, c00, c01, c10, c11);
    asm volatile("" : "+v"(c00), "+v"(c01), "+v"(c10), "+v"(c11));
    const char* cB = S.b_base(cur);
    GK_STAGE(GK_SB(0, 0), cB, voffB[0], voffB[1]); GK_STAGE(GK_SB(0, 1), cB + hstepB, voffB[0], voffB[1]); GK_STAGE(GK_SA(0, 0), Abase, c00, c01); GK_STAGE(GK_SA(0, 1), Abase, c10, c11);
    if (wr == 1) GK_BAR;
    GK_WAIT_V(2); GK_BAR;
    GK_STAGE(GK_SB(1, 0), cB + kstep, voffB[0], voffB[1]); GK_STAGE(GK_SA(1, 0), Abase + kstep, c00, c01); GK_STAGE(GK_SB(1, 1), cB + hstepB + kstep, voffB[0], voffB[1]);
    GK_WAIT_V(6); GK_BAR;
    for (;;) {
        const bool has_next = S.next(ui + 1, nxt);
        const char* nB = cB;
        n00 = c00; n01 = c01; n10 = c10; n11 = c11;
        if (has_next) { S.a_offs(nxt, RA, CA, n00, n01, n10, n11); nB = S.b_base(nxt); }
        asm volatile("" : "+v"(n00), "+v"(n01), "+v"(n10), "+v"(n11));
        for (int t = 0; t < nt; t += 2) {
            const bool last = (t == nt - 2);
            const char* a1 = Abase + (size_t)(t + 1) * kstep;
            const char* a2 = last ? Abase : Abase + (size_t)(t + 2) * kstep; const char* b2 = last ? nB : cB + (size_t)(t + 2) * kstep;
            const char* a3 = a2 + kstep; const char* b3 = b2 + kstep;
            const unsigned x00 = last ? n00 : c00, x01 = last ? n01 : c01, x10 = last ? n10 : c10, x11 = last ? n11 : c11;
            GK_LDB(B0, 0, 0); GK_LDB(B1, 0, 1); GK_SCHED; GK_LDA(At, 0, 0); GK_STAGE(GK_SA(1, 1), a1, c10, c11);
            GK_WAIT_V(8); GK_WAIT_L(0); GK_BAR; GK_MMA(0, 0, At, B0); GK_MMA(0, 1, At, B1); GK_BAR; GK_SCHED;
            GK_LDA(At, 0, 1); GK_STAGE(GK_SB(0, 0), b2, voffB[0], voffB[1]); GK_STAGE(GK_SB(0, 1), b2 + hstepB, voffB[0], voffB[1]); GK_STAGE(GK_SA(0, 0), a2, x00, x01);
            GK_WAIT_V(8); GK_WAIT_L(0); GK_BAR; GK_MMA(1, 0, At, B0); GK_MMA(1, 1, At, B1); GK_BAR; GK_SCHED;
            GK_LDB(B0, 1, 0); GK_LDB(B1, 1, 1); GK_SCHED; GK_LDA(At, 1, 0); GK_STAGE(GK_SA(0, 1), a2, x10, x11);
            GK_WAIT_V(8); GK_WAIT_L(0); GK_BAR; GK_MMA(0, 0, At, B0); GK_MMA(0, 1, At, B1); GK_BAR; GK_SCHED;
            GK_LDA(At, 1, 1); GK_STAGE(GK_SB(1, 0), b3, voffB[0], voffB[1]); GK_STAGE(GK_SB(1, 1), b3 + hstepB, voffB[0], voffB[1]); GK_STAGE(GK_SA(1, 0), a3, x00, x01);
            GK_WAIT_V(8); GK_WAIT_L(0); GK_BAR; GK_MMA(1, 0, At, B0); GK_MMA(1, 1, At, B1); GK_BAR; GK_SCHED;
        }
        if (wr == 0) GK_BAR;
        E(acc, cur, wr, wc, fr, fq);
        if (!has_next) break;
#pragma unroll
        for (int a = 0; a < 2; ++a)
#pragma unroll
            for (int b = 0; b < 2; ++b)
#pragma unroll
                for (int m = 0; m < 4; ++m)
#pragma unroll
                    for (int n = 0; n < 2; ++n) acc[a][b][m][n] = (f32x4){0.f, 0.f, 0.f, 0.f};
        cur = nxt; cB = nB; c00 = n00; c01 = n01; c10 = n10; c11 = n11; ++ui;
        if (wr == 1) GK_BAR;
    }
    GK_WAIT_V(0);
    GK_BAR;
#undef GK_SA
#undef GK_SB
#undef GK_STAGE
#undef GK_LDA
#undef GK_LDB
#undef GK_MMA
#undef GK_WAIT_V
#undef GK_WAIT_L
#undef GK_BAR
#undef GK_SCHED
}

struct DenseOrder {
    int nM, nN, nwg, G, c, K;
    __device__ void init(int M, int N, int K_, int G_, int c_) { nM = M / BM; nN = N / BM; nwg = nM * nN; G = G_; c = c_; K = K_; }
    __device__ __forceinline__ bool next(int i, Unit& u) const {
        const long Lx = (long)i * G + c; if (Lx >= nwg) return false;
        int wgid = (int)Lx; { const int q = nwg / NXCD, r = nwg % NXCD, xcd = wgid % NXCD, off = wgid / NXCD; wgid = (xcd < r ? xcd * (q + 1) : r * (q + 1) + (xcd - r) * q) + off; }
        const int nig = WGM * nN, gid = wgid / nig, fm = gid * WGM, gsz = (nM - fm) < WGM ? (nM - fm) : WGM;
        u.pm = fm + ((wgid % nig) % gsz); u.pn = (wgid % nig) / gsz; u.ex = 0; return true;
    }
    const char* Bt;
    __device__ __forceinline__ void a_offs(const Unit& u, const int (&RA)[2], const int (&CA)[2], unsigned& o00, unsigned& o01, unsigned& o10, unsigned& o11) const {
        const unsigned r0 = (unsigned)(u.pm * BM);
        o00 = ((r0 + RA[0]) * (unsigned)K + CA[0]) * 2u; o01 = ((r0 + RA[1]) * (unsigned)K + CA[1]) * 2u;
        o10 = ((r0 + HALF + RA[0]) * (unsigned)K + CA[0]) * 2u; o11 = ((r0 + HALF + RA[1]) * (unsigned)K + CA[1]) * 2u;
    }
    __device__ __forceinline__ const char* b_base(const Unit& u) const { return Bt + (size_t)u.pn * BM * K * 2; }
};
template <int NPN, bool GATHER>
struct GroupOrder {
    int ntile, G, c, K;
    const LAS int* pstart;
    const int* rtok;
    const char* Bt; size_t bstride;
    __device__ __forceinline__ bool next(int i, Unit& u) const {
        const long Lx = (long)i * G + c; if (Lx >= (long)ntile * NPN) return false;
        u.pm = (int)(Lx / NPN); u.pn = (int)(Lx % NPN);
        const int row = u.pm * BM; int lo = 0, hi = NE1;
        while (hi - lo > 1) { const int mid = (lo + hi) >> 1; if (pstart[mid] <= row) lo = mid; else hi = mid; }
        u.ex = lo; return true;
    }
    __device__ __forceinline__ void a_offs(const Unit& u, const int (&RA)[2], const int (&CA)[2], unsigned& o00, unsigned& o01, unsigned& o10, unsigned& o11) const {
        const int r0 = u.pm * BM;
        if (GATHER) {
            const int t00 = rtok[r0 + RA[0]], t01 = rtok[r0 + RA[1]], t10 = rtok[r0 + HALF + RA[0]], t11 = rtok[r0 + HALF + RA[1]];
            o00 = ((unsigned)t00 * (unsigned)K + CA[0]) * 2u; o01 = ((unsigned)t01 * (unsigned)K + CA[1]) * 2u;
            o10 = ((unsigned)t10 * (unsigned)K + CA[0]) * 2u; o11 = ((unsigned)t11 * (unsigned)K + CA[1]) * 2u;
        } else {
            o00 = ((unsigned)(r0 + RA[0]) * (unsigned)K + CA[0]) * 2u; o01 = ((unsigned)(r0 + RA[1]) * (unsigned)K + CA[1]) * 2u;
            o10 = ((unsigned)(r0 + HALF + RA[0]) * (unsigned)K + CA[0]) * 2u; o11 = ((unsigned)(r0 + HALF + RA[1]) * (unsigned)K + CA[1]) * 2u;
        }
    }
    __device__ __forceinline__ const char* b_base(const Unit& u) const { return Bt + (size_t)u.ex * bstride + (size_t)u.pn * BM * K * 2; }
};

struct EpiBf16Store {
    static constexpr bool PERM = true;
    bf16* O; int ldc;
    __device__ __forceinline__ void operator()(const f32x4 (&acc)[2][2][4][2], const Unit& u, int wr, int wc, int fr, int fq) const {
        const int row0 = u.pm * BM + wr * 64 + fr, col0 = u.pn * BM + wc * 32 + 8 * fq;
#pragma unroll
        for (int ai = 0; ai < 2; ++ai)
#pragma unroll
            for (int m = 0; m < 4; ++m) { bf16* rowp = O + (size_t)(row0 + ai * HALF + m * 16) * ldc + col0;
#pragma unroll
                for (int bj = 0; bj < 2; ++bj) { const f32x4 v0 = acc[ai][bj][m][0], v1 = acc[ai][bj][m][1];
                    v4u w; w.x = cvt_pk_bf16(v0[0], v0[1]); w.y = cvt_pk_bf16(v0[2], v0[3]); w.z = cvt_pk_bf16(v1[0], v1[1]); w.w = cvt_pk_bf16(v1[2], v1[3]);
                    *(v4u*)(rowp + bj * HALF) = w; } }
    }
};
struct EpiResidual {
    static constexpr bool PERM = false;
    float* X; int ldc; const float* gate;
    __device__ __forceinline__ void operator()(const f32x4 (&acc)[2][2][4][2], const Unit& u, int wr, int wc, int fr, int fq) const {
        const int row0 = u.pm * BM + wr * 64 + fr, col0 = u.pn * BM + wc * 32 + 4 * fq;
        f32x4 gv[2][2];
#pragma unroll
        for (int bj = 0; bj < 2; ++bj)
#pragma unroll
            for (int n = 0; n < 2; ++n) gv[bj][n] = *(const f32x4*)(gate + col0 + bj * HALF + n * 16);
#pragma unroll
        for (int ai = 0; ai < 2; ++ai)
#pragma unroll
            for (int m = 0; m < 4; ++m) { float* rowp = X + (size_t)(row0 + ai * HALF + m * 16) * ldc + col0;
#pragma unroll
                for (int bj = 0; bj < 2; ++bj)
#pragma unroll
                    for (int n = 0; n < 2; ++n) { f32x4* p = (f32x4*)(rowp + bj * HALF + n * 16); *p = *p + gv[bj][n] * acc[ai][bj][m][n]; } }
    }
};
struct EpiGateUp {
    static constexpr bool PERM = true;
    bf16* O;
    __device__ __forceinline__ void operator()(const f32x4 (&acc)[2][2][4][2], const Unit& u, int wr, int wc, int fr, int fq) const {
        const int row0 = u.pm * BM + wr * 64 + fr, col0 = u.pn * HALF + wc * 32 + 8 * fq;
#pragma unroll
        for (int ai = 0; ai < 2; ++ai)
#pragma unroll
            for (int m = 0; m < 4; ++m) { bf16* rowp = O + (size_t)(row0 + ai * HALF + m * 16) * DE + col0;
                float h[8];
#pragma unroll
                for (int n = 0; n < 2; ++n)
#pragma unroll
                    for (int j = 0; j < 4; ++j) { const float g = acc[ai][0][m][n][j], up = acc[ai][1][m][n][j]; h[n * 4 + j] = silu_f(g) * up; }
                v4u w; w.x = cvt_pk_bf16(h[0], h[1]); w.y = cvt_pk_bf16(h[2], h[3]); w.z = cvt_pk_bf16(h[4], h[5]); w.w = cvt_pk_bf16(h[6], h[7]);
                *(v4u*)rowp = w; }
    }
};
struct EpiDown {
    static constexpr bool PERM = true;
    bf16* O; const float* rw;
    __device__ __forceinline__ void operator()(const f32x4 (&acc)[2][2][4][2], const Unit& u, int wr, int wc, int fr, int fq) const {
        const int row0 = u.pm * BM + wr * 64 + fr, col0 = u.pn * BM + wc * 32 + 8 * fq;
#pragma unroll
        for (int ai = 0; ai < 2; ++ai)
#pragma unroll
            for (int m = 0; m < 4; ++m) { const int row = row0 + ai * HALF + m * 16; const float s = rw[row]; bf16* rowp = O + (size_t)row * D + col0;
#pragma unroll
                for (int bj = 0; bj < 2; ++bj) { const f32x4 v0 = acc[ai][bj][m][0] * s, v1 = acc[ai][bj][m][1] * s;
                    v4u w; w.x = cvt_pk_bf16(v0[0], v0[1]); w.y = cvt_pk_bf16(v0[2], v0[3]); w.z = cvt_pk_bf16(v1[0], v1[1]); w.w = cvt_pk_bf16(v1[2], v1[3]);
                    *(v4u*)(rowp + bj * HALF) = w; } }
    }
};
}

struct Args { const float* in[36]; float* out; unsigned char* ws; int ph_lo, ph_hi; };
struct Frame {
    LAS unsigned char* lds;
    int tid, lane, wave, bid, G;
    const float* const* in; float* out; unsigned char* ws;
};
#define IN_X 0
#define IN_C 1
#define IN_CTX 2
#define IN_CCTX 3
#define IN_WADA 4
#define IN_BADA 5
#define IN_GMIX 6
#define IN_GFFN 7
#define IN_WIN 8
#define IN_BGATES 9
#define IN_CKW 10
#define IN_CKB 11
#define IN_CQW 12
#define IN_CQB 13
#define IN_GHEAD 14
#define IN_CHW 15
#define IN_CHB 16
#define IN_FW1 17
#define IN_FB1 18
#define IN_FF1 19
#define IN_FW2 20
#define IN_FB2 21
#define IN_FF2 22
#define IN_FW3 23
#define IN_FB3 24
#define IN_DSKIP 25
#define IN_WOUT 26
#define IN_WR 27
#define IN_BR 28
#define IN_W1E 29
#define IN_W3E 30
#define IN_W2E 31
#define IN_W1S 32
#define IN_W3S 33
#define IN_W2S 34
#define IN_GFIN 35

__device__ __forceinline__ void transpose_item(const float* W, int N, int k0, int n0, bf16* WT, int dstK, int dst_row0, LAS float* scr, int lane) {
#pragma unroll 8
    for (int i = 0; i < 32; ++i) { const int kk = 2 * i + (lane >> 5); scr[kk * 33 + (lane & 31)] = W[(size_t)(k0 + kk) * N + n0 + (lane & 31)]; }
    LDS_WAIT(); asm volatile("" ::: "memory");
    const int c = lane & 7;
#pragma unroll
    for (int j = 0; j < 4; ++j) { const int n = (lane >> 3) + 8 * j; const LAS float* s = scr + (8 * c) * 33 + n;
        v4u o; o.x = cvt_pk_bf16(s[0 * 33], s[1 * 33]); o.y = cvt_pk_bf16(s[2 * 33], s[3 * 33]); o.z = cvt_pk_bf16(s[4 * 33], s[5 * 33]); o.w = cvt_pk_bf16(s[6 * 33], s[7 * 33]);
        *(v4u*)(WT + (size_t)(dst_row0 + n) * dstK + k0 + 8 * c) = o; }
    LDS_WAIT(); asm volatile("" ::: "memory");
}
__device__ __forceinline__ void p0_prologue(Frame& F) {
    const float* const* in = F.in;
    {
        LAS float* sv = (LAS float*)F.lds;
        LAS float* red = sv + 4096;
        float* mod = (float*)(F.ws + WS_MOD);
        for (int job = F.bid; job < 192; job += F.G) {
            for (int i = F.tid; i < 2048; i += NT) { sv[i] = silu_f(in[IN_C][i]); sv[2048 + i] = silu_f(in[IN_CCTX][i]); }
            __syncthreads();
            const int col = job * 64 + F.lane, r0 = F.wave * 256;
            const float* W = in[IN_WADA] + col;
            float a0 = 0.f, a1 = 0.f;
            for (int i = r0; i < r0 + 256; i += 8) {
                float w[8];
#pragma unroll
                for (int j = 0; j < 8; ++j) w[j] = W[(size_t)(i + j) * 12288];
#pragma unroll
                for (int j = 0; j < 8; ++j) { a0 += sv[i + j] * w[j]; a1 += sv[2048 + i + j] * w[j]; }
            }
            red[(F.wave * 64 + F.lane) * 2 + 0] = a0; red[(F.wave * 64 + F.lane) * 2 + 1] = a1;
            __syncthreads();
            if (F.wave == 0) { float s0 = 0.f, s1 = 0.f;
#pragma unroll
                for (int w = 0; w < 8; ++w) { s0 += red[(w * 64 + F.lane) * 2 + 0]; s1 += red[(w * 64 + F.lane) * 2 + 1]; }
                const float b = in[IN_BADA][col]; mod[col] = s0 + b; mod[12288 + col] = s1 + b; }
            __syncthreads();
        }
    }
    const int gt = F.bid * NT + F.tid, NGT = F.G * NT;
    {
        float* pos = (float*)(F.ws + WS_POS);
        for (int i = gt; i < 320 * 1024; i += NGT) { const int p = i >> 10, j = i & 1023, jj = j & 511;
            const float pp = (float)(p < 256 ? p : p - 256);
            const float omega = 1.0f / powf(10000.0f, (float)jj * (1.0f / 512.0f)); const float ang = pp * omega;
            pos[i] = j < 512 ? sinf(ang) : cosf(ang); }
    }
    {
        v4u* z = (v4u*)(F.ws + WS_WIN + (size_t)NIN * D * 2); const int nz = (NINP - NIN) * D * 2 / 16;
        for (int i = gt; i < nz; i += NGT) z[i] = (v4u){0u, 0u, 0u, 0u};
        int* rt = (int*)(F.ws + WS_RTOK); float* rw = (float*)(F.ws + WS_RW);
        for (int i = gt; i < 2 * MAXROWS; i += NGT) { rt[i] = 0; rw[i] = 0.f; }
    }
    {
        LAS float* scr = (LAS float*)(F.lds + F.wave * 16384);
        const int gw = F.bid * NWAVES + F.wave, NGW = F.G * NWAVES;
        constexpr int I_IN = 32 * 193, I_OUT = 32 * 64, I_E = 512 * NE1;
        constexpr int NITEMS = I_IN + I_OUT + 3 * I_E;
        for (int it = gw; it < NITEMS; it += NGW) {
            int r = it;
            if (r < I_IN) { const int kb = r / 193, nb = r % 193; transpose_item(in[IN_WIN], NIN, 64 * kb, 32 * nb, (bf16*)(F.ws + WS_WIN), D, 32 * nb, scr, F.lane); continue; } r -= I_IN;
            if (r < I_OUT) { const int kb = r / 64, nb = r % 64; transpose_item(in[IN_WOUT], D, 64 * kb, 32 * nb, (bf16*)(F.ws + WS_WOUT), D, 32 * nb, scr, F.lane); continue; } r -= I_OUT;
            if (r < 2 * I_E) { const int which = r >= I_E; if (which) r -= I_E;
                const int e = r / 512, rr = r % 512, kb = rr / 16, nb = rr % 16, n0 = 32 * nb;
                const float* src = e < NE ? in[which ? IN_W3E : IN_W1E] + (size_t)e * D * DE : in[which ? IN_W3S : IN_W1S];
                transpose_item(src, DE, 64 * kb, n0, (bf16*)(F.ws + WS_W13) + (size_t)e * 1024 * D, D, (n0 >> 7) * 256 + which * 128 + (n0 & 127), scr, F.lane); continue; }
            r -= 2 * I_E;
            { const int e = r / 512, rr = r % 512, kb = rr / 64, nb = rr % 64;
                const float* src = e < NE ? in[IN_W2E] + (size_t)e * DE * D : in[IN_W2S];
                transpose_item(src, D, 64 * kb, 32 * nb, (bf16*)(F.ws + WS_W2) + (size_t)e * D * DE, DE, 32 * nb, scr, F.lane); }
        }
    }
}

__device__ __forceinline__ void p1_norm1(Frame& F) {
    const float* const* in = F.in;
    const int gw = F.bid * NWAVES + F.wave, NGW = F.G * NWAVES;
    const float* mod = (const float*)(F.ws + WS_MOD); const float* pos = (const float*)(F.ws + WS_POS);
    bf16* hA = (bf16*)(F.ws + WS_HA);
    for (int row = gw; row < MROWS; row += NGW) {
        f32x4 v[8]; float ss = 0.f;
        const bool mainrow = row < L;
        const float* src = mainrow ? in[IN_X] + (size_t)row * D : in[IN_CTX] + (size_t)(row - L) * D;
        const float* md = mainrow ? mod : mod + 12288;
#pragma unroll
        for (int j = 0; j < 8; ++j) { const int col = 4 * F.lane + 256 * j; v[j] = *(const f32x4*)(src + col);
            if (mainrow) { const float* pp = col < 1024 ? pos + (size_t)(row >> 6) * 1024 + col : pos + (size_t)(256 + (row & 63)) * 1024 + (col - 1024);
                v[j] = v[j] + *(const f32x4*)pp; *(f32x4*)(F.out + (size_t)row * D + col) = v[j]; }
            ss += (v[j].x * v[j].x + v[j].y * v[j].y) + (v[j].z * v[j].z + v[j].w * v[j].w); }
        const float rstd = rsqrtf(wave_sum(ss) * (1.0f / D) + EPS);
#pragma unroll
        for (int j = 0; j < 8; ++j) { const int col = 4 * F.lane + 256 * j;
            const f32x4 g = *(const f32x4*)(in[IN_GMIX] + col), sh = *(const f32x4*)(md + col), sc = *(const f32x4*)(md + 2048 + col);
            const f32x4 h = (v[j] * rstd * g) * (sc + 1.0f) + sh;
            v2u o; o.x = cvt_pk_bf16(h.x, h.y); o.y = cvt_pk_bf16(h.z, h.w);
            *(v2u*)(hA + (size_t)row * D + col) = o; }
    }
}

constexpr int VT_PITCH = 136;
__device__ __forceinline__ float wave_incl_add(float x, int lane) {
#pragma unroll
    for (int o = 1; o < 64; o <<= 1) { const float y = __shfl_up(x, o); if (lane >= o) x += y; }
    return x;
}
__device__ __forceinline__ float wave_incl_max(float x, int lane) {
#pragma unroll
    for (int o = 1; o < 64; o <<= 1) { const float y = __shfl_up(x, o); if (lane >= o) x = fmaxf(x, y); }
    return x;
}
__device__ __forceinline__ void ml_gates(Frame& F, int dir, int h, int rowbase, LAS float* bb, LAS float* al, LAS float* mx, float& g, float& mtot) {
    const bf16* z = (const bf16*)(F.ws + WS_Z);
    const int lane = F.lane, pi0 = 2 * lane, p0 = dir ? 127 - pi0 : pi0, p1 = dir ? p0 - 1 : p0 + 1;
    const float bgi = F.in[IN_BGATES][dir * 16 + h], bgf = F.in[IN_BGATES][dir * 16 + 8 + h];
    const bf16* z0 = z + (size_t)(rowbase + p0) * NINP + OFF_G + dir * 16 + h; const bf16* z1 = z + (size_t)(rowbase + p1) * NINP + OFF_G + dir * 16 + h;
    const float i0 = bf2f(z0[0]) + bgi, f0 = bf2f(z0[8]) + bgf, i1 = bf2f(z1[0]) + bgi, f1 = bf2f(z1[8]) + bgf;
    const float l0 = fminf(f0, 0.f) - log1pf(__expf(-fabsf(f0))), l1 = fminf(f1, 0.f) - log1pf(__expf(-fabsf(f1)));
    const float incl = wave_incl_add(l0 + l1, lane);
    const float b1 = incl, b0 = incl - l1;
    const float a0 = i0 - b0, a1 = i1 - b1;
    const float mi = wave_incl_max(fmaxf(a0, a1), lane);
    float mprev = __shfl_up(mi, 1); if (lane == 0) mprev = -INFINITY;
    const float M0 = fmaxf(mprev, a0), M1 = mi;
    bb[p0] = b0; bb[p1] = b1; al[p0] = a0; al[p1] = a1; mx[p0] = M0; mx[p1] = M1;
    g = __shfl(incl, 63); mtot = __shfl(mi, 63);
}
__device__ __forceinline__ void ml_stage_vT(Frame& F, int h, int rowbase, LAS bf16* vT) {
    const bf16* z = (const bf16*)(F.ws + WS_Z);
    const int s = F.tid >> 2, eg = F.tid & 3;
#pragma unroll
    for (int i = 0; i < 4; ++i) { const int e0 = 32 * eg + 8 * i; const v4u v = *(const v4u*)(z + (size_t)(rowbase + s) * NINP + OFF_V + h * 128 + e0);
        const unsigned w[4] = {v.x, v.y, v.z, v.w};
#pragma unroll
        for (int q = 0; q < 4; ++q) { vT[(e0 + 2 * q) * VT_PITCH + s] = (bf16)(w[q] & 0xffffu); vT[(e0 + 2 * q + 1) * VT_PITCH + s] = (bf16)(w[q] >> 16); } }
}
__device__ __forceinline__ void ml_prep_item(Frame& F, int item) {
    const float* const* in = F.in;
    const int n = item >> 3, h = item & 7, tid = F.tid, lane = F.lane, wave = F.wave;
    const bool isctx = n >= 128;
    const int rowbase = isctx ? L + 128 * (n - 128) : 128 * n, seqlo = isctx ? L : 0, seqhi = isctx ? L + LC - 1 : L - 1;
    LAS bf16* vT = (LAS bf16*)F.lds;
    LAS bf16* kw0 = vT + 128 * VT_PITCH;
    LAS bf16* kw1 = kw0 + 64 * VT_PITCH;
    LAS float* fs = (LAS float*)(kw1 + 64 * VT_PITCH);
    const bf16* z = (const bf16*)(F.ws + WS_Z);
    if (wave < 2) { float g, mtot; LAS float* bbp = fs + 256 + wave * 384; ml_gates(F, wave, h, rowbase, bbp, bbp + 128, bbp + 256, g, mtot);
        LDS_WAIT();
        fs[wave * 128 + 2 * lane] = __expf(bbp[128 + 2 * lane] - mtot); fs[wave * 128 + 2 * lane + 1] = __expf(bbp[128 + 2 * lane + 1] - mtot);
        if (lane == 0) { float* sc = (float*)(F.ws + WS_SC) + ((size_t)(wave * 8 + h) * 130 + n) * 2; sc[0] = g; sc[1] = g + mtot; } }
    ml_stage_vT(F, h, rowbase, vT);
    __syncthreads();
    {
        const int s = tid >> 2, d0 = (tid & 3) * 16, R = rowbase + s; const bool hp = R > seqlo, hn = R < seqhi;
        float kv[16], qv[16];
#pragma unroll
        for (int part = 0; part < 2; ++part) {
            const int zc = (part ? OFF_Q : OFF_K) + h * 64 + d0; const float* cw = in[part ? IN_CQW : IN_CKW] + h * 64 + d0; const float* cb = in[part ? IN_CQB : IN_CKB] + h * 64 + d0;
#pragma unroll
            for (int hv = 0; hv < 2; ++hv) {
                const v4u c = *(const v4u*)(z + (size_t)R * NINP + zc + 8 * hv);
                const v4u p = hp ? *(const v4u*)(z + (size_t)(R - 1) * NINP + zc + 8 * hv) : (v4u){0u, 0u, 0u, 0u};
                const v4u nx = hn ? *(const v4u*)(z + (size_t)(R + 1) * NINP + zc + 8 * hv) : (v4u){0u, 0u, 0u, 0u};
                const unsigned cc[4] = {c.x, c.y, c.z, c.w}, pp[4] = {p.x, p.y, p.z, p.w}, nn[4] = {nx.x, nx.y, nx.z, nx.w};
#pragma unroll
                for (int q = 0; q < 4; ++q) { const int d = 8 * hv + 2 * q;
                    const float v0 = silu_f(bflo(pp[q]) * cw[d] + bflo(cc[q]) * cw[512 + d] + bflo(nn[q]) * cw[1024 + d] + cb[d]);
                    const float v1 = silu_f(bfhi(pp[q]) * cw[d + 1] + bfhi(cc[q]) * cw[512 + d + 1] + bfhi(nn[q]) * cw[1024 + d + 1] + cb[d + 1]);
                    if (part) { qv[d] = v0 * 0.125f; qv[d + 1] = v1 * 0.125f; } else { kv[d] = v0; kv[d + 1] = v1; } }
            }
        }
        if (!isctx) {
            bf16* Qg = (bf16*)(F.ws + WS_Q) + ((size_t)h * L + R) * 64 + d0; bf16* Kg = (bf16*)(F.ws + WS_K) + ((size_t)h * L + R) * 64 + d0;
#pragma unroll
            for (int hv = 0; hv < 2; ++hv) { v4u w;
                w.x = cvt_pk_bf16(qv[8 * hv], qv[8 * hv + 1]); w.y = cvt_pk_bf16(qv[8 * hv + 2], qv[8 * hv + 3]); w.z = cvt_pk_bf16(qv[8 * hv + 4], qv[8 * hv + 5]); w.w = cvt_pk_bf16(qv[8 * hv + 6], qv[8 * hv + 7]); *(v4u*)(Qg + 8 * hv) = w;
                w.x = cvt_pk_bf16(kv[8 * hv], kv[8 * hv + 1]); w.y = cvt_pk_bf16(kv[8 * hv + 2], kv[8 * hv + 3]); w.z = cvt_pk_bf16(kv[8 * hv + 4], kv[8 * hv + 5]); w.w = cvt_pk_bf16(kv[8 * hv + 6], kv[8 * hv + 7]); *(v4u*)(Kg + 8 * hv) = w; }
        }
        const float w0 = fs[s], w1 = fs[128 + s];
#pragma unroll
        for (int d = 0; d < 16; ++d) { const float kr = bf2f((bf16)(cvt_pk_bf16(kv[d], 0.f) & 0xffffu));
            kw0[(d0 + d) * VT_PITCH + s] = (bf16)(cvt_pk_bf16(kr * w0, 0.f) & 0xffffu); kw1[(d0 + d) * VT_PITCH + s] = (bf16)(cvt_pk_bf16(kr * w1, 0.f) & 0xffffu); }
    }
    __syncthreads();
    {
        const int fr = lane & 15, fq = lane >> 4;
        bf16x8 a[4];
#pragma unroll
        for (int kk = 0; kk < 4; ++kk) a[kk] = *(const LAS bf16x8*)(vT + (16 * wave + fr) * VT_PITCH + 32 * kk + 8 * fq);
#pragma unroll
        for (int dir = 0; dir < 2; ++dir) { const LAS bf16* kw = dir ? kw1 : kw0;
            float* cl = (float*)(F.ws + WS_CL) + ((size_t)((dir * 8 + h) * 130 + n)) * 8192;
#pragma unroll
            for (int dt = 0; dt < 4; ++dt) { f32x4 acc = (f32x4){0.f, 0.f, 0.f, 0.f};
#pragma unroll
                for (int kk = 0; kk < 4; ++kk) { const bf16x8 b = *(const LAS bf16x8*)(kw + (16 * dt + fr) * VT_PITCH + 32 * kk + 8 * fq); acc = __builtin_amdgcn_mfma_f32_16x16x32_bf16(a[kk], b, acc, 0, 0, 0); }
#pragma unroll
                for (int r = 0; r < 4; ++r) cl[(16 * wave + 4 * fq + r) * 64 + 16 * dt + fr] = acc[r]; } }
        if (tid < 128) { const int dir = tid >> 6, d = tid & 63; const LAS bf16* kw = (dir ? kw1 : kw0) + d * VT_PITCH; float s = 0.f;
            for (int i = 0; i < 128; ++i) s += bf2f(kw[i]);
            ((float*)(F.ws + WS_NL))[((size_t)((dir * 8 + h) * 130 + n)) * 64 + d] = s; }
    }
    __syncthreads();
}
__device__ __forceinline__ int ml_order(int dir, int step) { return step < 2 ? (dir ? 129 - step : 128 + step) : (dir ? 129 - step : step - 2); }
__device__ __forceinline__ void ml_scan(Frame& F) {
    const float* CL = (const float*)(F.ws + WS_CL); const float* SC = (const float*)(F.ws + WS_SC); const float* NLp = (const float*)(F.ws + WS_NL);
    bf16* CI = (bf16*)(F.ws + WS_CI); float* NI = (float*)(F.ws + WS_NI); float* MI = (float*)(F.ws + WS_MI);
    for (int idx = F.bid * NT + F.tid; idx < 16 * 8192; idx += F.G * NT) {
        const int dh = idx >> 13, rem = idx & 8191, dir = dh >> 3; const bool don = rem < 64;
        float c = 0.f, nn = 0.f, m = 0.f;
        for (int s0 = 0; s0 < 130; s0 += 10) {
            float cl[10], nl[10], gg[10], ml[10];
#pragma unroll
            for (int i = 0; i < 10; ++i) { const int ch = ml_order(dir, s0 + i); cl[i] = CL[((size_t)(dh * 130 + ch)) * 8192 + rem]; gg[i] = SC[(dh * 130 + ch) * 2]; ml[i] = SC[(dh * 130 + ch) * 2 + 1];
                nl[i] = don ? NLp[(size_t)(dh * 130 + ch) * 64 + rem] : 0.f; }
#pragma unroll
            for (int i = 0; i < 10; ++i) { const int ch = ml_order(dir, s0 + i);
                if (ch < 128) { CI[((size_t)(dh * 128 + ch)) * 8192 + rem] = (bf16)(cvt_pk_bf16(c, 0.f) & 0xffffu); if (don) NI[(size_t)(dh * 128 + ch) * 64 + rem] = nn; if (rem == 0) MI[dh * 128 + ch] = m; }
                const float mn = fmaxf(gg[i] + m, ml[i]), sp = __expf(gg[i] + m - mn), sl = __expf(ml[i] - mn);
                c = sp * c + sl * cl[i]; nn = sp * nn + sl * nl[i]; m = mn; }
        }
    }
}
__device__ __forceinline__ void ml_out_item(Frame& F, int item) {
    const float* const* in = F.in;
    const int n = item >> 3, h = item & 7, tid = F.tid, lane = F.lane, wave = F.wave, fr = lane & 15, fq = lane >> 4;
    const int rowbase = 128 * n;
    LAS bf16* vT = (LAS bf16*)F.lds;
    LAS float* fs = (LAS float*)(vT + 128 * VT_PITCH);
    const bf16* z = (const bf16*)(F.ws + WS_Z);
    if (wave < 2) { float g, mtot; LAS float* bbp = fs + wave * 384; ml_gates(F, wave, h, rowbase, bbp, bbp + 128, bbp + 256, g, mtot);
        if (lane == 0) fs[768 + wave] = ((const float*)(F.ws + WS_MI))[(wave * 8 + h) * 128 + n]; }
    ml_stage_vT(F, h, rowbase, vT);
    __syncthreads();
    const bf16* Qg = (const bf16*)(F.ws + WS_Q) + ((size_t)h * L + rowbase) * 64; const bf16* Kg = (const bf16*)(F.ws + WS_K) + ((size_t)h * L + rowbase) * 64;
    const int tl = 16 * wave + fr;
    bf16x8 qf[2];
#pragma unroll
    for (int kk = 0; kk < 2; ++kk) qf[kk] = *(const bf16x8*)(Qg + (size_t)tl * 64 + 32 * kk + 8 * fq);
    f32x4 st[8];
#pragma unroll
    for (int j = 0; j < 8; ++j) { f32x4 acc = (f32x4){0.f, 0.f, 0.f, 0.f};
#pragma unroll
        for (int kk = 0; kk < 2; ++kk) { const bf16x8 kf = *(const bf16x8*)(Kg + (size_t)(16 * j + fr) * 64 + 32 * kk + 8 * fq); acc = __builtin_amdgcn_mfma_f32_16x16x32_bf16(kf, qf[kk], acc, 0, 0, 0); }
        st[j] = acc; }
    f32x4 hs[8];
#pragma unroll
    for (int et = 0; et < 8; ++et) hs[et] = (f32x4){0.f, 0.f, 0.f, 0.f};
#pragma unroll 1
    for (int dir = 0; dir < 2; ++dir) {
        const LAS float* bbp = fs + dir * 384; const LAS float* alp = bbp + 128; const LAS float* mxp = bbp + 256;
        const float m_in = fs[768 + dir];
        const float beta = fmaxf(m_in, mxp[tl]);
        const int dh = dir * 8 + h;
        bf16x8 pf[4]; float dsum = 0.f;
#pragma unroll
        for (int kk = 0; kk < 4; ++kk) { float pv[8];
#pragma unroll
            for (int hh = 0; hh < 2; ++hh)
#pragma unroll
                for (int r = 0; r < 4; ++r) { const int s = 32 * kk + 16 * hh + 4 * fq + r; const bool ok = dir ? (s >= tl) : (s <= tl);
                    const float e = __expf(fminf(alp[s] - beta, 0.f)); const float v = ok ? st[2 * kk + hh][r] * e : 0.f; pv[4 * hh + r] = v; dsum += v; }
            pf[kk] = __builtin_bit_cast(bf16x8, (v4u){cvt_pk_bf16(pv[0], pv[1]), cvt_pk_bf16(pv[2], pv[3]), cvt_pk_bf16(pv[4], pv[5]), cvt_pk_bf16(pv[6], pv[7])}); }
        dsum += __shfl_xor(dsum, 16); dsum += __shfl_xor(dsum, 32);
        const float* nip = (const float*)(F.ws + WS_NI) + (size_t)(dh * 128 + n) * 64; float qn = 0.f;
#pragma unroll
        for (int kk = 0; kk < 2; ++kk) { const v4u qq = __builtin_bit_cast(v4u, qf[kk]); const unsigned w[4] = {qq.x, qq.y, qq.z, qq.w};
#pragma unroll
            for (int q = 0; q < 4; ++q) { const int d = 32 * kk + 8 * fq + 2 * q; qn += bflo(w[q]) * nip[d] + bfhi(w[q]) * nip[d + 1]; } }
        qn += __shfl_xor(qn, 16); qn += __shfl_xor(qn, 32);
        const float sc_t = __expf(m_in - beta);
        const float den = dsum + sc_t * qn, dn = fmaxf(fabsf(den), __expf(-(bbp[tl] + beta)));
        LAS float* xinv = fs + 772 + (wave * 2 + dir) * 32;
        if (fq == 0) { xinv[fr] = 1.0f / dn; xinv[16 + fr] = sc_t; }
        LDS_WAIT();
        float inv_r[4], sc_r[4];
#pragma unroll
        for (int r = 0; r < 4; ++r) { inv_r[r] = xinv[4 * fq + r]; sc_r[r] = xinv[16 + 4 * fq + r]; }
        const bf16* cip = (const bf16*)(F.ws + WS_CI) + (size_t)(dh * 128 + n) * 8192;
#pragma unroll
        for (int et = 0; et < 8; ++et) {
            f32x4 acc = (f32x4){0.f, 0.f, 0.f, 0.f}, acci = (f32x4){0.f, 0.f, 0.f, 0.f};
#pragma unroll
            for (int kk = 0; kk < 4; ++kk) {
                const bool live = dir ? (2 * kk + 1 >= wave) : (2 * kk <= wave);
                if (live) { const LAS bf16* vr = vT + (16 * et + fr) * VT_PITCH + 32 * kk + 4 * fq;
                    const v2u lo = *(const LAS v2u*)vr, hi = *(const LAS v2u*)(vr + 16);
                    const bf16x8 vb = __builtin_bit_cast(bf16x8, (v4u){lo.x, lo.y, hi.x, hi.y});
                    acc = __builtin_amdgcn_mfma_f32_16x16x32_bf16(pf[kk], vb, acc, 0, 0, 0); } }
#pragma unroll
            for (int kk = 0; kk < 2; ++kk) { const bf16x8 cb = *(const bf16x8*)(cip + (size_t)(16 * et + fr) * 64 + 32 * kk + 8 * fq); acci = __builtin_amdgcn_mfma_f32_16x16x32_bf16(qf[kk], cb, acci, 0, 0, 0); }
#pragma unroll
            for (int r = 0; r < 4; ++r) hs[et][r] += (acc[r] + sc_r[r] * acci[r]) * inv_r[r];
        }
    }
    float rs[4];
#pragma unroll
    for (int r = 0; r < 4; ++r) { float ss = 0.f;
#pragma unroll
        for (int et = 0; et < 8; ++et) ss += hs[et][r] * hs[et][r];
        ss += __shfl_xor(ss, 1); ss += __shfl_xor(ss, 2); ss += __shfl_xor(ss, 4); ss += __shfl_xor(ss, 8);
        rs[r] = rsqrtf(ss * (1.0f / 128.0f) + EPS); }
    bf16* cat = (bf16*)(F.ws + WS_CAT);
#pragma unroll
    for (int et = 0; et < 8; ++et) { const int col = h * 128 + 16 * et + fr; const float gh = in[IN_GHEAD][col];
#pragma unroll
        for (int r = 0; r < 4; ++r) { const int t = rowbase + 16 * wave + 4 * fq + r;
            const float o = hs[et][r] * rs[r] * gh * sigmoid_f(bf2f(z[(size_t)t * NINP + OFF_O + col]));
            cat[(size_t)t * D + col] = (bf16)(cvt_pk_bf16(o, 0.f) & 0xffffu); } }
    __syncthreads();
}

__device__ __forceinline__ void p3_filter_tile(Frame& F, int tile) {
    const float* const* in = F.in;
    const int tid = F.tid;
    LAS float* feat = (LAS float*)F.lds;
    LAS float* h1 = feat + 64 * 36;
    LAS float* h2 = h1 + 64 * 65;
    LAS float* w1s = h2 + 64 * 64;
    LAS float* w2s = w1s + 33 * 64;
    for (int i = tid; i < 33 * 64; i += NT) w1s[i] = in[IN_FW1][i];
    for (int i = tid; i < 64 * 64; i += NT) w2s[i] = in[IN_FW2][i];
    {
        const int tt = tid >> 3, sub = tid & 7; const float t = (float)(tile * 64 + tt);
        const float w = (6.2831855f * t) / (float)L;
        if (sub == 0) feat[tt * 36] = t / (float)(L - 1);
#pragma unroll
        for (int q = 0; q < 2; ++q) { const int bi = sub * 2 + q; const float band = 1e-4f + (float)bi * ((15.0f - 1e-4f) / 15.0f); const float ang = w * band;
            feat[tt * 36 + 1 + bi] = cosf(ang); feat[tt * 36 + 17 + bi] = -sinf(ang); }
    }
    __syncthreads();
    {
        const int tt = tid >> 3, j0 = (tid & 7) * 8;
        float a[8];
#pragma unroll
        for (int q = 0; q < 8; ++q) a[q] = in[IN_FB1][j0 + q];
#pragma unroll 1
        for (int i = 0; i < 33; ++i) { const float f = feat[tt * 36 + i];
#pragma unroll
            for (int q = 0; q < 8; ++q) a[q] += f * w1s[i * 64 + j0 + q]; }
#pragma unroll
        for (int q = 0; q < 8; ++q) h1[tt * 65 + j0 + q] = sinf(in[IN_FF1][j0 + q] * a[q]);
    }
    __syncthreads();
    {
        const int tt = tid >> 3, j0 = (tid & 7) * 8;
        float a[8];
#pragma unroll
        for (int q = 0; q < 8; ++q) a[q] = in[IN_FB2][j0 + q];
#pragma unroll 1
        for (int i = 0; i < 64; ++i) { const float f = h1[tt * 65 + i];
#pragma unroll
            for (int q = 0; q < 8; ++q) a[q] += f * w2s[i * 64 + j0 + q]; }
#pragma unroll
        for (int q = 0; q < 8; ++q) h2[tt * 64 + j0 + q] = sinf(in[IN_FF2][j0 + q] * a[q]);
    }
    __syncthreads();
    {
        bf16* hd = (bf16*)(F.ws + WS_HDN);
        for (int i = tid; i < 64 * 32; i += NT) { const int tt = i >> 5, j = (i & 31) * 2; *(unsigned*)(hd + (size_t)(tile * 64 + tt) * 64 + j) = cvt_pk_bf16(h2[tt * 64 + j], h2[tt * 64 + j + 1]); }
    }
    __syncthreads();
}
__device__ __forceinline__ void p3_uin_tile(Frame& F, int tile) {
    const float* const* in = F.in;
    const bf16* z = (const bf16*)(F.ws + WS_Z); float* uT = (float*)(F.ws + WS_UIN);
    LAS float* tl = (LAS float*)F.lds;
    const int t0 = (tile >> 2) * 64, cb = (tile & 3) * 256;
    const int cg = F.tid & 31, c0 = cb + cg * 8, rsub = F.tid >> 5;
    for (int pass = 0; pass < 4; ++pass) {
        const int tt = pass * 16 + rsub, t = t0 + tt;
        float r1[8], r2[8];
#pragma unroll
        for (int part = 0; part < 2; ++part) {
            const int zc = OFF_HY + 1024 * (part + 1) + c0, wc = 1024 * (part + 1) + c0;
            const v4u cur = *(const v4u*)(z + (size_t)t * NINP + zc);
            const v4u prv = t > 0 ? *(const v4u*)(z + (size_t)(t - 1) * NINP + zc) : (v4u){0u, 0u, 0u, 0u};
            const v4u nxt = t < L - 1 ? *(const v4u*)(z + (size_t)(t + 1) * NINP + zc) : (v4u){0u, 0u, 0u, 0u};
            float* rr = part ? r2 : r1;
#pragma unroll
            for (int q = 0; q < 4; ++q) {
                const unsigned pc = q == 0 ? prv.x : q == 1 ? prv.y : q == 2 ? prv.z : prv.w, cc = q == 0 ? cur.x : q == 1 ? cur.y : q == 2 ? cur.z : cur.w, nc = q == 0 ? nxt.x : q == 1 ? nxt.y : q == 2 ? nxt.z : nxt.w;
                const int ch = wc + 2 * q;
                rr[2 * q] = bflo(pc) * in[IN_CHW][ch] + bflo(cc) * in[IN_CHW][3072 + ch] + bflo(nc) * in[IN_CHW][6144 + ch] + in[IN_CHB][ch];
                rr[2 * q + 1] = bfhi(pc) * in[IN_CHW][ch + 1] + bfhi(cc) * in[IN_CHW][3072 + ch + 1] + bfhi(nc) * in[IN_CHW][6144 + ch + 1] + in[IN_CHB][ch + 1];
            }
        }
#pragma unroll
        for (int q = 0; q < 8; ++q) tl[(cg * 8 + q) * 65 + tt] = r1[q] * r2[q];
    }
    __syncthreads();
    for (int i = F.tid; i < 256 * 16; i += NT) { const int c = i >> 4, tq = (i & 15) * 4; const LAS float* s = tl + c * 65 + tq;
        *(f32x4*)(uT + (size_t)(cb + c) * L + t0 + tq) = (f32x4){s[0], s[1], s[2], s[3]}; }
    __syncthreads();
}

#ifndef FFT_LAS
#define FFT_LAS LAS
#endif
#if defined(__HIP_DEVICE_COMPILE__)
#define FFT_OPAQUE(v) asm volatile("" : "+v"(v))
#else
#define FFT_OPAQUE(v)
#endif
constexpr int FN = 16384;
constexpr int FFT_SLOTS = 18432;
__host__ __device__ __forceinline__ int fphys(int p) { return p + (p >> 3); }
__host__ __device__ __forceinline__ float fcos32(int k) {
    constexpr float T[16] = {1.0f, 0.98078528040323043f, 0.92387953251128674f, 0.83146961230254524f, 0.70710678118654752f, 0.55557023301960218f, 0.38268343236508977f, 0.19509032201612825f,
                             0.0f, -0.19509032201612825f, -0.38268343236508977f, -0.55557023301960218f, -0.70710678118654752f, -0.83146961230254524f, -0.92387953251128674f, -0.98078528040323043f};
    return T[k]; }
__host__ __device__ __forceinline__ float fsin32(int k) {
    constexpr float T[16] = {0.0f, 0.19509032201612825f, 0.38268343236508977f, 0.55557023301960218f, 0.70710678118654752f, 0.83146961230254524f, 0.92387953251128674f, 0.98078528040323043f,
                             1.0f, 0.98078528040323043f, 0.92387953251128674f, 0.83146961230254524f, 0.70710678118654752f, 0.55557023301960218f, 0.38268343236508977f, 0.19509032201612825f};
    return T[k]; }
template <int R> __host__ __device__ __forceinline__ constexpr int fbrev(int x) { int r = 0; for (int b = 1; b < R; b <<= 1) { r = (r << 1) | (x & 1); x >>= 1; } return r; }
template <int R, bool INV>
__host__ __device__ __forceinline__ void fft_reg(float (&xr)[R], float (&xi)[R]) {
#pragma unroll
    for (int len = R; len >= 2; len >>= 1) {
        const int half = len >> 1;
#pragma unroll
        for (int blk = 0; blk < R; blk += len)
#pragma unroll
            for (int k = 0; k < half; ++k) {
                const int i0 = blk + k, i1 = i0 + half;
                const float ar = xr[i0], ai = xi[i0], br = xr[i1], bi = xi[i1];
                xr[i0] = ar + br; xi[i0] = ai + bi;
                const float dr = ar - br, di = ai - bi;
                if (k == 0) { xr[i1] = dr; xi[i1] = di; }
                else if (4 * k == len) { if (!INV) { xr[i1] = di; xi[i1] = -dr; } else { xr[i1] = -di; xi[i1] = dr; } }
                else { const float c = fcos32(k * (32 / len)), s = fsin32(k * (32 / len));
                    if (!INV) { xr[i1] = dr * c + di * s; xi[i1] = di * c - dr * s; } else { xr[i1] = dr * c - di * s; xi[i1] = di * c + dr * s; } }
            }
    }
}
__host__ __device__ __forceinline__ void ftw(int num, int den, float& c, float& s) {
#if defined(__HIP_DEVICE_COMPILE__)
    const float fr = (float)num / (float)den; c = __builtin_amdgcn_cosf(fr); s = __builtin_amdgcn_sinf(fr);
#else
    const double a = 6.283185307179586476925 * (double)num / (double)den; c = (float)cos(a); s = (float)sin(a);
#endif
}
template <int R, int M>
__host__ __device__ __forceinline__ void fft_fwd_bfly(FFT_LAS float* buf, int B, int j) {
    constexpr int S = M / R;
    float xr[R], xi[R];
#pragma unroll
    for (int q = 0; q < R; ++q) { const f32x2 v = *(const FFT_LAS f32x2*)(buf + 2 * fphys(B + j + q * S)); xr[q] = v.x; xi[q] = v.y; }
    fft_reg<R, false>(xr, xi);
    if (S > 1) { float c1, s1; ftw(j, M, c1, s1); float wr = c1, wi = -s1;
#pragma unroll
        for (int r = 1; r < R; ++r) { const int ix = fbrev<R>(r); const float tr = xr[ix] * wr - xi[ix] * wi, ti = xr[ix] * wi + xi[ix] * wr; xr[ix] = tr; xi[ix] = ti;
            const float nr = wr * c1 + wi * s1, ni = wi * c1 - wr * s1; wr = nr; wi = ni; } }
#pragma unroll
    for (int r = 0; r < R; ++r) { const int ix = fbrev<R>(r); *(FFT_LAS f32x2*)(buf + 2 * fphys(B + j + r * S)) = (f32x2){xr[ix], xi[ix]}; }
}
template <int R, int M>
__host__ __device__ __forceinline__ void fft_inv_bfly(FFT_LAS float* buf, int B, int j) {
    constexpr int S = M / R;
    float xr[R], xi[R];
#pragma unroll
    for (int r = 0; r < R; ++r) { const f32x2 v = *(const FFT_LAS f32x2*)(buf + 2 * fphys(B + j + r * S)); xr[r] = v.x; xi[r] = v.y; }
    if (S > 1) { float c1, s1; ftw(j, M, c1, s1); float wr = c1, wi = s1;
#pragma unroll
        for (int r = 1; r < R; ++r) { const float tr = xr[r] * wr - xi[r] * wi, ti = xr[r] * wi + xi[r] * wr; xr[r] = tr; xi[r] = ti;
            const float nr = wr * c1 - wi * s1, ni = wi * c1 + wr * s1; wr = nr; wi = ni; } }
    fft_reg<R, true>(xr, xi);
#pragma unroll
    for (int q = 0; q < R; ++q) { const int ix = fbrev<R>(q); *(FFT_LAS f32x2*)(buf + 2 * fphys(B + j + q * S)) = (f32x2){xr[ix], xi[ix]}; }
}
__host__ __device__ __forceinline__ void fft_fwd_pass(FFT_LAS float* buf, int pass, int tid) {
    FFT_OPAQUE(tid);
    if (pass == 0) {
#pragma unroll 1
        for (int i = 0; i < 2; ++i) fft_fwd_bfly<16, 16384>(buf, 0, tid + 512 * i); }
    else if (pass == 1) {
#pragma unroll 1
        for (int i = 0; i < 2; ++i) { const int id = tid + 512 * i; fft_fwd_bfly<16, 1024>(buf, (id >> 6) * 1024, id & 63); } }
    else if (pass == 2) {
#pragma unroll 1
        for (int i = 0; i < 4; ++i) { const int id = tid + 512 * i; fft_fwd_bfly<8, 64>(buf, (id >> 3) * 64, id & 7); } }
    else {
#pragma unroll 1
        for (int i = 0; i < 4; ++i) { const int id = tid + 512 * i; fft_fwd_bfly<8, 8>(buf, id * 8, 0); } }
}
__host__ __device__ __forceinline__ void fft_inv_pass(FFT_LAS float* buf, int pass, int tid) {
    FFT_OPAQUE(tid);
    if (pass == 0) {
#pragma unroll 1
        for (int i = 0; i < 4; ++i) { const int id = tid + 512 * i; fft_inv_bfly<8, 8>(buf, id * 8, 0); } }
    else if (pass == 1) {
#pragma unroll 1
        for (int i = 0; i < 4; ++i) { const int id = tid + 512 * i; fft_inv_bfly<8, 64>(buf, (id >> 3) * 64, id & 7); } }
    else if (pass == 2) {
#pragma unroll 1
        for (int i = 0; i < 2; ++i) { const int id = tid + 512 * i; fft_inv_bfly<16, 1024>(buf, (id >> 6) * 1024, id & 63); } }
    else {
#pragma unroll 1
        for (int i = 0; i < 2; ++i) fft_inv_bfly<16, 16384>(buf, 0, tid + 512 * i); }
}
__host__ __device__ __forceinline__ int fpos(int k) { return ((k & 15) << 10) | (((k >> 4) & 15) << 6) | (((k >> 8) & 7) << 3) | (k >> 11); }
__host__ __device__ __forceinline__ void fft_mul_one(FFT_LAS float* buf, int k, float cr, float ci, float dr_, float di_, float wc, float ws) {
    const int k2 = (FN - k) & (FN - 1);
    FFT_LAS f32x2* pa = (FFT_LAS f32x2*)(buf + 2 * fphys(fpos(k))); FFT_LAS f32x2* pb = (FFT_LAS f32x2*)(buf + 2 * fphys(fpos(k2)));
    const f32x2 A = *pa, Bm = *pb;
    const float ar = A.x, ai = A.y, br = Bm.x, bi = -Bm.y, dr = dr_, di = -di_;
    const float uer = 0.5f * (ar + br), uei = 0.5f * (ai + bi), uor = 0.5f * (ai - bi), uoi = -0.5f * (ar - br);
    const float ker = 0.5f * (cr + dr), kei = 0.5f * (ci + di), kor = 0.5f * (ci - di), koi = -0.5f * (cr - dr);
    const float pr = uor * kor - uoi * koi, pi = uor * koi + uoi * kor;
    const float yer = (uer * ker - uei * kei) + (pr * wc + pi * ws), yei = (uer * kei + uei * ker) + (pi * wc - pr * ws);
    const float yor = (uer * kor - uei * koi) + (uor * ker - uoi * kei), yoi = (uer * koi + uei * kor) + (uor * kei + uoi * ker);
    *pa = (f32x2){yer - yoi, yei + yor};
    *pb = (f32x2){yer + yoi, -yei + yor};
}
__device__ __forceinline__ void p4_fft_job(Frame& F, int job) {
    const float* const* in = F.in;
    int tid_ = F.tid, lane_ = F.lane; FFT_OPAQUE(tid_); FFT_OPAQUE(lane_);
    const int tid = tid_, lane = lane_, wave = F.wave, c0 = job * 4;
    LAS float* buf = (LAS float*)F.lds;
    LAS float* scr = (LAS float*)(F.lds + FFTSCR_OFF);
    float* hfT = (float*)(F.ws + WS_KF); float* hbT = (float*)(F.ws + WS_KB); const float* uT = (const float*)(F.ws + WS_UIN);
    {
        const bf16* hd = (const bf16*)(F.ws + WS_HDN);
        const int n = lane & 15, kq = lane >> 4, ch = (n >> 1) & 3, dir = n & 1, col = dir * 1024 + c0 + ch; const bool valid = n < 8;
        bf16x8 bfr[2];
#pragma unroll
        for (int ks = 0; ks < 2; ++ks) { unsigned w[4];
#pragma unroll
            for (int j = 0; j < 4; ++j) { const int k = ks * 32 + kq * 8 + 2 * j; const float a = valid ? in[IN_FW3][(size_t)k * 2048 + col] : 0.f, b = valid ? in[IN_FW3][(size_t)(k + 1) * 2048 + col] : 0.f; w[j] = cvt_pk_bf16(a, b); }
            bfr[ks] = __builtin_bit_cast(bf16x8, (v4u){w[0], w[1], w[2], w[3]}); }
        const float b3 = valid ? in[IN_FB3][col] : 0.f;
        const float r_slow = 3.0701134573253945f, r_fast = 15.350567286626972f;
        const float rate = r_slow + (float)(c0 + ch) * ((r_fast - r_slow) / 1023.0f);
        float asum = 0.f; float* dst = (dir ? hbT : hfT) + (size_t)(c0 + ch) * L;
#pragma unroll 1
        for (int tb = wave * 8; tb < L / 16; tb += NWAVES * 8) {
            bf16x8 a0[8], a1[8];
#pragma unroll
            for (int i = 0; i < 8; ++i) { const bf16* hp = hd + (size_t)((tb + i) * 16 + n) * 64 + kq * 8; a0[i] = *(const bf16x8*)hp; a1[i] = *(const bf16x8*)(hp + 32); }
#pragma unroll
            for (int i = 0; i < 8; ++i) { const int t0 = (tb + i) * 16;
                f32x4 acc = (f32x4){b3, b3, b3, b3};
                acc = __builtin_amdgcn_mfma_f32_16x16x32_bf16(a0[i], bfr[0], acc, 0, 0, 0);
                acc = __builtin_amdgcn_mfma_f32_16x16x32_bf16(a1[i], bfr[1], acc, 0, 0, 0);
                if (valid) { f32x4 o;
#pragma unroll
                    for (int r = 0; r < 4; ++r) { const int t = t0 + 4 * kq + r; const float t01 = (float)t / (float)(L - 1); const float v = acc[r] * __expf(-t01 * rate); o[r] = v; if (!(dir && t == 0)) asum += fabsf(v); }
                    *(f32x4*)(dst + t0 + 4 * kq) = o; } }
        }
        asum += __shfl_xor(asum, 16); asum += __shfl_xor(asum, 32);
        if (lane < 8) scr[wave * 8 + lane] = asum;
        VM_WAIT(); __syncthreads();
        float tot = 0.f;
        if (tid < 4) { for (int w = 0; w < 8; ++w) tot += scr[w * 8 + 2 * tid] + scr[w * 8 + 2 * tid + 1]; }
        __syncthreads();
        if (tid < 4) scr[tid] = 1.0f / (tot * (float)FN);
        __syncthreads();
    }
#pragma unroll 1
    for (int ch = 0; ch < 4; ++ch) {
        const int c = c0 + ch;
        const float* hf = hfT + (size_t)c * L; const float* hb = hbT + (size_t)c * L; const float* uc = uT + (size_t)c * L;
#pragma unroll 8
        for (int i = 0; i < 16; ++i) { const int a = tid + NT * i; const f32x2 v = *(const f32x2*)(hf + 2 * a); *(LAS f32x2*)(buf + 2 * fphys(a)) = v; }
#pragma unroll 8
        for (int i = 0; i < 16; ++i) { const int a = FN / 2 + tid + NT * i; const float ko = hb[2 * FN - 2 * a - 1]; float ke = hb[2 * FN - 2 * a]; if (a == FN / 2) ke = 0.f;
            *(LAS f32x2*)(buf + 2 * fphys(a)) = (f32x2){ke, ko}; }
        __syncthreads();
        fft_fwd_pass(buf, 0, tid); __syncthreads(); fft_fwd_pass(buf, 1, tid); __syncthreads(); fft_fwd_pass(buf, 2, tid); __syncthreads(); fft_fwd_pass(buf, 3, tid); __syncthreads();
        {
            int tq = tid; FFT_OPAQUE(tq);
            f32x2* sa = (f32x2*)(hfT + (size_t)c * L); f32x2* sb = (f32x2*)(hbT + (size_t)c * L);
#pragma unroll 4
            for (int m = 0; m < 16; ++m) { const int k = tq + 512 * m, k2 = (FN - k) & (FN - 1);
                sa[m * 512 + tq] = *(const LAS f32x2*)(buf + 2 * fphys(fpos(k))); sb[m * 512 + tq] = *(const LAS f32x2*)(buf + 2 * fphys(fpos(k2))); }
            if (tid == 0) { const f32x2 h = *(const LAS f32x2*)(buf + 2 * fphys(fpos(FN / 2))); scr[8] = h.x; scr[9] = h.y; }
        }
        __syncthreads();
#pragma unroll 8
        for (int i = 0; i < 16; ++i) { const int a = tid + NT * i; const f32x2 v = *(const f32x2*)(uc + 2 * a); *(LAS f32x2*)(buf + 2 * fphys(a)) = v; }
#pragma unroll 4
        for (int i = 0; i < 16; ++i) { const int a = FN / 2 + tid + NT * i; *(LAS f32x2*)(buf + 2 * fphys(a)) = (f32x2){0.f, 0.f}; }
        __syncthreads();
        fft_fwd_pass(buf, 0, tid); __syncthreads(); fft_fwd_pass(buf, 1, tid); __syncthreads(); fft_fwd_pass(buf, 2, tid); __syncthreads(); fft_fwd_pass(buf, 3, tid); __syncthreads();
        {   int tq = tid; FFT_OPAQUE(tq);
            const f32x2* sa = (const f32x2*)(hfT + (size_t)c * L); const f32x2* sb = (const f32x2*)(hbT + (size_t)c * L);
            float c1, s1; ftw(tq, FN, c1, s1);
#pragma unroll 8
            for (int m = 0; m < 16; ++m) { const float cm = fcos32(m), sm = fsin32(m); const float wc = c1 * cm - s1 * sm, ws = s1 * cm + c1 * sm;
                const f32x2 ka = sa[m * 512 + tq], kb = sb[m * 512 + tq];
                fft_mul_one(buf, tq + 512 * m, ka.x, ka.y, kb.x, kb.y, wc, ws); }
            if (tid == 0) fft_mul_one(buf, FN / 2, scr[8], scr[9], scr[8], scr[9], -1.0f, 0.0f);
        }
        VM_WAIT(); __syncthreads();
        fft_inv_pass(buf, 0, tid); __syncthreads(); fft_inv_pass(buf, 1, tid); __syncthreads(); fft_inv_pass(buf, 2, tid); __syncthreads(); fft_inv_pass(buf, 3, tid); __syncthreads();
        { const float sc = scr[ch]; float* yT = hfT + (size_t)c * L;
#pragma unroll 2
            for (int nn = tid; nn < FN / 2; nn += NT) { const f32x2 v = *(const LAS f32x2*)(buf + 2 * fphys(nn)); *(f32x2*)(yT + 2 * nn) = (f32x2){v.x * sc, v.y * sc}; } }
        __syncthreads();
    }
    VM_WAIT(); __syncthreads();
    {
        const bf16* z = (const bf16*)(F.ws + WS_Z); bf16* cat = (bf16*)(F.ws + WS_CAT);
        float w0[4], w1[4], w2[4], bb[4], dsk[4];
#pragma unroll
        for (int q = 0; q < 4; ++q) { w0[q] = in[IN_CHW][c0 + q]; w1[q] = in[IN_CHW][3072 + c0 + q]; w2[q] = in[IN_CHW][6144 + c0 + q]; bb[q] = in[IN_CHB][c0 + q]; dsk[q] = in[IN_DSKIP][c0 + q]; }
#pragma unroll 4
        for (int t = tid; t < L; t += NT) {
            const v2u zc = *(const v2u*)(z + (size_t)t * NINP + OFF_HY + c0);
            const v2u zp = t > 0 ? *(const v2u*)(z + (size_t)(t - 1) * NINP + OFF_HY + c0) : (v2u){0u, 0u};
            const v2u zn = t < L - 1 ? *(const v2u*)(z + (size_t)(t + 1) * NINP + OFF_HY + c0) : (v2u){0u, 0u};
            const float pv[4] = {bflo(zp.x), bfhi(zp.x), bflo(zp.y), bfhi(zp.y)}, cv[4] = {bflo(zc.x), bfhi(zc.x), bflo(zc.y), bfhi(zc.y)}, nv[4] = {bflo(zn.x), bfhi(zn.x), bflo(zn.y), bfhi(zn.y)};
            float o[4];
#pragma unroll
            for (int q = 0; q < 4; ++q) { const float y = hfT[(size_t)(c0 + q) * L + t] + dsk[q] * uT[(size_t)(c0 + q) * L + t];
                o[q] = (pv[q] * w0[q] + cv[q] * w1[q] + nv[q] * w2[q] + bb[q]) * y; }
            v2u w; w.x = cvt_pk_bf16(o[0], o[1]); w.y = cvt_pk_bf16(o[2], o[3]);
            *(v2u*)(cat + (size_t)t * D + MVW + c0) = w;
        }
    }
    __syncthreads();
}
__device__ __forceinline__ void p6_norm2_router(Frame& F) {
    const float* const* in = F.in;
    const float* mod = (const float*)(F.ws + WS_MOD);
    bf16* h2 = (bf16*)(F.ws + WS_HA);
    int* cnt = (int*)(F.ws + WS_CTL) + CW_CNT;
    int* aexp = (int*)(F.ws + WS_AEXP); int* arank = (int*)(F.ws + WS_ARANK); float* aw = (float*)(F.ws + WS_AW);
    LAS float* hrow = (LAS float*)F.lds + F.wave * 2048;
    LAS float* wch = (LAS float*)(F.lds + 65536);
    const int lane = F.lane;
    for (int t0 = F.bid * 8; t0 < L; t0 += F.G * 8) {
        const int t = t0 + F.wave;
        {
            f32x4 v[8]; float ss = 0.f;
#pragma unroll
            for (int j = 0; j < 8; ++j) { const int col = 4 * lane + 256 * j; v[j] = *(const f32x4*)(F.out + (size_t)t * D + col); ss += (v[j].x * v[j].x + v[j].y * v[j].y) + (v[j].z * v[j].z + v[j].w * v[j].w); }
            const float rstd = rsqrtf(wave_sum(ss) * (1.0f / D) + EPS);
#pragma unroll
            for (int j = 0; j < 8; ++j) { const int col = 4 * lane + 256 * j;
                const f32x4 g = *(const f32x4*)(in[IN_GFFN] + col), sh = *(const f32x4*)(mod + 6144 + col), sc = *(const f32x4*)(mod + 8192 + col);
                const f32x4 h = (v[j] * rstd * g) * (sc + 1.0f) + sh;
                *(LAS f32x4*)(hrow + col) = h;
                v2u o; o.x = cvt_pk_bf16(h.x, h.y); o.y = cvt_pk_bf16(h.z, h.w);
                *(v2u*)(h2 + (size_t)t * D + col) = o; }
        }
        float logit = 0.f;
        for (int ch = 0; ch < 8; ++ch) {
            __syncthreads();
            for (int i = F.tid; i < 4096; i += NT) *(LAS f32x4*)(wch + 4 * i) = *(const f32x4*)(in[IN_WR] + (size_t)ch * 16384 + 4 * i);
            __syncthreads();
            const LAS float* hr = hrow + ch * 256;
#pragma unroll 4
            for (int i = 0; i < 256; i += 4) { const f32x4 hv = *(const LAS f32x4*)(hr + i);
                logit += hv.x * wch[(i + 0) * 64 + lane]; logit += hv.y * wch[(i + 1) * 64 + lane]; logit += hv.z * wch[(i + 2) * 64 + lane]; logit += hv.w * wch[(i + 3) * 64 + lane]; }
        }
        const float s = 1.0f / (1.0f + expf(-logit)), sel = s + in[IN_BR][lane];
        const int grp = lane >> 3;
        float m1 = sel; m1 = fmaxf(m1, __shfl_xor(m1, 1)); m1 = fmaxf(m1, __shfl_xor(m1, 2)); m1 = fmaxf(m1, __shfl_xor(m1, 4));
        const unsigned long long gm = 0xFFull << (8 * grp);
        const unsigned long long b1 = __ballot(sel == m1) & gm;
        const int first = __ffsll((long long)b1) - 1;
        float m2 = (lane == first) ? -INFINITY : sel; m2 = fmaxf(m2, __shfl_xor(m2, 1)); m2 = fmaxf(m2, __shfl_xor(m2, 2)); m2 = fmaxf(m2, __shfl_xor(m2, 4));
        const float gs = m1 + m2;
        int grank = 0;
#pragma unroll
        for (int g = 0; g < 8; ++g) { const float og = __shfl(gs, 8 * g); grank += (og > gs || (og == gs && g < grp)) ? 1 : 0; }
        const float masked = grank < 4 ? sel : -INFINITY;
        int rank = 0;
        for (int e2 = 0; e2 < 64; ++e2) { const float om = __shfl(masked, e2); rank += (om > masked || (om == masked && e2 < lane)) ? 1 : 0; }
        const bool chosen = rank < 8;
        const float wsum = wave_sum(chosen ? s : 0.f);
        const unsigned long long cb = __ballot(chosen);
        if (chosen) {
            const int k = (int)__builtin_amdgcn_mbcnt_hi((unsigned)(cb >> 32), __builtin_amdgcn_mbcnt_lo((unsigned)cb, 0u));
            const int half = t >= HALF_T ? 1 : 0;
            const int r = atomicAdd(cnt + half * 64 + lane, 1);
            aexp[t * 8 + k] = lane; arank[t * 8 + k] = r; aw[t * 8 + k] = s / wsum * 2.5f;
        }
    }
    __syncthreads();
}
__device__ __forceinline__ void build_pstart(Frame& F) {
    LAS int* ps = (LAS int*)(F.lds + LDSCTL_OFF);
    const int* cnt = (const int*)(F.ws + WS_CTL) + CW_CNT;
    __syncthreads();
    if (F.tid < 2) { int a = 0;
        for (int e = 0; e < NE; ++e) { ps[F.tid * 66 + e] = a; a += (__hip_atomic_load(cnt + F.tid * 64 + e, __ATOMIC_RELAXED, __HIP_MEMORY_SCOPE_AGENT) + 255) & ~255; }
        ps[F.tid * 66 + 64] = a; ps[F.tid * 66 + 65] = a + HALF_T; }
    __syncthreads();
}
__device__ __forceinline__ void p7_fill_rows(Frame& F) {
    build_pstart(F);
    const LAS int* ps = (const LAS int*)(F.lds + LDSCTL_OFF);
    const int* aexp = (const int*)(F.ws + WS_AEXP); const int* arank = (const int*)(F.ws + WS_ARANK); const float* aw = (const float*)(F.ws + WS_AW);
    int* rt = (int*)(F.ws + WS_RTOK); float* rw = (float*)(F.ws + WS_RW);
    const int gt = F.bid * NT + F.tid, NGT = F.G * NT;
    for (int i = gt; i < L * 8; i += NGT) { const int t = i >> 3, h = t >= HALF_T ? 1 : 0; const int row = ps[h * 66 + aexp[i]] + arank[i];
        rt[h * MAXROWS + row] = t; rw[h * MAXROWS + row] = aw[i]; }
    for (int t = gt; t < L; t += NGT) { const int h = t >= HALF_T ? 1 : 0; const int row = ps[h * 66 + 64] + (t - h * HALF_T);
        rt[h * MAXROWS + row] = t; rw[h * MAXROWS + row] = 1.0f; }
}
__device__ __forceinline__ void moe_combine(Frame& F, int half) {
    const float* const* in = F.in;
    const LAS int* ps = (const LAS int*)(F.lds + LDSCTL_OFF) + half * 66;
    const float* mod = (const float*)(F.ws + WS_MOD);
    const int* aexp = (const int*)(F.ws + WS_AEXP); const int* arank = (const int*)(F.ws + WS_ARANK);
    const bf16* Y2 = (const bf16*)(F.ws + WS_Y2);
    const int gw = F.bid * NWAVES + F.wave, NGW = F.G * NWAVES, lane = F.lane;
    for (int tt = gw; tt < HALF_T; tt += NGW) {
        const int t = half * HALF_T + tt;
        float a[32];
#pragma unroll
        for (int i = 0; i < 32; ++i) a[i] = 0.f;
#pragma unroll 3
        for (int k = 0; k < 9; ++k) {
            const int row = k < 8 ? ps[aexp[t * 8 + k]] + arank[t * 8 + k] : ps[64] + tt;
            const bf16* yr = Y2 + (size_t)row * D + 8 * lane;
#pragma unroll
            for (int j = 0; j < 4; ++j) { const v4u y = *(const v4u*)(yr + 512 * j);
                a[8 * j + 0] += bflo(y.x); a[8 * j + 1] += bfhi(y.x); a[8 * j + 2] += bflo(y.y); a[8 * j + 3] += bfhi(y.y);
                a[8 * j + 4] += bflo(y.z); a[8 * j + 5] += bfhi(y.z); a[8 * j + 6] += bflo(y.w); a[8 * j + 7] += bfhi(y.w); }
        }
        float ss = 0.f;
#pragma unroll
        for (int j = 0; j < 4; ++j)
#pragma unroll
            for (int q = 0; q < 2; ++q) { const int col = 8 * lane + 512 * j + 4 * q;
                const f32x4 x1 = *(const f32x4*)(F.out + (size_t)t * D + col), g2 = *(const f32x4*)(mod + 10240 + col);
                const int i = 8 * j + 4 * q;
                a[i] = x1.x + g2.x * a[i]; a[i + 1] = x1.y + g2.y * a[i + 1]; a[i + 2] = x1.z + g2.z * a[i + 2]; a[i + 3] = x1.w + g2.w * a[i + 3];
                ss += (a[i] * a[i] + a[i + 1] * a[i + 1]) + (a[i + 2] * a[i + 2] + a[i + 3] * a[i + 3]); }
        const float rstd = rsqrtf(wave_sum(ss) * (1.0f / D) + EPS);
#pragma unroll
        for (int j = 0; j < 4; ++j)
#pragma unroll
            for (int q = 0; q < 2; ++q) { const int col = 8 * lane + 512 * j + 4 * q; const int i = 8 * j + 4 * q;
                const f32x4 gf = *(const f32x4*)(in[IN_GFIN] + col);
                *(f32x4*)(F.out + (size_t)t * D + col) = (f32x4){a[i] * rstd * gf.x, a[i + 1] * rstd * gf.y, a[i + 2] * rstd * gf.z, a[i + 3] * rstd * gf.w}; }
    }
}

constexpr int N_PHASES = 14;
__global__ void __launch_bounds__(NT, 2) fwd_kernel(Args args) {
    extern __shared__ __attribute__((aligned(16))) unsigned char lds_raw[];
    Frame F;
    F.lds = (LAS unsigned char*)lds_raw;
    F.tid = threadIdx.x; F.lane = F.tid & 63; F.wave = __builtin_amdgcn_readfirstlane(F.tid >> 6);
    F.bid = blockIdx.x; F.G = gridDim.x;
    F.in = args.in; F.out = args.out; F.ws = args.ws;
    volatile LAS unsigned* MISC = (volatile LAS unsigned*)(F.lds + LDSCTL_OFF + 768);
    if (F.tid < 64) ((LAS unsigned*)(F.lds + LDSCTL_OFF))[F.tid + 192] = 0u;
    __syncthreads();
    unsigned* ctl = (unsigned*)(F.ws + WS_CTL);
    const int lo = args.ph_lo, hi = args.ph_hi;
    XcdBarrier bar; bar.bar = ctl + CW_BAR; bar.x = 0; bar.st = nullptr;
    if (hi - lo > 1) bar = xcd_barrier_post(ctl + CW_BAR, MISC + 8);
#ifndef PH_MASK
#define PH_MASK 0xFFFF
#endif
#define IN(k) (((PH_MASK >> (k)) & 1) && lo <= (k) && (k) < hi)
#define SEAM(k) do { if (IN(k) && IN((k) + 1)) xcd_barrier(bar); } while (0)
#define REP(k) for (int rep_ = 0; rep_ < ((PROBE_DUP) == (k) ? 2 : 1); ++rep_) if ((rep_ ? __syncthreads() : (void)0), true)
    LAS int* ps = (LAS int*)(F.lds + LDSCTL_OFF);

    if (IN(0)) REP(0) { p0_prologue(F); } SEAM(0);
    if (IN(1)) REP(1) { p1_norm1(F); } SEAM(1);
    if (IN(2)) {
        gk::DenseOrder S; S.init(MROWS, NINP, D, F.G, F.bid); S.Bt = (const char*)(F.ws + WS_WIN);
        gk::EpiBf16Store E{(bf16*)(F.ws + WS_Z), NINP};
        gk::gemm_core(F.lds, (const char*)(F.ws + WS_HA), D, S, E);
    }
#if PROBE_DUP == 2
    if (IN(2)) { __syncthreads(); } if (IN(2)) {
        gk::DenseOrder S; S.init(MROWS, NINP, D, F.G, F.bid); S.Bt = (const char*)(F.ws + WS_WIN);
        gk::EpiBf16Store E{(bf16*)(F.ws + WS_Z), NINP};
        gk::gemm_core(F.lds, (const char*)(F.ws + WS_HA), D, S, E);
    }
#endif
    SEAM(2);
    if (IN(3)) REP(3) {
        for (int it = F.bid; it < 1040; it += F.G) ml_prep_item(F, it);
        for (int tile = F.bid; tile < 256; tile += F.G) p3_filter_tile(F, tile);
        for (int tile = F.bid; tile < 1024; tile += F.G) p3_uin_tile(F, tile);
    } SEAM(3);
    if (IN(4)) REP(4) { ml_scan(F); } SEAM(4);
    if (IN(5)) {
        for (int job = F.bid; job < 256; job += F.G) p4_fft_job(F, job);
#if PROBE_DUP == 50
        __syncthreads(); for (int job = F.bid; job < 256; job += F.G) p4_fft_job(F, job);
#endif
        for (int it = F.bid; it < 1024; it += F.G) ml_out_item(F, it);
#if PROBE_DUP == 51
        __syncthreads(); for (int it = F.bid; it < 1024; it += F.G) ml_out_item(F, it);
#endif
    } SEAM(5);
    if (IN(6)) {
        gk::DenseOrder S; S.init(L, D, D, F.G, F.bid); S.Bt = (const char*)(F.ws + WS_WOUT);
        gk::EpiResidual E{F.out, D, (const float*)(F.ws + WS_MOD) + 4096};
        gk::gemm_core(F.lds, (const char*)(F.ws + WS_CAT), D, S, E);
    } SEAM(6);
    if (IN(7)) { p6_norm2_router(F); } SEAM(7);
    if (IN(8)) { p7_fill_rows(F); } SEAM(8);
#define MOE_GU(h) do { build_pstart(F); \
        gk::GroupOrder<4, true> S; S.ntile = ps[(h) * 66 + 65] >> 8; S.G = F.G; S.c = F.bid; S.K = D; S.pstart = ps + (h) * 66; S.rtok = (const int*)(F.ws + WS_RTOK) + (h) * MAXROWS; \
        S.Bt = (const char*)(F.ws + WS_W13); S.bstride = (size_t)1024 * D * 2; \
        gk::EpiGateUp E{(bf16*)(F.ws + WS_HR)}; \
        gk::gemm_core(F.lds, (const char*)(F.ws + WS_HA), D, S, E); } while (0)
#define MOE_DN(h) do { build_pstart(F); \
        gk::GroupOrder<8, false> S; S.ntile = ps[(h) * 66 + 65] >> 8; S.G = F.G; S.c = F.bid; S.K = DE; S.pstart = ps + (h) * 66; S.rtok = nullptr; \
        S.Bt = (const char*)(F.ws + WS_W2); S.bstride = (size_t)D * DE * 2; \
        gk::EpiDown E{(bf16*)(F.ws + WS_Y2), (const float*)(F.ws + WS_RW) + (h) * MAXROWS}; \
        gk::gemm_core(F.lds, (const char*)(F.ws + WS_HR), DE, S, E); } while (0)
    if (IN(9)) REP(9) { MOE_GU(0); } SEAM(9);
    if (IN(10)) REP(10) { MOE_DN(0); } SEAM(10);
    if (IN(11)) { MOE_GU(1); moe_combine(F, 0); } SEAM(11);
    if (IN(12)) REP(12) { MOE_DN(1); } SEAM(12);
    if (IN(13)) { build_pstart(F); moe_combine(F, 1); }
#undef IN
#undef SEAM
}

extern "C" void kernel_launch(void* const* d_in, const int* in_sizes, int n_in, void* d_out, int out_size, void* d_ws, size_t ws_size, hipStream_t stream) {
    static int grid = 0;
    if (grid == 0) {
        if (n_in != 36 || out_size != L * D || ws_size < WS_END) { fprintf(stderr, "kernel_launch: unexpected shapes: n_in %d out %d ws %zu (need %zu)\n", n_in, out_size, ws_size, (size_t)WS_END); grid = -1; return; }
        int dev = 0, cus = 0, per_cu = 0;
        if (hipGetDevice(&dev) != hipSuccess || hipDeviceGetAttribute(&cus, hipDeviceAttributeMultiprocessorCount, dev) != hipSuccess) { grid = -1; return; }
        if (hipFuncSetAttribute((const void*)fwd_kernel, hipFuncAttributeMaxDynamicSharedMemorySize, LDS_BYTES) != hipSuccess) { fprintf(stderr, "kernel_launch: hipFuncSetAttribute failed\n"); grid = -1; return; }
        if (hipOccupancyMaxActiveBlocksPerMultiprocessor(&per_cu, (const void*)fwd_kernel, NT, LDS_BYTES) != hipSuccess || per_cu < 1) fprintf(stderr, "kernel_launch: occupancy query says %d\n", per_cu);
        (void)hipGetLastError();
        grid = cus;
    }
    if (grid < 0) return;
    if (hipMemsetAsync((char*)d_ws + WS_CTL, 0, CTL_ZERO_BYTES, stream) != hipSuccess) return;
    Args a{};
    for (int i = 0; i < 36; ++i) a.in[i] = (const float*)d_in[i];
    a.out = (float*)d_out; a.ws = (unsigned char*)d_ws;
    const int stop = MK_STOP_AFTER < N_PHASES ? MK_STOP_AFTER + 1 : N_PHASES;
#if MK_N_LAUNCHES == 1
    a.ph_lo = 0; a.ph_hi = stop;
    hipLaunchKernelGGL(fwd_kernel, dim3(grid), dim3(NT), LDS_BYTES, stream, a);
#else
    for (int p = 0; p < stop; ++p) { a.ph_lo = p; a.ph_hi = p + 1; hipLaunchKernelGGL(fwd_kernel, dim3(grid), dim3(NT), LDS_BYTES, stream, a); }
#endif
}
```

```cpp
#include <hip/hip_runtime.h>
#include <cstdio>
#include <cstdint>

#ifndef MK_N_LAUNCHES
#define MK_N_LAUNCHES 1
#endif
#ifndef PROBE_DUP
#define PROBE_DUP -1
#endif
#ifndef MK_STOP_AFTER
#define MK_STOP_AFTER 99
#endif

#define GAS __attribute__((address_space(1)))
#define LAS __attribute__((address_space(3)))
typedef unsigned short bf16;
typedef unsigned v4u __attribute__((ext_vector_type(4)));
typedef unsigned v2u __attribute__((ext_vector_type(2)));
typedef float f32x4 __attribute__((ext_vector_type(4)));
typedef float f32x2 __attribute__((ext_vector_type(2)));
typedef short bf16x8 __attribute__((ext_vector_type(8)));
#define LDS_WAIT() asm volatile("s_waitcnt lgkmcnt(0)" ::: "memory")
#define VM_WAIT() asm volatile("s_waitcnt vmcnt(0)" ::: "memory")

constexpr int NWAVES = 8, NT = NWAVES * 64;
constexpr int L = 16384, D = 2048, LC = 256, MROWS = L + LC;
constexpr int NIN = 6176, NINP = 6400;
constexpr int OFF_K = 0, OFF_V = 512, OFF_G = 1536, OFF_Q = 1568, OFF_O = 2080, OFF_HY = 3104;
constexpr int NH = 8, HYW = 1024, MVW = 1024;
constexpr int NE = 64, NE1 = 65, DE = 512;
constexpr int HALF_T = 8192;
constexpr int MAXROWS = 90112;
constexpr float EPS = 1e-6f;

constexpr size_t MiB = 1u << 20;
constexpr size_t WS_CTL = 0, CTL_ZERO_BYTES = 256 * 1024;
constexpr size_t WS_MOD = 1 * MiB;
constexpr size_t WS_POS = WS_MOD + 128 * 1024;
constexpr size_t WS_WR1 = 2 * MiB + 512 * 1024;
constexpr size_t WS_WR2 = WS_WR1 + 256 * 1024;
constexpr size_t WS_WIN = 3 * MiB;
constexpr size_t WS_WOUT = 28 * MiB;
constexpr size_t WS_W13 = 36 * MiB;
constexpr size_t WS_W2 = 296 * MiB;
constexpr size_t WS_HA = 426 * MiB;
constexpr size_t WS_Z = 491 * MiB;
constexpr size_t WS_CAT = 695 * MiB;
constexpr size_t WS_UIN = 759 * MiB;
constexpr size_t WS_KF = 823 * MiB;
constexpr size_t WS_KB = 887 * MiB;
constexpr size_t WS_CL = 426 * MiB;
constexpr size_t WS_CI = 951 * MiB;
constexpr size_t WS_Q = 983 * MiB;
constexpr size_t WS_K = 999 * MiB;
constexpr size_t WS_RTOK = 1015 * MiB;
constexpr size_t WS_RW = WS_RTOK + 2 * MAXROWS * 4;
constexpr size_t WS_AEXP = 1017 * MiB;
constexpr size_t WS_ARANK = WS_AEXP + 512 * 1024;
constexpr size_t WS_AW = WS_ARANK + 512 * 1024;
constexpr size_t WS_HDN = 1019 * MiB;
constexpr size_t WS_SC = 1021 * MiB;
constexpr size_t WS_NL = WS_SC + 32 * 1024;
constexpr size_t WS_NI = WS_NL + 640 * 1024;
constexpr size_t WS_MI = WS_NI + 640 * 1024;
constexpr size_t WS_END = 1023 * MiB;
constexpr size_t WS_HR = 491 * MiB;
constexpr size_t WS_Y2 = 579 * MiB;
static_assert(WS_Y2 + (size_t)MAXROWS * 2048 * 2 <= WS_CI, "overlay");
constexpr int CW_BAR = 4096;
constexpr int CW_CNT = 16384;

constexpr int RING_BYTES = 131072;
constexpr int LDSCTL_OFF = 147456;
constexpr int FFTSCR_OFF = LDSCTL_OFF + 1024;
constexpr int LDS_BYTES = 151552;

__device__ __forceinline__ unsigned cvt_pk_bf16(float lo, float hi) { unsigned r; asm volatile("v_cvt_pk_bf16_f32 %0, %1, %2" : "=v"(r) : "v"(lo), "v"(hi)); return r; }
__device__ __forceinline__ float bf2f(unsigned short b) { return __builtin_bit_cast(float, ((unsigned)b) << 16); }
__device__ __forceinline__ float bflo(unsigned u) { return __builtin_bit_cast(float, u << 16); }
__device__ __forceinline__ float bfhi(unsigned u) { return __builtin_bit_cast(float, u & 0xffff0000u); }
__device__ __forceinline__ float wave_sum(float v) {
#pragma unroll
    for (int o = 1; o < 64; o <<= 1) v += __shfl_xor(v, o);
    return v;
}
__device__ __forceinline__ float silu_f(float a) { return a / (1.f + __expf(-a)); }
__device__ __forceinline__ float sigmoid_f(float a) { return 1.f / (1.f + __expf(-a)); }

#define XB_TMO      128
#define XB_XCNT(j)  (256  + 64 * (j))
#define XB_XSUB(j)  (1280 + 64 * (j))
#define XB_XGEN(j)  (2304 + 64 * (j))
#define XB_TOP      3328
#define XB_TOPGEN   3392
#define XCD_BAR_WORDS 3456
#define XB_SPIN_CAP (1u << 18)

__device__ __forceinline__ unsigned xb_ld(unsigned* p)              { return __hip_atomic_load(p, __ATOMIC_RELAXED, __HIP_MEMORY_SCOPE_AGENT); }
__device__ __forceinline__ unsigned xb_add(unsigned* p, unsigned v) { return __hip_atomic_fetch_add(p, v, __ATOMIC_RELAXED, __HIP_MEMORY_SCOPE_AGENT); }
__device__ __forceinline__ unsigned xb_xcc_id() { return (unsigned)__builtin_amdgcn_s_getreg((3 << 11) | 20) & 0xFu; }
#define XB_SPIN(cond, bar) do { unsigned _sp = 0; while (cond) { __builtin_amdgcn_s_sleep(1); \
    if ((++_sp & 255u) == 0u) { if (xb_ld(&(bar)[XB_TMO])) break; if (_sp > XB_SPIN_CAP) { atomicAdd(&(bar)[XB_TMO], 1u); break; } } } } while (0)

struct XcdBarrier {
    unsigned* bar; unsigned x;
    volatile LAS unsigned* st;
};

__device__ __forceinline__ XcdBarrier xcd_barrier_post(unsigned* bar, volatile LAS unsigned* st) {
    XcdBarrier b; b.bar = bar; b.x = xb_xcc_id(); b.st = st;
    if (threadIdx.x == 0) (void)xb_add(&bar[XB_XCNT(b.x)], 1u);
    return b;
}
__device__ __forceinline__ void xcd_barrier_complete(unsigned* bar, unsigned x, unsigned& nloc, unsigned& nx) {
    const unsigned G = gridDim.x * gridDim.y * gridDim.z;
    unsigned sum, cnt, mine, sp = 0u;
    for (;;) {
        sum = 0u; cnt = 0u; mine = 0u;
#pragma unroll
        for (unsigned j = 0; j < 16; ++j) { const unsigned c = xb_ld(&bar[XB_XCNT(j)]); sum += c; cnt += (c > 0u) ? 1u : 0u; mine = (j == x) ? c : mine; }
        if (sum == G) break;
        __builtin_amdgcn_s_sleep(1);
        if ((++sp & 255u) == 0u) { if (xb_ld(&bar[XB_TMO])) break; if (sp > XB_SPIN_CAP) { atomicAdd(&bar[XB_TMO], 1u); break; } }
    }
    nloc = mine > 0u ? mine : 1u; nx = cnt > 0u ? cnt : 1u;
}

__device__ __forceinline__ void xcd_barrier(const XcdBarrier& b) {
    asm volatile("s_waitcnt vmcnt(0)" ::: "memory");
    __syncthreads();
    if (threadIdx.x == 0) {
        unsigned* bar = b.bar;
        __builtin_amdgcn_s_waitcnt(0);
        unsigned nloc = b.st[0], nx = b.st[1];
        if (nloc == 0u) { xcd_barrier_complete(bar, b.x, nloc, nx); b.st[0] = nloc; b.st[1] = nx; }
        const unsigned old = xb_add(&bar[XB_XSUB(b.x)], 1u);
        const unsigned gen = old / nloc;
        if (old + 1u == (gen + 1u) * nloc) {
            __builtin_amdgcn_fence(__ATOMIC_RELEASE, "agent");
            asm volatile("s_waitcnt vmcnt(0)" ::: "memory");
            const unsigned og = xb_add(&bar[XB_TOP], 1u);
            const unsigned tg = og / nx;
            if (og + 1u == (tg + 1u) * nx) xb_add(&bar[XB_TOPGEN], 1u);
            else XB_SPIN(xb_ld(&bar[XB_TOPGEN]) == tg, bar);
            __builtin_amdgcn_fence(__ATOMIC_ACQUIRE, "agent");
            xb_add(&bar[XB_XGEN(b.x)], 1u);
            asm volatile("s_waitcnt vmcnt(0)" ::: "memory");
        } else {
            XB_SPIN(xb_ld(&bar[XB_XGEN(b.x)]) == gen, bar);
            __builtin_amdgcn_fence(__ATOMIC_ACQUIRE, "agent");
            asm volatile("s_waitcnt vmcnt(0)" ::: "memory");
        }
    }
    __syncthreads();
}

namespace gk {
constexpr int BM = 256, BK = 64, HALF = 128, HTB = HALF * BK * 2, STAGE_BYTES = 8 * HTB, NXCD = 8, WGM = 8;
__host__ __device__ __forceinline__ int lds_byte(int r, int c) { const int st = (r >> 4) * 2 + (c >> 5), rr = r & 15, cc = c & 31, ob = rr * 64 + cc * 2; return st * 1024 + (ob ^ (((ob >> 9) & 1) << 5)); }
__host__ __device__ __forceinline__ void stage_rc(int b, int& R, int& C) { const int st = b / 1024, sb = b % 1024, swz = sb ^ (((sb >> 9) & 1) << 5); R = (st >> 1) * 16 + swz / 64; C = (st & 1) * 32 + (swz % 64) / 2; }
__host__ __device__ __forceinline__ int perm32(int rho) { const int n = rho >> 4, i = rho & 15; return 8 * (i >> 2) + 4 * n + (i & 3); }

struct Unit { int pm, pn, ex; };

template <class Epi, class Sched>
__device__ __forceinline__ void gemm_core(LAS unsigned char* lds, const char* Abase, const int K, const Sched& S, const Epi& E) {
    const int tid = threadIdx.x, wid = __builtin_amdgcn_readfirstlane(tid >> 6), lane = tid & 63, wr = wid >> 2, wc = wid & 3, fr = lane & 15, fq = lane >> 4;
    const int nt = K / BK;
    int RA[2], CA[2]; unsigned voffB[2];
#pragma unroll
    for (int i = 0; i < 2; ++i) { int R, C; stage_rc(tid * 16 + i * 8192, R, C); const int Rb = Epi::PERM ? ((R & ~31) + perm32(R & 31)) : R;
        RA[i] = R; CA[i] = C; voffB[i] = (unsigned)(Rb * K + C) * 2u; }
    const size_t kstep = (size_t)(BK * 2);
    const size_t hstepB = (size_t)HALF * K * 2;
    const unsigned ldsw = (unsigned)wid * 1024u;
    const int aoff = lds_byte(wr * 64 + fr, fq * 8), boff = lds_byte(wc * 32 + fr, fq * 8);
#define GK_SA(b, h) (((b) * 2 + (h)) * HTB)
#define GK_SB(b, h) ((4 + (b) * 2 + (h)) * HTB)
#define GK_STAGE(bufoff, gbase, v0, v1) do { \
        __builtin_amdgcn_global_load_lds((const unsigned*)((const char*)(gbase) + (v0)), (LAS unsigned*)(lds + (bufoff) + ldsw), 16, 0, 0); \
        __builtin_amdgcn_global_load_lds((const unsigned*)((const char*)(gbase) + (v1)), (LAS unsigned*)(lds + (bufoff) + ldsw + 8192), 16, 0, 0); } while (0)
#define GK_LDA(dst, b, h) do { _Pragma("unroll") for (int m = 0; m < 4; ++m) _Pragma("unroll") for (int k = 0; k < 2; ++k) dst[m][k] = *(const LAS bf16x8*)(lds + GK_SA(b, h) + aoff + m * 2048 + k * 1024); } while (0)
#define GK_LDB(dst, b, h) do { _Pragma("unroll") for (int n = 0; n < 2; ++n) _Pragma("unroll") for (int k = 0; k < 2; ++k) dst[n][k] = *(const LAS bf16x8*)(lds + GK_SB(b, h) + boff + n * 2048 + k * 1024); } while (0)
#define GK_MMA(ai, bj, At, Bt) do { __builtin_amdgcn_s_setprio(1); _Pragma("unroll") for (int m = 0; m < 4; ++m) _Pragma("unroll") for (int n = 0; n < 2; ++n) _Pragma("unroll") for (int k = 0; k < 2; ++k) \
        acc[ai][bj][m][n] = __builtin_amdgcn_mfma_f32_16x16x32_bf16(Bt[n][k], At[m][k], acc[ai][bj][m][n], 0, 0, 0); __builtin_amdgcn_s_setprio(0); } while (0)
#define GK_WAIT_V(n) asm volatile("s_waitcnt vmcnt(" #n ")" ::: "memory")
#define GK_WAIT_L(n) asm volatile("s_waitcnt lgkmcnt(" #n ")" ::: "memory")
#define GK_BAR __builtin_amdgcn_s_barrier()
#define GK_SCHED __builtin_amdgcn_sched_barrier(0)
    Unit cur, nxt; int ui = 0;
    if (!S.next(0, cur)) return;
    f32x4 acc[2][2][4][2];
#pragma unroll
    for (int a = 0; a < 2; ++a)
#pragma unroll
        for (int b = 0; b < 2; ++b)
#pragma unroll
            for (int m = 0; m < 4; ++m)
#pragma unroll
                for (int n = 0; n < 2; ++n) acc[a][b][m][n] = (f32x4){0.f, 0.f, 0.f, 0.f};
    bf16x8 At[4][2], B0[2][2], B1[2][2];
    unsigned c00, c01, c10, c11, n00, n01, n10, n11;
    S.a_offs(cur, RA, CA, c00, c01, c10, c11);
    asm volatile("" : "+v"(c00), "+v"(c01), "+v"(c10), "+v"(c11));
    const char* cB = S.b_base(cur);
    GK_STAGE(GK_SB(0, 0), cB, voffB[0], voffB[1]); GK_STAGE(GK_SB(0, 1), cB + hstepB, voffB[0], voffB[1]); GK_STAGE(GK_SA(0, 0), Abase, c00, c01); GK_STAGE(GK_SA(0, 1), Abase, c10, c11);
    if (wr == 1) GK_BAR;
    GK_WAIT_V(2); GK_BAR;
    GK_STAGE(GK_SB(1, 0), cB + kstep, voffB[0], voffB[1]); GK_STAGE(GK_SA(1, 0), Abase + kstep, c00, c01); GK_STAGE(GK_SB(1, 1), cB + hstepB + kstep, voffB[0], voffB[1]);
    GK_WAIT_V(6); GK_BAR;
    for (;;) {
        const bool has_next = S.next(ui + 1, nxt);
        const char* nB = cB;
        n00 = c00; n01 = c01; n10 = c10; n11 = c11;
        if (has_next) { S.a_offs(nxt, RA, CA, n00, n01, n10, n11); nB = S.b_base(nxt); }
        asm volatile("" : "+v"(n00), "+v"(n01), "+v"(n10), "+v"(n11));
        for (int t = 0; t < nt; t += 2) {
            const bool last = (t == nt - 2);
            const char* a1 = Abase + (size_t)(t + 1) * kstep;
            const char* a2 = last ? Abase : Abase + (size_t)(t + 2) * kstep; const char* b2 = last ? nB : cB + (size_t)(t + 2) * kstep;
            const char* a3 = a2 + kstep; const char* b3 = b2 + kstep;
            const unsigned x00 = last ? n00 : c00, x01 = last ? n01 : c01, x10 = last ? n10 : c10, x11 = last ? n11 : c11;
            GK_LDB(B0, 0, 0); GK_LDB(B1, 0, 1); GK_SCHED; GK_LDA(At, 0, 0); GK_STAGE(GK_SA(1, 1), a1, c10, c11);
            GK_WAIT_V(8); GK_WAIT_L(0); GK_BAR; GK_MMA(0, 0, At, B0); GK_MMA(0, 1, At, B1); GK_BAR; GK_SCHED;
            GK_LDA(At, 0, 1); GK_STAGE(GK_SB(0, 0), b2, voffB[0], voffB[1]); GK_STAGE(GK_SB(0, 1), b2 + hstepB, voffB[0], voffB[1]); GK_STAGE(GK_SA(0, 0), a2, x00, x01);
            GK_WAIT_V(8); GK_WAIT_L(0); GK_BAR; GK_MMA(1, 0, At, B0); GK_MMA(1, 1, At, B1); GK_BAR; GK_SCHED;
            GK_LDB(B0, 1, 0); GK_LDB(B1, 1, 1); GK_SCHED; GK_LDA(At, 1, 0); GK_STAGE(GK_SA(0, 1), a2, x10, x11);
            GK_WAIT_V(8); GK_WAIT_L(0); GK_BAR; GK_MMA(0, 0, At, B0); GK_MMA(0, 1, At, B1); GK_BAR; GK_SCHED;
            GK_LDA(At, 1, 1); GK_STAGE(GK_SB(1, 0), b3, voffB[0], voffB[1]); GK_STAGE(GK_SB(1, 1), b3 + hstepB, voffB[0], voffB[1]); GK_STAGE(GK_SA(1, 0), a3, x00, x01);
            GK_WAIT_V(8); GK_WAIT_L(0); GK_BAR; GK_MMA(1, 0, At, B0); GK_MMA(1, 1, At, B1); GK_BAR; GK_SCHED;
        }
        if (wr == 0) GK_BAR;
        E(acc, cur, wr, wc, fr, fq);
        if (!has_next) break;
#pragma unroll
        for (int a = 0; a < 2; ++a)
#pragma unroll
            for (int b = 0; b < 2; ++b)
#pragma unroll
                for (int m = 0; m < 4; ++m)
#pragma unroll
                    for (int n = 0; n < 2; ++n) acc[a][b][m][n] = (f32x4){0.f, 0.f, 0.f, 0.f};
        cur = nxt; cB = nB; c00 = n00; c01 = n01; c10 = n10; c11 = n11; ++ui;
        if (wr == 1) GK_BAR;
    }
    GK_WAIT_V(0);
    GK_BAR;
#undef GK_SA
#undef GK_SB
#undef GK_STAGE
#undef GK_LDA
#undef GK_LDB
#undef GK_MMA
#undef GK_WAIT_V
#undef GK_WAIT_L
#undef GK_BAR
#undef GK_SCHED
}

struct DenseOrder {
    int nM, nN, nwg, G, c, K;
    __device__ void init(int M, int N, int K_, int G_, int c_) { nM = M / BM; nN = N / BM; nwg = nM * nN; G = G_; c = c_; K = K_; }
    __device__ __forceinline__ bool next(int i, Unit& u) const {
        const long Lx = (long)i * G + c; if (Lx >= nwg) return false;
        int wgid = (int)Lx; { const int q = nwg / NXCD, r = nwg % NXCD, xcd = wgid % NXCD, off = wgid / NXCD; wgid = (xcd < r ? xcd * (q + 1) : r * (q + 1) + (xcd - r) * q) + off; }
        const int nig = WGM * nN, gid = wgid / nig, fm = gid * WGM, gsz = (nM - fm) < WGM ? (nM - fm) : WGM;
        u.pm = fm + ((wgid % nig) % gsz); u.pn = (wgid % nig) / gsz; u.ex = 0; return true;
    }
    const char* Bt;
    __device__ __forceinline__ void a_offs(const Unit& u, const int (&RA)[2], const int (&CA)[2], unsigned& o00, unsigned& o01, unsigned& o10, unsigned& o11) const {
        const unsigned r0 = (unsigned)(u.pm * BM);
        o00 = ((r0 + RA[0]) * (unsigned)K + CA[0]) * 2u; o01 = ((r0 + RA[1]) * (unsigned)K + CA[1]) * 2u;
        o10 = ((r0 + HALF + RA[0]) * (unsigned)K + CA[0]) * 2u; o11 = ((r0 + HALF + RA[1]) * (unsigned)K + CA[1]) * 2u;
    }
    __device__ __forceinline__ const char* b_base(const Unit& u) const { return Bt + (size_t)u.pn * BM * K * 2; }
};
template <int NPN, bool GATHER>
struct GroupOrder {
    int ntile, G, c, K;
    const LAS int* pstart;
    const int* rtok;
    const char* Bt; size_t bstride;
    __device__ __forceinline__ bool next(int i, Unit& u) const {
        const long Lx = (long)i * G + c; if (Lx >= (long)ntile * NPN) return false;
        u.pm = (int)(Lx / NPN); u.pn = (int)(Lx % NPN);
        const int row = u.pm * BM; int lo = 0, hi = NE1;
        while (hi - lo > 1) { const int mid = (lo + hi) >> 1; if (pstart[mid] <= row) lo = mid; else hi = mid; }
        u.ex = lo; return true;
    }
    __device__ __forceinline__ void a_offs(const Unit& u, const int (&RA)[2], const int (&CA)[2], unsigned& o00, unsigned& o01, unsigned& o10, unsigned& o11) const {
        const int r0 = u.pm * BM;
        if (GATHER) {
            const int t00 = rtok[r0 + RA[0]], t01 = rtok[r0 + RA[1]], t10 = rtok[r0 + HALF + RA[0]], t11 = rtok[r0 + HALF + RA[1]];
            o00 = ((unsigned)t00 * (unsigned)K + CA[0]) * 2u; o01 = ((unsigned)t01 * (unsigned)K + CA[1]) * 2u;
            o10 = ((unsigned)t10 * (unsigned)K + CA[0]) * 2u; o11 = ((unsigned)t11 * (unsigned)K + CA[1]) * 2u;
        } else {
            o00 = ((unsigned)(r0 + RA[0]) * (unsigned)K + CA[0]) * 2u; o01 = ((unsigned)(r0 + RA[1]) * (unsigned)K + CA[1]) * 2u;
            o10 = ((unsigned)(r0 + HALF + RA[0]) * (unsigned)K + CA[0]) * 2u; o11 = ((unsigned)(r0 + HALF + RA[1]) * (unsigned)K + CA[1]) * 2u;
        }
    }
    __device__ __forceinline__ const char* b_base(const Unit& u) const { return Bt + (size_t)u.ex * bstride + (size_t)u.pn * BM * K * 2; }
};

struct EpiBf16Store {
    static constexpr bool PERM = true;
    bf16* O; int ldc;
    __device__ __forceinline__ void operator()(const f32x4 (&acc)[2][2][4][2], const Unit& u, int wr, int wc, int fr, int fq) const {
        const int row0 = u.pm * BM + wr * 64 + fr, col0 = u.pn * BM + wc * 32 + 8 * fq;
#pragma unroll
        for (int ai = 0; ai < 2; ++ai)
#pragma unroll
            for (int m = 0; m < 4; ++m) { bf16* rowp = O + (size_t)(row0 + ai * HALF + m * 16) * ldc + col0;
#pragma unroll
                for (int bj = 0; bj < 2; ++bj) { const f32x4 v0 = acc[ai][bj][m][0], v1 = acc[ai][bj][m][1];
                    v4u w; w.x = cvt_pk_bf16(v0[0], v0[1]); w.y = cvt_pk_bf16(v0[2], v0[3]); w.z = cvt_pk_bf16(v1[0], v1[1]); w.w = cvt_pk_bf16(v1[2], v1[3]);
                    *(v4u*)(rowp + bj * HALF) = w; } }
    }
};
struct EpiResidual {
    static constexpr bool PERM = false;
    float* X; int ldc; const float* gate;
    __device__ __forceinline__ void operator()(const f32x4 (&acc)[2][2][4][2], const Unit& u, int wr, int wc, int fr, int fq) const {
        const int row0 = u.pm * BM + wr * 64 + fr, col0 = u.pn * BM + wc * 32 + 4 * fq;
        f32x4 gv[2][2];
#pragma unroll
        for (int bj = 0; bj < 2; ++bj)
#pragma unroll
            for (int n = 0; n < 2; ++n) gv[bj][n] = *(const f32x4*)(gate + col0 + bj * HALF + n * 16);
#pragma unroll
        for (int ai = 0; ai < 2; ++ai)
#pragma unroll
            for (int m = 0; m < 4; ++m) { float* rowp = X + (size_t)(row0 + ai * HALF + m * 16) * ldc + col0;
#pragma unroll
                for (int bj = 0; bj < 2; ++bj)
#pragma unroll
                    for (int n = 0; n < 2; ++n) { f32x4* p = (f32x4*)(rowp + bj * HALF + n * 16); *p = *p + gv[bj][n] * acc[ai][bj][m][n]; } }
    }
};
struct EpiGateUp {
    static constexpr bool PERM = true;
    bf16* O;
    __device__ __forceinline__ void operator()(const f32x4 (&acc)[2][2][4][2], const Unit& u, int wr, int wc, int fr, int fq) const {
        const int row0 = u.pm * BM + wr * 64 + fr, col0 = u.pn * HALF + wc * 32 + 8 * fq;
#pragma unroll
        for (int ai = 0; ai < 2; ++ai)
#pragma unroll
            for (int m = 0; m < 4; ++m) { bf16* rowp = O + (size_t)(row0 + ai * HALF + m * 16) * DE + col0;
                float h[8];
#pragma unroll
                for (int n = 0; n < 2; ++n)
#pragma unroll
                    for (int j = 0; j < 4; ++j) { const float g = acc[ai][0][m][n][j], up = acc[ai][1][m][n][j]; h[n * 4 + j] = silu_f(g) * up; }
                v4u w; w.x = cvt_pk_bf16(h[0], h[1]); w.y = cvt_pk_bf16(h[2], h[3]); w.z = cvt_pk_bf16(h[4], h[5]); w.w = cvt_pk_bf16(h[6], h[7]);
                *(v4u*)rowp = w; }
    }
};
struct EpiDown {
    static constexpr bool PERM = true;
    bf16* O; const float* rw;
    __device__ __forceinline__ void operator()(const f32x4 (&acc)[2][2][4][2], const Unit& u, int wr, int wc, int fr, int fq) const {
        const int row0 = u.pm * BM + wr * 64 + fr, col0 = u.pn * BM + wc * 32 + 8 * fq;
#pragma unroll
        for (int ai = 0; ai < 2; ++ai)
#pragma unroll
            for (int m = 0; m < 4; ++m) { const int row = row0 + ai * HALF + m * 16; const float s = rw[row]; bf16* rowp = O + (size_t)row * D + col0;
#pragma unroll
                for (int bj = 0; bj < 2; ++bj) { const f32x4 v0 = acc[ai][bj][m][0] * s, v1 = acc[ai][bj][m][1] * s;
                    v4u w; w.x = cvt_pk_bf16(v0[0], v0[1]); w.y = cvt_pk_bf16(v0[2], v0[3]); w.z = cvt_pk_bf16(v1[0], v1[1]); w.w = cvt_pk_bf16(v1[2], v1[3]);
                    *(v4u*)(rowp + bj * HALF) = w; } }
    }
};
}

struct Args { const float* in[36]; float* out; unsigned char* ws; int ph_lo, ph_hi; };
struct Frame {
    LAS unsigned char* lds;
    int tid, lane, wave, bid, G;
    const float* const* in; float* out; unsigned char* ws;
};
#define IN_X 0
#define IN_C 1
#define IN_CTX 2
#define IN_CCTX 3
#define IN_WADA 4
#define IN_BADA 5
#define IN_GMIX 6
#define IN_GFFN 7
#define IN_WIN 8
#define IN_BGATES 9
#define IN_CKW 10
#define IN_CKB 11
#define IN_CQW 12
#define IN_CQB 13
#define IN_GHEAD 14
#define IN_CHW 15
#define IN_CHB 16
#define IN_FW1 17
#define IN_FB1 18
#define IN_FF1 19
#define IN_FW2 20
#define IN_FB2 21
#define IN_FF2 22
#define IN_FW3 23
#define IN_FB3 24
#define IN_DSKIP 25
#define IN_WOUT 26
#define IN_WR 27
#define IN_BR 28
#define IN_W1E 29
#define IN_W3E 30
#define IN_W2E 31
#define IN_W1S 32
#define IN_W3S 33
#define IN_W2S 34
#define IN_GFIN 35

__device__ __forceinline__ void transpose_item(const float* W, int N, int k0, int n0, bf16* WT, int dstK, int dst_row0, LAS float* scr, int lane) {
#pragma unroll 8
    for (int i = 0; i < 32; ++i) { const int kk = 2 * i + (lane >> 5); scr[kk * 33 + (lane & 31)] = W[(size_t)(k0 + kk) * N + n0 + (lane & 31)]; }
    LDS_WAIT(); asm volatile("" ::: "memory");
    const int c = lane & 7;
#pragma unroll
    for (int j = 0; j < 4; ++j) { const int n = (lane >> 3) + 8 * j; const LAS float* s = scr + (8 * c) * 33 + n;
        v4u o; o.x = cvt_pk_bf16(s[0 * 33], s[1 * 33]); o.y = cvt_pk_bf16(s[2 * 33], s[3 * 33]); o.z = cvt_pk_bf16(s[4 * 33], s[5 * 33]); o.w = cvt_pk_bf16(s[6 * 33], s[7 * 33]);
        *(v4u*)(WT + (size_t)(dst_row0 + n) * dstK + k0 + 8 * c) = o; }
    LDS_WAIT(); asm volatile("" ::: "memory");
}
__device__ __forceinline__ void p0_prologue(Frame& F) {
    const float* const* in = F.in;
    {
        LAS float* sv = (LAS float*)F.lds;
        LAS float* red = sv + 4096;
        float* mod = (float*)(F.ws + WS_MOD);
        for (int job = F.bid; job < 192; job += F.G) {
            for (int i = F.tid; i < 2048; i += NT) { sv[i] = silu_f(in[IN_C][i]); sv[2048 + i] = silu_f(in[IN_CCTX][i]); }
            __syncthreads();
            const int col = job * 64 + F.lane, r0 = F.wave * 256;
            const float* W = in[IN_WADA] + col;
            float a0 = 0.f, a1 = 0.f;
            for (int i = r0; i < r0 + 256; i += 8) {
                float w[8];
#pragma unroll
                for (int j = 0; j < 8; ++j) w[j] = W[(size_t)(i + j) * 12288];
#pragma unroll
                for (int j = 0; j < 8; ++j) { a0 += sv[i + j] * w[j]; a1 += sv[2048 + i + j] * w[j]; }
            }
            red[(F.wave * 64 + F.lane) * 2 + 0] = a0; red[(F.wave * 64 + F.lane) * 2 + 1] = a1;
            __syncthreads();
            if (F.wave == 0) { float s0 = 0.f, s1 = 0.f;
#pragma unroll
                for (int w = 0; w < 8; ++w) { s0 += red[(w * 64 + F.lane) * 2 + 0]; s1 += red[(w * 64 + F.lane) * 2 + 1]; }
                const float b = in[IN_BADA][col]; mod[col] = s0 + b; mod[12288 + col] = s1 + b; }
            __syncthreads();
        }
    }
    const int gt = F.bid * NT + F.tid, NGT = F.G * NT;
    {
        float* pos = (float*)(F.ws + WS_POS);
        for (int i = gt; i < 320 * 1024; i += NGT) { const int p = i >> 10, j = i & 1023, jj = j & 511;
            const float pp = (float)(p < 256 ? p : p - 256);
            const float omega = 1.0f / powf(10000.0f, (float)jj * (1.0f / 512.0f)); const float ang = pp * omega;
            pos[i] = j < 512 ? sinf(ang) : cosf(ang); }
    }
    {
        v4u* z = (v4u*)(F.ws + WS_WIN + (size_t)NIN * D * 2); const int nz = (NINP - NIN) * D * 2 / 16;
        for (int i = gt; i < nz; i += NGT) z[i] = (v4u){0u, 0u, 0u, 0u};
        int* rt = (int*)(F.ws + WS_RTOK); float* rw = (float*)(F.ws + WS_RW);
        for (int i = gt; i < 2 * MAXROWS; i += NGT) { rt[i] = 0; rw[i] = 0.f; }
    }
    {
        bf16* w1 = (bf16*)(F.ws + WS_WR1); bf16* w2 = (bf16*)(F.ws + WS_WR2);
        for (int i = gt; i < 64 * 2048; i += NGT) { const int e = i >> 11, k = i & 2047; const float w = in[IN_WR][k * 64 + e];
            const unsigned hi = cvt_pk_bf16(w, 0.f) & 0xffffu; const float r = w - bf2f((bf16)hi);
            w1[i] = (bf16)hi; w2[i] = (bf16)(cvt_pk_bf16(r, 0.f) & 0xffffu); }
    }
    {
        LAS float* scr = (LAS float*)(F.lds + F.wave * 16384);
        const int gw = F.bid * NWAVES + F.wave, NGW = F.G * NWAVES;
        constexpr int I_IN = 32 * 193, I_OUT = 32 * 64, I_E = 512 * NE1;
        constexpr int NITEMS = I_IN + I_OUT + 3 * I_E;
        for (int it = gw; it < NITEMS; it += NGW) {
            int r = it;
            if (r < I_IN) { const int kb = r / 193, nb = r % 193; transpose_item(in[IN_WIN], NIN, 64 * kb, 32 * nb, (bf16*)(F.ws + WS_WIN), D, 32 * nb, scr, F.lane); continue; } r -= I_IN;
            if (r < I_OUT) { const int kb = r / 64, nb = r % 64; transpose_item(in[IN_WOUT], D, 64 * kb, 32 * nb, (bf16*)(F.ws + WS_WOUT), D, 32 * nb, scr, F.lane); continue; } r -= I_OUT;
            if (r < 2 * I_E) { const int which = r >= I_E; if (which) r -= I_E;
                const int e = r / 512, rr = r % 512, kb = rr / 16, nb = rr % 16, n0 = 32 * nb;
                const float* src = e < NE ? in[which ? IN_W3E : IN_W1E] + (size_t)e * D * DE : in[which ? IN_W3S : IN_W1S];
                transpose_item(src, DE, 64 * kb, n0, (bf16*)(F.ws + WS_W13) + (size_t)e * 1024 * D, D, (n0 >> 7) * 256 + which * 128 + (n0 & 127), scr, F.lane); continue; }
            r -= 2 * I_E;
            { const int e = r / 512, rr = r % 512, kb = rr / 64, nb = rr % 64;
                const float* src = e < NE ? in[IN_W2E] + (size_t)e * DE * D : in[IN_W2S];
                transpose_item(src, D, 64 * kb, 32 * nb, (bf16*)(F.ws + WS_W2) + (size_t)e * D * DE, DE, 32 * nb, scr, F.lane); }
        }
    }
}

__device__ __forceinline__ void p1_norm1(Frame& F) {
    const float* const* in = F.in;
    const int gw = F.bid * NWAVES + F.wave, NGW = F.G * NWAVES;
    const float* mod = (const float*)(F.ws + WS_MOD); const float* pos = (const float*)(F.ws + WS_POS);
    bf16* hA = (bf16*)(F.ws + WS_HA);
    for (int row = gw; row < MROWS; row += NGW) {
        f32x4 v[8]; float ss = 0.f;
        const bool mainrow = row < L;
        const float* src = mainrow ? in[IN_X] + (size_t)row * D : in[IN_CTX] + (size_t)(row - L) * D;
        const float* md = mainrow ? mod : mod + 12288;
#pragma unroll
        for (int j = 0; j < 8; ++j) { const int col = 4 * F.lane + 256 * j; v[j] = *(const f32x4*)(src + col);
            if (mainrow) { const float* pp = col < 1024 ? pos + (size_t)(row >> 6) * 1024 + col : pos + (size_t)(256 + (row & 63)) * 1024 + (col - 1024);
                v[j] = v[j] + *(const f32x4*)pp; *(f32x4*)(F.out + (size_t)row * D + col) = v[j]; }
            ss += (v[j].x * v[j].x + v[j].y * v[j].y) + (v[j].z * v[j].z + v[j].w * v[j].w); }
        const float rstd = rsqrtf(wave_sum(ss) * (1.0f / D) + EPS);
#pragma unroll
        for (int j = 0; j < 8; ++j) { const int col = 4 * F.lane + 256 * j;
            const f32x4 g = *(const f32x4*)(in[IN_GMIX] + col), sh = *(const f32x4*)(md + col), sc = *(const f32x4*)(md + 2048 + col);
            const f32x4 h = (v[j] * rstd * g) * (sc + 1.0f) + sh;
            v2u o; o.x = cvt_pk_bf16(h.x, h.y); o.y = cvt_pk_bf16(h.z, h.w);
            *(v2u*)(hA + (size_t)row * D + col) = o; }
    }
}

constexpr int VT_PITCH = 136;
__device__ __forceinline__ float wave_incl_add(float x, int lane) {
#pragma unroll
    for (int o = 1; o < 64; o <<= 1) { const float y = __shfl_up(x, o); if (lane >= o) x += y; }
    return x;
}
__device__ __forceinline__ float wave_incl_max(float x, int lane) {
#pragma unroll
    for (int o = 1; o < 64; o <<= 1) { const float y = __shfl_up(x, o); if (lane >= o) x = fmaxf(x, y); }
    return x;
}
__device__ __forceinline__ void ml_gates(Frame& F, int dir, int h, int rowbase, LAS float* bb, LAS float* al, LAS float* mx, float& g, float& mtot) {
    const bf16* z = (const bf16*)(F.ws + WS_Z);
    const int lane = F.lane, pi0 = 2 * lane, p0 = dir ? 127 - pi0 : pi0, p1 = dir ? p0 - 1 : p0 + 1;
    const float bgi = F.in[IN_BGATES][dir * 16 + h], bgf = F.in[IN_BGATES][dir * 16 + 8 + h];
    const bf16* z0 = z + (size_t)(rowbase + p0) * NINP + OFF_G + dir * 16 + h; const bf16* z1 = z + (size_t)(rowbase + p1) * NINP + OFF_G + dir * 16 + h;
    const float i0 = bf2f(z0[0]) + bgi, f0 = bf2f(z0[8]) + bgf, i1 = bf2f(z1[0]) + bgi, f1 = bf2f(z1[8]) + bgf;
    const float l0 = fminf(f0, 0.f) - log1pf(__expf(-fabsf(f0))), l1 = fminf(f1, 0.f) - log1pf(__expf(-fabsf(f1)));
    const float incl = wave_incl_add(l0 + l1, lane);
    const float b1 = incl, b0 = incl - l1;
    const float a0 = i0 - b0, a1 = i1 - b1;
    const float mi = wave_incl_max(fmaxf(a0, a1), lane);
    float mprev = __shfl_up(mi, 1); if (lane == 0) mprev = -INFINITY;
    const float M0 = fmaxf(mprev, a0), M1 = mi;
    bb[p0] = b0; bb[p1] = b1; al[p0] = a0; al[p1] = a1; mx[p0] = M0; mx[p1] = M1;
    g = __shfl(incl, 63); mtot = __shfl(mi, 63);
}
__device__ __forceinline__ void ml_stage_vT(Frame& F, int h, int rowbase, LAS bf16* vT) {
    const bf16* z = (const bf16*)(F.ws + WS_Z);
    const int s = F.tid >> 2, eg = F.tid & 3;
#pragma unroll
    for (int i = 0; i < 4; ++i) { const int e0 = 32 * eg + 8 * i; const v4u v = *(const v4u*)(z + (size_t)(rowbase + s) * NINP + OFF_V + h * 128 + e0);
        const unsigned w[4] = {v.x, v.y, v.z, v.w};
#pragma unroll
        for (int q = 0; q < 4; ++q) { vT[(e0 + 2 * q) * VT_PITCH + s] = (bf16)(w[q] & 0xffffu); vT[(e0 + 2 * q + 1) * VT_PITCH + s] = (bf16)(w[q] >> 16); } }
}
__device__ __forceinline__ void ml_prep_item(Frame& F, int item) {
    const float* const* in = F.in;
    const int n = item >> 3, h = item & 7, tid = F.tid, lane = F.lane, wave = F.wave;
    const bool isctx = n >= 128;
    const int rowbase = isctx ? L + 128 * (n - 128) : 128 * n, seqlo = isctx ? L : 0, seqhi = isctx ? L + LC - 1 : L - 1;
    LAS bf16* vT = (LAS bf16*)F.lds;
    LAS bf16* kw0 = vT + 128 * VT_PITCH;
    LAS bf16* kw1 = kw0 + 64 * VT_PITCH;
    LAS float* fs = (LAS float*)(kw1 + 64 * VT_PITCH);
    const bf16* z = (const bf16*)(F.ws + WS_Z);
    if (wave < 2) { float g, mtot; LAS float* bbp = fs + 256 + wave * 384; ml_gates(F, wave, h, rowbase, bbp, bbp + 128, bbp + 256, g, mtot);
        LDS_WAIT();
        fs[wave * 128 + 2 * lane] = __expf(bbp[128 + 2 * lane] - mtot); fs[wave * 128 + 2 * lane + 1] = __expf(bbp[128 + 2 * lane + 1] - mtot);
        if (lane == 0) { float* sc = (float*)(F.ws + WS_SC) + ((size_t)(wave * 8 + h) * 130 + n) * 2; sc[0] = g; sc[1] = g + mtot; } }
    ml_stage_vT(F, h, rowbase, vT);
    __syncthreads();
    {
        const int s = tid >> 2, d0 = (tid & 3) * 16, R = rowbase + s; const bool hp = R > seqlo, hn = R < seqhi;
        float kv[16], qv[16];
#pragma unroll
        for (int part = 0; part < 2; ++part) {
            const int zc = (part ? OFF_Q : OFF_K) + h * 64 + d0; const float* cw = in[part ? IN_CQW : IN_CKW] + h * 64 + d0; const float* cb = in[part ? IN_CQB : IN_CKB] + h * 64 + d0;
#pragma unroll
            for (int hv = 0; hv < 2; ++hv) {
                const v4u c = *(const v4u*)(z + (size_t)R * NINP + zc + 8 * hv);
                const v4u p = hp ? *(const v4u*)(z + (size_t)(R - 1) * NINP + zc + 8 * hv) : (v4u){0u, 0u, 0u, 0u};
                const v4u nx = hn ? *(const v4u*)(z + (size_t)(R + 1) * NINP + zc + 8 * hv) : (v4u){0u, 0u, 0u, 0u};
                const unsigned cc[4] = {c.x, c.y, c.z, c.w}, pp[4] = {p.x, p.y, p.z, p.w}, nn[4] = {nx.x, nx.y, nx.z, nx.w};
#pragma unroll
                for (int q = 0; q < 4; ++q) { const int d = 8 * hv + 2 * q;
                    const float v0 = silu_f(bflo(pp[q]) * cw[d] + bflo(cc[q]) * cw[512 + d] + bflo(nn[q]) * cw[1024 + d] + cb[d]);
                    const float v1 = silu_f(bfhi(pp[q]) * cw[d + 1] + bfhi(cc[q]) * cw[512 + d + 1] + bfhi(nn[q]) * cw[1024 + d + 1] + cb[d + 1]);
                    if (part) { qv[d] = v0 * 0.125f; qv[d + 1] = v1 * 0.125f; } else { kv[d] = v0; kv[d + 1] = v1; } }
            }
        }
        if (!isctx) {
            bf16* Qg = (bf16*)(F.ws + WS_Q) + ((size_t)h * L + R) * 64 + d0; bf16* Kg = (bf16*)(F.ws + WS_K) + ((size_t)h * L + R) * 64 + d0;
#pragma unroll
            for (int hv = 0; hv < 2; ++hv) { v4u w;
                w.x = cvt_pk_bf16(qv[8 * hv], qv[8 * hv + 1]); w.y = cvt_pk_bf16(qv[8 * hv + 2], qv[8 * hv + 3]); w.z = cvt_pk_bf16(qv[8 * hv + 4], qv[8 * hv + 5]); w.w = cvt_pk_bf16(qv[8 * hv + 6], qv[8 * hv + 7]); *(v4u*)(Qg + 8 * hv) = w;
                w.x = cvt_pk_bf16(kv[8 * hv], kv[8 * hv + 1]); w.y = cvt_pk_bf16(kv[8 * hv + 2], kv[8 * hv + 3]); w.z = cvt_pk_bf16(kv[8 * hv + 4], kv[8 * hv + 5]); w.w = cvt_pk_bf16(kv[8 * hv + 6], kv[8 * hv + 7]); *(v4u*)(Kg + 8 * hv) = w; }
        }
        const float w0 = fs[s], w1 = fs[128 + s];
#pragma unroll
        for (int d = 0; d < 16; ++d) { const float kr = bf2f((bf16)(cvt_pk_bf16(kv[d], 0.f) & 0xffffu));
            kw0[(d0 + d) * VT_PITCH + s] = (bf16)(cvt_pk_bf16(kr * w0, 0.f) & 0xffffu); kw1[(d0 + d) * VT_PITCH + s] = (bf16)(cvt_pk_bf16(kr * w1, 0.f) & 0xffffu); }
    }
    __syncthreads();
    {
        const int fr = lane & 15, fq = lane >> 4;
        bf16x8 a[4];
#pragma unroll
        for (int kk = 0; kk < 4; ++kk) a[kk] = *(const LAS bf16x8*)(vT + (16 * wave + fr) * VT_PITCH + 32 * kk + 8 * fq);
#pragma unroll
        for (int dir = 0; dir < 2; ++dir) { const LAS bf16* kw = dir ? kw1 : kw0;
            float* cl = (float*)(F.ws + WS_CL) + ((size_t)((dir * 8 + h) * 130 + n)) * 8192;
#pragma unroll
            for (int dt = 0; dt < 4; ++dt) { f32x4 acc = (f32x4){0.f, 0.f, 0.f, 0.f};
#pragma unroll
                for (int kk = 0; kk < 4; ++kk) { const bf16x8 b = *(const LAS bf16x8*)(kw + (16 * dt + fr) * VT_PITCH + 32 * kk + 8 * fq); acc = __builtin_amdgcn_mfma_f32_16x16x32_bf16(a[kk], b, acc, 0, 0, 0); }
#pragma unroll
                for (int r = 0; r < 4; ++r) cl[(16 * wave + 4 * fq + r) * 64 + 16 * dt + fr] = acc[r]; } }
        if (tid < 128) { const int dir = tid >> 6, d = tid & 63; const LAS bf16* kw = (dir ? kw1 : kw0) + d * VT_PITCH; float s = 0.f;
            for (int i = 0; i < 128; ++i) s += bf2f(kw[i]);
            ((float*)(F.ws + WS_NL))[((size_t)((dir * 8 + h) * 130 + n)) * 64 + d] = s; }
    }
    __syncthreads();
}
__device__ __forceinline__ int ml_order(int dir, int step) { return step < 2 ? (dir ? 129 - step : 128 + step) : (dir ? 129 - step : step - 2); }
__device__ __forceinline__ void ml_scan(Frame& F) {
    const float* CL = (const float*)(F.ws + WS_CL); const float* SC = (const float*)(F.ws + WS_SC); const float* NLp = (const float*)(F.ws + WS_NL);
    bf16* CI = (bf16*)(F.ws + WS_CI); float* NI = (float*)(F.ws + WS_NI); float* MI = (float*)(F.ws + WS_MI);
    for (int idx = F.bid * NT + F.tid; idx < 16 * 8192; idx += F.G * NT) {
        const int dh = idx >> 13, rem = idx & 8191, dir = dh >> 3; const bool don = rem < 64;
        float c = 0.f, nn = 0.f, m = 0.f;
        for (int s0 = 0; s0 < 130; s0 += 10) {
            float cl[10], nl[10], gg[10], ml[10];
#pragma unroll
            for (int i = 0; i < 10; ++i) { const int ch = ml_order(dir, s0 + i); cl[i] = CL[((size_t)(dh * 130 + ch)) * 8192 + rem]; gg[i] = SC[(dh * 130 + ch) * 2]; ml[i] = SC[(dh * 130 + ch) * 2 + 1];
                nl[i] = don ? NLp[(size_t)(dh * 130 + ch) * 64 + rem] : 0.f; }
#pragma unroll
            for (int i = 0; i < 10; ++i) { const int ch = ml_order(dir, s0 + i);
                if (ch < 128) { CI[((size_t)(dh * 128 + ch)) * 8192 + rem] = (bf16)(cvt_pk_bf16(c, 0.f) & 0xffffu); if (don) NI[(size_t)(dh * 128 + ch) * 64 + rem] = nn; if (rem == 0) MI[dh * 128 + ch] = m; }
                const float mn = fmaxf(gg[i] + m, ml[i]), sp = __expf(gg[i] + m - mn), sl = __expf(ml[i] - mn);
                c = sp * c + sl * cl[i]; nn = sp * nn + sl * nl[i]; m = mn; }
        }
    }
}
__device__ __forceinline__ void ml_out_item(Frame& F, int item) {
    const float* const* in = F.in;
    const int n = item >> 3, h = item & 7, tid = F.tid, lane = F.lane, wave = F.wave, fr = lane & 15, fq = lane >> 4;
    const int rowbase = 128 * n;
    LAS bf16* vT = (LAS bf16*)F.lds;
    LAS float* fs = (LAS float*)(vT + 128 * VT_PITCH);
    const bf16* z = (const bf16*)(F.ws + WS_Z);
    if (wave < 2) { float g, mtot; LAS float* bbp = fs + wave * 384; ml_gates(F, wave, h, rowbase, bbp, bbp + 128, bbp + 256, g, mtot);
        if (lane == 0) fs[768 + wave] = ((const float*)(F.ws + WS_MI))[(wave * 8 + h) * 128 + n]; }
    ml_stage_vT(F, h, rowbase, vT);
    __syncthreads();
    const bf16* Qg = (const bf16*)(F.ws + WS_Q) + ((size_t)h * L + rowbase) * 64; const bf16* Kg = (const bf16*)(F.ws + WS_K) + ((size_t)h * L + rowbase) * 64;
    const int tl = 16 * wave + fr;
    bf16x8 qf[2];
#pragma unroll
    for (int kk = 0; kk < 2; ++kk) qf[kk] = *(const bf16x8*)(Qg + (size_t)tl * 64 + 32 * kk + 8 * fq);
    f32x4 st[8];
#pragma unroll
    for (int j = 0; j < 8; ++j) { f32x4 acc = (f32x4){0.f, 0.f, 0.f, 0.f};
#pragma unroll
        for (int kk = 0; kk < 2; ++kk) { const bf16x8 kf = *(const bf16x8*)(Kg + (size_t)(16 * j + fr) * 64 + 32 * kk + 8 * fq); acc = __builtin_amdgcn_mfma_f32_16x16x32_bf16(kf, qf[kk], acc, 0, 0, 0); }
        st[j] = acc; }
    f32x4 hs[8];
#pragma unroll
    for (int et = 0; et < 8; ++et) hs[et] = (f32x4){0.f, 0.f, 0.f, 0.f};
#pragma unroll 1
    for (int dir = 0; dir < 2; ++dir) {
        const LAS float* bbp = fs + dir * 384; const LAS float* alp = bbp + 128; const LAS float* mxp = bbp + 256;
        const float m_in = fs[768 + dir];
        const float beta = fmaxf(m_in, mxp[tl]);
        const int dh = dir * 8 + h;
        bf16x8 pf[4]; float dsum = 0.f;
#pragma unroll
        for (int kk = 0; kk < 4; ++kk) { float pv[8];
#pragma unroll
            for (int hh = 0; hh < 2; ++hh)
#pragma unroll
                for (int r = 0; r < 4; ++r) { const int s = 32 * kk + 16 * hh + 4 * fq + r; const bool ok = dir ? (s >= tl) : (s <= tl);
                    const float e = __expf(fminf(alp[s] - beta, 0.f)); const float v = ok ? st[2 * kk + hh][r] * e : 0.f; pv[4 * hh + r] = v; dsum += v; }
            pf[kk] = __builtin_bit_cast(bf16x8, (v4u){cvt_pk_bf16(pv[0], pv[1]), cvt_pk_bf16(pv[2], pv[3]), cvt_pk_bf16(pv[4], pv[5]), cvt_pk_bf16(pv[6], pv[7])}); }
        dsum += __shfl_xor(dsum, 16); dsum += __shfl_xor(dsum, 32);
        const float* nip = (const float*)(F.ws + WS_NI) + (size_t)(dh * 128 + n) * 64; float qn = 0.f;
#pragma unroll
        for (int kk = 0; kk < 2; ++kk) { const v4u qq = __builtin_bit_cast(v4u, qf[kk]); const unsigned w[4] = {qq.x, qq.y, qq.z, qq.w};
#pragma unroll
            for (int q = 0; q < 4; ++q) { const int d = 32 * kk + 8 * fq + 2 * q; qn += bflo(w[q]) * nip[d] + bfhi(w[q]) * nip[d + 1]; } }
        qn += __shfl_xor(qn, 16); qn += __shfl_xor(qn, 32);
        const float sc_t = __expf(m_in - beta);
        const float den = dsum + sc_t * qn, dn = fmaxf(fabsf(den), __expf(-(bbp[tl] + beta)));
        LAS float* xinv = fs + 772 + (wave * 2 + dir) * 32;
        if (fq == 0) { xinv[fr] = 1.0f / dn; xinv[16 + fr] = sc_t; }
        LDS_WAIT();
        float inv_r[4], sc_r[4];
#pragma unroll
        for (int r = 0; r < 4; ++r) { inv_r[r] = xinv[4 * fq + r]; sc_r[r] = xinv[16 + 4 * fq + r]; }
        const bf16* cip = (const bf16*)(F.ws + WS_CI) + (size_t)(dh * 128 + n) * 8192;
#pragma unroll
        for (int et = 0; et < 8; ++et) {
            f32x4 acc = (f32x4){0.f, 0.f, 0.f, 0.f}, acci = (f32x4){0.f, 0.f, 0.f, 0.f};
#pragma unroll
            for (int kk = 0; kk < 4; ++kk) {
                const bool live = dir ? (2 * kk + 1 >= wave) : (2 * kk <= wave);
                if (live) { const LAS bf16* vr = vT + (16 * et + fr) * VT_PITCH + 32 * kk + 4 * fq;
                    const v2u lo = *(const LAS v2u*)vr, hi = *(const LAS v2u*)(vr + 16);
                    const bf16x8 vb = __builtin_bit_cast(bf16x8, (v4u){lo.x, lo.y, hi.x, hi.y});
                    acc = __builtin_amdgcn_mfma_f32_16x16x32_bf16(pf[kk], vb, acc, 0, 0, 0); } }
#pragma unroll
            for (int kk = 0; kk < 2; ++kk) { const bf16x8 cb = *(const bf16x8*)(cip + (size_t)(16 * et + fr) * 64 + 32 * kk + 8 * fq); acci = __builtin_amdgcn_mfma_f32_16x16x32_bf16(qf[kk], cb, acci, 0, 0, 0); }
#pragma unroll
            for (int r = 0; r < 4; ++r) hs[et][r] += (acc[r] + sc_r[r] * acci[r]) * inv_r[r];
        }
    }
    float rs[4];
#pragma unroll
    for (int r = 0; r < 4; ++r) { float ss = 0.f;
#pragma unroll
        for (int et = 0; et < 8; ++et) ss += hs[et][r] * hs[et][r];
        ss += __shfl_xor(ss, 1); ss += __shfl_xor(ss, 2); ss += __shfl_xor(ss, 4); ss += __shfl_xor(ss, 8);
        rs[r] = rsqrtf(ss * (1.0f / 128.0f) + EPS); }
    bf16* cat = (bf16*)(F.ws + WS_CAT);
#pragma unroll
    for (int et = 0; et < 8; ++et) { const int col = h * 128 + 16 * et + fr; const float gh = in[IN_GHEAD][col];
#pragma unroll
        for (int r = 0; r < 4; ++r) { const int t = rowbase + 16 * wave + 4 * fq + r;
            const float o = hs[et][r] * rs[r] * gh * sigmoid_f(bf2f(z[(size_t)t * NINP + OFF_O + col]));
            cat[(size_t)t * D + col] = (bf16)(cvt_pk_bf16(o, 0.f) & 0xffffu); } }
    __syncthreads();
}

__device__ __forceinline__ void p3_filter_tile(Frame& F, int tile) {
    const float* const* in = F.in;
    const int tid = F.tid;
    LAS float* feat = (LAS float*)F.lds;
    LAS float* h1 = feat + 64 * 36;
    LAS float* h2 = h1 + 64 * 65;
    LAS float* w1s = h2 + 64 * 64;
    LAS float* w2s = w1s + 33 * 64;
    for (int i = tid; i < 33 * 64; i += NT) w1s[i] = in[IN_FW1][i];
    for (int i = tid; i < 64 * 64; i += NT) w2s[i] = in[IN_FW2][i];
    {
        const int tt = tid >> 3, sub = tid & 7; const float t = (float)(tile * 64 + tt);
        const float w = (6.2831855f * t) / (float)L;
        if (sub == 0) feat[tt * 36] = t / (float)(L - 1);
#pragma unroll
        for (int q = 0; q < 2; ++q) { const int bi = sub * 2 + q; const float band = 1e-4f + (float)bi * ((15.0f - 1e-4f) / 15.0f); const float ang = w * band;
            feat[tt * 36 + 1 + bi] = cosf(ang); feat[tt * 36 + 17 + bi] = -sinf(ang); }
    }
    __syncthreads();
    {
        const int tt = tid >> 3, j0 = (tid & 7) * 8;
        float a[8];
#pragma unroll
        for (int q = 0; q < 8; ++q) a[q] = in[IN_FB1][j0 + q];
#pragma unroll 1
        for (int i = 0; i < 33; ++i) { const float f = feat[tt * 36 + i];
#pragma unroll
            for (int q = 0; q < 8; ++q) a[q] += f * w1s[i * 64 + j0 + q]; }
#pragma unroll
        for (int q = 0; q < 8; ++q) h1[tt * 65 + j0 + q] = sinf(in[IN_FF1][j0 + q] * a[q]);
    }
    __syncthreads();
    {
        const int tt = tid >> 3, j0 = (tid & 7) * 8;
        float a[8];
#pragma unroll
        for (int q = 0; q < 8; ++q) a[q] = in[IN_FB2][j0 + q];
#pragma unroll 1
        for (int i = 0; i < 64; ++i) { const float f = h1[tt * 65 + i];
#pragma unroll
            for (int q = 0; q < 8; ++q) a[q] += f * w2s[i * 64 + j0 + q]; }
#pragma unroll
        for (int q = 0; q < 8; ++q) h2[tt * 64 + j0 + q] = sinf(in[IN_FF2][j0 + q] * a[q]);
    }
    __syncthreads();
    {
        bf16* hd = (bf16*)(F.ws + WS_HDN);
        for (int i = tid; i < 64 * 32; i += NT) { const int tt = i >> 5, j = (i & 31) * 2; *(unsigned*)(hd + (size_t)(tile * 64 + tt) * 64 + j) = cvt_pk_bf16(h2[tt * 64 + j], h2[tt * 64 + j + 1]); }
    }
    __syncthreads();
}
__device__ __forceinline__ void p3_uin_tile(Frame& F, int tile) {
    const float* const* in = F.in;
    const bf16* z = (const bf16*)(F.ws + WS_Z); float* uT = (float*)(F.ws + WS_UIN);
    LAS float* tl = (LAS float*)F.lds;
    const int t0 = (tile >> 2) * 64, cb = (tile & 3) * 256;
    const int cg = F.tid & 31, c0 = cb + cg * 8, rsub = F.tid >> 5;
    for (int pass = 0; pass < 4; ++pass) {
        const int tt = pass * 16 + rsub, t = t0 + tt;
        float r1[8], r2[8];
#pragma unroll
        for (int part = 0; part < 2; ++part) {
            const int zc = OFF_HY + 1024 * (part + 1) + c0, wc = 1024 * (part + 1) + c0;
            const v4u cur = *(const v4u*)(z + (size_t)t * NINP + zc);
            const v4u prv = t > 0 ? *(const v4u*)(z + (size_t)(t - 1) * NINP + zc) : (v4u){0u, 0u, 0u, 0u};
            const v4u nxt = t < L - 1 ? *(const v4u*)(z + (size_t)(t + 1) * NINP + zc) : (v4u){0u, 0u, 0u, 0u};
            float* rr = part ? r2 : r1;
#pragma unroll
            for (int q = 0; q < 4; ++q) {
                const unsigned pc = q == 0 ? prv.x : q == 1 ? prv.y : q == 2 ? prv.z : prv.w, cc = q == 0 ? cur.x : q == 1 ? cur.y : q == 2 ? cur.z : cur.w, nc = q == 0 ? nxt.x : q == 1 ? nxt.y : q == 2 ? nxt.z : nxt.w;
                const int ch = wc + 2 * q;
                rr[2 * q] = bflo(pc) * in[IN_CHW][ch] + bflo(cc) * in[IN_CHW][3072 + ch] + bflo(nc) * in[IN_CHW][6144 + ch] + in[IN_CHB][ch];
                rr[2 * q + 1] = bfhi(pc) * in[IN_CHW][ch + 1] + bfhi(cc) * in[IN_CHW][3072 + ch + 1] + bfhi(nc) * in[IN_CHW][6144 + ch + 1] + in[IN_CHB][ch + 1];
            }
        }
#pragma unroll
        for (int q = 0; q < 8; ++q) tl[(cg * 8 + q) * 65 + tt] = r1[q] * r2[q];
    }
    __syncthreads();
    for (int i = F.tid; i < 256 * 16; i += NT) { const int c = i >> 4, tq = (i & 15) * 4; const LAS float* s = tl + c * 65 + tq;
        *(f32x4*)(uT + (size_t)(cb + c) * L + t0 + tq) = (f32x4){s[0], s[1], s[2], s[3]}; }
    __syncthreads();
}

#ifndef FFT_LAS
#define FFT_LAS LAS
#endif
#if defined(__HIP_DEVICE_COMPILE__)
#define FFT_OPAQUE(v) asm volatile("" : "+v"(v))
#else
#define FFT_OPAQUE(v)
#endif
constexpr int FN = 16384;
constexpr int FFT_SLOTS = 18432;
__host__ __device__ __forceinline__ int fphys(int p) { return p + (p >> 3); }
__host__ __device__ __forceinline__ float fcos32(int k) {
    constexpr float T[16] = {1.0f, 0.98078528040323043f, 0.92387953251128674f, 0.83146961230254524f, 0.70710678118654752f, 0.55557023301960218f, 0.38268343236508977f, 0.19509032201612825f,
                             0.0f, -0.19509032201612825f, -0.38268343236508977f, -0.55557023301960218f, -0.70710678118654752f, -0.83146961230254524f, -0.92387953251128674f, -0.98078528040323043f};
    return T[k]; }
__host__ __device__ __forceinline__ float fsin32(int k) {
    constexpr float T[16] = {0.0f, 0.19509032201612825f, 0.38268343236508977f, 0.55557023301960218f, 0.70710678118654752f, 0.83146961230254524f, 0.92387953251128674f, 0.98078528040323043f,
                             1.0f, 0.98078528040323043f, 0.92387953251128674f, 0.83146961230254524f, 0.70710678118654752f, 0.55557023301960218f, 0.38268343236508977f, 0.19509032201612825f};
    return T[k]; }
template <int R> __host__ __device__ __forceinline__ constexpr int fbrev(int x) { int r = 0; for (int b = 1; b < R; b <<= 1) { r = (r << 1) | (x & 1); x >>= 1; } return r; }
template <int R, bool INV>
__host__ __device__ __forceinline__ void fft_reg(float (&xr)[R], float (&xi)[R]) {
#pragma unroll
    for (int len = R; len >= 2; len >>= 1) {
        const int half = len >> 1;
#pragma unroll
        for (int blk = 0; blk < R; blk += len)
#pragma unroll
            for (int k = 0; k < half; ++k) {
                const int i0 = blk + k, i1 = i0 + half;
                const float ar = xr[i0], ai = xi[i0], br = xr[i1], bi = xi[i1];
                xr[i0] = ar + br; xi[i0] = ai + bi;
                const float dr = ar - br, di = ai - bi;
                if (k == 0) { xr[i1] = dr; xi[i1] = di; }
                else if (4 * k == len) { if (!INV) { xr[i1] = di; xi[i1] = -dr; } else { xr[i1] = -di; xi[i1] = dr; } }
                else { const float c = fcos32(k * (32 / len)), s = fsin32(k * (32 / len));
                    if (!INV) { xr[i1] = dr * c + di * s; xi[i1] = di * c - dr * s; } else { xr[i1] = dr * c - di * s; xi[i1] = di * c + dr * s; } }
            }
    }
}
__host__ __device__ __forceinline__ void ftw(int num, int den, float& c, float& s) {
#if defined(__HIP_DEVICE_COMPILE__)
    const float fr = (float)num / (float)den; c = __builtin_amdgcn_cosf(fr); s = __builtin_amdgcn_sinf(fr);
#else
    const double a = 6.283185307179586476925 * (double)num / (double)den; c = (float)cos(a); s = (float)sin(a);
#endif
}
template <int R, int M>
__host__ __device__ __forceinline__ void fft_fwd_bfly(FFT_LAS float* buf, int B, int j) {
    constexpr int S = M / R;
    float xr[R], xi[R];
#pragma unroll
    for (int q = 0; q < R; ++q) { const f32x2 v = *(const FFT_LAS f32x2*)(buf + 2 * fphys(B + j + q * S)); xr[q] = v.x; xi[q] = v.y; }
    fft_reg<R, false>(xr, xi);
    if (S > 1) { float c1, s1; ftw(j, M, c1, s1); float wr = c1, wi = -s1;
#pragma unroll
        for (int r = 1; r < R; ++r) { const int ix = fbrev<R>(r); const float tr = xr[ix] * wr - xi[ix] * wi, ti = xr[ix] * wi + xi[ix] * wr; xr[ix] = tr; xi[ix] = ti;
            const float nr = wr * c1 + wi * s1, ni = wi * c1 - wr * s1; wr = nr; wi = ni; } }
#pragma unroll
    for (int r = 0; r < R; ++r) { const int ix = fbrev<R>(r); *(FFT_LAS f32x2*)(buf + 2 * fphys(B + j + r * S)) = (f32x2){xr[ix], xi[ix]}; }
}
template <int R, int M>
__host__ __device__ __forceinline__ void fft_inv_bfly(FFT_LAS float* buf, int B, int j) {
    constexpr int S = M / R;
    float xr[R], xi[R];
#pragma unroll
    for (int r = 0; r < R; ++r) { const f32x2 v = *(const FFT_LAS f32x2*)(buf + 2 * fphys(B + j + r * S)); xr[r] = v.x; xi[r] = v.y; }
    if (S > 1) { float c1, s1; ftw(j, M, c1, s1); float wr = c1, wi = s1;
#pragma unroll
        for (int r = 1; r < R; ++r) { const float tr = xr[r] * wr - xi[r] * wi, ti = xr[r] * wi + xi[r] * wr; xr[r] = tr; xi[r] = ti;
            const float nr = wr * c1 - wi * s1, ni = wi * c1 + wr * s1; wr = nr; wi = ni; } }
    fft_reg<R, true>(xr, xi);
#pragma unroll
    for (int q = 0; q < R; ++q) { const int ix = fbrev<R>(q); *(FFT_LAS f32x2*)(buf + 2 * fphys(B + j + q * S)) = (f32x2){xr[ix], xi[ix]}; }
}
__host__ __device__ __forceinline__ void fft_fwd_pass(FFT_LAS float* buf, int pass, int tid) {
    FFT_OPAQUE(tid);
    if (pass == 0) {
#pragma unroll 1
        for (int i = 0; i < 2; ++i) fft_fwd_bfly<16, 16384>(buf, 0, tid + 512 * i); }
    else if (pass == 1) {
#pragma unroll 1
        for (int i = 0; i < 2; ++i) { const int id = tid + 512 * i; fft_fwd_bfly<16, 1024>(buf, (id >> 6) * 1024, id & 63); } }
    else if (pass == 2) {
#pragma unroll 1
        for (int i = 0; i < 4; ++i) { const int id = tid + 512 * i; fft_fwd_bfly<8, 64>(buf, (id >> 3) * 64, id & 7); } }
    else {
#pragma unroll 1
        for (int i = 0; i < 4; ++i) { const int id = tid + 512 * i; fft_fwd_bfly<8, 8>(buf, id * 8, 0); } }
}
__host__ __device__ __forceinline__ void fft_inv_pass(FFT_LAS float* buf, int pass, int tid) {
    FFT_OPAQUE(tid);
    if (pass == 0) {
#pragma unroll 1
        for (int i = 0; i < 4; ++i) { const int id = tid + 512 * i; fft_inv_bfly<8, 8>(buf, id * 8, 0); } }
    else if (pass == 1) {
#pragma unroll 1
        for (int i = 0; i < 4; ++i) { const int id = tid + 512 * i; fft_inv_bfly<8, 64>(buf, (id >> 3) * 64, id & 7); } }
    else if (pass == 2) {
#pragma unroll 1
        for (int i = 0; i < 2; ++i) { const int id = tid + 512 * i; fft_inv_bfly<16, 1024>(buf, (id >> 6) * 1024, id & 63); } }
    else {
#pragma unroll 1
        for (int i = 0; i < 2; ++i) fft_inv_bfly<16, 16384>(buf, 0, tid + 512 * i); }
}
__host__ __device__ __forceinline__ int fpos(int k) { return ((k & 15) << 10) | (((k >> 4) & 15) << 6) | (((k >> 8) & 7) << 3) | (k >> 11); }
__host__ __device__ __forceinline__ void fft_mul_one(FFT_LAS float* buf, int k, float cr, float ci, float dr_, float di_, float wc, float ws) {
    const int k2 = (FN - k) & (FN - 1);
    FFT_LAS f32x2* pa = (FFT_LAS f32x2*)(buf + 2 * fphys(fpos(k))); FFT_LAS f32x2* pb = (FFT_LAS f32x2*)(buf + 2 * fphys(fpos(k2)));
    const f32x2 A = *pa, Bm = *pb;
    const float ar = A.x, ai = A.y, br = Bm.x, bi = -Bm.y, dr = dr_, di = -di_;
    const float uer = 0.5f * (ar + br), uei = 0.5f * (ai + bi), uor = 0.5f * (ai - bi), uoi = -0.5f * (ar - br);
    const float ker = 0.5f * (cr + dr), kei = 0.5f * (ci + di), kor = 0.5f * (ci - di), koi = -0.5f * (cr - dr);
    const float pr = uor * kor - uoi * koi, pi = uor * koi + uoi * kor;
    const float yer = (uer * ker - uei * kei) + (pr * wc + pi * ws), yei = (uer * kei + uei * ker) + (pi * wc - pr * ws);
    const float yor = (uer * kor - uei * koi) + (uor * ker - uoi * kei), yoi = (uer * koi + uei * kor) + (uor * kei + uoi * ker);
    *pa = (f32x2){yer - yoi, yei + yor};
    *pb = (f32x2){yer + yoi, -yei + yor};
}
__device__ __forceinline__ void p4_fft_job(Frame& F, int job) {
    const float* const* in = F.in;
    int tid_ = F.tid, lane_ = F.lane; FFT_OPAQUE(tid_); FFT_OPAQUE(lane_);
    const int tid = tid_, lane = lane_, wave = F.wave, c0 = job * 4;
    LAS float* buf = (LAS float*)F.lds;
    LAS float* scr = (LAS float*)(F.lds + FFTSCR_OFF);
    float* hfT = (float*)(F.ws + WS_KF); float* hbT = (float*)(F.ws + WS_KB); const float* uT = (const float*)(F.ws + WS_UIN);
    {
        const bf16* hd = (const bf16*)(F.ws + WS_HDN);
        const int n = lane & 15, kq = lane >> 4, ch = (n >> 1) & 3, dir = n & 1, col = dir * 1024 + c0 + ch; const bool valid = n < 8;
        bf16x8 bfr[2];
#pragma unroll
        for (int ks = 0; ks < 2; ++ks) { unsigned w[4];
#pragma unroll
            for (int j = 0; j < 4; ++j) { const int k = ks * 32 + kq * 8 + 2 * j; const float a = valid ? in[IN_FW3][(size_t)k * 2048 + col] : 0.f, b = valid ? in[IN_FW3][(size_t)(k + 1) * 2048 + col] : 0.f; w[j] = cvt_pk_bf16(a, b); }
            bfr[ks] = __builtin_bit_cast(bf16x8, (v4u){w[0], w[1], w[2], w[3]}); }
        const float b3 = valid ? in[IN_FB3][col] : 0.f;
        const float r_slow = 3.0701134573253945f, r_fast = 15.350567286626972f;
        const float rate = r_slow + (float)(c0 + ch) * ((r_fast - r_slow) / 1023.0f);
        float asum = 0.f; float* dst = (dir ? hbT : hfT) + (size_t)(c0 + ch) * L;
#pragma unroll 1
        for (int tb = wave * 8; tb < L / 16; tb += NWAVES * 8) {
            bf16x8 a0[8], a1[8];
#pragma unroll
            for (int i = 0; i < 8; ++i) { const bf16* hp = hd + (size_t)((tb + i) * 16 + n) * 64 + kq * 8; a0[i] = *(const bf16x8*)hp; a1[i] = *(const bf16x8*)(hp + 32); }
#pragma unroll
            for (int i = 0; i < 8; ++i) { const int t0 = (tb + i) * 16;
                f32x4 acc = (f32x4){b3, b3, b3, b3};
                acc = __builtin_amdgcn_mfma_f32_16x16x32_bf16(a0[i], bfr[0], acc, 0, 0, 0);
                acc = __builtin_amdgcn_mfma_f32_16x16x32_bf16(a1[i], bfr[1], acc, 0, 0, 0);
                if (valid) { f32x4 o;
#pragma unroll
                    for (int r = 0; r < 4; ++r) { const int t = t0 + 4 * kq + r; const float t01 = (float)t / (float)(L - 1); const float v = acc[r] * __expf(-t01 * rate); o[r] = v; if (!(dir && t == 0)) asum += fabsf(v); }
                    *(f32x4*)(dst + t0 + 4 * kq) = o; } }
        }
        asum += __shfl_xor(asum, 16); asum += __shfl_xor(asum, 32);
        if (lane < 8) scr[wave * 8 + lane] = asum;
        VM_WAIT(); __syncthreads();
        float tot = 0.f;
        if (tid < 4) { for (int w = 0; w < 8; ++w) tot += scr[w * 8 + 2 * tid] + scr[w * 8 + 2 * tid + 1]; }
        __syncthreads();
        if (tid < 4) scr[tid] = 1.0f / (tot * (float)FN);
        __syncthreads();
    }
#pragma unroll 1
    for (int ch = 0; ch < 4; ++ch) {
        const int c = c0 + ch;
        const float* hf = hfT + (size_t)c * L; const float* hb = hbT + (size_t)c * L; const float* uc = uT + (size_t)c * L;
#pragma unroll 8
        for (int i = 0; i < 16; ++i) { const int a = tid + NT * i; const f32x2 v = *(const f32x2*)(hf + 2 * a); *(LAS f32x2*)(buf + 2 * fphys(a)) = v; }
#pragma unroll 8
        for (int i = 0; i < 16; ++i) { const int a = FN / 2 + tid + NT * i; const float ko = hb[2 * FN - 2 * a - 1]; float ke = hb[2 * FN - 2 * a]; if (a == FN / 2) ke = 0.f;
            *(LAS f32x2*)(buf + 2 * fphys(a)) = (f32x2){ke, ko}; }
        __syncthreads();
        fft_fwd_pass(buf, 0, tid); __syncthreads(); fft_fwd_pass(buf, 1, tid); __syncthreads(); fft_fwd_pass(buf, 2, tid); __syncthreads(); fft_fwd_pass(buf, 3, tid); __syncthreads();
        {
            int tq = tid; FFT_OPAQUE(tq);
            f32x2* sa = (f32x2*)(hfT + (size_t)c * L); f32x2* sb = (f32x2*)(hbT + (size_t)c * L);
#pragma unroll 4
            for (int m = 0; m < 16; ++m) { const int k = tq + 512 * m, k2 = (FN - k) & (FN - 1);
                sa[m * 512 + tq] = *(const LAS f32x2*)(buf + 2 * fphys(fpos(k))); sb[m * 512 + tq] = *(const LAS f32x2*)(buf + 2 * fphys(fpos(k2))); }
            if (tid == 0) { const f32x2 h = *(const LAS f32x2*)(buf + 2 * fphys(fpos(FN / 2))); scr[8] = h.x; scr[9] = h.y; }
        }
        __syncthreads();
#pragma unroll 8
        for (int i = 0; i < 16; ++i) { const int a = tid + NT * i; const f32x2 v = *(const f32x2*)(uc + 2 * a); *(LAS f32x2*)(buf + 2 * fphys(a)) = v; }
#pragma unroll 4
        for (int i = 0; i < 16; ++i) { const int a = FN / 2 + tid + NT * i; *(LAS f32x2*)(buf + 2 * fphys(a)) = (f32x2){0.f, 0.f}; }
        __syncthreads();
        fft_fwd_pass(buf, 0, tid); __syncthreads(); fft_fwd_pass(buf, 1, tid); __syncthreads(); fft_fwd_pass(buf, 2, tid); __syncthreads(); fft_fwd_pass(buf, 3, tid); __syncthreads();
        {   int tq = tid; FFT_OPAQUE(tq);
            const f32x2* sa = (const f32x2*)(hfT + (size_t)c * L); const f32x2* sb = (const f32x2*)(hbT + (size_t)c * L);
            float c1, s1; ftw(tq, FN, c1, s1);
#pragma unroll 8
            for (int m = 0; m < 16; ++m) { const float cm = fcos32(m), sm = fsin32(m); const float wc = c1 * cm - s1 * sm, ws = s1 * cm + c1 * sm;
                const f32x2 ka = sa[m * 512 + tq], kb = sb[m * 512 + tq];
                fft_mul_one(buf, tq + 512 * m, ka.x, ka.y, kb.x, kb.y, wc, ws); }
            if (tid == 0) fft_mul_one(buf, FN / 2, scr[8], scr[9], scr[8], scr[9], -1.0f, 0.0f);
        }
        VM_WAIT(); __syncthreads();
        fft_inv_pass(buf, 0, tid); __syncthreads(); fft_inv_pass(buf, 1, tid); __syncthreads(); fft_inv_pass(buf, 2, tid); __syncthreads(); fft_inv_pass(buf, 3, tid); __syncthreads();
        { const float sc = scr[ch]; float* yT = hfT + (size_t)c * L;
#pragma unroll 2
            for (int nn = tid; nn < FN / 2; nn += NT) { const f32x2 v = *(const LAS f32x2*)(buf + 2 * fphys(nn)); *(f32x2*)(yT + 2 * nn) = (f32x2){v.x * sc, v.y * sc}; } }
        __syncthreads();
    }
    VM_WAIT(); __syncthreads();
    {
        const bf16* z = (const bf16*)(F.ws + WS_Z); bf16* cat = (bf16*)(F.ws + WS_CAT);
        float w0[4], w1[4], w2[4], bb[4], dsk[4];
#pragma unroll
        for (int q = 0; q < 4; ++q) { w0[q] = in[IN_CHW][c0 + q]; w1[q] = in[IN_CHW][3072 + c0 + q]; w2[q] = in[IN_CHW][6144 + c0 + q]; bb[q] = in[IN_CHB][c0 + q]; dsk[q] = in[IN_DSKIP][c0 + q]; }
#pragma unroll 4
        for (int t = tid; t < L; t += NT) {
            const v2u zc = *(const v2u*)(z + (size_t)t * NINP + OFF_HY + c0);
            const v2u zp = t > 0 ? *(const v2u*)(z + (size_t)(t - 1) * NINP + OFF_HY + c0) : (v2u){0u, 0u};
            const v2u zn = t < L - 1 ? *(const v2u*)(z + (size_t)(t + 1) * NINP + OFF_HY + c0) : (v2u){0u, 0u};
            const float pv[4] = {bflo(zp.x), bfhi(zp.x), bflo(zp.y), bfhi(zp.y)}, cv[4] = {bflo(zc.x), bfhi(zc.x), bflo(zc.y), bfhi(zc.y)}, nv[4] = {bflo(zn.x), bfhi(zn.x), bflo(zn.y), bfhi(zn.y)};
            float o[4];
#pragma unroll
            for (int q = 0; q < 4; ++q) { const float y = hfT[(size_t)(c0 + q) * L + t] + dsk[q] * uT[(size_t)(c0 + q) * L + t];
                o[q] = (pv[q] * w0[q] + cv[q] * w1[q] + nv[q] * w2[q] + bb[q]) * y; }
            v2u w; w.x = cvt_pk_bf16(o[0], o[1]); w.y = cvt_pk_bf16(o[2], o[3]);
            *(v2u*)(cat + (size_t)t * D + MVW + c0) = w;
        }
    }
    __syncthreads();
}
constexpr int RT_PITCH = 2056;
__device__ __forceinline__ void p6_norm2_router(Frame& F) {
    const float* const* in = F.in;
    const float* mod = (const float*)(F.ws + WS_MOD);
    bf16* h2g = (bf16*)(F.ws + WS_HA);
    int* cnt = (int*)(F.ws + WS_CTL) + CW_CNT;
    int* aexp = (int*)(F.ws + WS_AEXP); int* arank = (int*)(F.ws + WS_ARANK); float* aw = (float*)(F.ws + WS_AW);
    LAS bf16* h1 = (LAS bf16*)F.lds; LAS bf16* h2 = h1 + 16 * RT_PITCH;
    LAS float* part = (LAS float*)(h2 + 16 * RT_PITCH);
    const bf16* w1 = (const bf16*)(F.ws + WS_WR1); const bf16* w2 = (const bf16*)(F.ws + WS_WR2);
    const int lane = F.lane, wave = F.wave, fr = lane & 15, fq = lane >> 4;
    for (int t0 = F.bid * 16; t0 < L; t0 += F.G * 16) {
#pragma unroll 1
        for (int rr = 0; rr < 2; ++rr) {
            const int tr = 2 * wave + rr, t = t0 + tr;
            f32x4 v[8]; float ss = 0.f;
#pragma unroll
            for (int j = 0; j < 8; ++j) { const int col = 4 * lane + 256 * j; v[j] = *(const f32x4*)(F.out + (size_t)t * D + col); ss += (v[j].x * v[j].x + v[j].y * v[j].y) + (v[j].z * v[j].z + v[j].w * v[j].w); }
            const float rstd = rsqrtf(wave_sum(ss) * (1.0f / D) + EPS);
#pragma unroll
            for (int j = 0; j < 8; ++j) { const int col = 4 * lane + 256 * j;
                const f32x4 g = *(const f32x4*)(in[IN_GFFN] + col), sh = *(const f32x4*)(mod + 6144 + col), sc = *(const f32x4*)(mod + 8192 + col);
                const f32x4 h = (v[j] * rstd * g) * (sc + 1.0f) + sh;
                v2u o; o.x = cvt_pk_bf16(h.x, h.y); o.y = cvt_pk_bf16(h.z, h.w);
                *(v2u*)(h2g + (size_t)t * D + col) = o;
                *(LAS v2u*)(h1 + tr * RT_PITCH + col) = o;
                v2u lo; lo.x = cvt_pk_bf16(h.x - bflo(o.x), h.y - bfhi(o.x)); lo.y = cvt_pk_bf16(h.z - bflo(o.y), h.w - bfhi(o.y));
                *(LAS v2u*)(h2 + tr * RT_PITCH + col) = lo; }
        }
        __syncthreads();
        {
            const int nt = wave & 3, kh = wave >> 2;
            f32x4 acc = (f32x4){0.f, 0.f, 0.f, 0.f};
            const bf16* b1p = w1 + (size_t)(16 * nt + fr) * 2048 + kh * 1024 + 8 * fq; const bf16* b2p = w2 + (size_t)(16 * nt + fr) * 2048 + kh * 1024 + 8 * fq;
            const LAS bf16* a1p = h1 + fr * RT_PITCH + kh * 1024 + 8 * fq; const LAS bf16* a2p = h2 + fr * RT_PITCH + kh * 1024 + 8 * fq;
#pragma unroll 8
            for (int ks = 0; ks < 32; ++ks) {
                const bf16x8 a1 = *(const LAS bf16x8*)(a1p + 32 * ks), a2 = *(const LAS bf16x8*)(a2p + 32 * ks);
                const bf16x8 b1 = *(const bf16x8*)(b1p + 32 * ks), b2 = *(const bf16x8*)(b2p + 32 * ks);
                acc = __builtin_amdgcn_mfma_f32_16x16x32_bf16(a2, b1, acc, 0, 0, 0);
                acc = __builtin_amdgcn_mfma_f32_16x16x32_bf16(a1, b2, acc, 0, 0, 0);
                acc = __builtin_amdgcn_mfma_f32_16x16x32_bf16(a1, b1, acc, 0, 0, 0); }
#pragma unroll
            for (int r = 0; r < 4; ++r) part[(kh * 16 + 4 * fq + r) * 64 + 16 * nt + fr] = acc[r];
        }
        __syncthreads();
#pragma unroll 1
        for (int rr = 0; rr < 2; ++rr) {
            const int tr = 2 * wave + rr, t = t0 + tr;
            const float logit = part[tr * 64 + lane] + part[(16 + tr) * 64 + lane];
            const float s = 1.0f / (1.0f + expf(-logit)), sel = s + in[IN_BR][lane];
            const int grp = lane >> 3;
            float m1 = sel; m1 = fmaxf(m1, __shfl_xor(m1, 1)); m1 = fmaxf(m1, __shfl_xor(m1, 2)); m1 = fmaxf(m1, __shfl_xor(m1, 4));
            const unsigned long long gm = 0xFFull << (8 * grp);
            const unsigned long long b1 = __ballot(sel == m1) & gm;
            const int first = __ffsll((long long)b1) - 1;
            float m2 = (lane == first) ? -INFINITY : sel; m2 = fmaxf(m2, __shfl_xor(m2, 1)); m2 = fmaxf(m2, __shfl_xor(m2, 2)); m2 = fmaxf(m2, __shfl_xor(m2, 4));
            const float gs = m1 + m2;
            int grank = 0;
#pragma unroll
            for (int g = 0; g < 8; ++g) { const float og = __shfl(gs, 8 * g); grank += (og > gs || (og == gs && g < grp)) ? 1 : 0; }
            const float masked = grank < 4 ? sel : -INFINITY;
            int rank = 0;
            for (int e2 = 0; e2 < 64; ++e2) { const float om = __shfl(masked, e2); rank += (om > masked || (om == masked && e2 < lane)) ? 1 : 0; }
            const bool chosen = rank < 8;
            const float wsum = wave_sum(chosen ? s : 0.f);
            const unsigned long long cb = __ballot(chosen);
            if (chosen) {
                const int k = (int)__builtin_amdgcn_mbcnt_hi((unsigned)(cb >> 32), __builtin_amdgcn_mbcnt_lo((unsigned)cb, 0u));
                const int half = t >= HALF_T ? 1 : 0;
                const int r = atomicAdd(cnt + half * 64 + lane, 1);
                aexp[t * 8 + k] = lane; arank[t * 8 + k] = r; aw[t * 8 + k] = s / wsum * 2.5f;
            }
        }
        __syncthreads();
    }
}
__device__ __forceinline__ void build_pstart(Frame& F) {
    LAS int* ps = (LAS int*)(F.lds + LDSCTL_OFF);
    const int* cnt = (const int*)(F.ws + WS_CTL) + CW_CNT;
    __syncthreads();
    if (F.tid < 2) { int a = 0;
        for (int e = 0; e < NE; ++e) { ps[F.tid * 66 + e] = a; a += (__hip_atomic_load(cnt + F.tid * 64 + e, __ATOMIC_RELAXED, __HIP_MEMORY_SCOPE_AGENT) + 255) & ~255; }
        ps[F.tid * 66 + 64] = a; ps[F.tid * 66 + 65] = a + HALF_T; }
    __syncthreads();
}
__device__ __forceinline__ void p7_fill_rows(Frame& F) {
    build_pstart(F);
    const LAS int* ps = (const LAS int*)(F.lds + LDSCTL_OFF);
    const int* aexp = (const int*)(F.ws + WS_AEXP); const int* arank = (const int*)(F.ws + WS_ARANK); const float* aw = (const float*)(F.ws + WS_AW);
    int* rt = (int*)(F.ws + WS_RTOK); float* rw = (float*)(F.ws + WS_RW);
    const int gt = F.bid * NT + F.tid, NGT = F.G * NT;
    for (int i = gt; i < L * 8; i += NGT) { const int t = i >> 3, h = t >= HALF_T ? 1 : 0; const int row = ps[h * 66 + aexp[i]] + arank[i];
        rt[h * MAXROWS + row] = t; rw[h * MAXROWS + row] = aw[i]; }
    for (int t = gt; t < L; t += NGT) { const int h = t >= HALF_T ? 1 : 0; const int row = ps[h * 66 + 64] + (t - h * HALF_T);
        rt[h * MAXROWS + row] = t; rw[h * MAXROWS + row] = 1.0f; }
}
__device__ __forceinline__ void moe_combine(Frame& F, int half) {
    const float* const* in = F.in;
    const LAS int* ps = (const LAS int*)(F.lds + LDSCTL_OFF) + half * 66;
    const float* mod = (const float*)(F.ws + WS_MOD);
    const int* aexp = (const int*)(F.ws + WS_AEXP); const int* arank = (const int*)(F.ws + WS_ARANK);
    const bf16* Y2 = (const bf16*)(F.ws + WS_Y2);
    const int gw = F.bid * NWAVES + F.wave, NGW = F.G * NWAVES, lane = F.lane;
    for (int tt = gw; tt < HALF_T; tt += NGW) {
        const int t = half * HALF_T + tt;
        float a[32];
#pragma unroll
        for (int i = 0; i < 32; ++i) a[i] = 0.f;
#pragma unroll 3
        for (int k = 0; k < 9; ++k) {
            const int row = k < 8 ? ps[aexp[t * 8 + k]] + arank[t * 8 + k] : ps[64] + tt;
            const bf16* yr = Y2 + (size_t)row * D + 8 * lane;
#pragma unroll
            for (int j = 0; j < 4; ++j) { const v4u y = *(const v4u*)(yr + 512 * j);
                a[8 * j + 0] += bflo(y.x); a[8 * j + 1] += bfhi(y.x); a[8 * j + 2] += bflo(y.y); a[8 * j + 3] += bfhi(y.y);
                a[8 * j + 4] += bflo(y.z); a[8 * j + 5] += bfhi(y.z); a[8 * j + 6] += bflo(y.w); a[8 * j + 7] += bfhi(y.w); }
        }
        float ss = 0.f;
#pragma unroll
        for (int j = 0; j < 4; ++j)
#pragma unroll
            for (int q = 0; q < 2; ++q) { const int col = 8 * lane + 512 * j + 4 * q;
                const f32x4 x1 = *(const f32x4*)(F.out + (size_t)t * D + col), g2 = *(const f32x4*)(mod + 10240 + col);
                const int i = 8 * j + 4 * q;
                a[i] = x1.x + g2.x * a[i]; a[i + 1] = x1.y + g2.y * a[i + 1]; a[i + 2] = x1.z + g2.z * a[i + 2]; a[i + 3] = x1.w + g2.w * a[i + 3];
                ss += (a[i] * a[i] + a[i + 1] * a[i + 1]) + (a[i + 2] * a[i + 2] + a[i + 3] * a[i + 3]); }
        const float rstd = rsqrtf(wave_sum(ss) * (1.0f / D) + EPS);
#pragma unroll
        for (int j = 0; j < 4; ++j)
#pragma unroll
            for (int q = 0; q < 2; ++q) { const int col = 8 * lane + 512 * j + 4 * q; const int i = 8 * j + 4 * q;
                const f32x4 gf = *(const f32x4*)(in[IN_GFIN] + col);
                *(f32x4*)(F.out + (size_t)t * D + col) = (f32x4){a[i] * rstd * gf.x, a[i + 1] * rstd * gf.y, a[i + 2] * rstd * gf.z, a[i + 3] * rstd * gf.w}; }
    }
}

constexpr int N_PHASES = 14;
__global__ void __launch_bounds__(NT, 2) fwd_kernel(Args args) {
    extern __shared__ __attribute__((aligned(16))) unsigned char lds_raw[];
    Frame F;
    F.lds = (LAS unsigned char*)lds_raw;
    F.tid = threadIdx.x; F.lane = F.tid & 63; F.wave = __builtin_amdgcn_readfirstlane(F.tid >> 6);
    F.bid = blockIdx.x; F.G = gridDim.x;
    F.in = args.in; F.out = args.out; F.ws = args.ws;
    volatile LAS unsigned* MISC = (volatile LAS unsigned*)(F.lds + LDSCTL_OFF + 768);
    if (F.tid < 64) ((LAS unsigned*)(F.lds + LDSCTL_OFF))[F.tid + 192] = 0u;
    __syncthreads();
    unsigned* ctl = (unsigned*)(F.ws + WS_CTL);
    const int lo = args.ph_lo, hi = args.ph_hi;
    XcdBarrier bar; bar.bar = ctl + CW_BAR; bar.x = 0; bar.st = nullptr;
    if (hi - lo > 1) bar = xcd_barrier_post(ctl + CW_BAR, MISC + 8);
#ifndef PH_MASK
#define PH_MASK 0xFFFF
#endif
#define IN(k) (((PH_MASK >> (k)) & 1) && lo <= (k) && (k) < hi)
#define SEAM(k) do { if (IN(k) && IN((k) + 1)) xcd_barrier(bar); } while (0)
#define REP(k) for (int rep_ = 0; rep_ < ((PROBE_DUP) == (k) ? 2 : 1); ++rep_) if ((rep_ ? __syncthreads() : (void)0), true)
    LAS int* ps = (LAS int*)(F.lds + LDSCTL_OFF);

    if (IN(0)) REP(0) { p0_prologue(F); } SEAM(0);
    if (IN(1)) REP(1) { p1_norm1(F); } SEAM(1);
    if (IN(2)) {
        gk::DenseOrder S; S.init(MROWS, NINP, D, F.G, F.bid); S.Bt = (const char*)(F.ws + WS_WIN);
        gk::EpiBf16Store E{(bf16*)(F.ws + WS_Z), NINP};
        gk::gemm_core(F.lds, (const char*)(F.ws + WS_HA), D, S, E);
    }
#if PROBE_DUP == 2
    if (IN(2)) { __syncthreads(); } if (IN(2)) {
        gk::DenseOrder S; S.init(MROWS, NINP, D, F.G, F.bid); S.Bt = (const char*)(F.ws + WS_WIN);
        gk::EpiBf16Store E{(bf16*)(F.ws + WS_Z), NINP};
        gk::gemm_core(F.lds, (const char*)(F.ws + WS_HA), D, S, E);
    }
#endif
    SEAM(2);
    if (IN(3)) REP(3) {
        for (int it = F.bid; it < 1040; it += F.G) ml_prep_item(F, it);
        for (int tile = F.bid; tile < 256; tile += F.G) p3_filter_tile(F, tile);
        for (int tile = F.bid; tile < 1024; tile += F.G) p3_uin_tile(F, tile);
    } SEAM(3);
    if (IN(4)) REP(4) { ml_scan(F); } SEAM(4);
    if (IN(5)) {
        for (int job = F.bid; job < 256; job += F.G) p4_fft_job(F, job);
#if PROBE_DUP == 50
        __syncthreads(); for (int job = F.bid; job < 256; job += F.G) p4_fft_job(F, job);
#endif
        for (int it = F.bid; it < 1024; it += F.G) ml_out_item(F, it);
#if PROBE_DUP == 51
        __syncthreads(); for (int it = F.bid; it < 1024; it += F.G) ml_out_item(F, it);
#endif
    } SEAM(5);
    if (IN(6)) {
        gk::DenseOrder S; S.init(L, D, D, F.G, F.bid); S.Bt = (const char*)(F.ws + WS_WOUT);
        gk::EpiResidual E{F.out, D, (const float*)(F.ws + WS_MOD) + 4096};
        gk::gemm_core(F.lds, (const char*)(F.ws + WS_CAT), D, S, E);
    } SEAM(6);
    if (IN(7)) { p6_norm2_router(F); } SEAM(7);
    if (IN(8)) { p7_fill_rows(F); } SEAM(8);
#define MOE_GU(h) do { build_pstart(F); \
        gk::GroupOrder<4, true> S; S.ntile = ps[(h) * 66 + 65] >> 8; S.G = F.G; S.c = F.bid; S.K = D; S.pstart = ps + (h) * 66; S.rtok = (const int*)(F.ws + WS_RTOK) + (h) * MAXROWS; \
        S.Bt = (const char*)(F.ws + WS_W13); S.bstride = (size_t)1024 * D * 2; \
        gk::EpiGateUp E{(bf16*)(F.ws + WS_HR)}; \
        gk::gemm_core(F.lds, (const char*)(F.ws + WS_HA), D, S, E); } while (0)
#define MOE_DN(h) do { build_pstart(F); \
        gk::GroupOrder<8, false> S; S.ntile = ps[(h) * 66 + 65] >> 8; S.G = F.G; S.c = F.bid; S.K = DE; S.pstart = ps + (h) * 66; S.rtok = nullptr; \
        S.Bt = (const char*)(F.ws + WS_W2); S.bstride = (size_t)D * DE * 2; \
        gk::EpiDown E{(bf16*)(F.ws + WS_Y2), (const float*)(F.ws + WS_RW) + (h) * MAXROWS}; \
        gk::gemm_core(F.lds, (const char*)(F.ws + WS_HR), DE, S, E); } while (0)
    if (IN(9)) REP(9) { MOE_GU(0); } SEAM(9);
    if (IN(10)) REP(10) { MOE_DN(0); } SEAM(10);
    if (IN(11)) { MOE_GU(1); moe_combine(F, 0); } SEAM(11);
    if (IN(12)) REP(12) { MOE_DN(1); } SEAM(12);
    if (IN(13)) { build_pstart(F); moe_combine(F, 1); }
#undef IN
#undef SEAM
}

extern "C" void kernel_launch(void* const* d_in, const int* in_sizes, int n_in, void* d_out, int out_size, void* d_ws, size_t ws_size, hipStream_t stream) {
    static int grid = 0;
    if (grid == 0) {
        if (n_in != 36 || out_size != L * D || ws_size < WS_END) { fprintf(stderr, "kernel_launch: unexpected shapes: n_in %d out %d ws %zu (need %zu)\n", n_in, out_size, ws_size, (size_t)WS_END); grid = -1; return; }
        int dev = 0, cus = 0, per_cu = 0;
        if (hipGetDevice(&dev) != hipSuccess || hipDeviceGetAttribute(&cus, hipDeviceAttributeMultiprocessorCount, dev) != hipSuccess) { grid = -1; return; }
        if (hipFuncSetAttribute((const void*)fwd_kernel, hipFuncAttributeMaxDynamicSharedMemorySize, LDS_BYTES) != hipSuccess) { fprintf(stderr, "kernel_launch: hipFuncSetAttribute failed\n"); grid = -1; return; }
        if (hipOccupancyMaxActiveBlocksPerMultiprocessor(&per_cu, (const void*)fwd_kernel, NT, LDS_BYTES) != hipSuccess || per_cu < 1) fprintf(stderr, "kernel_launch: occupancy query says %d\n", per_cu);
        (void)hipGetLastError();
        grid = cus;
    }
    if (grid < 0) return;
    if (hipMemsetAsync((char*)d_ws + WS_CTL, 0, CTL_ZERO_BYTES, stream) != hipSuccess) return;
    Args a{};
    for (int i = 0; i < 36; ++i) a.in[i] = (const float*)d_in[i];
    a.out = (float*)d_out; a.ws = (unsigned char*)d_ws;
    const int stop = MK_STOP_AFTER < N_PHASES ? MK_STOP_AFTER + 1 : N_PHASES;
#if MK_N_LAUNCHES == 1
    a.ph_lo = 0; a.ph_hi = stop;
    hipLaunchKernelGGL(fwd_kernel, dim3(grid), dim3(NT), LDS_BYTES, stream, a);
#else
    for (int p = 0; p < stop; ++p) { a.ph_lo = p; a.ph_hi = p + 1; hipLaunchKernelGGL(fwd_kernel, dim3(grid), dim3(NT), LDS_BYTES, stream, a); }
#endif
}
```

```cpp
#include <hip/hip_runtime.h>
#include <cstdio>
#include <cstdint>

#ifndef MK_N_LAUNCHES
#define MK_N_LAUNCHES 1
#endif
#ifndef PROBE_DUP
#define PROBE_DUP -1
#endif
#ifndef MK_STOP_AFTER
#define MK_STOP_AFTER 99
#endif

#define GAS __attribute__((address_space(1)))
#define LAS __attribute__((address_space(3)))
typedef unsigned short bf16;
typedef unsigned v4u __attribute__((ext_vector_type(4)));
typedef unsigned v2u __attribute__((ext_vector_type(2)));
typedef float f32x4 __attribute__((ext_vector_type(4)));
typedef float f32x2 __attribute__((ext_vector_type(2)));
typedef short bf16x8 __attribute__((ext_vector_type(8)));
#define LDS_WAIT() asm volatile("s_waitcnt lgkmcnt(0)" ::: "memory")
#define VM_WAIT() asm volatile("s_waitcnt vmcnt(0)" ::: "memory")

constexpr int NWAVES = 8, NT = NWAVES * 64;
constexpr int L = 16384, D = 2048, LC = 256, MROWS = L + LC;
constexpr int NIN = 6176, NINP = 6400;
constexpr int OFF_K = 0, OFF_V = 512, OFF_G = 1536, OFF_Q = 1568, OFF_O = 2080, OFF_HY = 3104;
constexpr int NH = 8, HYW = 1024, MVW = 1024;
constexpr int NE = 64, NE1 = 65, DE = 512;
constexpr int HALF_T = 8192;
constexpr int MAXROWS = 90112;
constexpr float EPS = 1e-6f;

constexpr size_t MiB = 1u << 20;
constexpr size_t WS_CTL = 0, CTL_ZERO_BYTES = 256 * 1024;
constexpr size_t WS_MOD = 1 * MiB;
constexpr size_t WS_POS = WS_MOD + 128 * 1024;
constexpr size_t WS_WR1 = 2 * MiB + 512 * 1024;
constexpr size_t WS_WR2 = WS_WR1 + 256 * 1024;
constexpr size_t WS_WIN = 3 * MiB;
constexpr size_t WS_WOUT = 28 * MiB;
constexpr size_t WS_W13 = 36 * MiB;
constexpr size_t WS_W2 = 296 * MiB;
constexpr size_t WS_HA = 426 * MiB;
constexpr size_t WS_Z = 491 * MiB;
constexpr size_t WS_CAT = 695 * MiB;
constexpr size_t WS_UIN = 759 * MiB;
constexpr size_t WS_KF = 823 * MiB;
constexpr size_t WS_KB = 887 * MiB;
constexpr size_t WS_CL = 426 * MiB;
constexpr size_t WS_CI = 951 * MiB;
constexpr size_t WS_Q = 983 * MiB;
constexpr size_t WS_K = 999 * MiB;
constexpr size_t WS_RTOK = 1015 * MiB;
constexpr size_t WS_RW = WS_RTOK + 2 * MAXROWS * 4;
constexpr size_t WS_AEXP = 1017 * MiB;
constexpr size_t WS_ARANK = WS_AEXP + 512 * 1024;
constexpr size_t WS_AW = WS_ARANK + 512 * 1024;
constexpr size_t WS_HDN = 1019 * MiB;
constexpr size_t WS_SC = 1021 * MiB;
constexpr size_t WS_NL = WS_SC + 32 * 1024;
constexpr size_t WS_NI = WS_NL + 640 * 1024;
constexpr size_t WS_MI = WS_NI + 640 * 1024;
constexpr size_t WS_END = 1023 * MiB;
constexpr size_t WS_HR = 491 * MiB;
constexpr size_t WS_Y2 = 579 * MiB;
static_assert(WS_Y2 + (size_t)MAXROWS * 2048 * 2 <= WS_CI, "overlay");
constexpr int CW_BAR = 4096;
constexpr int CW_CNT = 16384;

constexpr int RING_BYTES = 131072;
constexpr int LDSCTL_OFF = 147456;
constexpr int FFTSCR_OFF = LDSCTL_OFF + 1024;
constexpr int LDS_BYTES = 151552;

__device__ __forceinline__ unsigned cvt_pk_bf16(float lo, float hi) { unsigned r; asm volatile("v_cvt_pk_bf16_f32 %0, %1, %2" : "=v"(r) : "v"(lo), "v"(hi)); return r; }
__device__ __forceinline__ float bf2f(unsigned short b) { return __builtin_bit_cast(float, ((unsigned)b) << 16); }
__device__ __forceinline__ float bflo(unsigned u) { return __builtin_bit_cast(float, u << 16); }
__device__ __forceinline__ float bfhi(unsigned u) { return __builtin_bit_cast(float, u & 0xffff0000u); }
__device__ __forceinline__ float wave_sum(float v) {
#pragma unroll
    for (int o = 1; o < 64; o <<= 1) v += __shfl_xor(v, o);
    return v;
}
__device__ __forceinline__ float silu_f(float a) { return a / (1.f + __expf(-a)); }
__device__ __forceinline__ float sigmoid_f(float a) { return 1.f / (1.f + __expf(-a)); }

#define XB_TMO      128
#define XB_XCNT(j)  (256  + 64 * (j))
#define XB_XSUB(j)  (1280 + 64 * (j))
#define XB_XGEN(j)  (2304 + 64 * (j))
#define XB_TOP      3328
#define XB_TOPGEN   3392
#define XCD_BAR_WORDS 3456
#define XB_SPIN_CAP (1u << 18)

__device__ __forceinline__ unsigned xb_ld(unsigned* p)              { return __hip_atomic_load(p, __ATOMIC_RELAXED, __HIP_MEMORY_SCOPE_AGENT); }
__device__ __forceinline__ unsigned xb_add(unsigned* p, unsigned v) { return __hip_atomic_fetch_add(p, v, __ATOMIC_RELAXED, __HIP_MEMORY_SCOPE_AGENT); }
__device__ __forceinline__ unsigned xb_xcc_id() { return (unsigned)__builtin_amdgcn_s_getreg((3 << 11) | 20) & 0xFu; }
#define XB_SPIN(cond, bar) do { unsigned _sp = 0; while (cond) { __builtin_amdgcn_s_sleep(1); \
    if ((++_sp & 255u) == 0u) { if (xb_ld(&(bar)[XB_TMO])) break; if (_sp > XB_SPIN_CAP) { atomicAdd(&(bar)[XB_TMO], 1u); break; } } } } while (0)

struct XcdBarrier {
    unsigned* bar; unsigned x;
    volatile LAS unsigned* st;
};

__device__ __forceinline__ XcdBarrier xcd_barrier_post(unsigned* bar, volatile LAS unsigned* st) {
    XcdBarrier b; b.bar = bar; b.x = xb_xcc_id(); b.st = st;
    if (threadIdx.x == 0) (void)xb_add(&bar[XB_XCNT(b.x)], 1u);
    return b;
}
__device__ __forceinline__ void xcd_barrier_complete(unsigned* bar, unsigned x, unsigned& nloc, unsigned& nx) {
    const unsigned G = gridDim.x * gridDim.y * gridDim.z;
    unsigned sum, cnt, mine, sp = 0u;
    for (;;) {
        sum = 0u; cnt = 0u; mine = 0u;
#pragma unroll
        for (unsigned j = 0; j < 16; ++j) { const unsigned c = xb_ld(&bar[XB_XCNT(j)]); sum += c; cnt += (c > 0u) ? 1u : 0u; mine = (j == x) ? c : mine; }
        if (sum == G) break;
        __builtin_amdgcn_s_sleep(1);
        if ((++sp & 255u) == 0u) { if (xb_ld(&bar[XB_TMO])) break; if (sp > XB_SPIN_CAP) { atomicAdd(&bar[XB_TMO], 1u); break; } }
    }
    nloc = mine > 0u ? mine : 1u; nx = cnt > 0u ? cnt : 1u;
}

__device__ __forceinline__ void xcd_barrier(const XcdBarrier& b) {
    asm volatile("s_waitcnt vmcnt(0)" ::: "memory");
    __syncthreads();
    if (threadIdx.x == 0) {
        unsigned* bar = b.bar;
        __builtin_amdgcn_s_waitcnt(0);
        unsigned nloc = b.st[0], nx = b.st[1];
        if (nloc == 0u) { xcd_barrier_complete(bar, b.x, nloc, nx); b.st[0] = nloc; b.st[1] = nx; }
        const unsigned old = xb_add(&bar[XB_XSUB(b.x)], 1u);
        const unsigned gen = old / nloc;
        if (old + 1u == (gen + 1u) * nloc) {
            __builtin_amdgcn_fence(__ATOMIC_RELEASE, "agent");
            asm volatile("s_waitcnt vmcnt(0)" ::: "memory");
            const unsigned og = xb_add(&bar[XB_TOP], 1u);
            const unsigned tg = og / nx;
            if (og + 1u == (tg + 1u) * nx) xb_add(&bar[XB_TOPGEN], 1u);
            else XB_SPIN(xb_ld(&bar[XB_TOPGEN]) == tg, bar);
            __builtin_amdgcn_fence(__ATOMIC_ACQUIRE, "agent");
            xb_add(&bar[XB_XGEN(b.x)], 1u);
            asm volatile("s_waitcnt vmcnt(0)" ::: "memory");
        } else {
            XB_SPIN(xb_ld(&bar[XB_XGEN(b.x)]) == gen, bar);
            __builtin_amdgcn_fence(__ATOMIC_ACQUIRE, "agent");
            asm volatile("s_waitcnt vmcnt(0)" ::: "memory");
        }
    }
    __syncthreads();
}

namespace gk {
constexpr int BM = 256, BK = 64, HALF = 128, HTB = HALF * BK * 2, STAGE_BYTES = 8 * HTB, NXCD = 8, WGM = 8;
__host__ __device__ __forceinline__ int lds_byte(int r, int c) { const int st = (r >> 4) * 2 + (c >> 5), rr = r & 15, cc = c & 31, ob = rr * 64 + cc * 2; return st * 1024 + (ob ^ (((ob >> 9) & 1) << 5)); }
__host__ __device__ __forceinline__ void stage_rc(int b, int& R, int& C) { const int st = b / 1024, sb = b % 1024, swz = sb ^ (((sb >> 9) & 1) << 5); R = (st >> 1) * 16 + swz / 64; C = (st & 1) * 32 + (swz % 64) / 2; }
__host__ __device__ __forceinline__ int perm32(int rho) { const int n = rho >> 4, i = rho & 15; return 8 * (i >> 2) + 4 * n + (i & 3); }

struct Unit { int pm, pn, ex; };

template <class Epi, class Sched>
__device__ __forceinline__ void gemm_core(LAS unsigned char* lds, const char* Abase, const int K, const Sched& S, const Epi& E) {
    const int tid = threadIdx.x, wid = __builtin_amdgcn_readfirstlane(tid >> 6), lane = tid & 63, wr = wid >> 2, wc = wid & 3, fr = lane & 15, fq = lane >> 4;
    const int nt = K / BK;
    int RA[2], CA[2]; unsigned voffB[2];
#pragma unroll
    for (int i = 0; i < 2; ++i) { int R, C; stage_rc(tid * 16 + i * 8192, R, C); const int Rb = Epi::PERM ? ((R & ~31) + perm32(R & 31)) : R;
        RA[i] = R; CA[i] = C; voffB[i] = (unsigned)(Rb * K + C) * 2u; }
    const size_t kstep = (size_t)(BK * 2);
    const size_t hstepB = (size_t)HALF * K * 2;
    const unsigned ldsw = (unsigned)wid * 1024u;
    const int aoff = lds_byte(wr * 64 + fr, fq * 8), boff = lds_byte(wc * 32 + fr, fq * 8);
#define GK_SA(b, h) (((b) * 2 + (h)) * HTB)
#define GK_SB(b, h) ((4 + (b) * 2 + (h)) * HTB)
#define GK_STAGE(bufoff, gbase, v0, v1) do { \
        __builtin_amdgcn_global_load_lds((const unsigned*)((const char*)(gbase) + (v0)), (LAS unsigned*)(lds + (bufoff) + ldsw), 16, 0, 0); \
        __builtin_amdgcn_global_load_lds((const unsigned*)((const char*)(gbase) + (v1)), (LAS unsigned*)(lds + (bufoff) + ldsw + 8192), 16, 0, 0); } while (0)
#define GK_LDA(dst, b, h) do { _Pragma("unroll") for (int m = 0; m < 4; ++m) _Pragma("unroll") for (int k = 0; k < 2; ++k) dst[m][k] = *(const LAS bf16x8*)(lds + GK_SA(b, h) + aoff + m * 2048 + k * 1024); } while (0)
#define GK_LDB(dst, b, h) do { _Pragma("unroll") for (int n = 0; n < 2; ++n) _Pragma("unroll") for (int k = 0; k < 2; ++k) dst[n][k] = *(const LAS bf16x8*)(lds + GK_SB(b, h) + boff + n * 2048 + k * 1024); } while (0)
#define GK_MMA(ai, bj, At, Bt) do { __builtin_amdgcn_s_setprio(1); _Pragma("unroll") for (int m = 0; m < 4; ++m) _Pragma("unroll") for (int n = 0; n < 2; ++n) _Pragma("unroll") for (int k = 0; k < 2; ++k) \
        acc[ai][bj][m][n] = __builtin_amdgcn_mfma_f32_16x16x32_bf16(Bt[n][k], At[m][k], acc[ai][bj][m][n], 0, 0, 0); __builtin_amdgcn_s_setprio(0); } while (0)
#define GK_WAIT_V(n) asm volatile("s_waitcnt vmcnt(" #n ")" ::: "memory")
#define GK_WAIT_L(n) asm volatile("s_waitcnt lgkmcnt(" #n ")" ::: "memory")
#define GK_BAR __builtin_amdgcn_s_barrier()
#define GK_SCHED __builtin_amdgcn_sched_barrier(0)
    Unit cur, nxt; int ui = 0;
    if (!S.next(0, cur)) return;
    f32x4 acc[2][2][4][2];
#pragma unroll
    for (int a = 0; a < 2; ++a)
#pragma unroll
        for (int b = 0; b < 2; ++b)
#pragma unroll
            for (int m = 0; m < 4; ++m)
#pragma unroll
                for (int n = 0; n < 2; ++n) acc[a][b][m][n] = (f32x4){0.f, 0.f, 0.f, 0.f};
    bf16x8 At[4][2], B0[2][2], B1[2][2];
    unsigned c00, c01, c10, c11, n00, n01, n10, n11;
    S.a_offs(cur, RA, CA, c00, c01, c10, c11);
    asm volatile("" : "+v"(c00), "+v"(c01), "+v"(c10), "+v"(c11));
    const char* cB = S.b_base(cur);
    GK_STAGE(GK_SB(0, 0), cB, voffB[0], voffB[1]); GK_STAGE(GK_SB(0, 1), cB + hstepB, voffB[0], voffB[1]); GK_STAGE(GK_SA(0, 0), Abase, c00, c01); GK_STAGE(GK_SA(0, 1), Abase, c10, c11);
    if (wr == 1) GK_BAR;
    GK_WAIT_V(2); GK_BAR;
    GK_STAGE(GK_SB(1, 0), cB + kstep, voffB[0], voffB[1]); GK_STAGE(GK_SA(1, 0), Abase + kstep, c00, c01); GK_STAGE(GK_SB(1, 1), cB + hstepB + kstep, voffB[0], voffB[1]);
    GK_WAIT_V(6); GK_BAR;
    for (;;) {
        const bool has_next = S.next(ui + 1, nxt);
        const char* nB = cB;
        n00 = c00; n01 = c01; n10 = c10; n11 = c11;
        if (has_next) { S.a_offs(nxt, RA, CA, n00, n01, n10, n11); nB = S.b_base(nxt); }
        asm volatile("" : "+v"(n00), "+v"(n01), "+v"(n10), "+v"(n11));
        for (int t = 0; t < nt; t += 2) {
            const bool last = (t == nt - 2);
            const char* a1 = Abase + (size_t)(t + 1) * kstep;
            const char* a2 = last ? Abase : Abase + (size_t)(t + 2) * kstep; const char* b2 = last ? nB : cB + (size_t)(t + 2) * kstep;
            const char* a3 = a2 + kstep; const char* b3 = b2 + kstep;
            const unsigned x00 = last ? n00 : c00, x01 = last ? n01 : c01, x10 = last ? n10 : c10, x11 = last ? n11 : c11;
            GK_LDB(B0, 0, 0); GK_LDB(B1, 0, 1); GK_SCHED; GK_LDA(At, 0, 0); GK_STAGE(GK_SA(1, 1), a1, c10, c11);
            GK_WAIT_V(8); GK_WAIT_L(0); GK_BAR; GK_MMA(0, 0, At, B0); GK_MMA(0, 1, At, B1); GK_BAR; GK_SCHED;
            GK_LDA(At, 0, 1); GK_STAGE(GK_SB(0, 0), b2, voffB[0], voffB[1]); GK_STAGE(GK_SB(0, 1), b2 + hstepB, voffB[0], voffB[1]); GK_STAGE(GK_SA(0, 0), a2, x00, x01);
            GK_WAIT_V(8); GK_WAIT_L(0); GK_BAR; GK_MMA(1, 0, At, B0); GK_MMA(1, 1, At, B1); GK_BAR; GK_SCHED;
            GK_LDB(B0, 1, 0); GK_LDB(B1, 1, 1); GK_SCHED; GK_LDA(At, 1, 0); GK_STAGE(GK_SA(0, 1), a2, x10, x11);
            GK_WAIT_V(8); GK_WAIT_L(0); GK_BAR; GK_MMA(0, 0, At, B0); GK_MMA(0, 1, At, B1); GK_BAR; GK_SCHED;
            GK_LDA(At, 1, 1); GK_STAGE(GK_SB(1, 0), b3, voffB[0], voffB[1]); GK_STAGE(GK_SB(1, 1), b3 + hstepB, voffB[0], voffB[1]); GK_STAGE(GK_SA(1, 0), a3, x00, x01);
            GK_WAIT_V(8); GK_WAIT_L(0); GK_BAR; GK_MMA(1, 0, At, B0); GK_MMA(1, 1, At, B1); GK_BAR; GK_SCHED;
        }
        if (wr == 0) GK_BAR;
        E(acc, cur, wr, wc, fr, fq);
        if (!has_next) break;
#pragma unroll
        for (int a = 0; a < 2; ++a)
#pragma unroll
            for (int b = 0; b < 2; ++b)
#pragma unroll
                for (int m = 0; m < 4; ++m)
#pragma unroll
                    for (int n = 0; n < 2; ++n) acc[a][b][m][n] = (f32x4){0.f, 0.f, 0.f, 0.f};
        cur = nxt; cB = nB; c00 = n00; c01 = n01; c10 = n10; c11 = n11; ++ui;
        if (wr == 1) GK_BAR;
    }
    GK_WAIT_V(0);
    GK_BAR;
#undef GK_SA
#undef GK_SB
#undef GK_STAGE
#undef GK_LDA
#undef GK_LDB
#undef GK_MMA
#undef GK_WAIT_V
#undef GK_WAIT_L
#undef GK_BAR
#undef GK_SCHED
}

struct DenseOrder {
    int nM, nN, nwg, G, c, K;
    __device__ void init(int M, int N, int K_, int G_, int c_) { nM = M / BM; nN = N / BM; nwg = nM * nN; G = G_; c = c_; K = K_; }
    __device__ __forceinline__ bool next(int i, Unit& u) const {
        const long Lx = (long)i * G + c; if (Lx >= nwg) return false;
        int wgid = (int)Lx; { const int q = nwg / NXCD, r = nwg % NXCD, xcd = wgid % NXCD, off = wgid / NXCD; wgid = (xcd < r ? xcd * (q + 1) : r * (q + 1) + (xcd - r) * q) + off; }
        const int nig = WGM * nN, gid = wgid / nig, fm = gid * WGM, gsz = (nM - fm) < WGM ? (nM - fm) : WGM;
        u.pm = fm + ((wgid % nig) % gsz); u.pn = (wgid % nig) / gsz; u.ex = 0; return true;
    }
    const char* Bt;
    __device__ __forceinline__ void a_offs(const Unit& u, const int (&RA)[2], const int (&CA)[2], unsigned& o00, unsigned& o01, unsigned& o10, unsigned& o11) const {
        const unsigned r0 = (unsigned)(u.pm * BM);
        o00 = ((r0 + RA[0]) * (unsigned)K + CA[0]) * 2u; o01 = ((r0 + RA[1]) * (unsigned)K + CA[1]) * 2u;
        o10 = ((r0 + HALF + RA[0]) * (unsigned)K + CA[0]) * 2u; o11 = ((r0 + HALF + RA[1]) * (unsigned)K + CA[1]) * 2u;
    }
    __device__ __forceinline__ const char* b_base(const Unit& u) const { return Bt + (size_t)u.pn * BM * K * 2; }
};
template <int NPN, bool GATHER>
struct GroupOrder {
    int ntile, G, c, K;
    const LAS int* pstart;
    const int* rtok;
    const char* Bt; size_t bstride;
    __device__ __forceinline__ bool next(int i, Unit& u) const {
        const int x = c & 7, j = c >> 3, nj = G >> 3, T8 = (ntile + 7) >> 3, tlo = x * T8, thi = (tlo + T8) < ntile ? (tlo + T8) : ntile;
        const int Lx = i * nj + j, tl = Lx / NPN; if (tlo + tl >= thi) return false;
        u.pm = tlo + tl; u.pn = Lx % NPN;
        const int row = u.pm * BM; int lo = 0, hi = NE1;
        while (hi - lo > 1) { const int mid = (lo + hi) >> 1; if (pstart[mid] <= row) lo = mid; else hi = mid; }
        u.ex = lo; return true;
    }
    __device__ __forceinline__ void a_offs(const Unit& u, const int (&RA)[2], const int (&CA)[2], unsigned& o00, unsigned& o01, unsigned& o10, unsigned& o11) const {
        const int r0 = u.pm * BM;
        if (GATHER) {
            const int t00 = rtok[r0 + RA[0]], t01 = rtok[r0 + RA[1]], t10 = rtok[r0 + HALF + RA[0]], t11 = rtok[r0 + HALF + RA[1]];
            o00 = ((unsigned)t00 * (unsigned)K + CA[0]) * 2u; o01 = ((unsigned)t01 * (unsigned)K + CA[1]) * 2u;
            o10 = ((unsigned)t10 * (unsigned)K + CA[0]) * 2u; o11 = ((unsigned)t11 * (unsigned)K + CA[1]) * 2u;
        } else {
            o00 = ((unsigned)(r0 + RA[0]) * (unsigned)K + CA[0]) * 2u; o01 = ((unsigned)(r0 + RA[1]) * (unsigned)K + CA[1]) * 2u;
            o10 = ((unsigned)(r0 + HALF + RA[0]) * (unsigned)K + CA[0]) * 2u; o11 = ((unsigned)(r0 + HALF + RA[1]) * (unsigned)K + CA[1]) * 2u;
        }
    }
    __device__ __forceinline__ const char* b_base(const Unit& u) const { return Bt + (size_t)u.ex * bstride + (size_t)u.pn * BM * K * 2; }
};

struct EpiBf16Store {
    static constexpr bool PERM = true;
    bf16* O; int ldc;
    __device__ __forceinline__ void operator()(const f32x4 (&acc)[2][2][4][2], const Unit& u, int wr, int wc, int fr, int fq) const {
        const int row0 = u.pm * BM + wr * 64 + fr, col0 = u.pn * BM + wc * 32 + 8 * fq;
#pragma unroll
        for (int ai = 0; ai < 2; ++ai)
#pragma unroll
            for (int m = 0; m < 4; ++m) { bf16* rowp = O + (size_t)(row0 + ai * HALF + m * 16) * ldc + col0;
#pragma unroll
                for (int bj = 0; bj < 2; ++bj) { const f32x4 v0 = acc[ai][bj][m][0], v1 = acc[ai][bj][m][1];
                    v4u w; w.x = cvt_pk_bf16(v0[0], v0[1]); w.y = cvt_pk_bf16(v0[2], v0[3]); w.z = cvt_pk_bf16(v1[0], v1[1]); w.w = cvt_pk_bf16(v1[2], v1[3]);
                    *(v4u*)(rowp + bj * HALF) = w; } }
    }
};
struct EpiResidual {
    static constexpr bool PERM = false;
    float* X; int ldc; const float* gate;
    __device__ __forceinline__ void operator()(const f32x4 (&acc)[2][2][4][2], const Unit& u, int wr, int wc, int fr, int fq) const {
        const int row0 = u.pm * BM + wr * 64 + fr, col0 = u.pn * BM + wc * 32 + 4 * fq;
        f32x4 gv[2][2];
#pragma unroll
        for (int bj = 0; bj < 2; ++bj)
#pragma unroll
            for (int n = 0; n < 2; ++n) gv[bj][n] = *(const f32x4*)(gate + col0 + bj * HALF + n * 16);
#pragma unroll
        for (int ai = 0; ai < 2; ++ai)
#pragma unroll
            for (int m = 0; m < 4; ++m) { float* rowp = X + (size_t)(row0 + ai * HALF + m * 16) * ldc + col0;
#pragma unroll
                for (int bj = 0; bj < 2; ++bj)
#pragma unroll
                    for (int n = 0; n < 2; ++n) { f32x4* p = (f32x4*)(rowp + bj * HALF + n * 16); *p = *p + gv[bj][n] * acc[ai][bj][m][n]; } }
    }
};
struct EpiGateUp {
    static constexpr bool PERM = true;
    bf16* O;
    __device__ __forceinline__ void operator()(const f32x4 (&acc)[2][2][4][2], const Unit& u, int wr, int wc, int fr, int fq) const {
        const int row0 = u.pm * BM + wr * 64 + fr, col0 = u.pn * HALF + wc * 32 + 8 * fq;
#pragma unroll
        for (int ai = 0; ai < 2; ++ai)
#pragma unroll
            for (int m = 0; m < 4; ++m) { bf16* rowp = O + (size_t)(row0 + ai * HALF + m * 16) * DE + col0;
                float h[8];
#pragma unroll
                for (int n = 0; n < 2; ++n)
#pragma unroll
                    for (int j = 0; j < 4; ++j) { const float g = acc[ai][0][m][n][j], up = acc[ai][1][m][n][j]; h[n * 4 + j] = silu_f(g) * up; }
                v4u w; w.x = cvt_pk_bf16(h[0], h[1]); w.y = cvt_pk_bf16(h[2], h[3]); w.z = cvt_pk_bf16(h[4], h[5]); w.w = cvt_pk_bf16(h[6], h[7]);
                *(v4u*)rowp = w; }
    }
};
struct EpiDown {
    static constexpr bool PERM = true;
    bf16* O; const float* rw;
    __device__ __forceinline__ void operator()(const f32x4 (&acc)[2][2][4][2], const Unit& u, int wr, int wc, int fr, int fq) const {
        const int row0 = u.pm * BM + wr * 64 + fr, col0 = u.pn * BM + wc * 32 + 8 * fq;
#pragma unroll
        for (int ai = 0; ai < 2; ++ai)
#pragma unroll
            for (int m = 0; m < 4; ++m) { const int row = row0 + ai * HALF + m * 16; const float s = rw[row]; bf16* rowp = O + (size_t)row * D + col0;
#pragma unroll
                for (int bj = 0; bj < 2; ++bj) { const f32x4 v0 = acc[ai][bj][m][0] * s, v1 = acc[ai][bj][m][1] * s;
                    v4u w; w.x = cvt_pk_bf16(v0[0], v0[1]); w.y = cvt_pk_bf16(v0[2], v0[3]); w.z = cvt_pk_bf16(v1[0], v1[1]); w.w = cvt_pk_bf16(v1[2], v1[3]);
                    *(v4u*)(rowp + bj * HALF) = w; } }
    }
};
}

struct Args { const float* in[36]; float* out; unsigned char* ws; int ph_lo, ph_hi; };
struct Frame {
    LAS unsigned char* lds;
    int tid, lane, wave, bid, G;
    const float* const* in; float* out; unsigned char* ws;
};
#define IN_X 0
#define IN_C 1
#define IN_CTX 2
#define IN_CCTX 3
#define IN_WADA 4
#define IN_BADA 5
#define IN_GMIX 6
#define IN_GFFN 7
#define IN_WIN 8
#define IN_BGATES 9
#define IN_CKW 10
#define IN_CKB 11
#define IN_CQW 12
#define IN_CQB 13
#define IN_GHEAD 14
#define IN_CHW 15
#define IN_CHB 16
#define IN_FW1 17
#define IN_FB1 18
#define IN_FF1 19
#define IN_FW2 20
#define IN_FB2 21
#define IN_FF2 22
#define IN_FW3 23
#define IN_FB3 24
#define IN_DSKIP 25
#define IN_WOUT 26
#define IN_WR 27
#define IN_BR 28
#define IN_W1E 29
#define IN_W3E 30
#define IN_W2E 31
#define IN_W1S 32
#define IN_W3S 33
#define IN_W2S 34
#define IN_GFIN 35

__device__ __forceinline__ void transpose_item(const float* W, int N, int k0, int n0, bf16* WT, int dstK, int dst_row0, LAS float* scr, int lane) {
#pragma unroll 8
    for (int i = 0; i < 32; ++i) { const int kk = 2 * i + (lane >> 5); scr[kk * 33 + (lane & 31)] = W[(size_t)(k0 + kk) * N + n0 + (lane & 31)]; }
    LDS_WAIT(); asm volatile("" ::: "memory");
    const int c = lane & 7;
#pragma unroll
    for (int j = 0; j < 4; ++j) { const int n = (lane >> 3) + 8 * j; const LAS float* s = scr + (8 * c) * 33 + n;
        v4u o; o.x = cvt_pk_bf16(s[0 * 33], s[1 * 33]); o.y = cvt_pk_bf16(s[2 * 33], s[3 * 33]); o.z = cvt_pk_bf16(s[4 * 33], s[5 * 33]); o.w = cvt_pk_bf16(s[6 * 33], s[7 * 33]);
        *(v4u*)(WT + (size_t)(dst_row0 + n) * dstK + k0 + 8 * c) = o; }
    LDS_WAIT(); asm volatile("" ::: "memory");
}
__device__ __forceinline__ void p0_prologue(Frame& F) {
    const float* const* in = F.in;
    {
        LAS float* sv = (LAS float*)F.lds;
        LAS float* red = sv + 4096;
        float* mod = (float*)(F.ws + WS_MOD);
        for (int job = F.bid; job < 192; job += F.G) {
            for (int i = F.tid; i < 2048; i += NT) { sv[i] = silu_f(in[IN_C][i]); sv[2048 + i] = silu_f(in[IN_CCTX][i]); }
            __syncthreads();
            const int col = job * 64 + F.lane, r0 = F.wave * 256;
            const float* W = in[IN_WADA] + col;
            float a0 = 0.f, a1 = 0.f;
            for (int i = r0; i < r0 + 256; i += 8) {
                float w[8];
#pragma unroll
                for (int j = 0; j < 8; ++j) w[j] = W[(size_t)(i + j) * 12288];
#pragma unroll
                for (int j = 0; j < 8; ++j) { a0 += sv[i + j] * w[j]; a1 += sv[2048 + i + j] * w[j]; }
            }
            red[(F.wave * 64 + F.lane) * 2 + 0] = a0; red[(F.wave * 64 + F.lane) * 2 + 1] = a1;
            __syncthreads();
            if (F.wave == 0) { float s0 = 0.f, s1 = 0.f;
#pragma unroll
                for (int w = 0; w < 8; ++w) { s0 += red[(w * 64 + F.lane) * 2 + 0]; s1 += red[(w * 64 + F.lane) * 2 + 1]; }
                const float b = in[IN_BADA][col]; mod[col] = s0 + b; mod[12288 + col] = s1 + b; }
            __syncthreads();
        }
    }
    const int gt = F.bid * NT + F.tid, NGT = F.G * NT;
    {
        float* pos = (float*)(F.ws + WS_POS);
        for (int i = gt; i < 320 * 1024; i += NGT) { const int p = i >> 10, j = i & 1023, jj = j & 511;
            const float pp = (float)(p < 256 ? p : p - 256);
            const float omega = 1.0f / powf(10000.0f, (float)jj * (1.0f / 512.0f)); const float ang = pp * omega;
            pos[i] = j < 512 ? sinf(ang) : cosf(ang); }
    }
    {
        v4u* z = (v4u*)(F.ws + WS_WIN + (size_t)NIN * D * 2); const int nz = (NINP - NIN) * D * 2 / 16;
        for (int i = gt; i < nz; i += NGT) z[i] = (v4u){0u, 0u, 0u, 0u};
        int* rt = (int*)(F.ws + WS_RTOK); float* rw = (float*)(F.ws + WS_RW);
        for (int i = gt; i < 2 * MAXROWS; i += NGT) { rt[i] = 0; rw[i] = 0.f; }
    }
    {
        bf16* w1 = (bf16*)(F.ws + WS_WR1); bf16* w2 = (bf16*)(F.ws + WS_WR2);
        for (int i = gt; i < 64 * 2048; i += NGT) { const int e = i >> 11, k = i & 2047; const float w = in[IN_WR][k * 64 + e];
            const unsigned hi = cvt_pk_bf16(w, 0.f) & 0xffffu; const float r = w - bf2f((bf16)hi);
            w1[i] = (bf16)hi; w2[i] = (bf16)(cvt_pk_bf16(r, 0.f) & 0xffffu); }
    }
    {
        LAS float* scr = (LAS float*)(F.lds + F.wave * 16384);
        const int gw = F.bid * NWAVES + F.wave, NGW = F.G * NWAVES;
        constexpr int I_IN = 32 * 193, I_OUT = 32 * 64, I_E = 512 * NE1;
        constexpr int NITEMS = I_IN + I_OUT + 3 * I_E;
        for (int it = gw; it < NITEMS; it += NGW) {
            int r = it;
            if (r < I_IN) { const int kb = r / 193, nb = r % 193; transpose_item(in[IN_WIN], NIN, 64 * kb, 32 * nb, (bf16*)(F.ws + WS_WIN), D, 32 * nb, scr, F.lane); continue; } r -= I_IN;
            if (r < I_OUT) { const int kb = r / 64, nb = r % 64; transpose_item(in[IN_WOUT], D, 64 * kb, 32 * nb, (bf16*)(F.ws + WS_WOUT), D, 32 * nb, scr, F.lane); continue; } r -= I_OUT;
            if (r < 2 * I_E) { const int which = r >= I_E; if (which) r -= I_E;
                const int e = r / 512, rr = r % 512, kb = rr / 16, nb = rr % 16, n0 = 32 * nb;
                const float* src = e < NE ? in[which ? IN_W3E : IN_W1E] + (size_t)e * D * DE : in[which ? IN_W3S : IN_W1S];
                transpose_item(src, DE, 64 * kb, n0, (bf16*)(F.ws + WS_W13) + (size_t)e * 1024 * D, D, (n0 >> 7) * 256 + which * 128 + (n0 & 127), scr, F.lane); continue; }
            r -= 2 * I_E;
            { const int e = r / 512, rr = r % 512, kb = rr / 64, nb = rr % 64;
                const float* src = e < NE ? in[IN_W2E] + (size_t)e * DE * D : in[IN_W2S];
                transpose_item(src, D, 64 * kb, 32 * nb, (bf16*)(F.ws + WS_W2) + (size_t)e * D * DE, DE, 32 * nb, scr, F.lane); }
        }
    }
}

__device__ __forceinline__ void p1_norm1(Frame& F) {
    const float* const* in = F.in;
    const int gw = F.bid * NWAVES + F.wave, NGW = F.G * NWAVES;
    const float* mod = (const float*)(F.ws + WS_MOD); const float* pos = (const float*)(F.ws + WS_POS);
    bf16* hA = (bf16*)(F.ws + WS_HA);
    for (int row = gw; row < MROWS; row += NGW) {
        f32x4 v[8]; float ss = 0.f;
        const bool mainrow = row < L;
        const float* src = mainrow ? in[IN_X] + (size_t)row * D : in[IN_CTX] + (size_t)(row - L) * D;
        const float* md = mainrow ? mod : mod + 12288;
#pragma unroll
        for (int j = 0; j < 8; ++j) { const int col = 4 * F.lane + 256 * j; v[j] = *(const f32x4*)(src + col);
            if (mainrow) { const float* pp = col < 1024 ? pos + (size_t)(row >> 6) * 1024 + col : pos + (size_t)(256 + (row & 63)) * 1024 + (col - 1024);
                v[j] = v[j] + *(const f32x4*)pp; *(f32x4*)(F.out + (size_t)row * D + col) = v[j]; }
            ss += (v[j].x * v[j].x + v[j].y * v[j].y) + (v[j].z * v[j].z + v[j].w * v[j].w); }
        const float rstd = rsqrtf(wave_sum(ss) * (1.0f / D) + EPS);
#pragma unroll
        for (int j = 0; j < 8; ++j) { const int col = 4 * F.lane + 256 * j;
            const f32x4 g = *(const f32x4*)(in[IN_GMIX] + col), sh = *(const f32x4*)(md + col), sc = *(const f32x4*)(md + 2048 + col);
            const f32x4 h = (v[j] * rstd * g) * (sc + 1.0f) + sh;
            v2u o; o.x = cvt_pk_bf16(h.x, h.y); o.y = cvt_pk_bf16(h.z, h.w);
            *(v2u*)(hA + (size_t)row * D + col) = o; }
    }
}

constexpr int VT_PITCH = 136;
__device__ __forceinline__ float wave_incl_add(float x, int lane) {
#pragma unroll
    for (int o = 1; o < 64; o <<= 1) { const float y = __shfl_up(x, o); if (lane >= o) x += y; }
    return x;
}
__device__ __forceinline__ float wave_incl_max(float x, int lane) {
#pragma unroll
    for (int o = 1; o < 64; o <<= 1) { const float y = __shfl_up(x, o); if (lane >= o) x = fmaxf(x, y); }
    return x;
}
__device__ __forceinline__ void ml_gates(Frame& F, int dir, int h, int rowbase, LAS float* bb, LAS float* al, LAS float* mx, float& g, float& mtot) {
    const bf16* z = (const bf16*)(F.ws + WS_Z);
    const int lane = F.lane, pi0 = 2 * lane, p0 = dir ? 127 - pi0 : pi0, p1 = dir ? p0 - 1 : p0 + 1;
    const float bgi = F.in[IN_BGATES][dir * 16 + h], bgf = F.in[IN_BGATES][dir * 16 + 8 + h];
    const bf16* z0 = z + (size_t)(rowbase + p0) * NINP + OFF_G + dir * 16 + h; const bf16* z1 = z + (size_t)(rowbase + p1) * NINP + OFF_G + dir * 16 + h;
    const float i0 = bf2f(z0[0]) + bgi, f0 = bf2f(z0[8]) + bgf, i1 = bf2f(z1[0]) + bgi, f1 = bf2f(z1[8]) + bgf;
    const float l0 = fminf(f0, 0.f) - log1pf(__expf(-fabsf(f0))), l1 = fminf(f1, 0.f) - log1pf(__expf(-fabsf(f1)));
    const float incl = wave_incl_add(l0 + l1, lane);
    const float b1 = incl, b0 = incl - l1;
    const float a0 = i0 - b0, a1 = i1 - b1;
    const float mi = wave_incl_max(fmaxf(a0, a1), lane);
    float mprev = __shfl_up(mi, 1); if (lane == 0) mprev = -INFINITY;
    const float M0 = fmaxf(mprev, a0), M1 = mi;
    bb[p0] = b0; bb[p1] = b1; al[p0] = a0; al[p1] = a1; mx[p0] = M0; mx[p1] = M1;
    g = __shfl(incl, 63); mtot = __shfl(mi, 63);
}
__device__ __forceinline__ void ml_stage_vT(Frame& F, int h, int rowbase, LAS bf16* vT) {
    const bf16* z = (const bf16*)(F.ws + WS_Z);
    const int s = F.tid >> 2, eg = F.tid & 3;
#pragma unroll
    for (int i = 0; i < 4; ++i) { const int e0 = 32 * eg + 8 * i; const v4u v = *(const v4u*)(z + (size_t)(rowbase + s) * NINP + OFF_V + h * 128 + e0);
        const unsigned w[4] = {v.x, v.y, v.z, v.w};
#pragma unroll
        for (int q = 0; q < 4; ++q) { vT[(e0 + 2 * q) * VT_PITCH + s] = (bf16)(w[q] & 0xffffu); vT[(e0 + 2 * q + 1) * VT_PITCH + s] = (bf16)(w[q] >> 16); } }
}
__device__ __forceinline__ void ml_prep_item(Frame& F, int item) {
    const float* const* in = F.in;
    const int n = item >> 3, h = item & 7, tid = F.tid, lane = F.lane, wave = F.wave;
    const bool isctx = n >= 128;
    const int rowbase = isctx ? L + 128 * (n - 128) : 128 * n, seqlo = isctx ? L : 0, seqhi = isctx ? L + LC - 1 : L - 1;
    LAS bf16* vT = (LAS bf16*)F.lds;
    LAS bf16* kw0 = vT + 128 * VT_PITCH;
    LAS bf16* kw1 = kw0 + 64 * VT_PITCH;
    LAS float* fs = (LAS float*)(kw1 + 64 * VT_PITCH);
    const bf16* z = (const bf16*)(F.ws + WS_Z);
    if (wave < 2) { float g, mtot; LAS float* bbp = fs + 256 + wave * 384; ml_gates(F, wave, h, rowbase, bbp, bbp + 128, bbp + 256, g, mtot);
        LDS_WAIT();
        fs[wave * 128 + 2 * lane] = __expf(bbp[128 + 2 * lane] - mtot); fs[wave * 128 + 2 * lane + 1] = __expf(bbp[128 + 2 * lane + 1] - mtot);
        if (lane == 0) { float* sc = (float*)(F.ws + WS_SC) + ((size_t)(wave * 8 + h) * 130 + n) * 2; sc[0] = g; sc[1] = g + mtot; } }
    ml_stage_vT(F, h, rowbase, vT);
    __syncthreads();
    {
        const int s = tid >> 2, d0 = (tid & 3) * 16, R = rowbase + s; const bool hp = R > seqlo, hn = R < seqhi;
        float kv[16], qv[16];
#pragma unroll
        for (int part = 0; part < 2; ++part) {
            const int zc = (part ? OFF_Q : OFF_K) + h * 64 + d0; const float* cw = in[part ? IN_CQW : IN_CKW] + h * 64 + d0; const float* cb = in[part ? IN_CQB : IN_CKB] + h * 64 + d0;
#pragma unroll
            for (int hv = 0; hv < 2; ++hv) {
                const v4u c = *(const v4u*)(z + (size_t)R * NINP + zc + 8 * hv);
                const v4u p = hp ? *(const v4u*)(z + (size_t)(R - 1) * NINP + zc + 8 * hv) : (v4u){0u, 0u, 0u, 0u};
                const v4u nx = hn ? *(const v4u*)(z + (size_t)(R + 1) * NINP + zc + 8 * hv) : (v4u){0u, 0u, 0u, 0u};
                const unsigned cc[4] = {c.x, c.y, c.z, c.w}, pp[4] = {p.x, p.y, p.z, p.w}, nn[4] = {nx.x, nx.y, nx.z, nx.w};
#pragma unroll
                for (int q = 0; q < 4; ++q) { const int d = 8 * hv + 2 * q;
                    const float v0 = silu_f(bflo(pp[q]) * cw[d] + bflo(cc[q]) * cw[512 + d] + bflo(nn[q]) * cw[1024 + d] + cb[d]);
                    const float v1 = silu_f(bfhi(pp[q]) * cw[d + 1] + bfhi(cc[q]) * cw[512 + d + 1] + bfhi(nn[q]) * cw[1024 + d + 1] + cb[d + 1]);
                    if (part) { qv[d] = v0 * 0.125f; qv[d + 1] = v1 * 0.125f; } else { kv[d] = v0; kv[d + 1] = v1; } }
            }
        }
        if (!isctx) {
            bf16* Qg = (bf16*)(F.ws + WS_Q) + ((size_t)h * L + R) * 64 + d0; bf16* Kg = (bf16*)(F.ws + WS_K) + ((size_t)h * L + R) * 64 + d0;
#pragma unroll
            for (int hv = 0; hv < 2; ++hv) { v4u w;
                w.x = cvt_pk_bf16(qv[8 * hv], qv[8 * hv + 1]); w.y = cvt_pk_bf16(qv[8 * hv + 2], qv[8 * hv + 3]); w.z = cvt_pk_bf16(qv[8 * hv + 4], qv[8 * hv + 5]); w.w = cvt_pk_bf16(qv[8 * hv + 6], qv[8 * hv + 7]); *(v4u*)(Qg + 8 * hv) = w;
                w.x = cvt_pk_bf16(kv[8 * hv], kv[8 * hv + 1]); w.y = cvt_pk_bf16(kv[8 * hv + 2], kv[8 * hv + 3]); w.z = cvt_pk_bf16(kv[8 * hv + 4], kv[8 * hv + 5]); w.w = cvt_pk_bf16(kv[8 * hv + 6], kv[8 * hv + 7]); *(v4u*)(Kg + 8 * hv) = w; }
        }
        const float w0 = fs[s], w1 = fs[128 + s];
#pragma unroll
        for (int d = 0; d < 16; ++d) { const float kr = bf2f((bf16)(cvt_pk_bf16(kv[d], 0.f) & 0xffffu));
            kw0[(d0 + d) * VT_PITCH + s] = (bf16)(cvt_pk_bf16(kr * w0, 0.f) & 0xffffu); kw1[(d0 + d) * VT_PITCH + s] = (bf16)(cvt_pk_bf16(kr * w1, 0.f) & 0xffffu); }
    }
    __syncthreads();
    {
        const int fr = lane & 15, fq = lane >> 4;
        bf16x8 a[4];
#pragma unroll
        for (int kk = 0; kk < 4; ++kk) a[kk] = *(const LAS bf16x8*)(vT + (16 * wave + fr) * VT_PITCH + 32 * kk + 8 * fq);
#pragma unroll
        for (int dir = 0; dir < 2; ++dir) { const LAS bf16* kw = dir ? kw1 : kw0;
            float* cl = (float*)(F.ws + WS_CL) + ((size_t)((dir * 8 + h) * 130 + n)) * 8192;
#pragma unroll
            for (int dt = 0; dt < 4; ++dt) { f32x4 acc = (f32x4){0.f, 0.f, 0.f, 0.f};
#pragma unroll
                for (int kk = 0; kk < 4; ++kk) { const bf16x8 b = *(const LAS bf16x8*)(kw + (16 * dt + fr) * VT_PITCH + 32 * kk + 8 * fq); acc = __builtin_amdgcn_mfma_f32_16x16x32_bf16(a[kk], b, acc, 0, 0, 0); }
#pragma unroll
                for (int r = 0; r < 4; ++r) cl[(16 * wave + 4 * fq + r) * 64 + 16 * dt + fr] = acc[r]; } }
        if (tid < 128) { const int dir = tid >> 6, d = tid & 63; const LAS bf16* kw = (dir ? kw1 : kw0) + d * VT_PITCH; float s = 0.f;
            for (int i = 0; i < 128; ++i) s += bf2f(kw[i]);
            ((float*)(F.ws + WS_NL))[((size_t)((dir * 8 + h) * 130 + n)) * 64 + d] = s; }
    }
    __syncthreads();
}
__device__ __forceinline__ int ml_order(int dir, int step) { return step < 2 ? (dir ? 129 - step : 128 + step) : (dir ? 129 - step : step - 2); }
__device__ __forceinline__ void ml_scan(Frame& F) {
    const float* CL = (const float*)(F.ws + WS_CL); const float* SC = (const float*)(F.ws + WS_SC); const float* NLp = (const float*)(F.ws + WS_NL);
    bf16* CI = (bf16*)(F.ws + WS_CI); float* NI = (float*)(F.ws + WS_NI); float* MI = (float*)(F.ws + WS_MI);
    for (int idx = F.bid * NT + F.tid; idx < 16 * 8192; idx += F.G * NT) {
        const int dh = idx >> 13, rem = idx & 8191, dir = dh >> 3; const bool don = rem < 64;
        float c = 0.f, nn = 0.f, m = 0.f;
        for (int s0 = 0; s0 < 130; s0 += 10) {
            float cl[10], nl[10], gg[10], ml[10];
#pragma unroll
            for (int i = 0; i < 10; ++i) { const int ch = ml_order(dir, s0 + i); cl[i] = CL[((size_t)(dh * 130 + ch)) * 8192 + rem]; gg[i] = SC[(dh * 130 + ch) * 2]; ml[i] = SC[(dh * 130 + ch) * 2 + 1];
                nl[i] = don ? NLp[(size_t)(dh * 130 + ch) * 64 + rem] : 0.f; }
#pragma unroll
            for (int i = 0; i < 10; ++i) { const int ch = ml_order(dir, s0 + i);
                if (ch < 128) { CI[((size_t)(dh * 128 + ch)) * 8192 + rem] = (bf16)(cvt_pk_bf16(c, 0.f) & 0xffffu); if (don) NI[(size_t)(dh * 128 + ch) * 64 + rem] = nn; if (rem == 0) MI[dh * 128 + ch] = m; }
                const float mn = fmaxf(gg[i] + m, ml[i]), sp = __expf(gg[i] + m - mn), sl = __expf(ml[i] - mn);
                c = sp * c + sl * cl[i]; nn = sp * nn + sl * nl[i]; m = mn; }
        }
    }
}
__device__ __forceinline__ void ml_out_item(Frame& F, int item) {
    const float* const* in = F.in;
    const int n = item >> 3, h = item & 7, tid = F.tid, lane = F.lane, wave = F.wave, fr = lane & 15, fq = lane >> 4;
    const int rowbase = 128 * n;
    LAS bf16* vT = (LAS bf16*)F.lds;
    LAS float* fs = (LAS float*)(vT + 128 * VT_PITCH);
    const bf16* z = (const bf16*)(F.ws + WS_Z);
    if (wave < 2) { float g, mtot; LAS float* bbp = fs + wave * 384; ml_gates(F, wave, h, rowbase, bbp, bbp + 128, bbp + 256, g, mtot);
        if (lane == 0) fs[768 + wave] = ((const float*)(F.ws + WS_MI))[(wave * 8 + h) * 128 + n]; }
    ml_stage_vT(F, h, rowbase, vT);
    __syncthreads();
    const bf16* Qg = (const bf16*)(F.ws + WS_Q) + ((size_t)h * L + rowbase) * 64; const bf16* Kg = (const bf16*)(F.ws + WS_K) + ((size_t)h * L + rowbase) * 64;
    const int tl = 16 * wave + fr;
    bf16x8 qf[2];
#pragma unroll
    for (int kk = 0; kk < 2; ++kk) qf[kk] = *(const bf16x8*)(Qg + (size_t)tl * 64 + 32 * kk + 8 * fq);
    f32x4 st[8];
#pragma unroll
    for (int j = 0; j < 8; ++j) { f32x4 acc = (f32x4){0.f, 0.f, 0.f, 0.f};
#pragma unroll
        for (int kk = 0; kk < 2; ++kk) { const bf16x8 kf = *(const bf16x8*)(Kg + (size_t)(16 * j + fr) * 64 + 32 * kk + 8 * fq); acc = __builtin_amdgcn_mfma_f32_16x16x32_bf16(kf, qf[kk], acc, 0, 0, 0); }
        st[j] = acc; }
    f32x4 hs[8];
#pragma unroll
    for (int et = 0; et < 8; ++et) hs[et] = (f32x4){0.f, 0.f, 0.f, 0.f};
#pragma unroll 1
    for (int dir = 0; dir < 2; ++dir) {
        const LAS float* bbp = fs + dir * 384; const LAS float* alp = bbp + 128; const LAS float* mxp = bbp + 256;
        const float m_in = fs[768 + dir];
        const float beta = fmaxf(m_in, mxp[tl]);
        const int dh = dir * 8 + h;
        bf16x8 pf[4]; float dsum = 0.f;
#pragma unroll
        for (int kk = 0; kk < 4; ++kk) { float pv[8];
#pragma unroll
            for (int hh = 0; hh < 2; ++hh)
#pragma unroll
                for (int r = 0; r < 4; ++r) { const int s = 32 * kk + 16 * hh + 4 * fq + r; const bool ok = dir ? (s >= tl) : (s <= tl);
                    const float e = __expf(fminf(alp[s] - beta, 0.f)); const float v = ok ? st[2 * kk + hh][r] * e : 0.f; pv[4 * hh + r] = v; dsum += v; }
            pf[kk] = __builtin_bit_cast(bf16x8, (v4u){cvt_pk_bf16(pv[0], pv[1]), cvt_pk_bf16(pv[2], pv[3]), cvt_pk_bf16(pv[4], pv[5]), cvt_pk_bf16(pv[6], pv[7])}); }
        dsum += __shfl_xor(dsum, 16); dsum += __shfl_xor(dsum, 32);
        const float* nip = (const float*)(F.ws + WS_NI) + (size_t)(dh * 128 + n) * 64; float qn = 0.f;
#pragma unroll
        for (int kk = 0; kk < 2; ++kk) { const v4u qq = __builtin_bit_cast(v4u, qf[kk]); const unsigned w[4] = {qq.x, qq.y, qq.z, qq.w};
#pragma unroll
            for (int q = 0; q < 4; ++q) { const int d = 32 * kk + 8 * fq + 2 * q; qn += bflo(w[q]) * nip[d] + bfhi(w[q]) * nip[d + 1]; } }
        qn += __shfl_xor(qn, 16); qn += __shfl_xor(qn, 32);
        const float sc_t = __expf(m_in - beta);
        const float den = dsum + sc_t * qn, dn = fmaxf(fabsf(den), __expf(-(bbp[tl] + beta)));
        LAS float* xinv = fs + 772 + (wave * 2 + dir) * 32;
        if (fq == 0) { xinv[fr] = 1.0f / dn; xinv[16 + fr] = sc_t; }
        LDS_WAIT();
        float inv_r[4], sc_r[4];
#pragma unroll
        for (int r = 0; r < 4; ++r) { inv_r[r] = xinv[4 * fq + r]; sc_r[r] = xinv[16 + 4 * fq + r]; }
        const bf16* cip = (const bf16*)(F.ws + WS_CI) + (size_t)(dh * 128 + n) * 8192;
#pragma unroll
        for (int et = 0; et < 8; ++et) {
            f32x4 acc = (f32x4){0.f, 0.f, 0.f, 0.f}, acci = (f32x4){0.f, 0.f, 0.f, 0.f};
#pragma unroll
            for (int kk = 0; kk < 4; ++kk) {
                const bool live = dir ? (2 * kk + 1 >= wave) : (2 * kk <= wave);
                if (live) { const LAS bf16* vr = vT + (16 * et + fr) * VT_PITCH + 32 * kk + 4 * fq;
                    const v2u lo = *(const LAS v2u*)vr, hi = *(const LAS v2u*)(vr + 16);
                    const bf16x8 vb = __builtin_bit_cast(bf16x8, (v4u){lo.x, lo.y, hi.x, hi.y});
                    acc = __builtin_amdgcn_mfma_f32_16x16x32_bf16(pf[kk], vb, acc, 0, 0, 0); } }
#pragma unroll
            for (int kk = 0; kk < 2; ++kk) { const bf16x8 cb = *(const bf16x8*)(cip + (size_t)(16 * et + fr) * 64 + 32 * kk + 8 * fq); acci = __builtin_amdgcn_mfma_f32_16x16x32_bf16(qf[kk], cb, acci, 0, 0, 0); }
#pragma unroll
            for (int r = 0; r < 4; ++r) hs[et][r] += (acc[r] + sc_r[r] * acci[r]) * inv_r[r];
        }
    }
    float rs[4];
#pragma unroll
    for (int r = 0; r < 4; ++r) { float ss = 0.f;
#pragma unroll
        for (int et = 0; et < 8; ++et) ss += hs[et][r] * hs[et][r];
        ss += __shfl_xor(ss, 1); ss += __shfl_xor(ss, 2); ss += __shfl_xor(ss, 4); ss += __shfl_xor(ss, 8);
        rs[r] = rsqrtf(ss * (1.0f / 128.0f) + EPS); }
    bf16* cat = (bf16*)(F.ws + WS_CAT);
#pragma unroll
    for (int et = 0; et < 8; ++et) { const int col = h * 128 + 16 * et + fr; const float gh = in[IN_GHEAD][col];
#pragma unroll
        for (int r = 0; r < 4; ++r) { const int t = rowbase + 16 * wave + 4 * fq + r;
            const float o = hs[et][r] * rs[r] * gh * sigmoid_f(bf2f(z[(size_t)t * NINP + OFF_O + col]));
            cat[(size_t)t * D + col] = (bf16)(cvt_pk_bf16(o, 0.f) & 0xffffu); } }
    __syncthreads();
}

__device__ __forceinline__ void p3_filter_tile(Frame& F, int tile) {
    const float* const* in = F.in;
    const int tid = F.tid;
    LAS float* feat = (LAS float*)F.lds;
    LAS float* h1 = feat + 64 * 36;
    LAS float* h2 = h1 + 64 * 65;
    LAS float* w1s = h2 + 64 * 64;
    LAS float* w2s = w1s + 33 * 64;
    for (int i = tid; i < 33 * 64; i += NT) w1s[i] = in[IN_FW1][i];
    for (int i = tid; i < 64 * 64; i += NT) w2s[i] = in[IN_FW2][i];
    {
        const int tt = tid >> 3, sub = tid & 7; const float t = (float)(tile * 64 + tt);
        const float w = (6.2831855f * t) / (float)L;
        if (sub == 0) feat[tt * 36] = t / (float)(L - 1);
#pragma unroll
        for (int q = 0; q < 2; ++q) { const int bi = sub * 2 + q; const float band = 1e-4f + (float)bi * ((15.0f - 1e-4f) / 15.0f); const float ang = w * band;
            feat[tt * 36 + 1 + bi] = cosf(ang); feat[tt * 36 + 17 + bi] = -sinf(ang); }
    }
    __syncthreads();
    {
        const int tt = tid >> 3, j0 = (tid & 7) * 8;
        float a[8];
#pragma unroll
        for (int q = 0; q < 8; ++q) a[q] = in[IN_FB1][j0 + q];
#pragma unroll 1
        for (int i = 0; i < 33; ++i) { const float f = feat[tt * 36 + i];
#pragma unroll
            for (int q = 0; q < 8; ++q) a[q] += f * w1s[i * 64 + j0 + q]; }
#pragma unroll
        for (int q = 0; q < 8; ++q) h1[tt * 65 + j0 + q] = sinf(in[IN_FF1][j0 + q] * a[q]);
    }
    __syncthreads();
    {
        const int tt = tid >> 3, j0 = (tid & 7) * 8;
        float a[8];
#pragma unroll
        for (int q = 0; q < 8; ++q) a[q] = in[IN_FB2][j0 + q];
#pragma unroll 1
        for (int i = 0; i < 64; ++i) { const float f = h1[tt * 65 + i];
#pragma unroll
            for (int q = 0; q < 8; ++q) a[q] += f * w2s[i * 64 + j0 + q]; }
#pragma unroll
        for (int q = 0; q < 8; ++q) h2[tt * 64 + j0 + q] = sinf(in[IN_FF2][j0 + q] * a[q]);
    }
    __syncthreads();
    {
        bf16* hd = (bf16*)(F.ws + WS_HDN);
        for (int i = tid; i < 64 * 32; i += NT) { const int tt = i >> 5, j = (i & 31) * 2; *(unsigned*)(hd + (size_t)(tile * 64 + tt) * 64 + j) = cvt_pk_bf16(h2[tt * 64 + j], h2[tt * 64 + j + 1]); }
    }
    __syncthreads();
}
__device__ __forceinline__ void p3_uin_tile(Frame& F, int tile) {
    const float* const* in = F.in;
    const bf16* z = (const bf16*)(F.ws + WS_Z); float* uT = (float*)(F.ws + WS_UIN);
    LAS float* tl = (LAS float*)F.lds;
    const int t0 = (tile >> 2) * 64, cb = (tile & 3) * 256;
    const int cg = F.tid & 31, c0 = cb + cg * 8, rsub = F.tid >> 5;
    for (int pass = 0; pass < 4; ++pass) {
        const int tt = pass * 16 + rsub, t = t0 + tt;
        float r1[8], r2[8];
#pragma unroll
        for (int part = 0; part < 2; ++part) {
            const int zc = OFF_HY + 1024 * (part + 1) + c0, wc = 1024 * (part + 1) + c0;
            const v4u cur = *(const v4u*)(z + (size_t)t * NINP + zc);
            const v4u prv = t > 0 ? *(const v4u*)(z + (size_t)(t - 1) * NINP + zc) : (v4u){0u, 0u, 0u, 0u};
            const v4u nxt = t < L - 1 ? *(const v4u*)(z + (size_t)(t + 1) * NINP + zc) : (v4u){0u, 0u, 0u, 0u};
            float* rr = part ? r2 : r1;
#pragma unroll
            for (int q = 0; q < 4; ++q) {
                const unsigned pc = q == 0 ? prv.x : q == 1 ? prv.y : q == 2 ? prv.z : prv.w, cc = q == 0 ? cur.x : q == 1 ? cur.y : q == 2 ? cur.z : cur.w, nc = q == 0 ? nxt.x : q == 1 ? nxt.y : q == 2 ? nxt.z : nxt.w;
                const int ch = wc + 2 * q;
                rr[2 * q] = bflo(pc) * in[IN_CHW][ch] + bflo(cc) * in[IN_CHW][3072 + ch] + bflo(nc) * in[IN_CHW][6144 + ch] + in[IN_CHB][ch];
                rr[2 * q + 1] = bfhi(pc) * in[IN_CHW][ch + 1] + bfhi(cc) * in[IN_CHW][3072 + ch + 1] + bfhi(nc) * in[IN_CHW][6144 + ch + 1] + in[IN_CHB][ch + 1];
            }
        }
#pragma unroll
        for (int q = 0; q < 8; ++q) tl[(cg * 8 + q) * 65 + tt] = r1[q] * r2[q];
    }
    __syncthreads();
    for (int i = F.tid; i < 256 * 16; i += NT) { const int c = i >> 4, tq = (i & 15) * 4; const LAS float* s = tl + c * 65 + tq;
        *(f32x4*)(uT + (size_t)(cb + c) * L + t0 + tq) = (f32x4){s[0], s[1], s[2], s[3]}; }
    __syncthreads();
}

#ifndef FFT_LAS
#define FFT_LAS LAS
#endif
#if defined(__HIP_DEVICE_COMPILE__)
#define FFT_OPAQUE(v) asm volatile("" : "+v"(v))
#else
#define FFT_OPAQUE(v)
#endif
constexpr int FN = 16384;
constexpr int FFT_SLOTS = 18432;
__host__ __device__ __forceinline__ int fphys(int p) { return p + (p >> 3); }
__host__ __device__ __forceinline__ float fcos32(int k) {
    constexpr float T[16] = {1.0f, 0.98078528040323043f, 0.92387953251128674f, 0.83146961230254524f, 0.70710678118654752f, 0.55557023301960218f, 0.38268343236508977f, 0.19509032201612825f,
                             0.0f, -0.19509032201612825f, -0.38268343236508977f, -0.55557023301960218f, -0.70710678118654752f, -0.83146961230254524f, -0.92387953251128674f, -0.98078528040323043f};
    return T[k]; }
__host__ __device__ __forceinline__ float fsin32(int k) {
    constexpr float T[16] = {0.0f, 0.19509032201612825f, 0.38268343236508977f, 0.55557023301960218f, 0.70710678118654752f, 0.83146961230254524f, 0.92387953251128674f, 0.98078528040323043f,
                             1.0f, 0.98078528040323043f, 0.92387953251128674f, 0.83146961230254524f, 0.70710678118654752f, 0.55557023301960218f, 0.38268343236508977f, 0.19509032201612825f};
    return T[k]; }
template <int R> __host__ __device__ __forceinline__ constexpr int fbrev(int x) { int r = 0; for (int b = 1; b < R; b <<= 1) { r = (r << 1) | (x & 1); x >>= 1; } return r; }
template <int R, bool INV>
__host__ __device__ __forceinline__ void fft_reg(float (&xr)[R], float (&xi)[R]) {
#pragma unroll
    for (int len = R; len >= 2; len >>= 1) {
        const int half = len >> 1;
#pragma unroll
        for (int blk = 0; blk < R; blk += len)
#pragma unroll
            for (int k = 0; k < half; ++k) {
                const int i0 = blk + k, i1 = i0 + half;
                const float ar = xr[i0], ai = xi[i0], br = xr[i1], bi = xi[i1];
                xr[i0] = ar + br; xi[i0] = ai + bi;
                const float dr = ar - br, di = ai - bi;
                if (k == 0) { xr[i1] = dr; xi[i1] = di; }
                else if (4 * k == len) { if (!INV) { xr[i1] = di; xi[i1] = -dr; } else { xr[i1] = -di; xi[i1] = dr; } }
                else { const float c = fcos32(k * (32 / len)), s = fsin32(k * (32 / len));
                    if (!INV) { xr[i1] = dr * c + di * s; xi[i1] = di * c - dr * s; } else { xr[i1] = dr * c - di * s; xi[i1] = di * c + dr * s; } }
            }
    }
}
__host__ __device__ __forceinline__ void ftw(int num, int den, float& c, float& s) {
#if defined(__HIP_DEVICE_COMPILE__)
    const float fr = (float)num / (float)den; c = __builtin_amdgcn_cosf(fr); s = __builtin_amdgcn_sinf(fr);
#else
    const double a = 6.283185307179586476925 * (double)num / (double)den; c = (float)cos(a); s = (float)sin(a);
#endif
}
template <int R, int M>
__host__ __device__ __forceinline__ void fft_fwd_bfly(FFT_LAS float* buf, int B, int j) {
    constexpr int S = M / R;
    float xr[R], xi[R];
#pragma unroll
    for (int q = 0; q < R; ++q) { const f32x2 v = *(const FFT_LAS f32x2*)(buf + 2 * fphys(B + j + q * S)); xr[q] = v.x; xi[q] = v.y; }
    fft_reg<R, false>(xr, xi);
    if (S > 1) { float c1, s1; ftw(j, M, c1, s1); float wr = c1, wi = -s1;
#pragma unroll
        for (int r = 1; r < R; ++r) { const int ix = fbrev<R>(r); const float tr = xr[ix] * wr - xi[ix] * wi, ti = xr[ix] * wi + xi[ix] * wr; xr[ix] = tr; xi[ix] = ti;
            const float nr = wr * c1 + wi * s1, ni = wi * c1 - wr * s1; wr = nr; wi = ni; } }
#pragma unroll
    for (int r = 0; r < R; ++r) { const int ix = fbrev<R>(r); *(FFT_LAS f32x2*)(buf + 2 * fphys(B + j + r * S)) = (f32x2){xr[ix], xi[ix]}; }
}
template <int R, int M>
__host__ __device__ __forceinline__ void fft_inv_bfly(FFT_LAS float* buf, int B, int j) {
    constexpr int S = M / R;
    float xr[R], xi[R];
#pragma unroll
    for (int r = 0; r < R; ++r) { const f32x2 v = *(const FFT_LAS f32x2*)(buf + 2 * fphys(B + j + r * S)); xr[r] = v.x; xi[r] = v.y; }
    if (S > 1) { float c1, s1; ftw(j, M, c1, s1); float wr = c1, wi = s1;
#pragma unroll
        for (int r = 1; r < R; ++r) { const float tr = xr[r] * wr - xi[r] * wi, ti = xr[r] * wi + xi[r] * wr; xr[r] = tr; xi[r] = ti;
            const float nr = wr * c1 - wi * s1, ni = wi * c1 + wr * s1; wr = nr; wi = ni; } }
    fft_reg<R, true>(xr, xi);
#pragma unroll
    for (int q = 0; q < R; ++q) { const int ix = fbrev<R>(q); *(FFT_LAS f32x2*)(buf + 2 * fphys(B + j + q * S)) = (f32x2){xr[ix], xi[ix]}; }
}
__host__ __device__ __forceinline__ void fft_fwd_pass(FFT_LAS float* buf, int pass, int tid) {
    FFT_OPAQUE(tid);
    if (pass == 0) {
#pragma unroll 1
        for (int i = 0; i < 2; ++i) fft_fwd_bfly<16, 16384>(buf, 0, tid + 512 * i); }
    else if (pass == 1) {
#pragma unroll 1
        for (int i = 0; i < 2; ++i) { const int id = tid + 512 * i; fft_fwd_bfly<16, 1024>(buf, (id >> 6) * 1024, id & 63); } }
    else if (pass == 2) {
#pragma unroll 1
        for (int i = 0; i < 4; ++i) { const int id = tid + 512 * i; fft_fwd_bfly<8, 64>(buf, (id >> 3) * 64, id & 7); } }
    else {
#pragma unroll 1
        for (int i = 0; i < 4; ++i) { const int id = tid + 512 * i; fft_fwd_bfly<8, 8>(buf, id * 8, 0); } }
}
__host__ __device__ __forceinline__ void fft_inv_pass(FFT_LAS float* buf, int pass, int tid) {
    FFT_OPAQUE(tid);
    if (pass == 0) {
#pragma unroll 1
        for (int i = 0; i < 4; ++i) { const int id = tid + 512 * i; fft_inv_bfly<8, 8>(buf, id * 8, 0); } }
    else if (pass == 1) {
#pragma unroll 1
        for (int i = 0; i < 4; ++i) { const int id = tid + 512 * i; fft_inv_bfly<8, 64>(buf, (id >> 3) * 64, id & 7); } }
    else if (pass == 2) {
#pragma unroll 1
        for (int i = 0; i < 2; ++i) { const int id = tid + 512 * i; fft_inv_bfly<16, 1024>(buf, (id >> 6) * 1024, id & 63); } }
    else {
#pragma unroll 1
        for (int i = 0; i < 2; ++i) fft_inv_bfly<16, 16384>(buf, 0, tid + 512 * i); }
}
__host__ __device__ __forceinline__ int fpos(int k) { return ((k & 15) << 10) | (((k >> 4) & 15) << 6) | (((k >> 8) & 7) << 3) | (k >> 11); }
__host__ __device__ __forceinline__ void fft_mul_one(FFT_LAS float* buf, int k, float cr, float ci, float dr_, float di_, float wc, float ws) {
    const int k2 = (FN - k) & (FN - 1);
    FFT_LAS f32x2* pa = (FFT_LAS f32x2*)(buf + 2 * fphys(fpos(k))); FFT_LAS f32x2* pb = (FFT_LAS f32x2*)(buf + 2 * fphys(fpos(k2)));
    const f32x2 A = *pa, Bm = *pb;
    const float ar = A.x, ai = A.y, br = Bm.x, bi = -Bm.y, dr = dr_, di = -di_;
    const float uer = 0.5f * (ar + br), uei = 0.5f * (ai + bi), uor = 0.5f * (ai - bi), uoi = -0.5f * (ar - br);
    const float ker = 0.5f * (cr + dr), kei = 0.5f * (ci + di), kor = 0.5f * (ci - di), koi = -0.5f * (cr - dr);
    const float pr = uor * kor - uoi * koi, pi = uor * koi + uoi * kor;
    const float yer = (uer * ker - uei * kei) + (pr * wc + pi * ws), yei = (uer * kei + uei * ker) + (pi * wc - pr * ws);
    const float yor = (uer * kor - uei * koi) + (uor * ker - uoi * kei), yoi = (uer * koi + uei * kor) + (uor * kei + uoi * ker);
    *pa = (f32x2){yer - yoi, yei + yor};
    *pb = (f32x2){yer + yoi, -yei + yor};
}
__device__ __forceinline__ void p4_fft_job(Frame& F, int job) {
    const float* const* in = F.in;
    int tid_ = F.tid, lane_ = F.lane; FFT_OPAQUE(tid_); FFT_OPAQUE(lane_);
    const int tid = tid_, lane = lane_, wave = F.wave, c0 = job * 4;
    LAS float* buf = (LAS float*)F.lds;
    LAS float* scr = (LAS float*)(F.lds + FFTSCR_OFF);
    float* hfT = (float*)(F.ws + WS_KF); float* hbT = (float*)(F.ws + WS_KB); const float* uT = (const float*)(F.ws + WS_UIN);
    {
        const bf16* hd = (const bf16*)(F.ws + WS_HDN);
        const int n = lane & 15, kq = lane >> 4, ch = (n >> 1) & 3, dir = n & 1, col = dir * 1024 + c0 + ch; const bool valid = n < 8;
        bf16x8 bfr[2];
#pragma unroll
        for (int ks = 0; ks < 2; ++ks) { unsigned w[4];
#pragma unroll
            for (int j = 0; j < 4; ++j) { const int k = ks * 32 + kq * 8 + 2 * j; const float a = valid ? in[IN_FW3][(size_t)k * 2048 + col] : 0.f, b = valid ? in[IN_FW3][(size_t)(k + 1) * 2048 + col] : 0.f; w[j] = cvt_pk_bf16(a, b); }
            bfr[ks] = __builtin_bit_cast(bf16x8, (v4u){w[0], w[1], w[2], w[3]}); }
        const float b3 = valid ? in[IN_FB3][col] : 0.f;
        const float r_slow = 3.0701134573253945f, r_fast = 15.350567286626972f;
        const float rate = r_slow + (float)(c0 + ch) * ((r_fast - r_slow) / 1023.0f);
        float asum = 0.f; float* dst = (dir ? hbT : hfT) + (size_t)(c0 + ch) * L;
#pragma unroll 1
        for (int tb = wave * 8; tb < L / 16; tb += NWAVES * 8) {
            bf16x8 a0[8], a1[8];
#pragma unroll
            for (int i = 0; i < 8; ++i) { const bf16* hp = hd + (size_t)((tb + i) * 16 + n) * 64 + kq * 8; a0[i] = *(const bf16x8*)hp; a1[i] = *(const bf16x8*)(hp + 32); }
#pragma unroll
            for (int i = 0; i < 8; ++i) { const int t0 = (tb + i) * 16;
                f32x4 acc = (f32x4){b3, b3, b3, b3};
                acc = __builtin_amdgcn_mfma_f32_16x16x32_bf16(a0[i], bfr[0], acc, 0, 0, 0);
                acc = __builtin_amdgcn_mfma_f32_16x16x32_bf16(a1[i], bfr[1], acc, 0, 0, 0);
                if (valid) { f32x4 o;
#pragma unroll
                    for (int r = 0; r < 4; ++r) { const int t = t0 + 4 * kq + r; const float t01 = (float)t / (float)(L - 1); const float v = acc[r] * __expf(-t01 * rate); o[r] = v; if (!(dir && t == 0)) asum += fabsf(v); }
                    *(f32x4*)(dst + t0 + 4 * kq) = o; } }
        }
        asum += __shfl_xor(asum, 16); asum += __shfl_xor(asum, 32);
        if (lane < 8) scr[wave * 8 + lane] = asum;
        VM_WAIT(); __syncthreads();
        float tot = 0.f;
        if (tid < 4) { for (int w = 0; w < 8; ++w) tot += scr[w * 8 + 2 * tid] + scr[w * 8 + 2 * tid + 1]; }
        __syncthreads();
        if (tid < 4) scr[tid] = 1.0f / (tot * (float)FN);
        __syncthreads();
    }
#pragma unroll 1
    for (int ch = 0; ch < 4; ++ch) {
        const int c = c0 + ch;
        const float* hf = hfT + (size_t)c * L; const float* hb = hbT + (size_t)c * L; const float* uc = uT + (size_t)c * L;
#pragma unroll 8
        for (int i = 0; i < 16; ++i) { const int a = tid + NT * i; const f32x2 v = *(const f32x2*)(hf + 2 * a); *(LAS f32x2*)(buf + 2 * fphys(a)) = v; }
#pragma unroll 8
        for (int i = 0; i < 16; ++i) { const int a = FN / 2 + tid + NT * i; const float ko = hb[2 * FN - 2 * a - 1]; float ke = hb[2 * FN - 2 * a]; if (a == FN / 2) ke = 0.f;
            *(LAS f32x2*)(buf + 2 * fphys(a)) = (f32x2){ke, ko}; }
        __syncthreads();
        fft_fwd_pass(buf, 0, tid); __syncthreads(); fft_fwd_pass(buf, 1, tid); __syncthreads(); fft_fwd_pass(buf, 2, tid); __syncthreads(); fft_fwd_pass(buf, 3, tid); __syncthreads();
        {
            int tq = tid; FFT_OPAQUE(tq);
            f32x2* sa = (f32x2*)(hfT + (size_t)c * L); f32x2* sb = (f32x2*)(hbT + (size_t)c * L);
#pragma unroll 4
            for (int m = 0; m < 16; ++m) { const int k = tq + 512 * m, k2 = (FN - k) & (FN - 1);
                sa[m * 512 + tq] = *(const LAS f32x2*)(buf + 2 * fphys(fpos(k))); sb[m * 512 + tq] = *(const LAS f32x2*)(buf + 2 * fphys(fpos(k2))); }
            if (tid == 0) { const f32x2 h = *(const LAS f32x2*)(buf + 2 * fphys(fpos(FN / 2))); scr[8] = h.x; scr[9] = h.y; }
        }
        __syncthreads();
#pragma unroll 8
        for (int i = 0; i < 16; ++i) { const int a = tid + NT * i; const f32x2 v = *(const f32x2*)(uc + 2 * a); *(LAS f32x2*)(buf + 2 * fphys(a)) = v; }
#pragma unroll 4
        for (int i = 0; i < 16; ++i) { const int a = FN / 2 + tid + NT * i; *(LAS f32x2*)(buf + 2 * fphys(a)) = (f32x2){0.f, 0.f}; }
        __syncthreads();
        fft_fwd_pass(buf, 0, tid); __syncthreads(); fft_fwd_pass(buf, 1, tid); __syncthreads(); fft_fwd_pass(buf, 2, tid); __syncthreads(); fft_fwd_pass(buf, 3, tid); __syncthreads();
        {   int tq = tid; FFT_OPAQUE(tq);
            const f32x2* sa = (const f32x2*)(hfT + (size_t)c * L); const f32x2* sb = (const f32x2*)(hbT + (size_t)c * L);
            float c1, s1; ftw(tq, FN, c1, s1);
#pragma unroll 8
            for (int m = 0; m < 16; ++m) { const float cm = fcos32(m), sm = fsin32(m); const float wc = c1 * cm - s1 * sm, ws = s1 * cm + c1 * sm;
                const f32x2 ka = sa[m * 512 + tq], kb = sb[m * 512 + tq];
                fft_mul_one(buf, tq + 512 * m, ka.x, ka.y, kb.x, kb.y, wc, ws); }
            if (tid == 0) fft_mul_one(buf, FN / 2, scr[8], scr[9], scr[8], scr[9], -1.0f, 0.0f);
        }
        VM_WAIT(); __syncthreads();
        fft_inv_pass(buf, 0, tid); __syncthreads(); fft_inv_pass(buf, 1, tid); __syncthreads(); fft_inv_pass(buf, 2, tid); __syncthreads(); fft_inv_pass(buf, 3, tid); __syncthreads();
        { const float sc = scr[ch]; float* yT = hfT + (size_t)c * L;
#pragma unroll 2
            for (int nn = tid; nn < FN / 2; nn += NT) { const f32x2 v = *(const LAS f32x2*)(buf + 2 * fphys(nn)); *(f32x2*)(yT + 2 * nn) = (f32x2){v.x * sc, v.y * sc}; } }
        __syncthreads();
    }
    VM_WAIT(); __syncthreads();
    {
        const bf16* z = (const bf16*)(F.ws + WS_Z); bf16* cat = (bf16*)(F.ws + WS_CAT);
        float w0[4], w1[4], w2[4], bb[4], dsk[4];
#pragma unroll
        for (int q = 0; q < 4; ++q) { w0[q] = in[IN_CHW][c0 + q]; w1[q] = in[IN_CHW][3072 + c0 + q]; w2[q] = in[IN_CHW][6144 + c0 + q]; bb[q] = in[IN_CHB][c0 + q]; dsk[q] = in[IN_DSKIP][c0 + q]; }
#pragma unroll 4
        for (int t = tid; t < L; t += NT) {
            const v2u zc = *(const v2u*)(z + (size_t)t * NINP + OFF_HY + c0);
            const v2u zp = t > 0 ? *(const v2u*)(z + (size_t)(t - 1) * NINP + OFF_HY + c0) : (v2u){0u, 0u};
            const v2u zn = t < L - 1 ? *(const v2u*)(z + (size_t)(t + 1) * NINP + OFF_HY + c0) : (v2u){0u, 0u};
            const float pv[4] = {bflo(zp.x), bfhi(zp.x), bflo(zp.y), bfhi(zp.y)}, cv[4] = {bflo(zc.x), bfhi(zc.x), bflo(zc.y), bfhi(zc.y)}, nv[4] = {bflo(zn.x), bfhi(zn.x), bflo(zn.y), bfhi(zn.y)};
            float o[4];
#pragma unroll
            for (int q = 0; q < 4; ++q) { const float y = hfT[(size_t)(c0 + q) * L + t] + dsk[q] * uT[(size_t)(c0 + q) * L + t];
                o[q] = (pv[q] * w0[q] + cv[q] * w1[q] + nv[q] * w2[q] + bb[q]) * y; }
            v2u w; w.x = cvt_pk_bf16(o[0], o[1]); w.y = cvt_pk_bf16(o[2], o[3]);
            *(v2u*)(cat + (size_t)t * D + MVW + c0) = w;
        }
    }
    __syncthreads();
}
constexpr int RT_PITCH = 2056;
__device__ __forceinline__ void p6_norm2_router(Frame& F) {
    const float* const* in = F.in;
    const float* mod = (const float*)(F.ws + WS_MOD);
    bf16* h2g = (bf16*)(F.ws + WS_HA);
    int* cnt = (int*)(F.ws + WS_CTL) + CW_CNT;
    int* aexp = (int*)(F.ws + WS_AEXP); int* arank = (int*)(F.ws + WS_ARANK); float* aw = (float*)(F.ws + WS_AW);
    LAS bf16* h1 = (LAS bf16*)F.lds; LAS bf16* h2 = h1 + 16 * RT_PITCH;
    LAS float* part = (LAS float*)(h2 + 16 * RT_PITCH);
    const bf16* w1 = (const bf16*)(F.ws + WS_WR1); const bf16* w2 = (const bf16*)(F.ws + WS_WR2);
    const int lane = F.lane, wave = F.wave, fr = lane & 15, fq = lane >> 4;
    for (int t0 = F.bid * 16; t0 < L; t0 += F.G * 16) {
#pragma unroll 1
        for (int rr = 0; rr < 2; ++rr) {
            const int tr = 2 * wave + rr, t = t0 + tr;
            f32x4 v[8]; float ss = 0.f;
#pragma unroll
            for (int j = 0; j < 8; ++j) { const int col = 4 * lane + 256 * j; v[j] = *(const f32x4*)(F.out + (size_t)t * D + col); ss += (v[j].x * v[j].x + v[j].y * v[j].y) + (v[j].z * v[j].z + v[j].w * v[j].w); }
            const float rstd = rsqrtf(wave_sum(ss) * (1.0f / D) + EPS);
#pragma unroll
            for (int j = 0; j < 8; ++j) { const int col = 4 * lane + 256 * j;
                const f32x4 g = *(const f32x4*)(in[IN_GFFN] + col), sh = *(const f32x4*)(mod + 6144 + col), sc = *(const f32x4*)(mod + 8192 + col);
                const f32x4 h = (v[j] * rstd * g) * (sc + 1.0f) + sh;
                v2u o; o.x = cvt_pk_bf16(h.x, h.y); o.y = cvt_pk_bf16(h.z, h.w);
                *(v2u*)(h2g + (size_t)t * D + col) = o;
                *(LAS v2u*)(h1 + tr * RT_PITCH + col) = o;
                v2u lo; lo.x = cvt_pk_bf16(h.x - bflo(o.x), h.y - bfhi(o.x)); lo.y = cvt_pk_bf16(h.z - bflo(o.y), h.w - bfhi(o.y));
                *(LAS v2u*)(h2 + tr * RT_PITCH + col) = lo; }
        }
        __syncthreads();
        {
            const int nt = wave & 3, kh = wave >> 2;
            f32x4 acc = (f32x4){0.f, 0.f, 0.f, 0.f};
            const bf16* b1p = w1 + (size_t)(16 * nt + fr) * 2048 + kh * 1024 + 8 * fq; const bf16* b2p = w2 + (size_t)(16 * nt + fr) * 2048 + kh * 1024 + 8 * fq;
            const LAS bf16* a1p = h1 + fr * RT_PITCH + kh * 1024 + 8 * fq; const LAS bf16* a2p = h2 + fr * RT_PITCH + kh * 1024 + 8 * fq;
#pragma unroll 8
            for (int ks = 0; ks < 32; ++ks) {
                const bf16x8 a1 = *(const LAS bf16x8*)(a1p + 32 * ks), a2 = *(const LAS bf16x8*)(a2p + 32 * ks);
                const bf16x8 b1 = *(const bf16x8*)(b1p + 32 * ks), b2 = *(const bf16x8*)(b2p + 32 * ks);
                acc = __builtin_amdgcn_mfma_f32_16x16x32_bf16(a2, b1, acc, 0, 0, 0);
                acc = __builtin_amdgcn_mfma_f32_16x16x32_bf16(a1, b2, acc, 0, 0, 0);
                acc = __builtin_amdgcn_mfma_f32_16x16x32_bf16(a1, b1, acc, 0, 0, 0); }
#pragma unroll
            for (int r = 0; r < 4; ++r) part[(kh * 16 + 4 * fq + r) * 64 + 16 * nt + fr] = acc[r];
        }
        __syncthreads();
#pragma unroll 1
        for (int rr = 0; rr < 2; ++rr) {
            const int tr = 2 * wave + rr, t = t0 + tr;
            const float logit = part[tr * 64 + lane] + part[(16 + tr) * 64 + lane];
            const float s = 1.0f / (1.0f + expf(-logit)), sel = s + in[IN_BR][lane];
            const int grp = lane >> 3;
            float m1 = sel; m1 = fmaxf(m1, __shfl_xor(m1, 1)); m1 = fmaxf(m1, __shfl_xor(m1, 2)); m1 = fmaxf(m1, __shfl_xor(m1, 4));
            const unsigned long long gm = 0xFFull << (8 * grp);
            const unsigned long long b1 = __ballot(sel == m1) & gm;
            const int first = __ffsll((long long)b1) - 1;
            float m2 = (lane == first) ? -INFINITY : sel; m2 = fmaxf(m2, __shfl_xor(m2, 1)); m2 = fmaxf(m2, __shfl_xor(m2, 2)); m2 = fmaxf(m2, __shfl_xor(m2, 4));
            const float gs = m1 + m2;
            int grank = 0;
#pragma unroll
            for (int g = 0; g < 8; ++g) { const float og = __shfl(gs, 8 * g); grank += (og > gs || (og == gs && g < grp)) ? 1 : 0; }
            const float masked = grank < 4 ? sel : -INFINITY;
            int rank = 0;
            for (int e2 = 0; e2 < 64; ++e2) { const float om = __shfl(masked, e2); rank += (om > masked || (om == masked && e2 < lane)) ? 1 : 0; }
            const bool chosen = rank < 8;
            const float wsum = wave_sum(chosen ? s : 0.f);
            const unsigned long long cb = __ballot(chosen);
            if (chosen) {
                const int k = (int)__builtin_amdgcn_mbcnt_hi((unsigned)(cb >> 32), __builtin_amdgcn_mbcnt_lo((unsigned)cb, 0u));
                const int half = t >= HALF_T ? 1 : 0;
                const int r = atomicAdd(cnt + half * 64 + lane, 1);
                aexp[t * 8 + k] = lane; arank[t * 8 + k] = r; aw[t * 8 + k] = s / wsum * 2.5f;
            }
        }
        __syncthreads();
    }
}
__device__ __forceinline__ void build_pstart(Frame& F) {
    LAS int* ps = (LAS int*)(F.lds + LDSCTL_OFF);
    const int* cnt = (const int*)(F.ws + WS_CTL) + CW_CNT;
    __syncthreads();
    if (F.tid < 2) { int a = 0;
        for (int e = 0; e < NE; ++e) { ps[F.tid * 66 + e] = a; a += (__hip_atomic_load(cnt + F.tid * 64 + e, __ATOMIC_RELAXED, __HIP_MEMORY_SCOPE_AGENT) + 255) & ~255; }
        ps[F.tid * 66 + 64] = a; ps[F.tid * 66 + 65] = a + HALF_T; }
    __syncthreads();
}
__device__ __forceinline__ void p7_fill_rows(Frame& F) {
    build_pstart(F);
    const LAS int* ps = (const LAS int*)(F.lds + LDSCTL_OFF);
    const int* aexp = (const int*)(F.ws + WS_AEXP); const int* arank = (const int*)(F.ws + WS_ARANK); const float* aw = (const float*)(F.ws + WS_AW);
    int* rt = (int*)(F.ws + WS_RTOK); float* rw = (float*)(F.ws + WS_RW);
    const int gt = F.bid * NT + F.tid, NGT = F.G * NT;
    for (int i = gt; i < L * 8; i += NGT) { const int t = i >> 3, h = t >= HALF_T ? 1 : 0; const int row = ps[h * 66 + aexp[i]] + arank[i];
        rt[h * MAXROWS + row] = t; rw[h * MAXROWS + row] = aw[i]; }
    for (int t = gt; t < L; t += NGT) { const int h = t >= HALF_T ? 1 : 0; const int row = ps[h * 66 + 64] + (t - h * HALF_T);
        rt[h * MAXROWS + row] = t; rw[h * MAXROWS + row] = 1.0f; }
}
__device__ __forceinline__ void moe_combine(Frame& F, int half) {
    const float* const* in = F.in;
    const LAS int* ps = (const LAS int*)(F.lds + LDSCTL_OFF) + half * 66;
    const float* mod = (const float*)(F.ws + WS_MOD);
    const int* aexp = (const int*)(F.ws + WS_AEXP); const int* arank = (const int*)(F.ws + WS_ARANK);
    const bf16* Y2 = (const bf16*)(F.ws + WS_Y2);
    const int gw = F.bid * NWAVES + F.wave, NGW = F.G * NWAVES, lane = F.lane;
    for (int tt = gw; tt < HALF_T; tt += NGW) {
        const int t = half * HALF_T + tt;
        float a[32];
#pragma unroll
        for (int i = 0; i < 32; ++i) a[i] = 0.f;
#pragma unroll 3
        for (int k = 0; k < 9; ++k) {
            const int row = k < 8 ? ps[aexp[t * 8 + k]] + arank[t * 8 + k] : ps[64] + tt;
            const bf16* yr = Y2 + (size_t)row * D + 8 * lane;
#pragma unroll
            for (int j = 0; j < 4; ++j) { const v4u y = *(const v4u*)(yr + 512 * j);
                a[8 * j + 0] += bflo(y.x); a[8 * j + 1] += bfhi(y.x); a[8 * j + 2] += bflo(y.y); a[8 * j + 3] += bfhi(y.y);
                a[8 * j + 4] += bflo(y.z); a[8 * j + 5] += bfhi(y.z); a[8 * j + 6] += bflo(y.w); a[8 * j + 7] += bfhi(y.w); }
        }
        float ss = 0.f;
#pragma unroll
        for (int j = 0; j < 4; ++j)
#pragma unroll
            for (int q = 0; q < 2; ++q) { const int col = 8 * lane + 512 * j + 4 * q;
                const f32x4 x1 = *(const f32x4*)(F.out + (size_t)t * D + col), g2 = *(const f32x4*)(mod + 10240 + col);
                const int i = 8 * j + 4 * q;
                a[i] = x1.x + g2.x * a[i]; a[i + 1] = x1.y + g2.y * a[i + 1]; a[i + 2] = x1.z + g2.z * a[i + 2]; a[i + 3] = x1.w + g2.w * a[i + 3];
                ss += (a[i] * a[i] + a[i + 1] * a[i + 1]) + (a[i + 2] * a[i + 2] + a[i + 3] * a[i + 3]); }
        const float rstd = rsqrtf(wave_sum(ss) * (1.0f / D) + EPS);
#pragma unroll
        for (int j = 0; j < 4; ++j)
#pragma unroll
            for (int q = 0; q < 2; ++q) { const int col = 8 * lane + 512 * j + 4 * q; const int i = 8 * j + 4 * q;
                const f32x4 gf = *(const f32x4*)(in[IN_GFIN] + col);
                *(f32x4*)(F.out + (size_t)t * D + col) = (f32x4){a[i] * rstd * gf.x, a[i + 1] * rstd * gf.y, a[i + 2] * rstd * gf.z, a[i + 3] * rstd * gf.w}; }
    }
}

constexpr int N_PHASES = 14;
__global__ void __launch_bounds__(NT, 2) fwd_kernel(Args args) {
    extern __shared__ __attribute__((aligned(16))) unsigned char lds_raw[];
    Frame F;
    F.lds = (LAS unsigned char*)lds_raw;
    F.tid = threadIdx.x; F.lane = F.tid & 63; F.wave = __builtin_amdgcn_readfirstlane(F.tid >> 6);
    F.bid = blockIdx.x; F.G = gridDim.x;
    F.in = args.in; F.out = args.out; F.ws = args.ws;
    volatile LAS unsigned* MISC = (volatile LAS unsigned*)(F.lds + LDSCTL_OFF + 768);
    if (F.tid < 64) ((LAS unsigned*)(F.lds + LDSCTL_OFF))[F.tid + 192] = 0u;
    __syncthreads();
    unsigned* ctl = (unsigned*)(F.ws + WS_CTL);
    const int lo = args.ph_lo, hi = args.ph_hi;
    XcdBarrier bar; bar.bar = ctl + CW_BAR; bar.x = 0; bar.st = nullptr;
    if (hi - lo > 1) bar = xcd_barrier_post(ctl + CW_BAR, MISC + 8);
#ifndef PH_MASK
#define PH_MASK 0xFFFF
#endif
#define IN(k) (((PH_MASK >> (k)) & 1) && lo <= (k) && (k) < hi)
#define SEAM(k) do { if (IN(k) && IN((k) + 1)) xcd_barrier(bar); } while (0)
#define REP(k) for (int rep_ = 0; rep_ < ((PROBE_DUP) == (k) ? 2 : 1); ++rep_) if ((rep_ ? __syncthreads() : (void)0), true)
    LAS int* ps = (LAS int*)(F.lds + LDSCTL_OFF);

    if (IN(0)) REP(0) { p0_prologue(F); } SEAM(0);
    if (IN(1)) REP(1) { p1_norm1(F); } SEAM(1);
    if (IN(2)) {
        gk::DenseOrder S; S.init(MROWS, NINP, D, F.G, F.bid); S.Bt = (const char*)(F.ws + WS_WIN);
        gk::EpiBf16Store E{(bf16*)(F.ws + WS_Z), NINP};
        gk::gemm_core(F.lds, (const char*)(F.ws + WS_HA), D, S, E);
    }
#if PROBE_DUP == 2
    if (IN(2)) { __syncthreads(); } if (IN(2)) {
        gk::DenseOrder S; S.init(MROWS, NINP, D, F.G, F.bid); S.Bt = (const char*)(F.ws + WS_WIN);
        gk::EpiBf16Store E{(bf16*)(F.ws + WS_Z), NINP};
        gk::gemm_core(F.lds, (const char*)(F.ws + WS_HA), D, S, E);
    }
#endif
    SEAM(2);
    if (IN(3)) REP(3) {
        for (int it = F.bid; it < 1040; it += F.G) ml_prep_item(F, it);
        for (int tile = F.bid; tile < 256; tile += F.G) p3_filter_tile(F, tile);
        for (int tile = F.bid; tile < 1024; tile += F.G) p3_uin_tile(F, tile);
    } SEAM(3);
    if (IN(4)) REP(4) { ml_scan(F); } SEAM(4);
    if (IN(5)) {
        for (int job = F.bid; job < 256; job += F.G) p4_fft_job(F, job);
#if PROBE_DUP == 50
        __syncthreads(); for (int job = F.bid; job < 256; job += F.G) p4_fft_job(F, job);
#endif
        for (int it = F.bid; it < 1024; it += F.G) ml_out_item(F, it);
    }
#if PROBE_DUP == 51
    if (IN(5)) { __syncthreads(); for (int it = F.bid + 0 * F.G; it < 1024; it += F.G) ml_out_item(F, it); }
#endif
    SEAM(5);
    if (IN(6)) {
        gk::DenseOrder S; S.init(L, D, D, F.G, F.bid); S.Bt = (const char*)(F.ws + WS_WOUT);
        gk::EpiResidual E{F.out, D, (const float*)(F.ws + WS_MOD) + 4096};
        gk::gemm_core(F.lds, (const char*)(F.ws + WS_CAT), D, S, E);
    } SEAM(6);
    if (IN(7)) { p6_norm2_router(F); } SEAM(7);
    if (IN(8)) { p7_fill_rows(F); } SEAM(8);
#define MOE_GU(h) do { build_pstart(F); \
        gk::GroupOrder<4, true> S; S.ntile = ps[(h) * 66 + 65] >> 8; S.G = F.G; S.c = F.bid; S.K = D; S.pstart = ps + (h) * 66; S.rtok = (const int*)(F.ws + WS_RTOK) + (h) * MAXROWS; \
        S.Bt = (const char*)(F.ws + WS_W13); S.bstride = (size_t)1024 * D * 2; \
        gk::EpiGateUp E{(bf16*)(F.ws + WS_HR)}; \
        gk::gemm_core(F.lds, (const char*)(F.ws + WS_HA), D, S, E); } while (0)
#define MOE_DN(h) do { build_pstart(F); \
        gk::GroupOrder<8, false> S; S.ntile = ps[(h) * 66 + 65] >> 8; S.G = F.G; S.c = F.bid; S.K = DE; S.pstart = ps + (h) * 66; S.rtok = nullptr; \
        S.Bt = (const char*)(F.ws + WS_W2); S.bstride = (size_t)D * DE * 2; \
        gk::EpiDown E{(bf16*)(F.ws + WS_Y2), (const float*)(F.ws + WS_RW) + (h) * MAXROWS}; \
        gk::gemm_core(F.lds, (const char*)(F.ws + WS_HR), DE, S, E); } while (0)
    if (IN(9)) REP(9) { MOE_GU(0); } SEAM(9);
    if (IN(10)) REP(10) { MOE_DN(0); } SEAM(10);
    if (IN(11)) { MOE_GU(1); moe_combine(F, 0); } SEAM(11);
    if (IN(12)) REP(12) { MOE_DN(1); } SEAM(12);
    if (IN(13)) { build_pstart(F); moe_combine(F, 1); }
#undef IN
#undef SEAM
}

extern "C" void kernel_launch(void* const* d_in, const int* in_sizes, int n_in, void* d_out, int out_size, void* d_ws, size_t ws_size, hipStream_t stream) {
    static int grid = 0;
    if (grid == 0) {
        if (n_in != 36 || out_size != L * D || ws_size < WS_END) { fprintf(stderr, "kernel_launch: unexpected shapes: n_in %d out %d ws %zu (need %zu)\n", n_in, out_size, ws_size, (size_t)WS_END); grid = -1; return; }
        int dev = 0, cus = 0, per_cu = 0;
        if (hipGetDevice(&dev) != hipSuccess || hipDeviceGetAttribute(&cus, hipDeviceAttributeMultiprocessorCount, dev) != hipSuccess) { grid = -1; return; }
        if (hipFuncSetAttribute((const void*)fwd_kernel, hipFuncAttributeMaxDynamicSharedMemorySize, LDS_BYTES) != hipSuccess) { fprintf(stderr, "kernel_launch: hipFuncSetAttribute failed\n"); grid = -1; return; }
        if (hipOccupancyMaxActiveBlocksPerMultiprocessor(&per_cu, (const void*)fwd_kernel, NT, LDS_BYTES) != hipSuccess || per_cu < 1) fprintf(stderr, "kernel_launch: occupancy query says %d\n", per_cu);
        (void)hipGetLastError();
        grid = cus;
    }
    if (grid < 0) return;
    if (hipMemsetAsync((char*)d_ws + WS_CTL, 0, CTL_ZERO_BYTES, stream) != hipSuccess) return;
    Args a{};
    for (int i = 0; i < 36; ++i) a.in[i] = (const float*)d_in[i];
    a.out = (float*)d_out; a.ws = (unsigned char*)d_ws;
    const int stop = MK_STOP_AFTER < N_PHASES ? MK_STOP_AFTER + 1 : N_PHASES;
#if MK_N_LAUNCHES == 1
    a.ph_lo = 0; a.ph_hi = stop;
    hipLaunchKernelGGL(fwd_kernel, dim3(grid), dim3(NT), LDS_BYTES, stream, a);
#else
    for (int p = 0; p < stop; ++p) { a.ph_lo = p; a.ph_hi = p + 1; hipLaunchKernelGGL(fwd_kernel, dim3(grid), dim3(NT), LDS_BYTES, stream, a); }
#endif
}
```

```cpp
#include <hip/hip_runtime.h>
#include <cstdio>
#include <cstdint>

#ifndef MK_N_LAUNCHES
#define MK_N_LAUNCHES 1
#endif
#ifndef PROBE_DUP
#define PROBE_DUP -1
#endif
#ifndef MK_STOP_AFTER
#define MK_STOP_AFTER 99
#endif

#define GAS __attribute__((address_space(1)))
#define LAS __attribute__((address_space(3)))
typedef unsigned short bf16;
typedef unsigned v4u __attribute__((ext_vector_type(4)));
typedef unsigned v2u __attribute__((ext_vector_type(2)));
typedef float f32x4 __attribute__((ext_vector_type(4)));
typedef float f32x2 __attribute__((ext_vector_type(2)));
typedef short bf16x8 __attribute__((ext_vector_type(8)));
#define LDS_WAIT() asm volatile("s_waitcnt lgkmcnt(0)" ::: "memory")
#define VM_WAIT() asm volatile("s_waitcnt vmcnt(0)" ::: "memory")

constexpr int NWAVES = 8, NT = NWAVES * 64;
constexpr int L = 16384, D = 2048, LC = 256, MROWS = L + LC;
constexpr int NIN = 6176, NINP = 6400;
constexpr int OFF_K = 0, OFF_V = 512, OFF_G = 1536, OFF_Q = 1568, OFF_O = 2080, OFF_HY = 3104;
constexpr int NH = 8, HYW = 1024, MVW = 1024;
constexpr int NE = 64, NE1 = 65, DE = 512;
constexpr int HALF_T = 8192;
constexpr int MAXROWS = 90112;
constexpr float EPS = 1e-6f;

constexpr size_t MiB = 1u << 20;
constexpr size_t WS_CTL = 0, CTL_ZERO_BYTES = 256 * 1024;
constexpr size_t WS_MOD = 1 * MiB;
constexpr size_t WS_POS = WS_MOD + 128 * 1024;
constexpr size_t WS_WR1 = 2 * MiB + 512 * 1024;
constexpr size_t WS_WR2 = WS_WR1 + 256 * 1024;
constexpr size_t WS_WIN = 3 * MiB;
constexpr size_t WS_WOUT = 28 * MiB;
constexpr size_t WS_W13 = 36 * MiB;
constexpr size_t WS_W2 = 296 * MiB;
constexpr size_t WS_HA = 426 * MiB;
constexpr size_t WS_Z = 491 * MiB;
constexpr size_t WS_CAT = 695 * MiB;
constexpr size_t WS_UIN = 759 * MiB;
constexpr size_t WS_KF = 823 * MiB;
constexpr size_t WS_KB = 887 * MiB;
constexpr size_t WS_CL = 426 * MiB;
constexpr size_t WS_CI = 951 * MiB;
constexpr size_t WS_Q = 983 * MiB;
constexpr size_t WS_K = 999 * MiB;
constexpr size_t WS_RTOK = 1015 * MiB;
constexpr size_t WS_RW = WS_RTOK + 2 * MAXROWS * 4;
constexpr size_t WS_AEXP = 1017 * MiB;
constexpr size_t WS_ARANK = WS_AEXP + 512 * 1024;
constexpr size_t WS_AW = WS_ARANK + 512 * 1024;
constexpr size_t WS_HDN = 1019 * MiB;
constexpr size_t WS_SC = 1021 * MiB;
constexpr size_t WS_NL = WS_SC + 32 * 1024;
constexpr size_t WS_NI = WS_NL + 640 * 1024;
constexpr size_t WS_MI = WS_NI + 640 * 1024;
constexpr size_t WS_END = 1023 * MiB;
constexpr size_t WS_HR = 491 * MiB;
constexpr size_t WS_Y2 = 579 * MiB;
static_assert(WS_Y2 + (size_t)MAXROWS * 2048 * 2 <= WS_CI, "overlay");
constexpr int CW_BAR = 4096;
constexpr int CW_CNT = 16384;

constexpr int RING_BYTES = 131072;
constexpr int LDSCTL_OFF = 147456;
constexpr int FFTSCR_OFF = LDSCTL_OFF + 1024;
constexpr int LDS_BYTES = 151552;

__device__ __forceinline__ unsigned cvt_pk_bf16(float lo, float hi) { unsigned r; asm volatile("v_cvt_pk_bf16_f32 %0, %1, %2" : "=v"(r) : "v"(lo), "v"(hi)); return r; }
__device__ __forceinline__ float bf2f(unsigned short b) { return __builtin_bit_cast(float, ((unsigned)b) << 16); }
__device__ __forceinline__ float bflo(unsigned u) { return __builtin_bit_cast(float, u << 16); }
__device__ __forceinline__ float bfhi(unsigned u) { return __builtin_bit_cast(float, u & 0xffff0000u); }
__device__ __forceinline__ float wave_sum(float v) {
#pragma unroll
    for (int o = 1; o < 64; o <<= 1) v += __shfl_xor(v, o);
    return v;
}
__device__ __forceinline__ float silu_f(float a) { return a / (1.f + __expf(-a)); }
__device__ __forceinline__ float sigmoid_f(float a) { return 1.f / (1.f + __expf(-a)); }

#define XB_TMO      128
#define XB_XCNT(j)  (256  + 64 * (j))
#define XB_XSUB(j)  (1280 + 64 * (j))
#define XB_XGEN(j)  (2304 + 64 * (j))
#define XB_TOP      3328
#define XB_TOPGEN   3392
#define XCD_BAR_WORDS 3456
#define XB_SPIN_CAP (1u << 18)

__device__ __forceinline__ unsigned xb_ld(unsigned* p)              { return __hip_atomic_load(p, __ATOMIC_RELAXED, __HIP_MEMORY_SCOPE_AGENT); }
__device__ __forceinline__ unsigned xb_add(unsigned* p, unsigned v) { return __hip_atomic_fetch_add(p, v, __ATOMIC_RELAXED, __HIP_MEMORY_SCOPE_AGENT); }
__device__ __forceinline__ unsigned xb_xcc_id() { return (unsigned)__builtin_amdgcn_s_getreg((3 << 11) | 20) & 0xFu; }
#define XB_SPIN(cond, bar) do { unsigned _sp = 0; while (cond) { __builtin_amdgcn_s_sleep(1); \
    if ((++_sp & 255u) == 0u) { if (xb_ld(&(bar)[XB_TMO])) break; if (_sp > XB_SPIN_CAP) { atomicAdd(&(bar)[XB_TMO], 1u); break; } } } } while (0)

struct XcdBarrier {
    unsigned* bar; unsigned x;
    volatile LAS unsigned* st;
};

__device__ __forceinline__ XcdBarrier xcd_barrier_post(unsigned* bar, volatile LAS unsigned* st) {
    XcdBarrier b; b.bar = bar; b.x = xb_xcc_id(); b.st = st;
    if (threadIdx.x == 0) (void)xb_add(&bar[XB_XCNT(b.x)], 1u);
    return b;
}
__device__ __forceinline__ void xcd_barrier_complete(unsigned* bar, unsigned x, unsigned& nloc, unsigned& nx) {
    const unsigned G = gridDim.x * gridDim.y * gridDim.z;
    unsigned sum, cnt, mine, sp = 0u;
    for (;;) {
        sum = 0u; cnt = 0u; mine = 0u;
#pragma unroll
        for (unsigned j = 0; j < 16; ++j) { const unsigned c = xb_ld(&bar[XB_XCNT(j)]); sum += c; cnt += (c > 0u) ? 1u : 0u; mine = (j == x) ? c : mine; }
        if (sum == G) break;
        __builtin_amdgcn_s_sleep(1);
        if ((++sp & 255u) == 0u) { if (xb_ld(&bar[XB_TMO])) break; if (sp > XB_SPIN_CAP) { atomicAdd(&bar[XB_TMO], 1u); break; } }
    }
    nloc = mine > 0u ? mine : 1u; nx = cnt > 0u ? cnt : 1u;
}

__device__ __forceinline__ void xcd_barrier(const XcdBarrier& b) {
    asm volatile("s_waitcnt vmcnt(0)" ::: "memory");
    __syncthreads();
    if (threadIdx.x == 0) {
        unsigned* bar = b.bar;
        __builtin_amdgcn_s_waitcnt(0);
        unsigned nloc = b.st[0], nx = b.st[1];
        if (nloc == 0u) { xcd_barrier_complete(bar, b.x, nloc, nx); b.st[0] = nloc; b.st[1] = nx; }
        const unsigned old = xb_add(&bar[XB_XSUB(b.x)], 1u);
        const unsigned gen = old / nloc;
        if (old + 1u == (gen + 1u) * nloc) {
            __builtin_amdgcn_fence(__ATOMIC_RELEASE, "agent");
            asm volatile("s_waitcnt vmcnt(0)" ::: "memory");
            const unsigned og = xb_add(&bar[XB_TOP], 1u);
            const unsigned tg = og / nx;
            if (og + 1u == (tg + 1u) * nx) xb_add(&bar[XB_TOPGEN], 1u);
            else XB_SPIN(xb_ld(&bar[XB_TOPGEN]) == tg, bar);
            __builtin_amdgcn_fence(__ATOMIC_ACQUIRE, "agent");
            xb_add(&bar[XB_XGEN(b.x)], 1u);
            asm volatile("s_waitcnt vmcnt(0)" ::: "memory");
        } else {
            XB_SPIN(xb_ld(&bar[XB_XGEN(b.x)]) == gen, bar);
            __builtin_amdgcn_fence(__ATOMIC_ACQUIRE, "agent");
            asm volatile("s_waitcnt vmcnt(0)" ::: "memory");
        }
    }
    __syncthreads();
}

namespace gk {
constexpr int BM = 256, BK = 64, HALF = 128, HTB = HALF * BK * 2, STAGE_BYTES = 8 * HTB, NXCD = 8, WGM = 8;
__host__ __device__ __forceinline__ int lds_byte(int r, int c) { const int st = (r >> 4) * 2 + (c >> 5), rr = r & 15, cc = c & 31, ob = rr * 64 + cc * 2; return st * 1024 + (ob ^ (((ob >> 9) & 1) << 5)); }
__host__ __device__ __forceinline__ void stage_rc(int b, int& R, int& C) { const int st = b / 1024, sb = b % 1024, swz = sb ^ (((sb >> 9) & 1) << 5); R = (st >> 1) * 16 + swz / 64; C = (st & 1) * 32 + (swz % 64) / 2; }
__host__ __device__ __forceinline__ int perm32(int rho) { const int n = rho >> 4, i = rho & 15; return 8 * (i >> 2) + 4 * n + (i & 3); }

struct Unit { int pm, pn, ex; };

template <class Epi, class Sched>
__device__ __forceinline__ void gemm_core(LAS unsigned char* lds, const char* Abase, const int K, const Sched& S, const Epi& E) {
    const int tid = threadIdx.x, wid = __builtin_amdgcn_readfirstlane(tid >> 6), lane = tid & 63, wr = wid >> 2, wc = wid & 3, fr = lane & 15, fq = lane >> 4;
    const int nt = K / BK;
    int RA[2], CA[2]; unsigned voffB[2];
#pragma unroll
    for (int i = 0; i < 2; ++i) { int R, C; stage_rc(tid * 16 + i * 8192, R, C); const int Rb = Epi::PERM ? ((R & ~31) + perm32(R & 31)) : R;
        RA[i] = R; CA[i] = C; voffB[i] = (unsigned)(Rb * K + C) * 2u; }
    const size_t kstep = (size_t)(BK * 2);
    const size_t hstepB = (size_t)HALF * K * 2;
    const unsigned ldsw = (unsigned)wid * 1024u;
    const int aoff = lds_byte(wr * 64 + fr, fq * 8), boff = lds_byte(wc * 32 + fr, fq * 8);
#define GK_SA(b, h) (((b) * 2 + (h)) * HTB)
#define GK_SB(b, h) ((4 + (b) * 2 + (h)) * HTB)
#define GK_STAGE(bufoff, gbase, v0, v1) do { \
        __builtin_amdgcn_global_load_lds((const unsigned*)((const char*)(gbase) + (v0)), (LAS unsigned*)(lds + (bufoff) + ldsw), 16, 0, 0); \
        __builtin_amdgcn_global_load_lds((const unsigned*)((const char*)(gbase) + (v1)), (LAS unsigned*)(lds + (bufoff) + ldsw + 8192), 16, 0, 0); } while (0)
#define GK_LDA(dst, b, h) do { _Pragma("unroll") for (int m = 0; m < 4; ++m) _Pragma("unroll") for (int k = 0; k < 2; ++k) dst[m][k] = *(const LAS bf16x8*)(lds + GK_SA(b, h) + aoff + m * 2048 + k * 1024); } while (0)
#define GK_LDB(dst, b, h) do { _Pragma("unroll") for (int n = 0; n < 2; ++n) _Pragma("unroll") for (int k = 0; k < 2; ++k) dst[n][k] = *(const LAS bf16x8*)(lds + GK_SB(b, h) + boff + n * 2048 + k * 1024); } while (0)
#define GK_MMA(ai, bj, At, Bt) do { __builtin_amdgcn_s_setprio(1); _Pragma("unroll") for (int m = 0; m < 4; ++m) _Pragma("unroll") for (int n = 0; n < 2; ++n) _Pragma("unroll") for (int k = 0; k < 2; ++k) \
        acc[ai][bj][m][n] = __builtin_amdgcn_mfma_f32_16x16x32_bf16(Bt[n][k], At[m][k], acc[ai][bj][m][n], 0, 0, 0); __builtin_amdgcn_s_setprio(0); } while (0)
#define GK_WAIT_V(n) asm volatile("s_waitcnt vmcnt(" #n ")" ::: "memory")
#define GK_WAIT_L(n) asm volatile("s_waitcnt lgkmcnt(" #n ")" ::: "memory")
#define GK_BAR __builtin_amdgcn_s_barrier()
#define GK_SCHED __builtin_amdgcn_sched_barrier(0)
    Unit cur, nxt; int ui = 0;
    if (!S.next(0, cur)) return;
    f32x4 acc[2][2][4][2];
#pragma unroll
    for (int a = 0; a < 2; ++a)
#pragma unroll
        for (int b = 0; b < 2; ++b)
#pragma unroll
            for (int m = 0; m < 4; ++m)
#pragma unroll
                for (int n = 0; n < 2; ++n) acc[a][b][m][n] = (f32x4){0.f, 0.f, 0.f, 0.f};
    bf16x8 At[4][2], B0[2][2], B1[2][2];
    unsigned c00, c01, c10, c11, n00, n01, n10, n11;
    S.a_offs(cur, RA, CA, c00, c01, c10, c11);
    asm volatile("" : "+v"(c00), "+v"(c01), "+v"(c10), "+v"(c11));
    const char* cB = S.b_base(cur);
    GK_STAGE(GK_SB(0, 0), cB, voffB[0], voffB[1]); GK_STAGE(GK_SB(0, 1), cB + hstepB, voffB[0], voffB[1]); GK_STAGE(GK_SA(0, 0), Abase, c00, c01); GK_STAGE(GK_SA(0, 1), Abase, c10, c11);
    if (wr == 1) GK_BAR;
    GK_WAIT_V(2); GK_BAR;
    GK_STAGE(GK_SB(1, 0), cB + kstep, voffB[0], voffB[1]); GK_STAGE(GK_SA(1, 0), Abase + kstep, c00, c01); GK_STAGE(GK_SB(1, 1), cB + hstepB + kstep, voffB[0], voffB[1]);
    GK_WAIT_V(6); GK_BAR;
    for (;;) {
        const bool has_next = S.next(ui + 1, nxt);
        const char* nB = cB;
        n00 = c00; n01 = c01; n10 = c10; n11 = c11;
        if (has_next) { S.a_offs(nxt, RA, CA, n00, n01, n10, n11); nB = S.b_base(nxt); }
        asm volatile("" : "+v"(n00), "+v"(n01), "+v"(n10), "+v"(n11));
        for (int t = 0; t < nt; t += 2) {
            const bool last = (t == nt - 2);
            const char* a1 = Abase + (size_t)(t + 1) * kstep;
            const char* a2 = last ? Abase : Abase + (size_t)(t + 2) * kstep; const char* b2 = last ? nB : cB + (size_t)(t + 2) * kstep;
            const char* a3 = a2 + kstep; const char* b3 = b2 + kstep;
            const unsigned x00 = last ? n00 : c00, x01 = last ? n01 : c01, x10 = last ? n10 : c10, x11 = last ? n11 : c11;
            GK_LDB(B0, 0, 0); GK_LDB(B1, 0, 1); GK_SCHED; GK_LDA(At, 0, 0); GK_STAGE(GK_SA(1, 1), a1, c10, c11);
            GK_WAIT_V(8); GK_WAIT_L(0); GK_BAR; GK_MMA(0, 0, At, B0); GK_MMA(0, 1, At, B1); GK_BAR; GK_SCHED;
            GK_LDA(At, 0, 1); GK_STAGE(GK_SB(0, 0), b2, voffB[0], voffB[1]); GK_STAGE(GK_SB(0, 1), b2 + hstepB, voffB[0], voffB[1]); GK_STAGE(GK_SA(0, 0), a2, x00, x01);
            GK_WAIT_V(8); GK_WAIT_L(0); GK_BAR; GK_MMA(1, 0, At, B0); GK_MMA(1, 1, At, B1); GK_BAR; GK_SCHED;
            GK_LDB(B0, 1, 0); GK_LDB(B1, 1, 1); GK_SCHED; GK_LDA(At, 1, 0); GK_STAGE(GK_SA(0, 1), a2, x10, x11);
            GK_WAIT_V(8); GK_WAIT_L(0); GK_BAR; GK_MMA(0, 0, At, B0); GK_MMA(0, 1, At, B1); GK_BAR; GK_SCHED;
            GK_LDA(At, 1, 1); GK_STAGE(GK_SB(1, 0), b3, voffB[0], voffB[1]); GK_STAGE(GK_SB(1, 1), b3 + hstepB, voffB[0], voffB[1]); GK_STAGE(GK_SA(1, 0), a3, x00, x01);
            GK_WAIT_V(8); GK_WAIT_L(0); GK_BAR; GK_MMA(1, 0, At, B0); GK_MMA(1, 1, At, B1); GK_BAR; GK_SCHED;
        }
        if (wr == 0) GK_BAR;
        E(acc, cur, wr, wc, fr, fq);
        if (!has_next) break;
#pragma unroll
        for (int a = 0; a < 2; ++a)
#pragma unroll
            for (int b = 0; b < 2; ++b)
#pragma unroll
                for (int m = 0; m < 4; ++m)
#pragma unroll
                    for (int n = 0; n < 2; ++n) acc[a][b][m][n] = (f32x4){0.f, 0.f, 0.f, 0.f};
        cur = nxt; cB = nB; c00 = n00; c01 = n01; c10 = n10; c11 = n11; ++ui;
        if (wr == 1) GK_BAR;
    }
    GK_WAIT_V(0);
    GK_BAR;
#undef GK_SA
#undef GK_SB
#undef GK_STAGE
#undef GK_LDA
#undef GK_LDB
#undef GK_MMA
#undef GK_WAIT_V
#undef GK_WAIT_L
#undef GK_BAR
#undef GK_SCHED
}

struct DenseOrder {
    int nM, nN, nwg, G, c, K;
    __device__ void init(int M, int N, int K_, int G_, int c_) { nM = M / BM; nN = N / BM; nwg = nM * nN; G = G_; c = c_; K = K_; }
    __device__ __forceinline__ bool next(int i, Unit& u) const {
        const long Lx = (long)i * G + c; if (Lx >= nwg) return false;
        int wgid = (int)Lx; { const int q = nwg / NXCD, r = nwg % NXCD, xcd = wgid % NXCD, off = wgid / NXCD; wgid = (xcd < r ? xcd * (q + 1) : r * (q + 1) + (xcd - r) * q) + off; }
        const int nig = WGM * nN, gid = wgid / nig, fm = gid * WGM, gsz = (nM - fm) < WGM ? (nM - fm) : WGM;
        u.pm = fm + ((wgid % nig) % gsz); u.pn = (wgid % nig) / gsz; u.ex = 0; return true;
    }
    const char* Bt;
    __device__ __forceinline__ void a_offs(const Unit& u, const int (&RA)[2], const int (&CA)[2], unsigned& o00, unsigned& o01, unsigned& o10, unsigned& o11) const {
        const unsigned r0 = (unsigned)(u.pm * BM);
        o00 = ((r0 + RA[0]) * (unsigned)K + CA[0]) * 2u; o01 = ((r0 + RA[1]) * (unsigned)K + CA[1]) * 2u;
        o10 = ((r0 + HALF + RA[0]) * (unsigned)K + CA[0]) * 2u; o11 = ((r0 + HALF + RA[1]) * (unsigned)K + CA[1]) * 2u;
    }
    __device__ __forceinline__ const char* b_base(const Unit& u) const { return Bt + (size_t)u.pn * BM * K * 2; }
};
template <int NPN, bool GATHER>
struct GroupOrder {
    int ntile, G, c, K;
    const LAS int* pstart;
    const int* rtok;
    const char* Bt; size_t bstride;
    __device__ __forceinline__ bool next(int i, Unit& u) const {
        const int x = c & 7, j = c >> 3, nj = G >> 3, T8 = (ntile + 7) >> 3, tlo = x * T8, thi = (tlo + T8) < ntile ? (tlo + T8) : ntile;
        const int Lx = i * nj + j, tl = Lx / NPN; if (tlo + tl >= thi) return false;
        u.pm = tlo + tl; u.pn = Lx % NPN;
        const int row = u.pm * BM; int lo = 0, hi = NE1;
        while (hi - lo > 1) { const int mid = (lo + hi) >> 1; if (pstart[mid] <= row) lo = mid; else hi = mid; }
        u.ex = lo; return true;
    }
    __device__ __forceinline__ void a_offs(const Unit& u, const int (&RA)[2], const int (&CA)[2], unsigned& o00, unsigned& o01, unsigned& o10, unsigned& o11) const {
        const int r0 = u.pm * BM;
        if (GATHER) {
            const int t00 = rtok[r0 + RA[0]], t01 = rtok[r0 + RA[1]], t10 = rtok[r0 + HALF + RA[0]], t11 = rtok[r0 + HALF + RA[1]];
            o00 = ((unsigned)t00 * (unsigned)K + CA[0]) * 2u; o01 = ((unsigned)t01 * (unsigned)K + CA[1]) * 2u;
            o10 = ((unsigned)t10 * (unsigned)K + CA[0]) * 2u; o11 = ((unsigned)t11 * (unsigned)K + CA[1]) * 2u;
        } else {
            o00 = ((unsigned)(r0 + RA[0]) * (unsigned)K + CA[0]) * 2u; o01 = ((unsigned)(r0 + RA[1]) * (unsigned)K + CA[1]) * 2u;
            o10 = ((unsigned)(r0 + HALF + RA[0]) * (unsigned)K + CA[0]) * 2u; o11 = ((unsigned)(r0 + HALF + RA[1]) * (unsigned)K + CA[1]) * 2u;
        }
    }
    __device__ __forceinline__ const char* b_base(const Unit& u) const { return Bt + (size_t)u.ex * bstride + (size_t)u.pn * BM * K * 2; }
};

struct EpiBf16Store {
    static constexpr bool PERM = true;
    bf16* O; int ldc;
    __device__ __forceinline__ void operator()(const f32x4 (&acc)[2][2][4][2], const Unit& u, int wr, int wc, int fr, int fq) const {
        const int row0 = u.pm * BM + wr * 64 + fr, col0 = u.pn * BM + wc * 32 + 8 * fq;
#pragma unroll
        for (int ai = 0; ai < 2; ++ai)
#pragma unroll
            for (int m = 0; m < 4; ++m) { bf16* rowp = O + (size_t)(row0 + ai * HALF + m * 16) * ldc + col0;
#pragma unroll
                for (int bj = 0; bj < 2; ++bj) { const f32x4 v0 = acc[ai][bj][m][0], v1 = acc[ai][bj][m][1];
                    v4u w; w.x = cvt_pk_bf16(v0[0], v0[1]); w.y = cvt_pk_bf16(v0[2], v0[3]); w.z = cvt_pk_bf16(v1[0], v1[1]); w.w = cvt_pk_bf16(v1[2], v1[3]);
                    *(v4u*)(rowp + bj * HALF) = w; } }
    }
};
struct EpiResidual {
    static constexpr bool PERM = false;
    float* X; int ldc; const float* gate;
    __device__ __forceinline__ void operator()(const f32x4 (&acc)[2][2][4][2], const Unit& u, int wr, int wc, int fr, int fq) const {
        const int row0 = u.pm * BM + wr * 64 + fr, col0 = u.pn * BM + wc * 32 + 4 * fq;
        f32x4 gv[2][2];
#pragma unroll
        for (int bj = 0; bj < 2; ++bj)
#pragma unroll
            for (int n = 0; n < 2; ++n) gv[bj][n] = *(const f32x4*)(gate + col0 + bj * HALF + n * 16);
#pragma unroll
        for (int ai = 0; ai < 2; ++ai)
#pragma unroll
            for (int m = 0; m < 4; ++m) { float* rowp = X + (size_t)(row0 + ai * HALF + m * 16) * ldc + col0;
#pragma unroll
                for (int bj = 0; bj < 2; ++bj)
#pragma unroll
                    for (int n = 0; n < 2; ++n) { f32x4* p = (f32x4*)(rowp + bj * HALF + n * 16); *p = *p + gv[bj][n] * acc[ai][bj][m][n]; } }
    }
};
struct EpiGateUp {
    static constexpr bool PERM = true;
    bf16* O;
    __device__ __forceinline__ void operator()(const f32x4 (&acc)[2][2][4][2], const Unit& u, int wr, int wc, int fr, int fq) const {
        const int row0 = u.pm * BM + wr * 64 + fr, col0 = u.pn * HALF + wc * 32 + 8 * fq;
#pragma unroll
        for (int ai = 0; ai < 2; ++ai)
#pragma unroll
            for (int m = 0; m < 4; ++m) { bf16* rowp = O + (size_t)(row0 + ai * HALF + m * 16) * DE + col0;
                float h[8];
#pragma unroll
                for (int n = 0; n < 2; ++n)
#pragma unroll
                    for (int j = 0; j < 4; ++j) { const float g = acc[ai][0][m][n][j], up = acc[ai][1][m][n][j]; h[n * 4 + j] = silu_f(g) * up; }
                v4u w; w.x = cvt_pk_bf16(h[0], h[1]); w.y = cvt_pk_bf16(h[2], h[3]); w.z = cvt_pk_bf16(h[4], h[5]); w.w = cvt_pk_bf16(h[6], h[7]);
                *(v4u*)rowp = w; }
    }
};
struct EpiDown {
    static constexpr bool PERM = true;
    bf16* O; const float* rw;
    __device__ __forceinline__ void operator()(const f32x4 (&acc)[2][2][4][2], const Unit& u, int wr, int wc, int fr, int fq) const {
        const int row0 = u.pm * BM + wr * 64 + fr, col0 = u.pn * BM + wc * 32 + 8 * fq;
#pragma unroll
        for (int ai = 0; ai < 2; ++ai)
#pragma unroll
            for (int m = 0; m < 4; ++m) { const int row = row0 + ai * HALF + m * 16; const float s = rw[row]; bf16* rowp = O + (size_t)row * D + col0;
#pragma unroll
                for (int bj = 0; bj < 2; ++bj) { const f32x4 v0 = acc[ai][bj][m][0] * s, v1 = acc[ai][bj][m][1] * s;
                    v4u w; w.x = cvt_pk_bf16(v0[0], v0[1]); w.y = cvt_pk_bf16(v0[2], v0[3]); w.z = cvt_pk_bf16(v1[0], v1[1]); w.w = cvt_pk_bf16(v1[2], v1[3]);
                    *(v4u*)(rowp + bj * HALF) = w; } }
    }
};
}

struct Args { const float* in[36]; float* out; unsigned char* ws; int ph_lo, ph_hi; };
struct Frame {
    LAS unsigned char* lds;
    int tid, lane, wave, bid, G;
    const float* const* in; float* out; unsigned char* ws;
};
#define IN_X 0
#define IN_C 1
#define IN_CTX 2
#define IN_CCTX 3
#define IN_WADA 4
#define IN_BADA 5
#define IN_GMIX 6
#define IN_GFFN 7
#define IN_WIN 8
#define IN_BGATES 9
#define IN_CKW 10
#define IN_CKB 11
#define IN_CQW 12
#define IN_CQB 13
#define IN_GHEAD 14
#define IN_CHW 15
#define IN_CHB 16
#define IN_FW1 17
#define IN_FB1 18
#define IN_FF1 19
#define IN_FW2 20
#define IN_FB2 21
#define IN_FF2 22
#define IN_FW3 23
#define IN_FB3 24
#define IN_DSKIP 25
#define IN_WOUT 26
#define IN_WR 27
#define IN_BR 28
#define IN_W1E 29
#define IN_W3E 30
#define IN_W2E 31
#define IN_W1S 32
#define IN_W3S 33
#define IN_W2S 34
#define IN_GFIN 35

__device__ __forceinline__ void transpose_item(const float* W, int N, int k0, int n0, bf16* WT, int dstK, int dst_row0, LAS float* scr, int lane) {
#pragma unroll 8
    for (int i = 0; i < 32; ++i) { const int kk = 2 * i + (lane >> 5); scr[kk * 33 + (lane & 31)] = W[(size_t)(k0 + kk) * N + n0 + (lane & 31)]; }
    LDS_WAIT(); asm volatile("" ::: "memory");
    const int c = lane & 7;
#pragma unroll
    for (int j = 0; j < 4; ++j) { const int n = (lane >> 3) + 8 * j; const LAS float* s = scr + (8 * c) * 33 + n;
        v4u o; o.x = cvt_pk_bf16(s[0 * 33], s[1 * 33]); o.y = cvt_pk_bf16(s[2 * 33], s[3 * 33]); o.z = cvt_pk_bf16(s[4 * 33], s[5 * 33]); o.w = cvt_pk_bf16(s[6 * 33], s[7 * 33]);
        *(v4u*)(WT + (size_t)(dst_row0 + n) * dstK + k0 + 8 * c) = o; }
    LDS_WAIT(); asm volatile("" ::: "memory");
}
__device__ __forceinline__ void p0_prologue(Frame& F) {
    const float* const* in = F.in;
    {
        LAS float* sv = (LAS float*)F.lds;
        LAS float* red = sv + 4096;
        float* mod = (float*)(F.ws + WS_MOD);
        for (int job = F.bid; job < 192; job += F.G) {
            for (int i = F.tid; i < 2048; i += NT) { sv[i] = silu_f(in[IN_C][i]); sv[2048 + i] = silu_f(in[IN_CCTX][i]); }
            __syncthreads();
            const int col = job * 64 + F.lane, r0 = F.wave * 256;
            const float* W = in[IN_WADA] + col;
            float a0 = 0.f, a1 = 0.f;
            for (int i = r0; i < r0 + 256; i += 8) {
                float w[8];
#pragma unroll
                for (int j = 0; j < 8; ++j) w[j] = W[(size_t)(i + j) * 12288];
#pragma unroll
                for (int j = 0; j < 8; ++j) { a0 += sv[i + j] * w[j]; a1 += sv[2048 + i + j] * w[j]; }
            }
            red[(F.wave * 64 + F.lane) * 2 + 0] = a0; red[(F.wave * 64 + F.lane) * 2 + 1] = a1;
            __syncthreads();
            if (F.wave == 0) { float s0 = 0.f, s1 = 0.f;
#pragma unroll
                for (int w = 0; w < 8; ++w) { s0 += red[(w * 64 + F.lane) * 2 + 0]; s1 += red[(w * 64 + F.lane) * 2 + 1]; }
                const float b = in[IN_BADA][col]; mod[col] = s0 + b; mod[12288 + col] = s1 + b; }
            __syncthreads();
        }
    }
    const int gt = F.bid * NT + F.tid, NGT = F.G * NT;
    {
        float* pos = (float*)(F.ws + WS_POS);
        for (int i = gt; i < 320 * 1024; i += NGT) { const int p = i >> 10, j = i & 1023, jj = j & 511;
            const float pp = (float)(p < 256 ? p : p - 256);
            const float omega = 1.0f / powf(10000.0f, (float)jj * (1.0f / 512.0f)); const float ang = pp * omega;
            pos[i] = j < 512 ? sinf(ang) : cosf(ang); }
    }
    {
        v4u* z = (v4u*)(F.ws + WS_WIN + (size_t)NIN * D * 2); const int nz = (NINP - NIN) * D * 2 / 16;
        for (int i = gt; i < nz; i += NGT) z[i] = (v4u){0u, 0u, 0u, 0u};
        int* rt = (int*)(F.ws + WS_RTOK); float* rw = (float*)(F.ws + WS_RW);
        for (int i = gt; i < 2 * MAXROWS; i += NGT) { rt[i] = 0; rw[i] = 0.f; }
    }
    {
        bf16* w1 = (bf16*)(F.ws + WS_WR1); bf16* w2 = (bf16*)(F.ws + WS_WR2);
        for (int i = gt; i < 64 * 2048; i += NGT) { const int e = i >> 11, k = i & 2047; const float w = in[IN_WR][k * 64 + e];
            const unsigned hi = cvt_pk_bf16(w, 0.f) & 0xffffu; const float r = w - bf2f((bf16)hi);
            w1[i] = (bf16)hi; w2[i] = (bf16)(cvt_pk_bf16(r, 0.f) & 0xffffu); }
    }
    {
        LAS float* scr = (LAS float*)(F.lds + F.wave * 16384);
        const int gw = F.bid * NWAVES + F.wave, NGW = F.G * NWAVES;
        constexpr int I_IN = 32 * 193, I_OUT = 32 * 64, I_E = 512 * NE1;
        constexpr int NITEMS = I_IN + I_OUT + 3 * I_E;
        for (int it = gw; it < NITEMS; it += NGW) {
            int r = it;
            if (r < I_IN) { const int kb = r / 193, nb = r % 193; transpose_item(in[IN_WIN], NIN, 64 * kb, 32 * nb, (bf16*)(F.ws + WS_WIN), D, 32 * nb, scr, F.lane); continue; } r -= I_IN;
            if (r < I_OUT) { const int kb = r / 64, nb = r % 64; transpose_item(in[IN_WOUT], D, 64 * kb, 32 * nb, (bf16*)(F.ws + WS_WOUT), D, 32 * nb, scr, F.lane); continue; } r -= I_OUT;
            if (r < 2 * I_E) { const int which = r >= I_E; if (which) r -= I_E;
                const int e = r / 512, rr = r % 512, kb = rr / 16, nb = rr % 16, n0 = 32 * nb;
                const float* src = e < NE ? in[which ? IN_W3E : IN_W1E] + (size_t)e * D * DE : in[which ? IN_W3S : IN_W1S];
                transpose_item(src, DE, 64 * kb, n0, (bf16*)(F.ws + WS_W13) + (size_t)e * 1024 * D, D, (n0 >> 7) * 256 + which * 128 + (n0 & 127), scr, F.lane); continue; }
            r -= 2 * I_E;
            { const int e = r / 512, rr = r % 512, kb = rr / 64, nb = rr % 64;
                const float* src = e < NE ? in[IN_W2E] + (size_t)e * DE * D : in[IN_W2S];
                transpose_item(src, D, 64 * kb, 32 * nb, (bf16*)(F.ws + WS_W2) + (size_t)e * D * DE, DE, 32 * nb, scr, F.lane); }
        }
    }
}

__device__ __forceinline__ void p1_norm1(Frame& F) {
    const float* const* in = F.in;
    const int gw = F.bid * NWAVES + F.wave, NGW = F.G * NWAVES;
    const float* mod = (const float*)(F.ws + WS_MOD); const float* pos = (const float*)(F.ws + WS_POS);
    bf16* hA = (bf16*)(F.ws + WS_HA);
    for (int row = gw; row < MROWS; row += NGW) {
        f32x4 v[8]; float ss = 0.f;
        const bool mainrow = row < L;
        const float* src = mainrow ? in[IN_X] + (size_t)row * D : in[IN_CTX] + (size_t)(row - L) * D;
        const float* md = mainrow ? mod : mod + 12288;
#pragma unroll
        for (int j = 0; j < 8; ++j) { const int col = 4 * F.lane + 256 * j; v[j] = *(const f32x4*)(src + col);
            if (mainrow) { const float* pp = col < 1024 ? pos + (size_t)(row >> 6) * 1024 + col : pos + (size_t)(256 + (row & 63)) * 1024 + (col - 1024);
                v[j] = v[j] + *(const f32x4*)pp; *(f32x4*)(F.out + (size_t)row * D + col) = v[j]; }
            ss += (v[j].x * v[j].x + v[j].y * v[j].y) + (v[j].z * v[j].z + v[j].w * v[j].w); }
        const float rstd = rsqrtf(wave_sum(ss) * (1.0f / D) + EPS);
#pragma unroll
        for (int j = 0; j < 8; ++j) { const int col = 4 * F.lane + 256 * j;
            const f32x4 g = *(const f32x4*)(in[IN_GMIX] + col), sh = *(const f32x4*)(md + col), sc = *(const f32x4*)(md + 2048 + col);
            const f32x4 h = (v[j] * rstd * g) * (sc + 1.0f) + sh;
            v2u o; o.x = cvt_pk_bf16(h.x, h.y); o.y = cvt_pk_bf16(h.z, h.w);
            *(v2u*)(hA + (size_t)row * D + col) = o; }
    }
}

constexpr int VT_PITCH = 136;
__device__ __forceinline__ float wave_incl_add(float x, int lane) {
#pragma unroll
    for (int o = 1; o < 64; o <<= 1) { const float y = __shfl_up(x, o); if (lane >= o) x += y; }
    return x;
}
__device__ __forceinline__ float wave_incl_max(float x, int lane) {
#pragma unroll
    for (int o = 1; o < 64; o <<= 1) { const float y = __shfl_up(x, o); if (lane >= o) x = fmaxf(x, y); }
    return x;
}
__device__ __forceinline__ void ml_gates(Frame& F, int dir, int h, int rowbase, LAS float* bb, LAS float* al, LAS float* mx, float& g, float& mtot) {
    const bf16* z = (const bf16*)(F.ws + WS_Z);
    const int lane = F.lane, pi0 = 2 * lane, p0 = dir ? 127 - pi0 : pi0, p1 = dir ? p0 - 1 : p0 + 1;
    const float bgi = F.in[IN_BGATES][dir * 16 + h], bgf = F.in[IN_BGATES][dir * 16 + 8 + h];
    const bf16* z0 = z + (size_t)(rowbase + p0) * NINP + OFF_G + dir * 16 + h; const bf16* z1 = z + (size_t)(rowbase + p1) * NINP + OFF_G + dir * 16 + h;
    const float i0 = bf2f(z0[0]) + bgi, f0 = bf2f(z0[8]) + bgf, i1 = bf2f(z1[0]) + bgi, f1 = bf2f(z1[8]) + bgf;
    const float l0 = fminf(f0, 0.f) - log1pf(__expf(-fabsf(f0))), l1 = fminf(f1, 0.f) - log1pf(__expf(-fabsf(f1)));
    const float incl = wave_incl_add(l0 + l1, lane);
    const float b1 = incl, b0 = incl - l1;
    const float a0 = i0 - b0, a1 = i1 - b1;
    const float mi = wave_incl_max(fmaxf(a0, a1), lane);
    float mprev = __shfl_up(mi, 1); if (lane == 0) mprev = -INFINITY;
    const float M0 = fmaxf(mprev, a0), M1 = mi;
    bb[p0] = b0; bb[p1] = b1; al[p0] = a0; al[p1] = a1; mx[p0] = M0; mx[p1] = M1;
    g = __shfl(incl, 63); mtot = __shfl(mi, 63);
}
__device__ __forceinline__ void ml_stage_vT(Frame& F, int h, int rowbase, LAS bf16* vT) {
    const bf16* z = (const bf16*)(F.ws + WS_Z);
    const int s = F.tid >> 2, eg = F.tid & 3;
#pragma unroll
    for (int i = 0; i < 4; ++i) { const int e0 = 32 * eg + 8 * i; const v4u v = *(const v4u*)(z + (size_t)(rowbase + s) * NINP + OFF_V + h * 128 + e0);
        const unsigned w[4] = {v.x, v.y, v.z, v.w};
#pragma unroll
        for (int q = 0; q < 4; ++q) { vT[(e0 + 2 * q) * VT_PITCH + s] = (bf16)(w[q] & 0xffffu); vT[(e0 + 2 * q + 1) * VT_PITCH + s] = (bf16)(w[q] >> 16); } }
}
__device__ __forceinline__ void ml_prep_item(Frame& F, int item) {
    const float* const* in = F.in;
    const int n = item >> 3, h = item & 7, tid = F.tid, lane = F.lane, wave = F.wave;
    const bool isctx = n >= 128;
    const int rowbase = isctx ? L + 128 * (n - 128) : 128 * n, seqlo = isctx ? L : 0, seqhi = isctx ? L + LC - 1 : L - 1;
    LAS bf16* vT = (LAS bf16*)F.lds;
    LAS bf16* kw0 = vT + 128 * VT_PITCH;
    LAS bf16* kw1 = kw0 + 64 * VT_PITCH;
    LAS float* fs = (LAS float*)(kw1 + 64 * VT_PITCH);
    const bf16* z = (const bf16*)(F.ws + WS_Z);
    if (wave < 2) { float g, mtot; LAS float* bbp = fs + 256 + wave * 384; ml_gates(F, wave, h, rowbase, bbp, bbp + 128, bbp + 256, g, mtot);
        LDS_WAIT();
        fs[wave * 128 + 2 * lane] = __expf(bbp[128 + 2 * lane] - mtot); fs[wave * 128 + 2 * lane + 1] = __expf(bbp[128 + 2 * lane + 1] - mtot);
        if (lane == 0) { float* sc = (float*)(F.ws + WS_SC) + ((size_t)(wave * 8 + h) * 130 + n) * 2; sc[0] = g; sc[1] = g + mtot; } }
    ml_stage_vT(F, h, rowbase, vT);
    __syncthreads();
    {
        const int s = tid >> 2, d0 = (tid & 3) * 16, R = rowbase + s; const bool hp = R > seqlo, hn = R < seqhi;
        float kv[16], qv[16];
#pragma unroll
        for (int part = 0; part < 2; ++part) {
            const int zc = (part ? OFF_Q : OFF_K) + h * 64 + d0; const float* cw = in[part ? IN_CQW : IN_CKW] + h * 64 + d0; const float* cb = in[part ? IN_CQB : IN_CKB] + h * 64 + d0;
#pragma unroll
            for (int hv = 0; hv < 2; ++hv) {
                const v4u c = *(const v4u*)(z + (size_t)R * NINP + zc + 8 * hv);
                const v4u p = hp ? *(const v4u*)(z + (size_t)(R - 1) * NINP + zc + 8 * hv) : (v4u){0u, 0u, 0u, 0u};
                const v4u nx = hn ? *(const v4u*)(z + (size_t)(R + 1) * NINP + zc + 8 * hv) : (v4u){0u, 0u, 0u, 0u};
                const unsigned cc[4] = {c.x, c.y, c.z, c.w}, pp[4] = {p.x, p.y, p.z, p.w}, nn[4] = {nx.x, nx.y, nx.z, nx.w};
#pragma unroll
                for (int q = 0; q < 4; ++q) { const int d = 8 * hv + 2 * q;
                    const float v0 = silu_f(bflo(pp[q]) * cw[d] + bflo(cc[q]) * cw[512 + d] + bflo(nn[q]) * cw[1024 + d] + cb[d]);
                    const float v1 = silu_f(bfhi(pp[q]) * cw[d + 1] + bfhi(cc[q]) * cw[512 + d + 1] + bfhi(nn[q]) * cw[1024 + d + 1] + cb[d + 1]);
                    if (part) { qv[d] = v0 * 0.125f; qv[d + 1] = v1 * 0.125f; } else { kv[d] = v0; kv[d + 1] = v1; } }
            }
        }
        if (!isctx) {
            bf16* Qg = (bf16*)(F.ws + WS_Q) + ((size_t)h * L + R) * 64 + d0; bf16* Kg = (bf16*)(F.ws + WS_K) + ((size_t)h * L + R) * 64 + d0;
#pragma unroll
            for (int hv = 0; hv < 2; ++hv) { v4u w;
                w.x = cvt_pk_bf16(qv[8 * hv], qv[8 * hv + 1]); w.y = cvt_pk_bf16(qv[8 * hv + 2], qv[8 * hv + 3]); w.z = cvt_pk_bf16(qv[8 * hv + 4], qv[8 * hv + 5]); w.w = cvt_pk_bf16(qv[8 * hv + 6], qv[8 * hv + 7]); *(v4u*)(Qg + 8 * hv) = w;
                w.x = cvt_pk_bf16(kv[8 * hv], kv[8 * hv + 1]); w.y = cvt_pk_bf16(kv[8 * hv + 2], kv[8 * hv + 3]); w.z = cvt_pk_bf16(kv[8 * hv + 4], kv[8 * hv + 5]); w.w = cvt_pk_bf16(kv[8 * hv + 6], kv[8 * hv + 7]); *(v4u*)(Kg + 8 * hv) = w; }
        }
        const float w0 = fs[s], w1 = fs[128 + s];
#pragma unroll
        for (int d = 0; d < 16; ++d) { const float kr = bf2f((bf16)(cvt_pk_bf16(kv[d], 0.f) & 0xffffu));
            kw0[(d0 + d) * VT_PITCH + s] = (bf16)(cvt_pk_bf16(kr * w0, 0.f) & 0xffffu); kw1[(d0 + d) * VT_PITCH + s] = (bf16)(cvt_pk_bf16(kr * w1, 0.f) & 0xffffu); }
    }
    __syncthreads();
    {
        const int fr = lane & 15, fq = lane >> 4;
        bf16x8 a[4];
#pragma unroll
        for (int kk = 0; kk < 4; ++kk) a[kk] = *(const LAS bf16x8*)(vT + (16 * wave + fr) * VT_PITCH + 32 * kk + 8 * fq);
#pragma unroll
        for (int dir = 0; dir < 2; ++dir) { const LAS bf16* kw = dir ? kw1 : kw0;
            float* cl = (float*)(F.ws + WS_CL) + ((size_t)((dir * 8 + h) * 130 + n)) * 8192;
#pragma unroll
            for (int dt = 0; dt < 4; ++dt) { f32x4 acc = (f32x4){0.f, 0.f, 0.f, 0.f};
#pragma unroll
                for (int kk = 0; kk < 4; ++kk) { const bf16x8 b = *(const LAS bf16x8*)(kw + (16 * dt + fr) * VT_PITCH + 32 * kk + 8 * fq); acc = __builtin_amdgcn_mfma_f32_16x16x32_bf16(a[kk], b, acc, 0, 0, 0); }
#pragma unroll
                for (int r = 0; r < 4; ++r) cl[(16 * wave + 4 * fq + r) * 64 + 16 * dt + fr] = acc[r]; } }
        if (tid < 128) { const int dir = tid >> 6, d = tid & 63; const LAS bf16* kw = (dir ? kw1 : kw0) + d * VT_PITCH; float s = 0.f;
            for (int i = 0; i < 128; ++i) s += bf2f(kw[i]);
            ((float*)(F.ws + WS_NL))[((size_t)((dir * 8 + h) * 130 + n)) * 64 + d] = s; }
    }
    __syncthreads();
}
__device__ __forceinline__ int ml_order(int dir, int step) { return step < 2 ? (dir ? 129 - step : 128 + step) : (dir ? 129 - step : step - 2); }
__device__ __forceinline__ void ml_scan(Frame& F) {
    const float* CL = (const float*)(F.ws + WS_CL); const float* SC = (const float*)(F.ws + WS_SC); const float* NLp = (const float*)(F.ws + WS_NL);
    bf16* CI = (bf16*)(F.ws + WS_CI); float* NI = (float*)(F.ws + WS_NI); float* MI = (float*)(F.ws + WS_MI);
    for (int idx = F.bid * NT + F.tid; idx < 16 * 8192; idx += F.G * NT) {
        const int dh = idx >> 13, rem = idx & 8191, dir = dh >> 3; const bool don = rem < 64;
        float c = 0.f, nn = 0.f, m = 0.f;
        for (int s0 = 0; s0 < 130; s0 += 10) {
            float cl[10], nl[10], gg[10], ml[10];
#pragma unroll
            for (int i = 0; i < 10; ++i) { const int ch = ml_order(dir, s0 + i); cl[i] = CL[((size_t)(dh * 130 + ch)) * 8192 + rem]; gg[i] = SC[(dh * 130 + ch) * 2]; ml[i] = SC[(dh * 130 + ch) * 2 + 1];
                nl[i] = don ? NLp[(size_t)(dh * 130 + ch) * 64 + rem] : 0.f; }
#pragma unroll
            for (int i = 0; i < 10; ++i) { const int ch = ml_order(dir, s0 + i);
                if (ch < 128) { CI[((size_t)(dh * 128 + ch)) * 8192 + rem] = (bf16)(cvt_pk_bf16(c, 0.f) & 0xffffu); if (don) NI[(size_t)(dh * 128 + ch) * 64 + rem] = nn; if (rem == 0) MI[dh * 128 + ch] = m; }
                const float mn = fmaxf(gg[i] + m, ml[i]), sp = __expf(gg[i] + m - mn), sl = __expf(ml[i] - mn);
                c = sp * c + sl * cl[i]; nn = sp * nn + sl * nl[i]; m = mn; }
        }
    }
}
__device__ __forceinline__ void ml_out_item(Frame& F, int item) {
    const float* const* in = F.in;
    const int n = item >> 3, h = item & 7, tid = F.tid, lane = F.lane, wave = F.wave, fr = lane & 15, fq = lane >> 4;
    const int rowbase = 128 * n;
    LAS bf16* vT = (LAS bf16*)F.lds;
    LAS float* fs = (LAS float*)(vT + 128 * VT_PITCH);
    const bf16* z = (const bf16*)(F.ws + WS_Z);
    if (wave < 2) { float g, mtot; LAS float* bbp = fs + wave * 384; ml_gates(F, wave, h, rowbase, bbp, bbp + 128, bbp + 256, g, mtot);
        if (lane == 0) fs[768 + wave] = ((const float*)(F.ws + WS_MI))[(wave * 8 + h) * 128 + n]; }
    ml_stage_vT(F, h, rowbase, vT);
    __syncthreads();
    const bf16* Qg = (const bf16*)(F.ws + WS_Q) + ((size_t)h * L + rowbase) * 64; const bf16* Kg = (const bf16*)(F.ws + WS_K) + ((size_t)h * L + rowbase) * 64;
    const int tl = 16 * wave + fr;
    bf16x8 qf[2];
#pragma unroll
    for (int kk = 0; kk < 2; ++kk) qf[kk] = *(const bf16x8*)(Qg + (size_t)tl * 64 + 32 * kk + 8 * fq);
    f32x4 st[8];
#pragma unroll
    for (int j = 0; j < 8; ++j) { f32x4 acc = (f32x4){0.f, 0.f, 0.f, 0.f};
#pragma unroll
        for (int kk = 0; kk < 2; ++kk) { const bf16x8 kf = *(const bf16x8*)(Kg + (size_t)(16 * j + fr) * 64 + 32 * kk + 8 * fq); acc = __builtin_amdgcn_mfma_f32_16x16x32_bf16(kf, qf[kk], acc, 0, 0, 0); }
        st[j] = acc; }
    f32x4 hs[8];
#pragma unroll
    for (int et = 0; et < 8; ++et) hs[et] = (f32x4){0.f, 0.f, 0.f, 0.f};
#pragma unroll 1
    for (int dir = 0; dir < 2; ++dir) {
        const LAS float* bbp = fs + dir * 384; const LAS float* alp = bbp + 128; const LAS float* mxp = bbp + 256;
        const float m_in = fs[768 + dir];
        const float beta = fmaxf(m_in, mxp[tl]);
        const int dh = dir * 8 + h;
        bf16x8 pf[4]; float dsum = 0.f;
#pragma unroll
        for (int kk = 0; kk < 4; ++kk) { float pv[8];
#pragma unroll
            for (int hh = 0; hh < 2; ++hh)
#pragma unroll
                for (int r = 0; r < 4; ++r) { const int s = 32 * kk + 16 * hh + 4 * fq + r; const bool ok = dir ? (s >= tl) : (s <= tl);
                    const float e = __expf(fminf(alp[s] - beta, 0.f)); const float v = ok ? st[2 * kk + hh][r] * e : 0.f; pv[4 * hh + r] = v; dsum += v; }
            pf[kk] = __builtin_bit_cast(bf16x8, (v4u){cvt_pk_bf16(pv[0], pv[1]), cvt_pk_bf16(pv[2], pv[3]), cvt_pk_bf16(pv[4], pv[5]), cvt_pk_bf16(pv[6], pv[7])}); }
        dsum += __shfl_xor(dsum, 16); dsum += __shfl_xor(dsum, 32);
        const float* nip = (const float*)(F.ws + WS_NI) + (size_t)(dh * 128 + n) * 64; float qn = 0.f;
#pragma unroll
        for (int kk = 0; kk < 2; ++kk) { const v4u qq = __builtin_bit_cast(v4u, qf[kk]); const unsigned w[4] = {qq.x, qq.y, qq.z, qq.w};
#pragma unroll
            for (int q = 0; q < 4; ++q) { const int d = 32 * kk + 8 * fq + 2 * q; qn += bflo(w[q]) * nip[d] + bfhi(w[q]) * nip[d + 1]; } }
        qn += __shfl_xor(qn, 16); qn += __shfl_xor(qn, 32);
        const float sc_t = __expf(m_in - beta);
        const float den = dsum + sc_t * qn, dn = fmaxf(fabsf(den), __expf(-(bbp[tl] + beta)));
        LAS float* xinv = fs + 772 + (wave * 2 + dir) * 32;
        if (fq == 0) { xinv[fr] = 1.0f / dn; xinv[16 + fr] = sc_t; }
        LDS_WAIT();
        float inv_r[4], sc_r[4];
#pragma unroll
        for (int r = 0; r < 4; ++r) { inv_r[r] = xinv[4 * fq + r]; sc_r[r] = xinv[16 + 4 * fq + r]; }
        const bf16* cip = (const bf16*)(F.ws + WS_CI) + (size_t)(dh * 128 + n) * 8192;
#pragma unroll
        for (int et = 0; et < 8; ++et) {
            f32x4 acc = (f32x4){0.f, 0.f, 0.f, 0.f}, acci = (f32x4){0.f, 0.f, 0.f, 0.f};
#pragma unroll
            for (int kk = 0; kk < 4; ++kk) {
                const bool live = dir ? (2 * kk + 1 >= wave) : (2 * kk <= wave);
                if (live) { const LAS bf16* vr = vT + (16 * et + fr) * VT_PITCH + 32 * kk + 4 * fq;
                    const v2u lo = *(const LAS v2u*)vr, hi = *(const LAS v2u*)(vr + 16);
                    const bf16x8 vb = __builtin_bit_cast(bf16x8, (v4u){lo.x, lo.y, hi.x, hi.y});
                    acc = __builtin_amdgcn_mfma_f32_16x16x32_bf16(pf[kk], vb, acc, 0, 0, 0); } }
#pragma unroll
            for (int kk = 0; kk < 2; ++kk) { const bf16x8 cb = *(const bf16x8*)(cip + (size_t)(16 * et + fr) * 64 + 32 * kk + 8 * fq); acci = __builtin_amdgcn_mfma_f32_16x16x32_bf16(qf[kk], cb, acci, 0, 0, 0); }
#pragma unroll
            for (int r = 0; r < 4; ++r) hs[et][r] += (acc[r] + sc_r[r] * acci[r]) * inv_r[r];
        }
    }
    float rs[4];
#pragma unroll
    for (int r = 0; r < 4; ++r) { float ss = 0.f;
#pragma unroll
        for (int et = 0; et < 8; ++et) ss += hs[et][r] * hs[et][r];
        ss += __shfl_xor(ss, 1); ss += __shfl_xor(ss, 2); ss += __shfl_xor(ss, 4); ss += __shfl_xor(ss, 8);
        rs[r] = rsqrtf(ss * (1.0f / 128.0f) + EPS); }
    bf16* cat = (bf16*)(F.ws + WS_CAT);
#pragma unroll
    for (int et = 0; et < 8; ++et) { const int col = h * 128 + 16 * et + fr; const float gh = in[IN_GHEAD][col];
#pragma unroll
        for (int r = 0; r < 4; ++r) { const int t = rowbase + 16 * wave + 4 * fq + r;
            const float o = hs[et][r] * rs[r] * gh * sigmoid_f(bf2f(z[(size_t)t * NINP + OFF_O + col]));
            cat[(size_t)t * D + col] = (bf16)(cvt_pk_bf16(o, 0.f) & 0xffffu); } }
    __syncthreads();
}

__device__ __forceinline__ void p3_filter_tile(Frame& F, int tile) {
    const float* const* in = F.in;
    const int tid = F.tid;
    LAS float* feat = (LAS float*)F.lds;
    LAS float* h1 = feat + 64 * 36;
    LAS float* h2 = h1 + 64 * 65;
    LAS float* w1s = h2 + 64 * 64;
    LAS float* w2s = w1s + 33 * 64;
    for (int i = tid; i < 33 * 64; i += NT) w1s[i] = in[IN_FW1][i];
    for (int i = tid; i < 64 * 64; i += NT) w2s[i] = in[IN_FW2][i];
    {
        const int tt = tid >> 3, sub = tid & 7; const float t = (float)(tile * 64 + tt);
        const float w = (6.2831855f * t) / (float)L;
        if (sub == 0) feat[tt * 36] = t / (float)(L - 1);
#pragma unroll
        for (int q = 0; q < 2; ++q) { const int bi = sub * 2 + q; const float band = 1e-4f + (float)bi * ((15.0f - 1e-4f) / 15.0f); const float ang = w * band;
            feat[tt * 36 + 1 + bi] = cosf(ang); feat[tt * 36 + 17 + bi] = -sinf(ang); }
    }
    __syncthreads();
    {
        const int tt = tid >> 3, j0 = (tid & 7) * 8;
        float a[8];
#pragma unroll
        for (int q = 0; q < 8; ++q) a[q] = in[IN_FB1][j0 + q];
#pragma unroll 1
        for (int i = 0; i < 33; ++i) { const float f = feat[tt * 36 + i];
#pragma unroll
            for (int q = 0; q < 8; ++q) a[q] += f * w1s[i * 64 + j0 + q]; }
#pragma unroll
        for (int q = 0; q < 8; ++q) h1[tt * 65 + j0 + q] = sinf(in[IN_FF1][j0 + q] * a[q]);
    }
    __syncthreads();
    {
        const int tt = tid >> 3, j0 = (tid & 7) * 8;
        float a[8];
#pragma unroll
        for (int q = 0; q < 8; ++q) a[q] = in[IN_FB2][j0 + q];
#pragma unroll 1
        for (int i = 0; i < 64; ++i) { const float f = h1[tt * 65 + i];
#pragma unroll
            for (int q = 0; q < 8; ++q) a[q] += f * w2s[i * 64 + j0 + q]; }
#pragma unroll
        for (int q = 0; q < 8; ++q) h2[tt * 64 + j0 + q] = sinf(in[IN_FF2][j0 + q] * a[q]);
    }
    __syncthreads();
    {
        bf16* hd = (bf16*)(F.ws + WS_HDN);
        for (int i = tid; i < 64 * 32; i += NT) { const int tt = i >> 5, j = (i & 31) * 2; *(unsigned*)(hd + (size_t)(tile * 64 + tt) * 64 + j) = cvt_pk_bf16(h2[tt * 64 + j], h2[tt * 64 + j + 1]); }
    }
    __syncthreads();
}
__device__ __forceinline__ void p3_uin_tile(Frame& F, int tile) {
    const float* const* in = F.in;
    const bf16* z = (const bf16*)(F.ws + WS_Z); float* uT = (float*)(F.ws + WS_UIN);
    LAS float* tl = (LAS float*)F.lds;
    const int t0 = (tile >> 2) * 64, cb = (tile & 3) * 256;
    const int cg = F.tid & 31, c0 = cb + cg * 8, rsub = F.tid >> 5;
    for (int pass = 0; pass < 4; ++pass) {
        const int tt = pass * 16 + rsub, t = t0 + tt;
        float r1[8], r2[8];
#pragma unroll
        for (int part = 0; part < 2; ++part) {
            const int zc = OFF_HY + 1024 * (part + 1) + c0, wc = 1024 * (part + 1) + c0;
            const v4u cur = *(const v4u*)(z + (size_t)t * NINP + zc);
            const v4u prv = t > 0 ? *(const v4u*)(z + (size_t)(t - 1) * NINP + zc) : (v4u){0u, 0u, 0u, 0u};
            const v4u nxt = t < L - 1 ? *(const v4u*)(z + (size_t)(t + 1) * NINP + zc) : (v4u){0u, 0u, 0u, 0u};
            float* rr = part ? r2 : r1;
#pragma unroll
            for (int q = 0; q < 4; ++q) {
                const unsigned pc = q == 0 ? prv.x : q == 1 ? prv.y : q == 2 ? prv.z : prv.w, cc = q == 0 ? cur.x : q == 1 ? cur.y : q == 2 ? cur.z : cur.w, nc = q == 0 ? nxt.x : q == 1 ? nxt.y : q == 2 ? nxt.z : nxt.w;
                const int ch = wc + 2 * q;
                rr[2 * q] = bflo(pc) * in[IN_CHW][ch] + bflo(cc) * in[IN_CHW][3072 + ch] + bflo(nc) * in[IN_CHW][6144 + ch] + in[IN_CHB][ch];
                rr[2 * q + 1] = bfhi(pc) * in[IN_CHW][ch + 1] + bfhi(cc) * in[IN_CHW][3072 + ch + 1] + bfhi(nc) * in[IN_CHW][6144 + ch + 1] + in[IN_CHB][ch + 1];
            }
        }
#pragma unroll
        for (int q = 0; q < 8; ++q) tl[(cg * 8 + q) * 65 + tt] = r1[q] * r2[q];
    }
    __syncthreads();
    for (int i = F.tid; i < 256 * 16; i += NT) { const int c = i >> 4, tq = (i & 15) * 4; const LAS float* s = tl + c * 65 + tq;
        *(f32x4*)(uT + (size_t)(cb + c) * L + t0 + tq) = (f32x4){s[0], s[1], s[2], s[3]}; }
    __syncthreads();
}

#ifndef FFT_LAS
#define FFT_LAS LAS
#endif
#if defined(__HIP_DEVICE_COMPILE__)
#define FFT_OPAQUE(v) asm volatile("" : "+v"(v))
#else
#define FFT_OPAQUE(v)
#endif
constexpr int FN = 16384;
constexpr int FFT_SLOTS = 18432;
__host__ __device__ __forceinline__ int fphys(int p) { return p + (p >> 3); }
__host__ __device__ __forceinline__ float fcos32(int k) {
    constexpr float T[16] = {1.0f, 0.98078528040323043f, 0.92387953251128674f, 0.83146961230254524f, 0.70710678118654752f, 0.55557023301960218f, 0.38268343236508977f, 0.19509032201612825f,
                             0.0f, -0.19509032201612825f, -0.38268343236508977f, -0.55557023301960218f, -0.70710678118654752f, -0.83146961230254524f, -0.92387953251128674f, -0.98078528040323043f};
    return T[k]; }
__host__ __device__ __forceinline__ float fsin32(int k) {
    constexpr float T[16] = {0.0f, 0.19509032201612825f, 0.38268343236508977f, 0.55557023301960218f, 0.70710678118654752f, 0.83146961230254524f, 0.92387953251128674f, 0.98078528040323043f,
                             1.0f, 0.98078528040323043f, 0.92387953251128674f, 0.83146961230254524f, 0.70710678118654752f, 0.55557023301960218f, 0.38268343236508977f, 0.19509032201612825f};
    return T[k]; }
template <int R> __host__ __device__ __forceinline__ constexpr int fbrev(int x) { int r = 0; for (int b = 1; b < R; b <<= 1) { r = (r << 1) | (x & 1); x >>= 1; } return r; }
template <int R, bool INV>
__host__ __device__ __forceinline__ void fft_reg(float (&xr)[R], float (&xi)[R]) {
#pragma unroll
    for (int len = R; len >= 2; len >>= 1) {
        const int half = len >> 1;
#pragma unroll
        for (int blk = 0; blk < R; blk += len)
#pragma unroll
            for (int k = 0; k < half; ++k) {
                const int i0 = blk + k, i1 = i0 + half;
                const float ar = xr[i0], ai = xi[i0], br = xr[i1], bi = xi[i1];
                xr[i0] = ar + br; xi[i0] = ai + bi;
                const float dr = ar - br, di = ai - bi;
                if (k == 0) { xr[i1] = dr; xi[i1] = di; }
                else if (4 * k == len) { if (!INV) { xr[i1] = di; xi[i1] = -dr; } else { xr[i1] = -di; xi[i1] = dr; } }
                else { const float c = fcos32(k * (32 / len)), s = fsin32(k * (32 / len));
                    if (!INV) { xr[i1] = dr * c + di * s; xi[i1] = di * c - dr * s; } else { xr[i1] = dr * c - di * s; xi[i1] = di * c + dr * s; } }
            }
    }
}
__host__ __device__ __forceinline__ void ftw(int num, int den, float& c, float& s) {
#if defined(__HIP_DEVICE_COMPILE__)
    const float fr = (float)num / (float)den; c = __builtin_amdgcn_cosf(fr); s = __builtin_amdgcn_sinf(fr);
#else
    const double a = 6.283185307179586476925 * (double)num / (double)den; c = (float)cos(a); s = (float)sin(a);
#endif
}
template <int R, int M>
__host__ __device__ __forceinline__ void fft_fwd_bfly(FFT_LAS float* buf, int B, int j) {
    constexpr int S = M / R;
    float xr[R], xi[R];
#pragma unroll
    for (int q = 0; q < R; ++q) { const f32x2 v = *(const FFT_LAS f32x2*)(buf + 2 * fphys(B + j + q * S)); xr[q] = v.x; xi[q] = v.y; }
    fft_reg<R, false>(xr, xi);
    if (S > 1) { float c1, s1; ftw(j, M, c1, s1); float wr = c1, wi = -s1;
#pragma unroll
        for (int r = 1; r < R; ++r) { const int ix = fbrev<R>(r); const float tr = xr[ix] * wr - xi[ix] * wi, ti = xr[ix] * wi + xi[ix] * wr; xr[ix] = tr; xi[ix] = ti;
            const float nr = wr * c1 + wi * s1, ni = wi * c1 - wr * s1; wr = nr; wi = ni; } }
#pragma unroll
    for (int r = 0; r < R; ++r) { const int ix = fbrev<R>(r); *(FFT_LAS f32x2*)(buf + 2 * fphys(B + j + r * S)) = (f32x2){xr[ix], xi[ix]}; }
}
template <int R, int M>
__host__ __device__ __forceinline__ void fft_inv_bfly(FFT_LAS float* buf, int B, int j) {
    constexpr int S = M / R;
    float xr[R], xi[R];
#pragma unroll
    for (int r = 0; r < R; ++r) { const f32x2 v = *(const FFT_LAS f32x2*)(buf + 2 * fphys(B + j + r * S)); xr[r] = v.x; xi[r] = v.y; }
    if (S > 1) { float c1, s1; ftw(j, M, c1, s1); float wr = c1, wi = s1;
#pragma unroll
        for (int r = 1; r < R; ++r) { const float tr = xr[r] * wr - xi[r] * wi, ti = xr[r] * wi + xi[r] * wr; xr[r] = tr; xi[r] = ti;
            const float nr = wr * c1 - wi * s1, ni = wi * c1 + wr * s1; wr = nr; wi = ni; } }
    fft_reg<R, true>(xr, xi);
#pragma unroll
    for (int q = 0; q < R; ++q) { const int ix = fbrev<R>(q); *(FFT_LAS f32x2*)(buf + 2 * fphys(B + j + q * S)) = (f32x2){xr[ix], xi[ix]}; }
}
__host__ __device__ __forceinline__ void fft_fwd_pass(FFT_LAS float* buf, int pass, int tid) {
    FFT_OPAQUE(tid);
    if (pass == 0) {
#pragma unroll 1
        for (int i = 0; i < 2; ++i) fft_fwd_bfly<16, 16384>(buf, 0, tid + 512 * i); }
    else if (pass == 1) {
#pragma unroll 1
        for (int i = 0; i < 2; ++i) { const int id = tid + 512 * i; fft_fwd_bfly<16, 1024>(buf, (id >> 6) * 1024, id & 63); } }
    else if (pass == 2) {
#pragma unroll 1
        for (int i = 0; i < 4; ++i) { const int id = tid + 512 * i; fft_fwd_bfly<8, 64>(buf, (id >> 3) * 64, id & 7); } }
    else {
#pragma unroll 1
        for (int i = 0; i < 4; ++i) { const int id = tid + 512 * i; fft_fwd_bfly<8, 8>(buf, id * 8, 0); } }
}
__host__ __device__ __forceinline__ void fft_inv_pass(FFT_LAS float* buf, int pass, int tid) {
    FFT_OPAQUE(tid);
    if (pass == 0) {
#pragma unroll 1
        for (int i = 0; i < 4; ++i) { const int id = tid + 512 * i; fft_inv_bfly<8, 8>(buf, id * 8, 0); } }
    else if (pass == 1) {
#pragma unroll 1
        for (int i = 0; i < 4; ++i) { const int id = tid + 512 * i; fft_inv_bfly<8, 64>(buf, (id >> 3) * 64, id & 7); } }
    else if (pass == 2) {
#pragma unroll 1
        for (int i = 0; i < 2; ++i) { const int id = tid + 512 * i; fft_inv_bfly<16, 1024>(buf, (id >> 6) * 1024, id & 63); } }
    else {
#pragma unroll 1
        for (int i = 0; i < 2; ++i) fft_inv_bfly<16, 16384>(buf, 0, tid + 512 * i); }
}
__host__ __device__ __forceinline__ int fpos(int k) { return ((k & 15) << 10) | (((k >> 4) & 15) << 6) | (((k >> 8) & 7) << 3) | (k >> 11); }
__host__ __device__ __forceinline__ void fft_mul_one(FFT_LAS float* buf, int k, float cr, float ci, float dr_, float di_, float wc, float ws) {
    const int k2 = (FN - k) & (FN - 1);
    FFT_LAS f32x2* pa = (FFT_LAS f32x2*)(buf + 2 * fphys(fpos(k))); FFT_LAS f32x2* pb = (FFT_LAS f32x2*)(buf + 2 * fphys(fpos(k2)));
    const f32x2 A = *pa, Bm = *pb;
    const float ar = A.x, ai = A.y, br = Bm.x, bi = -Bm.y, dr = dr_, di = -di_;
    const float uer = 0.5f * (ar + br), uei = 0.5f * (ai + bi), uor = 0.5f * (ai - bi), uoi = -0.5f * (ar - br);
    const float ker = 0.5f * (cr + dr), kei = 0.5f * (ci + di), kor = 0.5f * (ci - di), koi = -0.5f * (cr - dr);
    const float pr = uor * kor - uoi * koi, pi = uor * koi + uoi * kor;
    const float yer = (uer * ker - uei * kei) + (pr * wc + pi * ws), yei = (uer * kei + uei * ker) + (pi * wc - pr * ws);
    const float yor = (uer * kor - uei * koi) + (uor * ker - uoi * kei), yoi = (uer * koi + uei * kor) + (uor * kei + uoi * ker);
    *pa = (f32x2){yer - yoi, yei + yor};
    *pb = (f32x2){yer + yoi, -yei + yor};
}
__device__ __forceinline__ void p4_fft_job(Frame& F, int job) {
    const float* const* in = F.in;
    int tid_ = F.tid, lane_ = F.lane; FFT_OPAQUE(tid_); FFT_OPAQUE(lane_);
    const int tid = tid_, lane = lane_, wave = F.wave, c0 = job * 4;
    LAS float* buf = (LAS float*)F.lds;
    LAS float* scr = (LAS float*)(F.lds + FFTSCR_OFF);
    float* hfT = (float*)(F.ws + WS_KF); float* hbT = (float*)(F.ws + WS_KB); const float* uT = (const float*)(F.ws + WS_UIN);
    {
        const bf16* hd = (const bf16*)(F.ws + WS_HDN);
        const int n = lane & 15, kq = lane >> 4, ch = (n >> 1) & 3, dir = n & 1, col = dir * 1024 + c0 + ch; const bool valid = n < 8;
        bf16x8 bfr[2];
#pragma unroll
        for (int ks = 0; ks < 2; ++ks) { unsigned w[4];
#pragma unroll
            for (int j = 0; j < 4; ++j) { const int k = ks * 32 + kq * 8 + 2 * j; const float a = valid ? in[IN_FW3][(size_t)k * 2048 + col] : 0.f, b = valid ? in[IN_FW3][(size_t)(k + 1) * 2048 + col] : 0.f; w[j] = cvt_pk_bf16(a, b); }
            bfr[ks] = __builtin_bit_cast(bf16x8, (v4u){w[0], w[1], w[2], w[3]}); }
        const float b3 = valid ? in[IN_FB3][col] : 0.f;
        const float r_slow = 3.0701134573253945f, r_fast = 15.350567286626972f;
        const float rate = r_slow + (float)(c0 + ch) * ((r_fast - r_slow) / 1023.0f);
        float asum = 0.f; float* dst = (dir ? hbT : hfT) + (size_t)(c0 + ch) * L;
#pragma unroll 1
        for (int tb = wave * 8; tb < L / 16; tb += NWAVES * 8) {
            bf16x8 a0[8], a1[8];
#pragma unroll
            for (int i = 0; i < 8; ++i) { const bf16* hp = hd + (size_t)((tb + i) * 16 + n) * 64 + kq * 8; a0[i] = *(const bf16x8*)hp; a1[i] = *(const bf16x8*)(hp + 32); }
#pragma unroll
            for (int i = 0; i < 8; ++i) { const int t0 = (tb + i) * 16;
                f32x4 acc = (f32x4){b3, b3, b3, b3};
                acc = __builtin_amdgcn_mfma_f32_16x16x32_bf16(a0[i], bfr[0], acc, 0, 0, 0);
                acc = __builtin_amdgcn_mfma_f32_16x16x32_bf16(a1[i], bfr[1], acc, 0, 0, 0);
                if (valid) { f32x4 o;
#pragma unroll
                    for (int r = 0; r < 4; ++r) { const int t = t0 + 4 * kq + r; const float t01 = (float)t / (float)(L - 1); const float v = acc[r] * __expf(-t01 * rate); o[r] = v; if (!(dir && t == 0)) asum += fabsf(v); }
                    *(f32x4*)(dst + t0 + 4 * kq) = o; } }
        }
        asum += __shfl_xor(asum, 16); asum += __shfl_xor(asum, 32);
        if (lane < 8) scr[wave * 8 + lane] = asum;
        VM_WAIT(); __syncthreads();
        float tot = 0.f;
        if (tid < 4) { for (int w = 0; w < 8; ++w) tot += scr[w * 8 + 2 * tid] + scr[w * 8 + 2 * tid + 1]; }
        __syncthreads();
        if (tid < 4) scr[tid] = 1.0f / (tot * (float)FN);
        __syncthreads();
    }
#pragma unroll 1
    for (int ch = 0; ch < 4; ++ch) {
        const int c = c0 + ch;
        const float* hf = hfT + (size_t)c * L; const float* hb = hbT + (size_t)c * L; const float* uc = uT + (size_t)c * L;
#pragma unroll 8
        for (int i = 0; i < 16; ++i) { const int a = tid + NT * i; const f32x2 v = *(const f32x2*)(hf + 2 * a); *(LAS f32x2*)(buf + 2 * fphys(a)) = v; }
#pragma unroll 8
        for (int i = 0; i < 16; ++i) { const int a = FN / 2 + tid + NT * i; const float ko = hb[2 * FN - 2 * a - 1]; float ke = hb[2 * FN - 2 * a]; if (a == FN / 2) ke = 0.f;
            *(LAS f32x2*)(buf + 2 * fphys(a)) = (f32x2){ke, ko}; }
        __syncthreads();
        fft_fwd_pass(buf, 0, tid); __syncthreads(); fft_fwd_pass(buf, 1, tid); __syncthreads(); fft_fwd_pass(buf, 2, tid); __syncthreads(); fft_fwd_pass(buf, 3, tid); __syncthreads();
        {
            int tq = tid; FFT_OPAQUE(tq);
            f32x2* sa = (f32x2*)(hfT + (size_t)c * L); f32x2* sb = (f32x2*)(hbT + (size_t)c * L);
#pragma unroll 4
            for (int m = 0; m < 16; ++m) { const int k = tq + 512 * m, k2 = (FN - k) & (FN - 1);
                sa[m * 512 + tq] = *(const LAS f32x2*)(buf + 2 * fphys(fpos(k))); sb[m * 512 + tq] = *(const LAS f32x2*)(buf + 2 * fphys(fpos(k2))); }
            if (tid == 0) { const f32x2 h = *(const LAS f32x2*)(buf + 2 * fphys(fpos(FN / 2))); scr[8] = h.x; scr[9] = h.y; }
        }
        __syncthreads();
#pragma unroll 8
        for (int i = 0; i < 16; ++i) { const int a = tid + NT * i; const f32x2 v = *(const f32x2*)(uc + 2 * a); *(LAS f32x2*)(buf + 2 * fphys(a)) = v; }
#pragma unroll 4
        for (int i = 0; i < 16; ++i) { const int a = FN / 2 + tid + NT * i; *(LAS f32x2*)(buf + 2 * fphys(a)) = (f32x2){0.f, 0.f}; }
        __syncthreads();
        fft_fwd_pass(buf, 0, tid); __syncthreads(); fft_fwd_pass(buf, 1, tid); __syncthreads(); fft_fwd_pass(buf, 2, tid); __syncthreads(); fft_fwd_pass(buf, 3, tid); __syncthreads();
        {   int tq = tid; FFT_OPAQUE(tq);
            const f32x2* sa = (const f32x2*)(hfT + (size_t)c * L); const f32x2* sb = (const f32x2*)(hbT + (size_t)c * L);
            float c1, s1; ftw(tq, FN, c1, s1);
#pragma unroll 8
            for (int m = 0; m < 16; ++m) { const float cm = fcos32(m), sm = fsin32(m); const float wc = c1 * cm - s1 * sm, ws = s1 * cm + c1 * sm;
                const f32x2 ka = sa[m * 512 + tq], kb = sb[m * 512 + tq];
                fft_mul_one(buf, tq + 512 * m, ka.x, ka.y, kb.x, kb.y, wc, ws); }
            if (tid == 0) fft_mul_one(buf, FN / 2, scr[8], scr[9], scr[8], scr[9], -1.0f, 0.0f);
        }
        VM_WAIT(); __syncthreads();
        fft_inv_pass(buf, 0, tid); __syncthreads(); fft_inv_pass(buf, 1, tid); __syncthreads(); fft_inv_pass(buf, 2, tid); __syncthreads(); fft_inv_pass(buf, 3, tid); __syncthreads();
        { const float sc = scr[ch]; float* yT = hfT + (size_t)c * L;
#pragma unroll 2
            for (int nn = tid; nn < FN / 2; nn += NT) { const f32x2 v = *(const LAS f32x2*)(buf + 2 * fphys(nn)); *(f32x2*)(yT + 2 * nn) = (f32x2){v.x * sc, v.y * sc}; } }
        __syncthreads();
    }
    VM_WAIT(); __syncthreads();
    {
        const bf16* z = (const bf16*)(F.ws + WS_Z); bf16* cat = (bf16*)(F.ws + WS_CAT);
        float w0[4], w1[4], w2[4], bb[4], dsk[4];
#pragma unroll
        for (int q = 0; q < 4; ++q) { w0[q] = in[IN_CHW][c0 + q]; w1[q] = in[IN_CHW][3072 + c0 + q]; w2[q] = in[IN_CHW][6144 + c0 + q]; bb[q] = in[IN_CHB][c0 + q]; dsk[q] = in[IN_DSKIP][c0 + q]; }
#pragma unroll 4
        for (int t = tid; t < L; t += NT) {
            const v2u zc = *(const v2u*)(z + (size_t)t * NINP + OFF_HY + c0);
            const v2u zp = t > 0 ? *(const v2u*)(z + (size_t)(t - 1) * NINP + OFF_HY + c0) : (v2u){0u, 0u};
            const v2u zn = t < L - 1 ? *(const v2u*)(z + (size_t)(t + 1) * NINP + OFF_HY + c0) : (v2u){0u, 0u};
            const float pv[4] = {bflo(zp.x), bfhi(zp.x), bflo(zp.y), bfhi(zp.y)}, cv[4] = {bflo(zc.x), bfhi(zc.x), bflo(zc.y), bfhi(zc.y)}, nv[4] = {bflo(zn.x), bfhi(zn.x), bflo(zn.y), bfhi(zn.y)};
            float o[4];
#pragma unroll
            for (int q = 0; q < 4; ++q) { const float y = hfT[(size_t)(c0 + q) * L + t] + dsk[q] * uT[(size_t)(c0 + q) * L + t];
                o[q] = (pv[q] * w0[q] + cv[q] * w1[q] + nv[q] * w2[q] + bb[q]) * y; }
            v2u w; w.x = cvt_pk_bf16(o[0], o[1]); w.y = cvt_pk_bf16(o[2], o[3]);
            *(v2u*)(cat + (size_t)t * D + MVW + c0) = w;
        }
    }
    __syncthreads();
}
constexpr int RT_PITCH = 2056;
__device__ __forceinline__ void p6_norm2_router(Frame& F) {
    const float* const* in = F.in;
    const float* mod = (const float*)(F.ws + WS_MOD);
    bf16* h2g = (bf16*)(F.ws + WS_HA);
    int* cnt = (int*)(F.ws + WS_CTL) + CW_CNT;
    int* aexp = (int*)(F.ws + WS_AEXP); int* arank = (int*)(F.ws + WS_ARANK); float* aw = (float*)(F.ws + WS_AW);
    LAS bf16* h1 = (LAS bf16*)F.lds; LAS bf16* h2 = h1 + 16 * RT_PITCH;
    LAS float* part = (LAS float*)(h2 + 16 * RT_PITCH);
    const bf16* w1 = (const bf16*)(F.ws + WS_WR1); const bf16* w2 = (const bf16*)(F.ws + WS_WR2);
    const int lane = F.lane, wave = F.wave, fr = lane & 15, fq = lane >> 4;
    for (int t0 = F.bid * 16; t0 < L; t0 += F.G * 16) {
#pragma unroll 1
        for (int rr = 0; rr < 2; ++rr) {
            const int tr = 2 * wave + rr, t = t0 + tr;
            f32x4 v[8]; float ss = 0.f;
#pragma unroll
            for (int j = 0; j < 8; ++j) { const int col = 4 * lane + 256 * j; v[j] = *(const f32x4*)(F.out + (size_t)t * D + col); ss += (v[j].x * v[j].x + v[j].y * v[j].y) + (v[j].z * v[j].z + v[j].w * v[j].w); }
            const float rstd = rsqrtf(wave_sum(ss) * (1.0f / D) + EPS);
#pragma unroll
            for (int j = 0; j < 8; ++j) { const int col = 4 * lane + 256 * j;
                const f32x4 g = *(const f32x4*)(in[IN_GFFN] + col), sh = *(const f32x4*)(mod + 6144 + col), sc = *(const f32x4*)(mod + 8192 + col);
                const f32x4 h = (v[j] * rstd * g) * (sc + 1.0f) + sh;
                v2u o; o.x = cvt_pk_bf16(h.x, h.y); o.y = cvt_pk_bf16(h.z, h.w);
                *(v2u*)(h2g + (size_t)t * D + col) = o;
                *(LAS v2u*)(h1 + tr * RT_PITCH + col) = o;
                v2u lo; lo.x = cvt_pk_bf16(h.x - bflo(o.x), h.y - bfhi(o.x)); lo.y = cvt_pk_bf16(h.z - bflo(o.y), h.w - bfhi(o.y));
                *(LAS v2u*)(h2 + tr * RT_PITCH + col) = lo; }
        }
        __syncthreads();
        {
            const int nt = wave & 3, kh = wave >> 2;
            f32x4 acc = (f32x4){0.f, 0.f, 0.f, 0.f};
            const bf16* b1p = w1 + (size_t)(16 * nt + fr) * 2048 + kh * 1024 + 8 * fq; const bf16* b2p = w2 + (size_t)(16 * nt + fr) * 2048 + kh * 1024 + 8 * fq;
            const LAS bf16* a1p = h1 + fr * RT_PITCH + kh * 1024 + 8 * fq; const LAS bf16* a2p = h2 + fr * RT_PITCH + kh * 1024 + 8 * fq;
#pragma unroll 8
            for (int ks = 0; ks < 32; ++ks) {
                const bf16x8 a1 = *(const LAS bf16x8*)(a1p + 32 * ks), a2 = *(const LAS bf16x8*)(a2p + 32 * ks);
                const bf16x8 b1 = *(const bf16x8*)(b1p + 32 * ks), b2 = *(const bf16x8*)(b2p + 32 * ks);
                acc = __builtin_amdgcn_mfma_f32_16x16x32_bf16(a2, b1, acc, 0, 0, 0);
                acc = __builtin_amdgcn_mfma_f32_16x16x32_bf16(a1, b2, acc, 0, 0, 0);
                acc = __builtin_amdgcn_mfma_f32_16x16x32_bf16(a1, b1, acc, 0, 0, 0); }
#pragma unroll
            for (int r = 0; r < 4; ++r) part[(kh * 16 + 4 * fq + r) * 64 + 16 * nt + fr] = acc[r];
        }
        __syncthreads();
#pragma unroll 1
        for (int rr = 0; rr < 2; ++rr) {
            const int tr = 2 * wave + rr, t = t0 + tr;
            const float logit = part[tr * 64 + lane] + part[(16 + tr) * 64 + lane];
            const float s = 1.0f / (1.0f + expf(-logit)), sel = s + in[IN_BR][lane];
            const int grp = lane >> 3;
            float m1 = sel; m1 = fmaxf(m1, __shfl_xor(m1, 1)); m1 = fmaxf(m1, __shfl_xor(m1, 2)); m1 = fmaxf(m1, __shfl_xor(m1, 4));
            const unsigned long long gm = 0xFFull << (8 * grp);
            const unsigned long long b1 = __ballot(sel == m1) & gm;
            const int first = __ffsll((long long)b1) - 1;
            float m2 = (lane == first) ? -INFINITY : sel; m2 = fmaxf(m2, __shfl_xor(m2, 1)); m2 = fmaxf(m2, __shfl_xor(m2, 2)); m2 = fmaxf(m2, __shfl_xor(m2, 4));
            const float gs = m1 + m2;
            int grank = 0;
#pragma unroll
            for (int g = 0; g < 8; ++g) { const float og = __shfl(gs, 8 * g); grank += (og > gs || (og == gs && g < grp)) ? 1 : 0; }
            const float masked = grank < 4 ? sel : -INFINITY;
            int rank = 0;
            for (int e2 = 0; e2 < 64; ++e2) { const float om = __shfl(masked, e2); rank += (om > masked || (om == masked && e2 < lane)) ? 1 : 0; }
            const bool chosen = rank < 8;
            const float wsum = wave_sum(chosen ? s : 0.f);
            const unsigned long long cb = __ballot(chosen);
            if (chosen) {
                const int k = (int)__builtin_amdgcn_mbcnt_hi((unsigned)(cb >> 32), __builtin_amdgcn_mbcnt_lo((unsigned)cb, 0u));
                const int half = t >= HALF_T ? 1 : 0;
                const int r = atomicAdd(cnt + half * 64 + lane, 1);
                aexp[t * 8 + k] = lane; arank[t * 8 + k] = r; aw[t * 8 + k] = s / wsum * 2.5f;
            }
        }
        __syncthreads();
    }
}
__device__ __forceinline__ void build_pstart(Frame& F) {
    LAS int* ps = (LAS int*)(F.lds + LDSCTL_OFF);
    const int* cnt = (const int*)(F.ws + WS_CTL) + CW_CNT;
    __syncthreads();
    if (F.tid < 2) { int a = 0;
        for (int e = 0; e < NE; ++e) { ps[F.tid * 66 + e] = a; a += (__hip_atomic_load(cnt + F.tid * 64 + e, __ATOMIC_RELAXED, __HIP_MEMORY_SCOPE_AGENT) + 255) & ~255; }
        ps[F.tid * 66 + 64] = a; ps[F.tid * 66 + 65] = a + HALF_T; }
    __syncthreads();
}
__device__ __forceinline__ void p7_fill_rows(Frame& F) {
    build_pstart(F);
    const LAS int* ps = (const LAS int*)(F.lds + LDSCTL_OFF);
    const int* aexp = (const int*)(F.ws + WS_AEXP); const int* arank = (const int*)(F.ws + WS_ARANK); const float* aw = (const float*)(F.ws + WS_AW);
    int* rt = (int*)(F.ws + WS_RTOK); float* rw = (float*)(F.ws + WS_RW);
    const int gt = F.bid * NT + F.tid, NGT = F.G * NT;
    for (int i = gt; i < L * 8; i += NGT) { const int t = i >> 3, h = t >= HALF_T ? 1 : 0; const int row = ps[h * 66 + aexp[i]] + arank[i];
        rt[h * MAXROWS + row] = t; rw[h * MAXROWS + row] = aw[i]; }
    for (int t = gt; t < L; t += NGT) { const int h = t >= HALF_T ? 1 : 0; const int row = ps[h * 66 + 64] + (t - h * HALF_T);
        rt[h * MAXROWS + row] = t; rw[h * MAXROWS + row] = 1.0f; }
}
__device__ __forceinline__ void moe_combine(Frame& F, int half) {
    const float* const* in = F.in;
    const LAS int* ps = (const LAS int*)(F.lds + LDSCTL_OFF) + half * 66;
    const float* mod = (const float*)(F.ws + WS_MOD);
    const int* aexp = (const int*)(F.ws + WS_AEXP); const int* arank = (const int*)(F.ws + WS_ARANK); const float* aw = (const float*)(F.ws + WS_AW);
    const bf16* Y2 = (const bf16*)(F.ws + WS_Y2);
    const int gw = F.bid * NWAVES + F.wave, NGW = F.G * NWAVES, lane = F.lane;
    for (int tt = gw; tt < HALF_T; tt += NGW) {
        const int t = half * HALF_T + tt;
        float a[32];
#pragma unroll
        for (int i = 0; i < 32; ++i) a[i] = 0.f;
#pragma unroll 3
        for (int k = 0; k < 9; ++k) {
            const int row = k < 8 ? ps[aexp[t * 8 + k]] + arank[t * 8 + k] : ps[64] + tt;
            const float wk = k < 8 ? aw[t * 8 + k] : 1.0f;
            const bf16* yr = Y2 + (size_t)row * D + 8 * lane;
#pragma unroll
            for (int j = 0; j < 4; ++j) { const v4u y = *(const v4u*)(yr + 512 * j);
                a[8 * j + 0] += wk * bflo(y.x); a[8 * j + 1] += wk * bfhi(y.x); a[8 * j + 2] += wk * bflo(y.y); a[8 * j + 3] += wk * bfhi(y.y);
                a[8 * j + 4] += wk * bflo(y.z); a[8 * j + 5] += wk * bfhi(y.z); a[8 * j + 6] += wk * bflo(y.w); a[8 * j + 7] += wk * bfhi(y.w); }
        }
        float ss = 0.f;
#pragma unroll
        for (int j = 0; j < 4; ++j)
#pragma unroll
            for (int q = 0; q < 2; ++q) { const int col = 8 * lane + 512 * j + 4 * q;
                const f32x4 x1 = *(const f32x4*)(F.out + (size_t)t * D + col), g2 = *(const f32x4*)(mod + 10240 + col);
                const int i = 8 * j + 4 * q;
                a[i] = x1.x + g2.x * a[i]; a[i + 1] = x1.y + g2.y * a[i + 1]; a[i + 2] = x1.z + g2.z * a[i + 2]; a[i + 3] = x1.w + g2.w * a[i + 3];
                ss += (a[i] * a[i] + a[i + 1] * a[i + 1]) + (a[i + 2] * a[i + 2] + a[i + 3] * a[i + 3]); }
        const float rstd = rsqrtf(wave_sum(ss) * (1.0f / D) + EPS);
#pragma unroll
        for (int j = 0; j < 4; ++j)
#pragma unroll
            for (int q = 0; q < 2; ++q) { const int col = 8 * lane + 512 * j + 4 * q; const int i = 8 * j + 4 * q;
                const f32x4 gf = *(const f32x4*)(in[IN_GFIN] + col);
                *(f32x4*)(F.out + (size_t)t * D + col) = (f32x4){a[i] * rstd * gf.x, a[i + 1] * rstd * gf.y, a[i + 2] * rstd * gf.z, a[i + 3] * rstd * gf.w}; }
    }
}

constexpr int N_PHASES = 14;
__global__ void __launch_bounds__(NT, 2) fwd_kernel(Args args) {
    extern __shared__ __attribute__((aligned(16))) unsigned char lds_raw[];
    Frame F;
    F.lds = (LAS unsigned char*)lds_raw;
    F.tid = threadIdx.x; F.lane = F.tid & 63; F.wave = __builtin_amdgcn_readfirstlane(F.tid >> 6);
    F.bid = blockIdx.x; F.G = gridDim.x;
    F.in = args.in; F.out = args.out; F.ws = args.ws;
    volatile LAS unsigned* MISC = (volatile LAS unsigned*)(F.lds + LDSCTL_OFF + 768);
    if (F.tid < 64) ((LAS unsigned*)(F.lds + LDSCTL_OFF))[F.tid + 192] = 0u;
    __syncthreads();
    unsigned* ctl = (unsigned*)(F.ws + WS_CTL);
    const int lo = args.ph_lo, hi = args.ph_hi;
    XcdBarrier bar; bar.bar = ctl + CW_BAR; bar.x = 0; bar.st = nullptr;
    if (hi - lo > 1) bar = xcd_barrier_post(ctl + CW_BAR, MISC + 8);
#ifndef PH_MASK
#define PH_MASK 0xFFFF
#endif
#define IN(k) (((PH_MASK >> (k)) & 1) && lo <= (k) && (k) < hi)
#define SEAM(k) do { if (IN(k) && IN((k) + 1)) xcd_barrier(bar); } while (0)
#define REP(k) for (int rep_ = 0; rep_ < ((PROBE_DUP) == (k) ? 2 : 1); ++rep_) if ((rep_ ? __syncthreads() : (void)0), true)
    LAS int* ps = (LAS int*)(F.lds + LDSCTL_OFF);

    if (IN(0)) REP(0) { p0_prologue(F); } SEAM(0);
    if (IN(1)) REP(1) { p1_norm1(F); } SEAM(1);
    if (IN(2)) {
        gk::DenseOrder S; S.init(MROWS, NINP, D, F.G, F.bid); S.Bt = (const char*)(F.ws + WS_WIN);
        gk::EpiBf16Store E{(bf16*)(F.ws + WS_Z), NINP};
        gk::gemm_core(F.lds, (const char*)(F.ws + WS_HA), D, S, E);
    }
#if PROBE_DUP == 2
    if (IN(2)) { __syncthreads(); } if (IN(2)) {
        gk::DenseOrder S; S.init(MROWS, NINP, D, F.G, F.bid); S.Bt = (const char*)(F.ws + WS_WIN);
        gk::EpiBf16Store E{(bf16*)(F.ws + WS_Z), NINP};
        gk::gemm_core(F.lds, (const char*)(F.ws + WS_HA), D, S, E);
    }
#endif
    SEAM(2);
    if (IN(3)) REP(3) {
        for (int it = F.bid; it < 1040; it += F.G) ml_prep_item(F, it);
        for (int tile = F.bid; tile < 256; tile += F.G) p3_filter_tile(F, tile);
        for (int tile = F.bid; tile < 1024; tile += F.G) p3_uin_tile(F, tile);
    } SEAM(3);
    if (IN(4)) REP(4) { ml_scan(F); } SEAM(4);
    if (IN(5)) {
        for (int job = F.bid; job < 256; job += F.G) p4_fft_job(F, job);
#if PROBE_DUP == 50
        __syncthreads(); for (int job = F.bid; job < 256; job += F.G) p4_fft_job(F, job);
#endif
        for (int it = F.bid; it < 1024; it += F.G) ml_out_item(F, it);
    }
#if PROBE_DUP == 51
    if (IN(5)) { __syncthreads(); for (int it = F.bid + 0 * F.G; it < 1024; it += F.G) ml_out_item(F, it); }
#endif
    SEAM(5);
    if (IN(6)) {
        gk::DenseOrder S; S.init(L, D, D, F.G, F.bid); S.Bt = (const char*)(F.ws + WS_WOUT);
        gk::EpiResidual E{F.out, D, (const float*)(F.ws + WS_MOD) + 4096};
        gk::gemm_core(F.lds, (const char*)(F.ws + WS_CAT), D, S, E);
    } SEAM(6);
    if (IN(7)) { p6_norm2_router(F); } SEAM(7);
    if (IN(8)) { p7_fill_rows(F); } SEAM(8);
#define MOE_GU(h) do { build_pstart(F); \
        gk::GroupOrder<4, true> S; S.ntile = ps[(h) * 66 + 65] >> 8; S.G = F.G; S.c = F.bid; S.K = D; S.pstart = ps + (h) * 66; S.rtok = (const int*)(F.ws + WS_RTOK) + (h) * MAXROWS; \
        S.Bt = (const char*)(F.ws + WS_W13); S.bstride = (size_t)1024 * D * 2; \
        gk::EpiGateUp E{(bf16*)(F.ws + WS_HR)}; \
        gk::gemm_core(F.lds, (const char*)(F.ws + WS_HA), D, S, E); } while (0)
#define MOE_DN(h) do { build_pstart(F); \
        gk::GroupOrder<8, false> S; S.ntile = ps[(h) * 66 + 65] >> 8; S.G = F.G; S.c = F.bid; S.K = DE; S.pstart = ps + (h) * 66; S.rtok = nullptr; \
        S.Bt = (const char*)(F.ws + WS_W2); S.bstride = (size_t)D * DE * 2; \
        gk::EpiBf16Store E{(bf16*)(F.ws + WS_Y2), D}; \
        gk::gemm_core(F.lds, (const char*)(F.ws + WS_HR), DE, S, E); } while (0)
    if (IN(9)) REP(9) { MOE_GU(0); } SEAM(9);
    if (IN(10)) REP(10) { MOE_DN(0); } SEAM(10);
    if (IN(11)) { MOE_GU(1); moe_combine(F, 0); } SEAM(11);
    if (IN(12)) REP(12) { MOE_DN(1); } SEAM(12);
    if (IN(13)) { build_pstart(F); moe_combine(F, 1); }
#undef IN
#undef SEAM
}

extern "C" void kernel_launch(void* const* d_in, const int* in_sizes, int n_in, void* d_out, int out_size, void* d_ws, size_t ws_size, hipStream_t stream) {
    static int grid = 0;
    if (grid == 0) {
        if (n_in != 36 || out_size != L * D || ws_size < WS_END) { fprintf(stderr, "kernel_launch: unexpected shapes: n_in %d out %d ws %zu (need %zu)\n", n_in, out_size, ws_size, (size_t)WS_END); grid = -1; return; }
        int dev = 0, cus = 0, per_cu = 0;
        if (hipGetDevice(&dev) != hipSuccess || hipDeviceGetAttribute(&cus, hipDeviceAttributeMultiprocessorCount, dev) != hipSuccess) { grid = -1; return; }
        if (hipFuncSetAttribute((const void*)fwd_kernel, hipFuncAttributeMaxDynamicSharedMemorySize, LDS_BYTES) != hipSuccess) { fprintf(stderr, "kernel_launch: hipFuncSetAttribute failed\n"); grid = -1; return; }
        if (hipOccupancyMaxActiveBlocksPerMultiprocessor(&per_cu, (const void*)fwd_kernel, NT, LDS_BYTES) != hipSuccess || per_cu < 1) fprintf(stderr, "kernel_launch: occupancy query says %d\n", per_cu);
        (void)hipGetLastError();
        grid = cus;
    }
    if (grid < 0) return;
    if (hipMemsetAsync((char*)d_ws + WS_CTL, 0, CTL_ZERO_BYTES, stream) != hipSuccess) return;
    Args a{};
    for (int i = 0; i < 36; ++i) a.in[i] = (const float*)d_in[i];
    a.out = (float*)d_out; a.ws = (unsigned char*)d_ws;
    const int stop = MK_STOP_AFTER < N_PHASES ? MK_STOP_AFTER + 1 : N_PHASES;
#if MK_N_LAUNCHES == 1
    a.ph_lo = 0; a.ph_hi = stop;
    hipLaunchKernelGGL(fwd_kernel, dim3(grid), dim3(NT), LDS_BYTES, stream, a);
#else
    for (int p = 0; p < stop; ++p) { a.ph_lo = p; a.ph_hi = p + 1; hipLaunchKernelGGL(fwd_kernel, dim3(grid), dim3(NT), LDS_BYTES, stream, a); }
#endif
}
```

```cpp
#include <hip/hip_runtime.h>
#include <cstdio>
#include <cstdint>

#ifndef MK_N_LAUNCHES
#define MK_N_LAUNCHES 1
#endif
#ifndef PROBE_DUP
#define PROBE_DUP -1
#endif
#ifndef MK_STOP_AFTER
#define MK_STOP_AFTER 99
#endif

#define GAS __attribute__((address_space(1)))
#define LAS __attribute__((address_space(3)))
typedef unsigned short bf16;
typedef unsigned v4u __attribute__((ext_vector_type(4)));
typedef unsigned v2u __attribute__((ext_vector_type(2)));
typedef float f32x4 __attribute__((ext_vector_type(4)));
typedef float f32x2 __attribute__((ext_vector_type(2)));
typedef short bf16x8 __attribute__((ext_vector_type(8)));
#define LDS_WAIT() asm volatile("s_waitcnt lgkmcnt(0)" ::: "memory")
#define VM_WAIT() asm volatile("s_waitcnt vmcnt(0)" ::: "memory")

constexpr int NWAVES = 8, NT = NWAVES * 64;
constexpr int L = 16384, D = 2048, LC = 256, MROWS = L + LC;
constexpr int NIN = 6176, NINP = 6400;
constexpr int OFF_K = 0, OFF_V = 512, OFF_G = 1536, OFF_Q = 1568, OFF_O = 2080, OFF_HY = 3104;
constexpr int NH = 8, HYW = 1024, MVW = 1024;
constexpr int NE = 64, NE1 = 65, DE = 512;
constexpr int HALF_T = 8192;
constexpr int MAXROWS = 90112;
constexpr float EPS = 1e-6f;

constexpr size_t MiB = 1u << 20;
constexpr size_t WS_CTL = 0, CTL_ZERO_BYTES = 256 * 1024;
constexpr size_t WS_MOD = 1 * MiB;
constexpr size_t WS_POS = WS_MOD + 128 * 1024;
constexpr size_t WS_WR1 = 2 * MiB + 512 * 1024;
constexpr size_t WS_WR2 = WS_WR1 + 256 * 1024;
constexpr size_t WS_WIN = 3 * MiB;
constexpr size_t WS_WOUT = 28 * MiB;
constexpr size_t WS_W13 = 36 * MiB;
constexpr size_t WS_W2 = 296 * MiB;
constexpr size_t WS_HA = 426 * MiB;
constexpr size_t WS_Z = 491 * MiB;
constexpr size_t WS_CAT = 695 * MiB;
constexpr size_t WS_UIN = 759 * MiB;
constexpr size_t WS_KF = 823 * MiB;
constexpr size_t WS_KB = 887 * MiB;
constexpr size_t WS_CL = 426 * MiB;
constexpr size_t WS_CI = 951 * MiB;
constexpr size_t WS_Q = 983 * MiB;
constexpr size_t WS_K = 999 * MiB;
constexpr size_t WS_RTOK = 1015 * MiB;
constexpr size_t WS_RW = WS_RTOK + 2 * MAXROWS * 4;
constexpr size_t WS_AEXP = 1017 * MiB;
constexpr size_t WS_ARANK = WS_AEXP + 512 * 1024;
constexpr size_t WS_AW = WS_ARANK + 512 * 1024;
constexpr size_t WS_HDN = 1019 * MiB;
constexpr size_t WS_SC = 1021 * MiB;
constexpr size_t WS_NL = WS_SC + 32 * 1024;
constexpr size_t WS_NI = WS_NL + 640 * 1024;
constexpr size_t WS_MI = WS_NI + 640 * 1024;
constexpr size_t WS_END = 1023 * MiB;
constexpr size_t WS_HR = 491 * MiB;
constexpr size_t WS_Y2 = 579 * MiB;
static_assert(WS_Y2 + (size_t)MAXROWS * 2048 * 2 <= WS_CI, "overlay");
constexpr int CW_BAR = 4096;
constexpr int CW_CNT = 16384;

constexpr int RING_BYTES = 131072;
constexpr int LDSCTL_OFF = 147456;
constexpr int FFTSCR_OFF = LDSCTL_OFF + 1024;
constexpr int LDS_BYTES = 151552;

__device__ __forceinline__ unsigned cvt_pk_bf16(float lo, float hi) { unsigned r; asm volatile("v_cvt_pk_bf16_f32 %0, %1, %2" : "=v"(r) : "v"(lo), "v"(hi)); return r; }
__device__ __forceinline__ float bf2f(unsigned short b) { return __builtin_bit_cast(float, ((unsigned)b) << 16); }
__device__ __forceinline__ float bflo(unsigned u) { return __builtin_bit_cast(float, u << 16); }
__device__ __forceinline__ float bfhi(unsigned u) { return __builtin_bit_cast(float, u & 0xffff0000u); }
__device__ __forceinline__ float wave_sum(float v) {
#pragma unroll
    for (int o = 1; o < 64; o <<= 1) v += __shfl_xor(v, o);
    return v;
}
__device__ __forceinline__ float silu_f(float a) { return a / (1.f + __expf(-a)); }
__device__ __forceinline__ float sigmoid_f(float a) { return 1.f / (1.f + __expf(-a)); }

#define XB_TMO      128
#define XB_XCNT(j)  (256  + 64 * (j))
#define XB_XSUB(j)  (1280 + 64 * (j))
#define XB_XGEN(j)  (2304 + 64 * (j))
#define XB_TOP      3328
#define XB_TOPGEN   3392
#define XCD_BAR_WORDS 3456
#define XB_SPIN_CAP (1u << 18)

__device__ __forceinline__ unsigned xb_ld(unsigned* p)              { return __hip_atomic_load(p, __ATOMIC_RELAXED, __HIP_MEMORY_SCOPE_AGENT); }
__device__ __forceinline__ unsigned xb_add(unsigned* p, unsigned v) { return __hip_atomic_fetch_add(p, v, __ATOMIC_RELAXED, __HIP_MEMORY_SCOPE_AGENT); }
__device__ __forceinline__ unsigned xb_xcc_id() { return (unsigned)__builtin_amdgcn_s_getreg((3 << 11) | 20) & 0xFu; }
#define XB_SPIN(cond, bar) do { unsigned _sp = 0; while (cond) { __builtin_amdgcn_s_sleep(1); \
    if ((++_sp & 255u) == 0u) { if (xb_ld(&(bar)[XB_TMO])) break; if (_sp > XB_SPIN_CAP) { atomicAdd(&(bar)[XB_TMO], 1u); break; } } } } while (0)

struct XcdBarrier {
    unsigned* bar; unsigned x;
    volatile LAS unsigned* st;
};

__device__ __forceinline__ XcdBarrier xcd_barrier_post(unsigned* bar, volatile LAS unsigned* st) {
    XcdBarrier b; b.bar = bar; b.x = xb_xcc_id(); b.st = st;
    if (threadIdx.x == 0) (void)xb_add(&bar[XB_XCNT(b.x)], 1u);
    return b;
}
__device__ __forceinline__ void xcd_barrier_complete(unsigned* bar, unsigned x, unsigned& nloc, unsigned& nx) {
    const unsigned G = gridDim.x * gridDim.y * gridDim.z;
    unsigned sum, cnt, mine, sp = 0u;
    for (;;) {
        sum = 0u; cnt = 0u; mine = 0u;
#pragma unroll
        for (unsigned j = 0; j < 16; ++j) { const unsigned c = xb_ld(&bar[XB_XCNT(j)]); sum += c; cnt += (c > 0u) ? 1u : 0u; mine = (j == x) ? c : mine; }
        if (sum == G) break;
        __builtin_amdgcn_s_sleep(1);
        if ((++sp & 255u) == 0u) { if (xb_ld(&bar[XB_TMO])) break; if (sp > XB_SPIN_CAP) { atomicAdd(&bar[XB_TMO], 1u); break; } }
    }
    nloc = mine > 0u ? mine : 1u; nx = cnt > 0u ? cnt : 1u;
}

__device__ __forceinline__ void xcd_barrier(const XcdBarrier& b) {
    asm volatile("s_waitcnt vmcnt(0)" ::: "memory");
    __syncthreads();
    if (threadIdx.x == 0) {
        unsigned* bar = b.bar;
        __builtin_amdgcn_s_waitcnt(0);
        unsigned nloc = b.st[0], nx = b.st[1];
        if (nloc == 0u) { xcd_barrier_complete(bar, b.x, nloc, nx); b.st[0] = nloc; b.st[1] = nx; }
        const unsigned old = xb_add(&bar[XB_XSUB(b.x)], 1u);
        const unsigned gen = old / nloc;
        if (old + 1u == (gen + 1u) * nloc) {
            __builtin_amdgcn_fence(__ATOMIC_RELEASE, "agent");
            asm volatile("s_waitcnt vmcnt(0)" ::: "memory");
            const unsigned og = xb_add(&bar[XB_TOP], 1u);
            const unsigned tg = og / nx;
            if (og + 1u == (tg + 1u) * nx) xb_add(&bar[XB_TOPGEN], 1u);
            else XB_SPIN(xb_ld(&bar[XB_TOPGEN]) == tg, bar);
            __builtin_amdgcn_fence(__ATOMIC_ACQUIRE, "agent");
            xb_add(&bar[XB_XGEN(b.x)], 1u);
            asm volatile("s_waitcnt vmcnt(0)" ::: "memory");
        } else {
            XB_SPIN(xb_ld(&bar[XB_XGEN(b.x)]) == gen, bar);
            __builtin_amdgcn_fence(__ATOMIC_ACQUIRE, "agent");
            asm volatile("s_waitcnt vmcnt(0)" ::: "memory");
        }
    }
    __syncthreads();
}

namespace gk {
constexpr int BM = 256, BK = 64, HALF = 128, HTB = HALF * BK * 2, STAGE_BYTES = 8 * HTB, NXCD = 8, WGM = 8;
__host__ __device__ __forceinline__ int lds_byte(int r, int c) { const int st = (r >> 4) * 2 + (c >> 5), rr = r & 15, cc = c & 31, ob = rr * 64 + cc * 2; return st * 1024 + (ob ^ (((ob >> 9) & 1) << 5)); }
__host__ __device__ __forceinline__ void stage_rc(int b, int& R, int& C) { const int st = b / 1024, sb = b % 1024, swz = sb ^ (((sb >> 9) & 1) << 5); R = (st >> 1) * 16 + swz / 64; C = (st & 1) * 32 + (swz % 64) / 2; }
__host__ __device__ __forceinline__ int perm32(int rho) { const int n = rho >> 4, i = rho & 15; return 8 * (i >> 2) + 4 * n + (i & 3); }

struct Unit { int pm, pn, ex; };

template <class Epi, class Sched>
__device__ __forceinline__ void gemm_core(LAS unsigned char* lds, const char* Abase, const int K, const Sched& S, const Epi& E) {
    const int tid = threadIdx.x, wid = __builtin_amdgcn_readfirstlane(tid >> 6), lane = tid & 63, wr = wid >> 2, wc = wid & 3, fr = lane & 15, fq = lane >> 4;
    const int nt = K / BK;
    int RA[2], CA[2]; unsigned voffB[2];
#pragma unroll
    for (int i = 0; i < 2; ++i) { int R, C; stage_rc(tid * 16 + i * 8192, R, C); const int Rb = Epi::PERM ? ((R & ~31) + perm32(R & 31)) : R;
        RA[i] = R; CA[i] = C; voffB[i] = (unsigned)(Rb * K + C) * 2u; }
    const size_t kstep = (size_t)(BK * 2);
    const size_t hstepB = (size_t)HALF * K * 2;
    const unsigned ldsw = (unsigned)wid * 1024u;
    const int aoff = lds_byte(wr * 64 + fr, fq * 8), boff = lds_byte(wc * 32 + fr, fq * 8);
#define GK_SA(b, h) (((b) * 2 + (h)) * HTB)
#define GK_SB(b, h) ((4 + (b) * 2 + (h)) * HTB)
#define GK_STAGE(bufoff, gbase, v0, v1) do { \
        __builtin_amdgcn_global_load_lds((const unsigned*)((const char*)(gbase) + (v0)), (LAS unsigned*)(lds + (bufoff) + ldsw), 16, 0, 0); \
        __builtin_amdgcn_global_load_lds((const unsigned*)((const char*)(gbase) + (v1)), (LAS unsigned*)(lds + (bufoff) + ldsw + 8192), 16, 0, 0); } while (0)
#define GK_LDA(dst, b, h) do { _Pragma("unroll") for (int m = 0; m < 4; ++m) _Pragma("unroll") for (int k = 0; k < 2; ++k) dst[m][k] = *(const LAS bf16x8*)(lds + GK_SA(b, h) + aoff + m * 2048 + k * 1024); } while (0)
#define GK_LDB(dst, b, h) do { _Pragma("unroll") for (int n = 0; n < 2; ++n) _Pragma("unroll") for (int k = 0; k < 2; ++k) dst[n][k] = *(const LAS bf16x8*)(lds + GK_SB(b, h) + boff + n * 2048 + k * 1024); } while (0)
#define GK_MMA(ai, bj, At, Bt) do { __builtin_amdgcn_s_setprio(1); _Pragma("unroll") for (int m = 0; m < 4; ++m) _Pragma("unroll") for (int n = 0; n < 2; ++n) _Pragma("unroll") for (int k = 0; k < 2; ++k) \
        acc[ai][bj][m][n] = __builtin_amdgcn_mfma_f32_16x16x32_bf16(Bt[n][k], At[m][k], acc[ai][bj][m][n], 0, 0, 0); __builtin_amdgcn_s_setprio(0); } while (0)
#define GK_WAIT_V(n) asm volatile("s_waitcnt vmcnt(" #n ")" ::: "memory")
#define GK_WAIT_L(n) asm volatile("s_waitcnt lgkmcnt(" #n ")" ::: "memory")
#define GK_BAR __builtin_amdgcn_s_barrier()
#define GK_SCHED __builtin_amdgcn_sched_barrier(0)
    Unit cur, nxt; int ui = 0;
    if (!S.next(0, cur)) return;
    f32x4 acc[2][2][4][2];
#pragma unroll
    for (int a = 0; a < 2; ++a)
#pragma unroll
        for (int b = 0; b < 2; ++b)
#pragma unroll
            for (int m = 0; m < 4; ++m)
#pragma unroll
                for (int n = 0; n < 2; ++n) acc[a][b][m][n] = (f32x4){0.f, 0.f, 0.f, 0.f};
    bf16x8 At[4][2], B0[2][2], B1[2][2];
    unsigned c00, c01, c10, c11, n00, n01, n10, n11;
    S.a_offs(cur, RA, CA, c00, c01, c10, c11);
    asm volatile("" : "+v"(c00), "+v"(c01), "+v"(c10), "+v"(c11));
    const char* cB = S.b_base(cur);
    GK_STAGE(GK_SB(0, 0), cB, voffB[0], voffB[1]); GK_STAGE(GK_SB(0, 1), cB + hstepB, voffB[0], voffB[1]); GK_STAGE(GK_SA(0, 0), Abase, c00, c01); GK_STAGE(GK_SA(0, 1), Abase, c10, c11);
    if (wr == 1) GK_BAR;
    GK_WAIT_V(2); GK_BAR;
    GK_STAGE(GK_SB(1, 0), cB + kstep, voffB[0], voffB[1]); GK_STAGE(GK_SA(1, 0), Abase + kstep, c00, c01); GK_STAGE(GK_SB(1, 1), cB + hstepB + kstep, voffB[0], voffB[1]);
    GK_WAIT_V(6); GK_BAR;
    for (;;) {
        const bool has_next = S.next(ui + 1, nxt);
        const char* nB = cB;
        n00 = c00; n01 = c01; n10 = c10; n11 = c11;
        if (has_next) { S.a_offs(nxt, RA, CA, n00, n01, n10, n11); nB = S.b_base(nxt); }
        asm volatile("" : "+v"(n00), "+v"(n01), "+v"(n10), "+v"(n11));
        for (int t = 0; t < nt; t += 2) {
            const bool last = (t == nt - 2);
            const char* a1 = Abase + (size_t)(t + 1) * kstep;
            const char* a2 = last ? Abase : Abase + (size_t)(t + 2) * kstep; const char* b2 = last ? nB : cB + (size_t)(t + 2) * kstep;
            const char* a3 = a2 + kstep; const char* b3 = b2 + kstep;
            const unsigned x00 = last ? n00 : c00, x01 = last ? n01 : c01, x10 = last ? n10 : c10, x11 = last ? n11 : c11;
            GK_LDB(B0, 0, 0); GK_LDB(B1, 0, 1); GK_SCHED; GK_LDA(At, 0, 0); GK_STAGE(GK_SA(1, 1), a1, c10, c11);
            GK_WAIT_V(8); GK_WAIT_L(0); GK_BAR; GK_MMA(0, 0, At, B0); GK_MMA(0, 1, At, B1); GK_BAR; GK_SCHED;
            GK_LDA(At, 0, 1); GK_STAGE(GK_SB(0, 0), b2, voffB[0], voffB[1]); GK_STAGE(GK_SB(0, 1), b2 + hstepB, voffB[0], voffB[1]); GK_STAGE(GK_SA(0, 0), a2, x00, x01);
            GK_WAIT_V(8); GK_WAIT_L(0); GK_BAR; GK_MMA(1, 0, At, B0); GK_MMA(1, 1, At, B1); GK_BAR; GK_SCHED;
            GK_LDB(B0, 1, 0); GK_LDB(B1, 1, 1); GK_SCHED; GK_LDA(At, 1, 0); GK_STAGE(GK_SA(0, 1), a2, x10, x11);
            GK_WAIT_V(8); GK_WAIT_L(0); GK_BAR; GK_MMA(0, 0, At, B0); GK_MMA(0, 1, At, B1); GK_BAR; GK_SCHED;
            GK_LDA(At, 1, 1); GK_STAGE(GK_SB(1, 0), b3, voffB[0], voffB[1]); GK_STAGE(GK_SB(1, 1), b3 + hstepB, voffB[0], voffB[1]); GK_STAGE(GK_SA(1, 0), a3, x00, x01);
            GK_WAIT_V(8); GK_WAIT_L(0); GK_BAR; GK_MMA(1, 0, At, B0); GK_MMA(1, 1, At, B1); GK_BAR; GK_SCHED;
        }
        if (wr == 0) GK_BAR;
        E(acc, cur, wr, wc, fr, fq);
        if (!has_next) break;
#pragma unroll
        for (int a = 0; a < 2; ++a)
#pragma unroll
            for (int b = 0; b < 2; ++b)
#pragma unroll
                for (int m = 0; m < 4; ++m)
#pragma unroll
                    for (int n = 0; n < 2; ++n) acc[a][b][m][n] = (f32x4){0.f, 0.f, 0.f, 0.f};
        cur = nxt; cB = nB; c00 = n00; c01 = n01; c10 = n10; c11 = n11; ++ui;
        if (wr == 1) GK_BAR;
    }
    GK_WAIT_V(0);
    GK_BAR;
#undef GK_SA
#undef GK_SB
#undef GK_STAGE
#undef GK_LDA
#undef GK_LDB
#undef GK_MMA
#undef GK_WAIT_V
#undef GK_WAIT_L
#undef GK_BAR
#undef GK_SCHED
}

struct DenseOrder {
    int nM, nN, nwg, G, c, K;
    __device__ void init(int M, int N, int K_, int G_, int c_) { nM = M / BM; nN = N / BM; nwg = nM * nN; G = G_; c = c_; K = K_; }
    __device__ __forceinline__ bool next(int i, Unit& u) const {
        const long Lx = (long)i * G + c; if (Lx >= nwg) return false;
        int wgid = (int)Lx; { const int q = nwg / NXCD, r = nwg % NXCD, xcd = wgid % NXCD, off = wgid / NXCD; wgid = (xcd < r ? xcd * (q + 1) : r * (q + 1) + (xcd - r) * q) + off; }
        const int nig = WGM * nN, gid = wgid / nig, fm = gid * WGM, gsz = (nM - fm) < WGM ? (nM - fm) : WGM;
        u.pm = fm + ((wgid % nig) % gsz); u.pn = (wgid % nig) / gsz; u.ex = 0; return true;
    }
    const char* Bt;
    __device__ __forceinline__ void a_offs(const Unit& u, const int (&RA)[2], const int (&CA)[2], unsigned& o00, unsigned& o01, unsigned& o10, unsigned& o11) const {
        const unsigned r0 = (unsigned)(u.pm * BM);
        o00 = ((r0 + RA[0]) * (unsigned)K + CA[0]) * 2u; o01 = ((r0 + RA[1]) * (unsigned)K + CA[1]) * 2u;
        o10 = ((r0 + HALF + RA[0]) * (unsigned)K + CA[0]) * 2u; o11 = ((r0 + HALF + RA[1]) * (unsigned)K + CA[1]) * 2u;
    }
    __device__ __forceinline__ const char* b_base(const Unit& u) const { return Bt + (size_t)u.pn * BM * K * 2; }
};
template <int NPN, bool GATHER>
struct GroupOrder {
    int ntile, G, c, K;
    const LAS int* pstart;
    const int* rtok;
    const char* Bt; size_t bstride;
    __device__ __forceinline__ bool next(int i, Unit& u) const {
        const int x = c & 7, j = c >> 3, nj = G >> 3, T8 = (ntile + 7) >> 3, tlo = x * T8, thi = (tlo + T8) < ntile ? (tlo + T8) : ntile;
        const int Lx = i * nj + j, tl = Lx / NPN; if (tlo + tl >= thi) return false;
        u.pm = tlo + tl; u.pn = Lx % NPN;
        const int row = u.pm * BM; int lo = 0, hi = NE1;
        while (hi - lo > 1) { const int mid = (lo + hi) >> 1; if (pstart[mid] <= row) lo = mid; else hi = mid; }
        u.ex = lo; return true;
    }
    __device__ __forceinline__ void a_offs(const Unit& u, const int (&RA)[2], const int (&CA)[2], unsigned& o00, unsigned& o01, unsigned& o10, unsigned& o11) const {
        const int r0 = u.pm * BM;
        if (GATHER) {
            const int t00 = rtok[r0 + RA[0]], t01 = rtok[r0 + RA[1]], t10 = rtok[r0 + HALF + RA[0]], t11 = rtok[r0 + HALF + RA[1]];
            o00 = ((unsigned)t00 * (unsigned)K + CA[0]) * 2u; o01 = ((unsigned)t01 * (unsigned)K + CA[1]) * 2u;
            o10 = ((unsigned)t10 * (unsigned)K + CA[0]) * 2u; o11 = ((unsigned)t11 * (unsigned)K + CA[1]) * 2u;
        } else {
            o00 = ((unsigned)(r0 + RA[0]) * (unsigned)K + CA[0]) * 2u; o01 = ((unsigned)(r0 + RA[1]) * (unsigned)K + CA[1]) * 2u;
            o10 = ((unsigned)(r0 + HALF + RA[0]) * (unsigned)K + CA[0]) * 2u; o11 = ((unsigned)(r0 + HALF + RA[1]) * (unsigned)K + CA[1]) * 2u;
        }
    }
    __device__ __forceinline__ const char* b_base(const Unit& u) const { return Bt + (size_t)u.ex * bstride + (size_t)u.pn * BM * K * 2; }
};

struct EpiBf16Store {
    static constexpr bool PERM = true;
    bf16* O; int ldc;
    __device__ __forceinline__ void operator()(const f32x4 (&acc)[2][2][4][2], const Unit& u, int wr, int wc, int fr, int fq) const {
        const int row0 = u.pm * BM + wr * 64 + fr, col0 = u.pn * BM + wc * 32 + 8 * fq;
#pragma unroll
        for (int ai = 0; ai < 2; ++ai)
#pragma unroll
            for (int m = 0; m < 4; ++m) { bf16* rowp = O + (size_t)(row0 + ai * HALF + m * 16) * ldc + col0;
#pragma unroll
                for (int bj = 0; bj < 2; ++bj) { const f32x4 v0 = acc[ai][bj][m][0], v1 = acc[ai][bj][m][1];
                    v4u w; w.x = cvt_pk_bf16(v0[0], v0[1]); w.y = cvt_pk_bf16(v0[2], v0[3]); w.z = cvt_pk_bf16(v1[0], v1[1]); w.w = cvt_pk_bf16(v1[2], v1[3]);
                    *(v4u*)(rowp + bj * HALF) = w; } }
    }
};
struct EpiResidual {
    static constexpr bool PERM = false;
    float* X; int ldc; const float* gate;
    __device__ __forceinline__ void operator()(const f32x4 (&acc)[2][2][4][2], const Unit& u, int wr, int wc, int fr, int fq) const {
        const int row0 = u.pm * BM + wr * 64 + fr, col0 = u.pn * BM + wc * 32 + 4 * fq;
        f32x4 gv[2][2];
#pragma unroll
        for (int bj = 0; bj < 2; ++bj)
#pragma unroll
            for (int n = 0; n < 2; ++n) gv[bj][n] = *(const f32x4*)(gate + col0 + bj * HALF + n * 16);
#pragma unroll
        for (int ai = 0; ai < 2; ++ai)
#pragma unroll
            for (int m = 0; m < 4; ++m) { float* rowp = X + (size_t)(row0 + ai * HALF + m * 16) * ldc + col0;
#pragma unroll
                for (int bj = 0; bj < 2; ++bj)
#pragma unroll
                    for (int n = 0; n < 2; ++n) { f32x4* p = (f32x4*)(rowp + bj * HALF + n * 16); *p = *p + gv[bj][n] * acc[ai][bj][m][n]; } }
    }
};
struct EpiGateUp {
    static constexpr bool PERM = true;
    bf16* O;
    __device__ __forceinline__ void operator()(const f32x4 (&acc)[2][2][4][2], const Unit& u, int wr, int wc, int fr, int fq) const {
        const int row0 = u.pm * BM + wr * 64 + fr, col0 = u.pn * HALF + wc * 32 + 8 * fq;
#pragma unroll
        for (int ai = 0; ai < 2; ++ai)
#pragma unroll
            for (int m = 0; m < 4; ++m) { bf16* rowp = O + (size_t)(row0 + ai * HALF + m * 16) * DE + col0;
                float h[8];
#pragma unroll
                for (int n = 0; n < 2; ++n)
#pragma unroll
                    for (int j = 0; j < 4; ++j) { const float g = acc[ai][0][m][n][j], up = acc[ai][1][m][n][j]; h[n * 4 + j] = silu_f(g) * up; }
                v4u w; w.x = cvt_pk_bf16(h[0], h[1]); w.y = cvt_pk_bf16(h[2], h[3]); w.z = cvt_pk_bf16(h[4], h[5]); w.w = cvt_pk_bf16(h[6], h[7]);
                *(v4u*)rowp = w; }
    }
};
struct EpiDown {
    static constexpr bool PERM = true;
    bf16* O; const float* rw;
    __device__ __forceinline__ void operator()(const f32x4 (&acc)[2][2][4][2], const Unit& u, int wr, int wc, int fr, int fq) const {
        const int row0 = u.pm * BM + wr * 64 + fr, col0 = u.pn * BM + wc * 32 + 8 * fq;
#pragma unroll
        for (int ai = 0; ai < 2; ++ai)
#pragma unroll
            for (int m = 0; m < 4; ++m) { const int row = row0 + ai * HALF + m * 16; const float s = rw[row]; bf16* rowp = O + (size_t)row * D + col0;
#pragma unroll
                for (int bj = 0; bj < 2; ++bj) { const f32x4 v0 = acc[ai][bj][m][0] * s, v1 = acc[ai][bj][m][1] * s;
                    v4u w; w.x = cvt_pk_bf16(v0[0], v0[1]); w.y = cvt_pk_bf16(v0[2], v0[3]); w.z = cvt_pk_bf16(v1[0], v1[1]); w.w = cvt_pk_bf16(v1[2], v1[3]);
                    *(v4u*)(rowp + bj * HALF) = w; } }
    }
};
}

struct Args { const float* in[36]; float* out; unsigned char* ws; int ph_lo, ph_hi; };
struct Frame {
    LAS unsigned char* lds;
    int tid, lane, wave, bid, G;
    const float* const* in; float* out; unsigned char* ws;
};
#define IN_X 0
#define IN_C 1
#define IN_CTX 2
#define IN_CCTX 3
#define IN_WADA 4
#define IN_BADA 5
#define IN_GMIX 6
#define IN_GFFN 7
#define IN_WIN 8
#define IN_BGATES 9
#define IN_CKW 10
#define IN_CKB 11
#define IN_CQW 12
#define IN_CQB 13
#define IN_GHEAD 14
#define IN_CHW 15
#define IN_CHB 16
#define IN_FW1 17
#define IN_FB1 18
#define IN_FF1 19
#define IN_FW2 20
#define IN_FB2 21
#define IN_FF2 22
#define IN_FW3 23
#define IN_FB3 24
#define IN_DSKIP 25
#define IN_WOUT 26
#define IN_WR 27
#define IN_BR 28
#define IN_W1E 29
#define IN_W3E 30
#define IN_W2E 31
#define IN_W1S 32
#define IN_W3S 33
#define IN_W2S 34
#define IN_GFIN 35

__device__ __forceinline__ void transpose_item(const float* W, int N, int k0, int n0, bf16* WT, int dstK, int dst_row0, LAS float* scr, int lane) {
#pragma unroll 8
    for (int i = 0; i < 32; ++i) { const int kk = 2 * i + (lane >> 5); scr[kk * 33 + (lane & 31)] = W[(size_t)(k0 + kk) * N + n0 + (lane & 31)]; }
    LDS_WAIT(); asm volatile("" ::: "memory");
    const int c = lane & 7;
#pragma unroll
    for (int j = 0; j < 4; ++j) { const int n = (lane >> 3) + 8 * j; const LAS float* s = scr + (8 * c) * 33 + n;
        v4u o; o.x = cvt_pk_bf16(s[0 * 33], s[1 * 33]); o.y = cvt_pk_bf16(s[2 * 33], s[3 * 33]); o.z = cvt_pk_bf16(s[4 * 33], s[5 * 33]); o.w = cvt_pk_bf16(s[6 * 33], s[7 * 33]);
        *(v4u*)(WT + (size_t)(dst_row0 + n) * dstK + k0 + 8 * c) = o; }
    LDS_WAIT(); asm volatile("" ::: "memory");
}
__device__ __forceinline__ void p0_prologue(Frame& F) {
    const float* const* in = F.in;
    {
        LAS float* sv = (LAS float*)F.lds;
        LAS float* red = sv + 4096;
        float* mod = (float*)(F.ws + WS_MOD);
        for (int job = F.bid; job < 192; job += F.G) {
            for (int i = F.tid; i < 2048; i += NT) { sv[i] = silu_f(in[IN_C][i]); sv[2048 + i] = silu_f(in[IN_CCTX][i]); }
            __syncthreads();
            const int col = job * 64 + F.lane, r0 = F.wave * 256;
            const float* W = in[IN_WADA] + col;
            float a0 = 0.f, a1 = 0.f;
            for (int i = r0; i < r0 + 256; i += 8) {
                float w[8];
#pragma unroll
                for (int j = 0; j < 8; ++j) w[j] = W[(size_t)(i + j) * 12288];
#pragma unroll
                for (int j = 0; j < 8; ++j) { a0 += sv[i + j] * w[j]; a1 += sv[2048 + i + j] * w[j]; }
            }
            red[(F.wave * 64 + F.lane) * 2 + 0] = a0; red[(F.wave * 64 + F.lane) * 2 + 1] = a1;
            __syncthreads();
            if (F.wave == 0) { float s0 = 0.f, s1 = 0.f;
#pragma unroll
                for (int w = 0; w < 8; ++w) { s0 += red[(w * 64 + F.lane) * 2 + 0]; s1 += red[(w * 64 + F.lane) * 2 + 1]; }
                const float b = in[IN_BADA][col]; mod[col] = s0 + b; mod[12288 + col] = s1 + b; }
            __syncthreads();
        }
    }
    const int gt = F.bid * NT + F.tid, NGT = F.G * NT;
    {
        float* pos = (float*)(F.ws + WS_POS);
        for (int i = gt; i < 320 * 1024; i += NGT) { const int p = i >> 10, j = i & 1023, jj = j & 511;
            const float pp = (float)(p < 256 ? p : p - 256);
            const float omega = 1.0f / powf(10000.0f, (float)jj * (1.0f / 512.0f)); const float ang = pp * omega;
            pos[i] = j < 512 ? sinf(ang) : cosf(ang); }
    }
    {
        v4u* z = (v4u*)(F.ws + WS_WIN + (size_t)NIN * D * 2); const int nz = (NINP - NIN) * D * 2 / 16;
        for (int i = gt; i < nz; i += NGT) z[i] = (v4u){0u, 0u, 0u, 0u};
        int* rt = (int*)(F.ws + WS_RTOK); float* rw = (float*)(F.ws + WS_RW);
        for (int i = gt; i < 2 * MAXROWS; i += NGT) { rt[i] = 0; rw[i] = 0.f; }
    }
    {
        bf16* w1 = (bf16*)(F.ws + WS_WR1); bf16* w2 = (bf16*)(F.ws + WS_WR2);
        for (int i = gt; i < 64 * 2048; i += NGT) { const int e = i >> 11, k = i & 2047; const float w = in[IN_WR][k * 64 + e];
            const unsigned hi = cvt_pk_bf16(w, 0.f) & 0xffffu; const float r = w - bf2f((bf16)hi);
            w1[i] = (bf16)hi; w2[i] = (bf16)(cvt_pk_bf16(r, 0.f) & 0xffffu); }
    }
    {
        LAS float* scr = (LAS float*)(F.lds + F.wave * 16384);
        const int gw = F.bid * NWAVES + F.wave, NGW = F.G * NWAVES;
        constexpr int I_IN = 32 * 193, I_OUT = 32 * 64, I_E = 512 * NE1;
        constexpr int NITEMS = I_IN + I_OUT + 3 * I_E;
        for (int it = gw; it < NITEMS; it += NGW) {
            int r = it;
            if (r < I_IN) { const int kb = r / 193, nb = r % 193; transpose_item(in[IN_WIN], NIN, 64 * kb, 32 * nb, (bf16*)(F.ws + WS_WIN), D, 32 * nb, scr, F.lane); continue; } r -= I_IN;
            if (r < I_OUT) { const int kb = r / 64, nb = r % 64; transpose_item(in[IN_WOUT], D, 64 * kb, 32 * nb, (bf16*)(F.ws + WS_WOUT), D, 32 * nb, scr, F.lane); continue; } r -= I_OUT;
            if (r < 2 * I_E) { const int which = r >= I_E; if (which) r -= I_E;
                const int e = r / 512, rr = r % 512, kb = rr / 16, nb = rr % 16, n0 = 32 * nb;
                const float* src = e < NE ? in[which ? IN_W3E : IN_W1E] + (size_t)e * D * DE : in[which ? IN_W3S : IN_W1S];
                transpose_item(src, DE, 64 * kb, n0, (bf16*)(F.ws + WS_W13) + (size_t)e * 1024 * D, D, (n0 >> 7) * 256 + which * 128 + (n0 & 127), scr, F.lane); continue; }
            r -= 2 * I_E;
            { const int e = r / 512, rr = r % 512, kb = rr / 64, nb = rr % 64;
                const float* src = e < NE ? in[IN_W2E] + (size_t)e * DE * D : in[IN_W2S];
                transpose_item(src, D, 64 * kb, 32 * nb, (bf16*)(F.ws + WS_W2) + (size_t)e * D * DE, DE, 32 * nb, scr, F.lane); }
        }
    }
}

__device__ __forceinline__ void p1_norm1(Frame& F) {
    const float* const* in = F.in;
    const int gw = F.bid * NWAVES + F.wave, NGW = F.G * NWAVES;
    const float* mod = (const float*)(F.ws + WS_MOD); const float* pos = (const float*)(F.ws + WS_POS);
    bf16* hA = (bf16*)(F.ws + WS_HA);
    for (int row = gw; row < MROWS; row += NGW) {
        f32x4 v[8]; float ss = 0.f;
        const bool mainrow = row < L;
        const float* src = mainrow ? in[IN_X] + (size_t)row * D : in[IN_CTX] + (size_t)(row - L) * D;
        const float* md = mainrow ? mod : mod + 12288;
#pragma unroll
        for (int j = 0; j < 8; ++j) { const int col = 4 * F.lane + 256 * j; v[j] = *(const f32x4*)(src + col);
            if (mainrow) { const float* pp = col < 1024 ? pos + (size_t)(row >> 6) * 1024 + col : pos + (size_t)(256 + (row & 63)) * 1024 + (col - 1024);
                v[j] = v[j] + *(const f32x4*)pp; *(f32x4*)(F.out + (size_t)row * D + col) = v[j]; }
            ss += (v[j].x * v[j].x + v[j].y * v[j].y) + (v[j].z * v[j].z + v[j].w * v[j].w); }
        const float rstd = rsqrtf(wave_sum(ss) * (1.0f / D) + EPS);
#pragma unroll
        for (int j = 0; j < 8; ++j) { const int col = 4 * F.lane + 256 * j;
            const f32x4 g = *(const f32x4*)(in[IN_GMIX] + col), sh = *(const f32x4*)(md + col), sc = *(const f32x4*)(md + 2048 + col);
            const f32x4 h = (v[j] * rstd * g) * (sc + 1.0f) + sh;
            v2u o; o.x = cvt_pk_bf16(h.x, h.y); o.y = cvt_pk_bf16(h.z, h.w);
            *(v2u*)(hA + (size_t)row * D + col) = o; }
    }
}

constexpr int VT_PITCH = 136;
__device__ __forceinline__ float wave_incl_add(float x, int lane) {
#pragma unroll
    for (int o = 1; o < 64; o <<= 1) { const float y = __shfl_up(x, o); if (lane >= o) x += y; }
    return x;
}
__device__ __forceinline__ float wave_incl_max(float x, int lane) {
#pragma unroll
    for (int o = 1; o < 64; o <<= 1) { const float y = __shfl_up(x, o); if (lane >= o) x = fmaxf(x, y); }
    return x;
}
__device__ __forceinline__ void ml_gates(Frame& F, int dir, int h, int rowbase, LAS float* bb, LAS float* al, LAS float* mx, float& g, float& mtot) {
    const bf16* z = (const bf16*)(F.ws + WS_Z);
    const int lane = F.lane, pi0 = 2 * lane, p0 = dir ? 127 - pi0 : pi0, p1 = dir ? p0 - 1 : p0 + 1;
    const float bgi = F.in[IN_BGATES][dir * 16 + h], bgf = F.in[IN_BGATES][dir * 16 + 8 + h];
    const bf16* z0 = z + (size_t)(rowbase + p0) * NINP + OFF_G + dir * 16 + h; const bf16* z1 = z + (size_t)(rowbase + p1) * NINP + OFF_G + dir * 16 + h;
    const float i0 = bf2f(z0[0]) + bgi, f0 = bf2f(z0[8]) + bgf, i1 = bf2f(z1[0]) + bgi, f1 = bf2f(z1[8]) + bgf;
    const float l0 = fminf(f0, 0.f) - log1pf(__expf(-fabsf(f0))), l1 = fminf(f1, 0.f) - log1pf(__expf(-fabsf(f1)));
    const float incl = wave_incl_add(l0 + l1, lane);
    const float b1 = incl, b0 = incl - l1;
    const float a0 = i0 - b0, a1 = i1 - b1;
    const float mi = wave_incl_max(fmaxf(a0, a1), lane);
    float mprev = __shfl_up(mi, 1); if (lane == 0) mprev = -INFINITY;
    const float M0 = fmaxf(mprev, a0), M1 = mi;
    bb[p0] = b0; bb[p1] = b1; al[p0] = a0; al[p1] = a1; mx[p0] = M0; mx[p1] = M1;
    g = __shfl(incl, 63); mtot = __shfl(mi, 63);
}
__device__ __forceinline__ void ml_stage_vT(Frame& F, int h, int rowbase, LAS bf16* vT) {
    const bf16* z = (const bf16*)(F.ws + WS_Z);
    const int s = F.tid >> 2, eg = F.tid & 3;
#pragma unroll
    for (int i = 0; i < 4; ++i) { const int e0 = 32 * eg + 8 * i; const v4u v = *(const v4u*)(z + (size_t)(rowbase + s) * NINP + OFF_V + h * 128 + e0);
        const unsigned w[4] = {v.x, v.y, v.z, v.w};
#pragma unroll
        for (int q = 0; q < 4; ++q) { vT[(e0 + 2 * q) * VT_PITCH + s] = (bf16)(w[q] & 0xffffu); vT[(e0 + 2 * q + 1) * VT_PITCH + s] = (bf16)(w[q] >> 16); } }
}
__device__ __forceinline__ void ml_prep_item(Frame& F, int item) {
    const float* const* in = F.in;
    const int n = item >> 3, h = item & 7, tid = F.tid, lane = F.lane, wave = F.wave;
    const bool isctx = n >= 128;
    const int rowbase = isctx ? L + 128 * (n - 128) : 128 * n, seqlo = isctx ? L : 0, seqhi = isctx ? L + LC - 1 : L - 1;
    LAS bf16* vT = (LAS bf16*)F.lds;
    LAS bf16* kw0 = vT + 128 * VT_PITCH;
    LAS bf16* kw1 = kw0 + 64 * VT_PITCH;
    LAS float* fs = (LAS float*)(kw1 + 64 * VT_PITCH);
    const bf16* z = (const bf16*)(F.ws + WS_Z);
    if (wave < 2) { float g, mtot; LAS float* bbp = fs + 256 + wave * 384; ml_gates(F, wave, h, rowbase, bbp, bbp + 128, bbp + 256, g, mtot);
        LDS_WAIT();
        fs[wave * 128 + 2 * lane] = __expf(bbp[128 + 2 * lane] - mtot); fs[wave * 128 + 2 * lane + 1] = __expf(bbp[128 + 2 * lane + 1] - mtot);
        if (lane == 0) { float* sc = (float*)(F.ws + WS_SC) + ((size_t)(wave * 8 + h) * 130 + n) * 2; sc[0] = g; sc[1] = g + mtot; } }
    ml_stage_vT(F, h, rowbase, vT);
    __syncthreads();
    {
        const int s = tid >> 2, d0 = (tid & 3) * 16, R = rowbase + s; const bool hp = R > seqlo, hn = R < seqhi;
        float kv[16], qv[16];
#pragma unroll
        for (int part = 0; part < 2; ++part) {
            const int zc = (part ? OFF_Q : OFF_K) + h * 64 + d0; const float* cw = in[part ? IN_CQW : IN_CKW] + h * 64 + d0; const float* cb = in[part ? IN_CQB : IN_CKB] + h * 64 + d0;
#pragma unroll
            for (int hv = 0; hv < 2; ++hv) {
                const v4u c = *(const v4u*)(z + (size_t)R * NINP + zc + 8 * hv);
                const v4u p = hp ? *(const v4u*)(z + (size_t)(R - 1) * NINP + zc + 8 * hv) : (v4u){0u, 0u, 0u, 0u};
                const v4u nx = hn ? *(const v4u*)(z + (size_t)(R + 1) * NINP + zc + 8 * hv) : (v4u){0u, 0u, 0u, 0u};
                const unsigned cc[4] = {c.x, c.y, c.z, c.w}, pp[4] = {p.x, p.y, p.z, p.w}, nn[4] = {nx.x, nx.y, nx.z, nx.w};
#pragma unroll
                for (int q = 0; q < 4; ++q) { const int d = 8 * hv + 2 * q;
                    const float v0 = silu_f(bflo(pp[q]) * cw[d] + bflo(cc[q]) * cw[512 + d] + bflo(nn[q]) * cw[1024 + d] + cb[d]);
                    const float v1 = silu_f(bfhi(pp[q]) * cw[d + 1] + bfhi(cc[q]) * cw[512 + d + 1] + bfhi(nn[q]) * cw[1024 + d + 1] + cb[d + 1]);
                    if (part) { qv[d] = v0 * 0.125f; qv[d + 1] = v1 * 0.125f; } else { kv[d] = v0; kv[d + 1] = v1; } }
            }
        }
        if (!isctx) {
            bf16* Qg = (bf16*)(F.ws + WS_Q) + ((size_t)h * L + R) * 64 + d0; bf16* Kg = (bf16*)(F.ws + WS_K) + ((size_t)h * L + R) * 64 + d0;
#pragma unroll
            for (int hv = 0; hv < 2; ++hv) { v4u w;
                w.x = cvt_pk_bf16(qv[8 * hv], qv[8 * hv + 1]); w.y = cvt_pk_bf16(qv[8 * hv + 2], qv[8 * hv + 3]); w.z = cvt_pk_bf16(qv[8 * hv + 4], qv[8 * hv + 5]); w.w = cvt_pk_bf16(qv[8 * hv + 6], qv[8 * hv + 7]); *(v4u*)(Qg + 8 * hv) = w;
                w.x = cvt_pk_bf16(kv[8 * hv], kv[8 * hv + 1]); w.y = cvt_pk_bf16(kv[8 * hv + 2], kv[8 * hv + 3]); w.z = cvt_pk_bf16(kv[8 * hv + 4], kv[8 * hv + 5]); w.w = cvt_pk_bf16(kv[8 * hv + 6], kv[8 * hv + 7]); *(v4u*)(Kg + 8 * hv) = w; }
        }
        const float w0 = fs[s], w1 = fs[128 + s];
#pragma unroll
        for (int d = 0; d < 16; ++d) { const float kr = bf2f((bf16)(cvt_pk_bf16(kv[d], 0.f) & 0xffffu));
            kw0[(d0 + d) * VT_PITCH + s] = (bf16)(cvt_pk_bf16(kr * w0, 0.f) & 0xffffu); kw1[(d0 + d) * VT_PITCH + s] = (bf16)(cvt_pk_bf16(kr * w1, 0.f) & 0xffffu); }
    }
    __syncthreads();
    {
        const int fr = lane & 15, fq = lane >> 4;
        bf16x8 a[4];
#pragma unroll
        for (int kk = 0; kk < 4; ++kk) a[kk] = *(const LAS bf16x8*)(vT + (16 * wave + fr) * VT_PITCH + 32 * kk + 8 * fq);
#pragma unroll
        for (int dir = 0; dir < 2; ++dir) { const LAS bf16* kw = dir ? kw1 : kw0;
            float* cl = (float*)(F.ws + WS_CL) + ((size_t)((dir * 8 + h) * 130 + n)) * 8192;
#pragma unroll
            for (int dt = 0; dt < 4; ++dt) { f32x4 acc = (f32x4){0.f, 0.f, 0.f, 0.f};
#pragma unroll
                for (int kk = 0; kk < 4; ++kk) { const bf16x8 b = *(const LAS bf16x8*)(kw + (16 * dt + fr) * VT_PITCH + 32 * kk + 8 * fq); acc = __builtin_amdgcn_mfma_f32_16x16x32_bf16(a[kk], b, acc, 0, 0, 0); }
#pragma unroll
                for (int r = 0; r < 4; ++r) cl[(16 * wave + 4 * fq + r) * 64 + 16 * dt + fr] = acc[r]; } }
        if (tid < 128) { const int dir = tid >> 6, d = tid & 63; const LAS bf16* kw = (dir ? kw1 : kw0) + d * VT_PITCH; float s = 0.f;
            for (int i = 0; i < 128; ++i) s += bf2f(kw[i]);
            ((float*)(F.ws + WS_NL))[((size_t)((dir * 8 + h) * 130 + n)) * 64 + d] = s; }
    }
    __syncthreads();
}
__device__ __forceinline__ int ml_order(int dir, int step) { return step < 2 ? (dir ? 129 - step : 128 + step) : (dir ? 129 - step : step - 2); }
__device__ __forceinline__ void ml_scan(Frame& F) {
    const float* CL = (const float*)(F.ws + WS_CL); const float* SC = (const float*)(F.ws + WS_SC); const float* NLp = (const float*)(F.ws + WS_NL);
    bf16* CI = (bf16*)(F.ws + WS_CI); float* NI = (float*)(F.ws + WS_NI); float* MI = (float*)(F.ws + WS_MI);
    for (int idx = F.bid * NT + F.tid; idx < 16 * 8192; idx += F.G * NT) {
        const int dh = idx >> 13, rem = idx & 8191, dir = dh >> 3; const bool don = rem < 64;
        float c = 0.f, nn = 0.f, m = 0.f;
        for (int s0 = 0; s0 < 130; s0 += 10) {
            float cl[10], nl[10], gg[10], ml[10];
#pragma unroll
            for (int i = 0; i < 10; ++i) { const int ch = ml_order(dir, s0 + i); cl[i] = CL[((size_t)(dh * 130 + ch)) * 8192 + rem]; gg[i] = SC[(dh * 130 + ch) * 2]; ml[i] = SC[(dh * 130 + ch) * 2 + 1];
                nl[i] = don ? NLp[(size_t)(dh * 130 + ch) * 64 + rem] : 0.f; }
#pragma unroll
            for (int i = 0; i < 10; ++i) { const int ch = ml_order(dir, s0 + i);
                if (ch < 128) { CI[((size_t)(dh * 128 + ch)) * 8192 + rem] = (bf16)(cvt_pk_bf16(c, 0.f) & 0xffffu); if (don) NI[(size_t)(dh * 128 + ch) * 64 + rem] = nn; if (rem == 0) MI[dh * 128 + ch] = m; }
                const float mn = fmaxf(gg[i] + m, ml[i]), sp = __expf(gg[i] + m - mn), sl = __expf(ml[i] - mn);
                c = sp * c + sl * cl[i]; nn = sp * nn + sl * nl[i]; m = mn; }
        }
    }
}
__device__ __forceinline__ void ml_out_item(Frame& F, int item) {
    const float* const* in = F.in;
    const int n = item >> 3, h = item & 7, tid = F.tid, lane = F.lane, wave = F.wave, fr = lane & 15, fq = lane >> 4;
    const int rowbase = 128 * n;
    LAS bf16* vT = (LAS bf16*)F.lds;
    LAS float* fs = (LAS float*)(vT + 128 * VT_PITCH);
    const bf16* z = (const bf16*)(F.ws + WS_Z);
    if (wave < 2) { float g, mtot; LAS float* bbp = fs + wave * 384; ml_gates(F, wave, h, rowbase, bbp, bbp + 128, bbp + 256, g, mtot);
        if (lane == 0) fs[768 + wave] = ((const float*)(F.ws + WS_MI))[(wave * 8 + h) * 128 + n]; }
    ml_stage_vT(F, h, rowbase, vT);
    __syncthreads();
    const bf16* Qg = (const bf16*)(F.ws + WS_Q) + ((size_t)h * L + rowbase) * 64; const bf16* Kg = (const bf16*)(F.ws + WS_K) + ((size_t)h * L + rowbase) * 64;
    const int tl = 16 * wave + fr;
    bf16x8 qf[2];
#pragma unroll
    for (int kk = 0; kk < 2; ++kk) qf[kk] = *(const bf16x8*)(Qg + (size_t)tl * 64 + 32 * kk + 8 * fq);
    f32x4 st[8];
#pragma unroll
    for (int j = 0; j < 8; ++j) { f32x4 acc = (f32x4){0.f, 0.f, 0.f, 0.f};
#pragma unroll
        for (int kk = 0; kk < 2; ++kk) { const bf16x8 kf = *(const bf16x8*)(Kg + (size_t)(16 * j + fr) * 64 + 32 * kk + 8 * fq); acc = __builtin_amdgcn_mfma_f32_16x16x32_bf16(kf, qf[kk], acc, 0, 0, 0); }
        st[j] = acc; }
    f32x4 hs[8];
#pragma unroll
    for (int et = 0; et < 8; ++et) hs[et] = (f32x4){0.f, 0.f, 0.f, 0.f};
#pragma unroll 1
    for (int dir = 0; dir < 2; ++dir) {
        const LAS float* bbp = fs + dir * 384; const LAS float* alp = bbp + 128; const LAS float* mxp = bbp + 256;
        const float m_in = fs[768 + dir];
        const float beta = fmaxf(m_in, mxp[tl]);
        const int dh = dir * 8 + h;
        bf16x8 pf[4]; float dsum = 0.f;
#pragma unroll
        for (int kk = 0; kk < 4; ++kk) { float pv[8];
#pragma unroll
            for (int hh = 0; hh < 2; ++hh)
#pragma unroll
                for (int r = 0; r < 4; ++r) { const int s = 32 * kk + 16 * hh + 4 * fq + r; const bool ok = dir ? (s >= tl) : (s <= tl);
                    const float e = __expf(fminf(alp[s] - beta, 0.f)); const float v = ok ? st[2 * kk + hh][r] * e : 0.f; pv[4 * hh + r] = v; dsum += v; }
            pf[kk] = __builtin_bit_cast(bf16x8, (v4u){cvt_pk_bf16(pv[0], pv[1]), cvt_pk_bf16(pv[2], pv[3]), cvt_pk_bf16(pv[4], pv[5]), cvt_pk_bf16(pv[6], pv[7])}); }
        dsum += __shfl_xor(dsum, 16); dsum += __shfl_xor(dsum, 32);
        const float* nip = (const float*)(F.ws + WS_NI) + (size_t)(dh * 128 + n) * 64; float qn = 0.f;
#pragma unroll
        for (int kk = 0; kk < 2; ++kk) { const v4u qq = __builtin_bit_cast(v4u, qf[kk]); const unsigned w[4] = {qq.x, qq.y, qq.z, qq.w};
#pragma unroll
            for (int q = 0; q < 4; ++q) { const int d = 32 * kk + 8 * fq + 2 * q; qn += bflo(w[q]) * nip[d] + bfhi(w[q]) * nip[d + 1]; } }
        qn += __shfl_xor(qn, 16); qn += __shfl_xor(qn, 32);
        const float sc_t = __expf(m_in - beta);
        const float den = dsum + sc_t * qn, dn = fmaxf(fabsf(den), __expf(-(bbp[tl] + beta)));
        LAS float* xinv = fs + 772 + (wave * 2 + dir) * 32;
        if (fq == 0) { xinv[fr] = 1.0f / dn; xinv[16 + fr] = sc_t; }
        LDS_WAIT();
        float inv_r[4], sc_r[4];
#pragma unroll
        for (int r = 0; r < 4; ++r) { inv_r[r] = xinv[4 * fq + r]; sc_r[r] = xinv[16 + 4 * fq + r]; }
        const bf16* cip = (const bf16*)(F.ws + WS_CI) + (size_t)(dh * 128 + n) * 8192;
#pragma unroll
        for (int et = 0; et < 8; ++et) {
            f32x4 acc = (f32x4){0.f, 0.f, 0.f, 0.f}, acci = (f32x4){0.f, 0.f, 0.f, 0.f};
#pragma unroll
            for (int kk = 0; kk < 4; ++kk) {
                const bool live = dir ? (2 * kk + 1 >= wave) : (2 * kk <= wave);
                if (live) { const LAS bf16* vr = vT + (16 * et + fr) * VT_PITCH + 32 * kk + 4 * fq;
                    const v2u lo = *(const LAS v2u*)vr, hi = *(const LAS v2u*)(vr + 16);
                    const bf16x8 vb = __builtin_bit_cast(bf16x8, (v4u){lo.x, lo.y, hi.x, hi.y});
                    acc = __builtin_amdgcn_mfma_f32_16x16x32_bf16(pf[kk], vb, acc, 0, 0, 0); } }
#pragma unroll
            for (int kk = 0; kk < 2; ++kk) { const bf16x8 cb = *(const bf16x8*)(cip + (size_t)(16 * et + fr) * 64 + 32 * kk + 8 * fq); acci = __builtin_amdgcn_mfma_f32_16x16x32_bf16(qf[kk], cb, acci, 0, 0, 0); }
#pragma unroll
            for (int r = 0; r < 4; ++r) hs[et][r] += (acc[r] + sc_r[r] * acci[r]) * inv_r[r];
        }
    }
    float rs[4];
#pragma unroll
    for (int r = 0; r < 4; ++r) { float ss = 0.f;
#pragma unroll
        for (int et = 0; et < 8; ++et) ss += hs[et][r] * hs[et][r];
        ss += __shfl_xor(ss, 1); ss += __shfl_xor(ss, 2); ss += __shfl_xor(ss, 4); ss += __shfl_xor(ss, 8);
        rs[r] = rsqrtf(ss * (1.0f / 128.0f) + EPS); }
    bf16* cat = (bf16*)(F.ws + WS_CAT);
#pragma unroll
    for (int et = 0; et < 8; ++et) { const int col = h * 128 + 16 * et + fr; const float gh = in[IN_GHEAD][col];
#pragma unroll
        for (int r = 0; r < 4; ++r) { const int t = rowbase + 16 * wave + 4 * fq + r;
            const float o = hs[et][r] * rs[r] * gh * sigmoid_f(bf2f(z[(size_t)t * NINP + OFF_O + col]));
            cat[(size_t)t * D + col] = (bf16)(cvt_pk_bf16(o, 0.f) & 0xffffu); } }
    __syncthreads();
}

__device__ __forceinline__ void p3_filter_tile(Frame& F, int tile) {
    const float* const* in = F.in;
    const int tid = F.tid;
    LAS float* feat = (LAS float*)F.lds;
    LAS float* h1 = feat + 64 * 36;
    LAS float* h2 = h1 + 64 * 65;
    LAS float* w1s = h2 + 64 * 64;
    LAS float* w2s = w1s + 33 * 64;
    for (int i = tid; i < 33 * 64; i += NT) w1s[i] = in[IN_FW1][i];
    for (int i = tid; i < 64 * 64; i += NT) w2s[i] = in[IN_FW2][i];
    {
        const int tt = tid >> 3, sub = tid & 7; const float t = (float)(tile * 64 + tt);
        const float w = (6.2831855f * t) / (float)L;
        if (sub == 0) feat[tt * 36] = t / (float)(L - 1);
#pragma unroll
        for (int q = 0; q < 2; ++q) { const int bi = sub * 2 + q; const float band = 1e-4f + (float)bi * ((15.0f - 1e-4f) / 15.0f); const float ang = w * band;
            feat[tt * 36 + 1 + bi] = cosf(ang); feat[tt * 36 + 17 + bi] = -sinf(ang); }
    }
    __syncthreads();
    {
        const int tt = tid >> 3, j0 = (tid & 7) * 8;
        float a[8];
#pragma unroll
        for (int q = 0; q < 8; ++q) a[q] = in[IN_FB1][j0 + q];
#pragma unroll 1
        for (int i = 0; i < 33; ++i) { const float f = feat[tt * 36 + i];
#pragma unroll
            for (int q = 0; q < 8; ++q) a[q] += f * w1s[i * 64 + j0 + q]; }
#pragma unroll
        for (int q = 0; q < 8; ++q) h1[tt * 65 + j0 + q] = sinf(in[IN_FF1][j0 + q] * a[q]);
    }
    __syncthreads();
    {
        const int tt = tid >> 3, j0 = (tid & 7) * 8;
        float a[8];
#pragma unroll
        for (int q = 0; q < 8; ++q) a[q] = in[IN_FB2][j0 + q];
#pragma unroll 1
        for (int i = 0; i < 64; ++i) { const float f = h1[tt * 65 + i];
#pragma unroll
            for (int q = 0; q < 8; ++q) a[q] += f * w2s[i * 64 + j0 + q]; }
#pragma unroll
        for (int q = 0; q < 8; ++q) h2[tt * 64 + j0 + q] = sinf(in[IN_FF2][j0 + q] * a[q]);
    }
    __syncthreads();
    {
        bf16* hd = (bf16*)(F.ws + WS_HDN);
        for (int i = tid; i < 64 * 32; i += NT) { const int tt = i >> 5, j = (i & 31) * 2; *(unsigned*)(hd + (size_t)(tile * 64 + tt) * 64 + j) = cvt_pk_bf16(h2[tt * 64 + j], h2[tt * 64 + j + 1]); }
    }
    __syncthreads();
}
__device__ __forceinline__ void p3_uin_tile(Frame& F, int tile) {
    const float* const* in = F.in;
    const bf16* z = (const bf16*)(F.ws + WS_Z); float* uT = (float*)(F.ws + WS_UIN);
    LAS float* tl = (LAS float*)F.lds;
    const int t0 = (tile >> 2) * 64, cb = (tile & 3) * 256;
    const int cg = F.tid & 31, c0 = cb + cg * 8, rsub = F.tid >> 5;
    for (int pass = 0; pass < 4; ++pass) {
        const int tt = pass * 16 + rsub, t = t0 + tt;
        float r1[8], r2[8];
#pragma unroll
        for (int part = 0; part < 2; ++part) {
            const int zc = OFF_HY + 1024 * (part + 1) + c0, wc = 1024 * (part + 1) + c0;
            const v4u cur = *(const v4u*)(z + (size_t)t * NINP + zc);
            const v4u prv = t > 0 ? *(const v4u*)(z + (size_t)(t - 1) * NINP + zc) : (v4u){0u, 0u, 0u, 0u};
            const v4u nxt = t < L - 1 ? *(const v4u*)(z + (size_t)(t + 1) * NINP + zc) : (v4u){0u, 0u, 0u, 0u};
            float* rr = part ? r2 : r1;
#pragma unroll
            for (int q = 0; q < 4; ++q) {
                const unsigned pc = q == 0 ? prv.x : q == 1 ? prv.y : q == 2 ? prv.z : prv.w, cc = q == 0 ? cur.x : q == 1 ? cur.y : q == 2 ? cur.z : cur.w, nc = q == 0 ? nxt.x : q == 1 ? nxt.y : q == 2 ? nxt.z : nxt.w;
                const int ch = wc + 2 * q;
                rr[2 * q] = bflo(pc) * in[IN_CHW][ch] + bflo(cc) * in[IN_CHW][3072 + ch] + bflo(nc) * in[IN_CHW][6144 + ch] + in[IN_CHB][ch];
                rr[2 * q + 1] = bfhi(pc) * in[IN_CHW][ch + 1] + bfhi(cc) * in[IN_CHW][3072 + ch + 1] + bfhi(nc) * in[IN_CHW][6144 + ch + 1] + in[IN_CHB][ch + 1];
            }
        }
#pragma unroll
        for (int q = 0; q < 8; ++q) tl[(cg * 8 + q) * 65 + tt] = r1[q] * r2[q];
    }
    __syncthreads();
    for (int i = F.tid; i < 256 * 16; i += NT) { const int c = i >> 4, tq = (i & 15) * 4; const LAS float* s = tl + c * 65 + tq;
        *(f32x4*)(uT + (size_t)(cb + c) * L + t0 + tq) = (f32x4){s[0], s[1], s[2], s[3]}; }
    __syncthreads();
}

#ifndef FFT_LAS
#define FFT_LAS LAS
#endif
#if defined(__HIP_DEVICE_COMPILE__)
#define FFT_OPAQUE(v) asm volatile("" : "+v"(v))
#else
#define FFT_OPAQUE(v)
#endif
constexpr int FN = 16384;
constexpr int FFT_SLOTS = 18432;
__host__ __device__ __forceinline__ int fphys(int p) { return p + (p >> 3); }
__host__ __device__ __forceinline__ float fcos32(int k) {
    constexpr float T[16] = {1.0f, 0.98078528040323043f, 0.92387953251128674f, 0.83146961230254524f, 0.70710678118654752f, 0.55557023301960218f, 0.38268343236508977f, 0.19509032201612825f,
                             0.0f, -0.19509032201612825f, -0.38268343236508977f, -0.55557023301960218f, -0.70710678118654752f, -0.83146961230254524f, -0.92387953251128674f, -0.98078528040323043f};
    return T[k]; }
__host__ __device__ __forceinline__ float fsin32(int k) {
    constexpr float T[16] = {0.0f, 0.19509032201612825f, 0.38268343236508977f, 0.55557023301960218f, 0.70710678118654752f, 0.83146961230254524f, 0.92387953251128674f, 0.98078528040323043f,
                             1.0f, 0.98078528040323043f, 0.92387953251128674f, 0.83146961230254524f, 0.70710678118654752f, 0.55557023301960218f, 0.38268343236508977f, 0.19509032201612825f};
    return T[k]; }
template <int R> __host__ __device__ __forceinline__ constexpr int fbrev(int x) { int r = 0; for (int b = 1; b < R; b <<= 1) { r = (r << 1) | (x & 1); x >>= 1; } return r; }
__host__ __device__ __forceinline__ f32x2 cx_rot_m(f32x2 d) { return (f32x2){d.y, -d.x}; }
__host__ __device__ __forceinline__ f32x2 cx_rot_p(f32x2 d) { return (f32x2){-d.y, d.x}; }
__host__ __device__ __forceinline__ f32x2 cx_mul_cj(f32x2 d, float c, float s) { return d * c + cx_rot_m(d) * s; }
__host__ __device__ __forceinline__ f32x2 cx_mul(f32x2 d, float c, float s) { return d * c + cx_rot_p(d) * s; }
template <int R, bool INV>
__host__ __device__ __forceinline__ void fft_reg(f32x2 (&x)[R]) {
#pragma unroll
    for (int len = R; len >= 2; len >>= 1) {
        const int half = len >> 1;
#pragma unroll
        for (int blk = 0; blk < R; blk += len)
#pragma unroll
            for (int k = 0; k < half; ++k) {
                const int i0 = blk + k, i1 = i0 + half;
                const f32x2 a = x[i0], b = x[i1];
                x[i0] = a + b;
                const f32x2 d = a - b;
                if (k == 0) x[i1] = d;
                else if (4 * k == len) x[i1] = INV ? cx_rot_p(d) : cx_rot_m(d);
                else { const float c = fcos32(k * (32 / len)), s = fsin32(k * (32 / len)); x[i1] = INV ? cx_mul(d, c, s) : cx_mul_cj(d, c, s); }
            }
    }
}
__host__ __device__ __forceinline__ void ftw(int num, int den, float& c, float& s) {
#if defined(__HIP_DEVICE_COMPILE__)
    const float fr = (float)num * (1.0f / (float)den); c = __builtin_amdgcn_cosf(fr); s = __builtin_amdgcn_sinf(fr);
#else
    const double a = 6.283185307179586476925 * (double)num / (double)den; c = (float)cos(a); s = (float)sin(a);
#endif
}
template <int R, int M>
__host__ __device__ __forceinline__ void fft_fwd_bfly(FFT_LAS float* buf, int B, int j) {
    constexpr int S = M / R, PS = S == 1 ? 1 : S + S / 8;
    FFT_LAS f32x2* p = (FFT_LAS f32x2*)buf + fphys(B + j);
    f32x2 x[R];
#pragma unroll
    for (int q = 0; q < R; ++q) x[q] = p[q * PS];
    fft_reg<R, false>(x);
    if (S > 1) { float c1, s1; ftw(j, M, c1, s1); f32x2 w = (f32x2){c1, -s1};
#pragma unroll
        for (int r = 1; r < R; ++r) { const int ix = fbrev<R>(r); x[ix] = cx_mul(x[ix], w.x, w.y); w = cx_mul_cj(w, c1, s1); } }
#pragma unroll
    for (int r = 0; r < R; ++r) p[r * PS] = x[fbrev<R>(r)];
}
template <int R, int M>
__host__ __device__ __forceinline__ void fft_inv_bfly(FFT_LAS float* buf, int B, int j) {
    constexpr int S = M / R, PS = S == 1 ? 1 : S + S / 8;
    FFT_LAS f32x2* p = (FFT_LAS f32x2*)buf + fphys(B + j);
    f32x2 x[R];
#pragma unroll
    for (int r = 0; r < R; ++r) x[r] = p[r * PS];
    if (S > 1) { float c1, s1; ftw(j, M, c1, s1); f32x2 w = (f32x2){c1, s1};
#pragma unroll
        for (int r = 1; r < R; ++r) { x[r] = cx_mul(x[r], w.x, w.y); w = cx_mul(w, c1, s1); } }
    fft_reg<R, true>(x);
#pragma unroll
    for (int q = 0; q < R; ++q) p[q * PS] = x[fbrev<R>(q)];
}
__host__ __device__ __forceinline__ void fft_fwd_pass(FFT_LAS float* buf, int pass, int tid) {
    FFT_OPAQUE(tid);
    if (pass == 0) {
#pragma unroll 1
        for (int i = 0; i < 2; ++i) fft_fwd_bfly<16, 16384>(buf, 0, tid + 512 * i); }
    else if (pass == 1) {
#pragma unroll 1
        for (int i = 0; i < 2; ++i) { const int id = tid + 512 * i; fft_fwd_bfly<16, 1024>(buf, (id >> 6) * 1024, id & 63); } }
    else if (pass == 2) {
#pragma unroll 1
        for (int i = 0; i < 4; ++i) { const int id = tid + 512 * i; fft_fwd_bfly<8, 64>(buf, (id >> 3) * 64, id & 7); } }
    else {
#pragma unroll 1
        for (int i = 0; i < 4; ++i) { const int id = tid + 512 * i; fft_fwd_bfly<8, 8>(buf, id * 8, 0); } }
}
__host__ __device__ __forceinline__ void fft_inv_pass(FFT_LAS float* buf, int pass, int tid) {
    FFT_OPAQUE(tid);
    if (pass == 0) {
#pragma unroll 1
        for (int i = 0; i < 4; ++i) { const int id = tid + 512 * i; fft_inv_bfly<8, 8>(buf, id * 8, 0); } }
    else if (pass == 1) {
#pragma unroll 1
        for (int i = 0; i < 4; ++i) { const int id = tid + 512 * i; fft_inv_bfly<8, 64>(buf, (id >> 3) * 64, id & 7); } }
    else if (pass == 2) {
#pragma unroll 1
        for (int i = 0; i < 2; ++i) { const int id = tid + 512 * i; fft_inv_bfly<16, 1024>(buf, (id >> 6) * 1024, id & 63); } }
    else {
#pragma unroll 1
        for (int i = 0; i < 2; ++i) fft_inv_bfly<16, 16384>(buf, 0, tid + 512 * i); }
}
__host__ __device__ __forceinline__ int fpos(int k) { return ((k & 15) << 10) | (((k >> 4) & 15) << 6) | (((k >> 8) & 7) << 3) | (k >> 11); }
__host__ __device__ __forceinline__ void fft_mul_one(FFT_LAS float* buf, int k, float cr, float ci, float dr_, float di_, float wc, float ws) {
    const int k2 = (FN - k) & (FN - 1);
    FFT_LAS f32x2* pa = (FFT_LAS f32x2*)(buf + 2 * fphys(fpos(k))); FFT_LAS f32x2* pb = (FFT_LAS f32x2*)(buf + 2 * fphys(fpos(k2)));
    const f32x2 A = *pa, Bm = *pb;
    const float ar = A.x, ai = A.y, br = Bm.x, bi = -Bm.y, dr = dr_, di = -di_;
    const float uer = 0.5f * (ar + br), uei = 0.5f * (ai + bi), uor = 0.5f * (ai - bi), uoi = -0.5f * (ar - br);
    const float ker = 0.5f * (cr + dr), kei = 0.5f * (ci + di), kor = 0.5f * (ci - di), koi = -0.5f * (cr - dr);
    const float pr = uor * kor - uoi * koi, pi = uor * koi + uoi * kor;
    const float yer = (uer * ker - uei * kei) + (pr * wc + pi * ws), yei = (uer * kei + uei * ker) + (pi * wc - pr * ws);
    const float yor = (uer * kor - uei * koi) + (uor * ker - uoi * kei), yoi = (uer * koi + uei * kor) + (uor * kei + uoi * ker);
    *pa = (f32x2){yer - yoi, yei + yor};
    *pb = (f32x2){yer + yoi, -yei + yor};
}
__device__ __forceinline__ void p4_fft_job(Frame& F, int job) {
    const float* const* in = F.in;
    int tid_ = F.tid, lane_ = F.lane; FFT_OPAQUE(tid_); FFT_OPAQUE(lane_);
    const int tid = tid_, lane = lane_, wave = F.wave, c0 = job * 4;
    LAS float* buf = (LAS float*)F.lds;
    LAS float* scr = (LAS float*)(F.lds + FFTSCR_OFF);
    float* hfT = (float*)(F.ws + WS_KF); float* hbT = (float*)(F.ws + WS_KB); const float* uT = (const float*)(F.ws + WS_UIN);
    {
        const bf16* hd = (const bf16*)(F.ws + WS_HDN);
        const int n = lane & 15, kq = lane >> 4, ch = (n >> 1) & 3, dir = n & 1, col = dir * 1024 + c0 + ch; const bool valid = n < 8;
        bf16x8 bfr[2];
#pragma unroll
        for (int ks = 0; ks < 2; ++ks) { unsigned w[4];
#pragma unroll
            for (int j = 0; j < 4; ++j) { const int k = ks * 32 + kq * 8 + 2 * j; const float a = valid ? in[IN_FW3][(size_t)k * 2048 + col] : 0.f, b = valid ? in[IN_FW3][(size_t)(k + 1) * 2048 + col] : 0.f; w[j] = cvt_pk_bf16(a, b); }
            bfr[ks] = __builtin_bit_cast(bf16x8, (v4u){w[0], w[1], w[2], w[3]}); }
        const float b3 = valid ? in[IN_FB3][col] : 0.f;
        const float r_slow = 3.0701134573253945f, r_fast = 15.350567286626972f;
        const float rate = r_slow + (float)(c0 + ch) * ((r_fast - r_slow) / 1023.0f);
        const float nrl = -rate * (1.4426950408889634f / (float)(L - 1));
        float asum = 0.f; float* dst = (dir ? hbT : hfT) + (size_t)(c0 + ch) * L;
#pragma unroll 1
        for (int tb = wave * 8; tb < L / 16; tb += NWAVES * 8) {
            bf16x8 a0[8], a1[8];
#pragma unroll
            for (int i = 0; i < 8; ++i) { const bf16* hp = hd + (size_t)((tb + i) * 16 + n) * 64 + kq * 8; a0[i] = *(const bf16x8*)hp; a1[i] = *(const bf16x8*)(hp + 32); }
#pragma unroll
            for (int i = 0; i < 8; ++i) { const int t0 = (tb + i) * 16;
                f32x4 acc = (f32x4){b3, b3, b3, b3};
                acc = __builtin_amdgcn_mfma_f32_16x16x32_bf16(a0[i], bfr[0], acc, 0, 0, 0);
                acc = __builtin_amdgcn_mfma_f32_16x16x32_bf16(a1[i], bfr[1], acc, 0, 0, 0);
                if (valid) { f32x4 o;
#pragma unroll
                    for (int r = 0; r < 4; ++r) { const int t = t0 + 4 * kq + r; const float v = acc[r] * __builtin_amdgcn_exp2f((float)t * nrl); o[r] = v; if (!(dir && t == 0)) asum += fabsf(v); }
                    *(f32x4*)(dst + t0 + 4 * kq) = o; } }
        }
        asum += __shfl_xor(asum, 16); asum += __shfl_xor(asum, 32);
        if (lane < 8) scr[wave * 8 + lane] = asum;
        VM_WAIT(); __syncthreads();
        float tot = 0.f;
        if (tid < 4) { for (int w = 0; w < 8; ++w) tot += scr[w * 8 + 2 * tid] + scr[w * 8 + 2 * tid + 1]; }
        __syncthreads();
        if (tid < 4) scr[tid] = 1.0f / (tot * (float)FN);
        __syncthreads();
    }
#pragma unroll 1
    for (int ch = 0; ch < 4; ++ch) {
        const int c = c0 + ch;
        const float* hf = hfT + (size_t)c * L; const float* hb = hbT + (size_t)c * L; const float* uc = uT + (size_t)c * L;
#pragma unroll 8
        for (int i = 0; i < 16; ++i) { const int a = tid + NT * i; const f32x2 v = *(const f32x2*)(hf + 2 * a); *(LAS f32x2*)(buf + 2 * fphys(a)) = v; }
#pragma unroll 8
        for (int i = 0; i < 16; ++i) { const int a = FN / 2 + tid + NT * i; const float ko = hb[2 * FN - 2 * a - 1]; float ke = hb[2 * FN - 2 * a]; if (a == FN / 2) ke = 0.f;
            *(LAS f32x2*)(buf + 2 * fphys(a)) = (f32x2){ke, ko}; }
        __syncthreads();
        fft_fwd_pass(buf, 0, tid); __syncthreads(); fft_fwd_pass(buf, 1, tid); __syncthreads(); fft_fwd_pass(buf, 2, tid); __syncthreads(); fft_fwd_pass(buf, 3, tid); __syncthreads();
        {
            int tq = tid; FFT_OPAQUE(tq);
            f32x2* sa = (f32x2*)(hfT + (size_t)c * L); f32x2* sb = (f32x2*)(hbT + (size_t)c * L);
#pragma unroll 4
            for (int m = 0; m < 16; ++m) { const int k = tq + 512 * m, k2 = (FN - k) & (FN - 1);
                sa[m * 512 + tq] = *(const LAS f32x2*)(buf + 2 * fphys(fpos(k))); sb[m * 512 + tq] = *(const LAS f32x2*)(buf + 2 * fphys(fpos(k2))); }
            if (tid == 0) { const f32x2 h = *(const LAS f32x2*)(buf + 2 * fphys(fpos(FN / 2))); scr[8] = h.x; scr[9] = h.y; }
        }
        __syncthreads();
#pragma unroll 8
        for (int i = 0; i < 16; ++i) { const int a = tid + NT * i; const f32x2 v = *(const f32x2*)(uc + 2 * a); *(LAS f32x2*)(buf + 2 * fphys(a)) = v; }
#pragma unroll 4
        for (int i = 0; i < 16; ++i) { const int a = FN / 2 + tid + NT * i; *(LAS f32x2*)(buf + 2 * fphys(a)) = (f32x2){0.f, 0.f}; }
        __syncthreads();
        fft_fwd_pass(buf, 0, tid); __syncthreads(); fft_fwd_pass(buf, 1, tid); __syncthreads(); fft_fwd_pass(buf, 2, tid); __syncthreads(); fft_fwd_pass(buf, 3, tid); __syncthreads();
        {   int tq = tid; FFT_OPAQUE(tq);
            const f32x2* sa = (const f32x2*)(hfT + (size_t)c * L); const f32x2* sb = (const f32x2*)(hbT + (size_t)c * L);
            float c1, s1; ftw(tq, FN, c1, s1);
#pragma unroll 8
            for (int m = 0; m < 16; ++m) { const float cm = fcos32(m), sm = fsin32(m); const float wc = c1 * cm - s1 * sm, ws = s1 * cm + c1 * sm;
                const f32x2 ka = sa[m * 512 + tq], kb = sb[m * 512 + tq];
                fft_mul_one(buf, tq + 512 * m, ka.x, ka.y, kb.x, kb.y, wc, ws); }
            if (tid == 0) fft_mul_one(buf, FN / 2, scr[8], scr[9], scr[8], scr[9], -1.0f, 0.0f);
        }
        VM_WAIT(); __syncthreads();
        fft_inv_pass(buf, 0, tid); __syncthreads(); fft_inv_pass(buf, 1, tid); __syncthreads(); fft_inv_pass(buf, 2, tid); __syncthreads(); fft_inv_pass(buf, 3, tid); __syncthreads();
        { const float sc = scr[ch]; float* yT = hfT + (size_t)c * L;
#pragma unroll 2
            for (int nn = tid; nn < FN / 2; nn += NT) { const f32x2 v = *(const LAS f32x2*)(buf + 2 * fphys(nn)); *(f32x2*)(yT + 2 * nn) = (f32x2){v.x * sc, v.y * sc}; } }
        __syncthreads();
    }
    VM_WAIT(); __syncthreads();
    {
        const bf16* z = (const bf16*)(F.ws + WS_Z); bf16* cat = (bf16*)(F.ws + WS_CAT);
        float w0[4], w1[4], w2[4], bb[4], dsk[4];
#pragma unroll
        for (int q = 0; q < 4; ++q) { w0[q] = in[IN_CHW][c0 + q]; w1[q] = in[IN_CHW][3072 + c0 + q]; w2[q] = in[IN_CHW][6144 + c0 + q]; bb[q] = in[IN_CHB][c0 + q]; dsk[q] = in[IN_DSKIP][c0 + q]; }
#pragma unroll 4
        for (int t = tid; t < L; t += NT) {
            const v2u zc = *(const v2u*)(z + (size_t)t * NINP + OFF_HY + c0);
            const v2u zp = t > 0 ? *(const v2u*)(z + (size_t)(t - 1) * NINP + OFF_HY + c0) : (v2u){0u, 0u};
            const v2u zn = t < L - 1 ? *(const v2u*)(z + (size_t)(t + 1) * NINP + OFF_HY + c0) : (v2u){0u, 0u};
            const float pv[4] = {bflo(zp.x), bfhi(zp.x), bflo(zp.y), bfhi(zp.y)}, cv[4] = {bflo(zc.x), bfhi(zc.x), bflo(zc.y), bfhi(zc.y)}, nv[4] = {bflo(zn.x), bfhi(zn.x), bflo(zn.y), bfhi(zn.y)};
            float o[4];
#pragma unroll
            for (int q = 0; q < 4; ++q) { const float y = hfT[(size_t)(c0 + q) * L + t] + dsk[q] * uT[(size_t)(c0 + q) * L + t];
                o[q] = (pv[q] * w0[q] + cv[q] * w1[q] + nv[q] * w2[q] + bb[q]) * y; }
            v2u w; w.x = cvt_pk_bf16(o[0], o[1]); w.y = cvt_pk_bf16(o[2], o[3]);
            *(v2u*)(cat + (size_t)t * D + MVW + c0) = w;
        }
    }
    __syncthreads();
}
constexpr int RT_PITCH = 2056;
__device__ __forceinline__ void p6_norm2_router(Frame& F) {
    const float* const* in = F.in;
    const float* mod = (const float*)(F.ws + WS_MOD);
    bf16* h2g = (bf16*)(F.ws + WS_HA);
    int* cnt = (int*)(F.ws + WS_CTL) + CW_CNT;
    int* aexp = (int*)(F.ws + WS_AEXP); int* arank = (int*)(F.ws + WS_ARANK); float* aw = (float*)(F.ws + WS_AW);
    LAS bf16* h1 = (LAS bf16*)F.lds; LAS bf16* h2 = h1 + 16 * RT_PITCH;
    LAS float* part = (LAS float*)(h2 + 16 * RT_PITCH);
    const bf16* w1 = (const bf16*)(F.ws + WS_WR1); const bf16* w2 = (const bf16*)(F.ws + WS_WR2);
    const int lane = F.lane, wave = F.wave, fr = lane & 15, fq = lane >> 4;
    for (int t0 = F.bid * 16; t0 < L; t0 += F.G * 16) {
#pragma unroll 1
        for (int rr = 0; rr < 2; ++rr) {
            const int tr = 2 * wave + rr, t = t0 + tr;
            f32x4 v[8]; float ss = 0.f;
#pragma unroll
            for (int j = 0; j < 8; ++j) { const int col = 4 * lane + 256 * j; v[j] = *(const f32x4*)(F.out + (size_t)t * D + col); ss += (v[j].x * v[j].x + v[j].y * v[j].y) + (v[j].z * v[j].z + v[j].w * v[j].w); }
            const float rstd = rsqrtf(wave_sum(ss) * (1.0f / D) + EPS);
#pragma unroll
            for (int j = 0; j < 8; ++j) { const int col = 4 * lane + 256 * j;
                const f32x4 g = *(const f32x4*)(in[IN_GFFN] + col), sh = *(const f32x4*)(mod + 6144 + col), sc = *(const f32x4*)(mod + 8192 + col);
                const f32x4 h = (v[j] * rstd * g) * (sc + 1.0f) + sh;
                v2u o; o.x = cvt_pk_bf16(h.x, h.y); o.y = cvt_pk_bf16(h.z, h.w);
                *(v2u*)(h2g + (size_t)t * D + col) = o;
                *(LAS v2u*)(h1 + tr * RT_PITCH + col) = o;
                v2u lo; lo.x = cvt_pk_bf16(h.x - bflo(o.x), h.y - bfhi(o.x)); lo.y = cvt_pk_bf16(h.z - bflo(o.y), h.w - bfhi(o.y));
                *(LAS v2u*)(h2 + tr * RT_PITCH + col) = lo; }
        }
        __syncthreads();
        {
            const int nt = wave & 3, kh = wave >> 2;
            f32x4 acc = (f32x4){0.f, 0.f, 0.f, 0.f};
            const bf16* b1p = w1 + (size_t)(16 * nt + fr) * 2048 + kh * 1024 + 8 * fq; const bf16* b2p = w2 + (size_t)(16 * nt + fr) * 2048 + kh * 1024 + 8 * fq;
            const LAS bf16* a1p = h1 + fr * RT_PITCH + kh * 1024 + 8 * fq; const LAS bf16* a2p = h2 + fr * RT_PITCH + kh * 1024 + 8 * fq;
#pragma unroll 8
            for (int ks = 0; ks < 32; ++ks) {
                const bf16x8 a1 = *(const LAS bf16x8*)(a1p + 32 * ks), a2 = *(const LAS bf16x8*)(a2p + 32 * ks);
                const bf16x8 b1 = *(const bf16x8*)(b1p + 32 * ks), b2 = *(const bf16x8*)(b2p + 32 * ks);
                acc = __builtin_amdgcn_mfma_f32_16x16x32_bf16(a2, b1, acc, 0, 0, 0);
                acc = __builtin_amdgcn_mfma_f32_16x16x32_bf16(a1, b2, acc, 0, 0, 0);
                acc = __builtin_amdgcn_mfma_f32_16x16x32_bf16(a1, b1, acc, 0, 0, 0); }
#pragma unroll
            for (int r = 0; r < 4; ++r) part[(kh * 16 + 4 * fq + r) * 64 + 16 * nt + fr] = acc[r];
        }
        __syncthreads();
#pragma unroll 1
        for (int rr = 0; rr < 2; ++rr) {
            const int tr = 2 * wave + rr, t = t0 + tr;
            const float logit = part[tr * 64 + lane] + part[(16 + tr) * 64 + lane];
            const float s = 1.0f / (1.0f + expf(-logit)), sel = s + in[IN_BR][lane];
            const int grp = lane >> 3;
            float m1 = sel; m1 = fmaxf(m1, __shfl_xor(m1, 1)); m1 = fmaxf(m1, __shfl_xor(m1, 2)); m1 = fmaxf(m1, __shfl_xor(m1, 4));
            const unsigned long long gm = 0xFFull << (8 * grp);
            const unsigned long long b1 = __ballot(sel == m1) & gm;
            const int first = __ffsll((long long)b1) - 1;
            float m2 = (lane == first) ? -INFINITY : sel; m2 = fmaxf(m2, __shfl_xor(m2, 1)); m2 = fmaxf(m2, __shfl_xor(m2, 2)); m2 = fmaxf(m2, __shfl_xor(m2, 4));
            const float gs = m1 + m2;
            int grank = 0;
#pragma unroll
            for (int g = 0; g < 8; ++g) { const float og = __shfl(gs, 8 * g); grank += (og > gs || (og == gs && g < grp)) ? 1 : 0; }
            const float masked = grank < 4 ? sel : -INFINITY;
            int rank = 0;
            for (int e2 = 0; e2 < 64; ++e2) { const float om = __shfl(masked, e2); rank += (om > masked || (om == masked && e2 < lane)) ? 1 : 0; }
            const bool chosen = rank < 8;
            const float wsum = wave_sum(chosen ? s : 0.f);
            const unsigned long long cb = __ballot(chosen);
            if (chosen) {
                const int k = (int)__builtin_amdgcn_mbcnt_hi((unsigned)(cb >> 32), __builtin_amdgcn_mbcnt_lo((unsigned)cb, 0u));
                const int half = t >= HALF_T ? 1 : 0;
                const int r = atomicAdd(cnt + half * 64 + lane, 1);
                aexp[t * 8 + k] = lane; arank[t * 8 + k] = r; aw[t * 8 + k] = s / wsum * 2.5f;
            }
        }
        __syncthreads();
    }
}
__device__ __forceinline__ void build_pstart(Frame& F) {
    LAS int* ps = (LAS int*)(F.lds + LDSCTL_OFF);
    const int* cnt = (const int*)(F.ws + WS_CTL) + CW_CNT;
    __syncthreads();
    if (F.tid < 2) { int a = 0;
        for (int e = 0; e < NE; ++e) { ps[F.tid * 66 + e] = a; a += (__hip_atomic_load(cnt + F.tid * 64 + e, __ATOMIC_RELAXED, __HIP_MEMORY_SCOPE_AGENT) + 255) & ~255; }
        ps[F.tid * 66 + 64] = a; ps[F.tid * 66 + 65] = a + HALF_T; }
    __syncthreads();
}
__device__ __forceinline__ void p7_fill_rows(Frame& F) {
    build_pstart(F);
    const LAS int* ps = (const LAS int*)(F.lds + LDSCTL_OFF);
    const int* aexp = (const int*)(F.ws + WS_AEXP); const int* arank = (const int*)(F.ws + WS_ARANK); const float* aw = (const float*)(F.ws + WS_AW);
    int* rt = (int*)(F.ws + WS_RTOK); float* rw = (float*)(F.ws + WS_RW);
    const int gt = F.bid * NT + F.tid, NGT = F.G * NT;
    for (int i = gt; i < L * 8; i += NGT) { const int t = i >> 3, h = t >= HALF_T ? 1 : 0; const int row = ps[h * 66 + aexp[i]] + arank[i];
        rt[h * MAXROWS + row] = t; rw[h * MAXROWS + row] = aw[i]; }
    for (int t = gt; t < L; t += NGT) { const int h = t >= HALF_T ? 1 : 0; const int row = ps[h * 66 + 64] + (t - h * HALF_T);
        rt[h * MAXROWS + row] = t; rw[h * MAXROWS + row] = 1.0f; }
}
__device__ __forceinline__ void moe_combine(Frame& F, int half) {
    const float* const* in = F.in;
    const LAS int* ps = (const LAS int*)(F.lds + LDSCTL_OFF) + half * 66;
    const float* mod = (const float*)(F.ws + WS_MOD);
    const int* aexp = (const int*)(F.ws + WS_AEXP); const int* arank = (const int*)(F.ws + WS_ARANK); const float* aw = (const float*)(F.ws + WS_AW);
    const bf16* Y2 = (const bf16*)(F.ws + WS_Y2);
    const int gw = F.bid * NWAVES + F.wave, NGW = F.G * NWAVES, lane = F.lane;
    for (int tt = gw; tt < HALF_T; tt += NGW) {
        const int t = half * HALF_T + tt;
        float a[32];
#pragma unroll
        for (int i = 0; i < 32; ++i) a[i] = 0.f;
#pragma unroll 3
        for (int k = 0; k < 9; ++k) {
            const int row = k < 8 ? ps[aexp[t * 8 + k]] + arank[t * 8 + k] : ps[64] + tt;
            const float wk = k < 8 ? aw[t * 8 + k] : 1.0f;
            const bf16* yr = Y2 + (size_t)row * D + 8 * lane;
#pragma unroll
            for (int j = 0; j < 4; ++j) { const v4u y = *(const v4u*)(yr + 512 * j);
                a[8 * j + 0] += wk * bflo(y.x); a[8 * j + 1] += wk * bfhi(y.x); a[8 * j + 2] += wk * bflo(y.y); a[8 * j + 3] += wk * bfhi(y.y);
                a[8 * j + 4] += wk * bflo(y.z); a[8 * j + 5] += wk * bfhi(y.z); a[8 * j + 6] += wk * bflo(y.w); a[8 * j + 7] += wk * bfhi(y.w); }
        }
        float ss = 0.f;
#pragma unroll
        for (int j = 0; j < 4; ++j)
#pragma unroll
            for (int q = 0; q < 2; ++q) { const int col = 8 * lane + 512 * j + 4 * q;
                const f32x4 x1 = *(const f32x4*)(F.out + (size_t)t * D + col), g2 = *(const f32x4*)(mod + 10240 + col);
                const int i = 8 * j + 4 * q;
                a[i] = x1.x + g2.x * a[i]; a[i + 1] = x1.y + g2.y * a[i + 1]; a[i + 2] = x1.z + g2.z * a[i + 2]; a[i + 3] = x1.w + g2.w * a[i + 3];
                ss += (a[i] * a[i] + a[i + 1] * a[i + 1]) + (a[i + 2] * a[i + 2] + a[i + 3] * a[i + 3]); }
        const float rstd = rsqrtf(wave_sum(ss) * (1.0f / D) + EPS);
#pragma unroll
        for (int j = 0; j < 4; ++j)
#pragma unroll
            for (int q = 0; q < 2; ++q) { const int col = 8 * lane + 512 * j + 4 * q; const int i = 8 * j + 4 * q;
                const f32x4 gf = *(const f32x4*)(in[IN_GFIN] + col);
                *(f32x4*)(F.out + (size_t)t * D + col) = (f32x4){a[i] * rstd * gf.x, a[i + 1] * rstd * gf.y, a[i + 2] * rstd * gf.z, a[i + 3] * rstd * gf.w}; }
    }
}

constexpr int N_PHASES = 14;
__global__ void __launch_bounds__(NT, 2) fwd_kernel(Args args) {
    extern __shared__ __attribute__((aligned(16))) unsigned char lds_raw[];
    Frame F;
    F.lds = (LAS unsigned char*)lds_raw;
    F.tid = threadIdx.x; F.lane = F.tid & 63; F.wave = __builtin_amdgcn_readfirstlane(F.tid >> 6);
    F.bid = blockIdx.x; F.G = gridDim.x;
    F.in = args.in; F.out = args.out; F.ws = args.ws;
    volatile LAS unsigned* MISC = (volatile LAS unsigned*)(F.lds + LDSCTL_OFF + 768);
    if (F.tid < 64) ((LAS unsigned*)(F.lds + LDSCTL_OFF))[F.tid + 192] = 0u;
    __syncthreads();
    unsigned* ctl = (unsigned*)(F.ws + WS_CTL);
    const int lo = args.ph_lo, hi = args.ph_hi;
    XcdBarrier bar; bar.bar = ctl + CW_BAR; bar.x = 0; bar.st = nullptr;
    if (hi - lo > 1) bar = xcd_barrier_post(ctl + CW_BAR, MISC + 8);
#ifndef PH_MASK
#define PH_MASK 0xFFFF
#endif
#define IN(k) (((PH_MASK >> (k)) & 1) && lo <= (k) && (k) < hi)
#define SEAM(k) do { if (IN(k) && IN((k) + 1)) xcd_barrier(bar); } while (0)
#define REP(k) for (int rep_ = 0; rep_ < ((PROBE_DUP) == (k) ? 2 : 1); ++rep_) if ((rep_ ? __syncthreads() : (void)0), true)
    LAS int* ps = (LAS int*)(F.lds + LDSCTL_OFF);

    if (IN(0)) REP(0) { p0_prologue(F); } SEAM(0);
    if (IN(1)) REP(1) { p1_norm1(F); } SEAM(1);
    if (IN(2)) {
        gk::DenseOrder S; S.init(MROWS, NINP, D, F.G, F.bid); S.Bt = (const char*)(F.ws + WS_WIN);
        gk::EpiBf16Store E{(bf16*)(F.ws + WS_Z), NINP};
        gk::gemm_core(F.lds, (const char*)(F.ws + WS_HA), D, S, E);
    }
#if PROBE_DUP == 2
    if (IN(2)) { __syncthreads(); } if (IN(2)) {
        gk::DenseOrder S; S.init(MROWS, NINP, D, F.G, F.bid); S.Bt = (const char*)(F.ws + WS_WIN);
        gk::EpiBf16Store E{(bf16*)(F.ws + WS_Z), NINP};
        gk::gemm_core(F.lds, (const char*)(F.ws + WS_HA), D, S, E);
    }
#endif
    SEAM(2);
    if (IN(3)) REP(3) {
        for (int it = F.bid; it < 1040; it += F.G) ml_prep_item(F, it);
        for (int tile = F.bid; tile < 256; tile += F.G) p3_filter_tile(F, tile);
        for (int tile = F.bid; tile < 1024; tile += F.G) p3_uin_tile(F, tile);
    } SEAM(3);
    if (IN(4)) REP(4) { ml_scan(F); } SEAM(4);
    if (IN(5)) {
        for (int job = F.bid; job < 256; job += F.G) p4_fft_job(F, job);
#if PROBE_DUP == 50
        __syncthreads(); for (int job = F.bid; job < 256; job += F.G) p4_fft_job(F, job);
#endif
        for (int it = F.bid; it < 1024; it += F.G) ml_out_item(F, it);
    }
#if PROBE_DUP == 51
    if (IN(5)) { __syncthreads(); for (int it = F.bid + 0 * F.G; it < 1024; it += F.G) ml_out_item(F, it); }
#endif
    SEAM(5);
    if (IN(6)) {
        gk::DenseOrder S; S.init(L, D, D, F.G, F.bid); S.Bt = (const char*)(F.ws + WS_WOUT);
        gk::EpiResidual E{F.out, D, (const float*)(F.ws + WS_MOD) + 4096};
        gk::gemm_core(F.lds, (const char*)(F.ws + WS_CAT), D, S, E);
    } SEAM(6);
    if (IN(7)) { p6_norm2_router(F); } SEAM(7);
    if (IN(8)) { p7_fill_rows(F); } SEAM(8);
#define MOE_GU(h) do { build_pstart(F); \
        gk::GroupOrder<4, true> S; S.ntile = ps[(h) * 66 + 65] >> 8; S.G = F.G; S.c = F.bid; S.K = D; S.pstart = ps + (h) * 66; S.rtok = (const int*)(F.ws + WS_RTOK) + (h) * MAXROWS; \
        S.Bt = (const char*)(F.ws + WS_W13); S.bstride = (size_t)1024 * D * 2; \
        gk::EpiGateUp E{(bf16*)(F.ws + WS_HR)}; \
        gk::gemm_core(F.lds, (const char*)(F.ws + WS_HA), D, S, E); } while (0)
#define MOE_DN(h) do { build_pstart(F); \
        gk::GroupOrder<8, false> S; S.ntile = ps[(h) * 66 + 65] >> 8; S.G = F.G; S.c = F.bid; S.K = DE; S.pstart = ps + (h) * 66; S.rtok = nullptr; \
        S.Bt = (const char*)(F.ws + WS_W2); S.bstride = (size_t)D * DE * 2; \
        gk::EpiBf16Store E{(bf16*)(F.ws + WS_Y2), D}; \
        gk::gemm_core(F.lds, (const char*)(F.ws + WS_HR), DE, S, E); } while (0)
    if (IN(9)) REP(9) { MOE_GU(0); } SEAM(9);
    if (IN(10)) REP(10) { MOE_DN(0); } SEAM(10);
    if (IN(11)) { MOE_GU(1); moe_combine(F, 0); } SEAM(11);
    if (IN(12)) REP(12) { MOE_DN(1); } SEAM(12);
    if (IN(13)) { build_pstart(F); moe_combine(F, 1); }
#undef IN
#undef SEAM
}

extern "C" void kernel_launch(void* const* d_in, const int* in_sizes, int n_in, void* d_out, int out_size, void* d_ws, size_t ws_size, hipStream_t stream) {
    static int grid = 0;
    if (grid == 0) {
        if (n_in != 36 || out_size != L * D || ws_size < WS_END) { fprintf(stderr, "kernel_launch: unexpected shapes: n_in %d out %d ws %zu (need %zu)\n", n_in, out_size, ws_size, (size_t)WS_END); grid = -1; return; }
        int dev = 0, cus = 0, per_cu = 0;
        if (hipGetDevice(&dev) != hipSuccess || hipDeviceGetAttribute(&cus, hipDeviceAttributeMultiprocessorCount, dev) != hipSuccess) { grid = -1; return; }
        if (hipFuncSetAttribute((const void*)fwd_kernel, hipFuncAttributeMaxDynamicSharedMemorySize, LDS_BYTES) != hipSuccess) { fprintf(stderr, "kernel_launch: hipFuncSetAttribute failed\n"); grid = -1; return; }
        if (hipOccupancyMaxActiveBlocksPerMultiprocessor(&per_cu, (const void*)fwd_kernel, NT, LDS_BYTES) != hipSuccess || per_cu < 1) fprintf(stderr, "kernel_launch: occupancy query says %d\n", per_cu);
        (void)hipGetLastError();
        grid = cus;
    }
    if (grid < 0) return;
    if (hipMemsetAsync((char*)d_ws + WS_CTL, 0, CTL_ZERO_BYTES, stream) != hipSuccess) return;
    Args a{};
    for (int i = 0; i < 36; ++i) a.in[i] = (const float*)d_in[i];
    a.out = (float*)d_out; a.ws = (unsigned char*)d_ws;
    const int stop = MK_STOP_AFTER < N_PHASES ? MK_STOP_AFTER + 1 : N_PHASES;
#if MK_N_LAUNCHES == 1
    a.ph_lo = 0; a.ph_hi = stop;
    hipLaunchKernelGGL(fwd_kernel, dim3(grid), dim3(NT), LDS_BYTES, stream, a);
#else
    for (int p = 0; p < stop; ++p) { a.ph_lo = p; a.ph_hi = p + 1; hipLaunchKernelGGL(fwd_kernel, dim3(grid), dim3(NT), LDS_BYTES, stream, a); }
#endif
}
```

```cpp
#include <hip/hip_runtime.h>
#include <cstdio>
#include <cstdint>

#ifndef MK_N_LAUNCHES
#define MK_N_LAUNCHES 1
#endif
#ifndef PROBE_DUP
#define PROBE_DUP -1
#endif
#ifndef MK_STOP_AFTER
#define MK_STOP_AFTER 99
#endif

#define GAS __attribute__((address_space(1)))
#define LAS __attribute__((address_space(3)))
typedef unsigned short bf16;
typedef unsigned v4u __attribute__((ext_vector_type(4)));
typedef unsigned v2u __attribute__((ext_vector_type(2)));
typedef float f32x4 __attribute__((ext_vector_type(4)));
typedef float f32x2 __attribute__((ext_vector_type(2)));
typedef short bf16x8 __attribute__((ext_vector_type(8)));
#define LDS_WAIT() asm volatile("s_waitcnt lgkmcnt(0)" ::: "memory")
#define VM_WAIT() asm volatile("s_waitcnt vmcnt(0)" ::: "memory")

constexpr int NWAVES = 8, NT = NWAVES * 64;
constexpr int L = 16384, D = 2048, LC = 256, MROWS = L + LC;
constexpr int NIN = 6176, NINP = 6400;
constexpr int OFF_K = 0, OFF_V = 512, OFF_G = 1536, OFF_Q = 1568, OFF_O = 2080, OFF_HY = 3104;
constexpr int NH = 8, HYW = 1024, MVW = 1024;
constexpr int NE = 64, NE1 = 65, DE = 512;
constexpr int HALF_T = 8192;
constexpr int MAXROWS = 90112;
constexpr float EPS = 1e-6f;

constexpr size_t MiB = 1u << 20;
constexpr size_t WS_CTL = 0, CTL_ZERO_BYTES = 256 * 1024;
constexpr size_t WS_MOD = 1 * MiB;
constexpr size_t WS_POS = WS_MOD + 128 * 1024;
constexpr size_t WS_WR1 = 2 * MiB + 512 * 1024;
constexpr size_t WS_WR2 = WS_WR1 + 256 * 1024;
constexpr size_t WS_WIN = 3 * MiB;
constexpr size_t WS_WOUT = 28 * MiB;
constexpr size_t WS_W13 = 36 * MiB;
constexpr size_t WS_W2 = 296 * MiB;
constexpr size_t WS_HA = 426 * MiB;
constexpr size_t WS_Z = 491 * MiB;
constexpr size_t WS_CAT = 695 * MiB;
constexpr size_t WS_UIN = 759 * MiB;
constexpr size_t WS_KF = 823 * MiB;
constexpr size_t WS_KB = 887 * MiB;
constexpr size_t WS_CL = 426 * MiB;
constexpr size_t WS_CI = 951 * MiB;
constexpr size_t WS_Q = 983 * MiB;
constexpr size_t WS_K = 999 * MiB;
constexpr size_t WS_RTOK = 1015 * MiB;
constexpr size_t WS_RW = WS_RTOK + 2 * MAXROWS * 4;
constexpr size_t WS_AEXP = 1017 * MiB;
constexpr size_t WS_ARANK = WS_AEXP + 512 * 1024;
constexpr size_t WS_AW = WS_ARANK + 512 * 1024;
constexpr size_t WS_HDN = 1019 * MiB;
constexpr size_t WS_SC = 1021 * MiB;
constexpr size_t WS_NL = WS_SC + 32 * 1024;
constexpr size_t WS_NI = WS_NL + 640 * 1024;
constexpr size_t WS_MI = WS_NI + 640 * 1024;
constexpr size_t WS_END = 1023 * MiB;
constexpr size_t WS_HR = 491 * MiB;
constexpr size_t WS_Y2 = 579 * MiB;
static_assert(WS_Y2 + (size_t)MAXROWS * 2048 * 2 <= WS_CI, "overlay");
constexpr int CW_BAR = 4096;
constexpr int CW_CNT = 16384;

constexpr int RING_BYTES = 131072;
constexpr int LDSCTL_OFF = 147456;
constexpr int FFTSCR_OFF = LDSCTL_OFF + 1024;
constexpr int LDS_BYTES = 151552;

__device__ __forceinline__ unsigned cvt_pk_bf16(float lo, float hi) { unsigned r; asm volatile("v_cvt_pk_bf16_f32 %0, %1, %2" : "=v"(r) : "v"(lo), "v"(hi)); return r; }
__device__ __forceinline__ float bf2f(unsigned short b) { return __builtin_bit_cast(float, ((unsigned)b) << 16); }
__device__ __forceinline__ float bflo(unsigned u) { return __builtin_bit_cast(float, u << 16); }
__device__ __forceinline__ float bfhi(unsigned u) { return __builtin_bit_cast(float, u & 0xffff0000u); }
__device__ __forceinline__ float wave_sum(float v) {
#pragma unroll
    for (int o = 1; o < 64; o <<= 1) v += __shfl_xor(v, o);
    return v;
}
__device__ __forceinline__ float silu_f(float a) { return a / (1.f + __expf(-a)); }
__device__ __forceinline__ float sigmoid_f(float a) { return 1.f / (1.f + __expf(-a)); }

#define XB_TMO      128
#define XB_XCNT(j)  (256  + 64 * (j))
#define XB_XSUB(j)  (1280 + 64 * (j))
#define XB_XGEN(j)  (2304 + 64 * (j))
#define XB_TOP      3328
#define XB_TOPGEN   3392
#define XCD_BAR_WORDS 3456
#define XB_SPIN_CAP (1u << 18)

__device__ __forceinline__ unsigned xb_ld(unsigned* p)              { return __hip_atomic_load(p, __ATOMIC_RELAXED, __HIP_MEMORY_SCOPE_AGENT); }
__device__ __forceinline__ unsigned xb_add(unsigned* p, unsigned v) { return __hip_atomic_fetch_add(p, v, __ATOMIC_RELAXED, __HIP_MEMORY_SCOPE_AGENT); }
__device__ __forceinline__ unsigned xb_xcc_id() { return (unsigned)__builtin_amdgcn_s_getreg((3 << 11) | 20) & 0xFu; }
#define XB_SPIN(cond, bar) do { unsigned _sp = 0; while (cond) { __builtin_amdgcn_s_sleep(1); \
    if ((++_sp & 255u) == 0u) { if (xb_ld(&(bar)[XB_TMO])) break; if (_sp > XB_SPIN_CAP) { atomicAdd(&(bar)[XB_TMO], 1u); break; } } } } while (0)

struct XcdBarrier {
    unsigned* bar; unsigned x;
    volatile LAS unsigned* st;
};

__device__ __forceinline__ XcdBarrier xcd_barrier_post(unsigned* bar, volatile LAS unsigned* st) {
    XcdBarrier b; b.bar = bar; b.x = xb_xcc_id(); b.st = st;
    if (threadIdx.x == 0) (void)xb_add(&bar[XB_XCNT(b.x)], 1u);
    return b;
}
__device__ __forceinline__ void xcd_barrier_complete(unsigned* bar, unsigned x, unsigned& nloc, unsigned& nx) {
    const unsigned G = gridDim.x * gridDim.y * gridDim.z;
    unsigned sum, cnt, mine, sp = 0u;
    for (;;) {
        sum = 0u; cnt = 0u; mine = 0u;
#pragma unroll
        for (unsigned j = 0; j < 16; ++j) { const unsigned c = xb_ld(&bar[XB_XCNT(j)]); sum += c; cnt += (c > 0u) ? 1u : 0u; mine = (j == x) ? c : mine; }
        if (sum == G) break;
        __builtin_amdgcn_s_sleep(1);
        if ((++sp & 255u) == 0u) { if (xb_ld(&bar[XB_TMO])) break; if (sp > XB_SPIN_CAP) { atomicAdd(&bar[XB_TMO], 1u); break; } }
    }
    nloc = mine > 0u ? mine : 1u; nx = cnt > 0u ? cnt : 1u;
}

__device__ __forceinline__ void xcd_barrier(const XcdBarrier& b) {
    asm volatile("s_waitcnt vmcnt(0)" ::: "memory");
    __syncthreads();
    if (threadIdx.x == 0) {
        unsigned* bar = b.bar;
        __builtin_amdgcn_s_waitcnt(0);
        unsigned nloc = b.st[0], nx = b.st[1];
        if (nloc == 0u) { xcd_barrier_complete(bar, b.x, nloc, nx); b.st[0] = nloc; b.st[1] = nx; }
        const unsigned old = xb_add(&bar[XB_XSUB(b.x)], 1u);
        const unsigned gen = old / nloc;
        if (old + 1u == (gen + 1u) * nloc) {
            __builtin_amdgcn_fence(__ATOMIC_RELEASE, "agent");
            asm volatile("s_waitcnt vmcnt(0)" ::: "memory");
            const unsigned og = xb_add(&bar[XB_TOP], 1u);
            const unsigned tg = og / nx;
            if (og + 1u == (tg + 1u) * nx) xb_add(&bar[XB_TOPGEN], 1u);
            else XB_SPIN(xb_ld(&bar[XB_TOPGEN]) == tg, bar);
            __builtin_amdgcn_fence(__ATOMIC_ACQUIRE, "agent");
            xb_add(&bar[XB_XGEN(b.x)], 1u);
            asm volatile("s_waitcnt vmcnt(0)" ::: "memory");
        } else {
            XB_SPIN(xb_ld(&bar[XB_XGEN(b.x)]) == gen, bar);
            __builtin_amdgcn_fence(__ATOMIC_ACQUIRE, "agent");
            asm volatile("s_waitcnt vmcnt(0)" ::: "memory");
        }
    }
    __syncthreads();
}

namespace gk {
constexpr int BM = 256, BK = 64, HALF = 128, HTB = HALF * BK * 2, STAGE_BYTES = 8 * HTB, NXCD = 8, WGM = 8;
__host__ __device__ __forceinline__ int lds_byte(int r, int c) { const int st = (r >> 4) * 2 + (c >> 5), rr = r & 15, cc = c & 31, ob = rr * 64 + cc * 2; return st * 1024 + (ob ^ (((ob >> 9) & 1) << 5)); }
__host__ __device__ __forceinline__ void stage_rc(int b, int& R, int& C) { const int st = b / 1024, sb = b % 1024, swz = sb ^ (((sb >> 9) & 1) << 5); R = (st >> 1) * 16 + swz / 64; C = (st & 1) * 32 + (swz % 64) / 2; }
__host__ __device__ __forceinline__ int perm32(int rho) { const int n = rho >> 4, i = rho & 15; return 8 * (i >> 2) + 4 * n + (i & 3); }

struct Unit { int pm, pn, ex; };

template <class Epi, class Sched>
__device__ __forceinline__ void gemm_core(LAS unsigned char* lds, const char* Abase, const int K, const Sched& S, const Epi& E) {
    const int tid = threadIdx.x, wid = __builtin_amdgcn_readfirstlane(tid >> 6), lane = tid & 63, wr = wid >> 2, wc = wid & 3, fr = lane & 15, fq = lane >> 4;
    const int nt = K / BK;
    int RA[2], CA[2]; unsigned voffB[2];
#pragma unroll
    for (int i = 0; i < 2; ++i) { int R, C; stage_rc(tid * 16 + i * 8192, R, C); const int Rb = Epi::PERM ? ((R & ~31) + perm32(R & 31)) : R;
        RA[i] = R; CA[i] = C; voffB[i] = (unsigned)(Rb * K + C) * 2u; }
    const size_t kstep = (size_t)(BK * 2);
    const size_t hstepB = (size_t)HALF * K * 2;
    const unsigned ldsw = (unsigned)wid * 1024u;
    const int aoff = lds_byte(wr * 64 + fr, fq * 8), boff = lds_byte(wc * 32 + fr, fq * 8);
#define GK_SA(b, h) (((b) * 2 + (h)) * HTB)
#define GK_SB(b, h) ((4 + (b) * 2 + (h)) * HTB)
#define GK_STAGE(bufoff, gbase, v0, v1) do { \
        __builtin_amdgcn_global_load_lds((const unsigned*)((const char*)(gbase) + (v0)), (LAS unsigned*)(lds + (bufoff) + ldsw), 16, 0, 0); \
        __builtin_amdgcn_global_load_lds((const unsigned*)((const char*)(gbase) + (v1)), (LAS unsigned*)(lds + (bufoff) + ldsw + 8192), 16, 0, 0); } while (0)
#define GK_LDA(dst, b, h) do { _Pragma("unroll") for (int m = 0; m < 4; ++m) _Pragma("unroll") for (int k = 0; k < 2; ++k) dst[m][k] = *(const LAS bf16x8*)(lds + GK_SA(b, h) + aoff + m * 2048 + k * 1024); } while (0)
#define GK_LDB(dst, b, h) do { _Pragma("unroll") for (int n = 0; n < 2; ++n) _Pragma("unroll") for (int k = 0; k < 2; ++k) dst[n][k] = *(const LAS bf16x8*)(lds + GK_SB(b, h) + boff + n * 2048 + k * 1024); } while (0)
#define GK_MMA(ai, bj, At, Bt) do { __builtin_amdgcn_s_setprio(1); _Pragma("unroll") for (int m = 0; m < 4; ++m) _Pragma("unroll") for (int n = 0; n < 2; ++n) _Pragma("unroll") for (int k = 0; k < 2; ++k) \
        acc[ai][bj][m][n] = __builtin_amdgcn_mfma_f32_16x16x32_bf16(Bt[n][k], At[m][k], acc[ai][bj][m][n], 0, 0, 0); __builtin_amdgcn_s_setprio(0); } while (0)
#define GK_WAIT_V(n) asm volatile("s_waitcnt vmcnt(" #n ")" ::: "memory")
#define GK_WAIT_L(n) asm volatile("s_waitcnt lgkmcnt(" #n ")" ::: "memory")
#define GK_BAR __builtin_amdgcn_s_barrier()
#define GK_SCHED __builtin_amdgcn_sched_barrier(0)
    Unit cur, nxt; int ui = 0;
    if (!S.next(0, cur)) return;
    f32x4 acc[2][2][4][2];
#pragma unroll
    for (int a = 0; a < 2; ++a)
#pragma unroll
        for (int b = 0; b < 2; ++b)
#pragma unroll
            for (int m = 0; m < 4; ++m)
#pragma unroll
                for (int n = 0; n < 2; ++n) acc[a][b][m][n] = (f32x4){0.f, 0.f, 0.f, 0.f};
    bf16x8 At[4][2], B0[2][2], B1[2][2];
    unsigned c00, c01, c10, c11, n00, n01, n10, n11;
    S.a_offs(cur, RA, CA, c00, c01, c10, c11);
    asm volatile("" : "+v"(c00), "+v"(c01), "+v"(c10), "+v"(c11));
    const char* cB = S.b_base(cur);
    GK_STAGE(GK_SB(0, 0), cB, voffB[0], voffB[1]); GK_STAGE(GK_SB(0, 1), cB + hstepB, voffB[0], voffB[1]); GK_STAGE(GK_SA(0, 0), Abase, c00, c01); GK_STAGE(GK_SA(0, 1), Abase, c10, c11);
    if (wr == 1) GK_BAR;
    GK_WAIT_V(2); GK_BAR;
    GK_STAGE(GK_SB(1, 0), cB + kstep, voffB[0], voffB[1]); GK_STAGE(GK_SA(1, 0), Abase + kstep, c00, c01); GK_STAGE(GK_SB(1, 1), cB + hstepB + kstep, voffB[0], voffB[1]);
    GK_WAIT_V(6); GK_BAR;
    for (;;) {
        const bool has_next = S.next(ui + 1, nxt);
        const char* nB = cB;
        n00 = c00; n01 = c01; n10 = c10; n11 = c11;
        if (has_next) { S.a_offs(nxt, RA, CA, n00, n01, n10, n11); nB = S.b_base(nxt); }
        asm volatile("" : "+v"(n00), "+v"(n01), "+v"(n10), "+v"(n11));
        for (int t = 0; t < nt; t += 2) {
            const bool last = (t == nt - 2);
            const char* a1 = Abase + (size_t)(t + 1) * kstep;
            const char* a2 = last ? Abase : Abase + (size_t)(t + 2) * kstep; const char* b2 = last ? nB : cB + (size_t)(t + 2) * kstep;
            const char* a3 = a2 + kstep; const char* b3 = b2 + kstep;
            const unsigned x00 = last ? n00 : c00, x01 = last ? n01 : c01, x10 = last ? n10 : c10, x11 = last ? n11 : c11;
            GK_LDB(B0, 0, 0); GK_LDB(B1, 0, 1); GK_SCHED; GK_LDA(At, 0, 0); GK_STAGE(GK_SA(1, 1), a1, c10, c11);
            GK_WAIT_V(8); GK_WAIT_L(0); GK_BAR; GK_MMA(0, 0, At, B0); GK_MMA(0, 1, At, B1); GK_BAR; GK_SCHED;
            GK_LDA(At, 0, 1); GK_STAGE(GK_SB(0, 0), b2, voffB[0], voffB[1]); GK_STAGE(GK_SB(0, 1), b2 + hstepB, voffB[0], voffB[1]); GK_STAGE(GK_SA(0, 0), a2, x00, x01);
            GK_WAIT_V(8); GK_WAIT_L(0); GK_BAR; GK_MMA(1, 0, At, B0); GK_MMA(1, 1, At, B1); GK_BAR; GK_SCHED;
            GK_LDB(B0, 1, 0); GK_LDB(B1, 1, 1); GK_SCHED; GK_LDA(At, 1, 0); GK_STAGE(GK_SA(0, 1), a2, x10, x11);
            GK_WAIT_V(8); GK_WAIT_L(0); GK_BAR; GK_MMA(0, 0, At, B0); GK_MMA(0, 1, At, B1); GK_BAR; GK_SCHED;
            GK_LDA(At, 1, 1); GK_STAGE(GK_SB(1, 0), b3, voffB[0], voffB[1]); GK_STAGE(GK_SB(1, 1), b3 + hstepB, voffB[0], voffB[1]); GK_STAGE(GK_SA(1, 0), a3, x00, x01);
            GK_WAIT_V(8); GK_WAIT_L(0); GK_BAR; GK_MMA(1, 0, At, B0); GK_MMA(1, 1, At, B1); GK_BAR; GK_SCHED;
        }
        if (wr == 0) GK_BAR;
        E(acc, cur, wr, wc, fr, fq);
        if (!has_next) break;
#pragma unroll
        for (int a = 0; a < 2; ++a)
#pragma unroll
            for (int b = 0; b < 2; ++b)
#pragma unroll
                for (int m = 0; m < 4; ++m)
#pragma unroll
                    for (int n = 0; n < 2; ++n) acc[a][b][m][n] = (f32x4){0.f, 0.f, 0.f, 0.f};
        cur = nxt; cB = nB; c00 = n00; c01 = n01; c10 = n10; c11 = n11; ++ui;
        if (wr == 1) GK_BAR;
    }
    GK_WAIT_V(0);
    GK_BAR;
#undef GK_SA
#undef GK_SB
#undef GK_STAGE
#undef GK_LDA
#undef GK_LDB
#undef GK_MMA
#undef GK_WAIT_V
#undef GK_WAIT_L
#undef GK_BAR
#undef GK_SCHED
}

struct DenseOrder {
    int nM, nN, nwg, G, c, K;
    __device__ void init(int M, int N, int K_, int G_, int c_) { nM = M / BM; nN = N / BM; nwg = nM * nN; G = G_; c = c_; K = K_; }
    __device__ __forceinline__ bool next(int i, Unit& u) const {
        const long Lx = (long)i * G + c; if (Lx >= nwg) return false;
        int wgid = (int)Lx; { const int q = nwg / NXCD, r = nwg % NXCD, xcd = wgid % NXCD, off = wgid / NXCD; wgid = (xcd < r ? xcd * (q + 1) : r * (q + 1) + (xcd - r) * q) + off; }
        const int nig = WGM * nN, gid = wgid / nig, fm = gid * WGM, gsz = (nM - fm) < WGM ? (nM - fm) : WGM;
        u.pm = fm + ((wgid % nig) % gsz); u.pn = (wgid % nig) / gsz; u.ex = 0; return true;
    }
    const char* Bt;
    __device__ __forceinline__ void a_offs(const Unit& u, const int (&RA)[2], const int (&CA)[2], unsigned& o00, unsigned& o01, unsigned& o10, unsigned& o11) const {
        const unsigned r0 = (unsigned)(u.pm * BM);
        o00 = ((r0 + RA[0]) * (unsigned)K + CA[0]) * 2u; o01 = ((r0 + RA[1]) * (unsigned)K + CA[1]) * 2u;
        o10 = ((r0 + HALF + RA[0]) * (unsigned)K + CA[0]) * 2u; o11 = ((r0 + HALF + RA[1]) * (unsigned)K + CA[1]) * 2u;
    }
    __device__ __forceinline__ const char* b_base(const Unit& u) const { return Bt + (size_t)u.pn * BM * K * 2; }
};
template <int NPN, bool GATHER>
struct GroupOrder {
    int ntile, G, c, K;
    const LAS int* pstart;
    const int* rtok;
    const char* Bt; size_t bstride;
    __device__ __forceinline__ bool next(int i, Unit& u) const {
        const int x = c & 7, j = c >> 3, nj = G >> 3, T8 = (ntile + 7) >> 3, tlo = x * T8, thi = (tlo + T8) < ntile ? (tlo + T8) : ntile;
        const int Lx = i * nj + j, tl = Lx / NPN; if (tlo + tl >= thi) return false;
        u.pm = tlo + tl; u.pn = Lx % NPN;
        const int row = u.pm * BM; int lo = 0, hi = NE1;
        while (hi - lo > 1) { const int mid = (lo + hi) >> 1; if (pstart[mid] <= row) lo = mid; else hi = mid; }
        u.ex = lo; return true;
    }
    __device__ __forceinline__ void a_offs(const Unit& u, const int (&RA)[2], const int (&CA)[2], unsigned& o00, unsigned& o01, unsigned& o10, unsigned& o11) const {
        const int r0 = u.pm * BM;
        if (GATHER) {
            const int t00 = rtok[r0 + RA[0]], t01 = rtok[r0 + RA[1]], t10 = rtok[r0 + HALF + RA[0]], t11 = rtok[r0 + HALF + RA[1]];
            o00 = ((unsigned)t00 * (unsigned)K + CA[0]) * 2u; o01 = ((unsigned)t01 * (unsigned)K + CA[1]) * 2u;
            o10 = ((unsigned)t10 * (unsigned)K + CA[0]) * 2u; o11 = ((unsigned)t11 * (unsigned)K + CA[1]) * 2u;
        } else {
            o00 = ((unsigned)(r0 + RA[0]) * (unsigned)K + CA[0]) * 2u; o01 = ((unsigned)(r0 + RA[1]) * (unsigned)K + CA[1]) * 2u;
            o10 = ((unsigned)(r0 + HALF + RA[0]) * (unsigned)K + CA[0]) * 2u; o11 = ((unsigned)(r0 + HALF + RA[1]) * (unsigned)K + CA[1]) * 2u;
        }
    }
    __device__ __forceinline__ const char* b_base(const Unit& u) const { return Bt + (size_t)u.ex * bstride + (size_t)u.pn * BM * K * 2; }
};

struct EpiBf16Store {
    static constexpr bool PERM = true;
    bf16* O; int ldc;
    __device__ __forceinline__ void operator()(const f32x4 (&acc)[2][2][4][2], const Unit& u, int wr, int wc, int fr, int fq) const {
        const int row0 = u.pm * BM + wr * 64 + fr, col0 = u.pn * BM + wc * 32 + 8 * fq;
#pragma unroll
        for (int ai = 0; ai < 2; ++ai)
#pragma unroll
            for (int m = 0; m < 4; ++m) { bf16* rowp = O + (size_t)(row0 + ai * HALF + m * 16) * ldc + col0;
#pragma unroll
                for (int bj = 0; bj < 2; ++bj) { const f32x4 v0 = acc[ai][bj][m][0], v1 = acc[ai][bj][m][1];
                    v4u w; w.x = cvt_pk_bf16(v0[0], v0[1]); w.y = cvt_pk_bf16(v0[2], v0[3]); w.z = cvt_pk_bf16(v1[0], v1[1]); w.w = cvt_pk_bf16(v1[2], v1[3]);
                    *(v4u*)(rowp + bj * HALF) = w; } }
    }
};
struct EpiResidual {
    static constexpr bool PERM = false;
    float* X; int ldc; const float* gate;
    __device__ __forceinline__ void operator()(const f32x4 (&acc)[2][2][4][2], const Unit& u, int wr, int wc, int fr, int fq) const {
        const int row0 = u.pm * BM + wr * 64 + fr, col0 = u.pn * BM + wc * 32 + 4 * fq;
        f32x4 gv[2][2];
#pragma unroll
        for (int bj = 0; bj < 2; ++bj)
#pragma unroll
            for (int n = 0; n < 2; ++n) gv[bj][n] = *(const f32x4*)(gate + col0 + bj * HALF + n * 16);
#pragma unroll
        for (int ai = 0; ai < 2; ++ai)
#pragma unroll
            for (int m = 0; m < 4; ++m) { float* rowp = X + (size_t)(row0 + ai * HALF + m * 16) * ldc + col0;
#pragma unroll
                for (int bj = 0; bj < 2; ++bj)
#pragma unroll
                    for (int n = 0; n < 2; ++n) { f32x4* p = (f32x4*)(rowp + bj * HALF + n * 16); *p = *p + gv[bj][n] * acc[ai][bj][m][n]; } }
    }
};
struct EpiGateUp {
    static constexpr bool PERM = true;
    bf16* O;
    __device__ __forceinline__ void operator()(const f32x4 (&acc)[2][2][4][2], const Unit& u, int wr, int wc, int fr, int fq) const {
        const int row0 = u.pm * BM + wr * 64 + fr, col0 = u.pn * HALF + wc * 32 + 8 * fq;
#pragma unroll
        for (int ai = 0; ai < 2; ++ai)
#pragma unroll
            for (int m = 0; m < 4; ++m) { bf16* rowp = O + (size_t)(row0 + ai * HALF + m * 16) * DE + col0;
                float h[8];
#pragma unroll
                for (int n = 0; n < 2; ++n)
#pragma unroll
                    for (int j = 0; j < 4; ++j) { const float g = acc[ai][0][m][n][j], up = acc[ai][1][m][n][j]; h[n * 4 + j] = silu_f(g) * up; }
                v4u w; w.x = cvt_pk_bf16(h[0], h[1]); w.y = cvt_pk_bf16(h[2], h[3]); w.z = cvt_pk_bf16(h[4], h[5]); w.w = cvt_pk_bf16(h[6], h[7]);
                *(v4u*)rowp = w; }
    }
};
struct EpiDown {
    static constexpr bool PERM = true;
    bf16* O; const float* rw;
    __device__ __forceinline__ void operator()(const f32x4 (&acc)[2][2][4][2], const Unit& u, int wr, int wc, int fr, int fq) const {
        const int row0 = u.pm * BM + wr * 64 + fr, col0 = u.pn * BM + wc * 32 + 8 * fq;
#pragma unroll
        for (int ai = 0; ai < 2; ++ai)
#pragma unroll
            for (int m = 0; m < 4; ++m) { const int row = row0 + ai * HALF + m * 16; const float s = rw[row]; bf16* rowp = O + (size_t)row * D + col0;
#pragma unroll
                for (int bj = 0; bj < 2; ++bj) { const f32x4 v0 = acc[ai][bj][m][0] * s, v1 = acc[ai][bj][m][1] * s;
                    v4u w; w.x = cvt_pk_bf16(v0[0], v0[1]); w.y = cvt_pk_bf16(v0[2], v0[3]); w.z = cvt_pk_bf16(v1[0], v1[1]); w.w = cvt_pk_bf16(v1[2], v1[3]);
                    *(v4u*)(rowp + bj * HALF) = w; } }
    }
};
}

struct Args { const float* in[36]; float* out; unsigned char* ws; int ph_lo, ph_hi; };
struct Frame {
    LAS unsigned char* lds;
    int tid, lane, wave, bid, G;
    const float* const* in; float* out; unsigned char* ws;
};
#define IN_X 0
#define IN_C 1
#define IN_CTX 2
#define IN_CCTX 3
#define IN_WADA 4
#define IN_BADA 5
#define IN_GMIX 6
#define IN_GFFN 7
#define IN_WIN 8
#define IN_BGATES 9
#define IN_CKW 10
#define IN_CKB 11
#define IN_CQW 12
#define IN_CQB 13
#define IN_GHEAD 14
#define IN_CHW 15
#define IN_CHB 16
#define IN_FW1 17
#define IN_FB1 18
#define IN_FF1 19
#define IN_FW2 20
#define IN_FB2 21
#define IN_FF2 22
#define IN_FW3 23
#define IN_FB3 24
#define IN_DSKIP 25
#define IN_WOUT 26
#define IN_WR 27
#define IN_BR 28
#define IN_W1E 29
#define IN_W3E 30
#define IN_W2E 31
#define IN_W1S 32
#define IN_W3S 33
#define IN_W2S 34
#define IN_GFIN 35

__device__ __forceinline__ void transpose_item(const float* W, int N, int k0, int n0, bf16* WT, int dstK, int dst_row0, LAS float* scr, int lane) {
#pragma unroll 8
    for (int i = 0; i < 32; ++i) { const int kk = 2 * i + (lane >> 5); scr[kk * 33 + (lane & 31)] = W[(size_t)(k0 + kk) * N + n0 + (lane & 31)]; }
    LDS_WAIT(); asm volatile("" ::: "memory");
    const int c = lane & 7;
#pragma unroll
    for (int j = 0; j < 4; ++j) { const int n = (lane >> 3) + 8 * j; const LAS float* s = scr + (8 * c) * 33 + n;
        v4u o; o.x = cvt_pk_bf16(s[0 * 33], s[1 * 33]); o.y = cvt_pk_bf16(s[2 * 33], s[3 * 33]); o.z = cvt_pk_bf16(s[4 * 33], s[5 * 33]); o.w = cvt_pk_bf16(s[6 * 33], s[7 * 33]);
        *(v4u*)(WT + (size_t)(dst_row0 + n) * dstK + k0 + 8 * c) = o; }
    LDS_WAIT(); asm volatile("" ::: "memory");
}
__device__ __forceinline__ void p0_prologue(Frame& F) {
    const float* const* in = F.in;
    {
        LAS float* sv = (LAS float*)F.lds;
        LAS float* red = sv + 4096;
        float* mod = (float*)(F.ws + WS_MOD);
        for (int job = F.bid; job < 192; job += F.G) {
            for (int i = F.tid; i < 2048; i += NT) { sv[i] = silu_f(in[IN_C][i]); sv[2048 + i] = silu_f(in[IN_CCTX][i]); }
            __syncthreads();
            const int col = job * 64 + F.lane, r0 = F.wave * 256;
            const float* W = in[IN_WADA] + col;
            float a0 = 0.f, a1 = 0.f;
            for (int i = r0; i < r0 + 256; i += 8) {
                float w[8];
#pragma unroll
                for (int j = 0; j < 8; ++j) w[j] = W[(size_t)(i + j) * 12288];
#pragma unroll
                for (int j = 0; j < 8; ++j) { a0 += sv[i + j] * w[j]; a1 += sv[2048 + i + j] * w[j]; }
            }
            red[(F.wave * 64 + F.lane) * 2 + 0] = a0; red[(F.wave * 64 + F.lane) * 2 + 1] = a1;
            __syncthreads();
            if (F.wave == 0) { float s0 = 0.f, s1 = 0.f;
#pragma unroll
                for (int w = 0; w < 8; ++w) { s0 += red[(w * 64 + F.lane) * 2 + 0]; s1 += red[(w * 64 + F.lane) * 2 + 1]; }
                const float b = in[IN_BADA][col]; mod[col] = s0 + b; mod[12288 + col] = s1 + b; }
            __syncthreads();
        }
    }
    const int gt = F.bid * NT + F.tid, NGT = F.G * NT;
    {
        float* pos = (float*)(F.ws + WS_POS);
        for (int i = gt; i < 320 * 1024; i += NGT) { const int p = i >> 10, j = i & 1023, jj = j & 511;
            const float pp = (float)(p < 256 ? p : p - 256);
            const float omega = 1.0f / powf(10000.0f, (float)jj * (1.0f / 512.0f)); const float ang = pp * omega;
            pos[i] = j < 512 ? sinf(ang) : cosf(ang); }
    }
    {
        v4u* z = (v4u*)(F.ws + WS_WIN + (size_t)NIN * D * 2); const int nz = (NINP - NIN) * D * 2 / 16;
        for (int i = gt; i < nz; i += NGT) z[i] = (v4u){0u, 0u, 0u, 0u};
        int* rt = (int*)(F.ws + WS_RTOK); float* rw = (float*)(F.ws + WS_RW);
        for (int i = gt; i < 2 * MAXROWS; i += NGT) { rt[i] = 0; rw[i] = 0.f; }
    }
    {
        bf16* w1 = (bf16*)(F.ws + WS_WR1); bf16* w2 = (bf16*)(F.ws + WS_WR2);
        for (int i = gt; i < 64 * 2048; i += NGT) { const int e = i >> 11, k = i & 2047; const float w = in[IN_WR][k * 64 + e];
            const unsigned hi = cvt_pk_bf16(w, 0.f) & 0xffffu; const float r = w - bf2f((bf16)hi);
            w1[i] = (bf16)hi; w2[i] = (bf16)(cvt_pk_bf16(r, 0.f) & 0xffffu); }
    }
    {
        LAS float* scr = (LAS float*)(F.lds + F.wave * 16384);
        const int gw = F.bid * NWAVES + F.wave, NGW = F.G * NWAVES;
        constexpr int I_IN = 32 * 193, I_OUT = 32 * 64, I_E = 512 * NE1;
        constexpr int NITEMS = I_IN + I_OUT + 3 * I_E;
        for (int it = gw; it < NITEMS; it += NGW) {
            int r = it;
            if (r < I_IN) { const int kb = r / 193, nb = r % 193; transpose_item(in[IN_WIN], NIN, 64 * kb, 32 * nb, (bf16*)(F.ws + WS_WIN), D, 32 * nb, scr, F.lane); continue; } r -= I_IN;
            if (r < I_OUT) { const int kb = r / 64, nb = r % 64; transpose_item(in[IN_WOUT], D, 64 * kb, 32 * nb, (bf16*)(F.ws + WS_WOUT), D, 32 * nb, scr, F.lane); continue; } r -= I_OUT;
            if (r < 2 * I_E) { const int which = r >= I_E; if (which) r -= I_E;
                const int e = r / 512, rr = r % 512, kb = rr / 16, nb = rr % 16, n0 = 32 * nb;
                const float* src = e < NE ? in[which ? IN_W3E : IN_W1E] + (size_t)e * D * DE : in[which ? IN_W3S : IN_W1S];
                transpose_item(src, DE, 64 * kb, n0, (bf16*)(F.ws + WS_W13) + (size_t)e * 1024 * D, D, (n0 >> 7) * 256 + which * 128 + (n0 & 127), scr, F.lane); continue; }
            r -= 2 * I_E;
            { const int e = r / 512, rr = r % 512, kb = rr / 64, nb = rr % 64;
                const float* src = e < NE ? in[IN_W2E] + (size_t)e * DE * D : in[IN_W2S];
                transpose_item(src, D, 64 * kb, 32 * nb, (bf16*)(F.ws + WS_W2) + (size_t)e * D * DE, DE, 32 * nb, scr, F.lane); }
        }
    }
}

__device__ __forceinline__ void p1_norm1(Frame& F) {
    const float* const* in = F.in;
    const int gw = F.bid * NWAVES + F.wave, NGW = F.G * NWAVES;
    const float* mod = (const float*)(F.ws + WS_MOD); const float* pos = (const float*)(F.ws + WS_POS);
    bf16* hA = (bf16*)(F.ws + WS_HA);
    for (int row = gw; row < MROWS; row += NGW) {
        f32x4 v[8]; float ss = 0.f;
        const bool mainrow = row < L;
        const float* src = mainrow ? in[IN_X] + (size_t)row * D : in[IN_CTX] + (size_t)(row - L) * D;
        const float* md = mainrow ? mod : mod + 12288;
#pragma unroll
        for (int j = 0; j < 8; ++j) { const int col = 4 * F.lane + 256 * j; v[j] = *(const f32x4*)(src + col);
            if (mainrow) { const float* pp = col < 1024 ? pos + (size_t)(row >> 6) * 1024 + col : pos + (size_t)(256 + (row & 63)) * 1024 + (col - 1024);
                v[j] = v[j] + *(const f32x4*)pp; *(f32x4*)(F.out + (size_t)row * D + col) = v[j]; }
            ss += (v[j].x * v[j].x + v[j].y * v[j].y) + (v[j].z * v[j].z + v[j].w * v[j].w); }
        const float rstd = rsqrtf(wave_sum(ss) * (1.0f / D) + EPS);
#pragma unroll
        for (int j = 0; j < 8; ++j) { const int col = 4 * F.lane + 256 * j;
            const f32x4 g = *(const f32x4*)(in[IN_GMIX] + col), sh = *(const f32x4*)(md + col), sc = *(const f32x4*)(md + 2048 + col);
            const f32x4 h = (v[j] * rstd * g) * (sc + 1.0f) + sh;
            v2u o; o.x = cvt_pk_bf16(h.x, h.y); o.y = cvt_pk_bf16(h.z, h.w);
            *(v2u*)(hA + (size_t)row * D + col) = o; }
    }
}

constexpr int VT_PITCH = 136;
__device__ __forceinline__ float wave_incl_add(float x, int lane) {
#pragma unroll
    for (int o = 1; o < 64; o <<= 1) { const float y = __shfl_up(x, o); if (lane >= o) x += y; }
    return x;
}
__device__ __forceinline__ float wave_incl_max(float x, int lane) {
#pragma unroll
    for (int o = 1; o < 64; o <<= 1) { const float y = __shfl_up(x, o); if (lane >= o) x = fmaxf(x, y); }
    return x;
}
__device__ __forceinline__ void ml_gates(Frame& F, int dir, int h, int rowbase, LAS float* bb, LAS float* al, LAS float* mx, float& g, float& mtot) {
    const bf16* z = (const bf16*)(F.ws + WS_Z);
    const int lane = F.lane, pi0 = 2 * lane, p0 = dir ? 127 - pi0 : pi0, p1 = dir ? p0 - 1 : p0 + 1;
    const float bgi = F.in[IN_BGATES][dir * 16 + h], bgf = F.in[IN_BGATES][dir * 16 + 8 + h];
    const bf16* z0 = z + (size_t)(rowbase + p0) * NINP + OFF_G + dir * 16 + h; const bf16* z1 = z + (size_t)(rowbase + p1) * NINP + OFF_G + dir * 16 + h;
    const float i0 = bf2f(z0[0]) + bgi, f0 = bf2f(z0[8]) + bgf, i1 = bf2f(z1[0]) + bgi, f1 = bf2f(z1[8]) + bgf;
    const float l0 = fminf(f0, 0.f) - log1pf(__expf(-fabsf(f0))), l1 = fminf(f1, 0.f) - log1pf(__expf(-fabsf(f1)));
    const float incl = wave_incl_add(l0 + l1, lane);
    const float b1 = incl, b0 = incl - l1;
    const float a0 = i0 - b0, a1 = i1 - b1;
    const float mi = wave_incl_max(fmaxf(a0, a1), lane);
    float mprev = __shfl_up(mi, 1); if (lane == 0) mprev = -INFINITY;
    const float M0 = fmaxf(mprev, a0), M1 = mi;
    bb[p0] = b0; bb[p1] = b1; al[p0] = a0; al[p1] = a1; mx[p0] = M0; mx[p1] = M1;
    g = __shfl(incl, 63); mtot = __shfl(mi, 63);
}
__device__ __forceinline__ void ml_stage_vT(Frame& F, int h, int rowbase, LAS bf16* vT) {
    const bf16* z = (const bf16*)(F.ws + WS_Z);
    const int s = F.tid >> 2, eg = F.tid & 3;
#pragma unroll
    for (int i = 0; i < 4; ++i) { const int e0 = 32 * eg + 8 * i; const v4u v = *(const v4u*)(z + (size_t)(rowbase + s) * NINP + OFF_V + h * 128 + e0);
        const unsigned w[4] = {v.x, v.y, v.z, v.w};
#pragma unroll
        for (int q = 0; q < 4; ++q) { vT[(e0 + 2 * q) * VT_PITCH + s] = (bf16)(w[q] & 0xffffu); vT[(e0 + 2 * q + 1) * VT_PITCH + s] = (bf16)(w[q] >> 16); } }
}
__device__ __forceinline__ void ml_prep_item(Frame& F, int item) {
    const float* const* in = F.in;
    const int n = item >> 3, h = item & 7, tid = F.tid, lane = F.lane, wave = F.wave;
    const bool isctx = n >= 128;
    const int rowbase = isctx ? L + 128 * (n - 128) : 128 * n, seqlo = isctx ? L : 0, seqhi = isctx ? L + LC - 1 : L - 1;
    LAS bf16* vT = (LAS bf16*)F.lds;
    LAS bf16* kw0 = vT + 128 * VT_PITCH;
    LAS bf16* kw1 = kw0 + 64 * VT_PITCH;
    LAS float* fs = (LAS float*)(kw1 + 64 * VT_PITCH);
    const bf16* z = (const bf16*)(F.ws + WS_Z);
    if (wave < 2) { float g, mtot; LAS float* bbp = fs + 256 + wave * 384; ml_gates(F, wave, h, rowbase, bbp, bbp + 128, bbp + 256, g, mtot);
        LDS_WAIT();
        fs[wave * 128 + 2 * lane] = __expf(bbp[128 + 2 * lane] - mtot); fs[wave * 128 + 2 * lane + 1] = __expf(bbp[128 + 2 * lane + 1] - mtot);
        if (lane == 0) { float* sc = (float*)(F.ws + WS_SC) + ((size_t)(wave * 8 + h) * 130 + n) * 2; sc[0] = g; sc[1] = g + mtot; } }
    ml_stage_vT(F, h, rowbase, vT);
    __syncthreads();
    {
        const int s = tid >> 2, d0 = (tid & 3) * 16, R = rowbase + s; const bool hp = R > seqlo, hn = R < seqhi;
        float kv[16], qv[16];
#pragma unroll
        for (int part = 0; part < 2; ++part) {
            const int zc = (part ? OFF_Q : OFF_K) + h * 64 + d0; const float* cw = in[part ? IN_CQW : IN_CKW] + h * 64 + d0; const float* cb = in[part ? IN_CQB : IN_CKB] + h * 64 + d0;
#pragma unroll
            for (int hv = 0; hv < 2; ++hv) {
                const v4u c = *(const v4u*)(z + (size_t)R * NINP + zc + 8 * hv);
                const v4u p = hp ? *(const v4u*)(z + (size_t)(R - 1) * NINP + zc + 8 * hv) : (v4u){0u, 0u, 0u, 0u};
                const v4u nx = hn ? *(const v4u*)(z + (size_t)(R + 1) * NINP + zc + 8 * hv) : (v4u){0u, 0u, 0u, 0u};
                const unsigned cc[4] = {c.x, c.y, c.z, c.w}, pp[4] = {p.x, p.y, p.z, p.w}, nn[4] = {nx.x, nx.y, nx.z, nx.w};
#pragma unroll
                for (int q = 0; q < 4; ++q) { const int d = 8 * hv + 2 * q;
                    const float v0 = silu_f(bflo(pp[q]) * cw[d] + bflo(cc[q]) * cw[512 + d] + bflo(nn[q]) * cw[1024 + d] + cb[d]);
                    const float v1 = silu_f(bfhi(pp[q]) * cw[d + 1] + bfhi(cc[q]) * cw[512 + d + 1] + bfhi(nn[q]) * cw[1024 + d + 1] + cb[d + 1]);
                    if (part) { qv[d] = v0 * 0.125f; qv[d + 1] = v1 * 0.125f; } else { kv[d] = v0; kv[d + 1] = v1; } }
            }
        }
        if (!isctx) {
            bf16* Qg = (bf16*)(F.ws + WS_Q) + ((size_t)h * L + R) * 64 + d0; bf16* Kg = (bf16*)(F.ws + WS_K) + ((size_t)h * L + R) * 64 + d0;
#pragma unroll
            for (int hv = 0; hv < 2; ++hv) { v4u w;
                w.x = cvt_pk_bf16(qv[8 * hv], qv[8 * hv + 1]); w.y = cvt_pk_bf16(qv[8 * hv + 2], qv[8 * hv + 3]); w.z = cvt_pk_bf16(qv[8 * hv + 4], qv[8 * hv + 5]); w.w = cvt_pk_bf16(qv[8 * hv + 6], qv[8 * hv + 7]); *(v4u*)(Qg + 8 * hv) = w;
                w.x = cvt_pk_bf16(kv[8 * hv], kv[8 * hv + 1]); w.y = cvt_pk_bf16(kv[8 * hv + 2], kv[8 * hv + 3]); w.z = cvt_pk_bf16(kv[8 * hv + 4], kv[8 * hv + 5]); w.w = cvt_pk_bf16(kv[8 * hv + 6], kv[8 * hv + 7]); *(v4u*)(Kg + 8 * hv) = w; }
        }
        const float w0 = fs[s], w1 = fs[128 + s];
#pragma unroll
        for (int d = 0; d < 16; ++d) { const float kr = bf2f((bf16)(cvt_pk_bf16(kv[d], 0.f) & 0xffffu));
            kw0[(d0 + d) * VT_PITCH + s] = (bf16)(cvt_pk_bf16(kr * w0, 0.f) & 0xffffu); kw1[(d0 + d) * VT_PITCH + s] = (bf16)(cvt_pk_bf16(kr * w1, 0.f) & 0xffffu); }
    }
    __syncthreads();
    {
        const int fr = lane & 15, fq = lane >> 4;
        bf16x8 a[4];
#pragma unroll
        for (int kk = 0; kk < 4; ++kk) a[kk] = *(const LAS bf16x8*)(vT + (16 * wave + fr) * VT_PITCH + 32 * kk + 8 * fq);
#pragma unroll
        for (int dir = 0; dir < 2; ++dir) { const LAS bf16* kw = dir ? kw1 : kw0;
            float* cl = (float*)(F.ws + WS_CL) + ((size_t)((dir * 8 + h) * 130 + n)) * 8192;
#pragma unroll
            for (int dt = 0; dt < 4; ++dt) { f32x4 acc = (f32x4){0.f, 0.f, 0.f, 0.f};
#pragma unroll
                for (int kk = 0; kk < 4; ++kk) { const bf16x8 b = *(const LAS bf16x8*)(kw + (16 * dt + fr) * VT_PITCH + 32 * kk + 8 * fq); acc = __builtin_amdgcn_mfma_f32_16x16x32_bf16(a[kk], b, acc, 0, 0, 0); }
#pragma unroll
                for (int r = 0; r < 4; ++r) cl[(16 * wave + 4 * fq + r) * 64 + 16 * dt + fr] = acc[r]; } }
        if (tid < 128) { const int dir = tid >> 6, d = tid & 63; const LAS bf16* kw = (dir ? kw1 : kw0) + d * VT_PITCH; float s = 0.f;
            for (int i = 0; i < 128; ++i) s += bf2f(kw[i]);
            ((float*)(F.ws + WS_NL))[((size_t)((dir * 8 + h) * 130 + n)) * 64 + d] = s; }
    }
    __syncthreads();
}
__device__ __forceinline__ int ml_order(int dir, int step) { return step < 2 ? (dir ? 129 - step : 128 + step) : (dir ? 129 - step : step - 2); }
__device__ __forceinline__ void ml_scan(Frame& F) {
    const float* CL = (const float*)(F.ws + WS_CL); const float* SC = (const float*)(F.ws + WS_SC); const float* NLp = (const float*)(F.ws + WS_NL);
    bf16* CI = (bf16*)(F.ws + WS_CI); float* NI = (float*)(F.ws + WS_NI); float* MI = (float*)(F.ws + WS_MI);
    for (int idx = F.bid * NT + F.tid; idx < 16 * 8192; idx += F.G * NT) {
        const int dh = idx >> 13, rem = idx & 8191, dir = dh >> 3; const bool don = rem < 64;
        float c = 0.f, nn = 0.f, m = 0.f;
        for (int s0 = 0; s0 < 130; s0 += 10) {
            float cl[10], nl[10], gg[10], ml[10];
#pragma unroll
            for (int i = 0; i < 10; ++i) { const int ch = ml_order(dir, s0 + i); cl[i] = CL[((size_t)(dh * 130 + ch)) * 8192 + rem]; gg[i] = SC[(dh * 130 + ch) * 2]; ml[i] = SC[(dh * 130 + ch) * 2 + 1];
                nl[i] = don ? NLp[(size_t)(dh * 130 + ch) * 64 + rem] : 0.f; }
#pragma unroll
            for (int i = 0; i < 10; ++i) { const int ch = ml_order(dir, s0 + i);
                if (ch < 128) { CI[((size_t)(dh * 128 + ch)) * 8192 + rem] = (bf16)(cvt_pk_bf16(c, 0.f) & 0xffffu); if (don) NI[(size_t)(dh * 128 + ch) * 64 + rem] = nn; if (rem == 0) MI[dh * 128 + ch] = m; }
                const float mn = fmaxf(gg[i] + m, ml[i]), sp = __expf(gg[i] + m - mn), sl = __expf(ml[i] - mn);
                c = sp * c + sl * cl[i]; nn = sp * nn + sl * nl[i]; m = mn; }
        }
    }
}
__device__ __forceinline__ void ml_out_item(Frame& F, int item) {
    const float* const* in = F.in;
    const int n = item >> 3, h = item & 7, tid = F.tid, lane = F.lane, wave = F.wave, fr = lane & 15, fq = lane >> 4;
    const int rowbase = 128 * n;
    LAS bf16* vT = (LAS bf16*)F.lds;
    LAS float* fs = (LAS float*)(vT + 128 * VT_PITCH);
    const bf16* z = (const bf16*)(F.ws + WS_Z);
    if (wave < 2) { float g, mtot; LAS float* bbp = fs + wave * 384; ml_gates(F, wave, h, rowbase, bbp, bbp + 128, bbp + 256, g, mtot);
        if (lane == 0) fs[768 + wave] = ((const float*)(F.ws + WS_MI))[(wave * 8 + h) * 128 + n]; }
    ml_stage_vT(F, h, rowbase, vT);
    __syncthreads();
    const bf16* Qg = (const bf16*)(F.ws + WS_Q) + ((size_t)h * L + rowbase) * 64; const bf16* Kg = (const bf16*)(F.ws + WS_K) + ((size_t)h * L + rowbase) * 64;
    const int tl = 16 * wave + fr;
    bf16x8 qf[2];
#pragma unroll
    for (int kk = 0; kk < 2; ++kk) qf[kk] = *(const bf16x8*)(Qg + (size_t)tl * 64 + 32 * kk + 8 * fq);
    f32x4 st[8];
#pragma unroll
    for (int j = 0; j < 8; ++j) { f32x4 acc = (f32x4){0.f, 0.f, 0.f, 0.f};
#pragma unroll
        for (int kk = 0; kk < 2; ++kk) { const bf16x8 kf = *(const bf16x8*)(Kg + (size_t)(16 * j + fr) * 64 + 32 * kk + 8 * fq); acc = __builtin_amdgcn_mfma_f32_16x16x32_bf16(kf, qf[kk], acc, 0, 0, 0); }
        st[j] = acc; }
    f32x4 hs[8];
#pragma unroll
    for (int et = 0; et < 8; ++et) hs[et] = (f32x4){0.f, 0.f, 0.f, 0.f};
#pragma unroll 1
    for (int dir = 0; dir < 2; ++dir) {
        const LAS float* bbp = fs + dir * 384; const LAS float* alp = bbp + 128; const LAS float* mxp = bbp + 256;
        const float m_in = fs[768 + dir];
        const float beta = fmaxf(m_in, mxp[tl]);
        const int dh = dir * 8 + h;
        bf16x8 pf[4]; float dsum = 0.f;
#pragma unroll
        for (int kk = 0; kk < 4; ++kk) { float pv[8];
#pragma unroll
            for (int hh = 0; hh < 2; ++hh)
#pragma unroll
                for (int r = 0; r < 4; ++r) { const int s = 32 * kk + 16 * hh + 4 * fq + r; const bool ok = dir ? (s >= tl) : (s <= tl);
                    const float e = __expf(fminf(alp[s] - beta, 0.f)); const float v = ok ? st[2 * kk + hh][r] * e : 0.f; pv[4 * hh + r] = v; dsum += v; }
            pf[kk] = __builtin_bit_cast(bf16x8, (v4u){cvt_pk_bf16(pv[0], pv[1]), cvt_pk_bf16(pv[2], pv[3]), cvt_pk_bf16(pv[4], pv[5]), cvt_pk_bf16(pv[6], pv[7])}); }
        dsum += __shfl_xor(dsum, 16); dsum += __shfl_xor(dsum, 32);
        const float* nip = (const float*)(F.ws + WS_NI) + (size_t)(dh * 128 + n) * 64; float qn = 0.f;
#pragma unroll
        for (int kk = 0; kk < 2; ++kk) { const v4u qq = __builtin_bit_cast(v4u, qf[kk]); const unsigned w[4] = {qq.x, qq.y, qq.z, qq.w};
#pragma unroll
            for (int q = 0; q < 4; ++q) { const int d = 32 * kk + 8 * fq + 2 * q; qn += bflo(w[q]) * nip[d] + bfhi(w[q]) * nip[d + 1]; } }
        qn += __shfl_xor(qn, 16); qn += __shfl_xor(qn, 32);
        const float sc_t = __expf(m_in - beta);
        const float den = dsum + sc_t * qn, dn = fmaxf(fabsf(den), __expf(-(bbp[tl] + beta)));
        LAS float* xinv = fs + 772 + (wave * 2 + dir) * 32;
        if (fq == 0) { xinv[fr] = 1.0f / dn; xinv[16 + fr] = sc_t; }
        LDS_WAIT();
        float inv_r[4], sc_r[4];
#pragma unroll
        for (int r = 0; r < 4; ++r) { inv_r[r] = xinv[4 * fq + r]; sc_r[r] = xinv[16 + 4 * fq + r]; }
        const bf16* cip = (const bf16*)(F.ws + WS_CI) + (size_t)(dh * 128 + n) * 8192;
#pragma unroll
        for (int et = 0; et < 8; ++et) {
            f32x4 acc = (f32x4){0.f, 0.f, 0.f, 0.f}, acci = (f32x4){0.f, 0.f, 0.f, 0.f};
#pragma unroll
            for (int kk = 0; kk < 4; ++kk) {
                const bool live = dir ? (2 * kk + 1 >= wave) : (2 * kk <= wave);
                if (live) { const LAS bf16* vr = vT + (16 * et + fr) * VT_PITCH + 32 * kk + 4 * fq;
                    const v2u lo = *(const LAS v2u*)vr, hi = *(const LAS v2u*)(vr + 16);
                    const bf16x8 vb = __builtin_bit_cast(bf16x8, (v4u){lo.x, lo.y, hi.x, hi.y});
                    acc = __builtin_amdgcn_mfma_f32_16x16x32_bf16(pf[kk], vb, acc, 0, 0, 0); } }
#pragma unroll
            for (int kk = 0; kk < 2; ++kk) { const bf16x8 cb = *(const bf16x8*)(cip + (size_t)(16 * et + fr) * 64 + 32 * kk + 8 * fq); acci = __builtin_amdgcn_mfma_f32_16x16x32_bf16(qf[kk], cb, acci, 0, 0, 0); }
#pragma unroll
            for (int r = 0; r < 4; ++r) hs[et][r] += (acc[r] + sc_r[r] * acci[r]) * inv_r[r];
        }
    }
    float rs[4];
#pragma unroll
    for (int r = 0; r < 4; ++r) { float ss = 0.f;
#pragma unroll
        for (int et = 0; et < 8; ++et) ss += hs[et][r] * hs[et][r];
        ss += __shfl_xor(ss, 1); ss += __shfl_xor(ss, 2); ss += __shfl_xor(ss, 4); ss += __shfl_xor(ss, 8);
        rs[r] = rsqrtf(ss * (1.0f / 128.0f) + EPS); }
    bf16* cat = (bf16*)(F.ws + WS_CAT);
#pragma unroll
    for (int et = 0; et < 8; ++et) { const int col = h * 128 + 16 * et + fr; const float gh = in[IN_GHEAD][col];
#pragma unroll
        for (int r = 0; r < 4; ++r) { const int t = rowbase + 16 * wave + 4 * fq + r;
            const float o = hs[et][r] * rs[r] * gh * sigmoid_f(bf2f(z[(size_t)t * NINP + OFF_O + col]));
            cat[(size_t)t * D + col] = (bf16)(cvt_pk_bf16(o, 0.f) & 0xffffu); } }
    __syncthreads();
}

__device__ __forceinline__ void p3_filter_tile(Frame& F, int tile) {
    const float* const* in = F.in;
    const int tid = F.tid;
    LAS float* feat = (LAS float*)F.lds;
    LAS float* h1 = feat + 64 * 36;
    LAS float* h2 = h1 + 64 * 65;
    LAS float* w1s = h2 + 64 * 64;
    LAS float* w2s = w1s + 33 * 64;
    for (int i = tid; i < 33 * 64; i += NT) w1s[i] = in[IN_FW1][i];
    for (int i = tid; i < 64 * 64; i += NT) w2s[i] = in[IN_FW2][i];
    {
        const int tt = tid >> 3, sub = tid & 7; const float t = (float)(tile * 64 + tt);
        const float w = (6.2831855f * t) / (float)L;
        if (sub == 0) feat[tt * 36] = t / (float)(L - 1);
#pragma unroll
        for (int q = 0; q < 2; ++q) { const int bi = sub * 2 + q; const float band = 1e-4f + (float)bi * ((15.0f - 1e-4f) / 15.0f); const float ang = w * band;
            feat[tt * 36 + 1 + bi] = cosf(ang); feat[tt * 36 + 17 + bi] = -sinf(ang); }
    }
    __syncthreads();
    {
        const int tt = tid >> 3, j0 = (tid & 7) * 8;
        float a[8];
#pragma unroll
        for (int q = 0; q < 8; ++q) a[q] = in[IN_FB1][j0 + q];
#pragma unroll 1
        for (int i = 0; i < 33; ++i) { const float f = feat[tt * 36 + i];
#pragma unroll
            for (int q = 0; q < 8; ++q) a[q] += f * w1s[i * 64 + j0 + q]; }
#pragma unroll
        for (int q = 0; q < 8; ++q) h1[tt * 65 + j0 + q] = sinf(in[IN_FF1][j0 + q] * a[q]);
    }
    __syncthreads();
    {
        const int tt = tid >> 3, j0 = (tid & 7) * 8;
        float a[8];
#pragma unroll
        for (int q = 0; q < 8; ++q) a[q] = in[IN_FB2][j0 + q];
#pragma unroll 1
        for (int i = 0; i < 64; ++i) { const float f = h1[tt * 65 + i];
#pragma unroll
            for (int q = 0; q < 8; ++q) a[q] += f * w2s[i * 64 + j0 + q]; }
#pragma unroll
        for (int q = 0; q < 8; ++q) h2[tt * 64 + j0 + q] = sinf(in[IN_FF2][j0 + q] * a[q]);
    }
    __syncthreads();
    {
        bf16* hd = (bf16*)(F.ws + WS_HDN);
        for (int i = tid; i < 64 * 32; i += NT) { const int tt = i >> 5, j = (i & 31) * 2; *(unsigned*)(hd + (size_t)(tile * 64 + tt) * 64 + j) = cvt_pk_bf16(h2[tt * 64 + j], h2[tt * 64 + j + 1]); }
    }
    __syncthreads();
}
__device__ __forceinline__ void p3_uin_tile(Frame& F, int tile) {
    const float* const* in = F.in;
    const bf16* z = (const bf16*)(F.ws + WS_Z); float* uT = (float*)(F.ws + WS_UIN);
    LAS float* tl = (LAS float*)F.lds;
    const int t0 = (tile >> 2) * 64, cb = (tile & 3) * 256;
    const int cg = F.tid & 31, c0 = cb + cg * 8, rsub = F.tid >> 5;
    for (int pass = 0; pass < 4; ++pass) {
        const int tt = pass * 16 + rsub, t = t0 + tt;
        float r1[8], r2[8];
#pragma unroll
        for (int part = 0; part < 2; ++part) {
            const int zc = OFF_HY + 1024 * (part + 1) + c0, wc = 1024 * (part + 1) + c0;
            const v4u cur = *(const v4u*)(z + (size_t)t * NINP + zc);
            const v4u prv = t > 0 ? *(const v4u*)(z + (size_t)(t - 1) * NINP + zc) : (v4u){0u, 0u, 0u, 0u};
            const v4u nxt = t < L - 1 ? *(const v4u*)(z + (size_t)(t + 1) * NINP + zc) : (v4u){0u, 0u, 0u, 0u};
            float* rr = part ? r2 : r1;
#pragma unroll
            for (int q = 0; q < 4; ++q) {
                const unsigned pc = q == 0 ? prv.x : q == 1 ? prv.y : q == 2 ? prv.z : prv.w, cc = q == 0 ? cur.x : q == 1 ? cur.y : q == 2 ? cur.z : cur.w, nc = q == 0 ? nxt.x : q == 1 ? nxt.y : q == 2 ? nxt.z : nxt.w;
                const int ch = wc + 2 * q;
                rr[2 * q] = bflo(pc) * in[IN_CHW][ch] + bflo(cc) * in[IN_CHW][3072 + ch] + bflo(nc) * in[IN_CHW][6144 + ch] + in[IN_CHB][ch];
                rr[2 * q + 1] = bfhi(pc) * in[IN_CHW][ch + 1] + bfhi(cc) * in[IN_CHW][3072 + ch + 1] + bfhi(nc) * in[IN_CHW][6144 + ch + 1] + in[IN_CHB][ch + 1];
            }
        }
#pragma unroll
        for (int q = 0; q < 8; ++q) tl[(cg * 8 + q) * 65 + tt] = r1[q] * r2[q];
    }
    __syncthreads();
    for (int i = F.tid; i < 256 * 16; i += NT) { const int c = i >> 4, tq = (i & 15) * 4; const LAS float* s = tl + c * 65 + tq;
        *(f32x4*)(uT + (size_t)(cb + c) * L + t0 + tq) = (f32x4){s[0], s[1], s[2], s[3]}; }
    __syncthreads();
}

#ifndef FFT_LAS
#define FFT_LAS LAS
#endif
#if defined(__HIP_DEVICE_COMPILE__)
#define FFT_OPAQUE(v) asm volatile("" : "+v"(v))
#else
#define FFT_OPAQUE(v)
#endif
constexpr int FN = 16384;
constexpr int FFT_SLOTS = 18432;
__host__ __device__ __forceinline__ int fphys(int p) { return p + (p >> 3); }
__host__ __device__ __forceinline__ float fcos32(int k) {
    constexpr float T[16] = {1.0f, 0.98078528040323043f, 0.92387953251128674f, 0.83146961230254524f, 0.70710678118654752f, 0.55557023301960218f, 0.38268343236508977f, 0.19509032201612825f,
                             0.0f, -0.19509032201612825f, -0.38268343236508977f, -0.55557023301960218f, -0.70710678118654752f, -0.83146961230254524f, -0.92387953251128674f, -0.98078528040323043f};
    return T[k]; }
__host__ __device__ __forceinline__ float fsin32(int k) {
    constexpr float T[16] = {0.0f, 0.19509032201612825f, 0.38268343236508977f, 0.55557023301960218f, 0.70710678118654752f, 0.83146961230254524f, 0.92387953251128674f, 0.98078528040323043f,
                             1.0f, 0.98078528040323043f, 0.92387953251128674f, 0.83146961230254524f, 0.70710678118654752f, 0.55557023301960218f, 0.38268343236508977f, 0.19509032201612825f};
    return T[k]; }
template <int R> __host__ __device__ __forceinline__ constexpr int fbrev(int x) { int r = 0; for (int b = 1; b < R; b <<= 1) { r = (r << 1) | (x & 1); x >>= 1; } return r; }
__host__ __device__ __forceinline__ f32x2 cx_rot_m(f32x2 d) { return (f32x2){d.y, -d.x}; }
__host__ __device__ __forceinline__ f32x2 cx_rot_p(f32x2 d) { return (f32x2){-d.y, d.x}; }
__host__ __device__ __forceinline__ f32x2 cx_mul_cj(f32x2 d, float c, float s) { return d * c + cx_rot_m(d) * s; }
__host__ __device__ __forceinline__ f32x2 cx_mul(f32x2 d, float c, float s) { return d * c + cx_rot_p(d) * s; }
template <int R, bool INV>
__host__ __device__ __forceinline__ void fft_reg(f32x2 (&x)[R]) {
#pragma unroll
    for (int len = R; len >= 2; len >>= 1) {
        const int half = len >> 1;
#pragma unroll
        for (int blk = 0; blk < R; blk += len)
#pragma unroll
            for (int k = 0; k < half; ++k) {
                const int i0 = blk + k, i1 = i0 + half;
                const f32x2 a = x[i0], b = x[i1];
                x[i0] = a + b;
                const f32x2 d = a - b;
                if (k == 0) x[i1] = d;
                else if (4 * k == len) x[i1] = INV ? cx_rot_p(d) : cx_rot_m(d);
                else { const float c = fcos32(k * (32 / len)), s = fsin32(k * (32 / len)); x[i1] = INV ? cx_mul(d, c, s) : cx_mul_cj(d, c, s); }
            }
    }
}
__host__ __device__ __forceinline__ void ftw(int num, int den, float& c, float& s) {
#if defined(__HIP_DEVICE_COMPILE__)
    const float fr = (float)num * (1.0f / (float)den); c = __builtin_amdgcn_cosf(fr); s = __builtin_amdgcn_sinf(fr);
#else
    const double a = 6.283185307179586476925 * (double)num / (double)den; c = (float)cos(a); s = (float)sin(a);
#endif
}
template <int R, int M>
__host__ __device__ __forceinline__ void fft_fwd_bfly(FFT_LAS float* buf, int B, int j) {
    constexpr int S = M / R, PS = S == 1 ? 1 : S + S / 8;
    FFT_LAS f32x2* p = (FFT_LAS f32x2*)buf + fphys(B + j);
    f32x2 x[R];
#pragma unroll
    for (int q = 0; q < R; ++q) x[q] = p[q * PS];
    fft_reg<R, false>(x);
    if (S > 1) { float c1, s1; ftw(j, M, c1, s1); f32x2 w = (f32x2){c1, -s1};
#pragma unroll
        for (int r = 1; r < R; ++r) { const int ix = fbrev<R>(r); x[ix] = cx_mul(x[ix], w.x, w.y); w = cx_mul_cj(w, c1, s1); } }
#pragma unroll
    for (int r = 0; r < R; ++r) p[r * PS] = x[fbrev<R>(r)];
}
template <int R, int M>
__host__ __device__ __forceinline__ void fft_inv_bfly(FFT_LAS float* buf, int B, int j) {
    constexpr int S = M / R, PS = S == 1 ? 1 : S + S / 8;
    FFT_LAS f32x2* p = (FFT_LAS f32x2*)buf + fphys(B + j);
    f32x2 x[R];
#pragma unroll
    for (int r = 0; r < R; ++r) x[r] = p[r * PS];
    if (S > 1) { float c1, s1; ftw(j, M, c1, s1); f32x2 w = (f32x2){c1, s1};
#pragma unroll
        for (int r = 1; r < R; ++r) { x[r] = cx_mul(x[r], w.x, w.y); w = cx_mul(w, c1, s1); } }
    fft_reg<R, true>(x);
#pragma unroll
    for (int q = 0; q < R; ++q) p[q * PS] = x[fbrev<R>(q)];
}
__host__ __device__ __forceinline__ void fft_fwd_pass(FFT_LAS float* buf, int pass, int tid) {
    FFT_OPAQUE(tid);
    if (pass == 0) {
#pragma unroll 1
        for (int i = 0; i < 2; ++i) fft_fwd_bfly<16, 16384>(buf, 0, tid + 512 * i); }
    else if (pass == 1) {
#pragma unroll 1
        for (int i = 0; i < 2; ++i) { const int id = tid + 512 * i; fft_fwd_bfly<16, 1024>(buf, (id >> 6) * 1024, id & 63); } }
    else if (pass == 2) {
#pragma unroll 1
        for (int i = 0; i < 4; ++i) { const int id = tid + 512 * i; fft_fwd_bfly<8, 64>(buf, (id >> 3) * 64, id & 7); } }
    else {
#pragma unroll 1
        for (int i = 0; i < 4; ++i) { const int id = tid + 512 * i; fft_fwd_bfly<8, 8>(buf, id * 8, 0); } }
}
__host__ __device__ __forceinline__ void fft_inv_pass(FFT_LAS float* buf, int pass, int tid) {
    FFT_OPAQUE(tid);
    if (pass == 0) {
#pragma unroll 1
        for (int i = 0; i < 4; ++i) { const int id = tid + 512 * i; fft_inv_bfly<8, 8>(buf, id * 8, 0); } }
    else if (pass == 1) {
#pragma unroll 1
        for (int i = 0; i < 4; ++i) { const int id = tid + 512 * i; fft_inv_bfly<8, 64>(buf, (id >> 3) * 64, id & 7); } }
    else if (pass == 2) {
#pragma unroll 1
        for (int i = 0; i < 2; ++i) { const int id = tid + 512 * i; fft_inv_bfly<16, 1024>(buf, (id >> 6) * 1024, id & 63); } }
    else {
#pragma unroll 1
        for (int i = 0; i < 2; ++i) fft_inv_bfly<16, 16384>(buf, 0, tid + 512 * i); }
}
__host__ __device__ __forceinline__ int fpos(int k) { return ((k & 15) << 10) | (((k >> 4) & 15) << 6) | (((k >> 8) & 7) << 3) | (k >> 11); }
__host__ __device__ __forceinline__ void fft_mul_one(FFT_LAS float* buf, int k, float cr, float ci, float dr_, float di_, float wc, float ws) {
    const int k2 = (FN - k) & (FN - 1);
    FFT_LAS f32x2* pa = (FFT_LAS f32x2*)(buf + 2 * fphys(fpos(k))); FFT_LAS f32x2* pb = (FFT_LAS f32x2*)(buf + 2 * fphys(fpos(k2)));
    const f32x2 A = *pa, Bm = *pb;
    const float ar = A.x, ai = A.y, br = Bm.x, bi = -Bm.y, dr = dr_, di = -di_;
    const float uer = 0.5f * (ar + br), uei = 0.5f * (ai + bi), uor = 0.5f * (ai - bi), uoi = -0.5f * (ar - br);
    const float ker = 0.5f * (cr + dr), kei = 0.5f * (ci + di), kor = 0.5f * (ci - di), koi = -0.5f * (cr - dr);
    const float pr = uor * kor - uoi * koi, pi = uor * koi + uoi * kor;
    const float yer = (uer * ker - uei * kei) + (pr * wc + pi * ws), yei = (uer * kei + uei * ker) + (pi * wc - pr * ws);
    const float yor = (uer * kor - uei * koi) + (uor * ker - uoi * kei), yoi = (uer * koi + uei * kor) + (uor * kei + uoi * ker);
    *pa = (f32x2){yer - yoi, yei + yor};
    *pb = (f32x2){yer + yoi, -yei + yor};
}
__device__ __forceinline__ void p4_fft_job(Frame& F, int job) {
    const float* const* in = F.in;
    int tid_ = F.tid, lane_ = F.lane; FFT_OPAQUE(tid_); FFT_OPAQUE(lane_);
    const int tid = tid_, lane = lane_, wave = F.wave, c0 = job * 4;
    LAS float* buf = (LAS float*)F.lds;
    LAS float* scr = (LAS float*)(F.lds + FFTSCR_OFF);
    float* hfT = (float*)(F.ws + WS_KF); float* hbT = (float*)(F.ws + WS_KB); const float* uT = (const float*)(F.ws + WS_UIN);
    {
        const bf16* hd = (const bf16*)(F.ws + WS_HDN);
        const int n = lane & 15, kq = lane >> 4, ch = (n >> 1) & 3, dir = n & 1, col = dir * 1024 + c0 + ch; const bool valid = n < 8;
        bf16x8 bfr[2];
#pragma unroll
        for (int ks = 0; ks < 2; ++ks) { unsigned w[4];
#pragma unroll
            for (int j = 0; j < 4; ++j) { const int k = ks * 32 + kq * 8 + 2 * j; const float a = valid ? in[IN_FW3][(size_t)k * 2048 + col] : 0.f, b = valid ? in[IN_FW3][(size_t)(k + 1) * 2048 + col] : 0.f; w[j] = cvt_pk_bf16(a, b); }
            bfr[ks] = __builtin_bit_cast(bf16x8, (v4u){w[0], w[1], w[2], w[3]}); }
        const float b3 = valid ? in[IN_FB3][col] : 0.f;
        const float r_slow = 3.0701134573253945f, r_fast = 15.350567286626972f;
        const float rate = r_slow + (float)(c0 + ch) * ((r_fast - r_slow) / 1023.0f);
        const float nrl = -rate * (1.4426950408889634f / (float)(L - 1));
        float asum = 0.f; float* dst = (dir ? hbT : hfT) + (size_t)(c0 + ch) * L;
#pragma unroll 1
        for (int tb = wave * 8; tb < L / 16; tb += NWAVES * 8) {
            bf16x8 a0[8], a1[8];
#pragma unroll
            for (int i = 0; i < 8; ++i) { const bf16* hp = hd + (size_t)((tb + i) * 16 + n) * 64 + kq * 8; a0[i] = *(const bf16x8*)hp; a1[i] = *(const bf16x8*)(hp + 32); }
#pragma unroll
            for (int i = 0; i < 8; ++i) { const int t0 = (tb + i) * 16;
                f32x4 acc = (f32x4){b3, b3, b3, b3};
                acc = __builtin_amdgcn_mfma_f32_16x16x32_bf16(a0[i], bfr[0], acc, 0, 0, 0);
                acc = __builtin_amdgcn_mfma_f32_16x16x32_bf16(a1[i], bfr[1], acc, 0, 0, 0);
                if (valid) { f32x4 o;
#pragma unroll
                    for (int r = 0; r < 4; ++r) { const int t = t0 + 4 * kq + r; const float v = acc[r] * __builtin_amdgcn_exp2f((float)t * nrl); o[r] = v; if (!(dir && t == 0)) asum += fabsf(v); }
                    *(f32x4*)(dst + t0 + 4 * kq) = o; } }
        }
        asum += __shfl_xor(asum, 16); asum += __shfl_xor(asum, 32);
        if (lane < 8) scr[wave * 8 + lane] = asum;
        VM_WAIT(); __syncthreads();
        float tot = 0.f;
        if (tid < 4) { for (int w = 0; w < 8; ++w) tot += scr[w * 8 + 2 * tid] + scr[w * 8 + 2 * tid + 1]; }
        __syncthreads();
        if (tid < 4) scr[tid] = 1.0f / (tot * (float)FN);
        __syncthreads();
    }
#pragma unroll 1
    for (int ch = 0; ch < 4; ++ch) {
        const int c = c0 + ch;
        const float* hf = hfT + (size_t)c * L; const float* hb = hbT + (size_t)c * L; const float* uc = uT + (size_t)c * L;
#pragma unroll 8
        for (int i = 0; i < 16; ++i) { const int a = tid + NT * i; const f32x2 v = *(const f32x2*)(hf + 2 * a); *(LAS f32x2*)(buf + 2 * fphys(a)) = v; }
#pragma unroll 8
        for (int i = 0; i < 16; ++i) { const int a = FN / 2 + tid + NT * i; const float ko = hb[2 * FN - 2 * a - 1]; float ke = hb[2 * FN - 2 * a]; if (a == FN / 2) ke = 0.f;
            *(LAS f32x2*)(buf + 2 * fphys(a)) = (f32x2){ke, ko}; }
        __syncthreads();
        fft_fwd_pass(buf, 0, tid); __syncthreads(); fft_fwd_pass(buf, 1, tid); __syncthreads(); fft_fwd_pass(buf, 2, tid); __syncthreads(); fft_fwd_pass(buf, 3, tid); __syncthreads();
        {
            int tq = tid; FFT_OPAQUE(tq);
            f32x2* sa = (f32x2*)(hfT + (size_t)c * L); f32x2* sb = (f32x2*)(hbT + (size_t)c * L);
#pragma unroll 4
            for (int m = 0; m < 16; ++m) { const int k = tq + 512 * m, k2 = (FN - k) & (FN - 1);
                sa[m * 512 + tq] = *(const LAS f32x2*)(buf + 2 * fphys(fpos(k))); sb[m * 512 + tq] = *(const LAS f32x2*)(buf + 2 * fphys(fpos(k2))); }
            if (tid == 0) { const f32x2 h = *(const LAS f32x2*)(buf + 2 * fphys(fpos(FN / 2))); scr[8] = h.x; scr[9] = h.y; }
        }
        __syncthreads();
#pragma unroll 8
        for (int i = 0; i < 16; ++i) { const int a = tid + NT * i; const f32x2 v = *(const f32x2*)(uc + 2 * a); *(LAS f32x2*)(buf + 2 * fphys(a)) = v; }
#pragma unroll 4
        for (int i = 0; i < 16; ++i) { const int a = FN / 2 + tid + NT * i; *(LAS f32x2*)(buf + 2 * fphys(a)) = (f32x2){0.f, 0.f}; }
        __syncthreads();
        fft_fwd_pass(buf, 0, tid); __syncthreads(); fft_fwd_pass(buf, 1, tid); __syncthreads(); fft_fwd_pass(buf, 2, tid); __syncthreads(); fft_fwd_pass(buf, 3, tid); __syncthreads();
        {   int tq = tid; FFT_OPAQUE(tq);
            const f32x2* sa = (const f32x2*)(hfT + (size_t)c * L); const f32x2* sb = (const f32x2*)(hbT + (size_t)c * L);
            float c1, s1; ftw(tq, FN, c1, s1);
#pragma unroll 8
            for (int m = 0; m < 16; ++m) { const float cm = fcos32(m), sm = fsin32(m); const float wc = c1 * cm - s1 * sm, ws = s1 * cm + c1 * sm;
                const f32x2 ka = sa[m * 512 + tq], kb = sb[m * 512 + tq];
                fft_mul_one(buf, tq + 512 * m, ka.x, ka.y, kb.x, kb.y, wc, ws); }
            if (tid == 0) fft_mul_one(buf, FN / 2, scr[8], scr[9], scr[8], scr[9], -1.0f, 0.0f);
        }
        VM_WAIT(); __syncthreads();
        fft_inv_pass(buf, 0, tid); __syncthreads(); fft_inv_pass(buf, 1, tid); __syncthreads(); fft_inv_pass(buf, 2, tid); __syncthreads(); fft_inv_pass(buf, 3, tid); __syncthreads();
        { const float sc = scr[ch]; float* yT = hfT + (size_t)c * L;
#pragma unroll 2
            for (int nn = tid; nn < FN / 2; nn += NT) { const f32x2 v = *(const LAS f32x2*)(buf + 2 * fphys(nn)); *(f32x2*)(yT + 2 * nn) = (f32x2){v.x * sc, v.y * sc}; } }
        __syncthreads();
    }
    __syncthreads();
}
__device__ __forceinline__ void p5_hy_finish_tile(Frame& F, int tile) {
    const float* const* in = F.in;
    const int tid = F.tid, t0 = (tile >> 2) * 64, cb = (tile & 3) * 256;
    const float* yT = (const float*)(F.ws + WS_KF); const float* uT = (const float*)(F.ws + WS_UIN);
    const bf16* z = (const bf16*)(F.ws + WS_Z); bf16* cat = (bf16*)(F.ws + WS_CAT);
    LAS float* tl = (LAS float*)F.lds;
#pragma unroll 4
    for (int i = tid; i < 4096; i += NT) { const int c = i >> 4, tq = (i & 15) * 4;
        const f32x4 y4 = *(const f32x4*)(yT + (size_t)(cb + c) * L + t0 + tq), u4 = *(const f32x4*)(uT + (size_t)(cb + c) * L + t0 + tq);
        const float d = in[IN_DSKIP][cb + c]; LAS float* s = tl + c * 65 + tq;
        s[0] = y4.x + d * u4.x; s[1] = y4.y + d * u4.y; s[2] = y4.z + d * u4.z; s[3] = y4.w + d * u4.w; }
    __syncthreads();
    const int t = tid & 63, cg = tid >> 6, T = t0 + t, c0 = cb + 32 * cg;
    const bool hp = T > 0, hn = T < L - 1;
#pragma unroll 1
    for (int q = 0; q < 4; ++q) { const int c = c0 + 8 * q;
        const v4u zc = *(const v4u*)(z + (size_t)T * NINP + OFF_HY + c);
        const v4u zp = hp ? *(const v4u*)(z + (size_t)(T - 1) * NINP + OFF_HY + c) : (v4u){0u, 0u, 0u, 0u};
        const v4u zn = hn ? *(const v4u*)(z + (size_t)(T + 1) * NINP + OFF_HY + c) : (v4u){0u, 0u, 0u, 0u};
        const unsigned cc[4] = {zc.x, zc.y, zc.z, zc.w}, pp[4] = {zp.x, zp.y, zp.z, zp.w}, nn[4] = {zn.x, zn.y, zn.z, zn.w};
        float o[8];
#pragma unroll
        for (int k = 0; k < 4; ++k) { const int ch = c + 2 * k; const LAS float* s = tl + (32 * cg + 8 * q + 2 * k) * 65 + t;
            o[2 * k] = (bflo(pp[k]) * in[IN_CHW][ch] + bflo(cc[k]) * in[IN_CHW][3072 + ch] + bflo(nn[k]) * in[IN_CHW][6144 + ch] + in[IN_CHB][ch]) * s[0];
            o[2 * k + 1] = (bfhi(pp[k]) * in[IN_CHW][ch + 1] + bfhi(cc[k]) * in[IN_CHW][3072 + ch + 1] + bfhi(nn[k]) * in[IN_CHW][6144 + ch + 1] + in[IN_CHB][ch + 1]) * s[65]; }
        v4u w; w.x = cvt_pk_bf16(o[0], o[1]); w.y = cvt_pk_bf16(o[2], o[3]); w.z = cvt_pk_bf16(o[4], o[5]); w.w = cvt_pk_bf16(o[6], o[7]);
        *(v4u*)(cat + (size_t)T * D + MVW + c) = w; }
    __syncthreads();
}

constexpr int RT_PITCH = 2056;
__device__ __forceinline__ void p6_norm2_router(Frame& F) {
    const float* const* in = F.in;
    const float* mod = (const float*)(F.ws + WS_MOD);
    bf16* h2g = (bf16*)(F.ws + WS_HA);
    int* cnt = (int*)(F.ws + WS_CTL) + CW_CNT;
    int* aexp = (int*)(F.ws + WS_AEXP); int* arank = (int*)(F.ws + WS_ARANK); float* aw = (float*)(F.ws + WS_AW);
    LAS bf16* h1 = (LAS bf16*)F.lds; LAS bf16* h2 = h1 + 16 * RT_PITCH;
    LAS float* part = (LAS float*)(h2 + 16 * RT_PITCH);
    const bf16* w1 = (const bf16*)(F.ws + WS_WR1); const bf16* w2 = (const bf16*)(F.ws + WS_WR2);
    const int lane = F.lane, wave = F.wave, fr = lane & 15, fq = lane >> 4;
    for (int t0 = F.bid * 16; t0 < L; t0 += F.G * 16) {
#pragma unroll 1
        for (int rr = 0; rr < 2; ++rr) {
            const int tr = 2 * wave + rr, t = t0 + tr;
            f32x4 v[8]; float ss = 0.f;
#pragma unroll
            for (int j = 0; j < 8; ++j) { const int col = 4 * lane + 256 * j; v[j] = *(const f32x4*)(F.out + (size_t)t * D + col); ss += (v[j].x * v[j].x + v[j].y * v[j].y) + (v[j].z * v[j].z + v[j].w * v[j].w); }
            const float rstd = rsqrtf(wave_sum(ss) * (1.0f / D) + EPS);
#pragma unroll
            for (int j = 0; j < 8; ++j) { const int col = 4 * lane + 256 * j;
                const f32x4 g = *(const f32x4*)(in[IN_GFFN] + col), sh = *(const f32x4*)(mod + 6144 + col), sc = *(const f32x4*)(mod + 8192 + col);
                const f32x4 h = (v[j] * rstd * g) * (sc + 1.0f) + sh;
                v2u o; o.x = cvt_pk_bf16(h.x, h.y); o.y = cvt_pk_bf16(h.z, h.w);
                *(v2u*)(h2g + (size_t)t * D + col) = o;
                *(LAS v2u*)(h1 + tr * RT_PITCH + col) = o;
                v2u lo; lo.x = cvt_pk_bf16(h.x - bflo(o.x), h.y - bfhi(o.x)); lo.y = cvt_pk_bf16(h.z - bflo(o.y), h.w - bfhi(o.y));
                *(LAS v2u*)(h2 + tr * RT_PITCH + col) = lo; }
        }
        __syncthreads();
        {
            const int nt = wave & 3, kh = wave >> 2;
            f32x4 acc = (f32x4){0.f, 0.f, 0.f, 0.f};
            const bf16* b1p = w1 + (size_t)(16 * nt + fr) * 2048 + kh * 1024 + 8 * fq; const bf16* b2p = w2 + (size_t)(16 * nt + fr) * 2048 + kh * 1024 + 8 * fq;
            const LAS bf16* a1p = h1 + fr * RT_PITCH + kh * 1024 + 8 * fq; const LAS bf16* a2p = h2 + fr * RT_PITCH + kh * 1024 + 8 * fq;
#pragma unroll 8
            for (int ks = 0; ks < 32; ++ks) {
                const bf16x8 a1 = *(const LAS bf16x8*)(a1p + 32 * ks), a2 = *(const LAS bf16x8*)(a2p + 32 * ks);
                const bf16x8 b1 = *(const bf16x8*)(b1p + 32 * ks), b2 = *(const bf16x8*)(b2p + 32 * ks);
                acc = __builtin_amdgcn_mfma_f32_16x16x32_bf16(a2, b1, acc, 0, 0, 0);
                acc = __builtin_amdgcn_mfma_f32_16x16x32_bf16(a1, b2, acc, 0, 0, 0);
                acc = __builtin_amdgcn_mfma_f32_16x16x32_bf16(a1, b1, acc, 0, 0, 0); }
#pragma unroll
            for (int r = 0; r < 4; ++r) part[(kh * 16 + 4 * fq + r) * 64 + 16 * nt + fr] = acc[r];
        }
        __syncthreads();
#pragma unroll 1
        for (int rr = 0; rr < 2; ++rr) {
            const int tr = 2 * wave + rr, t = t0 + tr;
            const float logit = part[tr * 64 + lane] + part[(16 + tr) * 64 + lane];
            const float s = 1.0f / (1.0f + expf(-logit)), sel = s + in[IN_BR][lane];
            const int grp = lane >> 3;
            float m1 = sel; m1 = fmaxf(m1, __shfl_xor(m1, 1)); m1 = fmaxf(m1, __shfl_xor(m1, 2)); m1 = fmaxf(m1, __shfl_xor(m1, 4));
            const unsigned long long gm = 0xFFull << (8 * grp);
            const unsigned long long b1 = __ballot(sel == m1) & gm;
            const int first = __ffsll((long long)b1) - 1;
            float m2 = (lane == first) ? -INFINITY : sel; m2 = fmaxf(m2, __shfl_xor(m2, 1)); m2 = fmaxf(m2, __shfl_xor(m2, 2)); m2 = fmaxf(m2, __shfl_xor(m2, 4));
            const float gs = m1 + m2;
            int grank = 0;
#pragma unroll
            for (int g = 0; g < 8; ++g) { const float og = __shfl(gs, 8 * g); grank += (og > gs || (og == gs && g < grp)) ? 1 : 0; }
            const float masked = grank < 4 ? sel : -INFINITY;
            int rank = 0;
            for (int e2 = 0; e2 < 64; ++e2) { const float om = __shfl(masked, e2); rank += (om > masked || (om == masked && e2 < lane)) ? 1 : 0; }
            const bool chosen = rank < 8;
            const float wsum = wave_sum(chosen ? s : 0.f);
            const unsigned long long cb = __ballot(chosen);
            if (chosen) {
                const int k = (int)__builtin_amdgcn_mbcnt_hi((unsigned)(cb >> 32), __builtin_amdgcn_mbcnt_lo((unsigned)cb, 0u));
                const int half = t >= HALF_T ? 1 : 0;
                const int r = atomicAdd(cnt + half * 64 + lane, 1);
                aexp[t * 8 + k] = lane; arank[t * 8 + k] = r; aw[t * 8 + k] = s / wsum * 2.5f;
            }
        }
        __syncthreads();
    }
}
__device__ __forceinline__ void build_pstart(Frame& F) {
    LAS int* ps = (LAS int*)(F.lds + LDSCTL_OFF);
    const int* cnt = (const int*)(F.ws + WS_CTL) + CW_CNT;
    __syncthreads();
    if (F.tid < 2) { int a = 0;
        for (int e = 0; e < NE; ++e) { ps[F.tid * 66 + e] = a; a += (__hip_atomic_load(cnt + F.tid * 64 + e, __ATOMIC_RELAXED, __HIP_MEMORY_SCOPE_AGENT) + 255) & ~255; }
        ps[F.tid * 66 + 64] = a; ps[F.tid * 66 + 65] = a + HALF_T; }
    __syncthreads();
}
__device__ __forceinline__ void p7_fill_rows(Frame& F) {
    build_pstart(F);
    const LAS int* ps = (const LAS int*)(F.lds + LDSCTL_OFF);
    const int* aexp = (const int*)(F.ws + WS_AEXP); const int* arank = (const int*)(F.ws + WS_ARANK); const float* aw = (const float*)(F.ws + WS_AW);
    int* rt = (int*)(F.ws + WS_RTOK); float* rw = (float*)(F.ws + WS_RW);
    const int gt = F.bid * NT + F.tid, NGT = F.G * NT;
    for (int i = gt; i < L * 8; i += NGT) { const int t = i >> 3, h = t >= HALF_T ? 1 : 0; const int row = ps[h * 66 + aexp[i]] + arank[i];
        rt[h * MAXROWS + row] = t; rw[h * MAXROWS + row] = aw[i]; }
    for (int t = gt; t < L; t += NGT) { const int h = t >= HALF_T ? 1 : 0; const int row = ps[h * 66 + 64] + (t - h * HALF_T);
        rt[h * MAXROWS + row] = t; rw[h * MAXROWS + row] = 1.0f; }
}
__device__ __forceinline__ void moe_combine(Frame& F, int half) {
    const float* const* in = F.in;
    const LAS int* ps = (const LAS int*)(F.lds + LDSCTL_OFF) + half * 66;
    const float* mod = (const float*)(F.ws + WS_MOD);
    const int* aexp = (const int*)(F.ws + WS_AEXP); const int* arank = (const int*)(F.ws + WS_ARANK); const float* aw = (const float*)(F.ws + WS_AW);
    const bf16* Y2 = (const bf16*)(F.ws + WS_Y2);
    const int gw = F.bid * NWAVES + F.wave, NGW = F.G * NWAVES, lane = F.lane;
    for (int tt = gw; tt < HALF_T; tt += NGW) {
        const int t = half * HALF_T + tt;
        float a[32];
#pragma unroll
        for (int i = 0; i < 32; ++i) a[i] = 0.f;
#pragma unroll 3
        for (int k = 0; k < 9; ++k) {
            const int row = k < 8 ? ps[aexp[t * 8 + k]] + arank[t * 8 + k] : ps[64] + tt;
            const float wk = k < 8 ? aw[t * 8 + k] : 1.0f;
            const bf16* yr = Y2 + (size_t)row * D + 8 * lane;
#pragma unroll
            for (int j = 0; j < 4; ++j) { const v4u y = *(const v4u*)(yr + 512 * j);
                a[8 * j + 0] += wk * bflo(y.x); a[8 * j + 1] += wk * bfhi(y.x); a[8 * j + 2] += wk * bflo(y.y); a[8 * j + 3] += wk * bfhi(y.y);
                a[8 * j + 4] += wk * bflo(y.z); a[8 * j + 5] += wk * bfhi(y.z); a[8 * j + 6] += wk * bflo(y.w); a[8 * j + 7] += wk * bfhi(y.w); }
        }
        float ss = 0.f;
#pragma unroll
        for (int j = 0; j < 4; ++j)
#pragma unroll
            for (int q = 0; q < 2; ++q) { const int col = 8 * lane + 512 * j + 4 * q;
                const f32x4 x1 = *(const f32x4*)(F.out + (size_t)t * D + col), g2 = *(const f32x4*)(mod + 10240 + col);
                const int i = 8 * j + 4 * q;
                a[i] = x1.x + g2.x * a[i]; a[i + 1] = x1.y + g2.y * a[i + 1]; a[i + 2] = x1.z + g2.z * a[i + 2]; a[i + 3] = x1.w + g2.w * a[i + 3];
                ss += (a[i] * a[i] + a[i + 1] * a[i + 1]) + (a[i + 2] * a[i + 2] + a[i + 3] * a[i + 3]); }
        const float rstd = rsqrtf(wave_sum(ss) * (1.0f / D) + EPS);
#pragma unroll
        for (int j = 0; j < 4; ++j)
#pragma unroll
            for (int q = 0; q < 2; ++q) { const int col = 8 * lane + 512 * j + 4 * q; const int i = 8 * j + 4 * q;
                const f32x4 gf = *(const f32x4*)(in[IN_GFIN] + col);
                *(f32x4*)(F.out + (size_t)t * D + col) = (f32x4){a[i] * rstd * gf.x, a[i + 1] * rstd * gf.y, a[i + 2] * rstd * gf.z, a[i + 3] * rstd * gf.w}; }
    }
}

constexpr int N_PHASES = 14;
__global__ void __launch_bounds__(NT, 2) fwd_kernel(Args args) {
    extern __shared__ __attribute__((aligned(16))) unsigned char lds_raw[];
    Frame F;
    F.lds = (LAS unsigned char*)lds_raw;
    F.tid = threadIdx.x; F.lane = F.tid & 63; F.wave = __builtin_amdgcn_readfirstlane(F.tid >> 6);
    F.bid = blockIdx.x; F.G = gridDim.x;
    F.in = args.in; F.out = args.out; F.ws = args.ws;
    volatile LAS unsigned* MISC = (volatile LAS unsigned*)(F.lds + LDSCTL_OFF + 768);
    if (F.tid < 64) ((LAS unsigned*)(F.lds + LDSCTL_OFF))[F.tid + 192] = 0u;
    __syncthreads();
    unsigned* ctl = (unsigned*)(F.ws + WS_CTL);
    const int lo = args.ph_lo, hi = args.ph_hi;
    XcdBarrier bar; bar.bar = ctl + CW_BAR; bar.x = 0; bar.st = nullptr;
    if (hi - lo > 1) bar = xcd_barrier_post(ctl + CW_BAR, MISC + 8);
#ifndef PH_MASK
#define PH_MASK 0xFFFF
#endif
#define IN(k) (((PH_MASK >> (k)) & 1) && lo <= (k) && (k) < hi)
#define SEAM(k) do { if (IN(k) && IN((k) + 1)) xcd_barrier(bar); } while (0)
#define REP(k) for (int rep_ = 0; rep_ < ((PROBE_DUP) == (k) ? 2 : 1); ++rep_) if ((rep_ ? __syncthreads() : (void)0), true)
    LAS int* ps = (LAS int*)(F.lds + LDSCTL_OFF);

    if (IN(0)) REP(0) { p0_prologue(F); } SEAM(0);
    if (IN(1)) REP(1) { p1_norm1(F); } SEAM(1);
    if (IN(2)) {
        gk::DenseOrder S; S.init(MROWS, NINP, D, F.G, F.bid); S.Bt = (const char*)(F.ws + WS_WIN);
        gk::EpiBf16Store E{(bf16*)(F.ws + WS_Z), NINP};
        gk::gemm_core(F.lds, (const char*)(F.ws + WS_HA), D, S, E);
    }
#if PROBE_DUP == 2
    if (IN(2)) { __syncthreads(); } if (IN(2)) {
        gk::DenseOrder S; S.init(MROWS, NINP, D, F.G, F.bid); S.Bt = (const char*)(F.ws + WS_WIN);
        gk::EpiBf16Store E{(bf16*)(F.ws + WS_Z), NINP};
        gk::gemm_core(F.lds, (const char*)(F.ws + WS_HA), D, S, E);
    }
#endif
    SEAM(2);
    if (IN(3)) REP(3) {
        for (int it = F.bid; it < 1040; it += F.G) ml_prep_item(F, it);
        for (int tile = F.bid; tile < 256; tile += F.G) p3_filter_tile(F, tile);
        for (int tile = F.bid; tile < 1024; tile += F.G) p3_uin_tile(F, tile);
    } SEAM(3);
    if (IN(4)) REP(4) {
        ml_scan(F);
        __syncthreads();
        for (int job = F.bid; job < 256; job += F.G) p4_fft_job(F, job);
    } SEAM(4);
    if (IN(5)) REP(5) {
        for (int it = F.bid; it < 1024; it += F.G) ml_out_item(F, it);
        for (int tile = F.bid; tile < 1024; tile += F.G) p5_hy_finish_tile(F, tile);
    } SEAM(5);
    if (IN(6)) {
        gk::DenseOrder S; S.init(L, D, D, F.G, F.bid); S.Bt = (const char*)(F.ws + WS_WOUT);
        gk::EpiResidual E{F.out, D, (const float*)(F.ws + WS_MOD) + 4096};
        gk::gemm_core(F.lds, (const char*)(F.ws + WS_CAT), D, S, E);
    } SEAM(6);
    if (IN(7)) { p6_norm2_router(F); } SEAM(7);
    if (IN(8)) { p7_fill_rows(F); } SEAM(8);
#define MOE_GU(h) do { build_pstart(F); \
        gk::GroupOrder<4, true> S; S.ntile = ps[(h) * 66 + 65] >> 8; S.G = F.G; S.c = F.bid; S.K = D; S.pstart = ps + (h) * 66; S.rtok = (const int*)(F.ws + WS_RTOK) + (h) * MAXROWS; \
        S.Bt = (const char*)(F.ws + WS_W13); S.bstride = (size_t)1024 * D * 2; \
        gk::EpiGateUp E{(bf16*)(F.ws + WS_HR)}; \
        gk::gemm_core(F.lds, (const char*)(F.ws + WS_HA), D, S, E); } while (0)
#define MOE_DN(h) do { build_pstart(F); \
        gk::GroupOrder<8, false> S; S.ntile = ps[(h) * 66 + 65] >> 8; S.G = F.G; S.c = F.bid; S.K = DE; S.pstart = ps + (h) * 66; S.rtok = nullptr; \
        S.Bt = (const char*)(F.ws + WS_W2); S.bstride = (size_t)D * DE * 2; \
        gk::EpiBf16Store E{(bf16*)(F.ws + WS_Y2), D}; \
        gk::gemm_core(F.lds, (const char*)(F.ws + WS_HR), DE, S, E); } while (0)
    if (IN(9)) REP(9) { MOE_GU(0); } SEAM(9);
    if (IN(10)) REP(10) { MOE_DN(0); } SEAM(10);
    if (IN(11)) { MOE_GU(1); moe_combine(F, 0); } SEAM(11);
    if (IN(12)) REP(12) { MOE_DN(1); } SEAM(12);
    if (IN(13)) { build_pstart(F); moe_combine(F, 1); }
#undef IN
#undef SEAM
}

extern "C" void kernel_launch(void* const* d_in, const int* in_sizes, int n_in, void* d_out, int out_size, void* d_ws, size_t ws_size, hipStream_t stream) {
    static int grid = 0;
    if (grid == 0) {
        if (n_in != 36 || out_size != L * D || ws_size < WS_END) { fprintf(stderr, "kernel_launch: unexpected shapes: n_in %d out %d ws %zu (need %zu)\n", n_in, out_size, ws_size, (size_t)WS_END); grid = -1; return; }
        int dev = 0, cus = 0, per_cu = 0;
        if (hipGetDevice(&dev) != hipSuccess || hipDeviceGetAttribute(&cus, hipDeviceAttributeMultiprocessorCount, dev) != hipSuccess) { grid = -1; return; }
        if (hipFuncSetAttribute((const void*)fwd_kernel, hipFuncAttributeMaxDynamicSharedMemorySize, LDS_BYTES) != hipSuccess) { fprintf(stderr, "kernel_launch: hipFuncSetAttribute failed\n"); grid = -1; return; }
        if (hipOccupancyMaxActiveBlocksPerMultiprocessor(&per_cu, (const void*)fwd_kernel, NT, LDS_BYTES) != hipSuccess || per_cu < 1) fprintf(stderr, "kernel_launch: occupancy query says %d\n", per_cu);
        (void)hipGetLastError();
        grid = cus;
    }
    if (grid < 0) return;
    if (hipMemsetAsync((char*)d_ws + WS_CTL, 0, CTL_ZERO_BYTES, stream) != hipSuccess) return;
    Args a{};
    for (int i = 0; i < 36; ++i) a.in[i] = (const float*)d_in[i];
    a.out = (float*)d_out; a.ws = (unsigned char*)d_ws;
    const int stop = MK_STOP_AFTER < N_PHASES ? MK_STOP_AFTER + 1 : N_PHASES;
#if MK_N_LAUNCHES == 1
    a.ph_lo = 0; a.ph_hi = stop;
    hipLaunchKernelGGL(fwd_kernel, dim3(grid), dim3(NT), LDS_BYTES, stream, a);
#else
    for (int p = 0; p < stop; ++p) { a.ph_lo = p; a.ph_hi = p + 1; hipLaunchKernelGGL(fwd_kernel, dim3(grid), dim3(NT), LDS_BYTES, stream, a); }
#endif
}
```

```cpp
#include <hip/hip_runtime.h>
#include <cstdio>
#include <cstdint>

#ifndef MK_N_LAUNCHES
#define MK_N_LAUNCHES 1
#endif
#ifndef PROBE_DUP
#define PROBE_DUP -1
#endif
#ifndef MK_STOP_AFTER
#define MK_STOP_AFTER 99
#endif

#define GAS __attribute__((address_space(1)))
#define LAS __attribute__((address_space(3)))
typedef unsigned short bf16;
typedef unsigned v4u __attribute__((ext_vector_type(4)));
typedef unsigned v2u __attribute__((ext_vector_type(2)));
typedef float f32x4 __attribute__((ext_vector_type(4)));
typedef float f32x2 __attribute__((ext_vector_type(2)));
typedef short bf16x8 __attribute__((ext_vector_type(8)));
#define LDS_WAIT() asm volatile("s_waitcnt lgkmcnt(0)" ::: "memory")
#define VM_WAIT() asm volatile("s_waitcnt vmcnt(0)" ::: "memory")

constexpr int NWAVES = 8, NT = NWAVES * 64;
constexpr int L = 16384, D = 2048, LC = 256, MROWS = L + LC;
constexpr int NIN = 6176, NINP = 6400;
constexpr int OFF_K = 0, OFF_V = 512, OFF_G = 1536, OFF_Q = 1568, OFF_O = 2080, OFF_HY = 3104;
constexpr int NH = 8, HYW = 1024, MVW = 1024;
constexpr int NE = 64, NE1 = 65, DE = 512;
constexpr int HALF_T = 8192;
constexpr int MAXROWS = 90112;
constexpr float EPS = 1e-6f;
constexpr float W13_PRE = 64.0f, W2_PRE = 32.0f, HR_PRE = 4.0f;

constexpr size_t MiB = 1u << 20;
constexpr size_t WS_CTL = 0, CTL_ZERO_BYTES = 256 * 1024;
constexpr size_t WS_MOD = 1 * MiB;
constexpr size_t WS_POS = WS_MOD + 128 * 1024;
constexpr size_t WS_WR1 = 2 * MiB + 512 * 1024;
constexpr size_t WS_WR2 = WS_WR1 + 256 * 1024;
constexpr size_t WS_WIN = 3 * MiB;
constexpr size_t WS_WOUT = 28 * MiB;
constexpr size_t WS_W13 = 36 * MiB;
constexpr size_t WS_W2 = 296 * MiB;
constexpr size_t WS_HA = 426 * MiB;
constexpr size_t WS_Z = 491 * MiB;
constexpr size_t WS_CAT = 695 * MiB;
constexpr size_t WS_UIN = 759 * MiB;
constexpr size_t WS_KF = 823 * MiB;
constexpr size_t WS_KB = 887 * MiB;
constexpr size_t WS_CL = 426 * MiB;
constexpr size_t WS_CI = 951 * MiB;
constexpr size_t WS_Q = 983 * MiB;
constexpr size_t WS_K = 999 * MiB;
constexpr size_t WS_RTOK = 1015 * MiB;
constexpr size_t WS_RW = WS_RTOK + 2 * MAXROWS * 4;
constexpr size_t WS_AEXP = 1017 * MiB;
constexpr size_t WS_ARANK = WS_AEXP + 512 * 1024;
constexpr size_t WS_AW = WS_ARANK + 512 * 1024;
constexpr size_t WS_HDN = 1019 * MiB;
constexpr size_t WS_SC = 1021 * MiB;
constexpr size_t WS_NL = WS_SC + 32 * 1024;
constexpr size_t WS_NI = WS_NL + 640 * 1024;
constexpr size_t WS_MI = WS_NI + 640 * 1024;
constexpr size_t WS_END = 1023 * MiB;
constexpr size_t WS_HR = 491 * MiB;
constexpr size_t WS_Y2 = 579 * MiB;
static_assert(WS_Y2 + (size_t)MAXROWS * 2048 * 2 <= WS_CI, "overlay");
constexpr int CW_BAR = 4096;
constexpr int CW_CNT = 16384;

constexpr int RING_BYTES = 131072;
constexpr int LDSCTL_OFF = 147456;
constexpr int FFTSCR_OFF = LDSCTL_OFF + 1024;
constexpr int LDS_BYTES = 151552;

__device__ __forceinline__ unsigned cvt_pk_bf16(float lo, float hi) { unsigned r; asm volatile("v_cvt_pk_bf16_f32 %0, %1, %2" : "=v"(r) : "v"(lo), "v"(hi)); return r; }
__device__ __forceinline__ float bf2f(unsigned short b) { return __builtin_bit_cast(float, ((unsigned)b) << 16); }
__device__ __forceinline__ float bflo(unsigned u) { return __builtin_bit_cast(float, u << 16); }
__device__ __forceinline__ float bfhi(unsigned u) { return __builtin_bit_cast(float, u & 0xffff0000u); }
__device__ __forceinline__ float wave_sum(float v) {
#pragma unroll
    for (int o = 1; o < 64; o <<= 1) v += __shfl_xor(v, o);
    return v;
}
__device__ __forceinline__ float silu_f(float a) { return a / (1.f + __expf(-a)); }
__device__ __forceinline__ float sigmoid_f(float a) { return 1.f / (1.f + __expf(-a)); }

#define XB_TMO      128
#define XB_XCNT(j)  (256  + 64 * (j))
#define XB_XSUB(j)  (1280 + 64 * (j))
#define XB_XGEN(j)  (2304 + 64 * (j))
#define XB_TOP      3328
#define XB_TOPGEN   3392
#define XCD_BAR_WORDS 3456
#define XB_SPIN_CAP (1u << 18)

__device__ __forceinline__ unsigned xb_ld(unsigned* p)              { return __hip_atomic_load(p, __ATOMIC_RELAXED, __HIP_MEMORY_SCOPE_AGENT); }
__device__ __forceinline__ unsigned xb_add(unsigned* p, unsigned v) { return __hip_atomic_fetch_add(p, v, __ATOMIC_RELAXED, __HIP_MEMORY_SCOPE_AGENT); }
__device__ __forceinline__ unsigned xb_xcc_id() { return (unsigned)__builtin_amdgcn_s_getreg((3 << 11) | 20) & 0xFu; }
#define XB_SPIN(cond, bar) do { unsigned _sp = 0; while (cond) { __builtin_amdgcn_s_sleep(1); \
    if ((++_sp & 255u) == 0u) { if (xb_ld(&(bar)[XB_TMO])) break; if (_sp > XB_SPIN_CAP) { atomicAdd(&(bar)[XB_TMO], 1u); break; } } } } while (0)

struct XcdBarrier {
    unsigned* bar; unsigned x;
    volatile LAS unsigned* st;
};

__device__ __forceinline__ XcdBarrier xcd_barrier_post(unsigned* bar, volatile LAS unsigned* st) {
    XcdBarrier b; b.bar = bar; b.x = xb_xcc_id(); b.st = st;
    if (threadIdx.x == 0) (void)xb_add(&bar[XB_XCNT(b.x)], 1u);
    return b;
}
__device__ __forceinline__ void xcd_barrier_complete(unsigned* bar, unsigned x, unsigned& nloc, unsigned& nx) {
    const unsigned G = gridDim.x * gridDim.y * gridDim.z;
    unsigned sum, cnt, mine, sp = 0u;
    for (;;) {
        sum = 0u; cnt = 0u; mine = 0u;
#pragma unroll
        for (unsigned j = 0; j < 16; ++j) { const unsigned c = xb_ld(&bar[XB_XCNT(j)]); sum += c; cnt += (c > 0u) ? 1u : 0u; mine = (j == x) ? c : mine; }
        if (sum == G) break;
        __builtin_amdgcn_s_sleep(1);
        if ((++sp & 255u) == 0u) { if (xb_ld(&bar[XB_TMO])) break; if (sp > XB_SPIN_CAP) { atomicAdd(&bar[XB_TMO], 1u); break; } }
    }
    nloc = mine > 0u ? mine : 1u; nx = cnt > 0u ? cnt : 1u;
}

__device__ __forceinline__ void xcd_barrier(const XcdBarrier& b) {
    asm volatile("s_waitcnt vmcnt(0)" ::: "memory");
    __syncthreads();
    if (threadIdx.x == 0) {
        unsigned* bar = b.bar;
        __builtin_amdgcn_s_waitcnt(0);
        unsigned nloc = b.st[0], nx = b.st[1];
        if (nloc == 0u) { xcd_barrier_complete(bar, b.x, nloc, nx); b.st[0] = nloc; b.st[1] = nx; }
        const unsigned old = xb_add(&bar[XB_XSUB(b.x)], 1u);
        const unsigned gen = old / nloc;
        if (old + 1u == (gen + 1u) * nloc) {
            __builtin_amdgcn_fence(__ATOMIC_RELEASE, "agent");
            asm volatile("s_waitcnt vmcnt(0)" ::: "memory");
            const unsigned og = xb_add(&bar[XB_TOP], 1u);
            const unsigned tg = og / nx;
            if (og + 1u == (tg + 1u) * nx) xb_add(&bar[XB_TOPGEN], 1u);
            else XB_SPIN(xb_ld(&bar[XB_TOPGEN]) == tg, bar);
            __builtin_amdgcn_fence(__ATOMIC_ACQUIRE, "agent");
            xb_add(&bar[XB_XGEN(b.x)], 1u);
            asm volatile("s_waitcnt vmcnt(0)" ::: "memory");
        } else {
            XB_SPIN(xb_ld(&bar[XB_XGEN(b.x)]) == gen, bar);
            __builtin_amdgcn_fence(__ATOMIC_ACQUIRE, "agent");
            asm volatile("s_waitcnt vmcnt(0)" ::: "memory");
        }
    }
    __syncthreads();
}

namespace gk {
constexpr int BM = 256, BK = 64, HALF = 128, HTB = HALF * BK * 2, STAGE_BYTES = 8 * HTB, NXCD = 8, WGM = 8;
__host__ __device__ __forceinline__ int lds_byte(int r, int c) { const int st = (r >> 4) * 2 + (c >> 5), rr = r & 15, cc = c & 31, ob = rr * 64 + cc * 2; return st * 1024 + (ob ^ (((ob >> 9) & 1) << 5)); }
__host__ __device__ __forceinline__ void stage_rc(int b, int& R, int& C) { const int st = b / 1024, sb = b % 1024, swz = sb ^ (((sb >> 9) & 1) << 5); R = (st >> 1) * 16 + swz / 64; C = (st & 1) * 32 + (swz % 64) / 2; }
__host__ __device__ __forceinline__ int perm32(int rho) { const int n = rho >> 4, i = rho & 15; return 8 * (i >> 2) + 4 * n + (i & 3); }

struct Unit { int pm, pn, ex; };

typedef int v8i_t __attribute__((ext_vector_type(8)));
typedef int v4i_t __attribute__((ext_vector_type(4)));
template <class Epi, class Sched, bool F8 = false>
__device__ __forceinline__ void gemm_core(LAS unsigned char* lds, const char* Abase, const int KB_  , const Sched& S, const Epi& E) {
    int KBo = KB_; asm volatile("" : "+s"(KBo)); const int KB = KBo;
    const int tid = threadIdx.x, wid = __builtin_amdgcn_readfirstlane(tid >> 6), lane = tid & 63, wr = wid >> 2, wc = wid & 3, fr = lane & 15, fq = lane >> 4;
    const int nt = KB / (BK * 2);
    int RA[2], CA[2]; unsigned voffB[2];
#pragma unroll
    for (int i = 0; i < 2; ++i) { int R, C; stage_rc(tid * 16 + i * 8192, R, C); const int Rb = Epi::PERM ? ((R & ~31) + perm32(R & 31)) : R;
        RA[i] = R; CA[i] = C; voffB[i] = (unsigned)(Rb * KB + C * 2); }
    const size_t kstep = (size_t)(BK * 2);
    const size_t hstepB = (size_t)HALF * KB;
    const unsigned ldsw = (unsigned)wid * 1024u;
    const int aoff = lds_byte(wr * 64 + fr, fq * 8), boff = lds_byte(wc * 32 + fr, fq * 8);
#define GK_SA(b, h) (((b) * 2 + (h)) * HTB)
#define GK_SB(b, h) ((4 + (b) * 2 + (h)) * HTB)
#define GK_STAGE(bufoff, gbase, v0, v1) do { \
        __builtin_amdgcn_global_load_lds((const unsigned*)((const char*)(gbase) + (v0)), (LAS unsigned*)(lds + (bufoff) + ldsw), 16, 0, 0); \
        __builtin_amdgcn_global_load_lds((const unsigned*)((const char*)(gbase) + (v1)), (LAS unsigned*)(lds + (bufoff) + ldsw + 8192), 16, 0, 0); } while (0)
#define GK_LDA(dst, b, h) do { _Pragma("unroll") for (int m = 0; m < 4; ++m) _Pragma("unroll") for (int k = 0; k < 2; ++k) dst[m][k] = *(const LAS bf16x8*)(lds + GK_SA(b, h) + aoff + m * 2048 + k * 1024); } while (0)
#define GK_LDB(dst, b, h) do { _Pragma("unroll") for (int n = 0; n < 2; ++n) _Pragma("unroll") for (int k = 0; k < 2; ++k) dst[n][k] = *(const LAS bf16x8*)(lds + GK_SB(b, h) + boff + n * 2048 + k * 1024); } while (0)
#define GK_MMA(ai, bj, At, Bt) do { __builtin_amdgcn_s_setprio(1); _Pragma("unroll") for (int m = 0; m < 4; ++m) _Pragma("unroll") for (int n = 0; n < 2; ++n) { \
        if constexpr (F8) { const v8i_t bb = __builtin_shufflevector(__builtin_bit_cast(v4i_t, Bt[n][0]), __builtin_bit_cast(v4i_t, Bt[n][1]), 0, 1, 2, 3, 4, 5, 6, 7); \
            const v8i_t aa = __builtin_shufflevector(__builtin_bit_cast(v4i_t, At[m][0]), __builtin_bit_cast(v4i_t, At[m][1]), 0, 1, 2, 3, 4, 5, 6, 7); \
            asm volatile("v_mfma_scale_f32_16x16x128_f8f6f4 %0, %1, %2, %0, %3, %3 op_sel_hi:[0,0,0]" : "+v"(acc[ai][bj][m][n]) : "v"(bb), "v"(aa), "v"(f8scale)); } \
        else { _Pragma("unroll") for (int k = 0; k < 2; ++k) acc[ai][bj][m][n] = __builtin_amdgcn_mfma_f32_16x16x32_bf16(Bt[n][k], At[m][k], acc[ai][bj][m][n], 0, 0, 0); } } \
        __builtin_amdgcn_s_setprio(0); } while (0)
#define GK_WAIT_V(n) asm volatile("s_waitcnt vmcnt(" #n ")" ::: "memory")
#define GK_WAIT_L(n) asm volatile("s_waitcnt lgkmcnt(" #n ")" ::: "memory")
#define GK_BAR __builtin_amdgcn_s_barrier()
#define GK_SCHED __builtin_amdgcn_sched_barrier(0)
    Unit cur, nxt; int ui = 0;
    if (!S.next(0, cur)) return;
    int f8scale = 0x7F7F7F7F; asm volatile("" : "+v"(f8scale));
    f32x4 acc[2][2][4][2];
#pragma unroll
    for (int a = 0; a < 2; ++a)
#pragma unroll
        for (int b = 0; b < 2; ++b)
#pragma unroll
            for (int m = 0; m < 4; ++m)
#pragma unroll
                for (int n = 0; n < 2; ++n) acc[a][b][m][n] = (f32x4){0.f, 0.f, 0.f, 0.f};
    bf16x8 At[4][2], B0[2][2], B1[2][2];
    unsigned c00, c01, c10, c11, n00, n01, n10, n11;
    S.a_offs(cur, RA, CA, c00, c01, c10, c11);
    asm volatile("" : "+v"(c00), "+v"(c01), "+v"(c10), "+v"(c11));
    const char* cB = S.b_base(cur);
    GK_STAGE(GK_SB(0, 0), cB, voffB[0], voffB[1]); GK_STAGE(GK_SB(0, 1), cB + hstepB, voffB[0], voffB[1]); GK_STAGE(GK_SA(0, 0), Abase, c00, c01); GK_STAGE(GK_SA(0, 1), Abase, c10, c11);
    if (wr == 1) GK_BAR;
    GK_WAIT_V(2); GK_BAR;
    GK_STAGE(GK_SB(1, 0), cB + kstep, voffB[0], voffB[1]); GK_STAGE(GK_SA(1, 0), Abase + kstep, c00, c01); GK_STAGE(GK_SB(1, 1), cB + hstepB + kstep, voffB[0], voffB[1]);
    GK_WAIT_V(6); GK_BAR;
    for (;;) {
        const bool has_next = S.next(ui + 1, nxt);
        const char* nB = cB;
        n00 = c00; n01 = c01; n10 = c10; n11 = c11;
        if (has_next) { S.a_offs(nxt, RA, CA, n00, n01, n10, n11); nB = S.b_base(nxt); }
        asm volatile("" : "+v"(n00), "+v"(n01), "+v"(n10), "+v"(n11));
        for (int t = 0; t < nt; t += 2) {
            const bool last = (t == nt - 2);
            const char* a1 = Abase + (size_t)(t + 1) * kstep;
            const char* a2 = last ? Abase : Abase + (size_t)(t + 2) * kstep; const char* b2 = last ? nB : cB + (size_t)(t + 2) * kstep;
            const char* a3 = a2 + kstep; const char* b3 = b2 + kstep;
            const unsigned x00 = last ? n00 : c00, x01 = last ? n01 : c01, x10 = last ? n10 : c10, x11 = last ? n11 : c11;
            GK_LDB(B0, 0, 0); GK_LDB(B1, 0, 1); GK_SCHED; GK_LDA(At, 0, 0); GK_STAGE(GK_SA(1, 1), a1, c10, c11);
            GK_WAIT_V(8); GK_WAIT_L(0); GK_BAR; GK_MMA(0, 0, At, B0); GK_MMA(0, 1, At, B1); GK_BAR; GK_SCHED;
            GK_LDA(At, 0, 1); GK_STAGE(GK_SB(0, 0), b2, voffB[0], voffB[1]); GK_STAGE(GK_SB(0, 1), b2 + hstepB, voffB[0], voffB[1]); GK_STAGE(GK_SA(0, 0), a2, x00, x01);
            GK_WAIT_V(8); GK_WAIT_L(0); GK_BAR; GK_MMA(1, 0, At, B0); GK_MMA(1, 1, At, B1); GK_BAR; GK_SCHED;
            GK_LDB(B0, 1, 0); GK_LDB(B1, 1, 1); GK_SCHED; GK_LDA(At, 1, 0); GK_STAGE(GK_SA(0, 1), a2, x10, x11);
            GK_WAIT_V(8); GK_WAIT_L(0); GK_BAR; GK_MMA(0, 0, At, B0); GK_MMA(0, 1, At, B1); GK_BAR; GK_SCHED;
            GK_LDA(At, 1, 1); GK_STAGE(GK_SB(1, 0), b3, voffB[0], voffB[1]); GK_STAGE(GK_SB(1, 1), b3 + hstepB, voffB[0], voffB[1]); GK_STAGE(GK_SA(1, 0), a3, x00, x01);
            GK_WAIT_V(8); GK_WAIT_L(0); GK_BAR; GK_MMA(1, 0, At, B0); GK_MMA(1, 1, At, B1); GK_BAR; GK_SCHED;
        }
        if (wr == 0) GK_BAR;
        if constexpr (F8) asm volatile("s_nop 15\n\ts_nop 15\n\ts_nop 15\n\ts_nop 15\n\ts_nop 15\n\ts_nop 15" ::: "memory");
        E(acc, cur, wr, wc, fr, fq);
        if (!has_next) break;
#pragma unroll
        for (int a = 0; a < 2; ++a)
#pragma unroll
            for (int b = 0; b < 2; ++b)
#pragma unroll
                for (int m = 0; m < 4; ++m)
#pragma unroll
                    for (int n = 0; n < 2; ++n) acc[a][b][m][n] = (f32x4){0.f, 0.f, 0.f, 0.f};
        cur = nxt; cB = nB; c00 = n00; c01 = n01; c10 = n10; c11 = n11; ++ui;
        if (wr == 1) GK_BAR;
    }
    GK_WAIT_V(0);
    GK_BAR;
#undef GK_SA
#undef GK_SB
#undef GK_STAGE
#undef GK_LDA
#undef GK_LDB
#undef GK_MMA
#undef GK_WAIT_V
#undef GK_WAIT_L
#undef GK_BAR
#undef GK_SCHED
}

struct DenseOrder {
    int nM, nN, nwg, G, c, KB;
    __device__ void init(int M, int N, int KB_, int G_, int c_) { nM = M / BM; nN = N / BM; nwg = nM * nN; G = G_; c = c_; KB = KB_; }
    __device__ __forceinline__ bool next(int i, Unit& u) const {
        const long Lx = (long)i * G + c; if (Lx >= nwg) return false;
        int wgid = (int)Lx; { const int q = nwg / NXCD, r = nwg % NXCD, xcd = wgid % NXCD, off = wgid / NXCD; wgid = (xcd < r ? xcd * (q + 1) : r * (q + 1) + (xcd - r) * q) + off; }
        const int nig = WGM * nN, gid = wgid / nig, fm = gid * WGM, gsz = (nM - fm) < WGM ? (nM - fm) : WGM;
        u.pm = fm + ((wgid % nig) % gsz); u.pn = (wgid % nig) / gsz; u.ex = 0; return true;
    }
    const char* Bt;
    __device__ __forceinline__ void a_offs(const Unit& u, const int (&RA)[2], const int (&CA)[2], unsigned& o00, unsigned& o01, unsigned& o10, unsigned& o11) const {
        const unsigned r0 = (unsigned)(u.pm * BM);
        o00 = (r0 + RA[0]) * (unsigned)KB + CA[0] * 2u; o01 = (r0 + RA[1]) * (unsigned)KB + CA[1] * 2u;
        o10 = (r0 + HALF + RA[0]) * (unsigned)KB + CA[0] * 2u; o11 = (r0 + HALF + RA[1]) * (unsigned)KB + CA[1] * 2u;
    }
    __device__ __forceinline__ const char* b_base(const Unit& u) const { return Bt + (size_t)u.pn * BM * KB; }
};
template <int NPN, bool GATHER>
struct GroupOrder {
    int ntile, G, c, KB;
    const LAS int* pstart;
    const int* rtok;
    const char* Bt; size_t bstride;
    __device__ __forceinline__ bool next(int i, Unit& u) const {
        const int x = c & 7, j = c >> 3, nj = G >> 3, T8 = (ntile + 7) >> 3, tlo = x * T8, thi = (tlo + T8) < ntile ? (tlo + T8) : ntile;
        const int Lx = i * nj + j, tl = Lx / NPN; if (tlo + tl >= thi) return false;
        u.pm = tlo + tl; u.pn = Lx % NPN;
        const int row = u.pm * BM; int lo = 0, hi = NE1;
        while (hi - lo > 1) { const int mid = (lo + hi) >> 1; if (pstart[mid] <= row) lo = mid; else hi = mid; }
        u.ex = lo; return true;
    }
    __device__ __forceinline__ void a_offs(const Unit& u, const int (&RA)[2], const int (&CA)[2], unsigned& o00, unsigned& o01, unsigned& o10, unsigned& o11) const {
        const int r0 = u.pm * BM;
        if (GATHER) {
            const int t00 = rtok[r0 + RA[0]], t01 = rtok[r0 + RA[1]], t10 = rtok[r0 + HALF + RA[0]], t11 = rtok[r0 + HALF + RA[1]];
            o00 = (unsigned)t00 * (unsigned)KB + CA[0] * 2u; o01 = (unsigned)t01 * (unsigned)KB + CA[1] * 2u;
            o10 = (unsigned)t10 * (unsigned)KB + CA[0] * 2u; o11 = (unsigned)t11 * (unsigned)KB + CA[1] * 2u;
        } else {
            o00 = (unsigned)(r0 + RA[0]) * (unsigned)KB + CA[0] * 2u; o01 = (unsigned)(r0 + RA[1]) * (unsigned)KB + CA[1] * 2u;
            o10 = (unsigned)(r0 + HALF + RA[0]) * (unsigned)KB + CA[0] * 2u; o11 = (unsigned)(r0 + HALF + RA[1]) * (unsigned)KB + CA[1] * 2u;
        }
    }
    __device__ __forceinline__ const char* b_base(const Unit& u) const { return Bt + (size_t)u.ex * bstride + (size_t)u.pn * BM * KB; }
};

struct EpiBf16Store {
    static constexpr bool PERM = true;
    bf16* O; int ldc; float sc;
    __device__ __forceinline__ void operator()(const f32x4 (&acc)[2][2][4][2], const Unit& u, int wr, int wc, int fr, int fq) const {
        const int row0 = u.pm * BM + wr * 64 + fr, col0 = u.pn * BM + wc * 32 + 8 * fq;
#pragma unroll
        for (int ai = 0; ai < 2; ++ai)
#pragma unroll
            for (int m = 0; m < 4; ++m) { bf16* rowp = O + (size_t)(row0 + ai * HALF + m * 16) * ldc + col0;
#pragma unroll
                for (int bj = 0; bj < 2; ++bj) { const f32x4 v0 = acc[ai][bj][m][0] * sc, v1 = acc[ai][bj][m][1] * sc;
                    v4u w; w.x = cvt_pk_bf16(v0[0], v0[1]); w.y = cvt_pk_bf16(v0[2], v0[3]); w.z = cvt_pk_bf16(v1[0], v1[1]); w.w = cvt_pk_bf16(v1[2], v1[3]);
                    *(v4u*)(rowp + bj * HALF) = w; } }
    }
};
__device__ __forceinline__ unsigned pk_fp8x4(float a, float b, float c, float d) {
    a = fminf(fmaxf(a, -448.f), 448.f); b = fminf(fmaxf(b, -448.f), 448.f); c = fminf(fmaxf(c, -448.f), 448.f); d = fminf(fmaxf(d, -448.f), 448.f);
    int v = __builtin_amdgcn_cvt_pk_fp8_f32(a, b, 0, false); v = __builtin_amdgcn_cvt_pk_fp8_f32(c, d, v, true); return (unsigned)v; }
struct EpiGateUpF8 {
    static constexpr bool PERM = true;
    unsigned char* O; float isc, osc;
    __device__ __forceinline__ void operator()(const f32x4 (&acc)[2][2][4][2], const Unit& u, int wr, int wc, int fr, int fq) const {
        const int row0 = u.pm * BM + wr * 64 + fr, col0 = u.pn * HALF + wc * 32 + 8 * fq;
#pragma unroll
        for (int ai = 0; ai < 2; ++ai)
#pragma unroll
            for (int m = 0; m < 4; ++m) { unsigned char* rowp = O + (size_t)(row0 + ai * HALF + m * 16) * DE + col0;
                float h[8];
#pragma unroll
                for (int n = 0; n < 2; ++n)
#pragma unroll
                    for (int j = 0; j < 4; ++j) { const float a0 = acc[ai][0][m][n][j], a1 = acc[ai][1][m][n][j];
                        h[n * 4 + j] = (a0 * a1) * (isc * isc * osc) * __builtin_amdgcn_rcpf(1.0f + __builtin_amdgcn_exp2f(a0 * (-1.4426950408889634f * isc))); }
                v2u w; w.x = pk_fp8x4(h[0], h[1], h[2], h[3]); w.y = pk_fp8x4(h[4], h[5], h[6], h[7]);
                *(v2u*)rowp = w; }
    }
};
struct EpiResidual {
    static constexpr bool PERM = false;
    float* X; int ldc; const float* gate;
    __device__ __forceinline__ void operator()(const f32x4 (&acc)[2][2][4][2], const Unit& u, int wr, int wc, int fr, int fq) const {
        const int row0 = u.pm * BM + wr * 64 + fr, col0 = u.pn * BM + wc * 32 + 4 * fq;
        f32x4 gv[2][2];
#pragma unroll
        for (int bj = 0; bj < 2; ++bj)
#pragma unroll
            for (int n = 0; n < 2; ++n) gv[bj][n] = *(const f32x4*)(gate + col0 + bj * HALF + n * 16);
#pragma unroll
        for (int ai = 0; ai < 2; ++ai)
#pragma unroll
            for (int m = 0; m < 4; ++m) { float* rowp = X + (size_t)(row0 + ai * HALF + m * 16) * ldc + col0;
#pragma unroll
                for (int bj = 0; bj < 2; ++bj)
#pragma unroll
                    for (int n = 0; n < 2; ++n) { f32x4* p = (f32x4*)(rowp + bj * HALF + n * 16); *p = *p + gv[bj][n] * acc[ai][bj][m][n]; } }
    }
};
struct EpiGateUp {
    static constexpr bool PERM = true;
    bf16* O;
    __device__ __forceinline__ void operator()(const f32x4 (&acc)[2][2][4][2], const Unit& u, int wr, int wc, int fr, int fq) const {
        const int row0 = u.pm * BM + wr * 64 + fr, col0 = u.pn * HALF + wc * 32 + 8 * fq;
#pragma unroll
        for (int ai = 0; ai < 2; ++ai)
#pragma unroll
            for (int m = 0; m < 4; ++m) { bf16* rowp = O + (size_t)(row0 + ai * HALF + m * 16) * DE + col0;
                float h[8];
#pragma unroll
                for (int n = 0; n < 2; ++n)
#pragma unroll
                    for (int j = 0; j < 4; ++j) { const float g = acc[ai][0][m][n][j], up = acc[ai][1][m][n][j]; h[n * 4 + j] = silu_f(g) * up; }
                v4u w; w.x = cvt_pk_bf16(h[0], h[1]); w.y = cvt_pk_bf16(h[2], h[3]); w.z = cvt_pk_bf16(h[4], h[5]); w.w = cvt_pk_bf16(h[6], h[7]);
                *(v4u*)rowp = w; }
    }
};
struct EpiDown {
    static constexpr bool PERM = true;
    bf16* O; const float* rw;
    __device__ __forceinline__ void operator()(const f32x4 (&acc)[2][2][4][2], const Unit& u, int wr, int wc, int fr, int fq) const {
        const int row0 = u.pm * BM + wr * 64 + fr, col0 = u.pn * BM + wc * 32 + 8 * fq;
#pragma unroll
        for (int ai = 0; ai < 2; ++ai)
#pragma unroll
            for (int m = 0; m < 4; ++m) { const int row = row0 + ai * HALF + m * 16; const float s = rw[row]; bf16* rowp = O + (size_t)row * D + col0;
#pragma unroll
                for (int bj = 0; bj < 2; ++bj) { const f32x4 v0 = acc[ai][bj][m][0] * s, v1 = acc[ai][bj][m][1] * s;
                    v4u w; w.x = cvt_pk_bf16(v0[0], v0[1]); w.y = cvt_pk_bf16(v0[2], v0[3]); w.z = cvt_pk_bf16(v1[0], v1[1]); w.w = cvt_pk_bf16(v1[2], v1[3]);
                    *(v4u*)(rowp + bj * HALF) = w; } }
    }
};
}

using gk::pk_fp8x4;
struct Args { const float* in[36]; float* out; unsigned char* ws; int ph_lo, ph_hi; };
struct Frame {
    LAS unsigned char* lds;
    int tid, lane, wave, bid, G;
    const float* const* in; float* out; unsigned char* ws;
};
#define IN_X 0
#define IN_C 1
#define IN_CTX 2
#define IN_CCTX 3
#define IN_WADA 4
#define IN_BADA 5
#define IN_GMIX 6
#define IN_GFFN 7
#define IN_WIN 8
#define IN_BGATES 9
#define IN_CKW 10
#define IN_CKB 11
#define IN_CQW 12
#define IN_CQB 13
#define IN_GHEAD 14
#define IN_CHW 15
#define IN_CHB 16
#define IN_FW1 17
#define IN_FB1 18
#define IN_FF1 19
#define IN_FW2 20
#define IN_FB2 21
#define IN_FF2 22
#define IN_FW3 23
#define IN_FB3 24
#define IN_DSKIP 25
#define IN_WOUT 26
#define IN_WR 27
#define IN_BR 28
#define IN_W1E 29
#define IN_W3E 30
#define IN_W2E 31
#define IN_W1S 32
#define IN_W3S 33
#define IN_W2S 34
#define IN_GFIN 35

__device__ __forceinline__ void transpose_item(const float* W, int N, int k0, int n0, bf16* WT, int dstK, int dst_row0, LAS float* scr, int lane) {
#pragma unroll 8
    for (int i = 0; i < 32; ++i) { const int kk = 2 * i + (lane >> 5); scr[kk * 33 + (lane & 31)] = W[(size_t)(k0 + kk) * N + n0 + (lane & 31)]; }
    LDS_WAIT(); asm volatile("" ::: "memory");
    const int c = lane & 7;
#pragma unroll
    for (int j = 0; j < 4; ++j) { const int n = (lane >> 3) + 8 * j; const LAS float* s = scr + (8 * c) * 33 + n;
        v4u o; o.x = cvt_pk_bf16(s[0 * 33], s[1 * 33]); o.y = cvt_pk_bf16(s[2 * 33], s[3 * 33]); o.z = cvt_pk_bf16(s[4 * 33], s[5 * 33]); o.w = cvt_pk_bf16(s[6 * 33], s[7 * 33]);
        *(v4u*)(WT + (size_t)(dst_row0 + n) * dstK + k0 + 8 * c) = o; }
    LDS_WAIT(); asm volatile("" ::: "memory");
}
__device__ __forceinline__ void transpose_item_f8(const float* W, int N, int k0, int n0, unsigned char* WT, int dstKB, int dst_row0, float pre, LAS float* scr, int lane) {
#pragma unroll 8
    for (int i = 0; i < 32; ++i) { const int kk = 2 * i + (lane >> 5); scr[kk * 33 + (lane & 31)] = W[(size_t)(k0 + kk) * N + n0 + (lane & 31)] * pre; }
    LDS_WAIT(); asm volatile("" ::: "memory");
    const int n = lane >> 1, hf = lane & 1; const LAS float* s = scr + (32 * hf) * 33 + n;
    unsigned w[8];
#pragma unroll
    for (int q = 0; q < 8; ++q) w[q] = pk_fp8x4(s[(4 * q) * 33], s[(4 * q + 1) * 33], s[(4 * q + 2) * 33], s[(4 * q + 3) * 33]);
    unsigned char* dst = WT + (size_t)(dst_row0 + n) * dstKB + k0 + 32 * hf;
    *(v4u*)dst = (v4u){w[0], w[1], w[2], w[3]}; *(v4u*)(dst + 16) = (v4u){w[4], w[5], w[6], w[7]};
    LDS_WAIT(); asm volatile("" ::: "memory");
}
__device__ __forceinline__ void p0_prologue(Frame& F) {
    const float* const* in = F.in;
    {
        LAS float* sv = (LAS float*)F.lds;
        LAS float* red = sv + 4096;
        float* mod = (float*)(F.ws + WS_MOD);
        for (int job = F.bid; job < 192; job += F.G) {
            for (int i = F.tid; i < 2048; i += NT) { sv[i] = silu_f(in[IN_C][i]); sv[2048 + i] = silu_f(in[IN_CCTX][i]); }
            __syncthreads();
            const int col = job * 64 + F.lane, r0 = F.wave * 256;
            const float* W = in[IN_WADA] + col;
            float a0 = 0.f, a1 = 0.f;
            for (int i = r0; i < r0 + 256; i += 8) {
                float w[8];
#pragma unroll
                for (int j = 0; j < 8; ++j) w[j] = W[(size_t)(i + j) * 12288];
#pragma unroll
                for (int j = 0; j < 8; ++j) { a0 += sv[i + j] * w[j]; a1 += sv[2048 + i + j] * w[j]; }
            }
            red[(F.wave * 64 + F.lane) * 2 + 0] = a0; red[(F.wave * 64 + F.lane) * 2 + 1] = a1;
            __syncthreads();
            if (F.wave == 0) { float s0 = 0.f, s1 = 0.f;
#pragma unroll
                for (int w = 0; w < 8; ++w) { s0 += red[(w * 64 + F.lane) * 2 + 0]; s1 += red[(w * 64 + F.lane) * 2 + 1]; }
                const float b = in[IN_BADA][col]; mod[col] = s0 + b; mod[12288 + col] = s1 + b; }
            __syncthreads();
        }
    }
    const int gt = F.bid * NT + F.tid, NGT = F.G * NT;
    {
        float* pos = (float*)(F.ws + WS_POS);
        for (int i = gt; i < 320 * 1024; i += NGT) { const int p = i >> 10, j = i & 1023, jj = j & 511;
            const float pp = (float)(p < 256 ? p : p - 256);
            const float omega = 1.0f / powf(10000.0f, (float)jj * (1.0f / 512.0f)); const float ang = pp * omega;
            pos[i] = j < 512 ? sinf(ang) : cosf(ang); }
    }
    {
        v4u* z = (v4u*)(F.ws + WS_WIN + (size_t)NIN * D * 2); const int nz = (NINP - NIN) * D * 2 / 16;
        for (int i = gt; i < nz; i += NGT) z[i] = (v4u){0u, 0u, 0u, 0u};
        int* rt = (int*)(F.ws + WS_RTOK); float* rw = (float*)(F.ws + WS_RW);
        for (int i = gt; i < 2 * MAXROWS; i += NGT) { rt[i] = 0; rw[i] = 0.f; }
    }
    {
        bf16* w1 = (bf16*)(F.ws + WS_WR1); bf16* w2 = (bf16*)(F.ws + WS_WR2);
        for (int i = gt; i < 64 * 2048; i += NGT) { const int e = i >> 11, k = i & 2047; const float w = in[IN_WR][k * 64 + e];
            const unsigned hi = cvt_pk_bf16(w, 0.f) & 0xffffu; const float r = w - bf2f((bf16)hi);
            w1[i] = (bf16)hi; w2[i] = (bf16)(cvt_pk_bf16(r, 0.f) & 0xffffu); }
    }
    {
        LAS float* scr = (LAS float*)(F.lds + F.wave * 16384);
        const int gw = F.bid * NWAVES + F.wave, NGW = F.G * NWAVES;
        constexpr int I_IN = 32 * 193, I_OUT = 32 * 64, I_E = 512 * NE1;
        constexpr int NITEMS = I_IN + I_OUT + 3 * I_E;
        for (int it = gw; it < NITEMS; it += NGW) {
            int r = it;
            if (r < I_IN) { const int kb = r / 193, nb = r % 193; transpose_item(in[IN_WIN], NIN, 64 * kb, 32 * nb, (bf16*)(F.ws + WS_WIN), D, 32 * nb, scr, F.lane); continue; } r -= I_IN;
            if (r < I_OUT) { const int kb = r / 64, nb = r % 64; transpose_item(in[IN_WOUT], D, 64 * kb, 32 * nb, (bf16*)(F.ws + WS_WOUT), D, 32 * nb, scr, F.lane); continue; } r -= I_OUT;
            if (r < 2 * I_E) { const int which = r >= I_E; if (which) r -= I_E;
                const int e = r / 512, rr = r % 512, kb = rr / 16, nb = rr % 16, n0 = 32 * nb;
                const float* src = e < NE ? in[which ? IN_W3E : IN_W1E] + (size_t)e * D * DE : in[which ? IN_W3S : IN_W1S];
                transpose_item_f8(src, DE, 64 * kb, n0, (unsigned char*)(F.ws + WS_W13) + (size_t)e * 1024 * D, D, (n0 >> 7) * 256 + which * 128 + (n0 & 127), W13_PRE, scr, F.lane); continue; }
            r -= 2 * I_E;
            { const int e = r / 512, rr = r % 512, kb = rr / 64, nb = rr % 64;
                const float* src = e < NE ? in[IN_W2E] + (size_t)e * DE * D : in[IN_W2S];
                transpose_item_f8(src, D, 64 * kb, 32 * nb, (unsigned char*)(F.ws + WS_W2) + (size_t)e * D * DE, DE, 32 * nb, W2_PRE, scr, F.lane); }
        }
    }
}

__device__ __forceinline__ void p1_norm1(Frame& F) {
    const float* const* in = F.in;
    const int gw = F.bid * NWAVES + F.wave, NGW = F.G * NWAVES;
    const float* mod = (const float*)(F.ws + WS_MOD); const float* pos = (const float*)(F.ws + WS_POS);
    bf16* hA = (bf16*)(F.ws + WS_HA);
    for (int row = gw; row < MROWS; row += NGW) {
        f32x4 v[8]; float ss = 0.f;
        const bool mainrow = row < L;
        const float* src = mainrow ? in[IN_X] + (size_t)row * D : in[IN_CTX] + (size_t)(row - L) * D;
        const float* md = mainrow ? mod : mod + 12288;
#pragma unroll
        for (int j = 0; j < 8; ++j) { const int col = 4 * F.lane + 256 * j; v[j] = *(const f32x4*)(src + col);
            if (mainrow) { const float* pp = col < 1024 ? pos + (size_t)(row >> 6) * 1024 + col : pos + (size_t)(256 + (row & 63)) * 1024 + (col - 1024);
                v[j] = v[j] + *(const f32x4*)pp; *(f32x4*)(F.out + (size_t)row * D + col) = v[j]; }
            ss += (v[j].x * v[j].x + v[j].y * v[j].y) + (v[j].z * v[j].z + v[j].w * v[j].w); }
        const float rstd = rsqrtf(wave_sum(ss) * (1.0f / D) + EPS);
#pragma unroll
        for (int j = 0; j < 8; ++j) { const int col = 4 * F.lane + 256 * j;
            const f32x4 g = *(const f32x4*)(in[IN_GMIX] + col), sh = *(const f32x4*)(md + col), sc = *(const f32x4*)(md + 2048 + col);
            const f32x4 h = (v[j] * rstd * g) * (sc + 1.0f) + sh;
            v2u o; o.x = cvt_pk_bf16(h.x, h.y); o.y = cvt_pk_bf16(h.z, h.w);
            *(v2u*)(hA + (size_t)row * D + col) = o; }
    }
}

constexpr int VT_PITCH = 136;
__device__ __forceinline__ float wave_incl_add(float x, int lane) {
#pragma unroll
    for (int o = 1; o < 64; o <<= 1) { const float y = __shfl_up(x, o); if (lane >= o) x += y; }
    return x;
}
__device__ __forceinline__ float wave_incl_max(float x, int lane) {
#pragma unroll
    for (int o = 1; o < 64; o <<= 1) { const float y = __shfl_up(x, o); if (lane >= o) x = fmaxf(x, y); }
    return x;
}
__device__ __forceinline__ void ml_gates(Frame& F, int dir, int h, int rowbase, LAS float* bb, LAS float* al, LAS float* mx, float& g, float& mtot) {
    const bf16* z = (const bf16*)(F.ws + WS_Z);
    const int lane = F.lane, pi0 = 2 * lane, p0 = dir ? 127 - pi0 : pi0, p1 = dir ? p0 - 1 : p0 + 1;
    const float bgi = F.in[IN_BGATES][dir * 16 + h], bgf = F.in[IN_BGATES][dir * 16 + 8 + h];
    const bf16* z0 = z + (size_t)(rowbase + p0) * NINP + OFF_G + dir * 16 + h; const bf16* z1 = z + (size_t)(rowbase + p1) * NINP + OFF_G + dir * 16 + h;
    const float i0 = bf2f(z0[0]) + bgi, f0 = bf2f(z0[8]) + bgf, i1 = bf2f(z1[0]) + bgi, f1 = bf2f(z1[8]) + bgf;
    const float l0 = fminf(f0, 0.f) - log1pf(__expf(-fabsf(f0))), l1 = fminf(f1, 0.f) - log1pf(__expf(-fabsf(f1)));
    const float incl = wave_incl_add(l0 + l1, lane);
    const float b1 = incl, b0 = incl - l1;
    const float a0 = i0 - b0, a1 = i1 - b1;
    const float mi = wave_incl_max(fmaxf(a0, a1), lane);
    float mprev = __shfl_up(mi, 1); if (lane == 0) mprev = -INFINITY;
    const float M0 = fmaxf(mprev, a0), M1 = mi;
    bb[p0] = b0; bb[p1] = b1; al[p0] = a0; al[p1] = a1; mx[p0] = M0; mx[p1] = M1;
    g = __shfl(incl, 63); mtot = __shfl(mi, 63);
}
__device__ __forceinline__ void ml_stage_vT(Frame& F, int h, int rowbase, LAS bf16* vT) {
    const bf16* z = (const bf16*)(F.ws + WS_Z);
    const int s = F.tid >> 2, eg = F.tid & 3;
#pragma unroll
    for (int i = 0; i < 4; ++i) { const int e0 = 32 * eg + 8 * i; const v4u v = *(const v4u*)(z + (size_t)(rowbase + s) * NINP + OFF_V + h * 128 + e0);
        const unsigned w[4] = {v.x, v.y, v.z, v.w};
#pragma unroll
        for (int q = 0; q < 4; ++q) { vT[(e0 + 2 * q) * VT_PITCH + s] = (bf16)(w[q] & 0xffffu); vT[(e0 + 2 * q + 1) * VT_PITCH + s] = (bf16)(w[q] >> 16); } }
}
__device__ __forceinline__ void ml_prep_item(Frame& F, int item) {
    const float* const* in = F.in;
    const int n = item >> 3, h = item & 7, tid = F.tid, lane = F.lane, wave = F.wave;
    const bool isctx = n >= 128;
    const int rowbase = isctx ? L + 128 * (n - 128) : 128 * n, seqlo = isctx ? L : 0, seqhi = isctx ? L + LC - 1 : L - 1;
    LAS bf16* vT = (LAS bf16*)F.lds;
    LAS bf16* kw0 = vT + 128 * VT_PITCH;
    LAS bf16* kw1 = kw0 + 64 * VT_PITCH;
    LAS float* fs = (LAS float*)(kw1 + 64 * VT_PITCH);
    const bf16* z = (const bf16*)(F.ws + WS_Z);
    if (wave < 2) { float g, mtot; LAS float* bbp = fs + 256 + wave * 384; ml_gates(F, wave, h, rowbase, bbp, bbp + 128, bbp + 256, g, mtot);
        LDS_WAIT();
        fs[wave * 128 + 2 * lane] = __expf(bbp[128 + 2 * lane] - mtot); fs[wave * 128 + 2 * lane + 1] = __expf(bbp[128 + 2 * lane + 1] - mtot);
        if (lane == 0) { float* sc = (float*)(F.ws + WS_SC) + ((size_t)(wave * 8 + h) * 130 + n) * 2; sc[0] = g; sc[1] = g + mtot; } }
    ml_stage_vT(F, h, rowbase, vT);
    __syncthreads();
    {
        const int s = tid >> 2, d0 = (tid & 3) * 16, R = rowbase + s; const bool hp = R > seqlo, hn = R < seqhi;
        float kv[16], qv[16];
#pragma unroll
        for (int part = 0; part < 2; ++part) {
            const int zc = (part ? OFF_Q : OFF_K) + h * 64 + d0; const float* cw = in[part ? IN_CQW : IN_CKW] + h * 64 + d0; const float* cb = in[part ? IN_CQB : IN_CKB] + h * 64 + d0;
#pragma unroll
            for (int hv = 0; hv < 2; ++hv) {
                const v4u c = *(const v4u*)(z + (size_t)R * NINP + zc + 8 * hv);
                const v4u p = hp ? *(const v4u*)(z + (size_t)(R - 1) * NINP + zc + 8 * hv) : (v4u){0u, 0u, 0u, 0u};
                const v4u nx = hn ? *(const v4u*)(z + (size_t)(R + 1) * NINP + zc + 8 * hv) : (v4u){0u, 0u, 0u, 0u};
                const unsigned cc[4] = {c.x, c.y, c.z, c.w}, pp[4] = {p.x, p.y, p.z, p.w}, nn[4] = {nx.x, nx.y, nx.z, nx.w};
#pragma unroll
                for (int q = 0; q < 4; ++q) { const int d = 8 * hv + 2 * q;
                    const float v0 = silu_f(bflo(pp[q]) * cw[d] + bflo(cc[q]) * cw[512 + d] + bflo(nn[q]) * cw[1024 + d] + cb[d]);
                    const float v1 = silu_f(bfhi(pp[q]) * cw[d + 1] + bfhi(cc[q]) * cw[512 + d + 1] + bfhi(nn[q]) * cw[1024 + d + 1] + cb[d + 1]);
                    if (part) { qv[d] = v0 * 0.125f; qv[d + 1] = v1 * 0.125f; } else { kv[d] = v0; kv[d + 1] = v1; } }
            }
        }
        if (!isctx) {
            bf16* Qg = (bf16*)(F.ws + WS_Q) + ((size_t)h * L + R) * 64 + d0; bf16* Kg = (bf16*)(F.ws + WS_K) + ((size_t)h * L + R) * 64 + d0;
#pragma unroll
            for (int hv = 0; hv < 2; ++hv) { v4u w;
                w.x = cvt_pk_bf16(qv[8 * hv], qv[8 * hv + 1]); w.y = cvt_pk_bf16(qv[8 * hv + 2], qv[8 * hv + 3]); w.z = cvt_pk_bf16(qv[8 * hv + 4], qv[8 * hv + 5]); w.w = cvt_pk_bf16(qv[8 * hv + 6], qv[8 * hv + 7]); *(v4u*)(Qg + 8 * hv) = w;
                w.x = cvt_pk_bf16(kv[8 * hv], kv[8 * hv + 1]); w.y = cvt_pk_bf16(kv[8 * hv + 2], kv[8 * hv + 3]); w.z = cvt_pk_bf16(kv[8 * hv + 4], kv[8 * hv + 5]); w.w = cvt_pk_bf16(kv[8 * hv + 6], kv[8 * hv + 7]); *(v4u*)(Kg + 8 * hv) = w; }
        }
        const float w0 = fs[s], w1 = fs[128 + s];
#pragma unroll
        for (int d = 0; d < 16; ++d) { const float kr = bf2f((bf16)(cvt_pk_bf16(kv[d], 0.f) & 0xffffu));
            kw0[(d0 + d) * VT_PITCH + s] = (bf16)(cvt_pk_bf16(kr * w0, 0.f) & 0xffffu); kw1[(d0 + d) * VT_PITCH + s] = (bf16)(cvt_pk_bf16(kr * w1, 0.f) & 0xffffu); }
    }
    __syncthreads();
    {
        const int fr = lane & 15, fq = lane >> 4;
        bf16x8 a[4];
#pragma unroll
        for (int kk = 0; kk < 4; ++kk) a[kk] = *(const LAS bf16x8*)(vT + (16 * wave + fr) * VT_PITCH + 32 * kk + 8 * fq);
#pragma unroll
        for (int dir = 0; dir < 2; ++dir) { const LAS bf16* kw = dir ? kw1 : kw0;
            float* cl = (float*)(F.ws + WS_CL) + ((size_t)((dir * 8 + h) * 130 + n)) * 8192;
#pragma unroll
            for (int dt = 0; dt < 4; ++dt) { f32x4 acc = (f32x4){0.f, 0.f, 0.f, 0.f};
#pragma unroll
                for (int kk = 0; kk < 4; ++kk) { const bf16x8 b = *(const LAS bf16x8*)(kw + (16 * dt + fr) * VT_PITCH + 32 * kk + 8 * fq); acc = __builtin_amdgcn_mfma_f32_16x16x32_bf16(a[kk], b, acc, 0, 0, 0); }
#pragma unroll
                for (int r = 0; r < 4; ++r) cl[(16 * wave + 4 * fq + r) * 64 + 16 * dt + fr] = acc[r]; } }
        if (tid < 128) { const int dir = tid >> 6, d = tid & 63; const LAS bf16* kw = (dir ? kw1 : kw0) + d * VT_PITCH; float s = 0.f;
            for (int i = 0; i < 128; ++i) s += bf2f(kw[i]);
            ((float*)(F.ws + WS_NL))[((size_t)((dir * 8 + h) * 130 + n)) * 64 + d] = s; }
    }
    __syncthreads();
}
__device__ __forceinline__ int ml_order(int dir, int step) { return step < 2 ? (dir ? 129 - step : 128 + step) : (dir ? 129 - step : step - 2); }
__device__ __forceinline__ void ml_scan(Frame& F) {
    const float* CL = (const float*)(F.ws + WS_CL); const float* SC = (const float*)(F.ws + WS_SC); const float* NLp = (const float*)(F.ws + WS_NL);
    bf16* CI = (bf16*)(F.ws + WS_CI); float* NI = (float*)(F.ws + WS_NI); float* MI = (float*)(F.ws + WS_MI);
    for (int idx = F.bid * NT + F.tid; idx < 16 * 8192; idx += F.G * NT) {
        const int dh = idx >> 13, rem = idx & 8191, dir = dh >> 3; const bool don = rem < 64;
        float c = 0.f, nn = 0.f, m = 0.f;
        for (int s0 = 0; s0 < 130; s0 += 10) {
            float cl[10], nl[10], gg[10], ml[10];
#pragma unroll
            for (int i = 0; i < 10; ++i) { const int ch = ml_order(dir, s0 + i); cl[i] = CL[((size_t)(dh * 130 + ch)) * 8192 + rem]; gg[i] = SC[(dh * 130 + ch) * 2]; ml[i] = SC[(dh * 130 + ch) * 2 + 1];
                nl[i] = don ? NLp[(size_t)(dh * 130 + ch) * 64 + rem] : 0.f; }
#pragma unroll
            for (int i = 0; i < 10; ++i) { const int ch = ml_order(dir, s0 + i);
                if (ch < 128) { CI[((size_t)(dh * 128 + ch)) * 8192 + rem] = (bf16)(cvt_pk_bf16(c, 0.f) & 0xffffu); if (don) NI[(size_t)(dh * 128 + ch) * 64 + rem] = nn; if (rem == 0) MI[dh * 128 + ch] = m; }
                const float mn = fmaxf(gg[i] + m, ml[i]), sp = __expf(gg[i] + m - mn), sl = __expf(ml[i] - mn);
                c = sp * c + sl * cl[i]; nn = sp * nn + sl * nl[i]; m = mn; }
        }
    }
}
__device__ __forceinline__ void ml_out_item(Frame& F, int item) {
    const float* const* in = F.in;
    const int n = item >> 3, h = item & 7, tid = F.tid, lane = F.lane, wave = F.wave, fr = lane & 15, fq = lane >> 4;
    const int rowbase = 128 * n;
    LAS bf16* vT = (LAS bf16*)F.lds;
    LAS float* fs = (LAS float*)(vT + 128 * VT_PITCH);
    const bf16* z = (const bf16*)(F.ws + WS_Z);
    if (wave < 2) { float g, mtot; LAS float* bbp = fs + wave * 384; ml_gates(F, wave, h, rowbase, bbp, bbp + 128, bbp + 256, g, mtot);
        if (lane == 0) fs[768 + wave] = ((const float*)(F.ws + WS_MI))[(wave * 8 + h) * 128 + n]; }
    ml_stage_vT(F, h, rowbase, vT);
    __syncthreads();
    const bf16* Qg = (const bf16*)(F.ws + WS_Q) + ((size_t)h * L + rowbase) * 64; const bf16* Kg = (const bf16*)(F.ws + WS_K) + ((size_t)h * L + rowbase) * 64;
    const int tl = 16 * wave + fr;
    bf16x8 qf[2];
#pragma unroll
    for (int kk = 0; kk < 2; ++kk) qf[kk] = *(const bf16x8*)(Qg + (size_t)tl * 64 + 32 * kk + 8 * fq);
    f32x4 st[8];
#pragma unroll
    for (int j = 0; j < 8; ++j) { f32x4 acc = (f32x4){0.f, 0.f, 0.f, 0.f};
#pragma unroll
        for (int kk = 0; kk < 2; ++kk) { const bf16x8 kf = *(const bf16x8*)(Kg + (size_t)(16 * j + fr) * 64 + 32 * kk + 8 * fq); acc = __builtin_amdgcn_mfma_f32_16x16x32_bf16(kf, qf[kk], acc, 0, 0, 0); }
        st[j] = acc; }
    f32x4 hs[8];
#pragma unroll
    for (int et = 0; et < 8; ++et) hs[et] = (f32x4){0.f, 0.f, 0.f, 0.f};
#pragma unroll 1
    for (int dir = 0; dir < 2; ++dir) {
        const LAS float* bbp = fs + dir * 384; const LAS float* alp = bbp + 128; const LAS float* mxp = bbp + 256;
        const float m_in = fs[768 + dir];
        const float beta = fmaxf(m_in, mxp[tl]);
        const int dh = dir * 8 + h;
        bf16x8 pf[4]; float dsum = 0.f;
#pragma unroll
        for (int kk = 0; kk < 4; ++kk) { float pv[8];
#pragma unroll
            for (int hh = 0; hh < 2; ++hh)
#pragma unroll
                for (int r = 0; r < 4; ++r) { const int s = 32 * kk + 16 * hh + 4 * fq + r; const bool ok = dir ? (s >= tl) : (s <= tl);
                    const float e = __expf(fminf(alp[s] - beta, 0.f)); const float v = ok ? st[2 * kk + hh][r] * e : 0.f; pv[4 * hh + r] = v; dsum += v; }
            pf[kk] = __builtin_bit_cast(bf16x8, (v4u){cvt_pk_bf16(pv[0], pv[1]), cvt_pk_bf16(pv[2], pv[3]), cvt_pk_bf16(pv[4], pv[5]), cvt_pk_bf16(pv[6], pv[7])}); }
        dsum += __shfl_xor(dsum, 16); dsum += __shfl_xor(dsum, 32);
        const float* nip = (const float*)(F.ws + WS_NI) + (size_t)(dh * 128 + n) * 64; float qn = 0.f;
#pragma unroll
        for (int kk = 0; kk < 2; ++kk) { const v4u qq = __builtin_bit_cast(v4u, qf[kk]); const unsigned w[4] = {qq.x, qq.y, qq.z, qq.w};
#pragma unroll
            for (int q = 0; q < 4; ++q) { const int d = 32 * kk + 8 * fq + 2 * q; qn += bflo(w[q]) * nip[d] + bfhi(w[q]) * nip[d + 1]; } }
        qn += __shfl_xor(qn, 16); qn += __shfl_xor(qn, 32);
        const float sc_t = __expf(m_in - beta);
        const float den = dsum + sc_t * qn, dn = fmaxf(fabsf(den), __expf(-(bbp[tl] + beta)));
        LAS float* xinv = fs + 772 + (wave * 2 + dir) * 32;
        if (fq == 0) { xinv[fr] = 1.0f / dn; xinv[16 + fr] = sc_t; }
        LDS_WAIT();
        float inv_r[4], sc_r[4];
#pragma unroll
        for (int r = 0; r < 4; ++r) { inv_r[r] = xinv[4 * fq + r]; sc_r[r] = xinv[16 + 4 * fq + r]; }
        const bf16* cip = (const bf16*)(F.ws + WS_CI) + (size_t)(dh * 128 + n) * 8192;
#pragma unroll
        for (int et = 0; et < 8; ++et) {
            f32x4 acc = (f32x4){0.f, 0.f, 0.f, 0.f}, acci = (f32x4){0.f, 0.f, 0.f, 0.f};
#pragma unroll
            for (int kk = 0; kk < 4; ++kk) {
                const bool live = dir ? (2 * kk + 1 >= wave) : (2 * kk <= wave);
                if (live) { const LAS bf16* vr = vT + (16 * et + fr) * VT_PITCH + 32 * kk + 4 * fq;
                    const v2u lo = *(const LAS v2u*)vr, hi = *(const LAS v2u*)(vr + 16);
                    const bf16x8 vb = __builtin_bit_cast(bf16x8, (v4u){lo.x, lo.y, hi.x, hi.y});
                    acc = __builtin_amdgcn_mfma_f32_16x16x32_bf16(pf[kk], vb, acc, 0, 0, 0); } }
#pragma unroll
            for (int kk = 0; kk < 2; ++kk) { const bf16x8 cb = *(const bf16x8*)(cip + (size_t)(16 * et + fr) * 64 + 32 * kk + 8 * fq); acci = __builtin_amdgcn_mfma_f32_16x16x32_bf16(qf[kk], cb, acci, 0, 0, 0); }
#pragma unroll
            for (int r = 0; r < 4; ++r) hs[et][r] += (acc[r] + sc_r[r] * acci[r]) * inv_r[r];
        }
    }
    float rs[4];
#pragma unroll
    for (int r = 0; r < 4; ++r) { float ss = 0.f;
#pragma unroll
        for (int et = 0; et < 8; ++et) ss += hs[et][r] * hs[et][r];
        ss += __shfl_xor(ss, 1); ss += __shfl_xor(ss, 2); ss += __shfl_xor(ss, 4); ss += __shfl_xor(ss, 8);
        rs[r] = rsqrtf(ss * (1.0f / 128.0f) + EPS); }
    bf16* cat = (bf16*)(F.ws + WS_CAT);
#pragma unroll
    for (int et = 0; et < 8; ++et) { const int col = h * 128 + 16 * et + fr; const float gh = in[IN_GHEAD][col];
#pragma unroll
        for (int r = 0; r < 4; ++r) { const int t = rowbase + 16 * wave + 4 * fq + r;
            const float o = hs[et][r] * rs[r] * gh * sigmoid_f(bf2f(z[(size_t)t * NINP + OFF_O + col]));
            cat[(size_t)t * D + col] = (bf16)(cvt_pk_bf16(o, 0.f) & 0xffffu); } }
    __syncthreads();
}

__device__ __forceinline__ void p3_filter_tile(Frame& F, int tile) {
    const float* const* in = F.in;
    const int tid = F.tid;
    LAS float* feat = (LAS float*)F.lds;
    LAS float* h1 = feat + 64 * 36;
    LAS float* h2 = h1 + 64 * 65;
    LAS float* w1s = h2 + 64 * 64;
    LAS float* w2s = w1s + 33 * 64;
    for (int i = tid; i < 33 * 64; i += NT) w1s[i] = in[IN_FW1][i];
    for (int i = tid; i < 64 * 64; i += NT) w2s[i] = in[IN_FW2][i];
    {
        const int tt = tid >> 3, sub = tid & 7; const float t = (float)(tile * 64 + tt);
        const float w = (6.2831855f * t) / (float)L;
        if (sub == 0) feat[tt * 36] = t / (float)(L - 1);
#pragma unroll
        for (int q = 0; q < 2; ++q) { const int bi = sub * 2 + q; const float band = 1e-4f + (float)bi * ((15.0f - 1e-4f) / 15.0f); const float ang = w * band;
            feat[tt * 36 + 1 + bi] = cosf(ang); feat[tt * 36 + 17 + bi] = -sinf(ang); }
    }
    __syncthreads();
    {
        const int tt = tid >> 3, j0 = (tid & 7) * 8;
        float a[8];
#pragma unroll
        for (int q = 0; q < 8; ++q) a[q] = in[IN_FB1][j0 + q];
#pragma unroll 1
        for (int i = 0; i < 33; ++i) { const float f = feat[tt * 36 + i];
#pragma unroll
            for (int q = 0; q < 8; ++q) a[q] += f * w1s[i * 64 + j0 + q]; }
#pragma unroll
        for (int q = 0; q < 8; ++q) h1[tt * 65 + j0 + q] = sinf(in[IN_FF1][j0 + q] * a[q]);
    }
    __syncthreads();
    {
        const int tt = tid >> 3, j0 = (tid & 7) * 8;
        float a[8];
#pragma unroll
        for (int q = 0; q < 8; ++q) a[q] = in[IN_FB2][j0 + q];
#pragma unroll 1
        for (int i = 0; i < 64; ++i) { const float f = h1[tt * 65 + i];
#pragma unroll
            for (int q = 0; q < 8; ++q) a[q] += f * w2s[i * 64 + j0 + q]; }
#pragma unroll
        for (int q = 0; q < 8; ++q) h2[tt * 64 + j0 + q] = sinf(in[IN_FF2][j0 + q] * a[q]);
    }
    __syncthreads();
    {
        bf16* hd = (bf16*)(F.ws + WS_HDN);
        for (int i = tid; i < 64 * 32; i += NT) { const int tt = i >> 5, j = (i & 31) * 2; *(unsigned*)(hd + (size_t)(tile * 64 + tt) * 64 + j) = cvt_pk_bf16(h2[tt * 64 + j], h2[tt * 64 + j + 1]); }
    }
    __syncthreads();
}
__device__ __forceinline__ void p3_uin_tile(Frame& F, int tile) {
    const float* const* in = F.in;
    const bf16* z = (const bf16*)(F.ws + WS_Z); float* uT = (float*)(F.ws + WS_UIN);
    LAS float* tl = (LAS float*)F.lds;
    const int t0 = (tile >> 2) * 64, cb = (tile & 3) * 256;
    const int cg = F.tid & 31, c0 = cb + cg * 8, rsub = F.tid >> 5;
    for (int pass = 0; pass < 4; ++pass) {
        const int tt = pass * 16 + rsub, t = t0 + tt;
        float r1[8], r2[8];
#pragma unroll
        for (int part = 0; part < 2; ++part) {
            const int zc = OFF_HY + 1024 * (part + 1) + c0, wc = 1024 * (part + 1) + c0;
            const v4u cur = *(const v4u*)(z + (size_t)t * NINP + zc);
            const v4u prv = t > 0 ? *(const v4u*)(z + (size_t)(t - 1) * NINP + zc) : (v4u){0u, 0u, 0u, 0u};
            const v4u nxt = t < L - 1 ? *(const v4u*)(z + (size_t)(t + 1) * NINP + zc) : (v4u){0u, 0u, 0u, 0u};
            float* rr = part ? r2 : r1;
#pragma unroll
            for (int q = 0; q < 4; ++q) {
                const unsigned pc = q == 0 ? prv.x : q == 1 ? prv.y : q == 2 ? prv.z : prv.w, cc = q == 0 ? cur.x : q == 1 ? cur.y : q == 2 ? cur.z : cur.w, nc = q == 0 ? nxt.x : q == 1 ? nxt.y : q == 2 ? nxt.z : nxt.w;
                const int ch = wc + 2 * q;
                rr[2 * q] = bflo(pc) * in[IN_CHW][ch] + bflo(cc) * in[IN_CHW][3072 + ch] + bflo(nc) * in[IN_CHW][6144 + ch] + in[IN_CHB][ch];
                rr[2 * q + 1] = bfhi(pc) * in[IN_CHW][ch + 1] + bfhi(cc) * in[IN_CHW][3072 + ch + 1] + bfhi(nc) * in[IN_CHW][6144 + ch + 1] + in[IN_CHB][ch + 1];
            }
        }
#pragma unroll
        for (int q = 0; q < 8; ++q) tl[(cg * 8 + q) * 65 + tt] = r1[q] * r2[q];
    }
    __syncthreads();
    for (int i = F.tid; i < 256 * 16; i += NT) { const int c = i >> 4, tq = (i & 15) * 4; const LAS float* s = tl + c * 65 + tq;
        *(f32x4*)(uT + (size_t)(cb + c) * L + t0 + tq) = (f32x4){s[0], s[1], s[2], s[3]}; }
    __syncthreads();
}

#ifndef FFT_LAS
#define FFT_LAS LAS
#endif
#if defined(__HIP_DEVICE_COMPILE__)
#define FFT_OPAQUE(v) asm volatile("" : "+v"(v))
#else
#define FFT_OPAQUE(v)
#endif
constexpr int FN = 16384;
constexpr int FFT_SLOTS = 18432;
__host__ __device__ __forceinline__ int fphys(int p) { return p + (p >> 3); }
__host__ __device__ __forceinline__ float fcos32(int k) {
    constexpr float T[16] = {1.0f, 0.98078528040323043f, 0.92387953251128674f, 0.83146961230254524f, 0.70710678118654752f, 0.55557023301960218f, 0.38268343236508977f, 0.19509032201612825f,
                             0.0f, -0.19509032201612825f, -0.38268343236508977f, -0.55557023301960218f, -0.70710678118654752f, -0.83146961230254524f, -0.92387953251128674f, -0.98078528040323043f};
    return T[k]; }
__host__ __device__ __forceinline__ float fsin32(int k) {
    constexpr float T[16] = {0.0f, 0.19509032201612825f, 0.38268343236508977f, 0.55557023301960218f, 0.70710678118654752f, 0.83146961230254524f, 0.92387953251128674f, 0.98078528040323043f,
                             1.0f, 0.98078528040323043f, 0.92387953251128674f, 0.83146961230254524f, 0.70710678118654752f, 0.55557023301960218f, 0.38268343236508977f, 0.19509032201612825f};
    return T[k]; }
template <int R> __host__ __device__ __forceinline__ constexpr int fbrev(int x) { int r = 0; for (int b = 1; b < R; b <<= 1) { r = (r << 1) | (x & 1); x >>= 1; } return r; }
__host__ __device__ __forceinline__ f32x2 cx_rot_m(f32x2 d) { return (f32x2){d.y, -d.x}; }
__host__ __device__ __forceinline__ f32x2 cx_rot_p(f32x2 d) { return (f32x2){-d.y, d.x}; }
__host__ __device__ __forceinline__ f32x2 cx_mul_cj(f32x2 d, float c, float s) { return d * c + cx_rot_m(d) * s; }
__host__ __device__ __forceinline__ f32x2 cx_mul(f32x2 d, float c, float s) { return d * c + cx_rot_p(d) * s; }
template <int R, bool INV>
__host__ __device__ __forceinline__ void fft_reg(f32x2 (&x)[R]) {
#pragma unroll
    for (int len = R; len >= 2; len >>= 1) {
        const int half = len >> 1;
#pragma unroll
        for (int blk = 0; blk < R; blk += len)
#pragma unroll
            for (int k = 0; k < half; ++k) {
                const int i0 = blk + k, i1 = i0 + half;
                const f32x2 a = x[i0], b = x[i1];
                x[i0] = a + b;
                const f32x2 d = a - b;
                if (k == 0) x[i1] = d;
                else if (4 * k == len) x[i1] = INV ? cx_rot_p(d) : cx_rot_m(d);
                else { const float c = fcos32(k * (32 / len)), s = fsin32(k * (32 / len)); x[i1] = INV ? cx_mul(d, c, s) : cx_mul_cj(d, c, s); }
            }
    }
}
__host__ __device__ __forceinline__ void ftw(int num, int den, float& c, float& s) {
#if defined(__HIP_DEVICE_COMPILE__)
    const float fr = (float)num * (1.0f / (float)den); c = __builtin_amdgcn_cosf(fr); s = __builtin_amdgcn_sinf(fr);
#else
    const double a = 6.283185307179586476925 * (double)num / (double)den; c = (float)cos(a); s = (float)sin(a);
#endif
}
template <int R, int M>
__host__ __device__ __forceinline__ void fft_fwd_bfly(FFT_LAS float* buf, int B, int j) {
    constexpr int S = M / R, PS = S == 1 ? 1 : S + S / 8;
    FFT_LAS f32x2* p = (FFT_LAS f32x2*)buf + fphys(B + j);
    f32x2 x[R];
#pragma unroll
    for (int q = 0; q < R; ++q) x[q] = p[q * PS];
    fft_reg<R, false>(x);
    if (S > 1) { float c1, s1; ftw(j, M, c1, s1); f32x2 w = (f32x2){c1, -s1};
#pragma unroll
        for (int r = 1; r < R; ++r) { const int ix = fbrev<R>(r); x[ix] = cx_mul(x[ix], w.x, w.y); w = cx_mul_cj(w, c1, s1); } }
#pragma unroll
    for (int r = 0; r < R; ++r) p[r * PS] = x[fbrev<R>(r)];
}
template <int R, int M>
__host__ __device__ __forceinline__ void fft_inv_bfly(FFT_LAS float* buf, int B, int j) {
    constexpr int S = M / R, PS = S == 1 ? 1 : S + S / 8;
    FFT_LAS f32x2* p = (FFT_LAS f32x2*)buf + fphys(B + j);
    f32x2 x[R];
#pragma unroll
    for (int r = 0; r < R; ++r) x[r] = p[r * PS];
    if (S > 1) { float c1, s1; ftw(j, M, c1, s1); f32x2 w = (f32x2){c1, s1};
#pragma unroll
        for (int r = 1; r < R; ++r) { x[r] = cx_mul(x[r], w.x, w.y); w = cx_mul(w, c1, s1); } }
    fft_reg<R, true>(x);
#pragma unroll
    for (int q = 0; q < R; ++q) p[q * PS] = x[fbrev<R>(q)];
}
__host__ __device__ __forceinline__ void fft_fwd_pass(FFT_LAS float* buf, int pass, int tid) {
    FFT_OPAQUE(tid);
    if (pass == 0) {
#pragma unroll 1
        for (int i = 0; i < 2; ++i) fft_fwd_bfly<16, 16384>(buf, 0, tid + 512 * i); }
    else if (pass == 1) {
#pragma unroll 1
        for (int i = 0; i < 2; ++i) { const int id = tid + 512 * i; fft_fwd_bfly<16, 1024>(buf, (id >> 6) * 1024, id & 63); } }
    else if (pass == 2) {
#pragma unroll 1
        for (int i = 0; i < 4; ++i) { const int id = tid + 512 * i; fft_fwd_bfly<8, 64>(buf, (id >> 3) * 64, id & 7); } }
    else {
#pragma unroll 1
        for (int i = 0; i < 4; ++i) { const int id = tid + 512 * i; fft_fwd_bfly<8, 8>(buf, id * 8, 0); } }
}
__host__ __device__ __forceinline__ void fft_inv_pass(FFT_LAS float* buf, int pass, int tid) {
    FFT_OPAQUE(tid);
    if (pass == 0) {
#pragma unroll 1
        for (int i = 0; i < 4; ++i) { const int id = tid + 512 * i; fft_inv_bfly<8, 8>(buf, id * 8, 0); } }
    else if (pass == 1) {
#pragma unroll 1
        for (int i = 0; i < 4; ++i) { const int id = tid + 512 * i; fft_inv_bfly<8, 64>(buf, (id >> 3) * 64, id & 7); } }
    else if (pass == 2) {
#pragma unroll 1
        for (int i = 0; i < 2; ++i) { const int id = tid + 512 * i; fft_inv_bfly<16, 1024>(buf, (id >> 6) * 1024, id & 63); } }
    else {
#pragma unroll 1
        for (int i = 0; i < 2; ++i) fft_inv_bfly<16, 16384>(buf, 0, tid + 512 * i); }
}
__host__ __device__ __forceinline__ int fpos(int k) { return ((k & 15) << 10) | (((k >> 4) & 15) << 6) | (((k >> 8) & 7) << 3) | (k >> 11); }
__host__ __device__ __forceinline__ void fft_mul_one(FFT_LAS float* buf, int k, float cr, float ci, float dr_, float di_, float wc, float ws) {
    const int k2 = (FN - k) & (FN - 1);
    FFT_LAS f32x2* pa = (FFT_LAS f32x2*)(buf + 2 * fphys(fpos(k))); FFT_LAS f32x2* pb = (FFT_LAS f32x2*)(buf + 2 * fphys(fpos(k2)));
    const f32x2 A = *pa, Bm = *pb;
    const float ar = A.x, ai = A.y, br = Bm.x, bi = -Bm.y, dr = dr_, di = -di_;
    const float uer = 0.5f * (ar + br), uei = 0.5f * (ai + bi), uor = 0.5f * (ai - bi), uoi = -0.5f * (ar - br);
    const float ker = 0.5f * (cr + dr), kei = 0.5f * (ci + di), kor = 0.5f * (ci - di), koi = -0.5f * (cr - dr);
    const float pr = uor * kor - uoi * koi, pi = uor * koi + uoi * kor;
    const float yer = (uer * ker - uei * kei) + (pr * wc + pi * ws), yei = (uer * kei + uei * ker) + (pi * wc - pr * ws);
    const float yor = (uer * kor - uei * koi) + (uor * ker - uoi * kei), yoi = (uer * koi + uei * kor) + (uor * kei + uoi * ker);
    *pa = (f32x2){yer - yoi, yei + yor};
    *pb = (f32x2){yer + yoi, -yei + yor};
}
__device__ __forceinline__ void p4_fft_job(Frame& F, int job) {
    const float* const* in = F.in;
    int tid_ = F.tid, lane_ = F.lane; FFT_OPAQUE(tid_); FFT_OPAQUE(lane_);
    const int tid = tid_, lane = lane_, wave = F.wave, c0 = job * 4;
    LAS float* buf = (LAS float*)F.lds;
    LAS float* scr = (LAS float*)(F.lds + FFTSCR_OFF);
    float* hfT = (float*)(F.ws + WS_KF); float* hbT = (float*)(F.ws + WS_KB); const float* uT = (const float*)(F.ws + WS_UIN);
    {
        const bf16* hd = (const bf16*)(F.ws + WS_HDN);
        const int n = lane & 15, kq = lane >> 4, ch = (n >> 1) & 3, dir = n & 1, col = dir * 1024 + c0 + ch; const bool valid = n < 8;
        bf16x8 bfr[2];
#pragma unroll
        for (int ks = 0; ks < 2; ++ks) { unsigned w[4];
#pragma unroll
            for (int j = 0; j < 4; ++j) { const int k = ks * 32 + kq * 8 + 2 * j; const float a = valid ? in[IN_FW3][(size_t)k * 2048 + col] : 0.f, b = valid ? in[IN_FW3][(size_t)(k + 1) * 2048 + col] : 0.f; w[j] = cvt_pk_bf16(a, b); }
            bfr[ks] = __builtin_bit_cast(bf16x8, (v4u){w[0], w[1], w[2], w[3]}); }
        const float b3 = valid ? in[IN_FB3][col] : 0.f;
        const float r_slow = 3.0701134573253945f, r_fast = 15.350567286626972f;
        const float rate = r_slow + (float)(c0 + ch) * ((r_fast - r_slow) / 1023.0f);
        const float nrl = -rate * (1.4426950408889634f / (float)(L - 1));
        float asum = 0.f; float* dst = (dir ? hbT : hfT) + (size_t)(c0 + ch) * L;
#pragma unroll 1
        for (int tb = wave * 8; tb < L / 16; tb += NWAVES * 8) {
            bf16x8 a0[8], a1[8];
#pragma unroll
            for (int i = 0; i < 8; ++i) { const bf16* hp = hd + (size_t)((tb + i) * 16 + n) * 64 + kq * 8; a0[i] = *(const bf16x8*)hp; a1[i] = *(const bf16x8*)(hp + 32); }
#pragma unroll
            for (int i = 0; i < 8; ++i) { const int t0 = (tb + i) * 16;
                f32x4 acc = (f32x4){b3, b3, b3, b3};
                acc = __builtin_amdgcn_mfma_f32_16x16x32_bf16(a0[i], bfr[0], acc, 0, 0, 0);
                acc = __builtin_amdgcn_mfma_f32_16x16x32_bf16(a1[i], bfr[1], acc, 0, 0, 0);
                if (valid) { f32x4 o;
#pragma unroll
                    for (int r = 0; r < 4; ++r) { const int t = t0 + 4 * kq + r; const float v = acc[r] * __builtin_amdgcn_exp2f((float)t * nrl); o[r] = v; if (!(dir && t == 0)) asum += fabsf(v); }
                    *(f32x4*)(dst + t0 + 4 * kq) = o; } }
        }
        asum += __shfl_xor(asum, 16); asum += __shfl_xor(asum, 32);
        if (lane < 8) scr[wave * 8 + lane] = asum;
        VM_WAIT(); __syncthreads();
        float tot = 0.f;
        if (tid < 4) { for (int w = 0; w < 8; ++w) tot += scr[w * 8 + 2 * tid] + scr[w * 8 + 2 * tid + 1]; }
        __syncthreads();
        if (tid < 4) scr[tid] = 1.0f / (tot * (float)FN);
        __syncthreads();
    }
#pragma unroll 1
    for (int ch = 0; ch < 4; ++ch) {
        const int c = c0 + ch;
        const float* hf = hfT + (size_t)c * L; const float* hb = hbT + (size_t)c * L; const float* uc = uT + (size_t)c * L;
#pragma unroll 8
        for (int i = 0; i < 16; ++i) { const int a = tid + NT * i; const f32x2 v = *(const f32x2*)(hf + 2 * a); *(LAS f32x2*)(buf + 2 * fphys(a)) = v; }
#pragma unroll 8
        for (int i = 0; i < 16; ++i) { const int a = FN / 2 + tid + NT * i; const float ko = hb[2 * FN - 2 * a - 1]; float ke = hb[2 * FN - 2 * a]; if (a == FN / 2) ke = 0.f;
            *(LAS f32x2*)(buf + 2 * fphys(a)) = (f32x2){ke, ko}; }
        __syncthreads();
        fft_fwd_pass(buf, 0, tid); __syncthreads(); fft_fwd_pass(buf, 1, tid); __syncthreads(); fft_fwd_pass(buf, 2, tid); __syncthreads(); fft_fwd_pass(buf, 3, tid); __syncthreads();
        {
            int tq = tid; FFT_OPAQUE(tq);
            f32x2* sa = (f32x2*)(hfT + (size_t)c * L); f32x2* sb = (f32x2*)(hbT + (size_t)c * L);
#pragma unroll 4
            for (int m = 0; m < 16; ++m) { const int k = tq + 512 * m, k2 = (FN - k) & (FN - 1);
                sa[m * 512 + tq] = *(const LAS f32x2*)(buf + 2 * fphys(fpos(k))); sb[m * 512 + tq] = *(const LAS f32x2*)(buf + 2 * fphys(fpos(k2))); }
            if (tid == 0) { const f32x2 h = *(const LAS f32x2*)(buf + 2 * fphys(fpos(FN / 2))); scr[8] = h.x; scr[9] = h.y; }
        }
        __syncthreads();
#pragma unroll 8
        for (int i = 0; i < 16; ++i) { const int a = tid + NT * i; const f32x2 v = *(const f32x2*)(uc + 2 * a); *(LAS f32x2*)(buf + 2 * fphys(a)) = v; }
#pragma unroll 4
        for (int i = 0; i < 16; ++i) { const int a = FN / 2 + tid + NT * i; *(LAS f32x2*)(buf + 2 * fphys(a)) = (f32x2){0.f, 0.f}; }
        __syncthreads();
        fft_fwd_pass(buf, 0, tid); __syncthreads(); fft_fwd_pass(buf, 1, tid); __syncthreads(); fft_fwd_pass(buf, 2, tid); __syncthreads(); fft_fwd_pass(buf, 3, tid); __syncthreads();
        {   int tq = tid; FFT_OPAQUE(tq);
            const f32x2* sa = (const f32x2*)(hfT + (size_t)c * L); const f32x2* sb = (const f32x2*)(hbT + (size_t)c * L);
            float c1, s1; ftw(tq, FN, c1, s1);
#pragma unroll 8
            for (int m = 0; m < 16; ++m) { const float cm = fcos32(m), sm = fsin32(m); const float wc = c1 * cm - s1 * sm, ws = s1 * cm + c1 * sm;
                const f32x2 ka = sa[m * 512 + tq], kb = sb[m * 512 + tq];
                fft_mul_one(buf, tq + 512 * m, ka.x, ka.y, kb.x, kb.y, wc, ws); }
            if (tid == 0) fft_mul_one(buf, FN / 2, scr[8], scr[9], scr[8], scr[9], -1.0f, 0.0f);
        }
        VM_WAIT(); __syncthreads();
        fft_inv_pass(buf, 0, tid); __syncthreads(); fft_inv_pass(buf, 1, tid); __syncthreads(); fft_inv_pass(buf, 2, tid); __syncthreads(); fft_inv_pass(buf, 3, tid); __syncthreads();
        { const float sc = scr[ch]; float* yT = hfT + (size_t)c * L;
#pragma unroll 2
            for (int nn = tid; nn < FN / 2; nn += NT) { const f32x2 v = *(const LAS f32x2*)(buf + 2 * fphys(nn)); *(f32x2*)(yT + 2 * nn) = (f32x2){v.x * sc, v.y * sc}; } }
        __syncthreads();
    }
    __syncthreads();
}
__device__ __forceinline__ void p5_hy_finish_tile(Frame& F, int tile) {
    const float* const* in = F.in;
    const int tid = F.tid, t0 = (tile >> 2) * 64, cb = (tile & 3) * 256;
    const float* yT = (const float*)(F.ws + WS_KF); const float* uT = (const float*)(F.ws + WS_UIN);
    const bf16* z = (const bf16*)(F.ws + WS_Z); bf16* cat = (bf16*)(F.ws + WS_CAT);
    LAS float* tl = (LAS float*)F.lds;
#pragma unroll 4
    for (int i = tid; i < 4096; i += NT) { const int c = i >> 4, tq = (i & 15) * 4;
        const f32x4 y4 = *(const f32x4*)(yT + (size_t)(cb + c) * L + t0 + tq), u4 = *(const f32x4*)(uT + (size_t)(cb + c) * L + t0 + tq);
        const float d = in[IN_DSKIP][cb + c]; LAS float* s = tl + c * 65 + tq;
        s[0] = y4.x + d * u4.x; s[1] = y4.y + d * u4.y; s[2] = y4.z + d * u4.z; s[3] = y4.w + d * u4.w; }
    __syncthreads();
    const int t = tid & 63, cg = tid >> 6, T = t0 + t, c0 = cb + 32 * cg;
    const bool hp = T > 0, hn = T < L - 1;
#pragma unroll 1
    for (int q = 0; q < 4; ++q) { const int c = c0 + 8 * q;
        const v4u zc = *(const v4u*)(z + (size_t)T * NINP + OFF_HY + c);
        const v4u zp = hp ? *(const v4u*)(z + (size_t)(T - 1) * NINP + OFF_HY + c) : (v4u){0u, 0u, 0u, 0u};
        const v4u zn = hn ? *(const v4u*)(z + (size_t)(T + 1) * NINP + OFF_HY + c) : (v4u){0u, 0u, 0u, 0u};
        const unsigned cc[4] = {zc.x, zc.y, zc.z, zc.w}, pp[4] = {zp.x, zp.y, zp.z, zp.w}, nn[4] = {zn.x, zn.y, zn.z, zn.w};
        float o[8];
#pragma unroll
        for (int k = 0; k < 4; ++k) { const int ch = c + 2 * k; const LAS float* s = tl + (32 * cg + 8 * q + 2 * k) * 65 + t;
            o[2 * k] = (bflo(pp[k]) * in[IN_CHW][ch] + bflo(cc[k]) * in[IN_CHW][3072 + ch] + bflo(nn[k]) * in[IN_CHW][6144 + ch] + in[IN_CHB][ch]) * s[0];
            o[2 * k + 1] = (bfhi(pp[k]) * in[IN_CHW][ch + 1] + bfhi(cc[k]) * in[IN_CHW][3072 + ch + 1] + bfhi(nn[k]) * in[IN_CHW][6144 + ch + 1] + in[IN_CHB][ch + 1]) * s[65]; }
        v4u w; w.x = cvt_pk_bf16(o[0], o[1]); w.y = cvt_pk_bf16(o[2], o[3]); w.z = cvt_pk_bf16(o[4], o[5]); w.w = cvt_pk_bf16(o[6], o[7]);
        *(v4u*)(cat + (size_t)T * D + MVW + c) = w; }
    __syncthreads();
}

constexpr int RT_PITCH = 2056;
__device__ __forceinline__ void p6_norm2_router(Frame& F) {
    const float* const* in = F.in;
    const float* mod = (const float*)(F.ws + WS_MOD);
    unsigned char* h2g = (unsigned char*)(F.ws + WS_HA);
    int* cnt = (int*)(F.ws + WS_CTL) + CW_CNT;
    int* aexp = (int*)(F.ws + WS_AEXP); int* arank = (int*)(F.ws + WS_ARANK); float* aw = (float*)(F.ws + WS_AW);
    LAS bf16* h1 = (LAS bf16*)F.lds; LAS bf16* h2 = h1 + 16 * RT_PITCH;
    LAS float* part = (LAS float*)(h2 + 16 * RT_PITCH);
    const bf16* w1 = (const bf16*)(F.ws + WS_WR1); const bf16* w2 = (const bf16*)(F.ws + WS_WR2);
    const int lane = F.lane, wave = F.wave, fr = lane & 15, fq = lane >> 4;
    for (int t0 = F.bid * 16; t0 < L; t0 += F.G * 16) {
#pragma unroll 1
        for (int rr = 0; rr < 2; ++rr) {
            const int tr = 2 * wave + rr, t = t0 + tr;
            f32x4 v[8]; float ss = 0.f;
#pragma unroll
            for (int j = 0; j < 8; ++j) { const int col = 4 * lane + 256 * j; v[j] = *(const f32x4*)(F.out + (size_t)t * D + col); ss += (v[j].x * v[j].x + v[j].y * v[j].y) + (v[j].z * v[j].z + v[j].w * v[j].w); }
            const float rstd = rsqrtf(wave_sum(ss) * (1.0f / D) + EPS);
#pragma unroll
            for (int j = 0; j < 8; ++j) { const int col = 4 * lane + 256 * j;
                const f32x4 g = *(const f32x4*)(in[IN_GFFN] + col), sh = *(const f32x4*)(mod + 6144 + col), sc = *(const f32x4*)(mod + 8192 + col);
                const f32x4 h = (v[j] * rstd * g) * (sc + 1.0f) + sh;
                v2u o; o.x = cvt_pk_bf16(h.x, h.y); o.y = cvt_pk_bf16(h.z, h.w);
                *(unsigned*)(h2g + (size_t)t * D + col) = pk_fp8x4(h.x, h.y, h.z, h.w);
                *(LAS v2u*)(h1 + tr * RT_PITCH + col) = o;
                v2u lo; lo.x = cvt_pk_bf16(h.x - bflo(o.x), h.y - bfhi(o.x)); lo.y = cvt_pk_bf16(h.z - bflo(o.y), h.w - bfhi(o.y));
                *(LAS v2u*)(h2 + tr * RT_PITCH + col) = lo; }
        }
        __syncthreads();
        {
            const int nt = wave & 3, kh = wave >> 2;
            f32x4 acc = (f32x4){0.f, 0.f, 0.f, 0.f};
            const bf16* b1p = w1 + (size_t)(16 * nt + fr) * 2048 + kh * 1024 + 8 * fq; const bf16* b2p = w2 + (size_t)(16 * nt + fr) * 2048 + kh * 1024 + 8 * fq;
            const LAS bf16* a1p = h1 + fr * RT_PITCH + kh * 1024 + 8 * fq; const LAS bf16* a2p = h2 + fr * RT_PITCH + kh * 1024 + 8 * fq;
#pragma unroll 8
            for (int ks = 0; ks < 32; ++ks) {
                const bf16x8 a1 = *(const LAS bf16x8*)(a1p + 32 * ks), a2 = *(const LAS bf16x8*)(a2p + 32 * ks);
                const bf16x8 b1 = *(const bf16x8*)(b1p + 32 * ks), b2 = *(const bf16x8*)(b2p + 32 * ks);
                acc = __builtin_amdgcn_mfma_f32_16x16x32_bf16(a2, b1, acc, 0, 0, 0);
                acc = __builtin_amdgcn_mfma_f32_16x16x32_bf16(a1, b2, acc, 0, 0, 0);
                acc = __builtin_amdgcn_mfma_f32_16x16x32_bf16(a1, b1, acc, 0, 0, 0); }
#pragma unroll
            for (int r = 0; r < 4; ++r) part[(kh * 16 + 4 * fq + r) * 64 + 16 * nt + fr] = acc[r];
        }
        __syncthreads();
#pragma unroll 1
        for (int rr = 0; rr < 2; ++rr) {
            const int tr = 2 * wave + rr, t = t0 + tr;
            const float logit = part[tr * 64 + lane] + part[(16 + tr) * 64 + lane];
            const float s = 1.0f / (1.0f + expf(-logit)), sel = s + in[IN_BR][lane];
            const int grp = lane >> 3;
            float m1 = sel; m1 = fmaxf(m1, __shfl_xor(m1, 1)); m1 = fmaxf(m1, __shfl_xor(m1, 2)); m1 = fmaxf(m1, __shfl_xor(m1, 4));
            const unsigned long long gm = 0xFFull << (8 * grp);
            const unsigned long long b1 = __ballot(sel == m1) & gm;
            const int first = __ffsll((long long)b1) - 1;
            float m2 = (lane == first) ? -INFINITY : sel; m2 = fmaxf(m2, __shfl_xor(m2, 1)); m2 = fmaxf(m2, __shfl_xor(m2, 2)); m2 = fmaxf(m2, __shfl_xor(m2, 4));
            const float gs = m1 + m2;
            int grank = 0;
#pragma unroll
            for (int g = 0; g < 8; ++g) { const float og = __shfl(gs, 8 * g); grank += (og > gs || (og == gs && g < grp)) ? 1 : 0; }
            const float masked = grank < 4 ? sel : -INFINITY;
            int rank = 0;
            for (int e2 = 0; e2 < 64; ++e2) { const float om = __shfl(masked, e2); rank += (om > masked || (om == masked && e2 < lane)) ? 1 : 0; }
            const bool chosen = rank < 8;
            const float wsum = wave_sum(chosen ? s : 0.f);
            const unsigned long long cb = __ballot(chosen);
            if (chosen) {
                const int k = (int)__builtin_amdgcn_mbcnt_hi((unsigned)(cb >> 32), __builtin_amdgcn_mbcnt_lo((unsigned)cb, 0u));
                const int half = t >= HALF_T ? 1 : 0;
                const int r = atomicAdd(cnt + half * 64 + lane, 1);
                aexp[t * 8 + k] = lane; arank[t * 8 + k] = r; aw[t * 8 + k] = s / wsum * 2.5f;
            }
        }
        __syncthreads();
    }
}
__device__ __forceinline__ void build_pstart(Frame& F) {
    LAS int* ps = (LAS int*)(F.lds + LDSCTL_OFF);
    const int* cnt = (const int*)(F.ws + WS_CTL) + CW_CNT;
    __syncthreads();
    if (F.tid < 2) { int a = 0;
        for (int e = 0; e < NE; ++e) { ps[F.tid * 66 + e] = a; a += (__hip_atomic_load(cnt + F.tid * 64 + e, __ATOMIC_RELAXED, __HIP_MEMORY_SCOPE_AGENT) + 255) & ~255; }
        ps[F.tid * 66 + 64] = a; ps[F.tid * 66 + 65] = a + HALF_T; }
    __syncthreads();
}
__device__ __forceinline__ void p7_fill_rows(Frame& F) {
    build_pstart(F);
    const LAS int* ps = (const LAS int*)(F.lds + LDSCTL_OFF);
    const int* aexp = (const int*)(F.ws + WS_AEXP); const int* arank = (const int*)(F.ws + WS_ARANK); const float* aw = (const float*)(F.ws + WS_AW);
    int* rt = (int*)(F.ws + WS_RTOK); float* rw = (float*)(F.ws + WS_RW);
    const int gt = F.bid * NT + F.tid, NGT = F.G * NT;
    for (int i = gt; i < L * 8; i += NGT) { const int t = i >> 3, h = t >= HALF_T ? 1 : 0; const int row = ps[h * 66 + aexp[i]] + arank[i];
        rt[h * MAXROWS + row] = t; rw[h * MAXROWS + row] = aw[i]; }
    for (int t = gt; t < L; t += NGT) { const int h = t >= HALF_T ? 1 : 0; const int row = ps[h * 66 + 64] + (t - h * HALF_T);
        rt[h * MAXROWS + row] = t; rw[h * MAXROWS + row] = 1.0f; }
}
__device__ __forceinline__ void moe_combine(Frame& F, int half) {
    const float* const* in = F.in;
    const LAS int* ps = (const LAS int*)(F.lds + LDSCTL_OFF) + half * 66;
    const float* mod = (const float*)(F.ws + WS_MOD);
    const int* aexp = (const int*)(F.ws + WS_AEXP); const int* arank = (const int*)(F.ws + WS_ARANK); const float* aw = (const float*)(F.ws + WS_AW);
    const bf16* Y2 = (const bf16*)(F.ws + WS_Y2);
    const int gw = F.bid * NWAVES + F.wave, NGW = F.G * NWAVES, lane = F.lane;
    for (int tt = gw; tt < HALF_T; tt += NGW) {
        const int t = half * HALF_T + tt;
        float a[32];
#pragma unroll
        for (int i = 0; i < 32; ++i) a[i] = 0.f;
#pragma unroll 3
        for (int k = 0; k < 9; ++k) {
            const int row = k < 8 ? ps[aexp[t * 8 + k]] + arank[t * 8 + k] : ps[64] + tt;
            const float wk = (k < 8 ? aw[t * 8 + k] : 1.0f) * (1.0f / (W2_PRE * HR_PRE));
            const bf16* yr = Y2 + (size_t)row * D + 8 * lane;
#pragma unroll
            for (int j = 0; j < 4; ++j) { const v4u y = *(const v4u*)(yr + 512 * j);
                a[8 * j + 0] += wk * bflo(y.x); a[8 * j + 1] += wk * bfhi(y.x); a[8 * j + 2] += wk * bflo(y.y); a[8 * j + 3] += wk * bfhi(y.y);
                a[8 * j + 4] += wk * bflo(y.z); a[8 * j + 5] += wk * bfhi(y.z); a[8 * j + 6] += wk * bflo(y.w); a[8 * j + 7] += wk * bfhi(y.w); }
        }
        float ss = 0.f;
#pragma unroll
        for (int j = 0; j < 4; ++j)
#pragma unroll
            for (int q = 0; q < 2; ++q) { const int col = 8 * lane + 512 * j + 4 * q;
                const f32x4 x1 = *(const f32x4*)(F.out + (size_t)t * D + col), g2 = *(const f32x4*)(mod + 10240 + col);
                const int i = 8 * j + 4 * q;
                a[i] = x1.x + g2.x * a[i]; a[i + 1] = x1.y + g2.y * a[i + 1]; a[i + 2] = x1.z + g2.z * a[i + 2]; a[i + 3] = x1.w + g2.w * a[i + 3];
                ss += (a[i] * a[i] + a[i + 1] * a[i + 1]) + (a[i + 2] * a[i + 2] + a[i + 3] * a[i + 3]); }
        const float rstd = rsqrtf(wave_sum(ss) * (1.0f / D) + EPS);
#pragma unroll
        for (int j = 0; j < 4; ++j)
#pragma unroll
            for (int q = 0; q < 2; ++q) { const int col = 8 * lane + 512 * j + 4 * q; const int i = 8 * j + 4 * q;
                const f32x4 gf = *(const f32x4*)(in[IN_GFIN] + col);
                *(f32x4*)(F.out + (size_t)t * D + col) = (f32x4){a[i] * rstd * gf.x, a[i + 1] * rstd * gf.y, a[i + 2] * rstd * gf.z, a[i + 3] * rstd * gf.w}; }
    }
}

constexpr int N_PHASES = 14;
__global__ void __launch_bounds__(NT, 2) fwd_kernel(Args args) {
    extern __shared__ __attribute__((aligned(16))) unsigned char lds_raw[];
    Frame F;
    F.lds = (LAS unsigned char*)lds_raw;
    F.tid = threadIdx.x; F.lane = F.tid & 63; F.wave = __builtin_amdgcn_readfirstlane(F.tid >> 6);
    F.bid = blockIdx.x; F.G = gridDim.x;
    F.in = args.in; F.out = args.out; F.ws = args.ws;
    volatile LAS unsigned* MISC = (volatile LAS unsigned*)(F.lds + LDSCTL_OFF + 768);
    if (F.tid < 64) ((LAS unsigned*)(F.lds + LDSCTL_OFF))[F.tid + 192] = 0u;
    __syncthreads();
    unsigned* ctl = (unsigned*)(F.ws + WS_CTL);
    const int lo = args.ph_lo, hi = args.ph_hi;
    XcdBarrier bar; bar.bar = ctl + CW_BAR; bar.x = 0; bar.st = nullptr;
    if (hi - lo > 1) bar = xcd_barrier_post(ctl + CW_BAR, MISC + 8);
#ifndef PH_MASK
#define PH_MASK 0xFFFF
#endif
#define IN(k) (((PH_MASK >> (k)) & 1) && lo <= (k) && (k) < hi)
#define SEAM(k) do { if (IN(k) && IN((k) + 1)) xcd_barrier(bar); } while (0)
#define REP(k) for (int rep_ = 0; rep_ < ((PROBE_DUP) == (k) ? 2 : 1); ++rep_) if ((rep_ ? __syncthreads() : (void)0), true)
    LAS int* ps = (LAS int*)(F.lds + LDSCTL_OFF);

    if (IN(0)) REP(0) { p0_prologue(F); } SEAM(0);
    if (IN(1)) REP(1) { p1_norm1(F); } SEAM(1);
    if (IN(2)) {
        gk::DenseOrder S; S.init(MROWS, NINP, D * 2, F.G, F.bid); S.Bt = (const char*)(F.ws + WS_WIN);
        gk::EpiBf16Store E{(bf16*)(F.ws + WS_Z), NINP, 1.0f};
        gk::gemm_core(F.lds, (const char*)(F.ws + WS_HA), D * 2, S, E);
    }
#if PROBE_DUP == 2
    if (IN(2)) { __syncthreads(); } if (IN(2)) {
        gk::DenseOrder S; S.init(MROWS, NINP, D * 2, F.G, F.bid); S.Bt = (const char*)(F.ws + WS_WIN);
        gk::EpiBf16Store E{(bf16*)(F.ws + WS_Z), NINP, 1.0f};
        gk::gemm_core(F.lds, (const char*)(F.ws + WS_HA), D * 2, S, E);
    }
#endif
    SEAM(2);
    if (IN(3)) REP(3) {
        for (int it = F.bid; it < 1040; it += F.G) ml_prep_item(F, it);
        for (int tile = F.bid; tile < 256; tile += F.G) p3_filter_tile(F, tile);
        for (int tile = F.bid; tile < 1024; tile += F.G) p3_uin_tile(F, tile);
    } SEAM(3);
    if (IN(4)) REP(4) {
        ml_scan(F);
        __syncthreads();
        for (int job = F.bid; job < 256; job += F.G) p4_fft_job(F, job);
    } SEAM(4);
    if (IN(5)) REP(5) {
        for (int it = F.bid; it < 1024; it += F.G) ml_out_item(F, it);
        for (int tile = F.bid; tile < 1024; tile += F.G) p5_hy_finish_tile(F, tile);
    } SEAM(5);
    if (IN(6)) {
        gk::DenseOrder S; S.init(L, D, D * 2, F.G, F.bid); S.Bt = (const char*)(F.ws + WS_WOUT);
        gk::EpiResidual E{F.out, D, (const float*)(F.ws + WS_MOD) + 4096};
        gk::gemm_core(F.lds, (const char*)(F.ws + WS_CAT), D * 2, S, E);
    } SEAM(6);
    if (IN(7)) { p6_norm2_router(F); } SEAM(7);
    if (IN(8)) { p7_fill_rows(F); } SEAM(8);
#define MOE_GU(h) do { build_pstart(F); \
        gk::GroupOrder<4, true> S; S.ntile = ps[(h) * 66 + 65] >> 8; S.G = F.G; S.c = F.bid; S.KB = D; S.pstart = ps + (h) * 66; S.rtok = (const int*)(F.ws + WS_RTOK) + (h) * MAXROWS; \
        S.Bt = (const char*)(F.ws + WS_W13); S.bstride = (size_t)1024 * D; \
        gk::EpiGateUpF8 E{(unsigned char*)(F.ws + WS_HR), 1.0f / W13_PRE, HR_PRE}; \
        gk::gemm_core<gk::EpiGateUpF8, gk::GroupOrder<4, true>, true>(F.lds, (const char*)(F.ws + WS_HA), D, S, E); } while (0)
#define MOE_DN(h) do { build_pstart(F); \
        gk::GroupOrder<8, false> S; S.ntile = ps[(h) * 66 + 65] >> 8; S.G = F.G; S.c = F.bid; S.KB = DE; S.pstart = ps + (h) * 66; S.rtok = nullptr; \
        S.Bt = (const char*)(F.ws + WS_W2); S.bstride = (size_t)D * DE; \
        gk::EpiBf16Store E{(bf16*)(F.ws + WS_Y2), D, 1.0f}; \
        gk::gemm_core<gk::EpiBf16Store, gk::GroupOrder<8, false>, true>(F.lds, (const char*)(F.ws + WS_HR), DE, S, E); } while (0)
    if (IN(9)) REP(9) { MOE_GU(0); } SEAM(9);
    if (IN(10)) REP(10) { MOE_DN(0); } SEAM(10);
    if (IN(11)) { MOE_GU(1); moe_combine(F, 0); } SEAM(11);
    if (IN(12)) REP(12) { MOE_DN(1); } SEAM(12);
    if (IN(13)) { build_pstart(F); moe_combine(F, 1); }
#undef IN
#undef SEAM
}

extern "C" void kernel_launch(void* const* d_in, const int* in_sizes, int n_in, void* d_out, int out_size, void* d_ws, size_t ws_size, hipStream_t stream) {
    static int grid = 0;
    if (grid == 0) {
        if (n_in != 36 || out_size != L * D || ws_size < WS_END) { fprintf(stderr, "kernel_launch: unexpected shapes: n_in %d out %d ws %zu (need %zu)\n", n_in, out_size, ws_size, (size_t)WS_END); grid = -1; return; }
        int dev = 0, cus = 0, per_cu = 0;
        if (hipGetDevice(&dev) != hipSuccess || hipDeviceGetAttribute(&cus, hipDeviceAttributeMultiprocessorCount, dev) != hipSuccess) { grid = -1; return; }
        if (hipFuncSetAttribute((const void*)fwd_kernel, hipFuncAttributeMaxDynamicSharedMemorySize, LDS_BYTES) != hipSuccess) { fprintf(stderr, "kernel_launch: hipFuncSetAttribute failed\n"); grid = -1; return; }
        if (hipOccupancyMaxActiveBlocksPerMultiprocessor(&per_cu, (const void*)fwd_kernel, NT, LDS_BYTES) != hipSuccess || per_cu < 1) fprintf(stderr, "kernel_launch: occupancy query says %d\n", per_cu);
        (void)hipGetLastError();
        grid = cus;
    }
    if (grid < 0) return;
    if (hipMemsetAsync((char*)d_ws + WS_CTL, 0, CTL_ZERO_BYTES, stream) != hipSuccess) return;
    Args a{};
    for (int i = 0; i < 36; ++i) a.in[i] = (const float*)d_in[i];
    a.out = (float*)d_out; a.ws = (unsigned char*)d_ws;
    const int stop = MK_STOP_AFTER < N_PHASES ? MK_STOP_AFTER + 1 : N_PHASES;
#if MK_N_LAUNCHES == 1
    a.ph_lo = 0; a.ph_hi = stop;
    hipLaunchKernelGGL(fwd_kernel, dim3(grid), dim3(NT), LDS_BYTES, stream, a);
#else
    for (int p = 0; p < stop; ++p) { a.ph_lo = p; a.ph_hi = p + 1; hipLaunchKernelGGL(fwd_kernel, dim3(grid), dim3(NT), LDS_BYTES, stream, a); }
#endif
}
```

```cpp
#include <hip/hip_runtime.h>
#include <cstdio>
#include <cstdint>

#ifndef MK_N_LAUNCHES
#define MK_N_LAUNCHES 1
#endif
#ifndef PROBE_DUP
#define PROBE_DUP -1
#endif
#ifndef MK_STOP_AFTER
#define MK_STOP_AFTER 99
#endif

#define GAS __attribute__((address_space(1)))
#define LAS __attribute__((address_space(3)))
typedef unsigned short bf16;
typedef unsigned v4u __attribute__((ext_vector_type(4)));
typedef unsigned v2u __attribute__((ext_vector_type(2)));
typedef float f32x4 __attribute__((ext_vector_type(4)));
typedef float f32x2 __attribute__((ext_vector_type(2)));
typedef short bf16x8 __attribute__((ext_vector_type(8)));
#define LDS_WAIT() asm volatile("s_waitcnt lgkmcnt(0)" ::: "memory")
#define VM_WAIT() asm volatile("s_waitcnt vmcnt(0)" ::: "memory")

constexpr int NWAVES = 8, NT = NWAVES * 64;
constexpr int L = 16384, D = 2048, LC = 256, MROWS = L + LC;
constexpr int NIN = 6176, NINP = 6400;
constexpr int OFF_K = 0, OFF_V = 512, OFF_G = 1536, OFF_Q = 1568, OFF_O = 2080, OFF_HY = 3104;
constexpr int NH = 8, HYW = 1024, MVW = 1024;
constexpr int NE = 64, NE1 = 65, DE = 512;
constexpr int HALF_T = L;
constexpr int MAXROWS = 163840;
constexpr float EPS = 1e-6f;
constexpr float W13_PRE = 64.0f, W2_PRE = 32.0f, HR_PRE = 4.0f, Y2_PRE = 8.0f;

constexpr size_t MiB = 1u << 20;
constexpr size_t WS_CTL = 0, CTL_ZERO_BYTES = 256 * 1024;
constexpr size_t WS_MOD = 1 * MiB;
constexpr size_t WS_POS = WS_MOD + 128 * 1024;
constexpr size_t WS_WR1 = 2 * MiB + 512 * 1024;
constexpr size_t WS_WR2 = WS_WR1 + 256 * 1024;
constexpr size_t WS_WIN = 3 * MiB;
constexpr size_t WS_WOUT = 28 * MiB;
constexpr size_t WS_W13 = 36 * MiB;
constexpr size_t WS_YG = 166 * MiB;
constexpr size_t WS_W2 = 296 * MiB;
constexpr size_t WS_HA = 426 * MiB;
constexpr size_t WS_Z = 491 * MiB;
constexpr size_t WS_CAT = 695 * MiB;
constexpr size_t WS_UIN = 759 * MiB;
constexpr size_t WS_KF = 823 * MiB;
constexpr size_t WS_KB = 887 * MiB;
constexpr size_t WS_CL = 426 * MiB;
constexpr size_t WS_CI = 951 * MiB;
constexpr size_t WS_Q = 983 * MiB;
constexpr size_t WS_K = 999 * MiB;
constexpr size_t WS_RTOK = 1015 * MiB;
constexpr size_t WS_RW = WS_RTOK + MAXROWS * 4;
constexpr size_t WS_AEXP = 1017 * MiB;
constexpr size_t WS_ARANK = WS_AEXP + 512 * 1024;
constexpr size_t WS_AW = WS_ARANK + 512 * 1024;
constexpr size_t WS_CNTB = WS_AW + 512 * 1024;
constexpr size_t WS_HDN = 1019 * MiB;
constexpr size_t WS_SC = 1021 * MiB;
constexpr size_t WS_NL = WS_SC + 32 * 1024;
constexpr size_t WS_NI = WS_NL + 640 * 1024;
constexpr size_t WS_MI = WS_NI + 640 * 1024;
constexpr size_t WS_END = 1023 * MiB;
constexpr size_t WS_HR = 491 * MiB;
constexpr size_t WS_Y2 = 579 * MiB;
static_assert(WS_HR + (size_t)MAXROWS * 512 <= WS_Y2 && WS_Y2 + (size_t)MAXROWS * 2048 <= WS_CI && WS_RW + (size_t)MAXROWS * 4 <= 1017 * MiB, "overlay");
constexpr int CW_BAR = 4096;
constexpr int CW_CNT = 16384;
constexpr int CW_QCONV = 20480;

constexpr int RING_BYTES = 131072;
constexpr int LDSCTL_OFF = 147456;
constexpr int FFTSCR_OFF = LDSCTL_OFF + 1024;
constexpr int LDS_BYTES = 151552;

__device__ __forceinline__ unsigned cvt_pk_bf16(float lo, float hi) { unsigned r; asm volatile("v_cvt_pk_bf16_f32 %0, %1, %2" : "=v"(r) : "v"(lo), "v"(hi)); return r; }
__device__ __forceinline__ float bf2f(unsigned short b) { return __builtin_bit_cast(float, ((unsigned)b) << 16); }
__device__ __forceinline__ float bflo(unsigned u) { return __builtin_bit_cast(float, u << 16); }
__device__ __forceinline__ float bfhi(unsigned u) { return __builtin_bit_cast(float, u & 0xffff0000u); }
__device__ __forceinline__ float wave_sum(float v) {
#pragma unroll
    for (int o = 1; o < 64; o <<= 1) v += __shfl_xor(v, o);
    return v;
}
__device__ __forceinline__ float silu_f(float a) { return a / (1.f + __expf(-a)); }
__device__ __forceinline__ float sigmoid_f(float a) { return 1.f / (1.f + __expf(-a)); }

#define XB_TMO      128
#define XB_XCNT(j)  (256  + 64 * (j))
#define XB_XSUB(j)  (1280 + 64 * (j))
#define XB_XGEN(j)  (2304 + 64 * (j))
#define XB_TOP      3328
#define XB_TOPGEN   3392
#define XCD_BAR_WORDS 3456
#define XB_SPIN_CAP (1u << 18)

__device__ __forceinline__ unsigned xb_ld(unsigned* p)              { return __hip_atomic_load(p, __ATOMIC_RELAXED, __HIP_MEMORY_SCOPE_AGENT); }
__device__ __forceinline__ unsigned xb_add(unsigned* p, unsigned v) { return __hip_atomic_fetch_add(p, v, __ATOMIC_RELAXED, __HIP_MEMORY_SCOPE_AGENT); }
__device__ __forceinline__ unsigned xb_xcc_id() { return (unsigned)__builtin_amdgcn_s_getreg((3 << 11) | 20) & 0xFu; }
#define XB_SPIN(cond, bar) do { unsigned _sp = 0; while (cond) { __builtin_amdgcn_s_sleep(1); \
    if ((++_sp & 255u) == 0u) { if (xb_ld(&(bar)[XB_TMO])) break; if (_sp > XB_SPIN_CAP) { atomicAdd(&(bar)[XB_TMO], 1u); break; } } } } while (0)

struct XcdBarrier {
    unsigned* bar; unsigned x;
    volatile LAS unsigned* st;
};

__device__ __forceinline__ XcdBarrier xcd_barrier_post(unsigned* bar, volatile LAS unsigned* st) {
    XcdBarrier b; b.bar = bar; b.x = xb_xcc_id(); b.st = st;
    if (threadIdx.x == 0) (void)xb_add(&bar[XB_XCNT(b.x)], 1u);
    return b;
}
__device__ __forceinline__ void xcd_barrier_complete(unsigned* bar, unsigned x, unsigned& nloc, unsigned& nx) {
    const unsigned G = gridDim.x * gridDim.y * gridDim.z;
    unsigned sum, cnt, mine, sp = 0u;
    for (;;) {
        sum = 0u; cnt = 0u; mine = 0u;
#pragma unroll
        for (unsigned j = 0; j < 16; ++j) { const unsigned c = xb_ld(&bar[XB_XCNT(j)]); sum += c; cnt += (c > 0u) ? 1u : 0u; mine = (j == x) ? c : mine; }
        if (sum == G) break;
        __builtin_amdgcn_s_sleep(1);
        if ((++sp & 255u) == 0u) { if (xb_ld(&bar[XB_TMO])) break; if (sp > XB_SPIN_CAP) { atomicAdd(&bar[XB_TMO], 1u); break; } }
    }
    nloc = mine > 0u ? mine : 1u; nx = cnt > 0u ? cnt : 1u;
}

__device__ __forceinline__ void xcd_barrier(const XcdBarrier& b) {
    asm volatile("s_waitcnt vmcnt(0)" ::: "memory");
    __syncthreads();
    if (threadIdx.x == 0) {
        unsigned* bar = b.bar;
        __builtin_amdgcn_s_waitcnt(0);
        unsigned nloc = b.st[0], nx = b.st[1];
        if (nloc == 0u) { xcd_barrier_complete(bar, b.x, nloc, nx); b.st[0] = nloc; b.st[1] = nx; }
        const unsigned old = xb_add(&bar[XB_XSUB(b.x)], 1u);
        const unsigned gen = old / nloc;
        if (old + 1u == (gen + 1u) * nloc) {
            __builtin_amdgcn_fence(__ATOMIC_RELEASE, "agent");
            asm volatile("s_waitcnt vmcnt(0)" ::: "memory");
            const unsigned og = xb_add(&bar[XB_TOP], 1u);
            const unsigned tg = og / nx;
            if (og + 1u == (tg + 1u) * nx) xb_add(&bar[XB_TOPGEN], 1u);
            else XB_SPIN(xb_ld(&bar[XB_TOPGEN]) == tg, bar);
            __builtin_amdgcn_fence(__ATOMIC_ACQUIRE, "agent");
            xb_add(&bar[XB_XGEN(b.x)], 1u);
            asm volatile("s_waitcnt vmcnt(0)" ::: "memory");
        } else {
            XB_SPIN(xb_ld(&bar[XB_XGEN(b.x)]) == gen, bar);
            __builtin_amdgcn_fence(__ATOMIC_ACQUIRE, "agent");
            asm volatile("s_waitcnt vmcnt(0)" ::: "memory");
        }
    }
    __syncthreads();
}

namespace gk {
constexpr int BM = 256, BK = 64, HALF = 128, HTB = HALF * BK * 2, STAGE_BYTES = 8 * HTB, NXCD = 8, WGM = 8;
__host__ __device__ __forceinline__ int lds_byte(int r, int c) { const int st = (r >> 4) * 2 + (c >> 5), rr = r & 15, cc = c & 31, ob = rr * 64 + cc * 2; return st * 1024 + (ob ^ (((ob >> 9) & 1) << 5)); }
__host__ __device__ __forceinline__ void stage_rc(int b, int& R, int& C) { const int st = b / 1024, sb = b % 1024, swz = sb ^ (((sb >> 9) & 1) << 5); R = (st >> 1) * 16 + swz / 64; C = (st & 1) * 32 + (swz % 64) / 2; }
__host__ __device__ __forceinline__ int perm32(int rho) { const int n = rho >> 4, i = rho & 15; return 8 * (i >> 2) + 4 * n + (i & 3); }

struct Unit { int pm, pn, ex; };

typedef int v8i_t __attribute__((ext_vector_type(8)));
typedef int v4i_t __attribute__((ext_vector_type(4)));
template <class Epi, class Sched, bool F8 = false>
__device__ __forceinline__ void gemm_core(LAS unsigned char* lds, const char* Abase, const int KB_  , const Sched& S, const Epi& E, const int stag = 0  ) {
    int KBo = KB_; asm volatile("" : "+s"(KBo)); const int KB = KBo;
    if (stag > 0) {
        const unsigned long long t0 = __builtin_amdgcn_s_memrealtime(), tgt = t0 + (unsigned long long)((blockIdx.x >> 3) & 7u) * (unsigned)stag;
        while (__builtin_amdgcn_s_memrealtime() < tgt) __builtin_amdgcn_s_sleep(8);
    }
    const int tid = threadIdx.x, wid = __builtin_amdgcn_readfirstlane(tid >> 6), lane = tid & 63, wr = wid >> 2, wc = wid & 3, fr = lane & 15, fq = lane >> 4;
    const int nt = KB / (BK * 2);
    int RA[2], CA[2]; unsigned voffB[2];
#pragma unroll
    for (int i = 0; i < 2; ++i) { int R, C; stage_rc(tid * 16 + i * 8192, R, C);
        const int Rb = Epi::P64 ? (64 * (R >> 5) + 16 * ((R & 15) >> 2) + 4 * ((R >> 4) & 1) + (R & 3)) : Epi::P32 ? (64 * (R >> 5) + 8 * ((R & 15) >> 2) + 4 * ((R >> 4) & 1) + (R & 3)) : Epi::PERM ? ((R & ~31) + perm32(R & 31)) : R;
        RA[i] = R; CA[i] = C; voffB[i] = (unsigned)(Rb * KB + C * 2); }
    const size_t kstep = (size_t)(BK * 2), kstepA = (size_t)Sched::KSTEP_A;
    const size_t hstepB = (size_t)(Epi::P64 ? 8 : Epi::P32 ? 32 : HALF) * KB;
    const unsigned ldsw = (unsigned)wid * 1024u;
    const int aoff = lds_byte(wr * 64 + fr, fq * 8), boff = lds_byte(wc * 32 + fr, fq * 8);
#define GK_SA(b, h) (((b) * 2 + (h)) * HTB)
#define GK_SB(b, h) ((4 + (b) * 2 + (h)) * HTB)
#define GK_STAGE(bufoff, gbase, v0, v1) do { \
        __builtin_amdgcn_global_load_lds((const unsigned*)((const char*)(gbase) + (v0)), (LAS unsigned*)(lds + (bufoff) + ldsw), 16, 0, 0); \
        __builtin_amdgcn_global_load_lds((const unsigned*)((const char*)(gbase) + (v1)), (LAS unsigned*)(lds + (bufoff) + ldsw + 8192), 16, 0, 0); } while (0)
#define GK_LDA(dst, b, h) do { _Pragma("unroll") for (int m = 0; m < 4; ++m) _Pragma("unroll") for (int k = 0; k < 2; ++k) dst[m][k] = *(const LAS bf16x8*)(lds + GK_SA(b, h) + aoff + m * 2048 + k * 1024); } while (0)
#define GK_LDB(dst, b, h) do { _Pragma("unroll") for (int n = 0; n < 2; ++n) _Pragma("unroll") for (int k = 0; k < 2; ++k) dst[n][k] = *(const LAS bf16x8*)(lds + GK_SB(b, h) + boff + n * 2048 + k * 1024); } while (0)
#define GK_MMA(ai, bj, At, Bt) do { __builtin_amdgcn_s_setprio(1); _Pragma("unroll") for (int m = 0; m < 4; ++m) _Pragma("unroll") for (int n = 0; n < 2; ++n) { \
        if constexpr (F8) { const v8i_t bb = __builtin_shufflevector(__builtin_bit_cast(v4i_t, Bt[n][0]), __builtin_bit_cast(v4i_t, Bt[n][1]), 0, 1, 2, 3, 4, 5, 6, 7); \
            const v8i_t aa = __builtin_shufflevector(__builtin_bit_cast(v4i_t, At[m][0]), __builtin_bit_cast(v4i_t, At[m][1]), 0, 1, 2, 3, 4, 5, 6, 7); \
            asm volatile("v_mfma_scale_f32_16x16x128_f8f6f4 %0, %1, %2, %0, %3, %3 op_sel_hi:[0,0,0]" : "+v"(acc[ai][bj][m][n]) : "v"(bb), "v"(aa), "v"(f8scale)); } \
        else { _Pragma("unroll") for (int k = 0; k < 2; ++k) acc[ai][bj][m][n] = __builtin_amdgcn_mfma_f32_16x16x32_bf16(Bt[n][k], At[m][k], acc[ai][bj][m][n], 0, 0, 0); } } \
        __builtin_amdgcn_s_setprio(0); } while (0)
#define GK_WAIT_V(n) asm volatile("s_waitcnt vmcnt(" #n ")" ::: "memory")
#define GK_WAIT_L(n) asm volatile("s_waitcnt lgkmcnt(" #n ")" ::: "memory")
#define GK_BAR __builtin_amdgcn_s_barrier()
#define GK_SCHED __builtin_amdgcn_sched_barrier(0)
    Unit cur, nxt; int ui = 0;
    if (!S.next(0, cur)) return;
    int f8scale = 0x7F7F7F7F; asm volatile("" : "+v"(f8scale));
    f32x4 acc[2][2][4][2];
#pragma unroll
    for (int a = 0; a < 2; ++a)
#pragma unroll
        for (int b = 0; b < 2; ++b)
#pragma unroll
            for (int m = 0; m < 4; ++m)
#pragma unroll
                for (int n = 0; n < 2; ++n) acc[a][b][m][n] = (f32x4){0.f, 0.f, 0.f, 0.f};
    bf16x8 At[4][2], B0[2][2], B1[2][2];
    unsigned c00, c01, c10, c11, n00, n01, n10, n11;
    S.a_offs(cur, RA, CA, c00, c01, c10, c11);
    asm volatile("" : "+v"(c00), "+v"(c01), "+v"(c10), "+v"(c11));
    const char* cB = S.b_base(cur);
    GK_STAGE(GK_SB(0, 0), cB, voffB[0], voffB[1]); GK_STAGE(GK_SB(0, 1), cB + hstepB, voffB[0], voffB[1]); GK_STAGE(GK_SA(0, 0), Abase, c00, c01); GK_STAGE(GK_SA(0, 1), Abase, c10, c11);
    if (wr == 1) GK_BAR;
    GK_WAIT_V(2); GK_BAR;
    GK_STAGE(GK_SB(1, 0), cB + kstep, voffB[0], voffB[1]); GK_STAGE(GK_SA(1, 0), Abase + kstepA, c00, c01); GK_STAGE(GK_SB(1, 1), cB + hstepB + kstep, voffB[0], voffB[1]);
    GK_WAIT_V(6); GK_BAR;
    for (;;) {
        const bool has_next = S.next(ui + 1, nxt);
        const char* nB = cB;
        n00 = c00; n01 = c01; n10 = c10; n11 = c11;
        if (has_next) { S.a_offs(nxt, RA, CA, n00, n01, n10, n11); nB = S.b_base(nxt); }
        asm volatile("" : "+v"(n00), "+v"(n01), "+v"(n10), "+v"(n11));
        for (int t = 0; t < nt; t += 2) {
            const bool last = (t == nt - 2);
            const char* a1 = Abase + (size_t)(t + 1) * kstepA;
            const char* a2 = last ? Abase : Abase + (size_t)(t + 2) * kstepA; const char* b2 = last ? nB : cB + (size_t)(t + 2) * kstep;
            const char* a3 = a2 + kstepA; const char* b3 = b2 + kstep;
            const unsigned x00 = last ? n00 : c00, x01 = last ? n01 : c01, x10 = last ? n10 : c10, x11 = last ? n11 : c11;
            GK_LDB(B0, 0, 0); GK_LDB(B1, 0, 1); GK_SCHED; GK_LDA(At, 0, 0); GK_STAGE(GK_SA(1, 1), a1, c10, c11);
            GK_WAIT_V(8); GK_WAIT_L(0); GK_BAR; GK_MMA(0, 0, At, B0); GK_MMA(0, 1, At, B1); GK_BAR; GK_SCHED;
            GK_LDA(At, 0, 1); GK_STAGE(GK_SB(0, 0), b2, voffB[0], voffB[1]); GK_STAGE(GK_SB(0, 1), b2 + hstepB, voffB[0], voffB[1]); GK_STAGE(GK_SA(0, 0), a2, x00, x01);
            GK_WAIT_V(8); GK_WAIT_L(0); GK_BAR; GK_MMA(1, 0, At, B0); GK_MMA(1, 1, At, B1); GK_BAR; GK_SCHED;
            GK_LDB(B0, 1, 0); GK_LDB(B1, 1, 1); GK_SCHED; GK_LDA(At, 1, 0); GK_STAGE(GK_SA(0, 1), a2, x10, x11);
            GK_WAIT_V(8); GK_WAIT_L(0); GK_BAR; GK_MMA(0, 0, At, B0); GK_MMA(0, 1, At, B1); GK_BAR; GK_SCHED;
            GK_LDA(At, 1, 1); GK_STAGE(GK_SB(1, 0), b3, voffB[0], voffB[1]); GK_STAGE(GK_SB(1, 1), b3 + hstepB, voffB[0], voffB[1]); GK_STAGE(GK_SA(1, 0), a3, x00, x01);
            GK_WAIT_V(8); GK_WAIT_L(0); GK_BAR; GK_MMA(1, 0, At, B0); GK_MMA(1, 1, At, B1); GK_BAR; GK_SCHED;
        }
        if (wr == 0) GK_BAR;
        if constexpr (F8) {
#define GK_ACC8(a, b) "+v"(acc[a][b][0][0]), "+v"(acc[a][b][0][1]), "+v"(acc[a][b][1][0]), "+v"(acc[a][b][1][1]), "+v"(acc[a][b][2][0]), "+v"(acc[a][b][2][1]), "+v"(acc[a][b][3][0]), "+v"(acc[a][b][3][1])
            asm volatile("s_nop 15\n\ts_nop 15\n\ts_nop 15\n\ts_nop 15\n\ts_nop 15\n\ts_nop 15" : GK_ACC8(0, 0), GK_ACC8(0, 1) :: "memory");
            asm volatile("" : GK_ACC8(1, 0), GK_ACC8(1, 1) :: "memory");
#undef GK_ACC8
        }
        E(acc, cur, wr, wc, fr, fq);
        if (!has_next) break;
#pragma unroll
        for (int a = 0; a < 2; ++a)
#pragma unroll
            for (int b = 0; b < 2; ++b)
#pragma unroll
                for (int m = 0; m < 4; ++m)
#pragma unroll
                    for (int n = 0; n < 2; ++n) acc[a][b][m][n] = (f32x4){0.f, 0.f, 0.f, 0.f};
        cur = nxt; cB = nB; c00 = n00; c01 = n01; c10 = n10; c11 = n11; ++ui;
        if (wr == 1) GK_BAR;
    }
    GK_WAIT_V(0);
    GK_BAR;
#undef GK_SA
#undef GK_SB
#undef GK_STAGE
#undef GK_LDA
#undef GK_LDB
#undef GK_MMA
#undef GK_WAIT_V
#undef GK_WAIT_L
#undef GK_BAR
#undef GK_SCHED
}

struct DenseOrder {
    static constexpr int KSTEP_A = BK * 2;
    int nM, nN, nwg, G, c, KB, nExtra;
    __device__ void init(int M, int N, int KB_, int G_, int c_) { nM = M / BM; nN = N / BM; nwg = nM * nN; G = G_; c = c_; KB = KB_; nExtra = 0; }
    __device__ __forceinline__ bool next(int i, Unit& u) const {
        const long Lx = (long)i * G + c;
        if (Lx >= nwg) { if (Lx < nwg + nExtra) { u.pm = nM; u.pn = (int)(Lx - nwg); u.ex = 0; return true; } return false; }
        int wgid = (int)Lx; { const int q = nwg / NXCD, r = nwg % NXCD, xcd = wgid % NXCD, off = wgid / NXCD; wgid = (xcd < r ? xcd * (q + 1) : r * (q + 1) + (xcd - r) * q) + off; }
        const int nig = WGM * nN, gid = wgid / nig, fm = gid * WGM, gsz = (nM - fm) < WGM ? (nM - fm) : WGM;
        u.pm = fm + ((wgid % nig) % gsz); u.pn = (wgid % nig) / gsz; u.ex = 0; return true;
    }
    const char* Bt;
    __device__ __forceinline__ void a_offs(const Unit& u, const int (&RA)[2], const int (&CA)[2], unsigned& o00, unsigned& o01, unsigned& o10, unsigned& o11) const {
        const unsigned r0 = (unsigned)(u.pm * BM);
        o00 = (r0 + RA[0]) * (unsigned)KB + CA[0] * 2u; o01 = (r0 + RA[1]) * (unsigned)KB + CA[1] * 2u;
        o10 = (r0 + HALF + RA[0]) * (unsigned)KB + CA[0] * 2u; o11 = (r0 + HALF + RA[1]) * (unsigned)KB + CA[1] * 2u;
    }
    __device__ __forceinline__ const char* b_base(const Unit& u) const { return Bt + (size_t)u.pn * BM * KB; }
};
__host__ __device__ __forceinline__ unsigned hr4_off(unsigned R, unsigned cb) { return (((R >> 2) * 16u + (cb >> 5)) << 7) + ((R & 3u) << 5) + (cb & 31u); }
template <int NPN, bool GATHER, bool HR4 = false>
struct GroupOrder {
    static constexpr int KSTEP_A = HR4 ? 512 : BK * 2;
    int ntile, G, c, KB;
    const LAS int* pstart;
    const LAS unsigned char* texp;
    const int* rtok;
    const char* Bt; size_t bstride;
    __device__ __forceinline__ bool next(int i, Unit& u) const {
        const int x = c & 7, j = c >> 3, nj = G >> 3, T8 = (ntile + 7) >> 3, tlo = x * T8, thi = (tlo + T8) < ntile ? (tlo + T8) : ntile;
        const int Lx = i * nj + j, tl = Lx / NPN; if (tlo + tl >= thi) return false;
        u.pm = tlo + tl; u.pn = Lx % NPN;
        u.ex = texp[u.pm]; return true;
    }
    __device__ __forceinline__ void a_offs(const Unit& u, const int (&RA)[2], const int (&CA)[2], unsigned& o00, unsigned& o01, unsigned& o10, unsigned& o11) const {
        const int r0 = u.pm * BM;
        if (GATHER) {
            const int t00 = rtok[r0 + RA[0]], t01 = rtok[r0 + RA[1]], t10 = rtok[r0 + HALF + RA[0]], t11 = rtok[r0 + HALF + RA[1]];
            o00 = (unsigned)t00 * (unsigned)KB + CA[0] * 2u; o01 = (unsigned)t01 * (unsigned)KB + CA[1] * 2u;
            o10 = (unsigned)t10 * (unsigned)KB + CA[0] * 2u; o11 = (unsigned)t11 * (unsigned)KB + CA[1] * 2u;
        } else if (HR4) {
            o00 = hr4_off((unsigned)(r0 + RA[0]), CA[0] * 2u); o01 = hr4_off((unsigned)(r0 + RA[1]), CA[1] * 2u);
            o10 = hr4_off((unsigned)(r0 + HALF + RA[0]), CA[0] * 2u); o11 = hr4_off((unsigned)(r0 + HALF + RA[1]), CA[1] * 2u);
        } else {
            o00 = (unsigned)(r0 + RA[0]) * (unsigned)KB + CA[0] * 2u; o01 = (unsigned)(r0 + RA[1]) * (unsigned)KB + CA[1] * 2u;
            o10 = (unsigned)(r0 + HALF + RA[0]) * (unsigned)KB + CA[0] * 2u; o11 = (unsigned)(r0 + HALF + RA[1]) * (unsigned)KB + CA[1] * 2u;
        }
    }
    __device__ __forceinline__ const char* b_base(const Unit& u) const { return Bt + (size_t)u.ex * bstride + (size_t)u.pn * BM * KB; }
};

struct EpiBf16Store {
    static constexpr bool PERM = true;
    static constexpr bool P64 = false;
    static constexpr bool P32 = true;
    bf16* O; int ldc; float sc;
    __device__ __forceinline__ void operator()(const f32x4 (&acc)[2][2][4][2], const Unit& u, int wr, int wc, int fr, int fq) const {
        const int row0 = u.pm * BM + wr * 64 + fr, col0 = u.pn * BM + wc * 64 + 8 * fq;
#pragma unroll
        for (int ai = 0; ai < 2; ++ai)
#pragma unroll
            for (int m = 0; m < 4; ++m) { bf16* rowp = O + (size_t)(row0 + ai * HALF + m * 16) * ldc + col0;
#pragma unroll
                for (int bj = 0; bj < 2; ++bj) { const f32x4 v0 = acc[ai][bj][m][0] * sc, v1 = acc[ai][bj][m][1] * sc;
                    v4u w; w.x = cvt_pk_bf16(v0[0], v0[1]); w.y = cvt_pk_bf16(v0[2], v0[3]); w.z = cvt_pk_bf16(v1[0], v1[1]); w.w = cvt_pk_bf16(v1[2], v1[3]);
                    *(v4u*)(rowp + bj * 32) = w; } }
    }
};
__device__ __forceinline__ unsigned pk_fp8x4(float a, float b, float c, float d) {
    a = fminf(fmaxf(a, -448.f), 448.f); b = fminf(fmaxf(b, -448.f), 448.f); c = fminf(fmaxf(c, -448.f), 448.f); d = fminf(fmaxf(d, -448.f), 448.f);
    int v = __builtin_amdgcn_cvt_pk_fp8_f32(a, b, 0, false); v = __builtin_amdgcn_cvt_pk_fp8_f32(c, d, v, true); return (unsigned)v; }
struct EpiF8Store {
    static constexpr bool PERM = true;
    static constexpr bool P32 = false;
    static constexpr bool P64 = true;
    unsigned char* O; int ldc; float sc; unsigned nbytes;
    __device__ __forceinline__ void operator()(const f32x4 (&acc)[2][2][4][2], const Unit& u, int wr, int wc, int fr, int fq) const {
        const int row0 = u.pm * BM + wr * 64 + fr, col0 = u.pn * BM + wc * 64 + 16 * fq;
        const __amdgpu_buffer_rsrc_t rs = __builtin_amdgcn_make_buffer_rsrc(O, 0, (int)nbytes, 0x00020000);
#pragma unroll
        for (int ai = 0; ai < 2; ++ai)
#pragma unroll
            for (int m = 0; m < 4; ++m) { const unsigned ro = (unsigned)(row0 + ai * HALF + m * 16) * (unsigned)ldc + (unsigned)col0;
                v4u w;
                { const f32x4 v0 = acc[ai][0][m][0] * sc, v1 = acc[ai][0][m][1] * sc; w.x = pk_fp8x4(v0[0], v0[1], v0[2], v0[3]); w.y = pk_fp8x4(v1[0], v1[1], v1[2], v1[3]); }
                { const f32x4 v0 = acc[ai][1][m][0] * sc, v1 = acc[ai][1][m][1] * sc; w.z = pk_fp8x4(v0[0], v0[1], v0[2], v0[3]); w.w = pk_fp8x4(v1[0], v1[1], v1[2], v1[3]); }
                __builtin_amdgcn_raw_buffer_store_b128(w, rs, (int)ro, 0, 0); }
    }
};
struct EpiGateUpF8 {
    static constexpr bool PERM = true;
    static constexpr bool P64 = false;
    static constexpr bool P32 = false;
    unsigned char* O; float isc, osc;
    __device__ __forceinline__ void operator()(const f32x4 (&acc)[2][2][4][2], const Unit& u, int wr, int wc, int fr, int fq) const {
        const int row0 = u.pm * BM + wr * 64 + fr, col0 = u.pn * HALF + wc * 32 + 8 * fq;
#pragma unroll
        for (int ai = 0; ai < 2; ++ai)
#pragma unroll
            for (int m = 0; m < 4; ++m) { unsigned char* rowp = O + hr4_off((unsigned)(row0 + ai * HALF + m * 16), (unsigned)col0);
                float h[8];
#pragma unroll
                for (int n = 0; n < 2; ++n)
#pragma unroll
                    for (int j = 0; j < 4; ++j) { const float a0 = acc[ai][0][m][n][j], a1 = acc[ai][1][m][n][j];
                        h[n * 4 + j] = (a0 * a1) * (isc * isc * osc) * __builtin_amdgcn_rcpf(1.0f + __builtin_amdgcn_exp2f(a0 * (-1.4426950408889634f * isc))); }
                v2u w; w.x = pk_fp8x4(h[0], h[1], h[2], h[3]); w.y = pk_fp8x4(h[4], h[5], h[6], h[7]);
                *(v2u*)rowp = w; }
    }
};
struct EpiLinearStore {
    static constexpr bool PERM = true;
    static constexpr bool P64 = false;
    static constexpr bool P32 = false;
    bf16* O;
    __device__ __forceinline__ void operator()(const f32x4 (&acc)[2][2][4][2], const Unit& u, int wr, int wc, int fr, int fq) const {
        bf16* base = O + ((size_t)(u.pm * 25 + u.pn) * 65536) + (size_t)((wr * 4 + wc) * 8192) + (size_t)(fq * 16 + fr) * 8;
#pragma unroll
        for (int ai = 0; ai < 2; ++ai)
#pragma unroll
            for (int m = 0; m < 4; ++m)
#pragma unroll
                for (int bj = 0; bj < 2; ++bj) { const f32x4 v0 = acc[ai][bj][m][0], v1 = acc[ai][bj][m][1];
                    v4u w; w.x = cvt_pk_bf16(v0[0], v0[1]); w.y = cvt_pk_bf16(v0[2], v0[3]); w.z = cvt_pk_bf16(v1[0], v1[1]); w.w = cvt_pk_bf16(v1[2], v1[3]);
                    *(v4u*)(base + ((ai * 4 + m) * 2 + bj) * 512) = w; }
    }
};
struct EpiNoStore {
    static constexpr bool PERM = true;
    static constexpr bool P64 = false;
    static constexpr bool P32 = false;
    float* O;
    __device__ __forceinline__ void operator()(const f32x4 (&acc)[2][2][4][2], const Unit& u, int wr, int wc, int fr, int fq) const {
        float s = 0.f;
#pragma unroll
        for (int ai = 0; ai < 2; ++ai)
#pragma unroll
            for (int bj = 0; bj < 2; ++bj)
#pragma unroll
                for (int m = 0; m < 4; ++m)
#pragma unroll
                    for (int n = 0; n < 2; ++n) s += (acc[ai][bj][m][n][0] + acc[ai][bj][m][n][1]) + (acc[ai][bj][m][n][2] + acc[ai][bj][m][n][3]);
        if (s == 12345.678f) O[u.pm] = s;
    }
};
struct EpiGateBf16 {
    static constexpr bool PERM = true;
    static constexpr bool P64 = false;
    static constexpr bool P32 = true;
    bf16* O; int ldc; const float* gate;
    __device__ __forceinline__ void operator()(const f32x4 (&acc)[2][2][4][2], const Unit& u, int wr, int wc, int fr, int fq) const {
        const int row0 = u.pm * BM + wr * 64 + fr, col0 = u.pn * BM + wc * 64 + 8 * fq;
        f32x4 gv[2][2];
#pragma unroll
        for (int bj = 0; bj < 2; ++bj)
#pragma unroll
            for (int n = 0; n < 2; ++n) gv[bj][n] = *(const f32x4*)(gate + col0 + bj * 32 + 4 * n);
#pragma unroll
        for (int ai = 0; ai < 2; ++ai)
#pragma unroll
            for (int m = 0; m < 4; ++m) { bf16* rowp = O + (size_t)(row0 + ai * HALF + m * 16) * ldc + col0;
#pragma unroll
                for (int bj = 0; bj < 2; ++bj) { const f32x4 v0 = acc[ai][bj][m][0] * gv[bj][0], v1 = acc[ai][bj][m][1] * gv[bj][1];
                    v4u w; w.x = cvt_pk_bf16(v0[0], v0[1]); w.y = cvt_pk_bf16(v0[2], v0[3]); w.z = cvt_pk_bf16(v1[0], v1[1]); w.w = cvt_pk_bf16(v1[2], v1[3]);
                    *(v4u*)(rowp + bj * 32) = w; } }
    }
};
struct EpiResidual {
    static constexpr bool PERM = false;
    static constexpr bool P64 = false;
    static constexpr bool P32 = false;
    float* X; const float* xin; const float* pos; int ldc; const float* gate;
    __device__ __forceinline__ void operator()(const f32x4 (&acc)[2][2][4][2], const Unit& u, int wr, int wc, int fr, int fq) const {
        const int row0 = u.pm * BM + wr * 64 + fr, col0 = u.pn * BM + wc * 32 + 4 * fq;
        const bool rowpart = col0 < 1024;
        const int pc0 = rowpart ? col0 : col0 - 1024;
        f32x4 gv[2][2];
#pragma unroll
        for (int bj = 0; bj < 2; ++bj)
#pragma unroll
            for (int n = 0; n < 2; ++n) gv[bj][n] = *(const f32x4*)(gate + col0 + bj * HALF + n * 16);
#pragma unroll
        for (int ai = 0; ai < 2; ++ai)
#pragma unroll
            for (int m = 0; m < 4; ++m) { const int row = row0 + ai * HALF + m * 16;
                float* rowp = X + (size_t)row * ldc + col0; const float* xr = xin + (size_t)row * ldc + col0;
                const float* pr = pos + (size_t)(rowpart ? (row >> 6) : 256 + (row & 63)) * 1024 + pc0;
#pragma unroll
                for (int bj = 0; bj < 2; ++bj)
#pragma unroll
                    for (int n = 0; n < 2; ++n) { const int o = bj * HALF + n * 16;
                        *(f32x4*)(rowp + o) = (*(const f32x4*)(xr + o) + *(const f32x4*)(pr + o)) + gv[bj][n] * acc[ai][bj][m][n]; } }
    }
};
struct EpiGateUp {
    static constexpr bool PERM = true;
    static constexpr bool P64 = false;
    static constexpr bool P32 = false;
    bf16* O;
    __device__ __forceinline__ void operator()(const f32x4 (&acc)[2][2][4][2], const Unit& u, int wr, int wc, int fr, int fq) const {
        const int row0 = u.pm * BM + wr * 64 + fr, col0 = u.pn * HALF + wc * 32 + 8 * fq;
#pragma unroll
        for (int ai = 0; ai < 2; ++ai)
#pragma unroll
            for (int m = 0; m < 4; ++m) { bf16* rowp = O + (size_t)(row0 + ai * HALF + m * 16) * DE + col0;
                float h[8];
#pragma unroll
                for (int n = 0; n < 2; ++n)
#pragma unroll
                    for (int j = 0; j < 4; ++j) { const float g = acc[ai][0][m][n][j], up = acc[ai][1][m][n][j]; h[n * 4 + j] = silu_f(g) * up; }
                v4u w; w.x = cvt_pk_bf16(h[0], h[1]); w.y = cvt_pk_bf16(h[2], h[3]); w.z = cvt_pk_bf16(h[4], h[5]); w.w = cvt_pk_bf16(h[6], h[7]);
                *(v4u*)rowp = w; }
    }
};
struct EpiDown {
    static constexpr bool PERM = true;
    static constexpr bool P64 = false;
    static constexpr bool P32 = false;
    bf16* O; const float* rw;
    __device__ __forceinline__ void operator()(const f32x4 (&acc)[2][2][4][2], const Unit& u, int wr, int wc, int fr, int fq) const {
        const int row0 = u.pm * BM + wr * 64 + fr, col0 = u.pn * BM + wc * 32 + 8 * fq;
#pragma unroll
        for (int ai = 0; ai < 2; ++ai)
#pragma unroll
            for (int m = 0; m < 4; ++m) { const int row = row0 + ai * HALF + m * 16; const float s = rw[row]; bf16* rowp = O + (size_t)row * D + col0;
#pragma unroll
                for (int bj = 0; bj < 2; ++bj) { const f32x4 v0 = acc[ai][bj][m][0] * s, v1 = acc[ai][bj][m][1] * s;
                    v4u w; w.x = cvt_pk_bf16(v0[0], v0[1]); w.y = cvt_pk_bf16(v0[2], v0[3]); w.z = cvt_pk_bf16(v1[0], v1[1]); w.w = cvt_pk_bf16(v1[2], v1[3]);
                    *(v4u*)(rowp + bj * HALF) = w; } }
    }
};
}

using gk::pk_fp8x4;
struct Args { const float* in[36]; float* out; unsigned char* ws; int ph_lo, ph_hi; };
struct Frame {
    LAS unsigned char* lds;
    int tid, lane, wave, bid, G;
    const float* const* in; float* out; unsigned char* ws;
};
#define IN_X 0
#define IN_C 1
#define IN_CTX 2
#define IN_CCTX 3
#define IN_WADA 4
#define IN_BADA 5
#define IN_GMIX 6
#define IN_GFFN 7
#define IN_WIN 8
#define IN_BGATES 9
#define IN_CKW 10
#define IN_CKB 11
#define IN_CQW 12
#define IN_CQB 13
#define IN_GHEAD 14
#define IN_CHW 15
#define IN_CHB 16
#define IN_FW1 17
#define IN_FB1 18
#define IN_FF1 19
#define IN_FW2 20
#define IN_FB2 21
#define IN_FF2 22
#define IN_FW3 23
#define IN_FB3 24
#define IN_DSKIP 25
#define IN_WOUT 26
#define IN_WR 27
#define IN_BR 28
#define IN_W1E 29
#define IN_W3E 30
#define IN_W2E 31
#define IN_W1S 32
#define IN_W3S 33
#define IN_W2S 34
#define IN_GFIN 35

__device__ __forceinline__ void transpose_item(const float* W, int N, int k0, int n0, bf16* WT, int dstK, int dst_row0, LAS float* scr, int lane) {
#pragma unroll 8
    for (int i = 0; i < 32; ++i) { const int kk = 2 * i + (lane >> 5); scr[kk * 33 + (lane & 31)] = W[(size_t)(k0 + kk) * N + n0 + (lane & 31)]; }
    LDS_WAIT(); asm volatile("" ::: "memory");
    const int c = lane & 7;
#pragma unroll
    for (int j = 0; j < 4; ++j) { const int n = (lane >> 3) + 8 * j; const LAS float* s = scr + (8 * c) * 33 + n;
        v4u o; o.x = cvt_pk_bf16(s[0 * 33], s[1 * 33]); o.y = cvt_pk_bf16(s[2 * 33], s[3 * 33]); o.z = cvt_pk_bf16(s[4 * 33], s[5 * 33]); o.w = cvt_pk_bf16(s[6 * 33], s[7 * 33]);
        *(v4u*)(WT + (size_t)(dst_row0 + n) * dstK + k0 + 8 * c) = o; }
    LDS_WAIT(); asm volatile("" ::: "memory");
}
__device__ __forceinline__ void f8_item_load(const float* W, int N, int k0, int n0, int lane, f32x4 (&v)[8]) {
#pragma unroll
    for (int i = 0; i < 8; ++i) v[i] = *(const f32x4*)(W + (size_t)(k0 + 8 * i + (lane >> 3)) * N + n0 + 4 * (lane & 7));
}
__device__ __forceinline__ void f8_item_finish(const f32x4 (&v)[8], int k0, unsigned char* WT, int dstKB, int dst_row0, float pre, LAS float* scr, int lane) {
#pragma unroll
    for (int i = 0; i < 8; ++i) *(LAS f32x4*)(scr + (8 * i + (lane >> 3)) * 36 + 4 * (lane & 7)) = v[i] * pre;
    LDS_WAIT(); asm volatile("" ::: "memory");
    const int n = lane >> 1, hf = lane & 1; const LAS float* s = scr + (32 * hf) * 36 + n;
    unsigned w[8];
#pragma unroll
    for (int q = 0; q < 8; ++q) w[q] = pk_fp8x4(s[(4 * q) * 36], s[(4 * q + 1) * 36], s[(4 * q + 2) * 36], s[(4 * q + 3) * 36]);
    unsigned char* dst = WT + (size_t)(dst_row0 + n) * dstKB + k0 + 32 * hf;
    *(v4u*)dst = (v4u){w[0], w[1], w[2], w[3]}; *(v4u*)(dst + 16) = (v4u){w[4], w[5], w[6], w[7]};
    LDS_WAIT(); asm volatile("" ::: "memory");
}
__device__ __forceinline__ void p0_prologue(Frame& F) {
    const float* const* in = F.in;
    {
        LAS float* sv = (LAS float*)F.lds;
        LAS float* red = sv + 4096;
        float* mod = (float*)(F.ws + WS_MOD);
        for (int job = F.bid; job < 192; job += F.G) {
            for (int i = F.tid; i < 2048; i += NT) { sv[i] = silu_f(in[IN_C][i]); sv[2048 + i] = silu_f(in[IN_CCTX][i]); }
            __syncthreads();
            const int col = job * 64 + F.lane, r0 = F.wave * 256;
            const float* W = in[IN_WADA] + col;
            float a0 = 0.f, a1 = 0.f;
            for (int i = r0; i < r0 + 256; i += 8) {
                float w[8];
#pragma unroll
                for (int j = 0; j < 8; ++j) w[j] = W[(size_t)(i + j) * 12288];
#pragma unroll
                for (int j = 0; j < 8; ++j) { a0 += sv[i + j] * w[j]; a1 += sv[2048 + i + j] * w[j]; }
            }
            red[(F.wave * 64 + F.lane) * 2 + 0] = a0; red[(F.wave * 64 + F.lane) * 2 + 1] = a1;
            __syncthreads();
            if (F.wave == 0) { float s0 = 0.f, s1 = 0.f;
#pragma unroll
                for (int w = 0; w < 8; ++w) { s0 += red[(w * 64 + F.lane) * 2 + 0]; s1 += red[(w * 64 + F.lane) * 2 + 1]; }
                const float b = in[IN_BADA][col]; mod[col] = s0 + b; mod[12288 + col] = s1 + b; }
            __syncthreads();
        }
    }
    const int nsm = F.G > 192 ? F.G - 192 : F.G, bsm = F.G > 192 ? F.bid - 192 : F.bid;
    const int gt = (bsm < 0 ? 0 : bsm) * NT + F.tid, NGT = bsm < 0 ? 0x40000000 : nsm * NT;
    const int gts = bsm < 0 ? 0x40000000 : gt;
    {
        float* pos = (float*)(F.ws + WS_POS);
        for (int i = gts; i < 320 * 1024; i += NGT) { const int p = i >> 10, j = i & 1023, jj = j & 511;
            const float pp = (float)(p < 256 ? p : p - 256);
            const float omega = 1.0f / powf(10000.0f, (float)jj * (1.0f / 512.0f)); const float ang = pp * omega;
            pos[i] = j < 512 ? sinf(ang) : cosf(ang); }
    }
    {
        v4u* z = (v4u*)(F.ws + WS_WIN + (size_t)NIN * D * 2); const int nz = (NINP - NIN) * D * 2 / 16;
        for (int i = gts; i < nz; i += NGT) z[i] = (v4u){0u, 0u, 0u, 0u};
        int* rt = (int*)(F.ws + WS_RTOK); float* rw = (float*)(F.ws + WS_RW);
        for (int i = gts; i < MAXROWS; i += NGT) { rt[i] = 0; rw[i] = 0.f; }
    }
    {
        bf16* w1 = (bf16*)(F.ws + WS_WR1); bf16* w2 = (bf16*)(F.ws + WS_WR2);
        for (int i = gts; i < 64 * 2048; i += NGT) { const int e = i >> 11, k = i & 2047; const float w = in[IN_WR][k * 64 + e];
            const unsigned hi = cvt_pk_bf16(w, 0.f) & 0xffffu; const float r = w - bf2f((bf16)hi);
            w1[i] = (bf16)hi; w2[i] = (bf16)(cvt_pk_bf16(r, 0.f) & 0xffffu); }
    }
    {
        LAS float* scr = (LAS float*)(F.lds + F.wave * 16384);
        const int gw = F.bid * NWAVES + F.wave, NGW = F.G * NWAVES;
        constexpr int I_IN = 32 * 193, I_OUT = 32 * 64;
        for (int it = gw; it < I_IN + I_OUT; it += NGW) {
            int r = it;
            if (r < I_IN) { const int kb = r / 193, nb = r % 193; transpose_item(in[IN_WIN], NIN, 64 * kb, 32 * nb, (bf16*)(F.ws + WS_WIN), D, 32 * nb, scr, F.lane); continue; } r -= I_IN;
            { const int kb = r / 64, nb = r % 64; transpose_item(in[IN_WOUT], D, 64 * kb, 32 * nb, (bf16*)(F.ws + WS_WOUT), D, 32 * nb, scr, F.lane); }
        }
    }
}
constexpr int N_EXP_ITEMS = 3 * 512 * NE1;
struct ExpItem { const float* src; int N, k0, n0; unsigned char* dst; int dstKB, row0; float pre; };
__device__ __forceinline__ ExpItem decode_expert_item(Frame& F, int r) {
    const float* const* in = F.in;
    constexpr int I_E = 512 * NE1;
    ExpItem it;
    if (r < 2 * I_E) { const int which = r >= I_E; if (which) r -= I_E;
        const int e = r / 512, rr = r % 512, kb = rr / 16, nb = rr % 16, n0 = 32 * nb;
        it.src = e < NE ? in[which ? IN_W3E : IN_W1E] + (size_t)e * D * DE : in[which ? IN_W3S : IN_W1S];
        it.N = DE; it.k0 = 64 * kb; it.n0 = n0; it.dst = (unsigned char*)(F.ws + WS_W13) + (size_t)e * 1024 * D; it.dstKB = D; it.row0 = (n0 >> 7) * 256 + which * 128 + (n0 & 127); it.pre = W13_PRE; return it; }
    r -= 2 * I_E;
    { const int e = r / 512, rr = r % 512, kb = rr / 64, nb = rr % 64;
        it.src = e < NE ? in[IN_W2E] + (size_t)e * DE * D : in[IN_W2S];
        it.N = D; it.k0 = 64 * kb; it.n0 = 32 * nb; it.dst = (unsigned char*)(F.ws + WS_W2) + (size_t)e * D * DE; it.dstKB = DE; it.row0 = 32 * nb; it.pre = W2_PRE; return it; }
}
__device__ __forceinline__ void conv_worker(Frame& F) {
    LAS float* scr = (LAS float*)(F.lds + F.wave * 16384);
    unsigned* q = (unsigned*)(F.ws + WS_CTL) + CW_QCONV;
    for (;;) {
        unsigned base = 0;
        if (F.lane == 0) base = __hip_atomic_fetch_add(q, 8u, __ATOMIC_RELAXED, __HIP_MEMORY_SCOPE_AGENT);
        base = (unsigned)__builtin_amdgcn_readfirstlane((int)base);
        if (base >= (unsigned)N_EXP_ITEMS) break;
#pragma unroll 1
        for (int i = 0; i < 8; i += 2) {
            const ExpItem ia = decode_expert_item(F, (int)base + i), ib = decode_expert_item(F, (int)base + i + 1);
            f32x4 va[8], vb[8];
            f8_item_load(ia.src, ia.N, ia.k0, ia.n0, F.lane, va); f8_item_load(ib.src, ib.N, ib.k0, ib.n0, F.lane, vb);
            f8_item_finish(va, ia.k0, ia.dst, ia.dstKB, ia.row0, ia.pre, scr, F.lane);
            f8_item_finish(vb, ib.k0, ib.dst, ib.dstKB, ib.row0, ib.pre, scr, F.lane);
        }
    }
}

__device__ __forceinline__ void p1_norm1(Frame& F) {
    const float* const* in = F.in;
    const int gw = F.bid * NWAVES + F.wave, NGW = F.G * NWAVES;
    const float* mod = (const float*)(F.ws + WS_MOD); const float* pos = (const float*)(F.ws + WS_POS);
    bf16* hA = (bf16*)(F.ws + WS_HA);
    for (int row = gw; row < MROWS; row += NGW) {
        f32x4 v[8]; float ss = 0.f;
        const bool mainrow = row < L;
        const float* src = mainrow ? in[IN_X] + (size_t)row * D : in[IN_CTX] + (size_t)(row - L) * D;
        const float* md = mainrow ? mod : mod + 12288;
#pragma unroll
        for (int j = 0; j < 8; ++j) { const int col = 4 * F.lane + 256 * j; v[j] = *(const f32x4*)(src + col);
            if (mainrow) { const float* pp = col < 1024 ? pos + (size_t)(row >> 6) * 1024 + col : pos + (size_t)(256 + (row & 63)) * 1024 + (col - 1024);
                v[j] = v[j] + *(const f32x4*)pp; }
            ss += (v[j].x * v[j].x + v[j].y * v[j].y) + (v[j].z * v[j].z + v[j].w * v[j].w); }
        const float rstd = rsqrtf(wave_sum(ss) * (1.0f / D) + EPS);
#pragma unroll
        for (int j = 0; j < 8; ++j) { const int col = 4 * F.lane + 256 * j;
            const f32x4 g = *(const f32x4*)(in[IN_GMIX] + col), sh = *(const f32x4*)(md + col), sc = *(const f32x4*)(md + 2048 + col);
            const f32x4 h = (v[j] * rstd * g) * (sc + 1.0f) + sh;
            v2u o; o.x = cvt_pk_bf16(h.x, h.y); o.y = cvt_pk_bf16(h.z, h.w);
            *(v2u*)(hA + (size_t)row * D + col) = o; }
    }
}

constexpr int VT_PITCH = 136;
__device__ __forceinline__ float wave_incl_add(float x, int lane) {
#pragma unroll
    for (int o = 1; o < 64; o <<= 1) { const float y = __shfl_up(x, o); if (lane >= o) x += y; }
    return x;
}
__device__ __forceinline__ float wave_incl_max(float x, int lane) {
#pragma unroll
    for (int o = 1; o < 64; o <<= 1) { const float y = __shfl_up(x, o); if (lane >= o) x = fmaxf(x, y); }
    return x;
}
__device__ __forceinline__ void ml_gates(Frame& F, int dir, int h, int rowbase, LAS float* bb, LAS float* al, LAS float* mx, float& g, float& mtot) {
    const bf16* z = (const bf16*)(F.ws + WS_Z);
    const int lane = F.lane, pi0 = 2 * lane, p0 = dir ? 127 - pi0 : pi0, p1 = dir ? p0 - 1 : p0 + 1;
    const float bgi = F.in[IN_BGATES][dir * 16 + h], bgf = F.in[IN_BGATES][dir * 16 + 8 + h];
    const bf16* z0 = z + (size_t)(rowbase + p0) * NINP + OFF_G + dir * 16 + h; const bf16* z1 = z + (size_t)(rowbase + p1) * NINP + OFF_G + dir * 16 + h;
    const float i0 = bf2f(z0[0]) + bgi, f0 = bf2f(z0[8]) + bgf, i1 = bf2f(z1[0]) + bgi, f1 = bf2f(z1[8]) + bgf;
    const float l0 = fminf(f0, 0.f) - log1pf(__expf(-fabsf(f0))), l1 = fminf(f1, 0.f) - log1pf(__expf(-fabsf(f1)));
    const float incl = wave_incl_add(l0 + l1, lane);
    const float b1 = incl, b0 = incl - l1;
    const float a0 = i0 - b0, a1 = i1 - b1;
    const float mi = wave_incl_max(fmaxf(a0, a1), lane);
    float mprev = __shfl_up(mi, 1); if (lane == 0) mprev = -INFINITY;
    const float M0 = fmaxf(mprev, a0), M1 = mi;
    bb[p0] = b0; bb[p1] = b1; al[p0] = a0; al[p1] = a1; mx[p0] = M0; mx[p1] = M1;
    g = __shfl(incl, 63); mtot = __shfl(mi, 63);
}
__device__ __forceinline__ void ml_stage_vT(Frame& F, int h, int rowbase, LAS bf16* vT) {
    const bf16* z = (const bf16*)(F.ws + WS_Z);
    const int s = F.tid >> 2, eg = F.tid & 3;
#pragma unroll
    for (int i = 0; i < 4; ++i) { const int e0 = 32 * eg + 8 * i; const v4u v = *(const v4u*)(z + (size_t)(rowbase + s) * NINP + OFF_V + h * 128 + e0);
        const unsigned w[4] = {v.x, v.y, v.z, v.w};
#pragma unroll
        for (int q = 0; q < 4; ++q) { vT[(e0 + 2 * q) * VT_PITCH + s] = (bf16)(w[q] & 0xffffu); vT[(e0 + 2 * q + 1) * VT_PITCH + s] = (bf16)(w[q] >> 16); } }
}
__device__ __forceinline__ void ml_prep_item(Frame& F, int item) {
    const float* const* in = F.in;
    const int n = item >> 3, h = item & 7, tid = F.tid, lane = F.lane, wave = F.wave;
    const bool isctx = n >= 128;
    const int rowbase = isctx ? L + 128 * (n - 128) : 128 * n, seqlo = isctx ? L : 0, seqhi = isctx ? L + LC - 1 : L - 1;
    LAS bf16* vT = (LAS bf16*)F.lds;
    LAS bf16* kw0 = vT + 128 * VT_PITCH;
    LAS bf16* kw1 = kw0 + 64 * VT_PITCH;
    LAS float* fs = (LAS float*)(kw1 + 64 * VT_PITCH);
    const bf16* z = (const bf16*)(F.ws + WS_Z);
    if (wave < 2) { float g, mtot; LAS float* bbp = fs + 256 + wave * 384; ml_gates(F, wave, h, rowbase, bbp, bbp + 128, bbp + 256, g, mtot);
        LDS_WAIT();
        fs[wave * 128 + 2 * lane] = __expf(bbp[128 + 2 * lane] - mtot); fs[wave * 128 + 2 * lane + 1] = __expf(bbp[128 + 2 * lane + 1] - mtot);
        if (lane == 0) { float* sc = (float*)(F.ws + WS_SC) + ((size_t)(wave * 8 + h) * 130 + n) * 2; sc[0] = g; sc[1] = g + mtot; } }
    ml_stage_vT(F, h, rowbase, vT);
    __syncthreads();
    {
        const int s = tid >> 2, d0 = (tid & 3) * 16, R = rowbase + s; const bool hp = R > seqlo, hn = R < seqhi;
        float kv[16], qv[16];
#pragma unroll
        for (int part = 0; part < 2; ++part) {
            const int zc = (part ? OFF_Q : OFF_K) + h * 64 + d0; const float* cw = in[part ? IN_CQW : IN_CKW] + h * 64 + d0; const float* cb = in[part ? IN_CQB : IN_CKB] + h * 64 + d0;
#pragma unroll
            for (int hv = 0; hv < 2; ++hv) {
                const v4u c = *(const v4u*)(z + (size_t)R * NINP + zc + 8 * hv);
                const v4u p = hp ? *(const v4u*)(z + (size_t)(R - 1) * NINP + zc + 8 * hv) : (v4u){0u, 0u, 0u, 0u};
                const v4u nx = hn ? *(const v4u*)(z + (size_t)(R + 1) * NINP + zc + 8 * hv) : (v4u){0u, 0u, 0u, 0u};
                const unsigned cc[4] = {c.x, c.y, c.z, c.w}, pp[4] = {p.x, p.y, p.z, p.w}, nn[4] = {nx.x, nx.y, nx.z, nx.w};
#pragma unroll
                for (int q = 0; q < 4; ++q) { const int d = 8 * hv + 2 * q;
                    const float v0 = silu_f(bflo(pp[q]) * cw[d] + bflo(cc[q]) * cw[512 + d] + bflo(nn[q]) * cw[1024 + d] + cb[d]);
                    const float v1 = silu_f(bfhi(pp[q]) * cw[d + 1] + bfhi(cc[q]) * cw[512 + d + 1] + bfhi(nn[q]) * cw[1024 + d + 1] + cb[d + 1]);
                    if (part) { qv[d] = v0 * 0.125f; qv[d + 1] = v1 * 0.125f; } else { kv[d] = v0; kv[d + 1] = v1; } }
            }
        }
        if (!isctx) {
            bf16* Qg = (bf16*)(F.ws + WS_Q) + ((size_t)h * L + R) * 64 + d0; bf16* Kg = (bf16*)(F.ws + WS_K) + ((size_t)h * L + R) * 64 + d0;
#pragma unroll
            for (int hv = 0; hv < 2; ++hv) { v4u w;
                w.x = cvt_pk_bf16(qv[8 * hv], qv[8 * hv + 1]); w.y = cvt_pk_bf16(qv[8 * hv + 2], qv[8 * hv + 3]); w.z = cvt_pk_bf16(qv[8 * hv + 4], qv[8 * hv + 5]); w.w = cvt_pk_bf16(qv[8 * hv + 6], qv[8 * hv + 7]); *(v4u*)(Qg + 8 * hv) = w;
                w.x = cvt_pk_bf16(kv[8 * hv], kv[8 * hv + 1]); w.y = cvt_pk_bf16(kv[8 * hv + 2], kv[8 * hv + 3]); w.z = cvt_pk_bf16(kv[8 * hv + 4], kv[8 * hv + 5]); w.w = cvt_pk_bf16(kv[8 * hv + 6], kv[8 * hv + 7]); *(v4u*)(Kg + 8 * hv) = w; }
        }
        const float w0 = fs[s], w1 = fs[128 + s];
#pragma unroll
        for (int d = 0; d < 16; ++d) { const float kr = bf2f((bf16)(cvt_pk_bf16(kv[d], 0.f) & 0xffffu));
            kw0[(d0 + d) * VT_PITCH + s] = (bf16)(cvt_pk_bf16(kr * w0, 0.f) & 0xffffu); kw1[(d0 + d) * VT_PITCH + s] = (bf16)(cvt_pk_bf16(kr * w1, 0.f) & 0xffffu); }
    }
    __syncthreads();
    {
        const int fr = lane & 15, fq = lane >> 4;
        bf16x8 a[4];
#pragma unroll
        for (int kk = 0; kk < 4; ++kk) a[kk] = *(const LAS bf16x8*)(vT + (16 * wave + fr) * VT_PITCH + 32 * kk + 8 * fq);
#pragma unroll
        for (int dir = 0; dir < 2; ++dir) { const LAS bf16* kw = dir ? kw1 : kw0;
            float* cl = (float*)(F.ws + WS_CL) + ((size_t)((dir * 8 + h) * 130 + n)) * 8192;
#pragma unroll
            for (int dt = 0; dt < 4; ++dt) { f32x4 acc = (f32x4){0.f, 0.f, 0.f, 0.f};
#pragma unroll
                for (int kk = 0; kk < 4; ++kk) { const bf16x8 b = *(const LAS bf16x8*)(kw + (16 * dt + fr) * VT_PITCH + 32 * kk + 8 * fq); acc = __builtin_amdgcn_mfma_f32_16x16x32_bf16(a[kk], b, acc, 0, 0, 0); }
#pragma unroll
                for (int r = 0; r < 4; ++r) cl[(16 * wave + 4 * fq + r) * 64 + 16 * dt + fr] = acc[r]; } }
        if (tid < 128) { const int dir = tid >> 6, d = tid & 63; const LAS bf16* kw = (dir ? kw1 : kw0) + d * VT_PITCH; float s = 0.f;
            for (int i = 0; i < 128; ++i) s += bf2f(kw[i]);
            ((float*)(F.ws + WS_NL))[((size_t)((dir * 8 + h) * 130 + n)) * 64 + d] = s; }
    }
    __syncthreads();
}
__device__ __forceinline__ int ml_order(int dir, int step) { return step < 2 ? (dir ? 129 - step : 128 + step) : (dir ? 129 - step : step - 2); }
__device__ __forceinline__ void ml_scan(Frame& F) {
    const float* CL = (const float*)(F.ws + WS_CL); const float* SC = (const float*)(F.ws + WS_SC); const float* NLp = (const float*)(F.ws + WS_NL);
    bf16* CI = (bf16*)(F.ws + WS_CI); float* NI = (float*)(F.ws + WS_NI); float* MI = (float*)(F.ws + WS_MI);
    LAS float* ssc = (LAS float*)F.lds;
    for (int idx0 = F.bid * NT; idx0 < 16 * 8192; idx0 += F.G * NT) {
        const int idx = idx0 + F.tid, dh = idx >> 13, rem = idx & 8191, dir = dh >> 3; const bool don = rem < 64;
        __syncthreads();
        if (F.tid < 130) { const int ch = ml_order(dir, F.tid); ssc[2 * F.tid] = SC[(dh * 130 + ch) * 2]; ssc[2 * F.tid + 1] = SC[(dh * 130 + ch) * 2 + 1]; }
        __syncthreads();
        float c = 0.f, nn = 0.f, m = 0.f;
#pragma unroll 1
        for (int s0 = 0; s0 < 130; s0 += 26) {
            float cl[26];
#pragma unroll
            for (int i = 0; i < 26; ++i) cl[i] = CL[((size_t)(dh * 130 + ml_order(dir, s0 + i))) * 8192 + rem];
#pragma unroll
            for (int i = 0; i < 26; ++i) { const int ch = ml_order(dir, s0 + i); const float gg = ssc[2 * (s0 + i)], ml = ssc[2 * (s0 + i) + 1];
                const float nl = don ? NLp[(size_t)(dh * 130 + ch) * 64 + rem] : 0.f;
                if (ch < 128) { CI[((size_t)(dh * 128 + ch)) * 8192 + rem] = (bf16)(cvt_pk_bf16(c, 0.f) & 0xffffu); if (don) NI[(size_t)(dh * 128 + ch) * 64 + rem] = nn; if (rem == 0) MI[dh * 128 + ch] = m; }
                const float mn = fmaxf(gg + m, ml), sp = __expf(gg + m - mn), sl = __expf(ml - mn);
                c = sp * c + sl * cl[i]; nn = sp * nn + sl * nl; m = mn; }
        }
    }
    __syncthreads();
}
__device__ __forceinline__ void ml_out_item(Frame& F, int item) {
    const float* const* in = F.in;
    const int n = item >> 3, h = item & 7, tid = F.tid, lane = F.lane, wave = F.wave, fr = lane & 15, fq = lane >> 4;
    const int rowbase = 128 * n;
    LAS bf16* vT = (LAS bf16*)F.lds;
    LAS float* fs = (LAS float*)(vT + 128 * VT_PITCH);
    const bf16* z = (const bf16*)(F.ws + WS_Z);
    const bf16* Qg = (const bf16*)(F.ws + WS_Q) + ((size_t)h * L + rowbase) * 64; const bf16* Kg = (const bf16*)(F.ws + WS_K) + ((size_t)h * L + rowbase) * 64;
    const int tl = 16 * wave + fr;
    bf16x8 qf[2], kf[8][2];
#pragma unroll
    for (int kk = 0; kk < 2; ++kk) qf[kk] = *(const bf16x8*)(Qg + (size_t)tl * 64 + 32 * kk + 8 * fq);
#pragma unroll
    for (int j = 0; j < 8; ++j)
#pragma unroll
        for (int kk = 0; kk < 2; ++kk) kf[j][kk] = *(const bf16x8*)(Kg + (size_t)(16 * j + fr) * 64 + 32 * kk + 8 * fq);
    if (wave < 2) { float g, mtot; LAS float* bbp = fs + wave * 384; ml_gates(F, wave, h, rowbase, bbp, bbp + 128, bbp + 256, g, mtot);
        if (lane == 0) fs[768 + wave] = ((const float*)(F.ws + WS_MI))[(wave * 8 + h) * 128 + n]; }
    ml_stage_vT(F, h, rowbase, vT);
    __syncthreads();
    f32x4 st[8];
#pragma unroll
    for (int j = 0; j < 8; ++j) { f32x4 acc = (f32x4){0.f, 0.f, 0.f, 0.f};
#pragma unroll
        for (int kk = 0; kk < 2; ++kk) acc = __builtin_amdgcn_mfma_f32_16x16x32_bf16(kf[j][kk], qf[kk], acc, 0, 0, 0);
        st[j] = acc; }
    f32x4 hs[8];
#pragma unroll
    for (int et = 0; et < 8; ++et) hs[et] = (f32x4){0.f, 0.f, 0.f, 0.f};
#pragma unroll 1
    for (int dir = 0; dir < 2; ++dir) {
        const LAS float* bbp = fs + dir * 384; const LAS float* alp = bbp + 128; const LAS float* mxp = bbp + 256;
        const float m_in = fs[768 + dir];
        const float beta = fmaxf(m_in, mxp[tl]);
        const int dh = dir * 8 + h;
        const bf16* cip = (const bf16*)(F.ws + WS_CI) + (size_t)(dh * 128 + n) * 8192;
        bf16x8 cbf[8][2];
#pragma unroll
        for (int et = 0; et < 8; ++et)
#pragma unroll
            for (int kk = 0; kk < 2; ++kk) cbf[et][kk] = *(const bf16x8*)(cip + (size_t)(16 * et + fr) * 64 + 32 * kk + 8 * fq);
        bf16x8 pf[4]; float dsum = 0.f;
#pragma unroll
        for (int kk = 0; kk < 4; ++kk) { float pv[8];
#pragma unroll
            for (int hh = 0; hh < 2; ++hh)
#pragma unroll
                for (int r = 0; r < 4; ++r) { const int s = 32 * kk + 16 * hh + 4 * fq + r; const bool ok = dir ? (s >= tl) : (s <= tl);
                    const float e = __expf(fminf(alp[s] - beta, 0.f)); const float v = ok ? st[2 * kk + hh][r] * e : 0.f; pv[4 * hh + r] = v; dsum += v; }
            pf[kk] = __builtin_bit_cast(bf16x8, (v4u){cvt_pk_bf16(pv[0], pv[1]), cvt_pk_bf16(pv[2], pv[3]), cvt_pk_bf16(pv[4], pv[5]), cvt_pk_bf16(pv[6], pv[7])}); }
        dsum += __shfl_xor(dsum, 16); dsum += __shfl_xor(dsum, 32);
        const float* nip = (const float*)(F.ws + WS_NI) + (size_t)(dh * 128 + n) * 64; float qn = 0.f;
#pragma unroll
        for (int kk = 0; kk < 2; ++kk) { const v4u qq = __builtin_bit_cast(v4u, qf[kk]); const unsigned w[4] = {qq.x, qq.y, qq.z, qq.w};
#pragma unroll
            for (int q = 0; q < 4; ++q) { const int d = 32 * kk + 8 * fq + 2 * q; qn += bflo(w[q]) * nip[d] + bfhi(w[q]) * nip[d + 1]; } }
        qn += __shfl_xor(qn, 16); qn += __shfl_xor(qn, 32);
        const float sc_t = __expf(m_in - beta);
        const float den = dsum + sc_t * qn, dn = fmaxf(fabsf(den), __expf(-(bbp[tl] + beta)));
        LAS float* xinv = fs + 772 + (wave * 2 + dir) * 32;
        if (fq == 0) { xinv[fr] = 1.0f / dn; xinv[16 + fr] = sc_t; }
        LDS_WAIT();
        float inv_r[4], sc_r[4];
#pragma unroll
        for (int r = 0; r < 4; ++r) { inv_r[r] = xinv[4 * fq + r]; sc_r[r] = xinv[16 + 4 * fq + r]; }
#pragma unroll
        for (int et = 0; et < 8; ++et) {
            f32x4 acc = (f32x4){0.f, 0.f, 0.f, 0.f}, acci = (f32x4){0.f, 0.f, 0.f, 0.f};
#pragma unroll
            for (int kk = 0; kk < 4; ++kk) {
                const bool live = dir ? (2 * kk + 1 >= wave) : (2 * kk <= wave);
                if (live) { const LAS bf16* vr = vT + (16 * et + fr) * VT_PITCH + 32 * kk + 4 * fq;
                    const v2u lo = *(const LAS v2u*)vr, hi = *(const LAS v2u*)(vr + 16);
                    const bf16x8 vb = __builtin_bit_cast(bf16x8, (v4u){lo.x, lo.y, hi.x, hi.y});
                    acc = __builtin_amdgcn_mfma_f32_16x16x32_bf16(pf[kk], vb, acc, 0, 0, 0); } }
#pragma unroll
            for (int kk = 0; kk < 2; ++kk) acci = __builtin_amdgcn_mfma_f32_16x16x32_bf16(qf[kk], cbf[et][kk], acci, 0, 0, 0);
#pragma unroll
            for (int r = 0; r < 4; ++r) hs[et][r] += (acc[r] + sc_r[r] * acci[r]) * inv_r[r];
        }
    }
    float rs[4];
#pragma unroll
    for (int r = 0; r < 4; ++r) { float ss = 0.f;
#pragma unroll
        for (int et = 0; et < 8; ++et) ss += hs[et][r] * hs[et][r];
        ss += __shfl_xor(ss, 1); ss += __shfl_xor(ss, 2); ss += __shfl_xor(ss, 4); ss += __shfl_xor(ss, 8);
        rs[r] = rsqrtf(ss * (1.0f / 128.0f) + EPS); }
    bf16* cat = (bf16*)(F.ws + WS_CAT);
#pragma unroll
    for (int et = 0; et < 8; ++et) { const int col = h * 128 + 16 * et + fr; const float gh = in[IN_GHEAD][col];
#pragma unroll
        for (int r = 0; r < 4; ++r) { const int t = rowbase + 16 * wave + 4 * fq + r;
            const float o = hs[et][r] * rs[r] * gh * sigmoid_f(bf2f(z[(size_t)t * NINP + OFF_O + col]));
            cat[(size_t)t * D + col] = (bf16)(cvt_pk_bf16(o, 0.f) & 0xffffu); } }
    __syncthreads();
}

__device__ __forceinline__ void p3_filter_tile(Frame& F, int tile) {
    const float* const* in = F.in;
    const int tid = F.tid;
    LAS float* feat = (LAS float*)F.lds;
    LAS float* h1 = feat + 64 * 36;
    LAS float* h2 = h1 + 64 * 65;
    LAS float* w1s = h2 + 64 * 64;
    LAS float* w2s = w1s + 33 * 64;
    for (int i = tid; i < 33 * 64; i += NT) w1s[i] = in[IN_FW1][i];
    for (int i = tid; i < 64 * 64; i += NT) w2s[i] = in[IN_FW2][i];
    {
        const int tt = tid >> 3, sub = tid & 7; const float t = (float)(tile * 64 + tt);
        const float w = (6.2831855f * t) / (float)L;
        if (sub == 0) feat[tt * 36] = t / (float)(L - 1);
#pragma unroll
        for (int q = 0; q < 2; ++q) { const int bi = sub * 2 + q; const float band = 1e-4f + (float)bi * ((15.0f - 1e-4f) / 15.0f); const float ang = w * band;
            feat[tt * 36 + 1 + bi] = cosf(ang); feat[tt * 36 + 17 + bi] = -sinf(ang); }
    }
    __syncthreads();
    {
        const int tt = tid >> 3, j0 = (tid & 7) * 8;
        float a[8];
#pragma unroll
        for (int q = 0; q < 8; ++q) a[q] = in[IN_FB1][j0 + q];
#pragma unroll 1
        for (int i = 0; i < 33; ++i) { const float f = feat[tt * 36 + i];
#pragma unroll
            for (int q = 0; q < 8; ++q) a[q] += f * w1s[i * 64 + j0 + q]; }
#pragma unroll
        for (int q = 0; q < 8; ++q) h1[tt * 65 + j0 + q] = sinf(in[IN_FF1][j0 + q] * a[q]);
    }
    __syncthreads();
    {
        const int tt = tid >> 3, j0 = (tid & 7) * 8;
        float a[8];
#pragma unroll
        for (int q = 0; q < 8; ++q) a[q] = in[IN_FB2][j0 + q];
#pragma unroll 1
        for (int i = 0; i < 64; ++i) { const float f = h1[tt * 65 + i];
#pragma unroll
            for (int q = 0; q < 8; ++q) a[q] += f * w2s[i * 64 + j0 + q]; }
#pragma unroll
        for (int q = 0; q < 8; ++q) h2[tt * 64 + j0 + q] = sinf(in[IN_FF2][j0 + q] * a[q]);
    }
    __syncthreads();
    {
        bf16* hd = (bf16*)(F.ws + WS_HDN);
        for (int i = tid; i < 64 * 32; i += NT) { const int tt = i >> 5, j = (i & 31) * 2; *(unsigned*)(hd + (size_t)(tile * 64 + tt) * 64 + j) = cvt_pk_bf16(h2[tt * 64 + j], h2[tt * 64 + j + 1]); }
    }
    __syncthreads();
}
__device__ __forceinline__ void p3_uin_tile(Frame& F, int tile) {
    const float* const* in = F.in;
    const bf16* z = (const bf16*)(F.ws + WS_Z); float* uT = (float*)(F.ws + WS_UIN);
    LAS float* tl = (LAS float*)F.lds;
    const int t0 = (tile >> 2) * 64, cb = (tile & 3) * 256;
    const int cg = F.tid & 31, c0 = cb + cg * 8, rsub = F.tid >> 5;
    for (int pass = 0; pass < 4; ++pass) {
        const int tt = pass * 16 + rsub, t = t0 + tt;
        float r1[8], r2[8];
#pragma unroll
        for (int part = 0; part < 2; ++part) {
            const int zc = OFF_HY + 1024 * (part + 1) + c0, wc = 1024 * (part + 1) + c0;
            const v4u cur = *(const v4u*)(z + (size_t)t * NINP + zc);
            const v4u prv = t > 0 ? *(const v4u*)(z + (size_t)(t - 1) * NINP + zc) : (v4u){0u, 0u, 0u, 0u};
            const v4u nxt = t < L - 1 ? *(const v4u*)(z + (size_t)(t + 1) * NINP + zc) : (v4u){0u, 0u, 0u, 0u};
            float* rr = part ? r2 : r1;
#pragma unroll
            for (int q = 0; q < 4; ++q) {
                const unsigned pc = q == 0 ? prv.x : q == 1 ? prv.y : q == 2 ? prv.z : prv.w, cc = q == 0 ? cur.x : q == 1 ? cur.y : q == 2 ? cur.z : cur.w, nc = q == 0 ? nxt.x : q == 1 ? nxt.y : q == 2 ? nxt.z : nxt.w;
                const int ch = wc + 2 * q;
                rr[2 * q] = bflo(pc) * in[IN_CHW][ch] + bflo(cc) * in[IN_CHW][3072 + ch] + bflo(nc) * in[IN_CHW][6144 + ch] + in[IN_CHB][ch];
                rr[2 * q + 1] = bfhi(pc) * in[IN_CHW][ch + 1] + bfhi(cc) * in[IN_CHW][3072 + ch + 1] + bfhi(nc) * in[IN_CHW][6144 + ch + 1] + in[IN_CHB][ch + 1];
            }
        }
#pragma unroll
        for (int q = 0; q < 8; ++q) tl[(cg * 8 + q) * 65 + tt] = r1[q] * r2[q];
    }
    __syncthreads();
    for (int i = F.tid; i < 256 * 16; i += NT) { const int c = i >> 4, tq = (i & 15) * 4; const LAS float* s = tl + c * 65 + tq;
        *(f32x4*)(uT + (size_t)(cb + c) * L + t0 + tq) = (f32x4){s[0], s[1], s[2], s[3]}; }
    __syncthreads();
}

#ifndef FFT_LAS
#define FFT_LAS LAS
#endif
#if defined(__HIP_DEVICE_COMPILE__)
#define FFT_OPAQUE(v) asm volatile("" : "+v"(v))
#else
#define FFT_OPAQUE(v)
#endif
constexpr int FN = 16384;
constexpr int FFT_SLOTS = 18432;
__host__ __device__ __forceinline__ int fphys(int p) { return p + (p >> 3); }
__host__ __device__ __forceinline__ float fcos32(int k) {
    constexpr float T[16] = {1.0f, 0.98078528040323043f, 0.92387953251128674f, 0.83146961230254524f, 0.70710678118654752f, 0.55557023301960218f, 0.38268343236508977f, 0.19509032201612825f,
                             0.0f, -0.19509032201612825f, -0.38268343236508977f, -0.55557023301960218f, -0.70710678118654752f, -0.83146961230254524f, -0.92387953251128674f, -0.98078528040323043f};
    return T[k]; }
__host__ __device__ __forceinline__ float fsin32(int k) {
    constexpr float T[16] = {0.0f, 0.19509032201612825f, 0.38268343236508977f, 0.55557023301960218f, 0.70710678118654752f, 0.83146961230254524f, 0.92387953251128674f, 0.98078528040323043f,
                             1.0f, 0.98078528040323043f, 0.92387953251128674f, 0.83146961230254524f, 0.70710678118654752f, 0.55557023301960218f, 0.38268343236508977f, 0.19509032201612825f};
    return T[k]; }
__host__ __device__ __forceinline__ float fcosN(int m) {
    constexpr float T[16] = {1.0f, 0.99999992646571789f, 0.99999970586288223f, 0.99999933819152553f, 0.99999882345170188f, 0.99999816164348698f, 0.99999735276697821f, 0.99999639682229435f,
                             0.99999529380957619f, 0.99999404372898582f, 0.99999264658070719f, 0.99999110236494559f, 0.9999894110819284f, 0.99998757273190408f, 0.9999855873151432f, 0.99998345483193773f};
    return T[m]; }
__host__ __device__ __forceinline__ float fsinN(int m) {
    constexpr float T[16] = {0.0f, 0.00038349518757139556f, 0.00076699031874270449f, 0.0011504853371138485f, 0.0015339801862847655f, 0.001917474809855419f, 0.002300969151425805f, 0.0026844631545959617f,
                             0.0030679567629659761f, 0.003451449920135994f, 0.0038349425697062275f, 0.004218434655276963f, 0.0046019261204485705f, 0.0049854169088215106f, 0.0053689069639963425f, 0.0057523962295737358f};
    return T[m]; }
template <int R> __host__ __device__ __forceinline__ constexpr int fbrev(int x) { int r = 0; for (int b = 1; b < R; b <<= 1) { r = (r << 1) | (x & 1); x >>= 1; } return r; }
#if defined(__HIP_DEVICE_COMPILE__)
__device__ __forceinline__ f32x2 cx_mul_cj2(f32x2 d, f32x2 cs) { f32x2 t, o;
    asm("v_pk_mul_f32 %0, %1, %2 op_sel_hi:[1,0]" : "=v"(t) : "v"(d), "v"(cs));
    asm("v_pk_fma_f32 %0, %1, %2, %3 op_sel:[1,1,0] op_sel_hi:[0,1,1] neg_hi:[1,0,0]" : "=v"(o) : "v"(d), "v"(cs), "v"(t)); return o; }
__device__ __forceinline__ f32x2 cx_mul2(f32x2 d, f32x2 cs) { f32x2 t, o;
    asm("v_pk_mul_f32 %0, %1, %2 op_sel_hi:[1,0]" : "=v"(t) : "v"(d), "v"(cs));
    asm("v_pk_fma_f32 %0, %1, %2, %3 op_sel:[1,1,0] op_sel_hi:[0,1,1] neg_lo:[1,0,0]" : "=v"(o) : "v"(d), "v"(cs), "v"(t)); return o; }
__device__ __forceinline__ f32x2 cx_sub_rot_m(f32x2 a, f32x2 b) { f32x2 o;
    asm("v_pk_add_f32 %0, %1, %2 op_sel:[1,1] op_sel_hi:[0,0] neg_lo:[0,1] neg_hi:[1,0]" : "=v"(o) : "v"(a), "v"(b)); return o; }
__device__ __forceinline__ f32x2 cx_sub_rot_p(f32x2 a, f32x2 b) { f32x2 o;
    asm("v_pk_add_f32 %0, %1, %2 op_sel:[1,1] op_sel_hi:[0,0] neg_lo:[1,0] neg_hi:[0,1]" : "=v"(o) : "v"(a), "v"(b)); return o; }
__device__ __forceinline__ f32x2 cx_add_conj(f32x2 a, f32x2 b) { f32x2 o; asm("v_pk_add_f32 %0, %1, %2 neg_hi:[0,1]" : "=v"(o) : "v"(a), "v"(b)); return o; }
__device__ __forceinline__ f32x2 cx_mi_sub_conj(f32x2 a, f32x2 b) { f32x2 o; asm("v_pk_add_f32 %0, %1, %2 op_sel:[1,1] op_sel_hi:[0,0] neg_hi:[1,0]" : "=v"(o) : "v"(a), "v"(b)); return o; }
__device__ __forceinline__ f32x2 cx_add_i(f32x2 a, f32x2 b) { f32x2 o; asm("v_pk_add_f32 %0, %1, %2 op_sel:[0,1] op_sel_hi:[1,0] neg_lo:[0,1]" : "=v"(o) : "v"(a), "v"(b)); return o; }
__device__ __forceinline__ f32x2 cx_conj_add_i_conj(f32x2 a, f32x2 b) { f32x2 o; asm("v_pk_add_f32 %0, %1, %2 op_sel:[0,1] op_sel_hi:[1,0] neg_hi:[1,0]" : "=v"(o) : "v"(a), "v"(b)); return o; }
#else
__host__ __device__ __forceinline__ f32x2 cx_add_conj(f32x2 a, f32x2 b) { return (f32x2){a.x + b.x, a.y - b.y}; }
__host__ __device__ __forceinline__ f32x2 cx_mi_sub_conj(f32x2 a, f32x2 b) { return (f32x2){a.y + b.y, b.x - a.x}; }
__host__ __device__ __forceinline__ f32x2 cx_add_i(f32x2 a, f32x2 b) { return (f32x2){a.x - b.y, a.y + b.x}; }
__host__ __device__ __forceinline__ f32x2 cx_conj_add_i_conj(f32x2 a, f32x2 b) { return (f32x2){a.x + b.y, b.x - a.y}; }
__host__ __device__ __forceinline__ f32x2 cx_mul_cj2(f32x2 d, f32x2 cs) { return (f32x2){d.x * cs.x + d.y * cs.y, d.y * cs.x - d.x * cs.y}; }
__host__ __device__ __forceinline__ f32x2 cx_mul2(f32x2 d, f32x2 cs) { return (f32x2){d.x * cs.x - d.y * cs.y, d.y * cs.x + d.x * cs.y}; }
__host__ __device__ __forceinline__ f32x2 cx_sub_rot_m(f32x2 a, f32x2 b) { return (f32x2){a.y - b.y, b.x - a.x}; }
__host__ __device__ __forceinline__ f32x2 cx_sub_rot_p(f32x2 a, f32x2 b) { return (f32x2){b.y - a.y, a.x - b.x}; }
#endif
template <int R, bool INV>
__host__ __device__ __forceinline__ void fft_reg(f32x2 (&x)[R]) {
#pragma unroll
    for (int len = R; len >= 2; len >>= 1) {
        const int half = len >> 1;
#pragma unroll
        for (int blk = 0; blk < R; blk += len)
#pragma unroll
            for (int k = 0; k < half; ++k) {
                const int i0 = blk + k, i1 = i0 + half;
                const f32x2 a = x[i0], b = x[i1];
                x[i0] = a + b;
                if (k == 0) x[i1] = a - b;
                else if (4 * k == len) x[i1] = INV ? cx_sub_rot_p(a, b) : cx_sub_rot_m(a, b);
                else { const f32x2 cs = (f32x2){fcos32(k * (32 / len)), fsin32(k * (32 / len))}; const f32x2 d = a - b; x[i1] = INV ? cx_mul2(d, cs) : cx_mul_cj2(d, cs); }
            }
    }
}
__host__ __device__ __forceinline__ void ftw(int num, int den, float& c, float& s) {
#if defined(__HIP_DEVICE_COMPILE__)
    const float fr = (float)num * (1.0f / (float)den); c = __builtin_amdgcn_cosf(fr); s = __builtin_amdgcn_sinf(fr);
#else
    const double a = 6.283185307179586476925 * (double)num / (double)den; c = (float)cos(a); s = (float)sin(a);
#endif
}
template <int R, int M>
__host__ __device__ __forceinline__ void fft_fwd_bfly(FFT_LAS float* buf, int B, int j) {
    constexpr int S = M / R, PS = S == 1 ? 1 : S + S / 8;
    FFT_LAS f32x2* p = (FFT_LAS f32x2*)buf + fphys(B + j);
    f32x2 x[R];
#pragma unroll
    for (int q = 0; q < R; ++q) x[q] = p[q * PS];
    fft_reg<R, false>(x);
    if (S > 1) { float c1, s1; ftw(j, M, c1, s1); const f32x2 cs1 = (f32x2){c1, s1}; f32x2 w = cs1;
#pragma unroll
        for (int r = 1; r < R; ++r) { const int ix = fbrev<R>(r); x[ix] = cx_mul_cj2(x[ix], w); w = cx_mul2(w, cs1); } }
#pragma unroll
    for (int r = 0; r < R; ++r) p[r * PS] = x[fbrev<R>(r)];
}
template <int R, int M>
__host__ __device__ __forceinline__ void fft_inv_bfly(FFT_LAS float* buf, int B, int j) {
    constexpr int S = M / R, PS = S == 1 ? 1 : S + S / 8;
    FFT_LAS f32x2* p = (FFT_LAS f32x2*)buf + fphys(B + j);
    f32x2 x[R];
#pragma unroll
    for (int r = 0; r < R; ++r) x[r] = p[r * PS];
    if (S > 1) { float c1, s1; ftw(j, M, c1, s1); const f32x2 cs1 = (f32x2){c1, s1}; f32x2 w = cs1;
#pragma unroll
        for (int r = 1; r < R; ++r) { x[r] = cx_mul2(x[r], w); w = cx_mul2(w, cs1); } }
    fft_reg<R, true>(x);
#pragma unroll
    for (int q = 0; q < R; ++q) p[q * PS] = x[fbrev<R>(q)];
}
__host__ __device__ __forceinline__ void fft_fwd_pass(FFT_LAS float* buf, int pass, int tid) {
    FFT_OPAQUE(tid);
    if (pass == 0) {
#pragma unroll 1
        for (int i = 0; i < 2; ++i) fft_fwd_bfly<16, 16384>(buf, 0, tid + 512 * i); }
    else if (pass == 1) {
#pragma unroll 1
        for (int i = 0; i < 2; ++i) { const int id = tid + 512 * i; fft_fwd_bfly<16, 1024>(buf, (id >> 6) * 1024, id & 63); } }
    else if (pass == 2) {
#pragma unroll 1
        for (int i = 0; i < 4; ++i) { const int id = tid + 512 * i; fft_fwd_bfly<8, 64>(buf, (id >> 3) * 64, id & 7); } }
    else {
#pragma unroll 1
        for (int i = 0; i < 4; ++i) { const int id = tid + 512 * i; fft_fwd_bfly<8, 8>(buf, id * 8, 0); } }
}
__host__ __device__ __forceinline__ void fft_inv_pass(FFT_LAS float* buf, int pass, int tid) {
    FFT_OPAQUE(tid);
    if (pass == 0) {
#pragma unroll 1
        for (int i = 0; i < 4; ++i) { const int id = tid + 512 * i; fft_inv_bfly<8, 8>(buf, id * 8, 0); } }
    else if (pass == 1) {
#pragma unroll 1
        for (int i = 0; i < 4; ++i) { const int id = tid + 512 * i; fft_inv_bfly<8, 64>(buf, (id >> 3) * 64, id & 7); } }
    else if (pass == 2) {
#pragma unroll 1
        for (int i = 0; i < 2; ++i) { const int id = tid + 512 * i; fft_inv_bfly<16, 1024>(buf, (id >> 6) * 1024, id & 63); } }
    else {
#pragma unroll 1
        for (int i = 0; i < 2; ++i) fft_inv_bfly<16, 16384>(buf, 0, tid + 512 * i); }
}
__host__ __device__ __forceinline__ int fpos(int k) { return ((k & 15) << 10) | (((k >> 4) & 15) << 6) | (((k >> 8) & 7) << 3) | (k >> 11); }
__host__ __device__ __forceinline__ void fft_mul_one(FFT_LAS float* buf, int k, f32x2 c, f32x2 dm, f32x2 w) {
    const int k2 = (FN - k) & (FN - 1);
    FFT_LAS f32x2* pa = (FFT_LAS f32x2*)(buf + 2 * fphys(fpos(k))); FFT_LAS f32x2* pb = (FFT_LAS f32x2*)(buf + 2 * fphys(fpos(k2)));
    const f32x2 A = *pa, Bm = *pb;
    const f32x2 ue = cx_add_conj(A, Bm), uo = cx_mi_sub_conj(A, Bm), ke = cx_add_conj(c, dm), ko = cx_mi_sub_conj(c, dm);
    const f32x2 ye = cx_mul2(ue, ke) + cx_mul_cj2(cx_mul2(uo, ko), w);
    const f32x2 yo = cx_mul2(ue, ko) + cx_mul2(uo, ke);
    *pa = cx_add_i(ye, yo);
    *pb = cx_conj_add_i_conj(ye, yo);
}
__device__ __forceinline__ void p4_fft_job(Frame& F, int job) {
    const float* const* in = F.in;
    int tid_ = F.tid, lane_ = F.lane; FFT_OPAQUE(tid_); FFT_OPAQUE(lane_);
    const int tid = tid_, lane = lane_, wave = F.wave, c0 = job * 4;
    LAS float* buf = (LAS float*)F.lds;
    LAS float* scr = (LAS float*)(F.lds + FFTSCR_OFF);
    float* hfT = (float*)(F.ws + WS_KF); float* hbT = (float*)(F.ws + WS_KB); const float* uT = (const float*)(F.ws + WS_UIN);
    {
        const bf16* hd = (const bf16*)(F.ws + WS_HDN);
        const int n = lane & 15, kq = lane >> 4, ch = (n >> 1) & 3, dir = n & 1, col = dir * 1024 + c0 + ch; const bool valid = n < 8;
        bf16x8 bfr[2];
#pragma unroll
        for (int ks = 0; ks < 2; ++ks) { unsigned w[4];
#pragma unroll
            for (int j = 0; j < 4; ++j) { const int k = ks * 32 + kq * 8 + 2 * j; const float a = valid ? in[IN_FW3][(size_t)k * 2048 + col] : 0.f, b = valid ? in[IN_FW3][(size_t)(k + 1) * 2048 + col] : 0.f; w[j] = cvt_pk_bf16(a, b); }
            bfr[ks] = __builtin_bit_cast(bf16x8, (v4u){w[0], w[1], w[2], w[3]}); }
        const float b3 = valid ? in[IN_FB3][col] : 0.f;
        const float r_slow = 3.0701134573253945f, r_fast = 15.350567286626972f;
        const float rate = r_slow + (float)(c0 + ch) * ((r_fast - r_slow) / 1023.0f);
        const float nrl = -rate * (1.4426950408889634f / (float)(L - 1));
        float asum = 0.f; float* dst = (dir ? hbT : hfT) + (size_t)(c0 + ch) * L;
#pragma unroll 1
        for (int tb = wave * 8; tb < L / 16; tb += NWAVES * 8) {
            bf16x8 a0[8], a1[8];
#pragma unroll
            for (int i = 0; i < 8; ++i) { const bf16* hp = hd + (size_t)((tb + i) * 16 + n) * 64 + kq * 8; a0[i] = *(const bf16x8*)hp; a1[i] = *(const bf16x8*)(hp + 32); }
#pragma unroll
            for (int i = 0; i < 8; ++i) { const int t0 = (tb + i) * 16;
                f32x4 acc = (f32x4){b3, b3, b3, b3};
                acc = __builtin_amdgcn_mfma_f32_16x16x32_bf16(a0[i], bfr[0], acc, 0, 0, 0);
                acc = __builtin_amdgcn_mfma_f32_16x16x32_bf16(a1[i], bfr[1], acc, 0, 0, 0);
                if (valid) { f32x4 o;
#pragma unroll
                    for (int r = 0; r < 4; ++r) { const int t = t0 + 4 * kq + r; const float v = acc[r] * __builtin_amdgcn_exp2f((float)t * nrl); o[r] = v; if (!(dir && t == 0)) asum += fabsf(v); }
                    *(f32x4*)(dst + t0 + 4 * kq) = o; } }
        }
        asum += __shfl_xor(asum, 16); asum += __shfl_xor(asum, 32);
        if (lane < 8) scr[wave * 8 + lane] = asum;
        VM_WAIT(); __syncthreads();
        float tot = 0.f;
        if (tid < 4) { for (int w = 0; w < 8; ++w) tot += scr[w * 8 + 2 * tid] + scr[w * 8 + 2 * tid + 1]; }
        __syncthreads();
        if (tid < 4) scr[tid] = 0.25f / (tot * (float)FN);
        __syncthreads();
    }
    f32x2 hfv[16]; float hbe[16], hbo[16];
#define HY_LOAD_FILTER(c_) do { int tq_ = tid; FFT_OPAQUE(tq_); const float* hf_ = hfT + (size_t)(c_) * L; const float* hb_ = hbT + (size_t)(c_) * L; \
        _Pragma("unroll") for (int i = 0; i < 16; ++i) { const int a = tq_ + NT * i; hfv[i] = *(const f32x2*)(hf_ + 2 * a); } \
        _Pragma("unroll") for (int i = 0; i < 16; ++i) { const int a = FN / 2 + tq_ + NT * i; hbo[i] = hb_[2 * FN - 2 * a - 1]; hbe[i] = hb_[2 * FN - 2 * a]; } } while (0)
#pragma unroll 1
    for (int ch = 0; ch < 4; ++ch) {
        const int c = c0 + ch;
        const float* uc = uT + (size_t)c * L;
        HY_LOAD_FILTER(c);
        { int tq = tid; FFT_OPAQUE(tq);
#pragma unroll
        for (int i = 0; i < 16; ++i) { const int a = tq + NT * i; *(LAS f32x2*)(buf + 2 * fphys(a)) = hfv[i]; }
#pragma unroll
        for (int i = 0; i < 16; ++i) { const int a = FN / 2 + tq + NT * i; *(LAS f32x2*)(buf + 2 * fphys(a)) = (f32x2){a == FN / 2 ? 0.f : hbe[i], hbo[i]}; } }
        f32x2 uv[16];
        { int tq = tid; FFT_OPAQUE(tq);
#pragma unroll
        for (int i = 0; i < 16; ++i) { const int a = tq + NT * i; uv[i] = *(const f32x2*)(uc + 2 * a); } }
        __syncthreads();
        fft_fwd_pass(buf, 0, tid); __syncthreads(); fft_fwd_pass(buf, 1, tid); __syncthreads(); fft_fwd_pass(buf, 2, tid); __syncthreads(); fft_fwd_pass(buf, 3, tid); __syncthreads();
        f32x2 ska[16], skb[16];
        int kbase = ((tid >> 5) << 4) + ((tid & 31) << 8); FFT_OPAQUE(kbase);
#pragma unroll
        for (int m = 0; m < 16; ++m) { const int k = kbase + m, k2 = (FN - k) & (FN - 1); ska[m] = *(const LAS f32x2*)(buf + 2 * fphys(fpos(k))); skb[m] = *(const LAS f32x2*)(buf + 2 * fphys(fpos(k2))); }
        if (tid == 0) { const f32x2 h = *(const LAS f32x2*)(buf + 2 * fphys(fpos(FN / 2))); scr[8] = h.x; scr[9] = h.y; }
        __syncthreads();
        { int tq = tid; FFT_OPAQUE(tq);
#pragma unroll
        for (int i = 0; i < 16; ++i) { const int a = tq + NT * i; *(LAS f32x2*)(buf + 2 * fphys(a)) = uv[i]; }
#pragma unroll 4
        for (int i = 0; i < 16; ++i) { const int a = FN / 2 + tq + NT * i; *(LAS f32x2*)(buf + 2 * fphys(a)) = (f32x2){0.f, 0.f}; } }
        __syncthreads();
        fft_fwd_pass(buf, 0, tid); __syncthreads(); fft_fwd_pass(buf, 1, tid); __syncthreads(); fft_fwd_pass(buf, 2, tid); __syncthreads(); fft_fwd_pass(buf, 3, tid); __syncthreads();
        {   FFT_OPAQUE(kbase); float c1, s1; ftw(kbase, FN, c1, s1);
#pragma unroll
            for (int m = 0; m < 16; ++m) { const float cm = fcosN(m), sm = fsinN(m); const f32x2 w = (f32x2){c1 * cm - s1 * sm, s1 * cm + c1 * sm};
                fft_mul_one(buf, kbase + m, ska[m], skb[m], w); }
            if (tid == 0) { const f32x2 zh = (f32x2){scr[8], scr[9]}; fft_mul_one(buf, FN / 2, zh, zh, (f32x2){-1.0f, 0.0f}); }
        }
        __syncthreads();
        fft_inv_pass(buf, 0, tid); __syncthreads(); fft_inv_pass(buf, 1, tid); __syncthreads(); fft_inv_pass(buf, 2, tid); __syncthreads(); fft_inv_pass(buf, 3, tid); __syncthreads();
        { const float sc = scr[ch]; float* yT = hfT + (size_t)c * L;
#pragma unroll 4
            for (int nn = tid; nn < FN / 2; nn += NT) { const f32x2 v = *(const LAS f32x2*)(buf + 2 * fphys(nn)); *(f32x2*)(yT + 2 * nn) = (f32x2){v.x * sc, v.y * sc}; } }
        __syncthreads();
    }
#undef HY_LOAD_FILTER
    __syncthreads();
}
__device__ __forceinline__ void p5_hy_finish_tile(Frame& F, int tile) {
    const float* const* in = F.in;
    const int tid = F.tid, t0 = (tile >> 2) * 64, cb = (tile & 3) * 256;
    const float* yT = (const float*)(F.ws + WS_KF); const float* uT = (const float*)(F.ws + WS_UIN);
    const bf16* z = (const bf16*)(F.ws + WS_Z); bf16* cat = (bf16*)(F.ws + WS_CAT);
    LAS float* tl = (LAS float*)F.lds;
#pragma unroll 4
    for (int i = tid; i < 4096; i += NT) { const int c = i >> 4, tq = (i & 15) * 4;
        const f32x4 y4 = *(const f32x4*)(yT + (size_t)(cb + c) * L + t0 + tq), u4 = *(const f32x4*)(uT + (size_t)(cb + c) * L + t0 + tq);
        const float d = in[IN_DSKIP][cb + c]; LAS float* s = tl + c * 65 + tq;
        s[0] = y4.x + d * u4.x; s[1] = y4.y + d * u4.y; s[2] = y4.z + d * u4.z; s[3] = y4.w + d * u4.w; }
    __syncthreads();
    const int t = tid & 63, cg = tid >> 6, T = t0 + t, c0 = cb + 32 * cg;
    const bool hp = T > 0, hn = T < L - 1;
#pragma unroll
    for (int q = 0; q < 4; ++q) { const int c = c0 + 8 * q;
        const v4u zc = *(const v4u*)(z + (size_t)T * NINP + OFF_HY + c);
        const v4u zp = hp ? *(const v4u*)(z + (size_t)(T - 1) * NINP + OFF_HY + c) : (v4u){0u, 0u, 0u, 0u};
        const v4u zn = hn ? *(const v4u*)(z + (size_t)(T + 1) * NINP + OFF_HY + c) : (v4u){0u, 0u, 0u, 0u};
        const unsigned cc[4] = {zc.x, zc.y, zc.z, zc.w}, pp[4] = {zp.x, zp.y, zp.z, zp.w}, nn[4] = {zn.x, zn.y, zn.z, zn.w};
        float o[8];
#pragma unroll
        for (int k = 0; k < 4; ++k) { const int ch = c + 2 * k; const LAS float* s = tl + (32 * cg + 8 * q + 2 * k) * 65 + t;
            o[2 * k] = (bflo(pp[k]) * in[IN_CHW][ch] + bflo(cc[k]) * in[IN_CHW][3072 + ch] + bflo(nn[k]) * in[IN_CHW][6144 + ch] + in[IN_CHB][ch]) * s[0];
            o[2 * k + 1] = (bfhi(pp[k]) * in[IN_CHW][ch + 1] + bfhi(cc[k]) * in[IN_CHW][3072 + ch + 1] + bfhi(nn[k]) * in[IN_CHW][6144 + ch + 1] + in[IN_CHB][ch + 1]) * s[65]; }
        v4u w; w.x = cvt_pk_bf16(o[0], o[1]); w.y = cvt_pk_bf16(o[2], o[3]); w.z = cvt_pk_bf16(o[4], o[5]); w.w = cvt_pk_bf16(o[6], o[7]);
        *(v4u*)(cat + (size_t)T * D + MVW + c) = w; }
    __syncthreads();
}

constexpr int RT_PITCH = 2056;
#define RT_BAR() asm volatile("s_waitcnt lgkmcnt(0)\n\ts_barrier" ::: "memory")
template <bool DRY>
__device__ __forceinline__ void p6_norm2_router(Frame& F) {
    const float* const* in = F.in;
    const float* mod = (const float*)(F.ws + WS_MOD);
    unsigned char* h2g = (unsigned char*)(F.ws + WS_HA);
    int* aexp = (int*)(F.ws + WS_AEXP); int* arank = (int*)(F.ws + WS_ARANK); float* aw = (float*)(F.ws + WS_AW);
    LAS bf16* h1 = (LAS bf16*)F.lds;
    LAS float* part = (LAS float*)(h1 + 2 * 16 * RT_PITCH);
    LAS int* lc = (LAS int*)(part + 2 * 16 * 64);
    if (F.tid < 128) lc[F.tid] = 0;
    __syncthreads();
    const bf16* w1 = (const bf16*)(F.ws + WS_WR1);
    const int lane = F.lane, wave = F.wave, fr = lane & 15, fq = lane >> 4;
    const bf16* yg = (const bf16*)(F.ws + WS_YG); const float* posb = (const float*)(F.ws + WS_POS);
    f32x4 xa[8], xb[8]; v2u ya[8], yb[8];
#define RT_PREFETCH(t0_) do { const int ta_ = (t0_) + 2 * wave, tb_ = ta_ + 1; _Pragma("unroll") for (int j = 0; j < 8; ++j) { const int col = 4 * lane + 256 * j; \
        xa[j] = *(const f32x4*)(in[IN_X] + (size_t)ta_ * D + col); xb[j] = *(const f32x4*)(in[IN_X] + (size_t)tb_ * D + col); \
        ya[j] = *(const v2u*)(yg + (size_t)ta_ * D + col); yb[j] = *(const v2u*)(yg + (size_t)tb_ * D + col); } } while (0)
    if (F.bid * 16 < L) RT_PREFETCH(F.bid * 16);
    for (int t0 = F.bid * 16; t0 < L; t0 += F.G * 16) {
        {
            f32x4 va[8], vb[8]; float sa = 0.f, sb = 0.f;
            int lane = F.lane; asm volatile("" : "+v"(lane));
            const int ta = t0 + 2 * wave, tb = ta + 1;
#pragma unroll
            for (int j = 0; j < 8; ++j) { const int col = 4 * lane + 256 * j;
                const float* pa = j < 4 ? posb + (size_t)(ta >> 6) * 1024 + col : posb + (size_t)(256 + (ta & 63)) * 1024 + (col - 1024);
                const float* pb = j < 4 ? posb + (size_t)(tb >> 6) * 1024 + col : posb + (size_t)(256 + (tb & 63)) * 1024 + (col - 1024);
                const f32x4 qa = *(const f32x4*)pa, qb = *(const f32x4*)pb;
                va[j] = (xa[j] + qa) + (f32x4){bflo(ya[j].x), bfhi(ya[j].x), bflo(ya[j].y), bfhi(ya[j].y)};
                vb[j] = (xb[j] + qb) + (f32x4){bflo(yb[j].x), bfhi(yb[j].x), bflo(yb[j].y), bfhi(yb[j].y)}; }
#pragma unroll
            for (int j = 0; j < 8; ++j) { sa += (va[j].x * va[j].x + va[j].y * va[j].y) + (va[j].z * va[j].z + va[j].w * va[j].w); sb += (vb[j].x * vb[j].x + vb[j].y * vb[j].y) + (vb[j].z * vb[j].z + vb[j].w * vb[j].w); }
            const float ra = rsqrtf(wave_sum(sa) * (1.0f / D) + EPS), rb = rsqrtf(wave_sum(sb) * (1.0f / D) + EPS);
#pragma unroll
            for (int j = 0; j < 8; ++j) { const int col = 4 * lane + 256 * j;
                const f32x4 gqj = *(const f32x4*)(in[IN_GFFN] + col) * (*(const f32x4*)(mod + 8192 + col) + 1.0f), sqj = *(const f32x4*)(mod + 6144 + col);
#pragma unroll
                for (int rr = 0; rr < 2; ++rr) { const int tr = 2 * wave + rr, t = t0 + tr;
                    const f32x4 h = ((rr ? vb[j] : va[j]) * (rr ? rb : ra)) * gqj + sqj;
                    v2u o; o.x = cvt_pk_bf16(h.x, h.y); o.y = cvt_pk_bf16(h.z, h.w);
                    *(unsigned*)(h2g + (size_t)t * D + col) = pk_fp8x4(h.x, h.y, h.z, h.w);
                    *(LAS v2u*)(h1 + tr * RT_PITCH + col) = o; } }
        }
        RT_BAR();
        if (t0 + F.G * 16 < L) RT_PREFETCH(t0 + F.G * 16);
        {
            const int nt = wave & 3, kh = wave >> 2;
            f32x4 acc = (f32x4){0.f, 0.f, 0.f, 0.f};
            const bf16* b1p = w1 + (size_t)(16 * nt + fr) * 2048 + kh * 1024 + 8 * fq;
            const LAS bf16* a1p = h1 + fr * RT_PITCH + kh * 1024 + 8 * fq;
#pragma unroll 8
            for (int ks = 0; ks < 32; ++ks) {
                const bf16x8 a1 = *(const LAS bf16x8*)(a1p + 32 * ks);
                const bf16x8 b1 = *(const bf16x8*)(b1p + 32 * ks);
                acc = __builtin_amdgcn_mfma_f32_16x16x32_bf16(a1, b1, acc, 0, 0, 0); }
#pragma unroll
            for (int r = 0; r < 4; ++r) part[(kh * 16 + 4 * fq + r) * 64 + 16 * nt + fr] = acc[r];
        }
        RT_BAR();
#pragma unroll 1
        for (int rr = 0; rr < 2; ++rr) {
            const int tr = 2 * wave + rr, t = t0 + tr;
            const float logit = part[tr * 64 + lane] + part[(16 + tr) * 64 + lane];
            const float s = 1.0f / (1.0f + expf(-logit)), sel = s + in[IN_BR][lane];
            const int grp = lane >> 3;
            float m1 = sel; m1 = fmaxf(m1, __shfl_xor(m1, 1)); m1 = fmaxf(m1, __shfl_xor(m1, 2)); m1 = fmaxf(m1, __shfl_xor(m1, 4));
            const unsigned long long gm = 0xFFull << (8 * grp);
            const unsigned long long b1 = __ballot(sel == m1) & gm;
            const int first = __ffsll((long long)b1) - 1;
            float m2 = (lane == first) ? -INFINITY : sel; m2 = fmaxf(m2, __shfl_xor(m2, 1)); m2 = fmaxf(m2, __shfl_xor(m2, 2)); m2 = fmaxf(m2, __shfl_xor(m2, 4));
            const float gs = m1 + m2;
            int grank = 0;
#pragma unroll
            for (int g = 0; g < 8; ++g) { const float og = __builtin_bit_cast(float, __builtin_amdgcn_readlane(__builtin_bit_cast(int, gs), 8 * g)); grank += (og > gs || (og == gs && g < grp)) ? 1 : 0; }
            const float masked = grank < 4 ? sel : -INFINITY;
            bool chosen = false; float rem = masked;
#pragma unroll
            for (int it8 = 0; it8 < 8; ++it8) { float mx = rem;
#pragma unroll
                for (int o = 1; o < 64; o <<= 1) mx = fmaxf(mx, __shfl_xor(mx, o));
                const unsigned long long bm = __ballot(rem == mx); const int win = __ffsll((long long)bm) - 1;
                if (lane == win) { chosen = true; rem = -INFINITY; } }
            const float wsum = wave_sum(chosen ? s : 0.f);
            const unsigned long long cb = __ballot(chosen);
            if (chosen) {
                const int k = (int)__builtin_amdgcn_mbcnt_hi((unsigned)(cb >> 32), __builtin_amdgcn_mbcnt_lo((unsigned)cb, 0u));
                const int half = t >= HALF_T ? 1 : 0;
                if (!DRY) { const int r = __hip_atomic_fetch_add(lc + half * 64 + lane, 1, __ATOMIC_RELAXED, __HIP_MEMORY_SCOPE_WORKGROUP);
                    aexp[t * 8 + k] = lane; arank[t * 8 + k] = r; aw[t * 8 + k] = s / wsum * 2.5f; }
                else if (s == 12345.678f) aw[t * 8 + k] = s + (float)half;
            }
        }
    }
    __syncthreads();
    if (!DRY && F.tid < 128) ((int*)(F.ws + WS_CNTB))[F.bid * 128 + F.tid] = lc[F.tid];
}
__device__ __forceinline__ void build_pstart(Frame& F) {
    LAS int* ps = (LAS int*)(F.lds + LDSCTL_OFF);
    const int* cnt = (const int*)(F.ws + WS_CTL) + CW_CNT;
    __syncthreads();
    if (F.tid < 2) { int a = 0;
        for (int e = 0; e < NE; ++e) { ps[F.tid * 66 + e] = a; a += (__hip_atomic_load(cnt + F.tid * 64 + e, __ATOMIC_RELAXED, __HIP_MEMORY_SCOPE_AGENT) + 255) & ~255; }
        ps[F.tid * 66 + 64] = a; ps[F.tid * 66 + 65] = a + HALF_T; }
    __syncthreads();
    {
        LAS unsigned char* texp = (LAS unsigned char*)(F.lds + LDSCTL_OFF + 2048); const int ntile = ps[65] >> 8;
        for (int tl = F.tid; tl < ntile; tl += NT) { const int row = tl * 256; int lo = 0, hi = NE1;
            while (hi - lo > 1) { const int mid = (lo + hi) >> 1; if (ps[mid] <= row) lo = mid; else hi = mid; }
            texp[tl] = (unsigned char)lo; }
    }
    __syncthreads();
}
__device__ __forceinline__ void p7_fill_rows(Frame& F) {
    LAS int* ps = (LAS int*)(F.lds + LDSCTL_OFF);
    LAS int* tot = (LAS int*)F.lds; LAS int* pre = tot + 128;
    const int* cntb = (const int*)(F.ws + WS_CNTB);
    int* aexp = (int*)(F.ws + WS_AEXP); int* arank = (int*)(F.ws + WS_ARANK); const float* aw = (const float*)(F.ws + WS_AW);
    int* rt = (int*)(F.ws + WS_RTOK); float* rw = (float*)(F.ws + WS_RW);
    __syncthreads();
    if (F.tid < 128) { int t_ = 0, p_ = 0;
#pragma unroll 8
        for (int b = 0; b < F.G; ++b) { const int v = cntb[b * 128 + F.tid]; t_ += v; p_ += b < F.bid ? v : 0; }
        tot[F.tid] = t_; pre[F.tid] = p_;
        if (F.bid == 0) ((int*)(F.ws + WS_CTL) + CW_CNT)[F.tid] = t_; }
    __syncthreads();
    if (F.tid < 2) { int a = 0;
        for (int e = 0; e < NE; ++e) { ps[F.tid * 66 + e] = a; a += (tot[F.tid * 64 + e] + 255) & ~255; }
        ps[F.tid * 66 + 64] = a; ps[F.tid * 66 + 65] = a + HALF_T; }
    __syncthreads();
    for (int t0 = F.bid * 16; t0 < L; t0 += F.G * 16) {
        if (F.tid < 128) { const int t = t0 + (F.tid >> 3), i = t * 8 + (F.tid & 7), h = t >= HALF_T ? 1 : 0, e = aexp[i];
            const int r = pre[h * 64 + e] + arank[i], row = ps[h * 66 + e] + r;
            arank[i] = r; rt[h * MAXROWS + row] = t; rw[h * MAXROWS + row] = aw[i]; }
        else if (F.tid < 144) { const int t = t0 + (F.tid - 128), h = t >= HALF_T ? 1 : 0; const int row = ps[h * 66 + 64] + (t - h * HALF_T);
            rt[h * MAXROWS + row] = t; rw[h * MAXROWS + row] = 1.0f; }
    }
    __syncthreads();
}
__device__ __forceinline__ void moe_combine(Frame& F, int half, float* outp) {
    const float* const* in = F.in;
    const LAS int* ps = (const LAS int*)(F.lds + LDSCTL_OFF) + half * 66;
    const float* mod = (const float*)(F.ws + WS_MOD);
    const int* aexp = (const int*)(F.ws + WS_AEXP); const int* arank = (const int*)(F.ws + WS_ARANK); const float* aw = (const float*)(F.ws + WS_AW);
    const unsigned char* Y2 = (const unsigned char*)(F.ws + WS_Y2);
    const int gw = F.bid * NWAVES + F.wave, NGW = F.G * NWAVES, lane = F.lane;
    for (int tt = gw; tt < HALF_T; tt += NGW) {
        const int t = half * HALF_T + tt;
        const float* posr = (const float*)(F.ws + WS_POS) + (size_t)(t >> 6) * 1024; const float* posc = (const float*)(F.ws + WS_POS) + (size_t)(256 + (t & 63)) * 1024; const bf16* yg = (const bf16*)(F.ws + WS_YG);
        float a[32];
#pragma unroll
        for (int i = 0; i < 32; ++i) a[i] = 0.f;
#pragma unroll
        for (int k = 0; k < 9; ++k) {
            const int row = k < 8 ? ps[aexp[t * 8 + k]] + arank[t * 8 + k] : ps[64] + tt;
            const float wk = (k < 8 ? aw[t * 8 + k] : 1.0f) * (1.0f / Y2_PRE);
            const unsigned char* yr = Y2 + (size_t)row * D + 8 * lane;
#pragma unroll
            for (int j = 0; j < 4; ++j) { const v2u y = *(const v2u*)(yr + 512 * j);
                const f32x2 p0 = __builtin_amdgcn_cvt_pk_f32_fp8((int)y.x, false), p1 = __builtin_amdgcn_cvt_pk_f32_fp8((int)y.x, true), p2 = __builtin_amdgcn_cvt_pk_f32_fp8((int)y.y, false), p3 = __builtin_amdgcn_cvt_pk_f32_fp8((int)y.y, true);
                a[8 * j + 0] += wk * p0.x; a[8 * j + 1] += wk * p0.y; a[8 * j + 2] += wk * p1.x; a[8 * j + 3] += wk * p1.y;
                a[8 * j + 4] += wk * p2.x; a[8 * j + 5] += wk * p2.y; a[8 * j + 6] += wk * p3.x; a[8 * j + 7] += wk * p3.y; }
        }
        float ss = 0.f;
#pragma unroll
        for (int j = 0; j < 4; ++j)
#pragma unroll
            for (int q = 0; q < 2; ++q) { const int col = 8 * lane + 512 * j + 4 * q;
                const f32x4 xx = *(const f32x4*)(in[IN_X] + (size_t)t * D + col), pp = *(const f32x4*)(j < 2 ? posr + col : posc + (col - 1024)); const v2u yy = *(const v2u*)(yg + (size_t)t * D + col);
                const f32x4 x1 = (xx + pp) + (f32x4){bflo(yy.x), bfhi(yy.x), bflo(yy.y), bfhi(yy.y)}, g2 = *(const f32x4*)(mod + 10240 + col);
                const int i = 8 * j + 4 * q;
                a[i] = x1.x + g2.x * a[i]; a[i + 1] = x1.y + g2.y * a[i + 1]; a[i + 2] = x1.z + g2.z * a[i + 2]; a[i + 3] = x1.w + g2.w * a[i + 3];
                ss += (a[i] * a[i] + a[i + 1] * a[i + 1]) + (a[i + 2] * a[i + 2] + a[i + 3] * a[i + 3]); }
        const float rstd = rsqrtf(wave_sum(ss) * (1.0f / D) + EPS);
#pragma unroll
        for (int j = 0; j < 4; ++j)
#pragma unroll
            for (int q = 0; q < 2; ++q) { const int col = 8 * lane + 512 * j + 4 * q; const int i = 8 * j + 4 * q;
                const f32x4 gf = *(const f32x4*)(in[IN_GFIN] + col);
                *(f32x4*)(outp + (size_t)t * D + col) = (f32x4){a[i] * rstd * gf.x, a[i + 1] * rstd * gf.y, a[i + 2] * rstd * gf.z, a[i + 3] * rstd * gf.w}; }
    }
}

constexpr int N_PHASES = 12;
__global__ void __launch_bounds__(NT, 2) fwd_kernel(Args args) {
    extern __shared__ __attribute__((aligned(16))) unsigned char lds_raw[];
    Frame F;
    F.lds = (LAS unsigned char*)lds_raw;
    F.tid = threadIdx.x; F.lane = F.tid & 63; F.wave = __builtin_amdgcn_readfirstlane(F.tid >> 6);
    F.bid = blockIdx.x; F.G = gridDim.x;
    F.in = args.in; F.out = args.out; F.ws = args.ws;
    volatile LAS unsigned* MISC = (volatile LAS unsigned*)(F.lds + LDSCTL_OFF + 768);
    if (F.tid < 64) ((LAS unsigned*)(F.lds + LDSCTL_OFF))[F.tid + 192] = 0u;
    __syncthreads();
    unsigned* ctl = (unsigned*)(F.ws + WS_CTL);
    const int lo = args.ph_lo, hi = args.ph_hi;
    XcdBarrier bar; bar.bar = ctl + CW_BAR; bar.x = 0; bar.st = nullptr;
    if (hi - lo > 1) bar = xcd_barrier_post(ctl + CW_BAR, MISC + 8);
#ifndef PH_MASK
#define PH_MASK 0xFFFF
#endif
#define IN(k) (((PH_MASK >> (k)) & 1) && lo <= (k) && (k) < hi)
#define SEAM(k) do { if (IN(k) && IN((k) + 1)) xcd_barrier(bar); } while (0)
#define REP(k) for (int rep_ = 0; rep_ < ((PROBE_DUP) == (k) ? 2 : 1); ++rep_) if ((rep_ ? __syncthreads() : (void)0), true)
    LAS int* ps = (LAS int*)(F.lds + LDSCTL_OFF);

    if (IN(0)) REP(0) { p0_prologue(F); } SEAM(0);
#if PROBE_DUP == 68
    if (IN(0) && IN(1)) { for (int i = 0; i < 10; ++i) xcd_barrier(bar); }
#endif
    if (IN(1)) REP(1) { p1_norm1(F); } SEAM(1);
    if (IN(2)) {
        const int nconv = F.G >= 128 ? 32 : 0, GG = F.G - nconv;
        if (F.bid >= GG) conv_worker(F);
        else {
            gk::DenseOrder S; S.init(L, NINP, D * 2, GG, F.bid); S.nExtra = 7; S.Bt = (const char*)(F.ws + WS_WIN);
            gk::EpiBf16Store E{(bf16*)(F.ws + WS_Z), NINP, 1.0f};
            gk::gemm_core(F.lds, (const char*)(F.ws + WS_HA), D * 2, S, E);
            conv_worker(F);
        }
    }
#if PROBE_DUP >= 60 && PROBE_DUP <= 63
    if (IN(2)) { __syncthreads(); gk::DenseOrder S; S.init(MROWS, NINP, D * 2, F.G, F.bid); S.Bt = (const char*)(F.ws + WS_WIN);
        gk::EpiBf16Store E{(bf16*)(F.ws + WS_CAT), NINP, 1.0f};
        gk::gemm_core(F.lds, (const char*)(F.ws + WS_HA), (D * 2) >> (PROBE_DUP - 60), S, E); }
#endif
#if PROBE_DUP == 64
    if (IN(2)) { __syncthreads(); gk::DenseOrder S; S.init(MROWS, NINP, D * 2, F.G, F.bid); S.Bt = (const char*)(F.ws + WS_WIN);
        gk::EpiLinearStore E{(bf16*)(F.ws + WS_CAT)};
        gk::gemm_core(F.lds, (const char*)(F.ws + WS_HA), (D * 2) >> 3, S, E); }
#endif
    SEAM(2);
    if (IN(3)) REP(3) {
        for (int it = F.bid; it < 1040; it += F.G) ml_prep_item(F, it);
        for (int tile = F.bid; tile < 256; tile += F.G) p3_filter_tile(F, tile);
        for (int tile = F.bid; tile < 1024; tile += F.G) p3_uin_tile(F, tile);
    } SEAM(3);
    if (IN(4)) REP(4) {
        ml_scan(F);
#if PROBE_DUP == 70
        ml_scan(F);
#endif
        __syncthreads();
        for (int job = F.bid; job < 256; job += F.G) p4_fft_job(F, job);
#if PROBE_DUP == 71
        for (int job = F.bid; job < 256; job += F.G) p4_fft_job(F, job);
#endif
    } SEAM(4);
    if (IN(5)) REP(5) {
        for (int it = F.bid; it < 1024; it += F.G) ml_out_item(F, it);
        for (int tile = F.bid; tile < 1024; tile += F.G) p5_hy_finish_tile(F, tile);
    } SEAM(5);
    if (IN(6)) {
        gk::DenseOrder S; S.init(L, D, D * 2, F.G, F.bid); S.Bt = (const char*)(F.ws + WS_WOUT);
        gk::EpiGateBf16 E{(bf16*)(F.ws + WS_YG), D, (const float*)(F.ws + WS_MOD) + 4096};
        gk::gemm_core(F.lds, (const char*)(F.ws + WS_CAT), D * 2, S, E);
    } SEAM(6);
    if (IN(7)) { p6_norm2_router<false>(F); }
#if PROBE_DUP == 66
    if (IN(7)) { __syncthreads(); p6_norm2_router<true>(F); }
#endif
    SEAM(7);
    if (IN(8)) { p7_fill_rows(F); } SEAM(8);
#define MOE_GU(h) do { build_pstart(F); \
        gk::GroupOrder<4, true> S; S.ntile = ps[(h) * 66 + 65] >> 8; S.G = F.G; S.c = F.bid; S.KB = D; S.pstart = ps + (h) * 66; S.texp = (const LAS unsigned char*)(F.lds + LDSCTL_OFF + 2048); S.rtok = (const int*)(F.ws + WS_RTOK) + (h) * MAXROWS; \
        S.Bt = (const char*)(F.ws + WS_W13); S.bstride = (size_t)1024 * D; \
        gk::EpiGateUpF8 E{(unsigned char*)(F.ws + WS_HR), 1.0f / W13_PRE, HR_PRE}; \
        gk::gemm_core<gk::EpiGateUpF8, gk::GroupOrder<4, true>, true>(F.lds, (const char*)(F.ws + WS_HA), D, S, E); } while (0)
#define MOE_DN(h) do { build_pstart(F); \
        gk::GroupOrder<8, false, true> S; S.ntile = ps[(h) * 66 + 65] >> 8; S.G = F.G; S.c = F.bid; S.KB = DE; S.pstart = ps + (h) * 66; S.texp = (const LAS unsigned char*)(F.lds + LDSCTL_OFF + 2048); S.rtok = nullptr; \
        S.Bt = (const char*)(F.ws + WS_W2); S.bstride = (size_t)D * DE; \
        gk::EpiF8Store E{(unsigned char*)(F.ws + WS_Y2), D, Y2_PRE / (W2_PRE * HR_PRE), (unsigned)((size_t)MAXROWS * D)}; \
        gk::gemm_core<gk::EpiF8Store, gk::GroupOrder<8, false, true>, true>(F.lds, (const char*)(F.ws + WS_HR), DE, S, E); } while (0)
    if (IN(9)) REP(9) { MOE_GU(0); } SEAM(9);
    if (IN(10)) REP(10) { MOE_DN(0); } SEAM(10);
    if (IN(11)) { build_pstart(F); moe_combine(F, 0, F.out); }
#undef IN
#undef SEAM
}

extern "C" void kernel_launch(void* const* d_in, const int* in_sizes, int n_in, void* d_out, int out_size, void* d_ws, size_t ws_size, hipStream_t stream) {
    static int grid = 0;
    if (grid == 0) {
        if (n_in != 36 || out_size != L * D || ws_size < WS_END) { fprintf(stderr, "kernel_launch: unexpected shapes: n_in %d out %d ws %zu (need %zu)\n", n_in, out_size, ws_size, (size_t)WS_END); grid = -1; return; }
        int dev = 0, cus = 0, per_cu = 0;
        if (hipGetDevice(&dev) != hipSuccess || hipDeviceGetAttribute(&cus, hipDeviceAttributeMultiprocessorCount, dev) != hipSuccess) { grid = -1; return; }
        if (hipFuncSetAttribute((const void*)fwd_kernel, hipFuncAttributeMaxDynamicSharedMemorySize, LDS_BYTES) != hipSuccess) { fprintf(stderr, "kernel_launch: hipFuncSetAttribute failed\n"); grid = -1; return; }
        if (hipOccupancyMaxActiveBlocksPerMultiprocessor(&per_cu, (const void*)fwd_kernel, NT, LDS_BYTES) != hipSuccess || per_cu < 1) fprintf(stderr, "kernel_launch: occupancy query says %d\n", per_cu);
        (void)hipGetLastError();
        grid = cus < 256 ? cus : 256;
    }
    if (grid < 0) return;
    if (hipMemsetAsync((char*)d_ws + WS_CTL, 0, CTL_ZERO_BYTES, stream) != hipSuccess) return;
    Args a{};
    for (int i = 0; i < 36; ++i) a.in[i] = (const float*)d_in[i];
    a.out = (float*)d_out; a.ws = (unsigned char*)d_ws;
    const int stop = MK_STOP_AFTER < N_PHASES ? MK_STOP_AFTER + 1 : N_PHASES;
#if MK_N_LAUNCHES == 1
    a.ph_lo = 0; a.ph_hi = stop;
    hipLaunchKernelGGL(fwd_kernel, dim3(grid), dim3(NT), LDS_BYTES, stream, a);
#else
    for (int p = 0; p < stop; ++p) { a.ph_lo = p; a.ph_hi = p + 1; hipLaunchKernelGGL(fwd_kernel, dim3(grid), dim3(NT), LDS_BYTES, stream, a); }
#endif
}
```

```cpp
#include <hip/hip_runtime.h>
#include <cstdio>
#include <cstdint>

#ifndef MK_N_LAUNCHES
#define MK_N_LAUNCHES 1
#endif
#ifndef PROBE_DUP
#define PROBE_DUP -1
#endif
#ifndef MK_STOP_AFTER
#define MK_STOP_AFTER 99
#endif

#define GAS __attribute__((address_space(1)))
#define LAS __attribute__((address_space(3)))
typedef unsigned short bf16;
typedef unsigned v4u __attribute__((ext_vector_type(4)));
typedef unsigned v2u __attribute__((ext_vector_type(2)));
typedef float f32x4 __attribute__((ext_vector_type(4)));
typedef float f32x2 __attribute__((ext_vector_type(2)));
typedef short bf16x8 __attribute__((ext_vector_type(8)));
#define LDS_WAIT() asm volatile("s_waitcnt lgkmcnt(0)" ::: "memory")
#define VM_WAIT() asm volatile("s_waitcnt vmcnt(0)" ::: "memory")

constexpr int NWAVES = 8, NT = NWAVES * 64;
constexpr int L = 16384, D = 2048, LC = 256, MROWS = L + LC;
constexpr int NIN = 6176, NINP = 6400;
constexpr int OFF_K = 0, OFF_V = 512, OFF_G = 1536, OFF_Q = 1568, OFF_O = 2080, OFF_HY = 3104;
constexpr int NH = 8, HYW = 1024, MVW = 1024;
constexpr int NE = 64, NE1 = 65, DE = 512;
constexpr int HALF_T = L;
constexpr int MAXROWS = 163840;
constexpr float EPS = 1e-6f;
constexpr float W13_PRE = 64.0f, W2_PRE = 32.0f, HR_PRE = 4.0f, Y2_PRE = 8.0f;

constexpr size_t MiB = 1u << 20;
constexpr size_t WS_CTL = 0, CTL_ZERO_BYTES = 256 * 1024;
constexpr size_t WS_MOD = 1 * MiB;
constexpr size_t WS_POS = WS_MOD + 128 * 1024;
constexpr size_t WS_WR1 = 2 * MiB + 512 * 1024;
constexpr size_t WS_WR2 = WS_WR1 + 256 * 1024;
constexpr size_t WS_WIN = 3 * MiB;
constexpr size_t WS_WOUT = 28 * MiB;
constexpr size_t WS_W13 = 36 * MiB;
constexpr size_t WS_YG = 166 * MiB;
constexpr size_t WS_W2 = 296 * MiB;
constexpr size_t WS_HA = 426 * MiB;
constexpr size_t WS_Z = 491 * MiB;
constexpr size_t WS_CAT = 695 * MiB;
constexpr size_t WS_UIN = 759 * MiB;
constexpr size_t WS_KF = 823 * MiB;
constexpr size_t WS_KB = 887 * MiB;
constexpr size_t WS_CL = 426 * MiB;
constexpr size_t WS_CI = 951 * MiB;
constexpr size_t WS_Q = 983 * MiB;
constexpr size_t WS_K = 999 * MiB;
constexpr size_t WS_RTOK = 1015 * MiB;
constexpr size_t WS_RW = WS_RTOK + MAXROWS * 4;
constexpr size_t WS_AEXP = 1017 * MiB;
constexpr size_t WS_ARANK = WS_AEXP + 512 * 1024;
constexpr size_t WS_AW = WS_ARANK + 512 * 1024;
constexpr size_t WS_CNTB = WS_AW + 512 * 1024;
constexpr size_t WS_HDN = 1019 * MiB;
constexpr size_t WS_SC = 1021 * MiB;
constexpr size_t WS_NL = WS_SC + 32 * 1024;
constexpr size_t WS_NI = WS_NL + 640 * 1024;
constexpr size_t WS_MI = WS_NI + 640 * 1024;
constexpr size_t WS_END = 1023 * MiB;
constexpr size_t WS_HR = 491 * MiB;
constexpr size_t WS_Y2 = 579 * MiB;
static_assert(WS_HR + (size_t)MAXROWS * 512 <= WS_Y2 && WS_Y2 + (size_t)MAXROWS * 2048 <= WS_CI && WS_RW + (size_t)MAXROWS * 4 <= 1017 * MiB, "overlay");
constexpr int CW_BAR = 4096;
constexpr int CW_CNT = 16384;
constexpr int CW_QCONV = 20480;

constexpr int RING_BYTES = 131072;
constexpr int LDSCTL_OFF = 147456;
constexpr int FFTSCR_OFF = LDSCTL_OFF + 1024;
constexpr int LDS_BYTES = 151552;

__device__ __forceinline__ unsigned cvt_pk_bf16(float lo, float hi) { unsigned r; asm volatile("v_cvt_pk_bf16_f32 %0, %1, %2" : "=v"(r) : "v"(lo), "v"(hi)); return r; }
__device__ __forceinline__ float bf2f(unsigned short b) { return __builtin_bit_cast(float, ((unsigned)b) << 16); }
__device__ __forceinline__ float bflo(unsigned u) { return __builtin_bit_cast(float, u << 16); }
__device__ __forceinline__ float bfhi(unsigned u) { return __builtin_bit_cast(float, u & 0xffff0000u); }
__device__ __forceinline__ float wave_sum(float v) {
#pragma unroll
    for (int o = 1; o < 64; o <<= 1) v += __shfl_xor(v, o);
    return v;
}
__device__ __forceinline__ float silu_f(float a) { return a / (1.f + __expf(-a)); }
__device__ __forceinline__ float sigmoid_f(float a) { return 1.f / (1.f + __expf(-a)); }

#define XB_TMO      128
#define XB_XCNT(j)  (256  + 64 * (j))
#define XB_XSUB(j)  (1280 + 64 * (j))
#define XB_XGEN(j)  (2304 + 64 * (j))
#define XB_TOP      3328
#define XB_TOPGEN   3392
#define XCD_BAR_WORDS 3456
#define XB_SPIN_CAP (1u << 18)

__device__ __forceinline__ unsigned xb_ld(unsigned* p)              { return __hip_atomic_load(p, __ATOMIC_RELAXED, __HIP_MEMORY_SCOPE_AGENT); }
__device__ __forceinline__ unsigned xb_add(unsigned* p, unsigned v) { return __hip_atomic_fetch_add(p, v, __ATOMIC_RELAXED, __HIP_MEMORY_SCOPE_AGENT); }
__device__ __forceinline__ unsigned xb_xcc_id() { return (unsigned)__builtin_amdgcn_s_getreg((3 << 11) | 20) & 0xFu; }
#define XB_SPIN(cond, bar) do { unsigned _sp = 0; while (cond) { __builtin_amdgcn_s_sleep(1); \
    if ((++_sp & 255u) == 0u) { if (xb_ld(&(bar)[XB_TMO])) break; if (_sp > XB_SPIN_CAP) { atomicAdd(&(bar)[XB_TMO], 1u); break; } } } } while (0)

struct XcdBarrier {
    unsigned* bar; unsigned x;
    volatile LAS unsigned* st;
};

__device__ __forceinline__ XcdBarrier xcd_barrier_post(unsigned* bar, volatile LAS unsigned* st) {
    XcdBarrier b; b.bar = bar; b.x = xb_xcc_id(); b.st = st;
    if (threadIdx.x == 0) (void)xb_add(&bar[XB_XCNT(b.x)], 1u);
    return b;
}
__device__ __forceinline__ void xcd_barrier_complete(unsigned* bar, unsigned x, unsigned& nloc, unsigned& nx) {
    const unsigned G = gridDim.x * gridDim.y * gridDim.z;
    unsigned sum, cnt, mine, sp = 0u;
    for (;;) {
        sum = 0u; cnt = 0u; mine = 0u;
#pragma unroll
        for (unsigned j = 0; j < 16; ++j) { const unsigned c = xb_ld(&bar[XB_XCNT(j)]); sum += c; cnt += (c > 0u) ? 1u : 0u; mine = (j == x) ? c : mine; }
        if (sum == G) break;
        __builtin_amdgcn_s_sleep(1);
        if ((++sp & 255u) == 0u) { if (xb_ld(&bar[XB_TMO])) break; if (sp > XB_SPIN_CAP) { atomicAdd(&bar[XB_TMO], 1u); break; } }
    }
    nloc = mine > 0u ? mine : 1u; nx = cnt > 0u ? cnt : 1u;
}

__device__ __forceinline__ void xcd_barrier(const XcdBarrier& b) {
    asm volatile("s_waitcnt vmcnt(0)" ::: "memory");
    __syncthreads();
    if (threadIdx.x == 0) {
        unsigned* bar = b.bar;
        __builtin_amdgcn_s_waitcnt(0);
        unsigned nloc = b.st[0], nx = b.st[1];
        if (nloc == 0u) { xcd_barrier_complete(bar, b.x, nloc, nx); b.st[0] = nloc; b.st[1] = nx; }
        const unsigned old = xb_add(&bar[XB_XSUB(b.x)], 1u);
        const unsigned gen = old / nloc;
        if (old + 1u == (gen + 1u) * nloc) {
            __builtin_amdgcn_fence(__ATOMIC_RELEASE, "agent");
            asm volatile("s_waitcnt vmcnt(0)" ::: "memory");
            const unsigned og = xb_add(&bar[XB_TOP], 1u);
            const unsigned tg = og / nx;
            if (og + 1u == (tg + 1u) * nx) xb_add(&bar[XB_TOPGEN], 1u);
            else XB_SPIN(xb_ld(&bar[XB_TOPGEN]) == tg, bar);
            __builtin_amdgcn_fence(__ATOMIC_ACQUIRE, "agent");
            xb_add(&bar[XB_XGEN(b.x)], 1u);
            asm volatile("s_waitcnt vmcnt(0)" ::: "memory");
        } else {
            XB_SPIN(xb_ld(&bar[XB_XGEN(b.x)]) == gen, bar);
            __builtin_amdgcn_fence(__ATOMIC_ACQUIRE, "agent");
            asm volatile("s_waitcnt vmcnt(0)" ::: "memory");
        }
    }
    __syncthreads();
}

namespace gk {
constexpr int BM = 256, BK = 64, HALF = 128, HTB = HALF * BK * 2, STAGE_BYTES = 8 * HTB, NXCD = 8, WGM = 8;
__host__ __device__ __forceinline__ int lds_byte(int r, int c) { const int st = (r >> 4) * 2 + (c >> 5), rr = r & 15, cc = c & 31, ob = rr * 64 + cc * 2; return st * 1024 + (ob ^ (((ob >> 9) & 1) << 5)); }
__host__ __device__ __forceinline__ void stage_rc(int b, int& R, int& C) { const int st = b / 1024, sb = b % 1024, swz = sb ^ (((sb >> 9) & 1) << 5); R = (st >> 1) * 16 + swz / 64; C = (st & 1) * 32 + (swz % 64) / 2; }
__host__ __device__ __forceinline__ int perm32(int rho) { const int n = rho >> 4, i = rho & 15; return 8 * (i >> 2) + 4 * n + (i & 3); }

struct Unit { int pm, pn, ex; };

typedef int v8i_t __attribute__((ext_vector_type(8)));
typedef int v4i_t __attribute__((ext_vector_type(4)));
template <class Epi, class Sched, bool F8 = false>
__device__ __forceinline__ void gemm_core(LAS unsigned char* lds, const char* Abase, const int KB_  , const Sched& S, const Epi& E, const int stag = 0  ) {
    int KBo = KB_; asm volatile("" : "+s"(KBo)); const int KB = KBo;
    if (stag > 0) {
        const unsigned long long t0 = __builtin_amdgcn_s_memrealtime(), tgt = t0 + (unsigned long long)((blockIdx.x >> 3) & 7u) * (unsigned)stag;
        while (__builtin_amdgcn_s_memrealtime() < tgt) __builtin_amdgcn_s_sleep(8);
    }
    const int tid = threadIdx.x, wid = __builtin_amdgcn_readfirstlane(tid >> 6), lane = tid & 63, wr = wid >> 2, wc = wid & 3, fr = lane & 15, fq = lane >> 4;
    const int nt = KB / (BK * 2);
    int RA[2], CA[2]; unsigned voffB[2];
#pragma unroll
    for (int i = 0; i < 2; ++i) { int R, C; stage_rc(tid * 16 + i * 8192, R, C);
        const int Rb = Epi::P64 ? (64 * (R >> 5) + 16 * ((R & 15) >> 2) + 4 * ((R >> 4) & 1) + (R & 3)) : Epi::P32 ? (64 * (R >> 5) + 8 * ((R & 15) >> 2) + 4 * ((R >> 4) & 1) + (R & 3)) : Epi::PERM ? ((R & ~31) + perm32(R & 31)) : R;
        RA[i] = R; CA[i] = C; voffB[i] = (unsigned)(Rb * KB + C * 2); }
    const size_t kstep = (size_t)(BK * 2);
    const size_t hstepB = (size_t)(Epi::P64 ? 8 : Epi::P32 ? 32 : HALF) * KB;
    const unsigned ldsw = (unsigned)wid * 1024u;
    const int aoff = lds_byte(wr * 64 + fr, fq * 8), boff = lds_byte(wc * 32 + fr, fq * 8);
#define GK_SA(b, h) (((b) * 2 + (h)) * HTB)
#define GK_SB(b, h) ((4 + (b) * 2 + (h)) * HTB)
#define GK_STAGE(bufoff, gbase, v0, v1) do { \
        __builtin_amdgcn_global_load_lds((const unsigned*)((const char*)(gbase) + (v0)), (LAS unsigned*)(lds + (bufoff) + ldsw), 16, 0, 0); \
        __builtin_amdgcn_global_load_lds((const unsigned*)((const char*)(gbase) + (v1)), (LAS unsigned*)(lds + (bufoff) + ldsw + 8192), 16, 0, 0); } while (0)
#define GK_LDA(dst, b, h) do { _Pragma("unroll") for (int m = 0; m < 4; ++m) _Pragma("unroll") for (int k = 0; k < 2; ++k) dst[m][k] = *(const LAS bf16x8*)(lds + GK_SA(b, h) + aoff + m * 2048 + k * 1024); } while (0)
#define GK_LDB(dst, b, h) do { _Pragma("unroll") for (int n = 0; n < 2; ++n) _Pragma("unroll") for (int k = 0; k < 2; ++k) dst[n][k] = *(const LAS bf16x8*)(lds + GK_SB(b, h) + boff + n * 2048 + k * 1024); } while (0)
#define GK_MMA(ai, bj, At, Bt) do { __builtin_amdgcn_s_setprio(1); _Pragma("unroll") for (int m = 0; m < 4; ++m) _Pragma("unroll") for (int n = 0; n < 2; ++n) { \
        if constexpr (F8) { const v8i_t bb = __builtin_shufflevector(__builtin_bit_cast(v4i_t, Bt[n][0]), __builtin_bit_cast(v4i_t, Bt[n][1]), 0, 1, 2, 3, 4, 5, 6, 7); \
            const v8i_t aa = __builtin_shufflevector(__builtin_bit_cast(v4i_t, At[m][0]), __builtin_bit_cast(v4i_t, At[m][1]), 0, 1, 2, 3, 4, 5, 6, 7); \
            asm volatile("v_mfma_scale_f32_16x16x128_f8f6f4 %0, %1, %2, %0, %3, %3 op_sel_hi:[0,0,0]" : "+v"(acc[ai][bj][m][n]) : "v"(bb), "v"(aa), "v"(f8scale)); } \
        else { _Pragma("unroll") for (int k = 0; k < 2; ++k) acc[ai][bj][m][n] = __builtin_amdgcn_mfma_f32_16x16x32_bf16(Bt[n][k], At[m][k], acc[ai][bj][m][n], 0, 0, 0); } } \
        __builtin_amdgcn_s_setprio(0); } while (0)
#define GK_WAIT_V(n) asm volatile("s_waitcnt vmcnt(" #n ")" ::: "memory")
#define GK_WAIT_L(n) asm volatile("s_waitcnt lgkmcnt(" #n ")" ::: "memory")
#define GK_BAR __builtin_amdgcn_s_barrier()
#define GK_SCHED __builtin_amdgcn_sched_barrier(0)
    Unit cur, nxt; int ui = 0;
    if (!S.next(0, cur)) return;
    int f8scale = 0x7F7F7F7F; asm volatile("" : "+v"(f8scale));
    f32x4 acc[2][2][4][2];
#pragma unroll
    for (int a = 0; a < 2; ++a)
#pragma unroll
        for (int b = 0; b < 2; ++b)
#pragma unroll
            for (int m = 0; m < 4; ++m)
#pragma unroll
                for (int n = 0; n < 2; ++n) acc[a][b][m][n] = (f32x4){0.f, 0.f, 0.f, 0.f};
    bf16x8 At[4][2], B0[2][2], B1[2][2];
    unsigned c00, c01, c10, c11, n00, n01, n10, n11;
    S.a_offs(cur, RA, CA, c00, c01, c10, c11);
    asm volatile("" : "+v"(c00), "+v"(c01), "+v"(c10), "+v"(c11));
    const char* cB = S.b_base(cur);
    GK_STAGE(GK_SB(0, 0), cB, voffB[0], voffB[1]); GK_STAGE(GK_SB(0, 1), cB + hstepB, voffB[0], voffB[1]); GK_STAGE(GK_SA(0, 0), Abase, c00, c01); GK_STAGE(GK_SA(0, 1), Abase, c10, c11);
    if (wr == 1) GK_BAR;
    GK_WAIT_V(2); GK_BAR;
    GK_STAGE(GK_SB(1, 0), cB + kstep, voffB[0], voffB[1]); GK_STAGE(GK_SA(1, 0), Abase + kstep, c00, c01); GK_STAGE(GK_SB(1, 1), cB + hstepB + kstep, voffB[0], voffB[1]);
    GK_WAIT_V(6); GK_BAR;
    for (;;) {
        const bool has_next = S.next(ui + 1, nxt);
        const char* nB = cB;
        n00 = c00; n01 = c01; n10 = c10; n11 = c11;
        if (has_next) { S.a_offs(nxt, RA, CA, n00, n01, n10, n11); nB = S.b_base(nxt); }
        asm volatile("" : "+v"(n00), "+v"(n01), "+v"(n10), "+v"(n11));
        for (int t = 0; t < nt; t += 2) {
            const bool last = (t == nt - 2);
            const char* a1 = Abase + (size_t)(t + 1) * kstep;
            const char* a2 = last ? Abase : Abase + (size_t)(t + 2) * kstep; const char* b2 = last ? nB : cB + (size_t)(t + 2) * kstep;
            const char* a3 = a2 + kstep; const char* b3 = b2 + kstep;
            const unsigned x00 = last ? n00 : c00, x01 = last ? n01 : c01, x10 = last ? n10 : c10, x11 = last ? n11 : c11;
            GK_LDB(B0, 0, 0); GK_LDB(B1, 0, 1); GK_SCHED; GK_LDA(At, 0, 0); GK_STAGE(GK_SA(1, 1), a1, c10, c11);
            GK_WAIT_V(8); GK_WAIT_L(0); GK_BAR; GK_MMA(0, 0, At, B0); GK_MMA(0, 1, At, B1); GK_BAR; GK_SCHED;
            GK_LDA(At, 0, 1); GK_STAGE(GK_SB(0, 0), b2, voffB[0], voffB[1]); GK_STAGE(GK_SB(0, 1), b2 + hstepB, voffB[0], voffB[1]); GK_STAGE(GK_SA(0, 0), a2, x00, x01);
            GK_WAIT_V(8); GK_WAIT_L(0); GK_BAR; GK_MMA(1, 0, At, B0); GK_MMA(1, 1, At, B1); GK_BAR; GK_SCHED;
            GK_LDB(B0, 1, 0); GK_LDB(B1, 1, 1); GK_SCHED; GK_LDA(At, 1, 0); GK_STAGE(GK_SA(0, 1), a2, x10, x11);
            GK_WAIT_V(8); GK_WAIT_L(0); GK_BAR; GK_MMA(0, 0, At, B0); GK_MMA(0, 1, At, B1); GK_BAR; GK_SCHED;
            GK_LDA(At, 1, 1); GK_STAGE(GK_SB(1, 0), b3, voffB[0], voffB[1]); GK_STAGE(GK_SB(1, 1), b3 + hstepB, voffB[0], voffB[1]); GK_STAGE(GK_SA(1, 0), a3, x00, x01);
            GK_WAIT_V(8); GK_WAIT_L(0); GK_BAR; GK_MMA(1, 0, At, B0); GK_MMA(1, 1, At, B1); GK_BAR; GK_SCHED;
        }
        if (wr == 0) GK_BAR;
        if constexpr (F8) {
#define GK_ACC8(a, b) "+v"(acc[a][b][0][0]), "+v"(acc[a][b][0][1]), "+v"(acc[a][b][1][0]), "+v"(acc[a][b][1][1]), "+v"(acc[a][b][2][0]), "+v"(acc[a][b][2][1]), "+v"(acc[a][b][3][0]), "+v"(acc[a][b][3][1])
            asm volatile("s_nop 15\n\ts_nop 15\n\ts_nop 15\n\ts_nop 15\n\ts_nop 15\n\ts_nop 15" : GK_ACC8(0, 0), GK_ACC8(0, 1) :: "memory");
            asm volatile("" : GK_ACC8(1, 0), GK_ACC8(1, 1) :: "memory");
#undef GK_ACC8
        }
        E(acc, cur, wr, wc, fr, fq);
        if (!has_next) break;
#pragma unroll
        for (int a = 0; a < 2; ++a)
#pragma unroll
            for (int b = 0; b < 2; ++b)
#pragma unroll
                for (int m = 0; m < 4; ++m)
#pragma unroll
                    for (int n = 0; n < 2; ++n) acc[a][b][m][n] = (f32x4){0.f, 0.f, 0.f, 0.f};
        cur = nxt; cB = nB; c00 = n00; c01 = n01; c10 = n10; c11 = n11; ++ui;
        if (wr == 1) GK_BAR;
    }
    GK_WAIT_V(0);
    GK_BAR;
#undef GK_SA
#undef GK_SB
#undef GK_STAGE
#undef GK_LDA
#undef GK_LDB
#undef GK_MMA
#undef GK_WAIT_V
#undef GK_WAIT_L
#undef GK_BAR
#undef GK_SCHED
}

struct DenseOrder {
    int nM, nN, nwg, G, c, KB, nExtra;
    __device__ void init(int M, int N, int KB_, int G_, int c_) { nM = M / BM; nN = N / BM; nwg = nM * nN; G = G_; c = c_; KB = KB_; nExtra = 0; }
    __device__ __forceinline__ bool next(int i, Unit& u) const {
        const long Lx = (long)i * G + c;
        if (Lx >= nwg) { if (Lx < nwg + nExtra) { u.pm = nM; u.pn = (int)(Lx - nwg); u.ex = 0; return true; } return false; }
        int wgid = (int)Lx; { const int q = nwg / NXCD, r = nwg % NXCD, xcd = wgid % NXCD, off = wgid / NXCD; wgid = (xcd < r ? xcd * (q + 1) : r * (q + 1) + (xcd - r) * q) + off; }
        const int nig = WGM * nN, gid = wgid / nig, fm = gid * WGM, gsz = (nM - fm) < WGM ? (nM - fm) : WGM;
        u.pm = fm + ((wgid % nig) % gsz); u.pn = (wgid % nig) / gsz; u.ex = 0; return true;
    }
    const char* Bt;
    __device__ __forceinline__ void a_offs(const Unit& u, const int (&RA)[2], const int (&CA)[2], unsigned& o00, unsigned& o01, unsigned& o10, unsigned& o11) const {
        const unsigned r0 = (unsigned)(u.pm * BM);
        o00 = (r0 + RA[0]) * (unsigned)KB + CA[0] * 2u; o01 = (r0 + RA[1]) * (unsigned)KB + CA[1] * 2u;
        o10 = (r0 + HALF + RA[0]) * (unsigned)KB + CA[0] * 2u; o11 = (r0 + HALF + RA[1]) * (unsigned)KB + CA[1] * 2u;
    }
    __device__ __forceinline__ const char* b_base(const Unit& u) const { return Bt + (size_t)u.pn * BM * KB; }
};
template <int NPN, bool GATHER>
struct GroupOrder {
    int ntile, G, c, KB;
    const LAS int* pstart;
    const LAS unsigned char* texp;
    const int* rtok;
    const char* Bt; size_t bstride;
    __device__ __forceinline__ bool next(int i, Unit& u) const {
        const int x = c & 7, j = c >> 3, nj = G >> 3, T8 = (ntile + 7) >> 3, tlo = x * T8, thi = (tlo + T8) < ntile ? (tlo + T8) : ntile;
        const int Lx = i * nj + j, tl = Lx / NPN; if (tlo + tl >= thi) return false;
        u.pm = tlo + tl; u.pn = Lx % NPN;
        u.ex = texp[u.pm]; return true;
    }
    __device__ __forceinline__ void a_offs(const Unit& u, const int (&RA)[2], const int (&CA)[2], unsigned& o00, unsigned& o01, unsigned& o10, unsigned& o11) const {
        const int r0 = u.pm * BM;
        if (GATHER) {
            const int t00 = rtok[r0 + RA[0]], t01 = rtok[r0 + RA[1]], t10 = rtok[r0 + HALF + RA[0]], t11 = rtok[r0 + HALF + RA[1]];
            o00 = (unsigned)t00 * (unsigned)KB + CA[0] * 2u; o01 = (unsigned)t01 * (unsigned)KB + CA[1] * 2u;
            o10 = (unsigned)t10 * (unsigned)KB + CA[0] * 2u; o11 = (unsigned)t11 * (unsigned)KB + CA[1] * 2u;
        } else {
            o00 = (unsigned)(r0 + RA[0]) * (unsigned)KB + CA[0] * 2u; o01 = (unsigned)(r0 + RA[1]) * (unsigned)KB + CA[1] * 2u;
            o10 = (unsigned)(r0 + HALF + RA[0]) * (unsigned)KB + CA[0] * 2u; o11 = (unsigned)(r0 + HALF + RA[1]) * (unsigned)KB + CA[1] * 2u;
        }
    }
    __device__ __forceinline__ const char* b_base(const Unit& u) const { return Bt + (size_t)u.ex * bstride + (size_t)u.pn * BM * KB; }
};

struct EpiBf16Store {
    static constexpr bool PERM = true;
    static constexpr bool P64 = false;
    static constexpr bool P32 = true;
    bf16* O; int ldc; float sc;
    __device__ __forceinline__ void operator()(const f32x4 (&acc)[2][2][4][2], const Unit& u, int wr, int wc, int fr, int fq) const {
        const int row0 = u.pm * BM + wr * 64 + fr, col0 = u.pn * BM + wc * 64 + 8 * fq;
#pragma unroll
        for (int ai = 0; ai < 2; ++ai)
#pragma unroll
            for (int m = 0; m < 4; ++m) { bf16* rowp = O + (size_t)(row0 + ai * HALF + m * 16) * ldc + col0;
#pragma unroll
                for (int bj = 0; bj < 2; ++bj) { const f32x4 v0 = acc[ai][bj][m][0] * sc, v1 = acc[ai][bj][m][1] * sc;
                    v4u w; w.x = cvt_pk_bf16(v0[0], v0[1]); w.y = cvt_pk_bf16(v0[2], v0[3]); w.z = cvt_pk_bf16(v1[0], v1[1]); w.w = cvt_pk_bf16(v1[2], v1[3]);
                    *(v4u*)(rowp + bj * 32) = w; } }
    }
};
__device__ __forceinline__ unsigned pk_fp8x4(float a, float b, float c, float d) {
    a = fminf(fmaxf(a, -448.f), 448.f); b = fminf(fmaxf(b, -448.f), 448.f); c = fminf(fmaxf(c, -448.f), 448.f); d = fminf(fmaxf(d, -448.f), 448.f);
    int v = __builtin_amdgcn_cvt_pk_fp8_f32(a, b, 0, false); v = __builtin_amdgcn_cvt_pk_fp8_f32(c, d, v, true); return (unsigned)v; }
struct EpiF8Store {
    static constexpr bool PERM = true;
    static constexpr bool P32 = false;
    static constexpr bool P64 = true;
    unsigned char* O; int ldc; float sc; unsigned nbytes;
    __device__ __forceinline__ void operator()(const f32x4 (&acc)[2][2][4][2], const Unit& u, int wr, int wc, int fr, int fq) const {
        const int row0 = u.pm * BM + wr * 64 + fr, col0 = u.pn * BM + wc * 64 + 16 * fq;
        const __amdgpu_buffer_rsrc_t rs = __builtin_amdgcn_make_buffer_rsrc(O, 0, (int)nbytes, 0x00020000);
#pragma unroll
        for (int ai = 0; ai < 2; ++ai)
#pragma unroll
            for (int m = 0; m < 4; ++m) { const unsigned ro = (unsigned)(row0 + ai * HALF + m * 16) * (unsigned)ldc + (unsigned)col0;
                v4u w;
                { const f32x4 v0 = acc[ai][0][m][0] * sc, v1 = acc[ai][0][m][1] * sc; w.x = pk_fp8x4(v0[0], v0[1], v0[2], v0[3]); w.y = pk_fp8x4(v1[0], v1[1], v1[2], v1[3]); }
                { const f32x4 v0 = acc[ai][1][m][0] * sc, v1 = acc[ai][1][m][1] * sc; w.z = pk_fp8x4(v0[0], v0[1], v0[2], v0[3]); w.w = pk_fp8x4(v1[0], v1[1], v1[2], v1[3]); }
                __builtin_amdgcn_raw_buffer_store_b128(w, rs, (int)ro, 0, 0); }
    }
};
struct EpiGateUpF8 {
    static constexpr bool PERM = true;
    static constexpr bool P64 = false;
    static constexpr bool P32 = false;
    unsigned char* O; float isc, osc;
    __device__ __forceinline__ void operator()(const f32x4 (&acc)[2][2][4][2], const Unit& u, int wr, int wc, int fr, int fq) const {
        const int row0 = u.pm * BM + wr * 64 + fr, col0 = u.pn * HALF + wc * 32 + 8 * fq;
#pragma unroll
        for (int ai = 0; ai < 2; ++ai)
#pragma unroll
            for (int m = 0; m < 4; ++m) { unsigned char* rowp = O + (size_t)(row0 + ai * HALF + m * 16) * DE + col0;
                float h[8];
#pragma unroll
                for (int n = 0; n < 2; ++n)
#pragma unroll
                    for (int j = 0; j < 4; ++j) { const float a0 = acc[ai][0][m][n][j], a1 = acc[ai][1][m][n][j];
                        h[n * 4 + j] = (a0 * a1) * (isc * isc * osc) * __builtin_amdgcn_rcpf(1.0f + __builtin_amdgcn_exp2f(a0 * (-1.4426950408889634f * isc))); }
                v2u w; w.x = pk_fp8x4(h[0], h[1], h[2], h[3]); w.y = pk_fp8x4(h[4], h[5], h[6], h[7]);
                *(v2u*)rowp = w; }
    }
};
struct EpiLinearStore {
    static constexpr bool PERM = true;
    static constexpr bool P64 = false;
    static constexpr bool P32 = false;
    bf16* O;
    __device__ __forceinline__ void operator()(const f32x4 (&acc)[2][2][4][2], const Unit& u, int wr, int wc, int fr, int fq) const {
        bf16* base = O + ((size_t)(u.pm * 25 + u.pn) * 65536) + (size_t)((wr * 4 + wc) * 8192) + (size_t)(fq * 16 + fr) * 8;
#pragma unroll
        for (int ai = 0; ai < 2; ++ai)
#pragma unroll
            for (int m = 0; m < 4; ++m)
#pragma unroll
                for (int bj = 0; bj < 2; ++bj) { const f32x4 v0 = acc[ai][bj][m][0], v1 = acc[ai][bj][m][1];
                    v4u w; w.x = cvt_pk_bf16(v0[0], v0[1]); w.y = cvt_pk_bf16(v0[2], v0[3]); w.z = cvt_pk_bf16(v1[0], v1[1]); w.w = cvt_pk_bf16(v1[2], v1[3]);
                    *(v4u*)(base + ((ai * 4 + m) * 2 + bj) * 512) = w; }
    }
};
struct EpiNoStore {
    static constexpr bool PERM = true;
    static constexpr bool P64 = false;
    static constexpr bool P32 = false;
    float* O;
    __device__ __forceinline__ void operator()(const f32x4 (&acc)[2][2][4][2], const Unit& u, int wr, int wc, int fr, int fq) const {
        float s = 0.f;
#pragma unroll
        for (int ai = 0; ai < 2; ++ai)
#pragma unroll
            for (int bj = 0; bj < 2; ++bj)
#pragma unroll
                for (int m = 0; m < 4; ++m)
#pragma unroll
                    for (int n = 0; n < 2; ++n) s += (acc[ai][bj][m][n][0] + acc[ai][bj][m][n][1]) + (acc[ai][bj][m][n][2] + acc[ai][bj][m][n][3]);
        if (s == 12345.678f) O[u.pm] = s;
    }
};
struct EpiGateBf16 {
    static constexpr bool PERM = true;
    static constexpr bool P64 = false;
    static constexpr bool P32 = true;
    bf16* O; int ldc; const float* gate;
    __device__ __forceinline__ void operator()(const f32x4 (&acc)[2][2][4][2], const Unit& u, int wr, int wc, int fr, int fq) const {
        const int row0 = u.pm * BM + wr * 64 + fr, col0 = u.pn * BM + wc * 64 + 8 * fq;
        f32x4 gv[2][2];
#pragma unroll
        for (int bj = 0; bj < 2; ++bj)
#pragma unroll
            for (int n = 0; n < 2; ++n) gv[bj][n] = *(const f32x4*)(gate + col0 + bj * 32 + 4 * n);
#pragma unroll
        for (int ai = 0; ai < 2; ++ai)
#pragma unroll
            for (int m = 0; m < 4; ++m) { bf16* rowp = O + (size_t)(row0 + ai * HALF + m * 16) * ldc + col0;
#pragma unroll
                for (int bj = 0; bj < 2; ++bj) { const f32x4 v0 = acc[ai][bj][m][0] * gv[bj][0], v1 = acc[ai][bj][m][1] * gv[bj][1];
                    v4u w; w.x = cvt_pk_bf16(v0[0], v0[1]); w.y = cvt_pk_bf16(v0[2], v0[3]); w.z = cvt_pk_bf16(v1[0], v1[1]); w.w = cvt_pk_bf16(v1[2], v1[3]);
                    *(v4u*)(rowp + bj * 32) = w; } }
    }
};
struct EpiResidual {
    static constexpr bool PERM = false;
    static constexpr bool P64 = false;
    static constexpr bool P32 = false;
    float* X; const float* xin; const float* pos; int ldc; const float* gate;
    __device__ __forceinline__ void operator()(const f32x4 (&acc)[2][2][4][2], const Unit& u, int wr, int wc, int fr, int fq) const {
        const int row0 = u.pm * BM + wr * 64 + fr, col0 = u.pn * BM + wc * 32 + 4 * fq;
        const bool rowpart = col0 < 1024;
        const int pc0 = rowpart ? col0 : col0 - 1024;
        f32x4 gv[2][2];
#pragma unroll
        for (int bj = 0; bj < 2; ++bj)
#pragma unroll
            for (int n = 0; n < 2; ++n) gv[bj][n] = *(const f32x4*)(gate + col0 + bj * HALF + n * 16);
#pragma unroll
        for (int ai = 0; ai < 2; ++ai)
#pragma unroll
            for (int m = 0; m < 4; ++m) { const int row = row0 + ai * HALF + m * 16;
                float* rowp = X + (size_t)row * ldc + col0; const float* xr = xin + (size_t)row * ldc + col0;
                const float* pr = pos + (size_t)(rowpart ? (row >> 6) : 256 + (row & 63)) * 1024 + pc0;
#pragma unroll
                for (int bj = 0; bj < 2; ++bj)
#pragma unroll
                    for (int n = 0; n < 2; ++n) { const int o = bj * HALF + n * 16;
                        *(f32x4*)(rowp + o) = (*(const f32x4*)(xr + o) + *(const f32x4*)(pr + o)) + gv[bj][n] * acc[ai][bj][m][n]; } }
    }
};
struct EpiGateUp {
    static constexpr bool PERM = true;
    static constexpr bool P64 = false;
    static constexpr bool P32 = false;
    bf16* O;
    __device__ __forceinline__ void operator()(const f32x4 (&acc)[2][2][4][2], const Unit& u, int wr, int wc, int fr, int fq) const {
        const int row0 = u.pm * BM + wr * 64 + fr, col0 = u.pn * HALF + wc * 32 + 8 * fq;
#pragma unroll
        for (int ai = 0; ai < 2; ++ai)
#pragma unroll
            for (int m = 0; m < 4; ++m) { bf16* rowp = O + (size_t)(row0 + ai * HALF + m * 16) * DE + col0;
                float h[8];
#pragma unroll
                for (int n = 0; n < 2; ++n)
#pragma unroll
                    for (int j = 0; j < 4; ++j) { const float g = acc[ai][0][m][n][j], up = acc[ai][1][m][n][j]; h[n * 4 + j] = silu_f(g) * up; }
                v4u w; w.x = cvt_pk_bf16(h[0], h[1]); w.y = cvt_pk_bf16(h[2], h[3]); w.z = cvt_pk_bf16(h[4], h[5]); w.w = cvt_pk_bf16(h[6], h[7]);
                *(v4u*)rowp = w; }
    }
};
struct EpiDown {
    static constexpr bool PERM = true;
    static constexpr bool P64 = false;
    static constexpr bool P32 = false;
    bf16* O; const float* rw;
    __device__ __forceinline__ void operator()(const f32x4 (&acc)[2][2][4][2], const Unit& u, int wr, int wc, int fr, int fq) const {
        const int row0 = u.pm * BM + wr * 64 + fr, col0 = u.pn * BM + wc * 32 + 8 * fq;
#pragma unroll
        for (int ai = 0; ai < 2; ++ai)
#pragma unroll
            for (int m = 0; m < 4; ++m) { const int row = row0 + ai * HALF + m * 16; const float s = rw[row]; bf16* rowp = O + (size_t)row * D + col0;
#pragma unroll
                for (int bj = 0; bj < 2; ++bj) { const f32x4 v0 = acc[ai][bj][m][0] * s, v1 = acc[ai][bj][m][1] * s;
                    v4u w; w.x = cvt_pk_bf16(v0[0], v0[1]); w.y = cvt_pk_bf16(v0[2], v0[3]); w.z = cvt_pk_bf16(v1[0], v1[1]); w.w = cvt_pk_bf16(v1[2], v1[3]);
                    *(v4u*)(rowp + bj * HALF) = w; } }
    }
};
}

using gk::pk_fp8x4;
struct Args { const float* in[36]; float* out; unsigned char* ws; int ph_lo, ph_hi; };
struct Frame {
    LAS unsigned char* lds;
    int tid, lane, wave, bid, G;
    const float* const* in; float* out; unsigned char* ws;
};
#define IN_X 0
#define IN_C 1
#define IN_CTX 2
#define IN_CCTX 3
#define IN_WADA 4
#define IN_BADA 5
#define IN_GMIX 6
#define IN_GFFN 7
#define IN_WIN 8
#define IN_BGATES 9
#define IN_CKW 10
#define IN_CKB 11
#define IN_CQW 12
#define IN_CQB 13
#define IN_GHEAD 14
#define IN_CHW 15
#define IN_CHB 16
#define IN_FW1 17
#define IN_FB1 18
#define IN_FF1 19
#define IN_FW2 20
#define IN_FB2 21
#define IN_FF2 22
#define IN_FW3 23
#define IN_FB3 24
#define IN_DSKIP 25
#define IN_WOUT 26
#define IN_WR 27
#define IN_BR 28
#define IN_W1E 29
#define IN_W3E 30
#define IN_W2E 31
#define IN_W1S 32
#define IN_W3S 33
#define IN_W2S 34
#define IN_GFIN 35

__device__ __forceinline__ void transpose_item(const float* W, int N, int k0, int n0, bf16* WT, int dstK, int dst_row0, LAS float* scr, int lane) {
#pragma unroll 8
    for (int i = 0; i < 32; ++i) { const int kk = 2 * i + (lane >> 5); scr[kk * 33 + (lane & 31)] = W[(size_t)(k0 + kk) * N + n0 + (lane & 31)]; }
    LDS_WAIT(); asm volatile("" ::: "memory");
    const int c = lane & 7;
#pragma unroll
    for (int j = 0; j < 4; ++j) { const int n = (lane >> 3) + 8 * j; const LAS float* s = scr + (8 * c) * 33 + n;
        v4u o; o.x = cvt_pk_bf16(s[0 * 33], s[1 * 33]); o.y = cvt_pk_bf16(s[2 * 33], s[3 * 33]); o.z = cvt_pk_bf16(s[4 * 33], s[5 * 33]); o.w = cvt_pk_bf16(s[6 * 33], s[7 * 33]);
        *(v4u*)(WT + (size_t)(dst_row0 + n) * dstK + k0 + 8 * c) = o; }
    LDS_WAIT(); asm volatile("" ::: "memory");
}
__device__ __forceinline__ void f8_item_load(const float* W, int N, int k0, int n0, int lane, f32x4 (&v)[8]) {
#pragma unroll
    for (int i = 0; i < 8; ++i) v[i] = *(const f32x4*)(W + (size_t)(k0 + 8 * i + (lane >> 3)) * N + n0 + 4 * (lane & 7));
}
__device__ __forceinline__ void f8_item_finish(const f32x4 (&v)[8], int k0, unsigned char* WT, int dstKB, int dst_row0, float pre, LAS float* scr, int lane) {
#pragma unroll
    for (int i = 0; i < 8; ++i) *(LAS f32x4*)(scr + (8 * i + (lane >> 3)) * 36 + 4 * (lane & 7)) = v[i] * pre;
    LDS_WAIT(); asm volatile("" ::: "memory");
    const int n = lane >> 1, hf = lane & 1; const LAS float* s = scr + (32 * hf) * 36 + n;
    unsigned w[8];
#pragma unroll
    for (int q = 0; q < 8; ++q) w[q] = pk_fp8x4(s[(4 * q) * 36], s[(4 * q + 1) * 36], s[(4 * q + 2) * 36], s[(4 * q + 3) * 36]);
    unsigned char* dst = WT + (size_t)(dst_row0 + n) * dstKB + k0 + 32 * hf;
    *(v4u*)dst = (v4u){w[0], w[1], w[2], w[3]}; *(v4u*)(dst + 16) = (v4u){w[4], w[5], w[6], w[7]};
    LDS_WAIT(); asm volatile("" ::: "memory");
}
__device__ __forceinline__ void f8n_item_load(const float* W, int N, int k0, int n0, int lane, f32x4 (&v)[8]) {
#pragma unroll
    for (int i = 0; i < 8; ++i) v[i] = *(const f32x4*)(W + (size_t)(k0 + 8 * (lane >> 3) + i) * N + n0 + 4 * (lane & 7));
}
__device__ __forceinline__ void f8n_item_finish(const f32x4 (&v)[8], int k0, unsigned char* WT, int dstKB, int dst_row0, float pre, int lane) {
    unsigned char* dst = WT + (size_t)(dst_row0 + 4 * (lane & 7)) * dstKB + k0 + 8 * (lane >> 3);
#pragma unroll
    for (int c = 0; c < 4; ++c) { v2u w; w.x = pk_fp8x4(v[0][c] * pre, v[1][c] * pre, v[2][c] * pre, v[3][c] * pre); w.y = pk_fp8x4(v[4][c] * pre, v[5][c] * pre, v[6][c] * pre, v[7][c] * pre);
        *(v2u*)(dst + (size_t)c * dstKB) = w; }
}
__device__ __forceinline__ void p0_prologue(Frame& F) {
    const float* const* in = F.in;
    {
        LAS float* sv = (LAS float*)F.lds;
        LAS float* red = sv + 4096;
        float* mod = (float*)(F.ws + WS_MOD);
        for (int job = F.bid; job < 192; job += F.G) {
            for (int i = F.tid; i < 2048; i += NT) { sv[i] = silu_f(in[IN_C][i]); sv[2048 + i] = silu_f(in[IN_CCTX][i]); }
            __syncthreads();
            const int col = job * 64 + F.lane, r0 = F.wave * 256;
            const float* W = in[IN_WADA] + col;
            float a0 = 0.f, a1 = 0.f;
            for (int i = r0; i < r0 + 256; i += 8) {
                float w[8];
#pragma unroll
                for (int j = 0; j < 8; ++j) w[j] = W[(size_t)(i + j) * 12288];
#pragma unroll
                for (int j = 0; j < 8; ++j) { a0 += sv[i + j] * w[j]; a1 += sv[2048 + i + j] * w[j]; }
            }
            red[(F.wave * 64 + F.lane) * 2 + 0] = a0; red[(F.wave * 64 + F.lane) * 2 + 1] = a1;
            __syncthreads();
            if (F.wave == 0) { float s0 = 0.f, s1 = 0.f;
#pragma unroll
                for (int w = 0; w < 8; ++w) { s0 += red[(w * 64 + F.lane) * 2 + 0]; s1 += red[(w * 64 + F.lane) * 2 + 1]; }
                const float b = in[IN_BADA][col]; mod[col] = s0 + b; mod[12288 + col] = s1 + b; }
            __syncthreads();
        }
    }
    const int nsm = F.G > 192 ? F.G - 192 : F.G, bsm = F.G > 192 ? F.bid - 192 : F.bid;
    const int gt = (bsm < 0 ? 0 : bsm) * NT + F.tid, NGT = bsm < 0 ? 0x40000000 : nsm * NT;
    const int gts = bsm < 0 ? 0x40000000 : gt;
    {
        float* pos = (float*)(F.ws + WS_POS);
        for (int i = gts; i < 320 * 1024; i += NGT) { const int p = i >> 10, j = i & 1023, jj = j & 511;
            const float pp = (float)(p < 256 ? p : p - 256);
            const float omega = 1.0f / powf(10000.0f, (float)jj * (1.0f / 512.0f)); const float ang = pp * omega;
            pos[i] = j < 512 ? sinf(ang) : cosf(ang); }
    }
    {
        v4u* z = (v4u*)(F.ws + WS_WIN + (size_t)NIN * D * 2); const int nz = (NINP - NIN) * D * 2 / 16;
        for (int i = gts; i < nz; i += NGT) z[i] = (v4u){0u, 0u, 0u, 0u};
        int* rt = (int*)(F.ws + WS_RTOK); float* rw = (float*)(F.ws + WS_RW);
        for (int i = gts; i < MAXROWS; i += NGT) { rt[i] = 0; rw[i] = 0.f; }
    }
    {
        bf16* w1 = (bf16*)(F.ws + WS_WR1); bf16* w2 = (bf16*)(F.ws + WS_WR2);
        for (int i = gts; i < 64 * 2048; i += NGT) { const int e = i >> 11, k = i & 2047; const float w = in[IN_WR][k * 64 + e];
            const unsigned hi = cvt_pk_bf16(w, 0.f) & 0xffffu; const float r = w - bf2f((bf16)hi);
            w1[i] = (bf16)hi; w2[i] = (bf16)(cvt_pk_bf16(r, 0.f) & 0xffffu); }
    }
    {
        LAS float* scr = (LAS float*)(F.lds + F.wave * 16384);
        const int gw = F.bid * NWAVES + F.wave, NGW = F.G * NWAVES;
        constexpr int I_IN = 32 * 193, I_OUT = 32 * 64;
        for (int it = gw; it < I_IN + I_OUT; it += NGW) {
            int r = it;
            if (r < I_IN) { const int kb = r / 193, nb = r % 193; transpose_item(in[IN_WIN], NIN, 64 * kb, 32 * nb, (bf16*)(F.ws + WS_WIN), D, 32 * nb, scr, F.lane); continue; } r -= I_IN;
            { const int kb = r / 64, nb = r % 64; transpose_item(in[IN_WOUT], D, 64 * kb, 32 * nb, (bf16*)(F.ws + WS_WOUT), D, 32 * nb, scr, F.lane); }
        }
    }
}
constexpr int N_EXP_ITEMS = 3 * 512 * NE1;
struct ExpItem { const float* src; int N, k0, n0; unsigned char* dst; int dstKB, row0; float pre; };
__device__ __forceinline__ ExpItem decode_expert_item(Frame& F, int r) {
    const float* const* in = F.in;
    constexpr int I_E = 512 * NE1;
    ExpItem it;
    if (r < 2 * I_E) { const int which = r >= I_E; if (which) r -= I_E;
        const int e = r / 512, rr = r % 512, kb = 2 * (rr / 32) + (rr & 1), nb = (rr >> 1) & 15, n0 = 32 * nb;
        it.src = e < NE ? in[which ? IN_W3E : IN_W1E] + (size_t)e * D * DE : in[which ? IN_W3S : IN_W1S];
        it.N = DE; it.k0 = 64 * kb; it.n0 = n0; it.dst = (unsigned char*)(F.ws + WS_W13) + (size_t)e * 1024 * D; it.dstKB = D; it.row0 = (n0 >> 7) * 256 + which * 128 + (n0 & 127); it.pre = W13_PRE; return it; }
    r -= 2 * I_E;
    { const int e = r / 512, rr = r % 512, kb = 2 * (rr / 128) + (rr & 1), nb = (rr >> 1) & 63;
        it.src = e < NE ? in[IN_W2E] + (size_t)e * DE * D : in[IN_W2S];
        it.N = D; it.k0 = 64 * kb; it.n0 = 32 * nb; it.dst = (unsigned char*)(F.ws + WS_W2) + (size_t)e * D * DE; it.dstKB = DE; it.row0 = 32 * nb; it.pre = W2_PRE; return it; }
}
__device__ __forceinline__ void conv_worker(Frame& F) {
    LAS float* scr = (LAS float*)(F.lds + F.wave * 16384);
    unsigned* q = (unsigned*)(F.ws + WS_CTL) + CW_QCONV;
    for (;;) {
        unsigned base = 0;
        if (F.lane == 0) base = __hip_atomic_fetch_add(q, 8u, __ATOMIC_RELAXED, __HIP_MEMORY_SCOPE_AGENT);
        base = (unsigned)__builtin_amdgcn_readfirstlane((int)base);
        if (base >= (unsigned)N_EXP_ITEMS) break;
#pragma unroll 1
        for (int i = 0; i < 8; i += 2) {
            const ExpItem ia = decode_expert_item(F, (int)base + i), ib = decode_expert_item(F, (int)base + i + 1);
            f32x4 va[8], vb[8];
            f8n_item_load(ia.src, ia.N, ia.k0, ia.n0, F.lane, va); f8n_item_load(ib.src, ib.N, ib.k0, ib.n0, F.lane, vb);
            f8n_item_finish(va, ia.k0, ia.dst, ia.dstKB, ia.row0, ia.pre, F.lane);
            f8n_item_finish(vb, ib.k0, ib.dst, ib.dstKB, ib.row0, ib.pre, F.lane);
        }
    }
}

__device__ __forceinline__ void p1_norm1(Frame& F) {
    const float* const* in = F.in;
    const int gw = F.bid * NWAVES + F.wave, NGW = F.G * NWAVES;
    const float* mod = (const float*)(F.ws + WS_MOD); const float* pos = (const float*)(F.ws + WS_POS);
    bf16* hA = (bf16*)(F.ws + WS_HA);
    for (int row = gw; row < MROWS; row += NGW) {
        f32x4 v[8]; float ss = 0.f;
        const bool mainrow = row < L;
        const float* src = mainrow ? in[IN_X] + (size_t)row * D : in[IN_CTX] + (size_t)(row - L) * D;
        const float* md = mainrow ? mod : mod + 12288;
#pragma unroll
        for (int j = 0; j < 8; ++j) { const int col = 4 * F.lane + 256 * j; v[j] = *(const f32x4*)(src + col);
            if (mainrow) { const float* pp = col < 1024 ? pos + (size_t)(row >> 6) * 1024 + col : pos + (size_t)(256 + (row & 63)) * 1024 + (col - 1024);
                v[j] = v[j] + *(const f32x4*)pp; }
            ss += (v[j].x * v[j].x + v[j].y * v[j].y) + (v[j].z * v[j].z + v[j].w * v[j].w); }
        const float rstd = rsqrtf(wave_sum(ss) * (1.0f / D) + EPS);
#pragma unroll
        for (int j = 0; j < 8; ++j) { const int col = 4 * F.lane + 256 * j;
            const f32x4 g = *(const f32x4*)(in[IN_GMIX] + col), sh = *(const f32x4*)(md + col), sc = *(const f32x4*)(md + 2048 + col);
            const f32x4 h = (v[j] * rstd * g) * (sc + 1.0f) + sh;
            v2u o; o.x = cvt_pk_bf16(h.x, h.y); o.y = cvt_pk_bf16(h.z, h.w);
            *(v2u*)(hA + (size_t)row * D + col) = o; }
    }
}

constexpr int VT_PITCH = 136;
__device__ __forceinline__ float wave_incl_add(float x, int lane) {
#pragma unroll
    for (int o = 1; o < 64; o <<= 1) { const float y = __shfl_up(x, o); if (lane >= o) x += y; }
    return x;
}
__device__ __forceinline__ float wave_incl_max(float x, int lane) {
#pragma unroll
    for (int o = 1; o < 64; o <<= 1) { const float y = __shfl_up(x, o); if (lane >= o) x = fmaxf(x, y); }
    return x;
}
__device__ __forceinline__ void ml_gates(Frame& F, int dir, int h, int rowbase, LAS float* bb, LAS float* al, LAS float* mx, float& g, float& mtot) {
    const bf16* z = (const bf16*)(F.ws + WS_Z);
    const int lane = F.lane, pi0 = 2 * lane, p0 = dir ? 127 - pi0 : pi0, p1 = dir ? p0 - 1 : p0 + 1;
    const float bgi = F.in[IN_BGATES][dir * 16 + h], bgf = F.in[IN_BGATES][dir * 16 + 8 + h];
    const bf16* z0 = z + (size_t)(rowbase + p0) * NINP + OFF_G + dir * 16 + h; const bf16* z1 = z + (size_t)(rowbase + p1) * NINP + OFF_G + dir * 16 + h;
    const float i0 = bf2f(z0[0]) + bgi, f0 = bf2f(z0[8]) + bgf, i1 = bf2f(z1[0]) + bgi, f1 = bf2f(z1[8]) + bgf;
    const float l0 = fminf(f0, 0.f) - log1pf(__expf(-fabsf(f0))), l1 = fminf(f1, 0.f) - log1pf(__expf(-fabsf(f1)));
    const float incl = wave_incl_add(l0 + l1, lane);
    const float b1 = incl, b0 = incl - l1;
    const float a0 = i0 - b0, a1 = i1 - b1;
    const float mi = wave_incl_max(fmaxf(a0, a1), lane);
    float mprev = __shfl_up(mi, 1); if (lane == 0) mprev = -INFINITY;
    const float M0 = fmaxf(mprev, a0), M1 = mi;
    bb[p0] = b0; bb[p1] = b1; al[p0] = a0; al[p1] = a1; mx[p0] = M0; mx[p1] = M1;
    g = __shfl(incl, 63); mtot = __shfl(mi, 63);
}
__device__ __forceinline__ void ml_stage_vT(Frame& F, int h, int rowbase, LAS bf16* vT) {
    const bf16* z = (const bf16*)(F.ws + WS_Z);
    const int s = F.tid >> 2, eg = F.tid & 3;
#pragma unroll
    for (int i = 0; i < 4; ++i) { const int e0 = 32 * eg + 8 * i; const v4u v = *(const v4u*)(z + (size_t)(rowbase + s) * NINP + OFF_V + h * 128 + e0);
        const unsigned w[4] = {v.x, v.y, v.z, v.w};
#pragma unroll
        for (int q = 0; q < 4; ++q) { vT[(e0 + 2 * q) * VT_PITCH + s] = (bf16)(w[q] & 0xffffu); vT[(e0 + 2 * q + 1) * VT_PITCH + s] = (bf16)(w[q] >> 16); } }
}
__device__ __forceinline__ void ml_prep_item(Frame& F, int item) {
    const float* const* in = F.in;
    const int n = item >> 3, h = item & 7, tid = F.tid, lane = F.lane, wave = F.wave;
    const bool isctx = n >= 128;
    const int rowbase = isctx ? L + 128 * (n - 128) : 128 * n, seqlo = isctx ? L : 0, seqhi = isctx ? L + LC - 1 : L - 1;
    LAS bf16* vT = (LAS bf16*)F.lds;
    LAS bf16* kw0 = vT + 128 * VT_PITCH;
    LAS bf16* kw1 = kw0 + 64 * VT_PITCH;
    LAS float* fs = (LAS float*)(kw1 + 64 * VT_PITCH);
    const bf16* z = (const bf16*)(F.ws + WS_Z);
    if (wave < 2) { float g, mtot; LAS float* bbp = fs + 256 + wave * 384; ml_gates(F, wave, h, rowbase, bbp, bbp + 128, bbp + 256, g, mtot);
        LDS_WAIT();
        fs[wave * 128 + 2 * lane] = __expf(bbp[128 + 2 * lane] - mtot); fs[wave * 128 + 2 * lane + 1] = __expf(bbp[128 + 2 * lane + 1] - mtot);
        if (lane == 0) { float* sc = (float*)(F.ws + WS_SC) + ((size_t)(wave * 8 + h) * 130 + n) * 2; sc[0] = g; sc[1] = g + mtot; } }
    ml_stage_vT(F, h, rowbase, vT);
    __syncthreads();
    {
        const int s = tid >> 2, d0 = (tid & 3) * 16, R = rowbase + s; const bool hp = R > seqlo, hn = R < seqhi;
        float kv[16], qv[16];
#pragma unroll
        for (int part = 0; part < 2; ++part) {
            const int zc = (part ? OFF_Q : OFF_K) + h * 64 + d0; const float* cw = in[part ? IN_CQW : IN_CKW] + h * 64 + d0; const float* cb = in[part ? IN_CQB : IN_CKB] + h * 64 + d0;
#pragma unroll
            for (int hv = 0; hv < 2; ++hv) {
                const v4u c = *(const v4u*)(z + (size_t)R * NINP + zc + 8 * hv);
                const v4u p = hp ? *(const v4u*)(z + (size_t)(R - 1) * NINP + zc + 8 * hv) : (v4u){0u, 0u, 0u, 0u};
                const v4u nx = hn ? *(const v4u*)(z + (size_t)(R + 1) * NINP + zc + 8 * hv) : (v4u){0u, 0u, 0u, 0u};
                const unsigned cc[4] = {c.x, c.y, c.z, c.w}, pp[4] = {p.x, p.y, p.z, p.w}, nn[4] = {nx.x, nx.y, nx.z, nx.w};
#pragma unroll
                for (int q = 0; q < 4; ++q) { const int d = 8 * hv + 2 * q;
                    const float v0 = silu_f(bflo(pp[q]) * cw[d] + bflo(cc[q]) * cw[512 + d] + bflo(nn[q]) * cw[1024 + d] + cb[d]);
                    const float v1 = silu_f(bfhi(pp[q]) * cw[d + 1] + bfhi(cc[q]) * cw[512 + d + 1] + bfhi(nn[q]) * cw[1024 + d + 1] + cb[d + 1]);
                    if (part) { qv[d] = v0 * 0.125f; qv[d + 1] = v1 * 0.125f; } else { kv[d] = v0; kv[d + 1] = v1; } }
            }
        }
        if (!isctx) {
            bf16* Qg = (bf16*)(F.ws + WS_Q) + ((size_t)h * L + R) * 64 + d0; bf16* Kg = (bf16*)(F.ws + WS_K) + ((size_t)h * L + R) * 64 + d0;
#pragma unroll
            for (int hv = 0; hv < 2; ++hv) { v4u w;
                w.x = cvt_pk_bf16(qv[8 * hv], qv[8 * hv + 1]); w.y = cvt_pk_bf16(qv[8 * hv + 2], qv[8 * hv + 3]); w.z = cvt_pk_bf16(qv[8 * hv + 4], qv[8 * hv + 5]); w.w = cvt_pk_bf16(qv[8 * hv + 6], qv[8 * hv + 7]); *(v4u*)(Qg + 8 * hv) = w;
                w.x = cvt_pk_bf16(kv[8 * hv], kv[8 * hv + 1]); w.y = cvt_pk_bf16(kv[8 * hv + 2], kv[8 * hv + 3]); w.z = cvt_pk_bf16(kv[8 * hv + 4], kv[8 * hv + 5]); w.w = cvt_pk_bf16(kv[8 * hv + 6], kv[8 * hv + 7]); *(v4u*)(Kg + 8 * hv) = w; }
        }
        const float w0 = fs[s], w1 = fs[128 + s];
#pragma unroll
        for (int d = 0; d < 16; ++d) { const float kr = bf2f((bf16)(cvt_pk_bf16(kv[d], 0.f) & 0xffffu));
            kw0[(d0 + d) * VT_PITCH + s] = (bf16)(cvt_pk_bf16(kr * w0, 0.f) & 0xffffu); kw1[(d0 + d) * VT_PITCH + s] = (bf16)(cvt_pk_bf16(kr * w1, 0.f) & 0xffffu); }
    }
    __syncthreads();
    {
        const int fr = lane & 15, fq = lane >> 4;
        bf16x8 a[4];
#pragma unroll
        for (int kk = 0; kk < 4; ++kk) a[kk] = *(const LAS bf16x8*)(vT + (16 * wave + fr) * VT_PITCH + 32 * kk + 8 * fq);
#pragma unroll
        for (int dir = 0; dir < 2; ++dir) { const LAS bf16* kw = dir ? kw1 : kw0;
            float* cl = (float*)(F.ws + WS_CL) + ((size_t)((dir * 8 + h) * 130 + n)) * 8192;
#pragma unroll
            for (int dt = 0; dt < 4; ++dt) { f32x4 acc = (f32x4){0.f, 0.f, 0.f, 0.f};
#pragma unroll
                for (int kk = 0; kk < 4; ++kk) { const bf16x8 b = *(const LAS bf16x8*)(kw + (16 * dt + fr) * VT_PITCH + 32 * kk + 8 * fq); acc = __builtin_amdgcn_mfma_f32_16x16x32_bf16(a[kk], b, acc, 0, 0, 0); }
#pragma unroll
                for (int r = 0; r < 4; ++r) cl[(16 * wave + 4 * fq + r) * 64 + 16 * dt + fr] = acc[r]; } }
        if (tid < 128) { const int dir = tid >> 6, d = tid & 63; const LAS bf16* kw = (dir ? kw1 : kw0) + d * VT_PITCH; float s = 0.f;
            for (int i = 0; i < 128; ++i) s += bf2f(kw[i]);
            ((float*)(F.ws + WS_NL))[((size_t)((dir * 8 + h) * 130 + n)) * 64 + d] = s; }
    }
    __syncthreads();
}
__device__ __forceinline__ int ml_order(int dir, int step) { return step < 2 ? (dir ? 129 - step : 128 + step) : (dir ? 129 - step : step - 2); }
__device__ __forceinline__ void ml_scan(Frame& F) {
    const float* CL = (const float*)(F.ws + WS_CL); const float* SC = (const float*)(F.ws + WS_SC); const float* NLp = (const float*)(F.ws + WS_NL);
    bf16* CI = (bf16*)(F.ws + WS_CI); float* NI = (float*)(F.ws + WS_NI); float* MI = (float*)(F.ws + WS_MI);
    LAS float* ssc = (LAS float*)F.lds;
    for (int idx0 = F.bid * NT; idx0 < 16 * 8192; idx0 += F.G * NT) {
        const int idx = idx0 + F.tid, dh = idx >> 13, rem = idx & 8191, dir = dh >> 3; const bool don = rem < 64;
        __syncthreads();
        if (F.tid < 130) { const int ch = ml_order(dir, F.tid); ssc[2 * F.tid] = SC[(dh * 130 + ch) * 2]; ssc[2 * F.tid + 1] = SC[(dh * 130 + ch) * 2 + 1]; }
        __syncthreads();
        float c = 0.f, nn = 0.f, m = 0.f;
#pragma unroll 1
        for (int s0 = 0; s0 < 130; s0 += 26) {
            float cl[26];
#pragma unroll
            for (int i = 0; i < 26; ++i) cl[i] = CL[((size_t)(dh * 130 + ml_order(dir, s0 + i))) * 8192 + rem];
#pragma unroll
            for (int i = 0; i < 26; ++i) { const int ch = ml_order(dir, s0 + i); const float gg = ssc[2 * (s0 + i)], ml = ssc[2 * (s0 + i) + 1];
                const float nl = don ? NLp[(size_t)(dh * 130 + ch) * 64 + rem] : 0.f;
                if (ch < 128) { CI[((size_t)(dh * 128 + ch)) * 8192 + rem] = (bf16)(cvt_pk_bf16(c, 0.f) & 0xffffu); if (don) NI[(size_t)(dh * 128 + ch) * 64 + rem] = nn; if (rem == 0) MI[dh * 128 + ch] = m; }
                const float mn = fmaxf(gg + m, ml), sp = __expf(gg + m - mn), sl = __expf(ml - mn);
                c = sp * c + sl * cl[i]; nn = sp * nn + sl * nl; m = mn; }
        }
    }
    __syncthreads();
}
__device__ __forceinline__ void ml_out_item(Frame& F, int item) {
    const float* const* in = F.in;
    const int n = item >> 3, h = item & 7, tid = F.tid, lane = F.lane, wave = F.wave, fr = lane & 15, fq = lane >> 4;
    const int rowbase = 128 * n;
    LAS bf16* vT = (LAS bf16*)F.lds;
    LAS float* fs = (LAS float*)(vT + 128 * VT_PITCH);
    const bf16* z = (const bf16*)(F.ws + WS_Z);
    const bf16* Qg = (const bf16*)(F.ws + WS_Q) + ((size_t)h * L + rowbase) * 64; const bf16* Kg = (const bf16*)(F.ws + WS_K) + ((size_t)h * L + rowbase) * 64;
    const int tl = 16 * wave + fr;
    bf16x8 qf[2], kf[8][2];
#pragma unroll
    for (int kk = 0; kk < 2; ++kk) qf[kk] = *(const bf16x8*)(Qg + (size_t)tl * 64 + 32 * kk + 8 * fq);
#pragma unroll
    for (int j = 0; j < 8; ++j)
#pragma unroll
        for (int kk = 0; kk < 2; ++kk) kf[j][kk] = *(const bf16x8*)(Kg + (size_t)(16 * j + fr) * 64 + 32 * kk + 8 * fq);
    if (wave < 2) { float g, mtot; LAS float* bbp = fs + wave * 384; ml_gates(F, wave, h, rowbase, bbp, bbp + 128, bbp + 256, g, mtot);
        if (lane == 0) fs[768 + wave] = ((const float*)(F.ws + WS_MI))[(wave * 8 + h) * 128 + n]; }
    ml_stage_vT(F, h, rowbase, vT);
    __syncthreads();
    f32x4 st[8];
#pragma unroll
    for (int j = 0; j < 8; ++j) { f32x4 acc = (f32x4){0.f, 0.f, 0.f, 0.f};
#pragma unroll
        for (int kk = 0; kk < 2; ++kk) acc = __builtin_amdgcn_mfma_f32_16x16x32_bf16(kf[j][kk], qf[kk], acc, 0, 0, 0);
        st[j] = acc; }
    f32x4 hs[8];
#pragma unroll
    for (int et = 0; et < 8; ++et) hs[et] = (f32x4){0.f, 0.f, 0.f, 0.f};
#pragma unroll 1
    for (int dir = 0; dir < 2; ++dir) {
        const LAS float* bbp = fs + dir * 384; const LAS float* alp = bbp + 128; const LAS float* mxp = bbp + 256;
        const float m_in = fs[768 + dir];
        const float beta = fmaxf(m_in, mxp[tl]);
        const int dh = dir * 8 + h;
        const bf16* cip = (const bf16*)(F.ws + WS_CI) + (size_t)(dh * 128 + n) * 8192;
        bf16x8 cbf[8][2];
#pragma unroll
        for (int et = 0; et < 8; ++et)
#pragma unroll
            for (int kk = 0; kk < 2; ++kk) cbf[et][kk] = *(const bf16x8*)(cip + (size_t)(16 * et + fr) * 64 + 32 * kk + 8 * fq);
        bf16x8 pf[4]; float dsum = 0.f;
#pragma unroll
        for (int kk = 0; kk < 4; ++kk) { float pv[8];
#pragma unroll
            for (int hh = 0; hh < 2; ++hh)
#pragma unroll
                for (int r = 0; r < 4; ++r) { const int s = 32 * kk + 16 * hh + 4 * fq + r; const bool ok = dir ? (s >= tl) : (s <= tl);
                    const float e = __expf(fminf(alp[s] - beta, 0.f)); const float v = ok ? st[2 * kk + hh][r] * e : 0.f; pv[4 * hh + r] = v; dsum += v; }
            pf[kk] = __builtin_bit_cast(bf16x8, (v4u){cvt_pk_bf16(pv[0], pv[1]), cvt_pk_bf16(pv[2], pv[3]), cvt_pk_bf16(pv[4], pv[5]), cvt_pk_bf16(pv[6], pv[7])}); }
        dsum += __shfl_xor(dsum, 16); dsum += __shfl_xor(dsum, 32);
        const float* nip = (const float*)(F.ws + WS_NI) + (size_t)(dh * 128 + n) * 64; float qn = 0.f;
#pragma unroll
        for (int kk = 0; kk < 2; ++kk) { const v4u qq = __builtin_bit_cast(v4u, qf[kk]); const unsigned w[4] = {qq.x, qq.y, qq.z, qq.w};
#pragma unroll
            for (int q = 0; q < 4; ++q) { const int d = 32 * kk + 8 * fq + 2 * q; qn += bflo(w[q]) * nip[d] + bfhi(w[q]) * nip[d + 1]; } }
        qn += __shfl_xor(qn, 16); qn += __shfl_xor(qn, 32);
        const float sc_t = __expf(m_in - beta);
        const float den = dsum + sc_t * qn, dn = fmaxf(fabsf(den), __expf(-(bbp[tl] + beta)));
        LAS float* xinv = fs + 772 + (wave * 2 + dir) * 32;
        if (fq == 0) { xinv[fr] = 1.0f / dn; xinv[16 + fr] = sc_t; }
        LDS_WAIT();
        float inv_r[4], sc_r[4];
#pragma unroll
        for (int r = 0; r < 4; ++r) { inv_r[r] = xinv[4 * fq + r]; sc_r[r] = xinv[16 + 4 * fq + r]; }
#pragma unroll
        for (int et = 0; et < 8; ++et) {
            f32x4 acc = (f32x4){0.f, 0.f, 0.f, 0.f}, acci = (f32x4){0.f, 0.f, 0.f, 0.f};
#pragma unroll
            for (int kk = 0; kk < 4; ++kk) {
                const bool live = dir ? (2 * kk + 1 >= wave) : (2 * kk <= wave);
                if (live) { const LAS bf16* vr = vT + (16 * et + fr) * VT_PITCH + 32 * kk + 4 * fq;
                    const v2u lo = *(const LAS v2u*)vr, hi = *(const LAS v2u*)(vr + 16);
                    const bf16x8 vb = __builtin_bit_cast(bf16x8, (v4u){lo.x, lo.y, hi.x, hi.y});
                    acc = __builtin_amdgcn_mfma_f32_16x16x32_bf16(pf[kk], vb, acc, 0, 0, 0); } }
#pragma unroll
            for (int kk = 0; kk < 2; ++kk) acci = __builtin_amdgcn_mfma_f32_16x16x32_bf16(qf[kk], cbf[et][kk], acci, 0, 0, 0);
#pragma unroll
            for (int r = 0; r < 4; ++r) hs[et][r] += (acc[r] + sc_r[r] * acci[r]) * inv_r[r];
        }
    }
    float rs[4];
#pragma unroll
    for (int r = 0; r < 4; ++r) { float ss = 0.f;
#pragma unroll
        for (int et = 0; et < 8; ++et) ss += hs[et][r] * hs[et][r];
        ss += __shfl_xor(ss, 1); ss += __shfl_xor(ss, 2); ss += __shfl_xor(ss, 4); ss += __shfl_xor(ss, 8);
        rs[r] = rsqrtf(ss * (1.0f / 128.0f) + EPS); }
    bf16* cat = (bf16*)(F.ws + WS_CAT);
#pragma unroll
    for (int et = 0; et < 8; ++et) { const int col = h * 128 + 16 * et + fr; const float gh = in[IN_GHEAD][col];
#pragma unroll
        for (int r = 0; r < 4; ++r) { const int t = rowbase + 16 * wave + 4 * fq + r;
            const float o = hs[et][r] * rs[r] * gh * sigmoid_f(bf2f(z[(size_t)t * NINP + OFF_O + col]));
            cat[(size_t)t * D + col] = (bf16)(cvt_pk_bf16(o, 0.f) & 0xffffu); } }
    __syncthreads();
}

__device__ __forceinline__ void p3_filter_tile(Frame& F, int tile) {
    const float* const* in = F.in;
    const int tid = F.tid;
    LAS float* feat = (LAS float*)F.lds;
    LAS float* h1 = feat + 64 * 36;
    LAS float* h2 = h1 + 64 * 65;
    LAS float* w1s = h2 + 64 * 64;
    LAS float* w2s = w1s + 33 * 64;
    for (int i = tid; i < 33 * 64; i += NT) w1s[i] = in[IN_FW1][i];
    for (int i = tid; i < 64 * 64; i += NT) w2s[i] = in[IN_FW2][i];
    {
        const int tt = tid >> 3, sub = tid & 7; const float t = (float)(tile * 64 + tt);
        const float w = (6.2831855f * t) / (float)L;
        if (sub == 0) feat[tt * 36] = t / (float)(L - 1);
#pragma unroll
        for (int q = 0; q < 2; ++q) { const int bi = sub * 2 + q; const float band = 1e-4f + (float)bi * ((15.0f - 1e-4f) / 15.0f); const float ang = w * band;
            feat[tt * 36 + 1 + bi] = cosf(ang); feat[tt * 36 + 17 + bi] = -sinf(ang); }
    }
    __syncthreads();
    {
        const int tt = tid >> 3, j0 = (tid & 7) * 8;
        float a[8];
#pragma unroll
        for (int q = 0; q < 8; ++q) a[q] = in[IN_FB1][j0 + q];
#pragma unroll 1
        for (int i = 0; i < 33; ++i) { const float f = feat[tt * 36 + i];
#pragma unroll
            for (int q = 0; q < 8; ++q) a[q] += f * w1s[i * 64 + j0 + q]; }
#pragma unroll
        for (int q = 0; q < 8; ++q) h1[tt * 65 + j0 + q] = sinf(in[IN_FF1][j0 + q] * a[q]);
    }
    __syncthreads();
    {
        const int tt = tid >> 3, j0 = (tid & 7) * 8;
        float a[8];
#pragma unroll
        for (int q = 0; q < 8; ++q) a[q] = in[IN_FB2][j0 + q];
#pragma unroll 1
        for (int i = 0; i < 64; ++i) { const float f = h1[tt * 65 + i];
#pragma unroll
            for (int q = 0; q < 8; ++q) a[q] += f * w2s[i * 64 + j0 + q]; }
#pragma unroll
        for (int q = 0; q < 8; ++q) h2[tt * 64 + j0 + q] = sinf(in[IN_FF2][j0 + q] * a[q]);
    }
    __syncthreads();
    {
        bf16* hd = (bf16*)(F.ws + WS_HDN);
        for (int i = tid; i < 64 * 32; i += NT) { const int tt = i >> 5, j = (i & 31) * 2; *(unsigned*)(hd + (size_t)(tile * 64 + tt) * 64 + j) = cvt_pk_bf16(h2[tt * 64 + j], h2[tt * 64 + j + 1]); }
    }
    __syncthreads();
}
__device__ __forceinline__ void p3_uin_tile(Frame& F, int tile) {
    const float* const* in = F.in;
    const bf16* z = (const bf16*)(F.ws + WS_Z); float* uT = (float*)(F.ws + WS_UIN);
    LAS float* tl = (LAS float*)F.lds;
    const int t0 = (tile >> 2) * 64, cb = (tile & 3) * 256;
    const int cg = F.tid & 31, c0 = cb + cg * 8, rsub = F.tid >> 5;
    for (int pass = 0; pass < 4; ++pass) {
        const int tt = pass * 16 + rsub, t = t0 + tt;
        float r1[8], r2[8];
#pragma unroll
        for (int part = 0; part < 2; ++part) {
            const int zc = OFF_HY + 1024 * (part + 1) + c0, wc = 1024 * (part + 1) + c0;
            const v4u cur = *(const v4u*)(z + (size_t)t * NINP + zc);
            const v4u prv = t > 0 ? *(const v4u*)(z + (size_t)(t - 1) * NINP + zc) : (v4u){0u, 0u, 0u, 0u};
            const v4u nxt = t < L - 1 ? *(const v4u*)(z + (size_t)(t + 1) * NINP + zc) : (v4u){0u, 0u, 0u, 0u};
            float* rr = part ? r2 : r1;
#pragma unroll
            for (int q = 0; q < 4; ++q) {
                const unsigned pc = q == 0 ? prv.x : q == 1 ? prv.y : q == 2 ? prv.z : prv.w, cc = q == 0 ? cur.x : q == 1 ? cur.y : q == 2 ? cur.z : cur.w, nc = q == 0 ? nxt.x : q == 1 ? nxt.y : q == 2 ? nxt.z : nxt.w;
                const int ch = wc + 2 * q;
                rr[2 * q] = bflo(pc) * in[IN_CHW][ch] + bflo(cc) * in[IN_CHW][3072 + ch] + bflo(nc) * in[IN_CHW][6144 + ch] + in[IN_CHB][ch];
                rr[2 * q + 1] = bfhi(pc) * in[IN_CHW][ch + 1] + bfhi(cc) * in[IN_CHW][3072 + ch + 1] + bfhi(nc) * in[IN_CHW][6144 + ch + 1] + in[IN_CHB][ch + 1];
            }
        }
#pragma unroll
        for (int q = 0; q < 8; ++q) tl[(cg * 8 + q) * 65 + tt] = r1[q] * r2[q];
    }
    __syncthreads();
    for (int i = F.tid; i < 256 * 16; i += NT) { const int c = i >> 4, tq = (i & 15) * 4; const LAS float* s = tl + c * 65 + tq;
        *(f32x4*)(uT + (size_t)(cb + c) * L + t0 + tq) = (f32x4){s[0], s[1], s[2], s[3]}; }
    __syncthreads();
}

#ifndef FFT_LAS
#define FFT_LAS LAS
#endif
#if defined(__HIP_DEVICE_COMPILE__)
#define FFT_OPAQUE(v) asm volatile("" : "+v"(v))
#else
#define FFT_OPAQUE(v)
#endif
constexpr int FN = 16384;
constexpr int FFT_SLOTS = 18432;
__host__ __device__ __forceinline__ int fphys(int p) { return p + (p >> 3); }
__host__ __device__ __forceinline__ float fcos32(int k) {
    constexpr float T[16] = {1.0f, 0.98078528040323043f, 0.92387953251128674f, 0.83146961230254524f, 0.70710678118654752f, 0.55557023301960218f, 0.38268343236508977f, 0.19509032201612825f,
                             0.0f, -0.19509032201612825f, -0.38268343236508977f, -0.55557023301960218f, -0.70710678118654752f, -0.83146961230254524f, -0.92387953251128674f, -0.98078528040323043f};
    return T[k]; }
__host__ __device__ __forceinline__ float fsin32(int k) {
    constexpr float T[16] = {0.0f, 0.19509032201612825f, 0.38268343236508977f, 0.55557023301960218f, 0.70710678118654752f, 0.83146961230254524f, 0.92387953251128674f, 0.98078528040323043f,
                             1.0f, 0.98078528040323043f, 0.92387953251128674f, 0.83146961230254524f, 0.70710678118654752f, 0.55557023301960218f, 0.38268343236508977f, 0.19509032201612825f};
    return T[k]; }
__host__ __device__ __forceinline__ float fcosN(int m) {
    constexpr float T[16] = {1.0f, 0.99999992646571789f, 0.99999970586288223f, 0.99999933819152553f, 0.99999882345170188f, 0.99999816164348698f, 0.99999735276697821f, 0.99999639682229435f,
                             0.99999529380957619f, 0.99999404372898582f, 0.99999264658070719f, 0.99999110236494559f, 0.9999894110819284f, 0.99998757273190408f, 0.9999855873151432f, 0.99998345483193773f};
    return T[m]; }
__host__ __device__ __forceinline__ float fsinN(int m) {
    constexpr float T[16] = {0.0f, 0.00038349518757139556f, 0.00076699031874270449f, 0.0011504853371138485f, 0.0015339801862847655f, 0.001917474809855419f, 0.002300969151425805f, 0.0026844631545959617f,
                             0.0030679567629659761f, 0.003451449920135994f, 0.0038349425697062275f, 0.004218434655276963f, 0.0046019261204485705f, 0.0049854169088215106f, 0.0053689069639963425f, 0.0057523962295737358f};
    return T[m]; }
template <int R> __host__ __device__ __forceinline__ constexpr int fbrev(int x) { int r = 0; for (int b = 1; b < R; b <<= 1) { r = (r << 1) | (x & 1); x >>= 1; } return r; }
#if defined(__HIP_DEVICE_COMPILE__)
__device__ __forceinline__ f32x2 cx_mul_cj2(f32x2 d, f32x2 cs) { f32x2 t, o;
    asm("v_pk_mul_f32 %0, %1, %2 op_sel_hi:[1,0]" : "=v"(t) : "v"(d), "v"(cs));
    asm("v_pk_fma_f32 %0, %1, %2, %3 op_sel:[1,1,0] op_sel_hi:[0,1,1] neg_hi:[1,0,0]" : "=v"(o) : "v"(d), "v"(cs), "v"(t)); return o; }
__device__ __forceinline__ f32x2 cx_mul2(f32x2 d, f32x2 cs) { f32x2 t, o;
    asm("v_pk_mul_f32 %0, %1, %2 op_sel_hi:[1,0]" : "=v"(t) : "v"(d), "v"(cs));
    asm("v_pk_fma_f32 %0, %1, %2, %3 op_sel:[1,1,0] op_sel_hi:[0,1,1] neg_lo:[1,0,0]" : "=v"(o) : "v"(d), "v"(cs), "v"(t)); return o; }
__device__ __forceinline__ f32x2 cx_sub_rot_m(f32x2 a, f32x2 b) { f32x2 o;
    asm("v_pk_add_f32 %0, %1, %2 op_sel:[1,1] op_sel_hi:[0,0] neg_lo:[0,1] neg_hi:[1,0]" : "=v"(o) : "v"(a), "v"(b)); return o; }
__device__ __forceinline__ f32x2 cx_sub_rot_p(f32x2 a, f32x2 b) { f32x2 o;
    asm("v_pk_add_f32 %0, %1, %2 op_sel:[1,1] op_sel_hi:[0,0] neg_lo:[1,0] neg_hi:[0,1]" : "=v"(o) : "v"(a), "v"(b)); return o; }
__device__ __forceinline__ f32x2 cx_add_conj(f32x2 a, f32x2 b) { f32x2 o; asm("v_pk_add_f32 %0, %1, %2 neg_hi:[0,1]" : "=v"(o) : "v"(a), "v"(b)); return o; }
__device__ __forceinline__ f32x2 cx_mi_sub_conj(f32x2 a, f32x2 b) { f32x2 o; asm("v_pk_add_f32 %0, %1, %2 op_sel:[1,1] op_sel_hi:[0,0] neg_hi:[1,0]" : "=v"(o) : "v"(a), "v"(b)); return o; }
__device__ __forceinline__ f32x2 cx_add_i(f32x2 a, f32x2 b) { f32x2 o; asm("v_pk_add_f32 %0, %1, %2 op_sel:[0,1] op_sel_hi:[1,0] neg_lo:[0,1]" : "=v"(o) : "v"(a), "v"(b)); return o; }
__device__ __forceinline__ f32x2 cx_conj_add_i_conj(f32x2 a, f32x2 b) { f32x2 o; asm("v_pk_add_f32 %0, %1, %2 op_sel:[0,1] op_sel_hi:[1,0] neg_hi:[1,0]" : "=v"(o) : "v"(a), "v"(b)); return o; }
#else
__host__ __device__ __forceinline__ f32x2 cx_add_conj(f32x2 a, f32x2 b) { return (f32x2){a.x + b.x, a.y - b.y}; }
__host__ __device__ __forceinline__ f32x2 cx_mi_sub_conj(f32x2 a, f32x2 b) { return (f32x2){a.y + b.y, b.x - a.x}; }
__host__ __device__ __forceinline__ f32x2 cx_add_i(f32x2 a, f32x2 b) { return (f32x2){a.x - b.y, a.y + b.x}; }
__host__ __device__ __forceinline__ f32x2 cx_conj_add_i_conj(f32x2 a, f32x2 b) { return (f32x2){a.x + b.y, b.x - a.y}; }
__host__ __device__ __forceinline__ f32x2 cx_mul_cj2(f32x2 d, f32x2 cs) { return (f32x2){d.x * cs.x + d.y * cs.y, d.y * cs.x - d.x * cs.y}; }
__host__ __device__ __forceinline__ f32x2 cx_mul2(f32x2 d, f32x2 cs) { return (f32x2){d.x * cs.x - d.y * cs.y, d.y * cs.x + d.x * cs.y}; }
__host__ __device__ __forceinline__ f32x2 cx_sub_rot_m(f32x2 a, f32x2 b) { return (f32x2){a.y - b.y, b.x - a.x}; }
__host__ __device__ __forceinline__ f32x2 cx_sub_rot_p(f32x2 a, f32x2 b) { return (f32x2){b.y - a.y, a.x - b.x}; }
#endif
template <int R, bool INV>
__host__ __device__ __forceinline__ void fft_reg(f32x2 (&x)[R]) {
#pragma unroll
    for (int len = R; len >= 2; len >>= 1) {
        const int half = len >> 1;
#pragma unroll
        for (int blk = 0; blk < R; blk += len)
#pragma unroll
            for (int k = 0; k < half; ++k) {
                const int i0 = blk + k, i1 = i0 + half;
                const f32x2 a = x[i0], b = x[i1];
                x[i0] = a + b;
                if (k == 0) x[i1] = a - b;
                else if (4 * k == len) x[i1] = INV ? cx_sub_rot_p(a, b) : cx_sub_rot_m(a, b);
                else { const f32x2 cs = (f32x2){fcos32(k * (32 / len)), fsin32(k * (32 / len))}; const f32x2 d = a - b; x[i1] = INV ? cx_mul2(d, cs) : cx_mul_cj2(d, cs); }
            }
    }
}
__host__ __device__ __forceinline__ void ftw(int num, int den, float& c, float& s) {
#if defined(__HIP_DEVICE_COMPILE__)
    const float fr = (float)num * (1.0f / (float)den); c = __builtin_amdgcn_cosf(fr); s = __builtin_amdgcn_sinf(fr);
#else
    const double a = 6.283185307179586476925 * (double)num / (double)den; c = (float)cos(a); s = (float)sin(a);
#endif
}
template <int R, int M>
__host__ __device__ __forceinline__ void fft_fwd_bfly(FFT_LAS float* buf, int B, int j) {
    constexpr int S = M / R, PS = S == 1 ? 1 : S + S / 8;
    FFT_LAS f32x2* p = (FFT_LAS f32x2*)buf + fphys(B + j);
    f32x2 x[R];
#pragma unroll
    for (int q = 0; q < R; ++q) x[q] = p[q * PS];
    fft_reg<R, false>(x);
    if (S > 1) { float c1, s1; ftw(j, M, c1, s1); const f32x2 cs1 = (f32x2){c1, s1}; f32x2 w = cs1;
#pragma unroll
        for (int r = 1; r < R; ++r) { const int ix = fbrev<R>(r); x[ix] = cx_mul_cj2(x[ix], w); w = cx_mul2(w, cs1); } }
#pragma unroll
    for (int r = 0; r < R; ++r) p[r * PS] = x[fbrev<R>(r)];
}
template <int R, int M>
__host__ __device__ __forceinline__ void fft_inv_bfly(FFT_LAS float* buf, int B, int j) {
    constexpr int S = M / R, PS = S == 1 ? 1 : S + S / 8;
    FFT_LAS f32x2* p = (FFT_LAS f32x2*)buf + fphys(B + j);
    f32x2 x[R];
#pragma unroll
    for (int r = 0; r < R; ++r) x[r] = p[r * PS];
    if (S > 1) { float c1, s1; ftw(j, M, c1, s1); const f32x2 cs1 = (f32x2){c1, s1}; f32x2 w = cs1;
#pragma unroll
        for (int r = 1; r < R; ++r) { x[r] = cx_mul2(x[r], w); w = cx_mul2(w, cs1); } }
    fft_reg<R, true>(x);
#pragma unroll
    for (int q = 0; q < R; ++q) p[q * PS] = x[fbrev<R>(q)];
}
__host__ __device__ __forceinline__ void fft_fwd_pass(FFT_LAS float* buf, int pass, int tid) {
    FFT_OPAQUE(tid);
    if (pass == 0) {
#pragma unroll 1
        for (int i = 0; i < 2; ++i) fft_fwd_bfly<16, 16384>(buf, 0, tid + 512 * i); }
    else if (pass == 1) {
#pragma unroll 1
        for (int i = 0; i < 2; ++i) { const int id = tid + 512 * i; fft_fwd_bfly<16, 1024>(buf, (id >> 6) * 1024, id & 63); } }
    else if (pass == 2) {
#pragma unroll 1
        for (int i = 0; i < 4; ++i) { const int id = tid + 512 * i; fft_fwd_bfly<8, 64>(buf, (id >> 3) * 64, id & 7); } }
    else {
#pragma unroll 1
        for (int i = 0; i < 4; ++i) { const int id = tid + 512 * i; fft_fwd_bfly<8, 8>(buf, id * 8, 0); } }
}
__host__ __device__ __forceinline__ void fft_inv_pass(FFT_LAS float* buf, int pass, int tid) {
    FFT_OPAQUE(tid);
    if (pass == 0) {
#pragma unroll 1
        for (int i = 0; i < 4; ++i) { const int id = tid + 512 * i; fft_inv_bfly<8, 8>(buf, id * 8, 0); } }
    else if (pass == 1) {
#pragma unroll 1
        for (int i = 0; i < 4; ++i) { const int id = tid + 512 * i; fft_inv_bfly<8, 64>(buf, (id >> 3) * 64, id & 7); } }
    else if (pass == 2) {
#pragma unroll 1
        for (int i = 0; i < 2; ++i) { const int id = tid + 512 * i; fft_inv_bfly<16, 1024>(buf, (id >> 6) * 1024, id & 63); } }
    else {
#pragma unroll 1
        for (int i = 0; i < 2; ++i) fft_inv_bfly<16, 16384>(buf, 0, tid + 512 * i); }
}
__host__ __device__ __forceinline__ int fpos(int k) { return ((k & 15) << 10) | (((k >> 4) & 15) << 6) | (((k >> 8) & 7) << 3) | (k >> 11); }
__host__ __device__ __forceinline__ void fft_mul_one(FFT_LAS float* buf, int k, f32x2 c, f32x2 dm, f32x2 w) {
    const int k2 = (FN - k) & (FN - 1);
    FFT_LAS f32x2* pa = (FFT_LAS f32x2*)(buf + 2 * fphys(fpos(k))); FFT_LAS f32x2* pb = (FFT_LAS f32x2*)(buf + 2 * fphys(fpos(k2)));
    const f32x2 A = *pa, Bm = *pb;
    const f32x2 ue = cx_add_conj(A, Bm), uo = cx_mi_sub_conj(A, Bm), ke = cx_add_conj(c, dm), ko = cx_mi_sub_conj(c, dm);
    const f32x2 ye = cx_mul2(ue, ke) + cx_mul_cj2(cx_mul2(uo, ko), w);
    const f32x2 yo = cx_mul2(ue, ko) + cx_mul2(uo, ke);
    *pa = cx_add_i(ye, yo);
    *pb = cx_conj_add_i_conj(ye, yo);
}
__device__ __forceinline__ void p4_fft_job(Frame& F, int job) {
    const float* const* in = F.in;
    int tid_ = F.tid, lane_ = F.lane; FFT_OPAQUE(tid_); FFT_OPAQUE(lane_);
    const int tid = tid_, lane = lane_, wave = F.wave, c0 = job * 4;
    LAS float* buf = (LAS float*)F.lds;
    LAS float* scr = (LAS float*)(F.lds + FFTSCR_OFF);
    float* hfT = (float*)(F.ws + WS_KF); float* hbT = (float*)(F.ws + WS_KB); const float* uT = (const float*)(F.ws + WS_UIN);
    {
        const bf16* hd = (const bf16*)(F.ws + WS_HDN);
        const int n = lane & 15, kq = lane >> 4, ch = (n >> 1) & 3, dir = n & 1, col = dir * 1024 + c0 + ch; const bool valid = n < 8;
        bf16x8 bfr[2];
#pragma unroll
        for (int ks = 0; ks < 2; ++ks) { unsigned w[4];
#pragma unroll
            for (int j = 0; j < 4; ++j) { const int k = ks * 32 + kq * 8 + 2 * j; const float a = valid ? in[IN_FW3][(size_t)k * 2048 + col] : 0.f, b = valid ? in[IN_FW3][(size_t)(k + 1) * 2048 + col] : 0.f; w[j] = cvt_pk_bf16(a, b); }
            bfr[ks] = __builtin_bit_cast(bf16x8, (v4u){w[0], w[1], w[2], w[3]}); }
        const float b3 = valid ? in[IN_FB3][col] : 0.f;
        const float r_slow = 3.0701134573253945f, r_fast = 15.350567286626972f;
        const float rate = r_slow + (float)(c0 + ch) * ((r_fast - r_slow) / 1023.0f);
        const float nrl = -rate * (1.4426950408889634f / (float)(L - 1));
        float asum = 0.f; float* dst = (dir ? hbT : hfT) + (size_t)(c0 + ch) * L;
#pragma unroll 1
        for (int tb = wave * 8; tb < L / 16; tb += NWAVES * 8) {
            bf16x8 a0[8], a1[8];
#pragma unroll
            for (int i = 0; i < 8; ++i) { const bf16* hp = hd + (size_t)((tb + i) * 16 + n) * 64 + kq * 8; a0[i] = *(const bf16x8*)hp; a1[i] = *(const bf16x8*)(hp + 32); }
#pragma unroll
            for (int i = 0; i < 8; ++i) { const int t0 = (tb + i) * 16;
                f32x4 acc = (f32x4){b3, b3, b3, b3};
                acc = __builtin_amdgcn_mfma_f32_16x16x32_bf16(a0[i], bfr[0], acc, 0, 0, 0);
                acc = __builtin_amdgcn_mfma_f32_16x16x32_bf16(a1[i], bfr[1], acc, 0, 0, 0);
                if (valid) { f32x4 o;
#pragma unroll
                    for (int r = 0; r < 4; ++r) { const int t = t0 + 4 * kq + r; const float v = acc[r] * __builtin_amdgcn_exp2f((float)t * nrl); o[r] = v; if (!(dir && t == 0)) asum += fabsf(v); }
                    *(f32x4*)(dst + t0 + 4 * kq) = o; } }
        }
        asum += __shfl_xor(asum, 16); asum += __shfl_xor(asum, 32);
        if (lane < 8) scr[wave * 8 + lane] = asum;
        VM_WAIT(); __syncthreads();
        float tot = 0.f;
        if (tid < 4) { for (int w = 0; w < 8; ++w) tot += scr[w * 8 + 2 * tid] + scr[w * 8 + 2 * tid + 1]; }
        __syncthreads();
        if (tid < 4) scr[tid] = 0.25f / (tot * (float)FN);
        __syncthreads();
    }
    f32x2 hfv[16]; float hbe[16], hbo[16];
#define HY_LOAD_FILTER(c_) do { int tq_ = tid; FFT_OPAQUE(tq_); const float* hf_ = hfT + (size_t)(c_) * L; const float* hb_ = hbT + (size_t)(c_) * L; \
        _Pragma("unroll") for (int i = 0; i < 16; ++i) { const int a = tq_ + NT * i; hfv[i] = *(const f32x2*)(hf_ + 2 * a); } \
        _Pragma("unroll") for (int i = 0; i < 16; ++i) { const int a = FN / 2 + tq_ + NT * i; hbo[i] = hb_[2 * FN - 2 * a - 1]; hbe[i] = hb_[2 * FN - 2 * a]; } } while (0)
#pragma unroll 1
    for (int ch = 0; ch < 4; ++ch) {
        const int c = c0 + ch;
        const float* uc = uT + (size_t)c * L;
        HY_LOAD_FILTER(c);
        { int tq = tid; FFT_OPAQUE(tq);
#pragma unroll
        for (int i = 0; i < 16; ++i) { const int a = tq + NT * i; *(LAS f32x2*)(buf + 2 * fphys(a)) = hfv[i]; }
#pragma unroll
        for (int i = 0; i < 16; ++i) { const int a = FN / 2 + tq + NT * i; *(LAS f32x2*)(buf + 2 * fphys(a)) = (f32x2){a == FN / 2 ? 0.f : hbe[i], hbo[i]}; } }
        f32x2 uv[16];
        { int tq = tid; FFT_OPAQUE(tq);
#pragma unroll
        for (int i = 0; i < 16; ++i) { const int a = tq + NT * i; uv[i] = *(const f32x2*)(uc + 2 * a); } }
        __syncthreads();
        fft_fwd_pass(buf, 0, tid); __syncthreads(); fft_fwd_pass(buf, 1, tid); __syncthreads(); fft_fwd_pass(buf, 2, tid); __syncthreads(); fft_fwd_pass(buf, 3, tid); __syncthreads();
        f32x2 ska[16], skb[16];
        int kbase = ((tid >> 5) << 4) + ((tid & 31) << 8); FFT_OPAQUE(kbase);
#pragma unroll
        for (int m = 0; m < 16; ++m) { const int k = kbase + m, k2 = (FN - k) & (FN - 1); ska[m] = *(const LAS f32x2*)(buf + 2 * fphys(fpos(k))); skb[m] = *(const LAS f32x2*)(buf + 2 * fphys(fpos(k2))); }
        if (tid == 0) { const f32x2 h = *(const LAS f32x2*)(buf + 2 * fphys(fpos(FN / 2))); scr[8] = h.x; scr[9] = h.y; }
        __syncthreads();
        { int tq = tid; FFT_OPAQUE(tq);
#pragma unroll
        for (int i = 0; i < 16; ++i) { const int a = tq + NT * i; *(LAS f32x2*)(buf + 2 * fphys(a)) = uv[i]; }
#pragma unroll 4
        for (int i = 0; i < 16; ++i) { const int a = FN / 2 + tq + NT * i; *(LAS f32x2*)(buf + 2 * fphys(a)) = (f32x2){0.f, 0.f}; } }
        __syncthreads();
        fft_fwd_pass(buf, 0, tid); __syncthreads(); fft_fwd_pass(buf, 1, tid); __syncthreads(); fft_fwd_pass(buf, 2, tid); __syncthreads(); fft_fwd_pass(buf, 3, tid); __syncthreads();
        {   FFT_OPAQUE(kbase); float c1, s1; ftw(kbase, FN, c1, s1);
#pragma unroll
            for (int m = 0; m < 16; ++m) { const float cm = fcosN(m), sm = fsinN(m); const f32x2 w = (f32x2){c1 * cm - s1 * sm, s1 * cm + c1 * sm};
                fft_mul_one(buf, kbase + m, ska[m], skb[m], w); }
            if (tid == 0) { const f32x2 zh = (f32x2){scr[8], scr[9]}; fft_mul_one(buf, FN / 2, zh, zh, (f32x2){-1.0f, 0.0f}); }
        }
        __syncthreads();
        fft_inv_pass(buf, 0, tid); __syncthreads(); fft_inv_pass(buf, 1, tid); __syncthreads(); fft_inv_pass(buf, 2, tid); __syncthreads(); fft_inv_pass(buf, 3, tid); __syncthreads();
        { const float sc = scr[ch]; float* yT = hfT + (size_t)c * L;
#pragma unroll 4
            for (int nn = tid; nn < FN / 2; nn += NT) { const f32x2 v = *(const LAS f32x2*)(buf + 2 * fphys(nn)); *(f32x2*)(yT + 2 * nn) = (f32x2){v.x * sc, v.y * sc}; } }
        __syncthreads();
    }
#undef HY_LOAD_FILTER
    __syncthreads();
}
__device__ __forceinline__ void p5_hy_finish_tile(Frame& F, int tile) {
    const float* const* in = F.in;
    const int tid = F.tid, t0 = (tile >> 2) * 64, cb = (tile & 3) * 256;
    const float* yT = (const float*)(F.ws + WS_KF); const float* uT = (const float*)(F.ws + WS_UIN);
    const bf16* z = (const bf16*)(F.ws + WS_Z); bf16* cat = (bf16*)(F.ws + WS_CAT);
    LAS float* tl = (LAS float*)F.lds;
#pragma unroll 4
    for (int i = tid; i < 4096; i += NT) { const int c = i >> 4, tq = (i & 15) * 4;
        const f32x4 y4 = *(const f32x4*)(yT + (size_t)(cb + c) * L + t0 + tq), u4 = *(const f32x4*)(uT + (size_t)(cb + c) * L + t0 + tq);
        const float d = in[IN_DSKIP][cb + c]; LAS float* s = tl + c * 65 + tq;
        s[0] = y4.x + d * u4.x; s[1] = y4.y + d * u4.y; s[2] = y4.z + d * u4.z; s[3] = y4.w + d * u4.w; }
    __syncthreads();
    const int t = tid & 63, cg = tid >> 6, T = t0 + t, c0 = cb + 32 * cg;
    const bool hp = T > 0, hn = T < L - 1;
#pragma unroll
    for (int q = 0; q < 4; ++q) { const int c = c0 + 8 * q;
        const v4u zc = *(const v4u*)(z + (size_t)T * NINP + OFF_HY + c);
        const v4u zp = hp ? *(const v4u*)(z + (size_t)(T - 1) * NINP + OFF_HY + c) : (v4u){0u, 0u, 0u, 0u};
        const v4u zn = hn ? *(const v4u*)(z + (size_t)(T + 1) * NINP + OFF_HY + c) : (v4u){0u, 0u, 0u, 0u};
        const unsigned cc[4] = {zc.x, zc.y, zc.z, zc.w}, pp[4] = {zp.x, zp.y, zp.z, zp.w}, nn[4] = {zn.x, zn.y, zn.z, zn.w};
        float o[8];
#pragma unroll
        for (int k = 0; k < 4; ++k) { const int ch = c + 2 * k; const LAS float* s = tl + (32 * cg + 8 * q + 2 * k) * 65 + t;
            o[2 * k] = (bflo(pp[k]) * in[IN_CHW][ch] + bflo(cc[k]) * in[IN_CHW][3072 + ch] + bflo(nn[k]) * in[IN_CHW][6144 + ch] + in[IN_CHB][ch]) * s[0];
            o[2 * k + 1] = (bfhi(pp[k]) * in[IN_CHW][ch + 1] + bfhi(cc[k]) * in[IN_CHW][3072 + ch + 1] + bfhi(nn[k]) * in[IN_CHW][6144 + ch + 1] + in[IN_CHB][ch + 1]) * s[65]; }
        v4u w; w.x = cvt_pk_bf16(o[0], o[1]); w.y = cvt_pk_bf16(o[2], o[3]); w.z = cvt_pk_bf16(o[4], o[5]); w.w = cvt_pk_bf16(o[6], o[7]);
        *(v4u*)(cat + (size_t)T * D + MVW + c) = w; }
    __syncthreads();
}

constexpr int RT_PITCH = 2056;
#define RT_BAR() asm volatile("s_waitcnt lgkmcnt(0)\n\ts_barrier" ::: "memory")
template <bool DRY>
__device__ __forceinline__ void p6_norm2_router(Frame& F) {
    const float* const* in = F.in;
    const float* mod = (const float*)(F.ws + WS_MOD);
    unsigned char* h2g = (unsigned char*)(F.ws + WS_HA);
    int* aexp = (int*)(F.ws + WS_AEXP); int* arank = (int*)(F.ws + WS_ARANK); float* aw = (float*)(F.ws + WS_AW);
    LAS bf16* h1 = (LAS bf16*)F.lds;
    LAS float* part = (LAS float*)(h1 + 2 * 16 * RT_PITCH);
    LAS int* lc = (LAS int*)(part + 2 * 16 * 64);
    if (F.tid < 128) lc[F.tid] = 0;
    __syncthreads();
    const bf16* w1 = (const bf16*)(F.ws + WS_WR1);
    const int lane = F.lane, wave = F.wave, fr = lane & 15, fq = lane >> 4;
    const bf16* yg = (const bf16*)(F.ws + WS_YG); const float* posb = (const float*)(F.ws + WS_POS);
    f32x4 xa[8], xb[8]; v2u ya[8], yb[8];
#define RT_PREFETCH(t0_) do { const int ta_ = (t0_) + 2 * wave, tb_ = ta_ + 1; _Pragma("unroll") for (int j = 0; j < 8; ++j) { const int col = 4 * lane + 256 * j; \
        xa[j] = *(const f32x4*)(in[IN_X] + (size_t)ta_ * D + col); xb[j] = *(const f32x4*)(in[IN_X] + (size_t)tb_ * D + col); \
        ya[j] = *(const v2u*)(yg + (size_t)ta_ * D + col); yb[j] = *(const v2u*)(yg + (size_t)tb_ * D + col); } } while (0)
    if (F.bid * 16 < L) RT_PREFETCH(F.bid * 16);
    for (int t0 = F.bid * 16; t0 < L; t0 += F.G * 16) {
        {
            f32x4 va[8], vb[8]; float sa = 0.f, sb = 0.f;
            int lane = F.lane; asm volatile("" : "+v"(lane));
            const int ta = t0 + 2 * wave, tb = ta + 1;
#pragma unroll
            for (int j = 0; j < 8; ++j) { const int col = 4 * lane + 256 * j;
                const float* pa = j < 4 ? posb + (size_t)(ta >> 6) * 1024 + col : posb + (size_t)(256 + (ta & 63)) * 1024 + (col - 1024);
                const float* pb = j < 4 ? posb + (size_t)(tb >> 6) * 1024 + col : posb + (size_t)(256 + (tb & 63)) * 1024 + (col - 1024);
                const f32x4 qa = *(const f32x4*)pa, qb = *(const f32x4*)pb;
                va[j] = (xa[j] + qa) + (f32x4){bflo(ya[j].x), bfhi(ya[j].x), bflo(ya[j].y), bfhi(ya[j].y)};
                vb[j] = (xb[j] + qb) + (f32x4){bflo(yb[j].x), bfhi(yb[j].x), bflo(yb[j].y), bfhi(yb[j].y)}; }
#pragma unroll
            for (int j = 0; j < 8; ++j) { sa += (va[j].x * va[j].x + va[j].y * va[j].y) + (va[j].z * va[j].z + va[j].w * va[j].w); sb += (vb[j].x * vb[j].x + vb[j].y * vb[j].y) + (vb[j].z * vb[j].z + vb[j].w * vb[j].w); }
            const float ra = rsqrtf(wave_sum(sa) * (1.0f / D) + EPS), rb = rsqrtf(wave_sum(sb) * (1.0f / D) + EPS);
#pragma unroll
            for (int j = 0; j < 8; ++j) { const int col = 4 * lane + 256 * j;
                const f32x4 gqj = *(const f32x4*)(in[IN_GFFN] + col) * (*(const f32x4*)(mod + 8192 + col) + 1.0f), sqj = *(const f32x4*)(mod + 6144 + col);
#pragma unroll
                for (int rr = 0; rr < 2; ++rr) { const int tr = 2 * wave + rr, t = t0 + tr;
                    const f32x4 h = ((rr ? vb[j] : va[j]) * (rr ? rb : ra)) * gqj + sqj;
                    v2u o; o.x = cvt_pk_bf16(h.x, h.y); o.y = cvt_pk_bf16(h.z, h.w);
                    *(unsigned*)(h2g + (size_t)t * D + col) = pk_fp8x4(h.x, h.y, h.z, h.w);
                    *(LAS v2u*)(h1 + tr * RT_PITCH + col) = o; } }
        }
        RT_BAR();
        if (t0 + F.G * 16 < L) RT_PREFETCH(t0 + F.G * 16);
        {
            const int nt = wave & 3, kh = wave >> 2;
            f32x4 acc = (f32x4){0.f, 0.f, 0.f, 0.f};
            const bf16* b1p = w1 + (size_t)(16 * nt + fr) * 2048 + kh * 1024 + 8 * fq;
            const LAS bf16* a1p = h1 + fr * RT_PITCH + kh * 1024 + 8 * fq;
#pragma unroll 8
            for (int ks = 0; ks < 32; ++ks) {
                const bf16x8 a1 = *(const LAS bf16x8*)(a1p + 32 * ks);
                const bf16x8 b1 = *(const bf16x8*)(b1p + 32 * ks);
                acc = __builtin_amdgcn_mfma_f32_16x16x32_bf16(a1, b1, acc, 0, 0, 0); }
#pragma unroll
            for (int r = 0; r < 4; ++r) part[(kh * 16 + 4 * fq + r) * 64 + 16 * nt + fr] = acc[r];
        }
        RT_BAR();
#pragma unroll 1
        for (int rr = 0; rr < 2; ++rr) {
            const int tr = 2 * wave + rr, t = t0 + tr;
            const float logit = part[tr * 64 + lane] + part[(16 + tr) * 64 + lane];
            const float s = 1.0f / (1.0f + expf(-logit)), sel = s + in[IN_BR][lane];
            const int grp = lane >> 3;
            float m1 = sel; m1 = fmaxf(m1, __shfl_xor(m1, 1)); m1 = fmaxf(m1, __shfl_xor(m1, 2)); m1 = fmaxf(m1, __shfl_xor(m1, 4));
            const unsigned long long gm = 0xFFull << (8 * grp);
            const unsigned long long b1 = __ballot(sel == m1) & gm;
            const int first = __ffsll((long long)b1) - 1;
            float m2 = (lane == first) ? -INFINITY : sel; m2 = fmaxf(m2, __shfl_xor(m2, 1)); m2 = fmaxf(m2, __shfl_xor(m2, 2)); m2 = fmaxf(m2, __shfl_xor(m2, 4));
            const float gs = m1 + m2;
            int grank = 0;
#pragma unroll
            for (int g = 0; g < 8; ++g) { const float og = __builtin_bit_cast(float, __builtin_amdgcn_readlane(__builtin_bit_cast(int, gs), 8 * g)); grank += (og > gs || (og == gs && g < grp)) ? 1 : 0; }
            const float masked = grank < 4 ? sel : -INFINITY;
            bool chosen = false; float rem = masked;
#pragma unroll
            for (int it8 = 0; it8 < 8; ++it8) { float mx = rem;
#pragma unroll
                for (int o = 1; o < 64; o <<= 1) mx = fmaxf(mx, __shfl_xor(mx, o));
                const unsigned long long bm = __ballot(rem == mx); const int win = __ffsll((long long)bm) - 1;
                if (lane == win) { chosen = true; rem = -INFINITY; } }
            const float wsum = wave_sum(chosen ? s : 0.f);
            const unsigned long long cb = __ballot(chosen);
            if (chosen) {
                const int k = (int)__builtin_amdgcn_mbcnt_hi((unsigned)(cb >> 32), __builtin_amdgcn_mbcnt_lo((unsigned)cb, 0u));
                const int half = t >= HALF_T ? 1 : 0;
                if (!DRY) { const int r = __hip_atomic_fetch_add(lc + half * 64 + lane, 1, __ATOMIC_RELAXED, __HIP_MEMORY_SCOPE_WORKGROUP);
                    aexp[t * 8 + k] = lane; arank[t * 8 + k] = r; aw[t * 8 + k] = s / wsum * 2.5f; }
                else if (s == 12345.678f) aw[t * 8 + k] = s + (float)half;
            }
        }
    }
    __syncthreads();
    if (!DRY && F.tid < 128) ((int*)(F.ws + WS_CNTB))[F.bid * 128 + F.tid] = lc[F.tid];
}
__device__ __forceinline__ void build_pstart(Frame& F) {
    LAS int* ps = (LAS int*)(F.lds + LDSCTL_OFF);
    const int* cnt = (const int*)(F.ws + WS_CTL) + CW_CNT;
    __syncthreads();
    if (F.tid < 2) { int a = 0;
        for (int e = 0; e < NE; ++e) { ps[F.tid * 66 + e] = a; a += (__hip_atomic_load(cnt + F.tid * 64 + e, __ATOMIC_RELAXED, __HIP_MEMORY_SCOPE_AGENT) + 255) & ~255; }
        ps[F.tid * 66 + 64] = a; ps[F.tid * 66 + 65] = a + HALF_T; }
    __syncthreads();
    {
        LAS unsigned char* texp = (LAS unsigned char*)(F.lds + LDSCTL_OFF + 2048); const int ntile = ps[65] >> 8;
        for (int tl = F.tid; tl < ntile; tl += NT) { const int row = tl * 256; int lo = 0, hi = NE1;
            while (hi - lo > 1) { const int mid = (lo + hi) >> 1; if (ps[mid] <= row) lo = mid; else hi = mid; }
            texp[tl] = (unsigned char)lo; }
    }
    __syncthreads();
}
__device__ __forceinline__ void p7_fill_rows(Frame& F) {
    LAS int* ps = (LAS int*)(F.lds + LDSCTL_OFF);
    LAS int* tot = (LAS int*)F.lds; LAS int* pre = tot + 128;
    const int* cntb = (const int*)(F.ws + WS_CNTB);
    int* aexp = (int*)(F.ws + WS_AEXP); int* arank = (int*)(F.ws + WS_ARANK); const float* aw = (const float*)(F.ws + WS_AW);
    int* rt = (int*)(F.ws + WS_RTOK); float* rw = (float*)(F.ws + WS_RW);
    __syncthreads();
    if (F.tid < 128) { int t_ = 0, p_ = 0;
#pragma unroll 8
        for (int b = 0; b < F.G; ++b) { const int v = cntb[b * 128 + F.tid]; t_ += v; p_ += b < F.bid ? v : 0; }
        tot[F.tid] = t_; pre[F.tid] = p_;
        if (F.bid == 0) ((int*)(F.ws + WS_CTL) + CW_CNT)[F.tid] = t_; }
    __syncthreads();
    if (F.tid < 2) { int a = 0;
        for (int e = 0; e < NE; ++e) { ps[F.tid * 66 + e] = a; a += (tot[F.tid * 64 + e] + 255) & ~255; }
        ps[F.tid * 66 + 64] = a; ps[F.tid * 66 + 65] = a + HALF_T; }
    __syncthreads();
    for (int t0 = F.bid * 16; t0 < L; t0 += F.G * 16) {
        if (F.tid < 128) { const int t = t0 + (F.tid >> 3), i = t * 8 + (F.tid & 7), h = t >= HALF_T ? 1 : 0, e = aexp[i];
            const int r = pre[h * 64 + e] + arank[i], row = ps[h * 66 + e] + r;
            arank[i] = r; rt[h * MAXROWS + row] = t; rw[h * MAXROWS + row] = aw[i]; }
        else if (F.tid < 144) { const int t = t0 + (F.tid - 128), h = t >= HALF_T ? 1 : 0; const int row = ps[h * 66 + 64] + (t - h * HALF_T);
            rt[h * MAXROWS + row] = t; rw[h * MAXROWS + row] = 1.0f; }
    }
    __syncthreads();
}
__device__ __forceinline__ void moe_combine(Frame& F, int half, float* outp) {
    const float* const* in = F.in;
    const LAS int* ps = (const LAS int*)(F.lds + LDSCTL_OFF) + half * 66;
    const float* mod = (const float*)(F.ws + WS_MOD);
    const int* aexp = (const int*)(F.ws + WS_AEXP); const int* arank = (const int*)(F.ws + WS_ARANK); const float* aw = (const float*)(F.ws + WS_AW);
    const unsigned char* Y2 = (const unsigned char*)(F.ws + WS_Y2);
    const int gw = F.bid * NWAVES + F.wave, NGW = F.G * NWAVES, lane = F.lane;
    for (int tt = gw; tt < HALF_T; tt += NGW) {
        const int t = half * HALF_T + tt;
        const float* posr = (const float*)(F.ws + WS_POS) + (size_t)(t >> 6) * 1024; const float* posc = (const float*)(F.ws + WS_POS) + (size_t)(256 + (t & 63)) * 1024; const bf16* yg = (const bf16*)(F.ws + WS_YG);
        float a[32];
#pragma unroll
        for (int i = 0; i < 32; ++i) a[i] = 0.f;
#pragma unroll
        for (int k = 0; k < 9; ++k) {
            const int row = k < 8 ? ps[aexp[t * 8 + k]] + arank[t * 8 + k] : ps[64] + tt;
            const float wk = (k < 8 ? aw[t * 8 + k] : 1.0f) * (1.0f / Y2_PRE);
            const unsigned char* yr = Y2 + (size_t)row * D + 8 * lane;
#pragma unroll
            for (int j = 0; j < 4; ++j) { const v2u y = *(const v2u*)(yr + 512 * j);
                const f32x2 p0 = __builtin_amdgcn_cvt_pk_f32_fp8((int)y.x, false), p1 = __builtin_amdgcn_cvt_pk_f32_fp8((int)y.x, true), p2 = __builtin_amdgcn_cvt_pk_f32_fp8((int)y.y, false), p3 = __builtin_amdgcn_cvt_pk_f32_fp8((int)y.y, true);
                a[8 * j + 0] += wk * p0.x; a[8 * j + 1] += wk * p0.y; a[8 * j + 2] += wk * p1.x; a[8 * j + 3] += wk * p1.y;
                a[8 * j + 4] += wk * p2.x; a[8 * j + 5] += wk * p2.y; a[8 * j + 6] += wk * p3.x; a[8 * j + 7] += wk * p3.y; }
        }
        float ss = 0.f;
#pragma unroll
        for (int j = 0; j < 4; ++j)
#pragma unroll
            for (int q = 0; q < 2; ++q) { const int col = 8 * lane + 512 * j + 4 * q;
                const f32x4 xx = *(const f32x4*)(in[IN_X] + (size_t)t * D + col), pp = *(const f32x4*)(j < 2 ? posr + col : posc + (col - 1024)); const v2u yy = *(const v2u*)(yg + (size_t)t * D + col);
                const f32x4 x1 = (xx + pp) + (f32x4){bflo(yy.x), bfhi(yy.x), bflo(yy.y), bfhi(yy.y)}, g2 = *(const f32x4*)(mod + 10240 + col);
                const int i = 8 * j + 4 * q;
                a[i] = x1.x + g2.x * a[i]; a[i + 1] = x1.y + g2.y * a[i + 1]; a[i + 2] = x1.z + g2.z * a[i + 2]; a[i + 3] = x1.w + g2.w * a[i + 3];
                ss += (a[i] * a[i] + a[i + 1] * a[i + 1]) + (a[i + 2] * a[i + 2] + a[i + 3] * a[i + 3]); }
        const float rstd = rsqrtf(wave_sum(ss) * (1.0f / D) + EPS);
#pragma unroll
        for (int j = 0; j < 4; ++j)
#pragma unroll
            for (int q = 0; q < 2; ++q) { const int col = 8 * lane + 512 * j + 4 * q; const int i = 8 * j + 4 * q;
                const f32x4 gf = *(const f32x4*)(in[IN_GFIN] + col);
                *(f32x4*)(outp + (size_t)t * D + col) = (f32x4){a[i] * rstd * gf.x, a[i + 1] * rstd * gf.y, a[i + 2] * rstd * gf.z, a[i + 3] * rstd * gf.w}; }
    }
}

constexpr int N_PHASES = 12;
__global__ void __launch_bounds__(NT, 2) fwd_kernel(Args args) {
    extern __shared__ __attribute__((aligned(16))) unsigned char lds_raw[];
    Frame F;
    F.lds = (LAS unsigned char*)lds_raw;
    F.tid = threadIdx.x; F.lane = F.tid & 63; F.wave = __builtin_amdgcn_readfirstlane(F.tid >> 6);
    F.bid = blockIdx.x; F.G = gridDim.x;
    F.in = args.in; F.out = args.out; F.ws = args.ws;
    volatile LAS unsigned* MISC = (volatile LAS unsigned*)(F.lds + LDSCTL_OFF + 768);
    if (F.tid < 64) ((LAS unsigned*)(F.lds + LDSCTL_OFF))[F.tid + 192] = 0u;
    __syncthreads();
    unsigned* ctl = (unsigned*)(F.ws + WS_CTL);
    const int lo = args.ph_lo, hi = args.ph_hi;
    XcdBarrier bar; bar.bar = ctl + CW_BAR; bar.x = 0; bar.st = nullptr;
    if (hi - lo > 1) bar = xcd_barrier_post(ctl + CW_BAR, MISC + 8);
#ifndef PH_MASK
#define PH_MASK 0xFFFF
#endif
#define IN(k) (((PH_MASK >> (k)) & 1) && lo <= (k) && (k) < hi)
#define SEAM(k) do { if (IN(k) && IN((k) + 1)) xcd_barrier(bar); } while (0)
#define REP(k) for (int rep_ = 0; rep_ < ((PROBE_DUP) == (k) ? 2 : 1); ++rep_) if ((rep_ ? __syncthreads() : (void)0), true)
    LAS int* ps = (LAS int*)(F.lds + LDSCTL_OFF);

    if (IN(0)) REP(0) { p0_prologue(F); } SEAM(0);
#if PROBE_DUP == 68
    if (IN(0) && IN(1)) { for (int i = 0; i < 10; ++i) xcd_barrier(bar); }
#endif
    if (IN(1)) REP(1) { p1_norm1(F); } SEAM(1);
    if (IN(2)) {
        const int nconv = F.G >= 128 ? 32 : 0, GG = F.G - nconv;
        if (F.bid >= GG) conv_worker(F);
        else {
            gk::DenseOrder S; S.init(L, NINP, D * 2, GG, F.bid); S.nExtra = 7; S.Bt = (const char*)(F.ws + WS_WIN);
            gk::EpiBf16Store E{(bf16*)(F.ws + WS_Z), NINP, 1.0f};
            gk::gemm_core(F.lds, (const char*)(F.ws + WS_HA), D * 2, S, E);
            conv_worker(F);
        }
    }
#if PROBE_DUP >= 60 && PROBE_DUP <= 63
    if (IN(2)) { __syncthreads(); gk::DenseOrder S; S.init(MROWS, NINP, D * 2, F.G, F.bid); S.Bt = (const char*)(F.ws + WS_WIN);
        gk::EpiBf16Store E{(bf16*)(F.ws + WS_CAT), NINP, 1.0f};
        gk::gemm_core(F.lds, (const char*)(F.ws + WS_HA), (D * 2) >> (PROBE_DUP - 60), S, E); }
#endif
#if PROBE_DUP == 64
    if (IN(2)) { __syncthreads(); gk::DenseOrder S; S.init(MROWS, NINP, D * 2, F.G, F.bid); S.Bt = (const char*)(F.ws + WS_WIN);
        gk::EpiLinearStore E{(bf16*)(F.ws + WS_CAT)};
        gk::gemm_core(F.lds, (const char*)(F.ws + WS_HA), (D * 2) >> 3, S, E); }
#endif
    SEAM(2);
    if (IN(3)) REP(3) {
        for (int it = F.bid; it < 1040; it += F.G) ml_prep_item(F, it);
        for (int tile = F.bid; tile < 256; tile += F.G) p3_filter_tile(F, tile);
        for (int tile = F.bid; tile < 1024; tile += F.G) p3_uin_tile(F, tile);
    } SEAM(3);
    if (IN(4)) REP(4) {
        ml_scan(F);
#if PROBE_DUP == 70
        ml_scan(F);
#endif
        __syncthreads();
        for (int job = F.bid; job < 256; job += F.G) p4_fft_job(F, job);
#if PROBE_DUP == 71
        for (int job = F.bid; job < 256; job += F.G) p4_fft_job(F, job);
#endif
    } SEAM(4);
    if (IN(5)) REP(5) {
        for (int it = F.bid; it < 1024; it += F.G) ml_out_item(F, it);
        for (int tile = F.bid; tile < 1024; tile += F.G) p5_hy_finish_tile(F, tile);
    } SEAM(5);
    if (IN(6)) {
        gk::DenseOrder S; S.init(L, D, D * 2, F.G, F.bid); S.Bt = (const char*)(F.ws + WS_WOUT);
        gk::EpiGateBf16 E{(bf16*)(F.ws + WS_YG), D, (const float*)(F.ws + WS_MOD) + 4096};
        gk::gemm_core(F.lds, (const char*)(F.ws + WS_CAT), D * 2, S, E);
    } SEAM(6);
    if (IN(7)) { p6_norm2_router<false>(F); }
#if PROBE_DUP == 66
    if (IN(7)) { __syncthreads(); p6_norm2_router<true>(F); }
#endif
    SEAM(7);
    if (IN(8)) { p7_fill_rows(F); } SEAM(8);
#define MOE_GU(h) do { build_pstart(F); \
        gk::GroupOrder<4, true> S; S.ntile = ps[(h) * 66 + 65] >> 8; S.G = F.G; S.c = F.bid; S.KB = D; S.pstart = ps + (h) * 66; S.texp = (const LAS unsigned char*)(F.lds + LDSCTL_OFF + 2048); S.rtok = (const int*)(F.ws + WS_RTOK) + (h) * MAXROWS; \
        S.Bt = (const char*)(F.ws + WS_W13); S.bstride = (size_t)1024 * D; \
        gk::EpiGateUpF8 E{(unsigned char*)(F.ws + WS_HR), 1.0f / W13_PRE, HR_PRE}; \
        gk::gemm_core<gk::EpiGateUpF8, gk::GroupOrder<4, true>, true>(F.lds, (const char*)(F.ws + WS_HA), D, S, E); } while (0)
#define MOE_DN(h) do { build_pstart(F); \
        gk::GroupOrder<8, false> S; S.ntile = ps[(h) * 66 + 65] >> 8; S.G = F.G; S.c = F.bid; S.KB = DE; S.pstart = ps + (h) * 66; S.texp = (const LAS unsigned char*)(F.lds + LDSCTL_OFF + 2048); S.rtok = nullptr; \
        S.Bt = (const char*)(F.ws + WS_W2); S.bstride = (size_t)D * DE; \
        gk::EpiF8Store E{(unsigned char*)(F.ws + WS_Y2), D, Y2_PRE / (W2_PRE * HR_PRE), (unsigned)((size_t)MAXROWS * D)}; \
        gk::gemm_core<gk::EpiF8Store, gk::GroupOrder<8, false>, true>(F.lds, (const char*)(F.ws + WS_HR), DE, S, E); } while (0)
    if (IN(9)) REP(9) { MOE_GU(0); } SEAM(9);
    if (IN(10)) REP(10) { MOE_DN(0); } SEAM(10);
    if (IN(11)) { build_pstart(F); moe_combine(F, 0, F.out); }
#undef IN
#undef SEAM
}

extern "C" void kernel_launch(void* const* d_in, const int* in_sizes, int n_in, void* d_out, int out_size, void* d_ws, size_t ws_size, hipStream_t stream) {
    static int grid = 0;
    if (grid == 0) {
        if (n_in != 36 || out_size != L * D || ws_size < WS_END) { fprintf(stderr, "kernel_launch: unexpected shapes: n_in %d out %d ws %zu (need %zu)\n", n_in, out_size, ws_size, (size_t)WS_END); grid = -1; return; }
        int dev = 0, cus = 0, per_cu = 0;
        if (hipGetDevice(&dev) != hipSuccess || hipDeviceGetAttribute(&cus, hipDeviceAttributeMultiprocessorCount, dev) != hipSuccess) { grid = -1; return; }
        if (hipFuncSetAttribute((const void*)fwd_kernel, hipFuncAttributeMaxDynamicSharedMemorySize, LDS_BYTES) != hipSuccess) { fprintf(stderr, "kernel_launch: hipFuncSetAttribute failed\n"); grid = -1; return; }
        if (hipOccupancyMaxActiveBlocksPerMultiprocessor(&per_cu, (const void*)fwd_kernel, NT, LDS_BYTES) != hipSuccess || per_cu < 1) fprintf(stderr, "kernel_launch: occupancy query says %d\n", per_cu);
        (void)hipGetLastError();
        grid = cus < 256 ? cus : 256;
    }
    if (grid < 0) return;
    if (hipMemsetAsync((char*)d_ws + WS_CTL, 0, CTL_ZERO_BYTES, stream) != hipSuccess) return;
    Args a{};
    for (int i = 0; i < 36; ++i) a.in[i] = (const float*)d_in[i];
    a.out = (float*)d_out; a.ws = (unsigned char*)d_ws;
    const int stop = MK_STOP_AFTER < N_PHASES ? MK_STOP_AFTER + 1 : N_PHASES;
#if MK_N_LAUNCHES == 1
    a.ph_lo = 0; a.ph_hi = stop;
    hipLaunchKernelGGL(fwd_kernel, dim3(grid), dim3(NT), LDS_BYTES, stream, a);
#else
    for (int p = 0; p < stop; ++p) { a.ph_lo = p; a.ph_hi = p + 1; hipLaunchKernelGGL(fwd_kernel, dim3(grid), dim3(NT), LDS_BYTES, stream, a); }
#endif
}
```
